# Optimizing an MI355X kernel written in HIP

```python
import math
import jax, jax.numpy as jnp
from jax import lax
import numpy as np

D_MODEL = 1024
BATCH = 4
SEQ = 4096
DEPTH = 1

DN_HEADS = 4
DN_HEAD_DIM = 128
DN_WIDTH = DN_HEADS * DN_HEAD_DIM
DN_QKV_WIDTH = 3 * DN_WIDTH
DN_CONV = 4
DN_CHUNK = 64
SWA_HEADS = 8
SWA_KV_HEADS = 2
SWA_HEAD_DIM = 64
SWA_GROUP = SWA_HEADS // SWA_KV_HEADS
SWA_WIDTH = SWA_HEADS * SWA_HEAD_DIM
SWA_KV_WIDTH = SWA_KV_HEADS * SWA_HEAD_DIM
WINDOW = 128
SWA_BLOCK = 128
REL_BUCKETS = 32
REL_MAX_DIST = 128
N_BRANCHES = 2
D_FF = ((8 * D_MODEL // 3 + 255) // 256) * 256
D_IN = DN_QKV_WIDTH + DN_WIDTH + 2 * DN_HEADS + SWA_WIDTH + 2 * SWA_KV_WIDTH + N_BRANCHES * D_MODEL
EPS = 1e-6

kernel_name = "hybrid_gdn_swa_gated_merge"


def rms_norm(x, gain):
    xf = x.astype(jnp.float32)
    y = xf * lax.rsqrt(jnp.mean(xf * xf, axis=-1, keepdims=True) + EPS)
    return (y * gain.astype(jnp.float32)).astype(x.dtype)


def l2_norm(x):
    xf = x.astype(jnp.float32)
    return xf * lax.rsqrt(jnp.sum(xf * xf, axis=-1, keepdims=True) + EPS)


def causal_dwconv(x, w):
    k = w.shape[0]
    return lax.conv_general_dilated(
        x, w[:, None, :], window_strides=(1,), padding=((k - 1, 0),),
        dimension_numbers=("NWC", "WIO", "NWC"), feature_group_count=x.shape[-1])


def chunk_gated_delta_rule(q, k, v, g, beta):
    B, S, H, DK = q.shape
    DV = v.shape[-1]
    C = DN_CHUNK
    NC = S // C
    q = q * (DK ** -0.5)

    def to_chunks(t):
        return t.reshape(B, NC, C, H, t.shape[-1]).transpose(0, 3, 1, 2, 4)

    qc, kc, vc = to_chunks(q), to_chunks(k), to_chunks(v)
    gc = jnp.cumsum(g.reshape(B, NC, C, H).transpose(0, 3, 1, 2), axis=-1)
    bc = beta.reshape(B, NC, C, H).transpose(0, 3, 1, 2)[..., None]
    k_beta = kc * bc
    v_beta = vc * bc

    idx = jnp.arange(C)
    lower_incl = idx[:, None] >= idx[None, :]
    strict_lower = idx[:, None] > idx[None, :]
    decay = jnp.exp(jnp.where(lower_incl, gc[..., :, None] - gc[..., None, :], -jnp.inf))

    a_mat = jnp.where(strict_lower, jnp.einsum("bhncd,bhnsd->bhncs", k_beta, kc) * decay, 0.0)
    lhs = a_mat + jnp.eye(C, dtype=a_mat.dtype)
    rhs = jnp.concatenate([v_beta, k_beta * jnp.exp(gc)[..., None]], axis=-1)
    sol = lax.linalg.triangular_solve(lhs, rhs, left_side=True, lower=True, unit_diagonal=True)
    u, w = sol[..., :DV], sol[..., DV:]
    qk = jnp.einsum("bhncd,bhnsd->bhncs", qc, kc) * decay

    def step(state, inp):
        q_i, k_i, u_i, w_i, g_i, qk_i = inp
        v_new = u_i - jnp.einsum("bhck,bhkv->bhcv", w_i, state)
        o_i = (jnp.einsum("bhck,bhkv->bhcv", q_i * jnp.exp(g_i)[..., None], state)
               + jnp.einsum("bhcs,bhsv->bhcv", qk_i, v_new))
        g_last = g_i[..., -1]
        k_dec = k_i * jnp.exp(g_last[..., None] - g_i)[..., None]
        state = state * jnp.exp(g_last)[..., None, None] + jnp.einsum("bhck,bhcv->bhkv", k_dec, v_new)
        return state, o_i

    xs = tuple(jnp.moveaxis(t, 2, 0) for t in (qc, kc, u, w, gc, qk))
    state0 = jnp.zeros((B, H, DK, DV), jnp.float32)
    _, o = lax.scan(step, state0, xs)
    return o.transpose(1, 0, 3, 2, 4).reshape(B, S, H, DV)


def gated_deltanet_branch(qkv, z, b_raw, a_raw, conv_w, a_log, dt_bias, out_gain):
    B, S, _ = qkv.shape
    qkv = jax.nn.silu(causal_dwconv(qkv, conv_w))
    q, k, v = jnp.split(qkv, 3, axis=-1)
    q = l2_norm(q.reshape(B, S, DN_HEADS, DN_HEAD_DIM))
    k = l2_norm(k.reshape(B, S, DN_HEADS, DN_HEAD_DIM))
    v = v.reshape(B, S, DN_HEADS, DN_HEAD_DIM).astype(jnp.float32)
    beta = jax.nn.sigmoid(b_raw.astype(jnp.float32))
    g = -jnp.exp(a_log.astype(jnp.float32)) * jax.nn.softplus(a_raw.astype(jnp.float32) + dt_bias.astype(jnp.float32))
    o = chunk_gated_delta_rule(q, k, v, g, beta)
    o = rms_norm(o, out_gain) * jax.nn.silu(z.reshape(B, S, DN_HEADS, DN_HEAD_DIM).astype(jnp.float32))
    return o.reshape(B, S, DN_WIDTH).astype(qkv.dtype)


def t5_causal_bucket(dist):
    n = jnp.maximum(dist, 0)
    max_exact = REL_BUCKETS // 2
    nf = jnp.maximum(n, 1).astype(jnp.float32)
    large = max_exact + (jnp.log(nf / max_exact) / math.log(REL_MAX_DIST / max_exact)
                         * (REL_BUCKETS - max_exact)).astype(jnp.int32)
    large = jnp.minimum(large, REL_BUCKETS - 1)
    return jnp.where(n < max_exact, n, large)


def sliding_window_branch(q, k, v, q_gain, k_gain, sinks, rel_bias):
    B, S, _ = q.shape
    NB = S // SWA_BLOCK
    q = rms_norm(q.reshape(B, S, SWA_HEADS, SWA_HEAD_DIM), q_gain)
    k = rms_norm(k.reshape(B, S, SWA_KV_HEADS, SWA_HEAD_DIM), k_gain)
    v = v.reshape(B, S, SWA_KV_HEADS, SWA_HEAD_DIM)
    qb = q.reshape(B, NB, SWA_BLOCK, SWA_KV_HEADS, SWA_GROUP, SWA_HEAD_DIM).astype(jnp.float32)

    def band(t):
        tp = jnp.pad(t, ((0, 0), (SWA_BLOCK, 0), (0, 0), (0, 0)))
        tp = tp.reshape(B, NB + 1, SWA_BLOCK, SWA_KV_HEADS, SWA_HEAD_DIM)
        return jnp.concatenate([tp[:, :-1], tp[:, 1:]], axis=2).astype(jnp.float32)

    kb, vb = band(k), band(v)
    logits = jnp.einsum("bnqkgd,bnskd->bnkgqs", qb, kb) * (SWA_HEAD_DIM ** -0.5)

    qi = jnp.arange(SWA_BLOCK)[:, None]
    kj = jnp.arange(2 * SWA_BLOCK)[None, :]
    dist = SWA_BLOCK + qi - kj
    in_window = (dist >= 0) & (dist < WINDOW)
    key_pos = (jnp.arange(NB)[:, None] - 1) * SWA_BLOCK + jnp.arange(2 * SWA_BLOCK)[None, :]
    mask = in_window[None, :, :] & (key_pos >= 0)[:, None, :]

    bias = rel_bias.astype(jnp.float32)[t5_causal_bucket(dist)]
    bias = bias.transpose(2, 0, 1).reshape(SWA_KV_HEADS, SWA_GROUP, SWA_BLOCK, 2 * SWA_BLOCK)
    logits = jnp.where(mask[None, :, None, None], logits + bias, -jnp.inf)

    sink = sinks.astype(jnp.float32).reshape(SWA_KV_HEADS, SWA_GROUP)[None, None, :, :, None, None]
    m = jnp.maximum(jnp.max(logits, axis=-1, keepdims=True), sink)
    p = jnp.exp(logits - m)
    denom = jnp.sum(p, axis=-1, keepdims=True) + jnp.exp(sink - m)
    out = jnp.einsum("bnkgqs,bnskd->bnqkgd", p / denom, vb)
    return out.reshape(B, S, SWA_WIDTH).astype(q.dtype)


def split_combined(p):
    sizes = (DN_QKV_WIDTH, DN_WIDTH, DN_HEADS, DN_HEADS, SWA_WIDTH, SWA_KV_WIDTH, SWA_KV_WIDTH,
             N_BRANCHES * D_MODEL)
    return jnp.split(p, np.cumsum(sizes)[:-1].tolist(), axis=-1)


def setup_inputs(seed: int = 0) -> dict:
    key = jax.random.key(seed)
    ks = jax.random.split(key, 20)
    f32 = jnp.float32
    L = DEPTH

    def nrm(k, shape, scale):
        return jax.random.normal(k, shape, f32) * scale

    dt = jnp.exp(jax.random.uniform(ks[5], (L, DN_HEADS), f32, math.log(1e-3), math.log(1e-1)))
    return {
        "x": nrm(ks[0], (BATCH, SEQ, D_MODEL), 1.0),
        "attn_norm": 1.0 + nrm(ks[1], (L, D_MODEL), 0.02),
        "w_in": nrm(ks[2], (L, D_MODEL, D_IN), D_MODEL ** -0.5),
        "dn_conv": nrm(ks[3], (L, DN_CONV, DN_QKV_WIDTH), DN_CONV ** -0.5),
        "dn_a_log": jnp.log(jax.random.uniform(ks[4], (L, DN_HEADS), f32, 1.0, 16.0)),
        "dn_dt_bias": dt + jnp.log(-jnp.expm1(-dt)),
        "dn_out_norm": 1.0 + nrm(ks[6], (L, DN_HEAD_DIM), 0.02),
        "swa_q_norm": 1.0 + nrm(ks[7], (L, SWA_HEAD_DIM), 0.02),
        "swa_k_norm": 1.0 + nrm(ks[8], (L, SWA_HEAD_DIM), 0.02),
        "swa_sinks": nrm(ks[9], (L, SWA_HEADS), 0.5),
        "rel_bias": nrm(ks[10], (REL_BUCKETS, SWA_HEADS), 0.1),
        "w_branch_dn": nrm(ks[11], (L, DN_WIDTH, D_MODEL), DN_WIDTH ** -0.5),
        "w_branch_swa": nrm(ks[12], (L, SWA_WIDTH, D_MODEL), SWA_WIDTH ** -0.5),
        "w_out": nrm(ks[13], (L, D_MODEL, D_MODEL), D_MODEL ** -0.5),
        "ffn_norm": 1.0 + nrm(ks[14], (L, D_MODEL), 0.02),
        "w_gate": nrm(ks[15], (L, D_MODEL, D_FF), D_MODEL ** -0.5),
        "w_up": nrm(ks[16], (L, D_MODEL, D_FF), D_MODEL ** -0.5),
        "w_down": nrm(ks[17], (L, D_FF, D_MODEL), D_FF ** -0.5),
    }


def reference(x, attn_norm, w_in, dn_conv, dn_a_log, dn_dt_bias, dn_out_norm, swa_q_norm,
              swa_k_norm, swa_sinks, rel_bias, w_branch_dn, w_branch_swa, w_out, ffn_norm,
              w_gate, w_up, w_down):
    B, S, _ = x.shape
    for l in range(DEPTH):
        h = rms_norm(x, attn_norm[l])
        proj = h @ w_in[l]
        dn_qkv, dn_z, dn_b, dn_a, sq, sk, sv, gate_raw = split_combined(proj)
        y_dn = gated_deltanet_branch(dn_qkv, dn_z, dn_b, dn_a, dn_conv[l], dn_a_log[l],
                                     dn_dt_bias[l], dn_out_norm[l])
        y_swa = sliding_window_branch(sq, sk, sv, swa_q_norm[l], swa_k_norm[l], swa_sinks[l], rel_bias)
        gates = jax.nn.sigmoid(gate_raw.astype(jnp.float32)).astype(x.dtype)
        gates = gates.reshape(B, S, N_BRANCHES, D_MODEL)
        merged = gates[:, :, 0] * (y_dn @ w_branch_dn[l]) + gates[:, :, 1] * (y_swa @ w_branch_swa[l])
        x = x + merged @ w_out[l]
        h2 = rms_norm(x, ffn_norm[l])
        x = x + (jax.nn.silu(h2 @ w_gate[l]) * (h2 @ w_up[l])) @ w_down[l]
    return x
```

```cpp
#include <hip/hip_runtime.h>
#include <cstdio>
#include <cstdint>

namespace pg8 {
#define PG8_LAS __attribute__((address_space(3)))
typedef unsigned short bf16_t;
typedef short bf16x8 __attribute__((ext_vector_type(8)));
typedef float f32x4 __attribute__((ext_vector_type(4)));
typedef unsigned u32x4 __attribute__((ext_vector_type(4)));
typedef unsigned u32x2 __attribute__((ext_vector_type(2)));
constexpr int BM = 256, BK = 64, HALF = 128, HTB = HALF * BK * 2  , STAGE_BYTES = 8 * HTB, NXCD = 8, WGM = 8;

__host__ __device__ __forceinline__ int lds_byte(int r, int c) { const int st = (r >> 4) * 2 + (c >> 5), rr = r & 15, cc = c & 31, ob = rr * 64 + cc * 2; return st * 1024 + (ob ^ (((ob >> 9) & 1) << 5)); }
__host__ __device__ __forceinline__ void stage_rc(int b, int& R, int& C) { const int st = b / 1024, sb = b % 1024, swz = sb ^ (((sb >> 9) & 1) << 5); R = (st >> 1) * 16 + swz / 64; C = (st & 1) * 32 + (swz % 64) / 2; }
__host__ __device__ __forceinline__ int perm32(int rho) { const int n = rho >> 4, i = rho & 15; return 8 * (i >> 2) + 4 * n + (i & 3); }

struct Unit { int pm, pn; };
struct Gemm { const bf16_t* A; const bf16_t* Bt; int M, N, K; };

struct StaticOrder {
    int nM, nN, nwg, G, c;
    __host__ __device__ void init(int M, int N, int G_, int c_) { nM = M / BM; nN = N / BM; nwg = nM * nN; G = G_; c = c_; }
    __host__ __device__ bool next(int i, Unit& u) const {
        const long L = (long)i * G + c; if (L >= nwg) return false;
        int wgid = (int)L; { const int q = nwg / NXCD, r = nwg % NXCD, xcd = wgid % NXCD, off = wgid / NXCD; wgid = (xcd < r ? xcd * (q + 1) : r * (q + 1) + (xcd - r) * q) + off; }
        const int nig = WGM * nN, gid = wgid / nig, fm = gid * WGM, gsz = (nM - fm) < WGM ? (nM - fm) : WGM;
        u.pm = fm + ((wgid % nig) % gsz); u.pn = (wgid % nig) / gsz; return true;
    }
    __device__ __forceinline__ void a_ready(const Unit&) const {}
    __device__ __forceinline__ void done(const Unit&) const {}
};
struct PairedOrder {
    StaticOrder so;
    __host__ __device__ void init(int M, int N, int G_, int c_) { so.init(M, N, G_, c_); }
    __host__ __device__ bool next(int i, Unit& u) const { if (!so.next(i >> 1, u)) return false; if (i & 1) { u.pm += so.nM; u.pn += so.nN; } return true; }
    __device__ __forceinline__ void a_ready(const Unit&) const {}
    __device__ __forceinline__ void done(const Unit&) const {}
};

__device__ __forceinline__ unsigned cvt_pk_bf16(float lo, float hi) { unsigned r; asm volatile("v_cvt_pk_bf16_f32 %0, %1, %2" : "=v"(r) : "v"(lo), "v"(hi)); return r; }
__device__ __forceinline__ float bf_lo(unsigned w) { return __builtin_bit_cast(float, w << 16); }
__device__ __forceinline__ float bf_hi(unsigned w) { return __builtin_bit_cast(float, w & 0xffff0000u); }
__device__ __forceinline__ float sigmoidf_(float x) { return 1.0f / (1.0f + __expf(-x)); }


struct EpiProj {
    static constexpr bool PERM = true, AFTER_DRAIN = false;
    bf16_t* O; int ldc; const float* rstd;
    __device__ __forceinline__ bool keep(const Unit&) const { return false; }
    __device__ __forceinline__ void operator()(f32x4 (&acc)[2][2][4][2], const Unit& u, int wr, int wc, int fr, int fq) const {
        const int row0 = u.pm * BM + wr * 64 + fr, col0 = u.pn * BM + wc * 32 + 8 * fq;
#pragma unroll
        for (int ai = 0; ai < 2; ++ai)
#pragma unroll
            for (int m = 0; m < 4; ++m) { const int row = row0 + ai * HALF + m * 16; const float s = rstd[row]; bf16_t* rowp = O + (size_t)row * ldc + col0;
#pragma unroll
                for (int bj = 0; bj < 2; ++bj) { const f32x4 v0 = acc[ai][bj][m][0] * s, v1 = acc[ai][bj][m][1] * s;
                    u32x4 w; w.x = cvt_pk_bf16(v0[0], v0[1]); w.y = cvt_pk_bf16(v0[2], v0[3]); w.z = cvt_pk_bf16(v1[0], v1[1]); w.w = cvt_pk_bf16(v1[2], v1[3]);
                    *(u32x4*)(rowp + bj * HALF) = w; } }
    }
};
struct EpiMerge {
    static constexpr bool PERM = true, AFTER_DRAIN = false;
    const bf16_t* G; int ldg; bf16_t* O; int ldc; int nM, nN;
    __device__ __forceinline__ bool keep(const Unit& u) const { return u.pm < nM; }
    __device__ __forceinline__ void operator()(f32x4 (&acc)[2][2][4][2], const Unit& u, int wr, int wc, int fr, int fq) const {
        const bool second = u.pm >= nM; const int pm = second ? u.pm - nM : u.pm, pn = second ? u.pn - nN : u.pn;
        const int row0 = pm * BM + wr * 64 + fr, col0 = pn * BM + wc * 32 + 8 * fq;
#pragma unroll
        for (int ai = 0; ai < 2; ++ai)
#pragma unroll
            for (int m = 0; m < 4; ++m) { const int row = row0 + ai * HALF + m * 16;
#pragma unroll
                for (int bj = 0; bj < 2; ++bj) { const int col = col0 + bj * HALF;
                    const u32x4 ga = *(const u32x4*)(G + (size_t)row * ldg + col), gb = *(const u32x4*)(G + (size_t)row * ldg + 1024 + col);
                    float ea[8], eb[8];
#pragma unroll
                    for (int j = 0; j < 4; ++j) { ea[2 * j] = __expf(-bf_lo(ga[j])); ea[2 * j + 1] = __expf(-bf_hi(ga[j])); eb[2 * j] = __expf(-bf_lo(gb[j])); eb[2 * j + 1] = __expf(-bf_hi(gb[j])); }
                    if (!second) {
#pragma unroll
                        for (int j = 0; j < 4; ++j) { acc[ai][bj][m][0][j] *= (1.0f + eb[j]) / (1.0f + ea[j]); acc[ai][bj][m][1][j] *= (1.0f + eb[4 + j]) / (1.0f + ea[4 + j]); }
                    } else {
                        f32x4 v0, v1;
#pragma unroll
                        for (int j = 0; j < 4; ++j) { v0[j] = acc[ai][bj][m][0][j] / (1.0f + eb[j]); v1[j] = acc[ai][bj][m][1][j] / (1.0f + eb[4 + j]); }
                        u32x4 w; w.x = cvt_pk_bf16(v0[0], v0[1]); w.y = cvt_pk_bf16(v0[2], v0[3]); w.z = cvt_pk_bf16(v1[0], v1[1]); w.w = cvt_pk_bf16(v1[2], v1[3]);
                        *(u32x4*)(O + (size_t)row * ldc + col) = w; } } }
    }
};
struct EpiX1 {
    static constexpr bool PERM = false, AFTER_DRAIN = false;
    const float* X; float* out; bf16_t* xb; float* ssq; int ldc;
    __device__ __forceinline__ bool keep(const Unit&) const { return false; }
    __device__ __forceinline__ void operator()(f32x4 (&acc)[2][2][4][2], const Unit& u, int wr, int wc, int fr, int fq) const {
        const int row0 = u.pm * BM + wr * 64 + fr, col0 = u.pn * BM + wc * 32 + 4 * fq;
#pragma unroll
        for (int ai = 0; ai < 2; ++ai)
#pragma unroll
            for (int m = 0; m < 4; ++m) { const int row = row0 + ai * HALF + m * 16; const size_t off = (size_t)row * ldc + col0; float ss = 0.f;
#pragma unroll
                for (int bj = 0; bj < 2; ++bj)
#pragma unroll
                    for (int n = 0; n < 2; ++n) { const f32x4 xv = *(const f32x4*)(X + off + bj * HALF + n * 16); const f32x4 o = xv + acc[ai][bj][m][n];
                        *(f32x4*)(out + off + bj * HALF + n * 16) = o; ss += (o[0] * o[0] + o[1] * o[1]) + (o[2] * o[2] + o[3] * o[3]);
                        u32x2 w; w.x = cvt_pk_bf16(o[0], o[1]); w.y = cvt_pk_bf16(o[2], o[3]); *(u32x2*)(xb + off + bj * HALF + n * 16) = w; }
                ss += __shfl_xor(ss, 16); ss += __shfl_xor(ss, 32);
                if (fq == 0) ssq[(size_t)row * 16 + u.pn * 4 + wc] = ss; }
    }
};
struct EpiSwiGLU {
    static constexpr bool PERM = true, AFTER_DRAIN = false;
    bf16_t* O; int ldc; const float* ssq; float eps;
    __device__ __forceinline__ bool keep(const Unit&) const { return false; }
    __device__ __forceinline__ void operator()(f32x4 (&acc)[2][2][4][2], const Unit& u, int wr, int wc, int fr, int fq) const {
        const int row0 = u.pm * BM + wr * 64 + fr, col0 = u.pn * HALF + wc * 32 + 8 * fq;
#pragma unroll
        for (int ai = 0; ai < 2; ++ai)
#pragma unroll
            for (int m = 0; m < 4; ++m) { const int row = row0 + ai * HALF + m * 16;
                const f32x4* sp = (const f32x4*)(ssq + (size_t)row * 16); const f32x4 s0 = sp[0], s1 = sp[1], s2 = sp[2], s3 = sp[3];
                const float tot = ((s0[0] + s0[1]) + (s0[2] + s0[3])) + ((s1[0] + s1[1]) + (s1[2] + s1[3])) + ((s2[0] + s2[1]) + (s2[2] + s2[3])) + ((s3[0] + s3[1]) + (s3[2] + s3[3]));
                const float s = __builtin_amdgcn_rsqf(tot * (1.0f / 1024.0f) + eps);
                float a[8];
#pragma unroll
                for (int n = 0; n < 2; ++n)
#pragma unroll
                    for (int j = 0; j < 4; ++j) { const float g = acc[ai][0][m][n][j] * s, up = acc[ai][1][m][n][j] * s; a[4 * n + j] = g * up / (1.0f + __expf(-g)); }
                u32x4 w; w.x = cvt_pk_bf16(a[0], a[1]); w.y = cvt_pk_bf16(a[2], a[3]); w.z = cvt_pk_bf16(a[4], a[5]); w.w = cvt_pk_bf16(a[6], a[7]);
                *(u32x4*)(O + (size_t)row * ldc + col0) = w; }
    }
};
struct EpiOut {
    static constexpr bool PERM = false, AFTER_DRAIN = false;
    float* out; int ldc;
    __device__ __forceinline__ bool keep(const Unit&) const { return false; }
    __device__ __forceinline__ void operator()(f32x4 (&acc)[2][2][4][2], const Unit& u, int wr, int wc, int fr, int fq) const {
        const int row0 = u.pm * BM + wr * 64 + fr, col0 = u.pn * BM + wc * 32 + 4 * fq;
#pragma unroll
        for (int ai = 0; ai < 2; ++ai)
#pragma unroll
            for (int m = 0; m < 4; ++m) { float* rowp = out + (size_t)(row0 + ai * HALF + m * 16) * ldc + col0;
#pragma unroll
                for (int bj = 0; bj < 2; ++bj)
#pragma unroll
                    for (int n = 0; n < 2; ++n) { const f32x4 b = *(const f32x4*)(rowp + bj * HALF + n * 16); *(f32x4*)(rowp + bj * HALF + n * 16) = b + acc[ai][bj][m][n]; } }
    }
};

template <class Epi, class Sched, bool ALIGN_EPI = false, bool SP2 = false>
__device__ __forceinline__ void gemm_phase(PG8_LAS unsigned char* lds, const Gemm g, const Sched& S, const Epi& E) {
    const int tid = threadIdx.x, wid = __builtin_amdgcn_readfirstlane(tid >> 6), lane = tid & 63, wr = wid >> 2, wc = wid & 3, fr = lane & 15, fq = lane >> 4;
    const int K = g.K, nt = K / BK;
    unsigned voffA[2], voffB[2];
#pragma unroll
    for (int i = 0; i < 2; ++i) { int R, C; stage_rc(tid * 16 + i * 8192, R, C); const int Rb = Epi::PERM ? ((R & ~31) + perm32(R & 31)) : R;
        voffA[i] = (unsigned)(R * K + C) * 2u; voffB[i] = (unsigned)(Rb * K + C) * 2u; }
    const size_t kstep = (size_t)(BK * 2);
    const size_t hstep = (size_t)HALF * K * 2;
    const size_t tstep = 2 * hstep;
    const unsigned ldsw = (unsigned)wid * 1024u;
    const int aoff = lds_byte(wr * 64 + fr, fq * 8), boff = lds_byte(wc * 32 + fr, fq * 8);
#define PG8_SA(b, h) (((b) * 2 + (h)) * HTB)
#define PG8_SB(b, h) ((4 + (b) * 2 + (h)) * HTB)
#define PG8_STAGE(bufoff, gbase, voff) do { _Pragma("unroll") for (int _i = 0; _i < 2; ++_i) \
        __builtin_amdgcn_global_load_lds((const unsigned*)((const char*)(gbase) + (voff)[_i]), (PG8_LAS unsigned*)(lds + (bufoff) + ldsw + _i * 8192), 16, 0, 0); } while (0)
#define PG8_LDA(dst, b, h) do { _Pragma("unroll") for (int m = 0; m < 4; ++m) _Pragma("unroll") for (int k = 0; k < 2; ++k) dst[m][k] = *(const PG8_LAS bf16x8*)(lds + PG8_SA(b, h) + aoff + m * 2048 + k * 1024); } while (0)
#define PG8_LDB(dst, b, h) do { _Pragma("unroll") for (int n = 0; n < 2; ++n) _Pragma("unroll") for (int k = 0; k < 2; ++k) dst[n][k] = *(const PG8_LAS bf16x8*)(lds + PG8_SB(b, h) + boff + n * 2048 + k * 1024); } while (0)
#define PG8_MMA(ai, bj, At, Bt) do { __builtin_amdgcn_s_setprio(1); _Pragma("unroll") for (int m = 0; m < 4; ++m) _Pragma("unroll") for (int n = 0; n < 2; ++n) _Pragma("unroll") for (int k = 0; k < 2; ++k) \
        acc[ai][bj][m][n] = __builtin_amdgcn_mfma_f32_16x16x32_bf16(Bt[n][k], At[m][k], acc[ai][bj][m][n], 0, 0, 0); __builtin_amdgcn_s_setprio(0); } while (0)
#define PG8_WAIT_V(n) asm volatile("s_waitcnt vmcnt(" #n ")" ::: "memory")
#define PG8_WAIT_L(n) asm volatile("s_waitcnt lgkmcnt(" #n ")" ::: "memory")
#define PG8_BAR __builtin_amdgcn_s_barrier()
#define PG8_SCHED __builtin_amdgcn_sched_barrier(0)
    Unit cur, nxt; int ui = 0;
    if (!S.next(0, cur)) return;
    f32x4 acc[2][2][4][2];
#pragma unroll
    for (int a = 0; a < 2; ++a)
#pragma unroll
        for (int b = 0; b < 2; ++b)
#pragma unroll
            for (int m = 0; m < 4; ++m)
#pragma unroll
                for (int n = 0; n < 2; ++n) acc[a][b][m][n] = (f32x4){0.f, 0.f, 0.f, 0.f};
    bf16x8 At[4][2], B0[2][2], B1[2][2];
    const char* cA = (const char*)g.A + (size_t)cur.pm * tstep; const char* cB = (const char*)g.Bt + (size_t)cur.pn * tstep;
    S.a_ready(cur);
    if constexpr (SP2) {
        PG8_STAGE(PG8_SB(0, 0), cB, voffB); PG8_STAGE(PG8_SB(0, 1), cB + hstep, voffB); PG8_STAGE(PG8_SA(0, 0), cA, voffA); PG8_STAGE(PG8_SA(0, 1), cA + hstep, voffA);
        if (wr == 1) PG8_BAR;
        PG8_WAIT_V(2); PG8_BAR;
        PG8_STAGE(PG8_SB(1, 0), cB + kstep, voffB); PG8_STAGE(PG8_SA(1, 0), cA + kstep, voffA); PG8_STAGE(PG8_SB(1, 1), cB + hstep + kstep, voffB);
        PG8_WAIT_V(6); PG8_BAR;
    } else {
        PG8_STAGE(PG8_SB(0, 0), cB, voffB); PG8_STAGE(PG8_SA(0, 0), cA, voffA); PG8_STAGE(PG8_SB(0, 1), cB + hstep, voffB); PG8_STAGE(PG8_SA(0, 1), cA + hstep, voffA);
        if (wr == 1) PG8_BAR;
        PG8_WAIT_V(4); PG8_BAR;
        PG8_STAGE(PG8_SB(1, 0), cB + kstep, voffB); PG8_STAGE(PG8_SA(1, 0), cA + kstep, voffA); PG8_STAGE(PG8_SB(1, 1), cB + hstep + kstep, voffB);
        PG8_WAIT_V(6); PG8_BAR;
    }
    for (;;) {
        const bool has_next = S.next(ui + 1, nxt);
        const char* nA = has_next ? (const char*)g.A + (size_t)nxt.pm * tstep : cA; const char* nB = has_next ? (const char*)g.Bt + (size_t)nxt.pn * tstep : cB;
        for (int t = 0; t < nt; t += 2) {
            const bool last = (t == nt - 2);
            const char* a1 = cA + (size_t)(t + 1) * kstep;
            const char* a2 = last ? nA : cA + (size_t)(t + 2) * kstep; const char* b2 = last ? nB : cB + (size_t)(t + 2) * kstep;
            const char* a3 = a2 + kstep; const char* b3 = b2 + kstep;
            if (last && has_next) S.a_ready(nxt);
            if constexpr (SP2) {
            PG8_LDB(B0, 0, 0); PG8_LDB(B1, 0, 1); PG8_SCHED; PG8_LDA(At, 0, 0); PG8_STAGE(PG8_SA(1, 1), a1 + hstep, voffA);
            PG8_WAIT_V(8); PG8_WAIT_L(0); PG8_BAR; PG8_MMA(0, 0, At, B0); PG8_MMA(0, 1, At, B1); PG8_BAR; PG8_SCHED;
            PG8_LDA(At, 0, 1); PG8_STAGE(PG8_SB(0, 0), b2, voffB); PG8_STAGE(PG8_SB(0, 1), b2 + hstep, voffB); PG8_STAGE(PG8_SA(0, 0), a2, voffA);
            PG8_WAIT_V(8); PG8_WAIT_L(0); PG8_BAR; PG8_MMA(1, 0, At, B0); PG8_MMA(1, 1, At, B1); PG8_BAR; PG8_SCHED;
            PG8_LDB(B0, 1, 0); PG8_LDB(B1, 1, 1); PG8_SCHED; PG8_LDA(At, 1, 0); PG8_STAGE(PG8_SA(0, 1), a2 + hstep, voffA);
            PG8_WAIT_V(8); PG8_WAIT_L(0); PG8_BAR; PG8_MMA(0, 0, At, B0); PG8_MMA(0, 1, At, B1); PG8_BAR; PG8_SCHED;
            PG8_LDA(At, 1, 1); PG8_STAGE(PG8_SB(1, 0), b3, voffB); PG8_STAGE(PG8_SB(1, 1), b3 + hstep, voffB); PG8_STAGE(PG8_SA(1, 0), a3, voffA);
            PG8_WAIT_V(8); PG8_WAIT_L(0); PG8_BAR; PG8_MMA(1, 0, At, B0); PG8_MMA(1, 1, At, B1); PG8_BAR; PG8_SCHED;
            } else {
            PG8_LDB(B0, 0, 0); PG8_SCHED; PG8_LDA(At, 0, 0); PG8_STAGE(PG8_SA(1, 1), a1 + hstep, voffA);
            PG8_WAIT_L(8); PG8_BAR; PG8_WAIT_L(0); PG8_MMA(0, 0, At, B0); PG8_BAR; PG8_SCHED;
            PG8_LDB(B1, 0, 1); PG8_STAGE(PG8_SB(0, 0), b2, voffB);
            PG8_BAR; PG8_WAIT_L(0); PG8_MMA(0, 1, At, B1); PG8_BAR;
            PG8_LDA(At, 0, 1); PG8_STAGE(PG8_SA(0, 0), a2, voffA);
            PG8_BAR; PG8_WAIT_L(0); PG8_MMA(1, 0, At, B0); PG8_BAR; PG8_SCHED;
            PG8_STAGE(PG8_SB(0, 1), b2 + hstep, voffB);
            PG8_WAIT_V(6); PG8_BAR; PG8_MMA(1, 1, At, B1); PG8_BAR;
            PG8_LDB(B0, 1, 0); PG8_SCHED; PG8_LDA(At, 1, 0); PG8_STAGE(PG8_SA(0, 1), a2 + hstep, voffA);
            PG8_WAIT_L(8); PG8_BAR; PG8_WAIT_L(0); PG8_MMA(0, 0, At, B0); PG8_BAR; PG8_SCHED;
            PG8_LDB(B1, 1, 1); PG8_STAGE(PG8_SB(1, 0), b3, voffB);
            PG8_BAR; PG8_WAIT_L(0); PG8_MMA(0, 1, At, B1); PG8_BAR;
            PG8_LDA(At, 1, 1); PG8_STAGE(PG8_SA(1, 0), a3, voffA);
            PG8_BAR; PG8_WAIT_L(0); PG8_MMA(1, 0, At, B0); PG8_BAR; PG8_SCHED;
            PG8_STAGE(PG8_SB(1, 1), b3 + hstep, voffB);
            PG8_WAIT_V(6); PG8_BAR; PG8_MMA(1, 1, At, B1); PG8_BAR;
            }
        }
        if constexpr (ALIGN_EPI) { if (wr == 0) PG8_BAR; }
        if constexpr (!Epi::AFTER_DRAIN) { E(acc, cur, wr, wc, fr, fq); S.done(cur); }
        if (!has_next) break;
        if (!E.keep(cur)) {
#pragma unroll
        for (int a = 0; a < 2; ++a)
#pragma unroll
            for (int b = 0; b < 2; ++b)
#pragma unroll
                for (int m = 0; m < 4; ++m)
#pragma unroll
                    for (int n = 0; n < 2; ++n) acc[a][b][m][n] = (f32x4){0.f, 0.f, 0.f, 0.f};
        }
        cur = nxt; cA = nA; cB = nB; ++ui;
        if constexpr (ALIGN_EPI) { if (wr == 1) PG8_BAR; }
    }
    PG8_WAIT_V(0);
    if constexpr (!ALIGN_EPI) { if (wr == 0) PG8_BAR; }
    PG8_BAR;
    if constexpr (Epi::AFTER_DRAIN) { E.fused(acc, cur, wr, wc, fr, fq, lds, wid, lane); S.done(cur); }
#undef PG8_SA
#undef PG8_SB
#undef PG8_STAGE
#undef PG8_LDA
#undef PG8_LDB
#undef PG8_MMA
#undef PG8_WAIT_V
#undef PG8_WAIT_L
#undef PG8_BAR
#undef PG8_SCHED
}
}

constexpr int NWAVES = 8;
#ifndef MK_N_LAUNCHES
#define MK_N_LAUNCHES 9
#endif
constexpr int PER_PHASE = 9;
constexpr int N_LAUNCHES = MK_N_LAUNCHES;

constexpr int BATCH = 4, SEQ = 4096, D = 1024, M = BATCH * SEQ;
constexpr int DN_H = 4, DN_D = 128, DN_W = 512, DN_QKV = 1536;
constexpr int SW_H = 8, SW_KV = 2, SW_D = 64, SW_W = 512, SW_KVW = 128, WINDOW = 128;
constexpr int FF = 2816;
constexpr int D_IN = 4872;
constexpr int NP = 4864;
constexpr int PC_Z = 1536, PC_SQ = 2048, PC_SK = 2560, PC_SV = 2688, PC_G = 2816;
constexpr float EPS = 1e-6f;

constexpr size_t MiB = 1u << 20;
constexpr size_t WS_CTL = 0, CTL_ZERO_BYTES = 1 * MiB;
constexpr size_t WS_WIN = 1 * MiB;
constexpr size_t WS_WAB = 11 * MiB;
constexpr size_t WS_WOUT = 13 * MiB;
constexpr size_t WS_WGU = 15 * MiB;
constexpr size_t WS_WD = 26 * MiB;
constexpr size_t WS_RSTD = 32 * MiB;
constexpr size_t WS_GB = WS_RSTD + 64 * 1024;
constexpr size_t WS_SSQ = 33 * MiB;
constexpr size_t WS_XB = 34 * MiB;
constexpr size_t WS_Y = 66 * MiB;
constexpr size_t WS_PROJ = 98 * MiB;
constexpr size_t WS_END = 250 * MiB;
static_assert(WS_PROJ + (size_t)M * NP * 2 <= WS_END, "ws map");
constexpr int CW_TMO = 0, CW_BAR = 4096;

constexpr int RING_OFF = 0, RING_BYTES = 131072;
constexpr int LDSCTL_OFF = RING_BYTES, MISC_OFF = LDSCTL_OFF + 320;
constexpr int LDS_BYTES = 147456;

#define GAS __attribute__((address_space(1)))
#define LAS __attribute__((address_space(3)))
typedef unsigned short bf16;
typedef unsigned v4u __attribute__((ext_vector_type(4)));
typedef float f32x4 __attribute__((ext_vector_type(4)));
typedef float f32x2 __attribute__((ext_vector_type(2)));
typedef GAS unsigned gu32;
#define RLX_AGENT __ATOMIC_RELAXED, __HIP_MEMORY_SCOPE_AGENT
#define LDS_WAIT() asm volatile("s_waitcnt lgkmcnt(0)" ::: "memory")
#define VM_WAIT() asm volatile("s_waitcnt vmcnt(0)" ::: "memory")
__device__ __forceinline__ unsigned f2bf(float f) { unsigned u = __builtin_bit_cast(unsigned, f); return (u + 0x7fffu + ((u >> 16) & 1u)) >> 16; }
__device__ __forceinline__ unsigned pk2(float lo, float hi) { return f2bf(lo) | (f2bf(hi) << 16); }
__device__ __forceinline__ float bflo(unsigned w) { return __builtin_bit_cast(float, w << 16); }
__device__ __forceinline__ float bfhi(unsigned w) { return __builtin_bit_cast(float, w & 0xffff0000u); }
__device__ __forceinline__ float bf1(bf16 h) { return __builtin_bit_cast(float, (unsigned)h << 16); }
__device__ __forceinline__ float sigm(float x) { return 1.0f / (1.0f + __expf(-x)); }
__device__ __forceinline__ float wave_sum(float v) {
#pragma unroll
    for (int o = 1; o < 64; o <<= 1) v += __shfl_xor(v, o);
    return v;
}
__device__ __forceinline__ float wave_max(float v) {
#pragma unroll
    for (int o = 1; o < 64; o <<= 1) v = fmaxf(v, __shfl_xor(v, o));
    return v;
}

#define XB_TMO      128
#define XB_XCNT(j)  (256  + 64 * (j))
#define XB_XSUB(j)  (1280 + 64 * (j))
#define XB_XGEN(j)  (2304 + 64 * (j))
#define XB_TOP      3328
#define XB_TOPGEN   3392
#define XCD_BAR_WORDS 3456
#define XB_SPIN_CAP (1u << 18)
__device__ __forceinline__ unsigned xb_ld(unsigned* p)              { return __hip_atomic_load(p, __ATOMIC_RELAXED, __HIP_MEMORY_SCOPE_AGENT); }
__device__ __forceinline__ unsigned xb_add(unsigned* p, unsigned v) { return __hip_atomic_fetch_add(p, v, __ATOMIC_RELAXED, __HIP_MEMORY_SCOPE_AGENT); }
__device__ __forceinline__ unsigned xb_xcc_id() { return (unsigned)__builtin_amdgcn_s_getreg((3 << 11) | 20) & 0xFu; }
#define XB_SPIN(cond, bar) do { unsigned _sp = 0; while (cond) { __builtin_amdgcn_s_sleep(1); \
    if ((++_sp & 255u) == 0u) { if (xb_ld(&(bar)[XB_TMO])) break; if (_sp > XB_SPIN_CAP) { atomicAdd(&(bar)[XB_TMO], 1u); break; } } } } while (0)
struct XcdBarrier { unsigned* bar; unsigned x; volatile LAS unsigned* st; };
__device__ __forceinline__ XcdBarrier xcd_barrier_post(unsigned* bar, volatile LAS unsigned* st) {
    XcdBarrier b; b.bar = bar; b.x = xb_xcc_id(); b.st = st;
    if (threadIdx.x == 0) (void)xb_add(&bar[XB_XCNT(b.x)], 1u);
    return b;
}
__device__ __forceinline__ void xcd_barrier_complete(unsigned* bar, unsigned x, unsigned& nloc, unsigned& nx) {
    const unsigned G = gridDim.x * gridDim.y * gridDim.z;
    unsigned sum, cnt, mine, sp = 0u;
    for (;;) {
        sum = 0u; cnt = 0u; mine = 0u;
#pragma unroll
        for (unsigned j = 0; j < 16; ++j) { const unsigned c = xb_ld(&bar[XB_XCNT(j)]); sum += c; cnt += (c > 0u) ? 1u : 0u; mine = (j == x) ? c : mine; }
        if (sum == G) break;
        __builtin_amdgcn_s_sleep(1);
        if ((++sp & 255u) == 0u) { if (xb_ld(&bar[XB_TMO])) break; if (sp > XB_SPIN_CAP) { atomicAdd(&bar[XB_TMO], 1u); break; } }
    }
    nloc = mine > 0u ? mine : 1u; nx = cnt > 0u ? cnt : 1u;
}
__device__ __forceinline__ void xcd_barrier(const XcdBarrier& b) {
    asm volatile("s_waitcnt vmcnt(0)" ::: "memory");
    __syncthreads();
    if (threadIdx.x == 0) {
        unsigned* bar = b.bar;
        __builtin_amdgcn_s_waitcnt(0);
        unsigned nloc = b.st[0], nx = b.st[1];
        if (nloc == 0u) { xcd_barrier_complete(bar, b.x, nloc, nx); b.st[0] = nloc; b.st[1] = nx; }
        const unsigned old = xb_add(&bar[XB_XSUB(b.x)], 1u);
        const unsigned gen = old / nloc;
        if (old + 1u == (gen + 1u) * nloc) {
            __builtin_amdgcn_fence(__ATOMIC_RELEASE, "agent");
            asm volatile("s_waitcnt vmcnt(0)" ::: "memory");
            const unsigned og = xb_add(&bar[XB_TOP], 1u);
            const unsigned tg = og / nx;
            if (og + 1u == (tg + 1u) * nx) xb_add(&bar[XB_TOPGEN], 1u);
            else XB_SPIN(xb_ld(&bar[XB_TOPGEN]) == tg, bar);
            __builtin_amdgcn_fence(__ATOMIC_ACQUIRE, "agent");
            xb_add(&bar[XB_XGEN(b.x)], 1u);
            asm volatile("s_waitcnt vmcnt(0)" ::: "memory");
        } else {
            XB_SPIN(xb_ld(&bar[XB_XGEN(b.x)]) == gen, bar);
            __builtin_amdgcn_fence(__ATOMIC_ACQUIRE, "agent");
            asm volatile("s_waitcnt vmcnt(0)" ::: "memory");
        }
    }
    __syncthreads();
}

struct Frame {
    LAS unsigned char* lds;
    volatile LAS unsigned* MISC;
    gu32* ctl;
    int tid, lane, wave;
    int vcu, G;
    const float* in[18]; float* out; unsigned char* ws;
};
__device__ const unsigned char T5_BUCKET[128] = {0,1,2,3,4,5,6,7,8,9,10,11,12,13,14,15,16,16,16,17,17,18,18,18,19,19,19,20,20,20,20,21,21,21,21,22,22,22,22,22,23,23,23,23,23,23,24,24,24,24,24,24,25,25,25,25,25,25,25,26,26,26,26,26,26,26,26,27,27,27,27,27,27,27,27,27,27,28,28,28,28,28,28,28,28,28,28,29,29,29,29,29,29,29,29,29,29,29,29,30,30,30,30,30,30,30,30,30,30,30,30,30,30,31,31,31,31,31,31,31,31,31,31,31,31,31,31,31};

__device__ __forceinline__ void p0_transpose_item(const float* W, int ldw, int src_col0, int K, bf16* WT, int dst_row0, const float* gain, LAS float* scr, int kb, int lane) {
    const int k0 = 64 * kb;
#pragma unroll 8
    for (int i = 0; i < 32; ++i) { const int kk = 2 * i + (lane >> 5); float v = W[(size_t)(k0 + kk) * ldw + src_col0 + (lane & 31)]; if (gain) v *= gain[k0 + kk]; scr[kk * 33 + (lane & 31)] = v; }
    LDS_WAIT(); asm volatile("" ::: "memory");
    const int c = lane & 7;
#pragma unroll
    for (int j = 0; j < 4; ++j) { const int n = (lane >> 3) + 8 * j; const LAS float* s = scr + (8 * c) * 33 + n;
        v4u o; o.x = pk2(s[0 * 33], s[1 * 33]); o.y = pk2(s[2 * 33], s[3 * 33]); o.z = pk2(s[4 * 33], s[5 * 33]); o.w = pk2(s[6 * 33], s[7 * 33]);
        *(GAS v4u*)(WT + (size_t)(dst_row0 + n) * K + k0 + 8 * c) = o; }
    LDS_WAIT(); asm volatile("" ::: "memory");
}
__device__ __forceinline__ void p0_prologue(Frame& F) {
    LAS float* scr = (LAS float*)(F.lds + RING_OFF + F.wave * 16384);
    const int gw = F.vcu * NWAVES + F.wave, NGW = F.G * NWAVES;
    unsigned char* ws = F.ws;
    bf16* WinT = (bf16*)(ws + WS_WIN); bf16* WabT = (bf16*)(ws + WS_WAB); bf16* WoutT = (bf16*)(ws + WS_WOUT); bf16* WguT = (bf16*)(ws + WS_WGU); bf16* WdT = (bf16*)(ws + WS_WD);
    constexpr int I_IN = 16 * (NP / 32), I_AB = 8 * 32, I_OUT = 16 * 32, I_GU = 16 * (2 * FF / 32), I_D = (FF / 64) * 32;
    constexpr int NITEMS = I_IN + 2 * I_AB + I_OUT + I_GU + I_D;
    for (int it = gw; it < NITEMS; it += NGW) {
        int r = it;
        if (r < I_IN) { const int nb = r % (NP / 32), kb = r / (NP / 32), dr = 32 * nb; p0_transpose_item(F.in[2], D_IN, dr < 2048 ? dr : dr + 8, D, WinT, dr, F.in[1], scr, kb, F.lane); continue; } r -= I_IN;
        if (r < I_AB) { const int nb = r % 32, kb = r / 32; p0_transpose_item(F.in[11], D, 32 * nb, DN_W, WabT, 32 * nb, nullptr, scr, kb, F.lane); continue; } r -= I_AB;
        if (r < I_AB) { const int nb = r % 32, kb = r / 32; p0_transpose_item(F.in[12], D, 32 * nb, SW_W, WabT, 1024 + 32 * nb, nullptr, scr, kb, F.lane); continue; } r -= I_AB;
        if (r < I_OUT) { const int nb = r % 32, kb = r / 32; p0_transpose_item(F.in[13], D, 32 * nb, D, WoutT, 32 * nb, nullptr, scr, kb, F.lane); continue; } r -= I_OUT;
        if (r < I_GU) { const int nb = r % (2 * FF / 32), kb = r / (2 * FF / 32), dr = 32 * nb, pn = dr >> 8, j = dr & 255;
            const float* W = (j < 128) ? F.in[15] : F.in[16]; p0_transpose_item(W, FF, 128 * pn + (j & 127), D, WguT, dr, F.in[14], scr, kb, F.lane); continue; } r -= I_GU;
        { const int nb = r % 32, kb = r / 32; p0_transpose_item(F.in[17], D, 32 * nb, FF, WdT, 32 * nb, nullptr, scr, kb, F.lane); }
    }
    __syncthreads();
    LAS float* wba = (LAS float*)(F.lds + RING_OFF);
    for (int idx = F.tid; idx < 8 * D; idx += NWAVES * 64) { const int k = idx >> 3, j = idx & 7; wba[j * D + k] = F.in[2][(size_t)k * D_IN + 2048 + j] * F.in[1][k]; }
    __syncthreads();
    const float* x = F.in[0]; bf16* XB = (bf16*)(ws + WS_XB); float* rstd1 = (float*)(ws + WS_RSTD); float* gbp = (float*)(ws + WS_GB);
    for (int m = gw; m < M; m += NGW) {
        const GAS f32x4* xr = (const GAS f32x4*)(x + (size_t)m * D) + F.lane;
        f32x4 v[4]; float ss = 0.f;
#pragma unroll
        for (int j = 0; j < 4; ++j) { v[j] = xr[64 * j]; ss += (v[j].x * v[j].x + v[j].y * v[j].y) + (v[j].z * v[j].z + v[j].w * v[j].w); }
        const float rstd = 1.0f / sqrtf(wave_sum(ss) * (1.0f / D) + EPS);
        GAS unsigned long long* o8 = (GAS unsigned long long*)(XB + (size_t)m * D) + F.lane;
#pragma unroll
        for (int j = 0; j < 4; ++j) o8[64 * j] = (unsigned long long)pk2(v[j].x, v[j].y) | ((unsigned long long)pk2(v[j].z, v[j].w) << 32);
        float acc[8];
#pragma unroll
        for (int c = 0; c < 8; ++c) { float a = 0.f;
#pragma unroll
            for (int j = 0; j < 4; ++j) { const f32x4 w = *(const LAS f32x4*)(wba + c * D + 256 * j + 4 * F.lane); a += (v[j].x * w.x + v[j].y * w.y) + (v[j].z * w.z + v[j].w * w.w); }
            acc[c] = wave_sum(a) * rstd; }
        if (F.lane == 0) {
            rstd1[m] = rstd;
#pragma unroll
            for (int h = 0; h < 4; ++h) {
                const float beta = 1.0f / (1.0f + expf(-acc[h]));
                const float xx = acc[4 + h] + F.in[5][h]; const float sp = xx > 20.f ? xx : log1pf(expf(xx));
                gbp[(size_t)m * 8 + h] = beta; gbp[(size_t)m * 8 + 4 + h] = -expf(F.in[4][h]) * sp; }
        }
    }
}

__device__ __forceinline__ void dn_pre(Frame& F) {
    const int gw = F.vcu * NWAVES + F.wave, NGW = F.G * NWAVES;
    const bf16* proj = (const bf16*)(F.ws + WS_PROJ); const float* conv = F.in[3];
    float* QN = F.out; float* KN = F.out + (size_t)M * DN_W; float* VV = (float*)(F.ws + WS_XB);
    for (int task = gw; task < M * DN_H; task += NGW) {
        const int m = task >> 2, h = task & 3, t = m & (SEQ - 1);
        float val[3][2];
#pragma unroll
        for (int part = 0; part < 3; ++part) { const int col = part * DN_W + h * DN_D + 2 * F.lane; float a0 = 0.f, a1 = 0.f;
#pragma unroll
            for (int j = 0; j < 4; ++j) { if (t - 3 + j >= 0) { const unsigned w = *(const unsigned*)(proj + (size_t)(m - 3 + j) * NP + col); a0 += conv[j * DN_QKV + col] * bflo(w); a1 += conv[j * DN_QKV + col + 1] * bfhi(w); } }
            val[part][0] = a0 * sigm(a0); val[part][1] = a1 * sigm(a1); }
        const float rq = 1.0f / sqrtf(wave_sum(val[0][0] * val[0][0] + val[0][1] * val[0][1]) + EPS) * 0.08838834764831845f;
        const float rk = 1.0f / sqrtf(wave_sum(val[1][0] * val[1][0] + val[1][1] * val[1][1]) + EPS);
        const size_t o = (size_t)m * DN_W + h * DN_D + 2 * F.lane;
        *(f32x2*)(QN + o) = (f32x2){val[0][0] * rq, val[0][1] * rq};
        *(f32x2*)(KN + o) = (f32x2){val[1][0] * rk, val[1][1] * rk};
        *(f32x2*)(VV + o) = (f32x2){val[2][0], val[2][1]};
    }
}
__device__ __forceinline__ void dn_scan_naive(Frame& F, int bh) {
    const int b = bh >> 2, h = bh & 3, tid = F.tid, dvi = tid >> 2, kq = tid & 3;
    LAS float* kL = (LAS float*)(F.lds + RING_OFF); LAS float* qL = kL + 32 * 128; LAS float* vL = qL + 32 * 128; LAS float* gL = vL + 32 * 128; LAS float* bL = gL + 32;
    const float* QN = F.out; const float* KN = F.out + (size_t)M * DN_W; float* VV = (float*)(F.ws + WS_XB); const float* gbp = (const float*)(F.ws + WS_GB);
    float S[32];
#pragma unroll
    for (int j = 0; j < 32; ++j) S[j] = 0.f;
    for (int t0 = 0; t0 < SEQ; t0 += 32) {
#pragma unroll
        for (int r = 0; r < 2; ++r) { const int idx = tid + 512 * r, tok = idx >> 5, c4 = idx & 31; const size_t src = (size_t)(b * SEQ + t0 + tok) * DN_W + h * DN_D + c4 * 4;
            *(LAS f32x4*)(kL + tok * 128 + c4 * 4) = *(const f32x4*)(KN + src); *(LAS f32x4*)(qL + tok * 128 + c4 * 4) = *(const f32x4*)(QN + src); *(LAS f32x4*)(vL + tok * 128 + c4 * 4) = *(const f32x4*)(VV + src); }
        if (tid < 32) { const size_t mm = (size_t)(b * SEQ + t0 + tid); bL[tid] = gbp[mm * 8 + h]; gL[tid] = gbp[mm * 8 + 4 + h]; }
        __syncthreads();
        for (int i = 0; i < 32; ++i) {
            const float eg = __expf(gL[i]), be = bL[i];
            float kk[32];
#pragma unroll
            for (int j = 0; j < 8; ++j) { const f32x4 w = *(const LAS f32x4*)(kL + i * 128 + kq * 32 + 4 * j); kk[4 * j] = w.x; kk[4 * j + 1] = w.y; kk[4 * j + 2] = w.z; kk[4 * j + 3] = w.w; }
            float part = 0.f;
#pragma unroll
            for (int j = 0; j < 32; ++j) part += kk[j] * S[j];
            part += __shfl_xor(part, 1); part += __shfl_xor(part, 2);
            const float c = be * (vL[i * 128 + dvi] - eg * part);
#pragma unroll
            for (int j = 0; j < 32; ++j) S[j] = eg * S[j] + c * kk[j];
            float po = 0.f;
#pragma unroll
            for (int j = 0; j < 8; ++j) { const f32x4 w = *(const LAS f32x4*)(qL + i * 128 + kq * 32 + 4 * j); po += (w.x * S[4 * j] + w.y * S[4 * j + 1]) + (w.z * S[4 * j + 2] + w.w * S[4 * j + 3]); }
            po += __shfl_xor(po, 1); po += __shfl_xor(po, 2);
            if (kq == 0) vL[i * 128 + dvi] = po;
        }
        __syncthreads();
#pragma unroll
        for (int r = 0; r < 2; ++r) { const int idx = tid + 512 * r, tok = idx >> 5, c4 = idx & 31; const size_t src = (size_t)(b * SEQ + t0 + tok) * DN_W + h * DN_D + c4 * 4;
            *(f32x4*)(VV + src) = *(const LAS f32x4*)(vL + tok * 128 + c4 * 4); }
        __syncthreads();
    }
}
__device__ __forceinline__ void swa_naive(Frame& F, int wv, int nworkers) {
    const bf16* proj = (const bf16*)(F.ws + WS_PROJ); bf16* YSWA = (bf16*)(F.ws + WS_Y) + (size_t)M * SW_W;
    LAS float* qs = (LAS float*)(F.lds + RING_OFF + 65536 + F.wave * 1024); LAS float* ps = qs + 64;
    const float* qg = F.in[7]; const float* kg = F.in[8]; const float* sinks = F.in[9]; const float* relb = F.in[10];
    const int lane = F.lane;
    for (int task = wv; task < M * SW_H; task += nworkers) {
        const int m = task >> 3, qh = task & 7, kvh = qh >> 2, t = m & (SEQ - 1);
        const float q = bf1(proj[(size_t)m * NP + PC_SQ + qh * SW_D + lane]);
        const float qn = q * (1.0f / sqrtf(wave_sum(q * q) * (1.0f / SW_D) + EPS)) * qg[lane];
        qs[lane] = qn * kg[lane];
        LDS_WAIT(); asm volatile("" ::: "memory");
        float lg[2];
#pragma unroll
        for (int hf = 0; hf < 2; ++hf) { const int j = lane + 64 * hf; lg[hf] = -INFINITY;
            if (t - 127 + j >= 0) { const v4u* kr = (const v4u*)(proj + (size_t)(m - 127 + j) * NP + PC_SK + kvh * SW_D); float ssk = 0.f, dot = 0.f;
#pragma unroll
                for (int c = 0; c < 8; ++c) { const v4u w = kr[c];
#pragma unroll
                    for (int e = 0; e < 4; ++e) { const float k0 = bflo(w[e]), k1 = bfhi(w[e]); ssk += k0 * k0 + k1 * k1; dot += qs[8 * c + 2 * e] * k0 + qs[8 * c + 2 * e + 1] * k1; } }
                lg[hf] = dot * (1.0f / sqrtf(ssk * (1.0f / SW_D) + EPS)) * 0.125f + relb[(int)T5_BUCKET[127 - j] * SW_H + qh]; } }
        const float sink = sinks[qh];
        const float mx = fmaxf(wave_max(fmaxf(lg[0], lg[1])), sink);
        const float p0 = (lg[0] == -INFINITY) ? 0.f : __expf(lg[0] - mx), p1 = (lg[1] == -INFINITY) ? 0.f : __expf(lg[1] - mx);
        const float den = wave_sum(p0 + p1) + __expf(sink - mx);
        ps[lane] = p0; ps[lane + 64] = p1;
        LDS_WAIT(); asm volatile("" ::: "memory");
        float o = 0.f; const int jmin = (127 - t) > 0 ? (127 - t) : 0;
        for (int j = jmin; j < 128; ++j) o += ps[j] * bf1(proj[(size_t)(m - 127 + j) * NP + PC_SV + kvh * SW_D + lane]);
        YSWA[(size_t)m * SW_W + qh * SW_D + lane] = (bf16)f2bf(o / den);
        LDS_WAIT(); asm volatile("" ::: "memory");
    }
}
__device__ __forceinline__ void dn_out(Frame& F) {
    const int gw = F.vcu * NWAVES + F.wave, NGW = F.G * NWAVES;
    const bf16* proj = (const bf16*)(F.ws + WS_PROJ); const float* VV = (const float*)(F.ws + WS_XB); bf16* YDN = (bf16*)(F.ws + WS_Y); const float* gain = F.in[6];
    for (int task = gw; task < M * DN_H; task += NGW) {
        const int m = task >> 2, h = task & 3;
        const f32x2 o = *(const f32x2*)(VV + (size_t)m * DN_W + h * DN_D + 2 * F.lane);
        const float r = 1.0f / sqrtf(wave_sum(o.x * o.x + o.y * o.y) * (1.0f / DN_D) + EPS);
        const unsigned zw = *(const unsigned*)(proj + (size_t)m * NP + PC_Z + h * DN_D + 2 * F.lane); const float z0 = bflo(zw), z1 = bfhi(zw);
        *(unsigned*)(YDN + (size_t)m * DN_W + h * DN_D + 2 * F.lane) = pk2(o.x * r * gain[2 * F.lane] * z0 * sigm(z0), o.y * r * gain[2 * F.lane + 1] * z1 * sigm(z1));
    }
}

struct Args { const float* in[18]; float* out; unsigned char* ws; int ph_lo, ph_hi, li, pad; };
__global__ void __launch_bounds__(NWAVES * 64, 2) fwd_kernel(Args args) {
    extern __shared__ __attribute__((aligned(16))) unsigned char lds[];
    Frame F;
    F.lds = (LAS unsigned char*)lds;
    F.MISC = (volatile LAS unsigned*)(F.lds + MISC_OFF);
    F.tid = threadIdx.x; F.lane = F.tid & 63; F.wave = __builtin_amdgcn_readfirstlane(F.tid >> 6);
    F.G = gridDim.x; { const int bx = blockIdx.x; F.vcu = (F.G % 8 == 0) ? (bx % 8) * (F.G / 8) + bx / 8 : bx; }
#pragma unroll
    for (int i = 0; i < 18; ++i) F.in[i] = args.in[i];
    F.out = args.out; F.ws = args.ws; unsigned char* ws = args.ws;
    F.ctl = (gu32*)(ws + WS_CTL);
    for (int u = F.tid; u < (LDS_BYTES - LDSCTL_OFF) / 4; u += NWAVES * 64) ((LAS unsigned*)(F.lds + LDSCTL_OFF))[u] = 0u;
    __syncthreads();
    const int lo = args.ph_lo, hi = args.ph_hi;
    XcdBarrier bar; bar.bar = (unsigned*)(F.ctl + CW_BAR) + args.li * XCD_BAR_WORDS; bar.x = 0; bar.st = nullptr;
    if (hi - lo > 1) bar = xcd_barrier_post((unsigned*)(F.ctl + CW_BAR) + args.li * XCD_BAR_WORDS, F.MISC + 8);
#define IN(k) (lo <= (k) && (k) < hi)
#define BOTH(k) (IN(k) && IN((k) + 1))
    bf16* XB = (bf16*)(ws + WS_XB); bf16* Y = (bf16*)(ws + WS_Y); bf16* PROJ = (bf16*)(ws + WS_PROJ);

    if (IN(0)) { p0_prologue(F); if (BOTH(0)) xcd_barrier(bar); }
    if (IN(1)) {
        pg8::Gemm g{XB, (const bf16*)(ws + WS_WIN), M, NP, D}; pg8::StaticOrder S; S.init(M, NP, F.G, (int)blockIdx.x);
        pg8::EpiProj E{PROJ, NP, (const float*)(ws + WS_RSTD)};
        pg8::gemm_phase<pg8::EpiProj, pg8::StaticOrder, true, true>(F.lds + RING_OFF, g, S, E);
        if (BOTH(1)) xcd_barrier(bar);
    }
    if (IN(2)) { dn_pre(F); if (BOTH(2)) xcd_barrier(bar); }
    if (IN(3)) {
        if (F.G > 16) { if (F.vcu < 16) dn_scan_naive(F, F.vcu); else swa_naive(F, (F.vcu - 16) * NWAVES + F.wave, (F.G - 16) * NWAVES); }
        else { for (int bh = F.vcu; bh < 16; bh += F.G) dn_scan_naive(F, bh); swa_naive(F, F.vcu * NWAVES + F.wave, F.G * NWAVES); }
        if (BOTH(3)) xcd_barrier(bar);
    }
    if (IN(4)) { dn_out(F); if (BOTH(4)) xcd_barrier(bar); }
    if (IN(5)) {
        pg8::Gemm g{Y, (const bf16*)(ws + WS_WAB), 2 * M, 2 * D, DN_W}; pg8::PairedOrder S; S.init(M, D, F.G, (int)blockIdx.x);
        pg8::EpiMerge E{PROJ + PC_G, NP, XB, D, M / 256, D / 256};
        pg8::gemm_phase<pg8::EpiMerge, pg8::PairedOrder, false, true>(F.lds + RING_OFF, g, S, E);
        if (BOTH(5)) xcd_barrier(bar);
    }
    if (IN(6)) {
        pg8::Gemm g{XB, (const bf16*)(ws + WS_WOUT), M, D, D}; pg8::StaticOrder S; S.init(M, D, F.G, (int)blockIdx.x);
        pg8::EpiX1 E{F.in[0], F.out, Y, (float*)(ws + WS_SSQ), D};
        pg8::gemm_phase<pg8::EpiX1, pg8::StaticOrder, false, true>(F.lds + RING_OFF, g, S, E);
        if (BOTH(6)) xcd_barrier(bar);
    }
    if (IN(7)) {
        pg8::Gemm g{Y, (const bf16*)(ws + WS_WGU), M, 2 * FF, D}; pg8::StaticOrder S; S.init(M, 2 * FF, F.G, (int)blockIdx.x);
        pg8::EpiSwiGLU E{PROJ, FF, (const float*)(ws + WS_SSQ), EPS};
        pg8::gemm_phase<pg8::EpiSwiGLU, pg8::StaticOrder, true, true>(F.lds + RING_OFF, g, S, E);
        if (BOTH(7)) xcd_barrier(bar);
    }
    if (IN(8)) {
        pg8::Gemm g{PROJ, (const bf16*)(ws + WS_WD), M, D, FF}; pg8::StaticOrder S; S.init(M, D, F.G, (int)blockIdx.x);
        pg8::EpiOut E{F.out, D};
        pg8::gemm_phase<pg8::EpiOut, pg8::StaticOrder, false, true>(F.lds + RING_OFF, g, S, E);
    }
#undef IN
#undef BOTH
}

extern "C" void kernel_launch(void* const* d_in, const int* in_sizes, int n_in, void* d_out, int out_size, void* d_ws, size_t ws_size, hipStream_t stream) {
    static int grid = 0;
    if (grid == 0) {
        if (n_in != 18 || in_sizes[0] != M * D || out_size != M * D || ws_size < WS_END) { fprintf(stderr, "kernel_launch: unexpected shapes (n_in %d, in0 %d, out %d, ws %zu)\n", n_in, n_in > 0 ? in_sizes[0] : -1, out_size, ws_size); grid = -1; return; }
        int dev = 0, cus = 0;
        if (hipGetDevice(&dev) != hipSuccess || hipDeviceGetAttribute(&cus, hipDeviceAttributeMultiprocessorCount, dev) != hipSuccess) { grid = -1; return; }
        if (hipFuncSetAttribute((const void*)fwd_kernel, hipFuncAttributeMaxDynamicSharedMemorySize, LDS_BYTES) != hipSuccess) { fprintf(stderr, "kernel_launch: hipFuncSetAttribute failed\n"); grid = -1; return; }
        int per_cu = 0;
        if (hipOccupancyMaxActiveBlocksPerMultiprocessor(&per_cu, (const void*)fwd_kernel, NWAVES * 64, LDS_BYTES) != hipSuccess || per_cu < 1) fprintf(stderr, "kernel_launch: occupancy query reports %d\n", per_cu);
        (void)hipGetLastError();
        grid = cus;
    }
    if (grid < 0) return;
    if (hipMemsetAsync((char*)d_ws + WS_CTL, 0, CTL_ZERO_BYTES, stream) != hipSuccess) return;
    Args a{};
    for (int i = 0; i < 18; ++i) a.in[i] = (const float*)d_in[i];
    a.out = (float*)d_out; a.ws = (unsigned char*)d_ws;
    for (int li = 0; li < N_LAUNCHES; ++li) {
        if (N_LAUNCHES == 1) { a.ph_lo = 0; a.ph_hi = PER_PHASE; } else { a.ph_lo = li * PER_PHASE / N_LAUNCHES; a.ph_hi = (li + 1) * PER_PHASE / N_LAUNCHES; }
        a.li = li;
        hipLaunchKernelGGL(fwd_kernel, dim3(grid), dim3(NWAVES * 64), LDS_BYTES, stream, a);
        const hipError_t le = hipPeekAtLastError();
        if (le != hipSuccess) { fprintf(stderr, "kernel_launch: launch %d failed: %s\n", li, hipGetErrorName(le)); break; }
    }
}
```

```cpp
#include <hip/hip_runtime.h>
#include <cstdio>
#include <cstdint>

namespace pg8 {
#define PG8_LAS __attribute__((address_space(3)))
typedef unsigned short bf16_t;
typedef short bf16x8 __attribute__((ext_vector_type(8)));
typedef float f32x4 __attribute__((ext_vector_type(4)));
typedef unsigned u32x4 __attribute__((ext_vector_type(4)));
typedef unsigned u32x2 __attribute__((ext_vector_type(2)));
constexpr int BM = 256, BK = 64, HALF = 128, HTB = HALF * BK * 2  , STAGE_BYTES = 8 * HTB, NXCD = 8, WGM = 8;

__host__ __device__ __forceinline__ int lds_byte(int r, int c) { const int st = (r >> 4) * 2 + (c >> 5), rr = r & 15, cc = c & 31, ob = rr * 64 + cc * 2; return st * 1024 + (ob ^ (((ob >> 9) & 1) << 5)); }
__host__ __device__ __forceinline__ void stage_rc(int b, int& R, int& C) { const int st = b / 1024, sb = b % 1024, swz = sb ^ (((sb >> 9) & 1) << 5); R = (st >> 1) * 16 + swz / 64; C = (st & 1) * 32 + (swz % 64) / 2; }
__host__ __device__ __forceinline__ int perm32(int rho) { const int n = rho >> 4, i = rho & 15; return 8 * (i >> 2) + 4 * n + (i & 3); }

struct Unit { int pm, pn; };
struct Gemm { const bf16_t* A; const bf16_t* Bt; int M, N, K; };

struct StaticOrder {
    int nM, nN, nwg, G, c;
    __host__ __device__ void init(int M, int N, int G_, int c_) { nM = M / BM; nN = N / BM; nwg = nM * nN; G = G_; c = c_; }
    __host__ __device__ bool next(int i, Unit& u) const {
        const long L = (long)i * G + c; if (L >= nwg) return false;
        int wgid = (int)L; { const int q = nwg / NXCD, r = nwg % NXCD, xcd = wgid % NXCD, off = wgid / NXCD; wgid = (xcd < r ? xcd * (q + 1) : r * (q + 1) + (xcd - r) * q) + off; }
        const int nig = WGM * nN, gid = wgid / nig, fm = gid * WGM, gsz = (nM - fm) < WGM ? (nM - fm) : WGM;
        u.pm = fm + ((wgid % nig) % gsz); u.pn = (wgid % nig) / gsz; return true;
    }
    __device__ __forceinline__ void a_ready(const Unit&) const {}
    __device__ __forceinline__ void done(const Unit&) const {}
};
struct PairedOrder {
    StaticOrder so;
    __host__ __device__ void init(int M, int N, int G_, int c_) { so.init(M, N, G_, c_); }
    __host__ __device__ bool next(int i, Unit& u) const { if (!so.next(i >> 1, u)) return false; if (i & 1) { u.pm += so.nM; u.pn += so.nN; } return true; }
    __device__ __forceinline__ void a_ready(const Unit&) const {}
    __device__ __forceinline__ void done(const Unit&) const {}
};

__device__ __forceinline__ unsigned cvt_pk_bf16(float lo, float hi) { unsigned r; asm volatile("v_cvt_pk_bf16_f32 %0, %1, %2" : "=v"(r) : "v"(lo), "v"(hi)); return r; }
__device__ __forceinline__ float bf_lo(unsigned w) { return __builtin_bit_cast(float, w << 16); }
__device__ __forceinline__ float bf_hi(unsigned w) { return __builtin_bit_cast(float, w & 0xffff0000u); }
__device__ __forceinline__ float sigmoidf_(float x) { return 1.0f / (1.0f + __expf(-x)); }


struct EpiProj {
    static constexpr bool PERM = true, AFTER_DRAIN = false;
    bf16_t* O; int ldc; const float* rstd;
    __device__ __forceinline__ bool keep(const Unit&) const { return false; }
    __device__ __forceinline__ void operator()(f32x4 (&acc)[2][2][4][2], const Unit& u, int wr, int wc, int fr, int fq) const {
        const int row0 = u.pm * BM + wr * 64 + fr, col0 = u.pn * BM + wc * 32 + 8 * fq;
#pragma unroll
        for (int ai = 0; ai < 2; ++ai)
#pragma unroll
            for (int m = 0; m < 4; ++m) { const int row = row0 + ai * HALF + m * 16; const float s = rstd[row]; bf16_t* rowp = O + (size_t)row * ldc + col0;
#pragma unroll
                for (int bj = 0; bj < 2; ++bj) { const f32x4 v0 = acc[ai][bj][m][0] * s, v1 = acc[ai][bj][m][1] * s;
                    u32x4 w; w.x = cvt_pk_bf16(v0[0], v0[1]); w.y = cvt_pk_bf16(v0[2], v0[3]); w.z = cvt_pk_bf16(v1[0], v1[1]); w.w = cvt_pk_bf16(v1[2], v1[3]);
                    *(u32x4*)(rowp + bj * HALF) = w; } }
    }
};
struct EpiMerge {
    static constexpr bool PERM = true, AFTER_DRAIN = false;
    const bf16_t* G; int ldg; bf16_t* O; int ldc; int nM, nN;
    __device__ __forceinline__ bool keep(const Unit& u) const { return u.pm < nM; }
    __device__ __forceinline__ void operator()(f32x4 (&acc)[2][2][4][2], const Unit& u, int wr, int wc, int fr, int fq) const {
        const bool second = u.pm >= nM; const int pm = second ? u.pm - nM : u.pm, pn = second ? u.pn - nN : u.pn;
        const int row0 = pm * BM + wr * 64 + fr, col0 = pn * BM + wc * 32 + 8 * fq;
#pragma unroll
        for (int ai = 0; ai < 2; ++ai)
#pragma unroll
            for (int m = 0; m < 4; ++m) { const int row = row0 + ai * HALF + m * 16;
#pragma unroll
                for (int bj = 0; bj < 2; ++bj) { const int col = col0 + bj * HALF;
                    const u32x4 ga = *(const u32x4*)(G + (size_t)row * ldg + col), gb = *(const u32x4*)(G + (size_t)row * ldg + 1024 + col);
                    float ea[8], eb[8];
#pragma unroll
                    for (int j = 0; j < 4; ++j) { ea[2 * j] = __expf(-bf_lo(ga[j])); ea[2 * j + 1] = __expf(-bf_hi(ga[j])); eb[2 * j] = __expf(-bf_lo(gb[j])); eb[2 * j + 1] = __expf(-bf_hi(gb[j])); }
                    if (!second) {
#pragma unroll
                        for (int j = 0; j < 4; ++j) { acc[ai][bj][m][0][j] *= (1.0f + eb[j]) / (1.0f + ea[j]); acc[ai][bj][m][1][j] *= (1.0f + eb[4 + j]) / (1.0f + ea[4 + j]); }
                    } else {
                        f32x4 v0, v1;
#pragma unroll
                        for (int j = 0; j < 4; ++j) { v0[j] = acc[ai][bj][m][0][j] / (1.0f + eb[j]); v1[j] = acc[ai][bj][m][1][j] / (1.0f + eb[4 + j]); }
                        u32x4 w; w.x = cvt_pk_bf16(v0[0], v0[1]); w.y = cvt_pk_bf16(v0[2], v0[3]); w.z = cvt_pk_bf16(v1[0], v1[1]); w.w = cvt_pk_bf16(v1[2], v1[3]);
                        *(u32x4*)(O + (size_t)row * ldc + col) = w; } } }
    }
};
struct EpiX1 {
    static constexpr bool PERM = false, AFTER_DRAIN = false;
    const float* X; float* out; bf16_t* xb; float* ssq; int ldc;
    __device__ __forceinline__ bool keep(const Unit&) const { return false; }
    __device__ __forceinline__ void operator()(f32x4 (&acc)[2][2][4][2], const Unit& u, int wr, int wc, int fr, int fq) const {
        const int row0 = u.pm * BM + wr * 64 + fr, col0 = u.pn * BM + wc * 32 + 4 * fq;
#pragma unroll
        for (int ai = 0; ai < 2; ++ai)
#pragma unroll
            for (int m = 0; m < 4; ++m) { const int row = row0 + ai * HALF + m * 16; const size_t off = (size_t)row * ldc + col0; float ss = 0.f;
#pragma unroll
                for (int bj = 0; bj < 2; ++bj)
#pragma unroll
                    for (int n = 0; n < 2; ++n) { const f32x4 xv = *(const f32x4*)(X + off + bj * HALF + n * 16); const f32x4 o = xv + acc[ai][bj][m][n];
                        *(f32x4*)(out + off + bj * HALF + n * 16) = o; ss += (o[0] * o[0] + o[1] * o[1]) + (o[2] * o[2] + o[3] * o[3]);
                        u32x2 w; w.x = cvt_pk_bf16(o[0], o[1]); w.y = cvt_pk_bf16(o[2], o[3]); *(u32x2*)(xb + off + bj * HALF + n * 16) = w; }
                ss += __shfl_xor(ss, 16); ss += __shfl_xor(ss, 32);
                if (fq == 0) ssq[(size_t)row * 16 + u.pn * 4 + wc] = ss; }
    }
};
struct EpiSwiGLU {
    static constexpr bool PERM = true, AFTER_DRAIN = false;
    bf16_t* O; int ldc; const float* ssq; float eps;
    __device__ __forceinline__ bool keep(const Unit&) const { return false; }
    __device__ __forceinline__ void operator()(f32x4 (&acc)[2][2][4][2], const Unit& u, int wr, int wc, int fr, int fq) const {
        const int row0 = u.pm * BM + wr * 64 + fr, col0 = u.pn * HALF + wc * 32 + 8 * fq;
#pragma unroll
        for (int ai = 0; ai < 2; ++ai)
#pragma unroll
            for (int m = 0; m < 4; ++m) { const int row = row0 + ai * HALF + m * 16;
                const f32x4* sp = (const f32x4*)(ssq + (size_t)row * 16); const f32x4 s0 = sp[0], s1 = sp[1], s2 = sp[2], s3 = sp[3];
                const float tot = ((s0[0] + s0[1]) + (s0[2] + s0[3])) + ((s1[0] + s1[1]) + (s1[2] + s1[3])) + ((s2[0] + s2[1]) + (s2[2] + s2[3])) + ((s3[0] + s3[1]) + (s3[2] + s3[3]));
                const float s = __builtin_amdgcn_rsqf(tot * (1.0f / 1024.0f) + eps);
                float a[8];
#pragma unroll
                for (int n = 0; n < 2; ++n)
#pragma unroll
                    for (int j = 0; j < 4; ++j) { const float g = acc[ai][0][m][n][j] * s, up = acc[ai][1][m][n][j] * s; a[4 * n + j] = g * up / (1.0f + __expf(-g)); }
                u32x4 w; w.x = cvt_pk_bf16(a[0], a[1]); w.y = cvt_pk_bf16(a[2], a[3]); w.z = cvt_pk_bf16(a[4], a[5]); w.w = cvt_pk_bf16(a[6], a[7]);
                *(u32x4*)(O + (size_t)row * ldc + col0) = w; }
    }
};
struct EpiOut {
    static constexpr bool PERM = false, AFTER_DRAIN = false;
    float* out; int ldc;
    __device__ __forceinline__ bool keep(const Unit&) const { return false; }
    __device__ __forceinline__ void operator()(f32x4 (&acc)[2][2][4][2], const Unit& u, int wr, int wc, int fr, int fq) const {
        const int row0 = u.pm * BM + wr * 64 + fr, col0 = u.pn * BM + wc * 32 + 4 * fq;
#pragma unroll
        for (int ai = 0; ai < 2; ++ai)
#pragma unroll
            for (int m = 0; m < 4; ++m) { float* rowp = out + (size_t)(row0 + ai * HALF + m * 16) * ldc + col0;
#pragma unroll
                for (int bj = 0; bj < 2; ++bj)
#pragma unroll
                    for (int n = 0; n < 2; ++n) { const f32x4 b = *(const f32x4*)(rowp + bj * HALF + n * 16); *(f32x4*)(rowp + bj * HALF + n * 16) = b + acc[ai][bj][m][n]; } }
    }
};

template <class Epi, class Sched, bool ALIGN_EPI = false, bool SP2 = false>
__device__ __forceinline__ void gemm_phase(PG8_LAS unsigned char* lds, const Gemm g, const Sched& S, const Epi& E) {
    const int tid = threadIdx.x, wid = __builtin_amdgcn_readfirstlane(tid >> 6), lane = tid & 63, wr = wid >> 2, wc = wid & 3, fr = lane & 15, fq = lane >> 4;
    const int K = g.K, nt = K / BK;
    unsigned voffA[2], voffB[2];
#pragma unroll
    for (int i = 0; i < 2; ++i) { int R, C; stage_rc(tid * 16 + i * 8192, R, C); const int Rb = Epi::PERM ? ((R & ~31) + perm32(R & 31)) : R;
        voffA[i] = (unsigned)(R * K + C) * 2u; voffB[i] = (unsigned)(Rb * K + C) * 2u; }
    const size_t kstep = (size_t)(BK * 2);
    const size_t hstep = (size_t)HALF * K * 2;
    const size_t tstep = 2 * hstep;
    const unsigned ldsw = (unsigned)wid * 1024u;
    const int aoff = lds_byte(wr * 64 + fr, fq * 8), boff = lds_byte(wc * 32 + fr, fq * 8);
#define PG8_SA(b, h) (((b) * 2 + (h)) * HTB)
#define PG8_SB(b, h) ((4 + (b) * 2 + (h)) * HTB)
#define PG8_STAGE(bufoff, gbase, voff) do { _Pragma("unroll") for (int _i = 0; _i < 2; ++_i) \
        __builtin_amdgcn_global_load_lds((const unsigned*)((const char*)(gbase) + (voff)[_i]), (PG8_LAS unsigned*)(lds + (bufoff) + ldsw + _i * 8192), 16, 0, 0); } while (0)
#define PG8_LDA(dst, b, h) do { _Pragma("unroll") for (int m = 0; m < 4; ++m) _Pragma("unroll") for (int k = 0; k < 2; ++k) dst[m][k] = *(const PG8_LAS bf16x8*)(lds + PG8_SA(b, h) + aoff + m * 2048 + k * 1024); } while (0)
#define PG8_LDB(dst, b, h) do { _Pragma("unroll") for (int n = 0; n < 2; ++n) _Pragma("unroll") for (int k = 0; k < 2; ++k) dst[n][k] = *(const PG8_LAS bf16x8*)(lds + PG8_SB(b, h) + boff + n * 2048 + k * 1024); } while (0)
#define PG8_MMA(ai, bj, At, Bt) do { __builtin_amdgcn_s_setprio(1); _Pragma("unroll") for (int m = 0; m < 4; ++m) _Pragma("unroll") for (int n = 0; n < 2; ++n) _Pragma("unroll") for (int k = 0; k < 2; ++k) \
        acc[ai][bj][m][n] = __builtin_amdgcn_mfma_f32_16x16x32_bf16(Bt[n][k], At[m][k], acc[ai][bj][m][n], 0, 0, 0); __builtin_amdgcn_s_setprio(0); } while (0)
#define PG8_WAIT_V(n) asm volatile("s_waitcnt vmcnt(" #n ")" ::: "memory")
#define PG8_WAIT_L(n) asm volatile("s_waitcnt lgkmcnt(" #n ")" ::: "memory")
#define PG8_BAR __builtin_amdgcn_s_barrier()
#define PG8_SCHED __builtin_amdgcn_sched_barrier(0)
    Unit cur, nxt; int ui = 0;
    if (!S.next(0, cur)) return;
    f32x4 acc[2][2][4][2];
#pragma unroll
    for (int a = 0; a < 2; ++a)
#pragma unroll
        for (int b = 0; b < 2; ++b)
#pragma unroll
            for (int m = 0; m < 4; ++m)
#pragma unroll
                for (int n = 0; n < 2; ++n) acc[a][b][m][n] = (f32x4){0.f, 0.f, 0.f, 0.f};
    bf16x8 At[4][2], B0[2][2], B1[2][2];
    const char* cA = (const char*)g.A + (size_t)cur.pm * tstep; const char* cB = (const char*)g.Bt + (size_t)cur.pn * tstep;
    S.a_ready(cur);
    if constexpr (SP2) {
        PG8_STAGE(PG8_SB(0, 0), cB, voffB); PG8_STAGE(PG8_SB(0, 1), cB + hstep, voffB); PG8_STAGE(PG8_SA(0, 0), cA, voffA); PG8_STAGE(PG8_SA(0, 1), cA + hstep, voffA);
        if (wr == 1) PG8_BAR;
        PG8_WAIT_V(2); PG8_BAR;
        PG8_STAGE(PG8_SB(1, 0), cB + kstep, voffB); PG8_STAGE(PG8_SA(1, 0), cA + kstep, voffA); PG8_STAGE(PG8_SB(1, 1), cB + hstep + kstep, voffB);
        PG8_WAIT_V(6); PG8_BAR;
    } else {
        PG8_STAGE(PG8_SB(0, 0), cB, voffB); PG8_STAGE(PG8_SA(0, 0), cA, voffA); PG8_STAGE(PG8_SB(0, 1), cB + hstep, voffB); PG8_STAGE(PG8_SA(0, 1), cA + hstep, voffA);
        if (wr == 1) PG8_BAR;
        PG8_WAIT_V(4); PG8_BAR;
        PG8_STAGE(PG8_SB(1, 0), cB + kstep, voffB); PG8_STAGE(PG8_SA(1, 0), cA + kstep, voffA); PG8_STAGE(PG8_SB(1, 1), cB + hstep + kstep, voffB);
        PG8_WAIT_V(6); PG8_BAR;
    }
    for (;;) {
        const bool has_next = S.next(ui + 1, nxt);
        const char* nA = has_next ? (const char*)g.A + (size_t)nxt.pm * tstep : cA; const char* nB = has_next ? (const char*)g.Bt + (size_t)nxt.pn * tstep : cB;
        for (int t = 0; t < nt; t += 2) {
            const bool last = (t == nt - 2);
            const char* a1 = cA + (size_t)(t + 1) * kstep;
            const char* a2 = last ? nA : cA + (size_t)(t + 2) * kstep; const char* b2 = last ? nB : cB + (size_t)(t + 2) * kstep;
            const char* a3 = a2 + kstep; const char* b3 = b2 + kstep;
            if (last && has_next) S.a_ready(nxt);
            if constexpr (SP2) {
            PG8_LDB(B0, 0, 0); PG8_LDB(B1, 0, 1); PG8_SCHED; PG8_LDA(At, 0, 0); PG8_STAGE(PG8_SA(1, 1), a1 + hstep, voffA);
            PG8_WAIT_V(8); PG8_WAIT_L(0); PG8_BAR; PG8_MMA(0, 0, At, B0); PG8_MMA(0, 1, At, B1); PG8_BAR; PG8_SCHED;
            PG8_LDA(At, 0, 1); PG8_STAGE(PG8_SB(0, 0), b2, voffB); PG8_STAGE(PG8_SB(0, 1), b2 + hstep, voffB); PG8_STAGE(PG8_SA(0, 0), a2, voffA);
            PG8_WAIT_V(8); PG8_WAIT_L(0); PG8_BAR; PG8_MMA(1, 0, At, B0); PG8_MMA(1, 1, At, B1); PG8_BAR; PG8_SCHED;
            PG8_LDB(B0, 1, 0); PG8_LDB(B1, 1, 1); PG8_SCHED; PG8_LDA(At, 1, 0); PG8_STAGE(PG8_SA(0, 1), a2 + hstep, voffA);
            PG8_WAIT_V(8); PG8_WAIT_L(0); PG8_BAR; PG8_MMA(0, 0, At, B0); PG8_MMA(0, 1, At, B1); PG8_BAR; PG8_SCHED;
            PG8_LDA(At, 1, 1); PG8_STAGE(PG8_SB(1, 0), b3, voffB); PG8_STAGE(PG8_SB(1, 1), b3 + hstep, voffB); PG8_STAGE(PG8_SA(1, 0), a3, voffA);
            PG8_WAIT_V(8); PG8_WAIT_L(0); PG8_BAR; PG8_MMA(1, 0, At, B0); PG8_MMA(1, 1, At, B1); PG8_BAR; PG8_SCHED;
            } else {
            PG8_LDB(B0, 0, 0); PG8_SCHED; PG8_LDA(At, 0, 0); PG8_STAGE(PG8_SA(1, 1), a1 + hstep, voffA);
            PG8_WAIT_L(8); PG8_BAR; PG8_WAIT_L(0); PG8_MMA(0, 0, At, B0); PG8_BAR; PG8_SCHED;
            PG8_LDB(B1, 0, 1); PG8_STAGE(PG8_SB(0, 0), b2, voffB);
            PG8_BAR; PG8_WAIT_L(0); PG8_MMA(0, 1, At, B1); PG8_BAR;
            PG8_LDA(At, 0, 1); PG8_STAGE(PG8_SA(0, 0), a2, voffA);
            PG8_BAR; PG8_WAIT_L(0); PG8_MMA(1, 0, At, B0); PG8_BAR; PG8_SCHED;
            PG8_STAGE(PG8_SB(0, 1), b2 + hstep, voffB);
            PG8_WAIT_V(6); PG8_BAR; PG8_MMA(1, 1, At, B1); PG8_BAR;
            PG8_LDB(B0, 1, 0); PG8_SCHED; PG8_LDA(At, 1, 0); PG8_STAGE(PG8_SA(0, 1), a2 + hstep, voffA);
            PG8_WAIT_L(8); PG8_BAR; PG8_WAIT_L(0); PG8_MMA(0, 0, At, B0); PG8_BAR; PG8_SCHED;
            PG8_LDB(B1, 1, 1); PG8_STAGE(PG8_SB(1, 0), b3, voffB);
            PG8_BAR; PG8_WAIT_L(0); PG8_MMA(0, 1, At, B1); PG8_BAR;
            PG8_LDA(At, 1, 1); PG8_STAGE(PG8_SA(1, 0), a3, voffA);
            PG8_BAR; PG8_WAIT_L(0); PG8_MMA(1, 0, At, B0); PG8_BAR; PG8_SCHED;
            PG8_STAGE(PG8_SB(1, 1), b3 + hstep, voffB);
            PG8_WAIT_V(6); PG8_BAR; PG8_MMA(1, 1, At, B1); PG8_BAR;
            }
        }
        if constexpr (ALIGN_EPI) { if (wr == 0) PG8_BAR; }
        if constexpr (!Epi::AFTER_DRAIN) { E(acc, cur, wr, wc, fr, fq); S.done(cur); }
        if (!has_next) break;
        if (!E.keep(cur)) {
#pragma unroll
        for (int a = 0; a < 2; ++a)
#pragma unroll
            for (int b = 0; b < 2; ++b)
#pragma unroll
                for (int m = 0; m < 4; ++m)
#pragma unroll
                    for (int n = 0; n < 2; ++n) acc[a][b][m][n] = (f32x4){0.f, 0.f, 0.f, 0.f};
        }
        cur = nxt; cA = nA; cB = nB; ++ui;
        if constexpr (ALIGN_EPI) { if (wr == 1) PG8_BAR; }
    }
    PG8_WAIT_V(0);
    if constexpr (!ALIGN_EPI) { if (wr == 0) PG8_BAR; }
    PG8_BAR;
    if constexpr (Epi::AFTER_DRAIN) { E.fused(acc, cur, wr, wc, fr, fq, lds, wid, lane); S.done(cur); }
#undef PG8_SA
#undef PG8_SB
#undef PG8_STAGE
#undef PG8_LDA
#undef PG8_LDB
#undef PG8_MMA
#undef PG8_WAIT_V
#undef PG8_WAIT_L
#undef PG8_BAR
#undef PG8_SCHED
}
}

constexpr int NWAVES = 8;
#ifndef MK_N_LAUNCHES
#define MK_N_LAUNCHES 1
#endif
constexpr int PER_PHASE = 9;
constexpr int N_LAUNCHES = MK_N_LAUNCHES;

constexpr int BATCH = 4, SEQ = 4096, D = 1024, M = BATCH * SEQ;
constexpr int DN_H = 4, DN_D = 128, DN_W = 512, DN_QKV = 1536;
constexpr int SW_H = 8, SW_KV = 2, SW_D = 64, SW_W = 512, SW_KVW = 128, WINDOW = 128;
constexpr int FF = 2816;
constexpr int D_IN = 4872;
constexpr int NP = 4864;
constexpr int PC_Z = 1536, PC_SQ = 2048, PC_SK = 2560, PC_SV = 2688, PC_G = 2816;
constexpr float EPS = 1e-6f;

constexpr size_t MiB = 1u << 20;
constexpr size_t WS_CTL = 0, CTL_ZERO_BYTES = 1 * MiB;
constexpr size_t WS_WIN = 1 * MiB;
constexpr size_t WS_WAB = 11 * MiB;
constexpr size_t WS_WOUT = 13 * MiB;
constexpr size_t WS_WGU = 15 * MiB;
constexpr size_t WS_WD = 26 * MiB;
constexpr size_t WS_RSTD = 32 * MiB;
constexpr size_t WS_GB = WS_RSTD + 64 * 1024;
constexpr size_t WS_SSQ = 33 * MiB;
constexpr size_t WS_XB = 34 * MiB;
constexpr size_t WS_Y = 66 * MiB;
constexpr size_t WS_PROJ = 98 * MiB;
constexpr size_t WS_END = 250 * MiB;
static_assert(WS_PROJ + (size_t)M * NP * 2 <= WS_END, "ws map");
constexpr int CW_TMO = 0, CW_BAR = 4096;

constexpr int RING_OFF = 0, RING_BYTES = 131072;
constexpr int LDSCTL_OFF = RING_BYTES, MISC_OFF = LDSCTL_OFF + 320;
constexpr int LDS_BYTES = 147456;

#define GAS __attribute__((address_space(1)))
#define LAS __attribute__((address_space(3)))
typedef unsigned short bf16;
typedef unsigned v4u __attribute__((ext_vector_type(4)));
typedef float f32x4 __attribute__((ext_vector_type(4)));
typedef float f32x2 __attribute__((ext_vector_type(2)));
typedef GAS unsigned gu32;
#define RLX_AGENT __ATOMIC_RELAXED, __HIP_MEMORY_SCOPE_AGENT
#define LDS_WAIT() asm volatile("s_waitcnt lgkmcnt(0)" ::: "memory")
#define VM_WAIT() asm volatile("s_waitcnt vmcnt(0)" ::: "memory")
__device__ __forceinline__ unsigned f2bf(float f) { unsigned u = __builtin_bit_cast(unsigned, f); return (u + 0x7fffu + ((u >> 16) & 1u)) >> 16; }
__device__ __forceinline__ unsigned pk2(float lo, float hi) { return f2bf(lo) | (f2bf(hi) << 16); }
__device__ __forceinline__ float bflo(unsigned w) { return __builtin_bit_cast(float, w << 16); }
__device__ __forceinline__ float bfhi(unsigned w) { return __builtin_bit_cast(float, w & 0xffff0000u); }
__device__ __forceinline__ float bf1(bf16 h) { return __builtin_bit_cast(float, (unsigned)h << 16); }
__device__ __forceinline__ float sigm(float x) { return 1.0f / (1.0f + __expf(-x)); }
__device__ __forceinline__ float wave_sum(float v) {
#pragma unroll
    for (int o = 1; o < 64; o <<= 1) v += __shfl_xor(v, o);
    return v;
}
__device__ __forceinline__ float wave_max(float v) {
#pragma unroll
    for (int o = 1; o < 64; o <<= 1) v = fmaxf(v, __shfl_xor(v, o));
    return v;
}

#define XB_TMO      128
#define XB_XCNT(j)  (256  + 64 * (j))
#define XB_XSUB(j)  (1280 + 64 * (j))
#define XB_XGEN(j)  (2304 + 64 * (j))
#define XB_TOP      3328
#define XB_TOPGEN   3392
#define XCD_BAR_WORDS 3456
#define XB_SPIN_CAP (1u << 18)
__device__ __forceinline__ unsigned xb_ld(unsigned* p)              { return __hip_atomic_load(p, __ATOMIC_RELAXED, __HIP_MEMORY_SCOPE_AGENT); }
__device__ __forceinline__ unsigned xb_add(unsigned* p, unsigned v) { return __hip_atomic_fetch_add(p, v, __ATOMIC_RELAXED, __HIP_MEMORY_SCOPE_AGENT); }
__device__ __forceinline__ unsigned xb_xcc_id() { return (unsigned)__builtin_amdgcn_s_getreg((3 << 11) | 20) & 0xFu; }
#define XB_SPIN(cond, bar) do { unsigned _sp = 0; while (cond) { __builtin_amdgcn_s_sleep(1); \
    if ((++_sp & 255u) == 0u) { if (xb_ld(&(bar)[XB_TMO])) break; if (_sp > XB_SPIN_CAP) { atomicAdd(&(bar)[XB_TMO], 1u); break; } } } } while (0)
struct XcdBarrier { unsigned* bar; unsigned x; volatile LAS unsigned* st; };
__device__ __forceinline__ XcdBarrier xcd_barrier_post(unsigned* bar, volatile LAS unsigned* st) {
    XcdBarrier b; b.bar = bar; b.x = xb_xcc_id(); b.st = st;
    if (threadIdx.x == 0) (void)xb_add(&bar[XB_XCNT(b.x)], 1u);
    return b;
}
__device__ __forceinline__ void xcd_barrier_complete(unsigned* bar, unsigned x, unsigned& nloc, unsigned& nx) {
    const unsigned G = gridDim.x * gridDim.y * gridDim.z;
    unsigned sum, cnt, mine, sp = 0u;
    for (;;) {
        sum = 0u; cnt = 0u; mine = 0u;
#pragma unroll
        for (unsigned j = 0; j < 16; ++j) { const unsigned c = xb_ld(&bar[XB_XCNT(j)]); sum += c; cnt += (c > 0u) ? 1u : 0u; mine = (j == x) ? c : mine; }
        if (sum == G) break;
        __builtin_amdgcn_s_sleep(1);
        if ((++sp & 255u) == 0u) { if (xb_ld(&bar[XB_TMO])) break; if (sp > XB_SPIN_CAP) { atomicAdd(&bar[XB_TMO], 1u); break; } }
    }
    nloc = mine > 0u ? mine : 1u; nx = cnt > 0u ? cnt : 1u;
}
__device__ __forceinline__ void xcd_barrier(const XcdBarrier& b) {
    asm volatile("s_waitcnt vmcnt(0)" ::: "memory");
    __syncthreads();
    if (threadIdx.x == 0) {
        unsigned* bar = b.bar;
        __builtin_amdgcn_s_waitcnt(0);
        unsigned nloc = b.st[0], nx = b.st[1];
        if (nloc == 0u) { xcd_barrier_complete(bar, b.x, nloc, nx); b.st[0] = nloc; b.st[1] = nx; }
        const unsigned old = xb_add(&bar[XB_XSUB(b.x)], 1u);
        const unsigned gen = old / nloc;
        if (old + 1u == (gen + 1u) * nloc) {
            __builtin_amdgcn_fence(__ATOMIC_RELEASE, "agent");
            asm volatile("s_waitcnt vmcnt(0)" ::: "memory");
            const unsigned og = xb_add(&bar[XB_TOP], 1u);
            const unsigned tg = og / nx;
            if (og + 1u == (tg + 1u) * nx) xb_add(&bar[XB_TOPGEN], 1u);
            else XB_SPIN(xb_ld(&bar[XB_TOPGEN]) == tg, bar);
            __builtin_amdgcn_fence(__ATOMIC_ACQUIRE, "agent");
            xb_add(&bar[XB_XGEN(b.x)], 1u);
            asm volatile("s_waitcnt vmcnt(0)" ::: "memory");
        } else {
            XB_SPIN(xb_ld(&bar[XB_XGEN(b.x)]) == gen, bar);
            __builtin_amdgcn_fence(__ATOMIC_ACQUIRE, "agent");
            asm volatile("s_waitcnt vmcnt(0)" ::: "memory");
        }
    }
    __syncthreads();
}

struct Frame {
    LAS unsigned char* lds;
    volatile LAS unsigned* MISC;
    gu32* ctl;
    int tid, lane, wave;
    int vcu, G;
    const float* in[18]; float* out; unsigned char* ws;
};
__device__ const unsigned char T5_BUCKET[128] = {0,1,2,3,4,5,6,7,8,9,10,11,12,13,14,15,16,16,16,17,17,18,18,18,19,19,19,20,20,20,20,21,21,21,21,22,22,22,22,22,23,23,23,23,23,23,24,24,24,24,24,24,25,25,25,25,25,25,25,26,26,26,26,26,26,26,26,27,27,27,27,27,27,27,27,27,27,28,28,28,28,28,28,28,28,28,28,29,29,29,29,29,29,29,29,29,29,29,29,30,30,30,30,30,30,30,30,30,30,30,30,30,30,31,31,31,31,31,31,31,31,31,31,31,31,31,31,31};

__device__ __forceinline__ void p0_transpose_item(const float* W, int ldw, int src_col0, int K, bf16* WT, int dst_row0, const float* gain, LAS float* scr, int kb, int lane) {
    const int k0 = 64 * kb;
#pragma unroll 8
    for (int i = 0; i < 32; ++i) { const int kk = 2 * i + (lane >> 5); float v = W[(size_t)(k0 + kk) * ldw + src_col0 + (lane & 31)]; if (gain) v *= gain[k0 + kk]; scr[kk * 33 + (lane & 31)] = v; }
    LDS_WAIT(); asm volatile("" ::: "memory");
    const int c = lane & 7;
#pragma unroll
    for (int j = 0; j < 4; ++j) { const int n = (lane >> 3) + 8 * j; const LAS float* s = scr + (8 * c) * 33 + n;
        v4u o; o.x = pk2(s[0 * 33], s[1 * 33]); o.y = pk2(s[2 * 33], s[3 * 33]); o.z = pk2(s[4 * 33], s[5 * 33]); o.w = pk2(s[6 * 33], s[7 * 33]);
        *(GAS v4u*)(WT + (size_t)(dst_row0 + n) * K + k0 + 8 * c) = o; }
    LDS_WAIT(); asm volatile("" ::: "memory");
}
__device__ __forceinline__ void p0_prologue(Frame& F) {
    LAS float* scr = (LAS float*)(F.lds + RING_OFF + F.wave * 16384);
    const int gw = F.vcu * NWAVES + F.wave, NGW = F.G * NWAVES;
    unsigned char* ws = F.ws;
    bf16* WinT = (bf16*)(ws + WS_WIN); bf16* WabT = (bf16*)(ws + WS_WAB); bf16* WoutT = (bf16*)(ws + WS_WOUT); bf16* WguT = (bf16*)(ws + WS_WGU); bf16* WdT = (bf16*)(ws + WS_WD);
    constexpr int I_IN = 16 * (NP / 32), I_AB = 8 * 32, I_OUT = 16 * 32, I_GU = 16 * (2 * FF / 32), I_D = (FF / 64) * 32;
    constexpr int NITEMS = I_IN + 2 * I_AB + I_OUT + I_GU + I_D;
    for (int it = gw; it < NITEMS; it += NGW) {
        int r = it;
        if (r < I_IN) { const int nb = r % (NP / 32), kb = r / (NP / 32), dr = 32 * nb; p0_transpose_item(F.in[2], D_IN, dr < 2048 ? dr : dr + 8, D, WinT, dr, F.in[1], scr, kb, F.lane); continue; } r -= I_IN;
        if (r < I_AB) { const int nb = r % 32, kb = r / 32; p0_transpose_item(F.in[11], D, 32 * nb, DN_W, WabT, 32 * nb, nullptr, scr, kb, F.lane); continue; } r -= I_AB;
        if (r < I_AB) { const int nb = r % 32, kb = r / 32; p0_transpose_item(F.in[12], D, 32 * nb, SW_W, WabT, 1024 + 32 * nb, nullptr, scr, kb, F.lane); continue; } r -= I_AB;
        if (r < I_OUT) { const int nb = r % 32, kb = r / 32; p0_transpose_item(F.in[13], D, 32 * nb, D, WoutT, 32 * nb, nullptr, scr, kb, F.lane); continue; } r -= I_OUT;
        if (r < I_GU) { const int nb = r % (2 * FF / 32), kb = r / (2 * FF / 32), dr = 32 * nb, pn = dr >> 8, j = dr & 255;
            const float* W = (j < 128) ? F.in[15] : F.in[16]; p0_transpose_item(W, FF, 128 * pn + (j & 127), D, WguT, dr, F.in[14], scr, kb, F.lane); continue; } r -= I_GU;
        { const int nb = r % 32, kb = r / 32; p0_transpose_item(F.in[17], D, 32 * nb, FF, WdT, 32 * nb, nullptr, scr, kb, F.lane); }
    }
    __syncthreads();
    LAS float* wba = (LAS float*)(F.lds + RING_OFF);
    for (int idx = F.tid; idx < 8 * D; idx += NWAVES * 64) { const int k = idx >> 3, j = idx & 7; wba[j * D + k] = F.in[2][(size_t)k * D_IN + 2048 + j] * F.in[1][k]; }
    __syncthreads();
    const float* x = F.in[0]; bf16* XB = (bf16*)(ws + WS_XB); float* rstd1 = (float*)(ws + WS_RSTD); float* gbp = (float*)(ws + WS_GB);
    for (int m = gw; m < M; m += NGW) {
        const GAS f32x4* xr = (const GAS f32x4*)(x + (size_t)m * D) + F.lane;
        f32x4 v[4]; float ss = 0.f;
#pragma unroll
        for (int j = 0; j < 4; ++j) { v[j] = xr[64 * j]; ss += (v[j].x * v[j].x + v[j].y * v[j].y) + (v[j].z * v[j].z + v[j].w * v[j].w); }
        const float rstd = 1.0f / sqrtf(wave_sum(ss) * (1.0f / D) + EPS);
        GAS unsigned long long* o8 = (GAS unsigned long long*)(XB + (size_t)m * D) + F.lane;
#pragma unroll
        for (int j = 0; j < 4; ++j) o8[64 * j] = (unsigned long long)pk2(v[j].x, v[j].y) | ((unsigned long long)pk2(v[j].z, v[j].w) << 32);
        float acc[8];
#pragma unroll
        for (int c = 0; c < 8; ++c) { float a = 0.f;
#pragma unroll
            for (int j = 0; j < 4; ++j) { const f32x4 w = *(const LAS f32x4*)(wba + c * D + 256 * j + 4 * F.lane); a += (v[j].x * w.x + v[j].y * w.y) + (v[j].z * w.z + v[j].w * w.w); }
            acc[c] = wave_sum(a) * rstd; }
        if (F.lane == 0) {
            rstd1[m] = rstd;
#pragma unroll
            for (int h = 0; h < 4; ++h) {
                const float beta = 1.0f / (1.0f + expf(-acc[h]));
                const float xx = acc[4 + h] + F.in[5][h]; const float sp = xx > 20.f ? xx : log1pf(expf(xx));
                gbp[(size_t)m * 8 + h] = beta; gbp[(size_t)m * 8 + 4 + h] = -expf(F.in[4][h]) * sp; }
        }
    }
}

__device__ __forceinline__ void dn_pre(Frame& F) {
    const int gw = F.vcu * NWAVES + F.wave, NGW = F.G * NWAVES;
    const bf16* proj = (const bf16*)(F.ws + WS_PROJ); const float* conv = F.in[3];
    float* QN = F.out; float* KN = F.out + (size_t)M * DN_W; float* VV = (float*)(F.ws + WS_XB);
    for (int task = gw; task < M * DN_H; task += NGW) {
        const int m = task >> 2, h = task & 3, t = m & (SEQ - 1);
        float val[3][2];
#pragma unroll
        for (int part = 0; part < 3; ++part) { const int col = part * DN_W + h * DN_D + 2 * F.lane; float a0 = 0.f, a1 = 0.f;
#pragma unroll
            for (int j = 0; j < 4; ++j) { if (t - 3 + j >= 0) { const unsigned w = *(const unsigned*)(proj + (size_t)(m - 3 + j) * NP + col); a0 += conv[j * DN_QKV + col] * bflo(w); a1 += conv[j * DN_QKV + col + 1] * bfhi(w); } }
            val[part][0] = a0 * sigm(a0); val[part][1] = a1 * sigm(a1); }
        const float rq = 1.0f / sqrtf(wave_sum(val[0][0] * val[0][0] + val[0][1] * val[0][1]) + EPS) * 0.08838834764831845f;
        const float rk = 1.0f / sqrtf(wave_sum(val[1][0] * val[1][0] + val[1][1] * val[1][1]) + EPS);
        const size_t o = (size_t)m * DN_W + h * DN_D + 2 * F.lane;
        *(f32x2*)(QN + o) = (f32x2){val[0][0] * rq, val[0][1] * rq};
        *(f32x2*)(KN + o) = (f32x2){val[1][0] * rk, val[1][1] * rk};
        *(f32x2*)(VV + o) = (f32x2){val[2][0], val[2][1]};
    }
}
__device__ __forceinline__ void dn_scan_naive(Frame& F, int bh) {
    const int b = bh >> 2, h = bh & 3, tid = F.tid, dvi = tid >> 2, kq = tid & 3;
    LAS float* kL = (LAS float*)(F.lds + RING_OFF); LAS float* qL = kL + 32 * 128; LAS float* vL = qL + 32 * 128; LAS float* gL = vL + 32 * 128; LAS float* bL = gL + 32;
    const float* QN = F.out; const float* KN = F.out + (size_t)M * DN_W; float* VV = (float*)(F.ws + WS_XB); const float* gbp = (const float*)(F.ws + WS_GB);
    float S[32];
#pragma unroll
    for (int j = 0; j < 32; ++j) S[j] = 0.f;
    for (int t0 = 0; t0 < SEQ; t0 += 32) {
#pragma unroll
        for (int r = 0; r < 2; ++r) { const int idx = tid + 512 * r, tok = idx >> 5, c4 = idx & 31; const size_t src = (size_t)(b * SEQ + t0 + tok) * DN_W + h * DN_D + c4 * 4;
            *(LAS f32x4*)(kL + tok * 128 + c4 * 4) = *(const f32x4*)(KN + src); *(LAS f32x4*)(qL + tok * 128 + c4 * 4) = *(const f32x4*)(QN + src); *(LAS f32x4*)(vL + tok * 128 + c4 * 4) = *(const f32x4*)(VV + src); }
        if (tid < 32) { const size_t mm = (size_t)(b * SEQ + t0 + tid); bL[tid] = gbp[mm * 8 + h]; gL[tid] = gbp[mm * 8 + 4 + h]; }
        __syncthreads();
        for (int i = 0; i < 32; ++i) {
            const float eg = __expf(gL[i]), be = bL[i];
            float kk[32];
#pragma unroll
            for (int j = 0; j < 8; ++j) { const f32x4 w = *(const LAS f32x4*)(kL + i * 128 + kq * 32 + 4 * j); kk[4 * j] = w.x; kk[4 * j + 1] = w.y; kk[4 * j + 2] = w.z; kk[4 * j + 3] = w.w; }
            float part = 0.f;
#pragma unroll
            for (int j = 0; j < 32; ++j) part += kk[j] * S[j];
            part += __shfl_xor(part, 1); part += __shfl_xor(part, 2);
            const float c = be * (vL[i * 128 + dvi] - eg * part);
#pragma unroll
            for (int j = 0; j < 32; ++j) S[j] = eg * S[j] + c * kk[j];
            float po = 0.f;
#pragma unroll
            for (int j = 0; j < 8; ++j) { const f32x4 w = *(const LAS f32x4*)(qL + i * 128 + kq * 32 + 4 * j); po += (w.x * S[4 * j] + w.y * S[4 * j + 1]) + (w.z * S[4 * j + 2] + w.w * S[4 * j + 3]); }
            po += __shfl_xor(po, 1); po += __shfl_xor(po, 2);
            if (kq == 0) vL[i * 128 + dvi] = po;
        }
        __syncthreads();
#pragma unroll
        for (int r = 0; r < 2; ++r) { const int idx = tid + 512 * r, tok = idx >> 5, c4 = idx & 31; const size_t src = (size_t)(b * SEQ + t0 + tok) * DN_W + h * DN_D + c4 * 4;
            *(f32x4*)(VV + src) = *(const LAS f32x4*)(vL + tok * 128 + c4 * 4); }
        __syncthreads();
    }
}
__device__ __forceinline__ void swa_naive(Frame& F, int wv, int nworkers) {
    const bf16* proj = (const bf16*)(F.ws + WS_PROJ); bf16* YSWA = (bf16*)(F.ws + WS_Y) + (size_t)M * SW_W;
    LAS float* qs = (LAS float*)(F.lds + RING_OFF + 65536 + F.wave * 1024); LAS float* ps = qs + 64;
    const float* qg = F.in[7]; const float* kg = F.in[8]; const float* sinks = F.in[9]; const float* relb = F.in[10];
    const int lane = F.lane;
    for (int task = wv; task < M * SW_H; task += nworkers) {
        const int m = task >> 3, qh = task & 7, kvh = qh >> 2, t = m & (SEQ - 1);
        const float q = bf1(proj[(size_t)m * NP + PC_SQ + qh * SW_D + lane]);
        const float qn = q * (1.0f / sqrtf(wave_sum(q * q) * (1.0f / SW_D) + EPS)) * qg[lane];
        qs[lane] = qn * kg[lane];
        LDS_WAIT(); asm volatile("" ::: "memory");
        float lg[2];
#pragma unroll
        for (int hf = 0; hf < 2; ++hf) { const int j = lane + 64 * hf; lg[hf] = -INFINITY;
            if (t - 127 + j >= 0) { const v4u* kr = (const v4u*)(proj + (size_t)(m - 127 + j) * NP + PC_SK + kvh * SW_D); float ssk = 0.f, dot = 0.f;
#pragma unroll
                for (int c = 0; c < 8; ++c) { const v4u w = kr[c];
#pragma unroll
                    for (int e = 0; e < 4; ++e) { const float k0 = bflo(w[e]), k1 = bfhi(w[e]); ssk += k0 * k0 + k1 * k1; dot += qs[8 * c + 2 * e] * k0 + qs[8 * c + 2 * e + 1] * k1; } }
                lg[hf] = dot * (1.0f / sqrtf(ssk * (1.0f / SW_D) + EPS)) * 0.125f + relb[(int)T5_BUCKET[127 - j] * SW_H + qh]; } }
        const float sink = sinks[qh];
        const float mx = fmaxf(wave_max(fmaxf(lg[0], lg[1])), sink);
        const float p0 = (lg[0] == -INFINITY) ? 0.f : __expf(lg[0] - mx), p1 = (lg[1] == -INFINITY) ? 0.f : __expf(lg[1] - mx);
        const float den = wave_sum(p0 + p1) + __expf(sink - mx);
        ps[lane] = p0; ps[lane + 64] = p1;
        LDS_WAIT(); asm volatile("" ::: "memory");
        float o = 0.f; const int jmin = (127 - t) > 0 ? (127 - t) : 0;
        for (int j = jmin; j < 128; ++j) o += ps[j] * bf1(proj[(size_t)(m - 127 + j) * NP + PC_SV + kvh * SW_D + lane]);
        YSWA[(size_t)m * SW_W + qh * SW_D + lane] = (bf16)f2bf(o / den);
        LDS_WAIT(); asm volatile("" ::: "memory");
    }
}
__device__ __forceinline__ void dn_out(Frame& F) {
    const int gw = F.vcu * NWAVES + F.wave, NGW = F.G * NWAVES;
    const bf16* proj = (const bf16*)(F.ws + WS_PROJ); const float* VV = (const float*)(F.ws + WS_XB); bf16* YDN = (bf16*)(F.ws + WS_Y); const float* gain = F.in[6];
    for (int task = gw; task < M * DN_H; task += NGW) {
        const int m = task >> 2, h = task & 3;
        const f32x2 o = *(const f32x2*)(VV + (size_t)m * DN_W + h * DN_D + 2 * F.lane);
        const float r = 1.0f / sqrtf(wave_sum(o.x * o.x + o.y * o.y) * (1.0f / DN_D) + EPS);
        const unsigned zw = *(const unsigned*)(proj + (size_t)m * NP + PC_Z + h * DN_D + 2 * F.lane); const float z0 = bflo(zw), z1 = bfhi(zw);
        *(unsigned*)(YDN + (size_t)m * DN_W + h * DN_D + 2 * F.lane) = pk2(o.x * r * gain[2 * F.lane] * z0 * sigm(z0), o.y * r * gain[2 * F.lane + 1] * z1 * sigm(z1));
    }
}

struct Args { const float* in[18]; float* out; unsigned char* ws; int ph_lo, ph_hi, li, pad; };
__global__ void __launch_bounds__(NWAVES * 64, 2) fwd_kernel(Args args) {
    extern __shared__ __attribute__((aligned(16))) unsigned char lds[];
    Frame F;
    F.lds = (LAS unsigned char*)lds;
    F.MISC = (volatile LAS unsigned*)(F.lds + MISC_OFF);
    F.tid = threadIdx.x; F.lane = F.tid & 63; F.wave = __builtin_amdgcn_readfirstlane(F.tid >> 6);
    F.G = gridDim.x; { const int bx = blockIdx.x; F.vcu = (F.G % 8 == 0) ? (bx % 8) * (F.G / 8) + bx / 8 : bx; }
#pragma unroll
    for (int i = 0; i < 18; ++i) F.in[i] = args.in[i];
    F.out = args.out; F.ws = args.ws; unsigned char* ws = args.ws;
    F.ctl = (gu32*)(ws + WS_CTL);
    for (int u = F.tid; u < (LDS_BYTES - LDSCTL_OFF) / 4; u += NWAVES * 64) ((LAS unsigned*)(F.lds + LDSCTL_OFF))[u] = 0u;
    __syncthreads();
    const int lo = args.ph_lo, hi = args.ph_hi;
    XcdBarrier bar; bar.bar = (unsigned*)(F.ctl + CW_BAR) + args.li * XCD_BAR_WORDS; bar.x = 0; bar.st = nullptr;
    if (hi - lo > 1) bar = xcd_barrier_post((unsigned*)(F.ctl + CW_BAR) + args.li * XCD_BAR_WORDS, F.MISC + 8);
#define IN(k) (lo <= (k) && (k) < hi)
#define BOTH(k) (IN(k) && IN((k) + 1))
    bf16* XB = (bf16*)(ws + WS_XB); bf16* Y = (bf16*)(ws + WS_Y); bf16* PROJ = (bf16*)(ws + WS_PROJ);

    if (IN(0)) { p0_prologue(F); if (BOTH(0)) xcd_barrier(bar); }
    if (IN(1)) {
        pg8::Gemm g{XB, (const bf16*)(ws + WS_WIN), M, NP, D}; pg8::StaticOrder S; S.init(M, NP, F.G, (int)blockIdx.x);
        pg8::EpiProj E{PROJ, NP, (const float*)(ws + WS_RSTD)};
        pg8::gemm_phase<pg8::EpiProj, pg8::StaticOrder, true, true>(F.lds + RING_OFF, g, S, E);
        if (BOTH(1)) xcd_barrier(bar);
    }
    if (IN(2)) { dn_pre(F); if (BOTH(2)) xcd_barrier(bar); }
    if (IN(3)) {
        if (F.G > 16) { if (F.vcu < 16) dn_scan_naive(F, F.vcu); else swa_naive(F, (F.vcu - 16) * NWAVES + F.wave, (F.G - 16) * NWAVES); }
        else { for (int bh = F.vcu; bh < 16; bh += F.G) dn_scan_naive(F, bh); swa_naive(F, F.vcu * NWAVES + F.wave, F.G * NWAVES); }
        if (BOTH(3)) xcd_barrier(bar);
    }
    if (IN(4)) { dn_out(F); if (BOTH(4)) xcd_barrier(bar); }
    if (IN(5)) {
        pg8::Gemm g{Y, (const bf16*)(ws + WS_WAB), 2 * M, 2 * D, DN_W}; pg8::PairedOrder S; S.init(M, D, F.G, (int)blockIdx.x);
        pg8::EpiMerge E{PROJ + PC_G, NP, XB, D, M / 256, D / 256};
        pg8::gemm_phase<pg8::EpiMerge, pg8::PairedOrder, false, true>(F.lds + RING_OFF, g, S, E);
        if (BOTH(5)) xcd_barrier(bar);
    }
    if (IN(6)) {
        pg8::Gemm g{XB, (const bf16*)(ws + WS_WOUT), M, D, D}; pg8::StaticOrder S; S.init(M, D, F.G, (int)blockIdx.x);
        pg8::EpiX1 E{F.in[0], F.out, Y, (float*)(ws + WS_SSQ), D};
        pg8::gemm_phase<pg8::EpiX1, pg8::StaticOrder, false, true>(F.lds + RING_OFF, g, S, E);
        if (BOTH(6)) xcd_barrier(bar);
    }
    if (IN(7)) {
        pg8::Gemm g{Y, (const bf16*)(ws + WS_WGU), M, 2 * FF, D}; pg8::StaticOrder S; S.init(M, 2 * FF, F.G, (int)blockIdx.x);
        pg8::EpiSwiGLU E{PROJ, FF, (const float*)(ws + WS_SSQ), EPS};
        pg8::gemm_phase<pg8::EpiSwiGLU, pg8::StaticOrder, true, true>(F.lds + RING_OFF, g, S, E);
        if (BOTH(7)) xcd_barrier(bar);
    }
    if (IN(8)) {
        pg8::Gemm g{PROJ, (const bf16*)(ws + WS_WD), M, D, FF}; pg8::StaticOrder S; S.init(M, D, F.G, (int)blockIdx.x);
        pg8::EpiOut E{F.out, D};
        pg8::gemm_phase<pg8::EpiOut, pg8::StaticOrder, false, true>(F.lds + RING_OFF, g, S, E);
    }
#undef IN
#undef BOTH
}

extern "C" void kernel_launch(void* const* d_in, const int* in_sizes, int n_in, void* d_out, int out_size, void* d_ws, size_t ws_size, hipStream_t stream) {
    static int grid = 0;
    if (grid == 0) {
        if (n_in != 18 || in_sizes[0] != M * D || out_size != M * D || ws_size < WS_END) { fprintf(stderr, "kernel_launch: unexpected shapes (n_in %d, in0 %d, out %d, ws %zu)\n", n_in, n_in > 0 ? in_sizes[0] : -1, out_size, ws_size); grid = -1; return; }
        int dev = 0, cus = 0;
        if (hipGetDevice(&dev) != hipSuccess || hipDeviceGetAttribute(&cus, hipDeviceAttributeMultiprocessorCount, dev) != hipSuccess) { grid = -1; return; }
        if (hipFuncSetAttribute((const void*)fwd_kernel, hipFuncAttributeMaxDynamicSharedMemorySize, LDS_BYTES) != hipSuccess) { fprintf(stderr, "kernel_launch: hipFuncSetAttribute failed\n"); grid = -1; return; }
        int per_cu = 0;
        if (hipOccupancyMaxActiveBlocksPerMultiprocessor(&per_cu, (const void*)fwd_kernel, NWAVES * 64, LDS_BYTES) != hipSuccess || per_cu < 1) fprintf(stderr, "kernel_launch: occupancy query reports %d\n", per_cu);
        (void)hipGetLastError();
        grid = cus;
    }
    if (grid < 0) return;
    if (hipMemsetAsync((char*)d_ws + WS_CTL, 0, CTL_ZERO_BYTES, stream) != hipSuccess) return;
    Args a{};
    for (int i = 0; i < 18; ++i) a.in[i] = (const float*)d_in[i];
    a.out = (float*)d_out; a.ws = (unsigned char*)d_ws;
    for (int li = 0; li < N_LAUNCHES; ++li) {
        if (N_LAUNCHES == 1) { a.ph_lo = 0; a.ph_hi = PER_PHASE; } else { a.ph_lo = li * PER_PHASE / N_LAUNCHES; a.ph_hi = (li + 1) * PER_PHASE / N_LAUNCHES; }
        a.li = li;
        hipLaunchKernelGGL(fwd_kernel, dim3(grid), dim3(NWAVES * 64), LDS_BYTES, stream, a);
        const hipError_t le = hipPeekAtLastError();
        if (le != hipSuccess) { fprintf(stderr, "kernel_launch: launch %d failed: %s\n", li, hipGetErrorName(le)); break; }
    }
}
```

```cpp
#include <hip/hip_runtime.h>
#include <cstdio>
#include <cstdint>

namespace pg8 {
#define PG8_LAS __attribute__((address_space(3)))
typedef unsigned short bf16_t;
typedef short bf16x8 __attribute__((ext_vector_type(8)));
typedef float f32x4 __attribute__((ext_vector_type(4)));
typedef unsigned u32x4 __attribute__((ext_vector_type(4)));
typedef unsigned u32x2 __attribute__((ext_vector_type(2)));
constexpr int BM = 256, BK = 64, HALF = 128, HTB = HALF * BK * 2  , STAGE_BYTES = 8 * HTB, NXCD = 8, WGM = 8;

__host__ __device__ __forceinline__ int lds_byte(int r, int c) { const int st = (r >> 4) * 2 + (c >> 5), rr = r & 15, cc = c & 31, ob = rr * 64 + cc * 2; return st * 1024 + (ob ^ (((ob >> 9) & 1) << 5)); }
__host__ __device__ __forceinline__ void stage_rc(int b, int& R, int& C) { const int st = b / 1024, sb = b % 1024, swz = sb ^ (((sb >> 9) & 1) << 5); R = (st >> 1) * 16 + swz / 64; C = (st & 1) * 32 + (swz % 64) / 2; }
__host__ __device__ __forceinline__ int perm32(int rho) { const int n = rho >> 4, i = rho & 15; return 8 * (i >> 2) + 4 * n + (i & 3); }

struct Unit { int pm, pn; };
struct Gemm { const bf16_t* A; const bf16_t* Bt; int M, N, K; };

struct StaticOrder {
    int nM, nN, nwg, G, c;
    __host__ __device__ void init(int M, int N, int G_, int c_) { nM = M / BM; nN = N / BM; nwg = nM * nN; G = G_; c = c_; }
    __host__ __device__ bool next(int i, Unit& u) const {
        const long L = (long)i * G + c; if (L >= nwg) return false;
        int wgid = (int)L; { const int q = nwg / NXCD, r = nwg % NXCD, xcd = wgid % NXCD, off = wgid / NXCD; wgid = (xcd < r ? xcd * (q + 1) : r * (q + 1) + (xcd - r) * q) + off; }
        const int nig = WGM * nN, gid = wgid / nig, fm = gid * WGM, gsz = (nM - fm) < WGM ? (nM - fm) : WGM;
        u.pm = fm + ((wgid % nig) % gsz); u.pn = (wgid % nig) / gsz; return true;
    }
    __device__ __forceinline__ void a_ready(const Unit&) const {}
    __device__ __forceinline__ void done(const Unit&) const {}
};
struct PairedOrder {
    StaticOrder so;
    __host__ __device__ void init(int M, int N, int G_, int c_) { so.init(M, N, G_, c_); }
    __host__ __device__ bool next(int i, Unit& u) const { if (!so.next(i >> 1, u)) return false; if (i & 1) { u.pm += so.nM; u.pn += so.nN; } return true; }
    __device__ __forceinline__ void a_ready(const Unit&) const {}
    __device__ __forceinline__ void done(const Unit&) const {}
};

__device__ __forceinline__ unsigned cvt_pk_bf16(float lo, float hi) { unsigned r; asm volatile("v_cvt_pk_bf16_f32 %0, %1, %2" : "=v"(r) : "v"(lo), "v"(hi)); return r; }
__device__ __forceinline__ float bf_lo(unsigned w) { return __builtin_bit_cast(float, w << 16); }
__device__ __forceinline__ float bf_hi(unsigned w) { return __builtin_bit_cast(float, w & 0xffff0000u); }
__device__ __forceinline__ float sigmoidf_(float x) { return 1.0f / (1.0f + __expf(-x)); }


struct EpiProj {
    static constexpr bool PERM = true, AFTER_DRAIN = false;
    bf16_t* O; int ldc; const float* rstd;
    __device__ __forceinline__ bool keep(const Unit&) const { return false; }
    __device__ __forceinline__ void operator()(f32x4 (&acc)[2][2][4][2], const Unit& u, int wr, int wc, int fr, int fq) const {
        const int row0 = u.pm * BM + wr * 64 + fr, col0 = u.pn * BM + wc * 32 + 8 * fq;
#pragma unroll
        for (int ai = 0; ai < 2; ++ai)
#pragma unroll
            for (int m = 0; m < 4; ++m) { const int row = row0 + ai * HALF + m * 16; const float s = rstd[row]; bf16_t* rowp = O + (size_t)row * ldc + col0;
#pragma unroll
                for (int bj = 0; bj < 2; ++bj) { const f32x4 v0 = acc[ai][bj][m][0] * s, v1 = acc[ai][bj][m][1] * s;
                    u32x4 w; w.x = cvt_pk_bf16(v0[0], v0[1]); w.y = cvt_pk_bf16(v0[2], v0[3]); w.z = cvt_pk_bf16(v1[0], v1[1]); w.w = cvt_pk_bf16(v1[2], v1[3]);
                    *(u32x4*)(rowp + bj * HALF) = w; } }
    }
};
struct EpiMerge {
    static constexpr bool PERM = true, AFTER_DRAIN = false;
    const bf16_t* G; int ldg; bf16_t* O; int ldc; int nM, nN;
    __device__ __forceinline__ bool keep(const Unit& u) const { return u.pm < nM; }
    __device__ __forceinline__ void operator()(f32x4 (&acc)[2][2][4][2], const Unit& u, int wr, int wc, int fr, int fq) const {
        const bool second = u.pm >= nM; const int pm = second ? u.pm - nM : u.pm, pn = second ? u.pn - nN : u.pn;
        const int row0 = pm * BM + wr * 64 + fr, col0 = pn * BM + wc * 32 + 8 * fq;
#pragma unroll
        for (int ai = 0; ai < 2; ++ai)
#pragma unroll
            for (int m = 0; m < 4; ++m) { const int row = row0 + ai * HALF + m * 16;
#pragma unroll
                for (int bj = 0; bj < 2; ++bj) { const int col = col0 + bj * HALF;
                    const u32x4 ga = *(const u32x4*)(G + (size_t)row * ldg + col), gb = *(const u32x4*)(G + (size_t)row * ldg + 1024 + col);
                    float ea[8], eb[8];
#pragma unroll
                    for (int j = 0; j < 4; ++j) { ea[2 * j] = __expf(-bf_lo(ga[j])); ea[2 * j + 1] = __expf(-bf_hi(ga[j])); eb[2 * j] = __expf(-bf_lo(gb[j])); eb[2 * j + 1] = __expf(-bf_hi(gb[j])); }
                    if (!second) {
#pragma unroll
                        for (int j = 0; j < 4; ++j) { acc[ai][bj][m][0][j] *= (1.0f + eb[j]) / (1.0f + ea[j]); acc[ai][bj][m][1][j] *= (1.0f + eb[4 + j]) / (1.0f + ea[4 + j]); }
                    } else {
                        f32x4 v0, v1;
#pragma unroll
                        for (int j = 0; j < 4; ++j) { v0[j] = acc[ai][bj][m][0][j] / (1.0f + eb[j]); v1[j] = acc[ai][bj][m][1][j] / (1.0f + eb[4 + j]); }
                        u32x4 w; w.x = cvt_pk_bf16(v0[0], v0[1]); w.y = cvt_pk_bf16(v0[2], v0[3]); w.z = cvt_pk_bf16(v1[0], v1[1]); w.w = cvt_pk_bf16(v1[2], v1[3]);
                        *(u32x4*)(O + (size_t)row * ldc + col) = w; } } }
    }
};
struct EpiX1 {
    static constexpr bool PERM = false, AFTER_DRAIN = false;
    const float* X; float* out; bf16_t* xb; float* ssq; int ldc;
    __device__ __forceinline__ bool keep(const Unit&) const { return false; }
    __device__ __forceinline__ void operator()(f32x4 (&acc)[2][2][4][2], const Unit& u, int wr, int wc, int fr, int fq) const {
        const int row0 = u.pm * BM + wr * 64 + fr, col0 = u.pn * BM + wc * 32 + 4 * fq;
#pragma unroll
        for (int ai = 0; ai < 2; ++ai)
#pragma unroll
            for (int m = 0; m < 4; ++m) { const int row = row0 + ai * HALF + m * 16; const size_t off = (size_t)row * ldc + col0; float ss = 0.f;
#pragma unroll
                for (int bj = 0; bj < 2; ++bj)
#pragma unroll
                    for (int n = 0; n < 2; ++n) { const f32x4 xv = *(const f32x4*)(X + off + bj * HALF + n * 16); const f32x4 o = xv + acc[ai][bj][m][n];
                        *(f32x4*)(out + off + bj * HALF + n * 16) = o; ss += (o[0] * o[0] + o[1] * o[1]) + (o[2] * o[2] + o[3] * o[3]);
                        u32x2 w; w.x = cvt_pk_bf16(o[0], o[1]); w.y = cvt_pk_bf16(o[2], o[3]); *(u32x2*)(xb + off + bj * HALF + n * 16) = w; }
                ss += __shfl_xor(ss, 16); ss += __shfl_xor(ss, 32);
                if (fq == 0) ssq[(size_t)row * 16 + u.pn * 4 + wc] = ss; }
    }
};
struct EpiSwiGLU {
    static constexpr bool PERM = true, AFTER_DRAIN = false;
    bf16_t* O; int ldc; const float* ssq; float eps;
    __device__ __forceinline__ bool keep(const Unit&) const { return false; }
    __device__ __forceinline__ void operator()(f32x4 (&acc)[2][2][4][2], const Unit& u, int wr, int wc, int fr, int fq) const {
        const int row0 = u.pm * BM + wr * 64 + fr, col0 = u.pn * HALF + wc * 32 + 8 * fq;
#pragma unroll
        for (int ai = 0; ai < 2; ++ai)
#pragma unroll
            for (int m = 0; m < 4; ++m) { const int row = row0 + ai * HALF + m * 16;
                const f32x4* sp = (const f32x4*)(ssq + (size_t)row * 16); const f32x4 s0 = sp[0], s1 = sp[1], s2 = sp[2], s3 = sp[3];
                const float tot = ((s0[0] + s0[1]) + (s0[2] + s0[3])) + ((s1[0] + s1[1]) + (s1[2] + s1[3])) + ((s2[0] + s2[1]) + (s2[2] + s2[3])) + ((s3[0] + s3[1]) + (s3[2] + s3[3]));
                const float s = __builtin_amdgcn_rsqf(tot * (1.0f / 1024.0f) + eps);
                float a[8];
#pragma unroll
                for (int n = 0; n < 2; ++n)
#pragma unroll
                    for (int j = 0; j < 4; ++j) { const float g = acc[ai][0][m][n][j] * s, up = acc[ai][1][m][n][j] * s; a[4 * n + j] = g * up / (1.0f + __expf(-g)); }
                u32x4 w; w.x = cvt_pk_bf16(a[0], a[1]); w.y = cvt_pk_bf16(a[2], a[3]); w.z = cvt_pk_bf16(a[4], a[5]); w.w = cvt_pk_bf16(a[6], a[7]);
                *(u32x4*)(O + (size_t)row * ldc + col0) = w; }
    }
};
struct EpiOut {
    static constexpr bool PERM = false, AFTER_DRAIN = false;
    float* out; int ldc;
    __device__ __forceinline__ bool keep(const Unit&) const { return false; }
    __device__ __forceinline__ void operator()(f32x4 (&acc)[2][2][4][2], const Unit& u, int wr, int wc, int fr, int fq) const {
        const int row0 = u.pm * BM + wr * 64 + fr, col0 = u.pn * BM + wc * 32 + 4 * fq;
#pragma unroll
        for (int ai = 0; ai < 2; ++ai)
#pragma unroll
            for (int m = 0; m < 4; ++m) { float* rowp = out + (size_t)(row0 + ai * HALF + m * 16) * ldc + col0;
#pragma unroll
                for (int bj = 0; bj < 2; ++bj)
#pragma unroll
                    for (int n = 0; n < 2; ++n) { const f32x4 b = *(const f32x4*)(rowp + bj * HALF + n * 16); *(f32x4*)(rowp + bj * HALF + n * 16) = b + acc[ai][bj][m][n]; } }
    }
};

template <class Epi, class Sched, bool ALIGN_EPI = false, bool SP2 = false>
__device__ __forceinline__ void gemm_phase(PG8_LAS unsigned char* lds, const Gemm g, const Sched& S, const Epi& E) {
    const int tid = threadIdx.x, wid = __builtin_amdgcn_readfirstlane(tid >> 6), lane = tid & 63, wr = wid >> 2, wc = wid & 3, fr = lane & 15, fq = lane >> 4;
    const int K = g.K, nt = K / BK;
    unsigned voffA[2], voffB[2];
#pragma unroll
    for (int i = 0; i < 2; ++i) { int R, C; stage_rc(tid * 16 + i * 8192, R, C); const int Rb = Epi::PERM ? ((R & ~31) + perm32(R & 31)) : R;
        voffA[i] = (unsigned)(R * K + C) * 2u; voffB[i] = (unsigned)(Rb * K + C) * 2u; }
    const size_t kstep = (size_t)(BK * 2);
    const size_t hstep = (size_t)HALF * K * 2;
    const size_t tstep = 2 * hstep;
    const unsigned ldsw = (unsigned)wid * 1024u;
    const int aoff = lds_byte(wr * 64 + fr, fq * 8), boff = lds_byte(wc * 32 + fr, fq * 8);
#define PG8_SA(b, h) (((b) * 2 + (h)) * HTB)
#define PG8_SB(b, h) ((4 + (b) * 2 + (h)) * HTB)
#define PG8_STAGE(bufoff, gbase, voff) do { _Pragma("unroll") for (int _i = 0; _i < 2; ++_i) \
        __builtin_amdgcn_global_load_lds((const unsigned*)((const char*)(gbase) + (voff)[_i]), (PG8_LAS unsigned*)(lds + (bufoff) + ldsw + _i * 8192), 16, 0, 0); } while (0)
#define PG8_LDA(dst, b, h) do { _Pragma("unroll") for (int m = 0; m < 4; ++m) _Pragma("unroll") for (int k = 0; k < 2; ++k) dst[m][k] = *(const PG8_LAS bf16x8*)(lds + PG8_SA(b, h) + aoff + m * 2048 + k * 1024); } while (0)
#define PG8_LDB(dst, b, h) do { _Pragma("unroll") for (int n = 0; n < 2; ++n) _Pragma("unroll") for (int k = 0; k < 2; ++k) dst[n][k] = *(const PG8_LAS bf16x8*)(lds + PG8_SB(b, h) + boff + n * 2048 + k * 1024); } while (0)
#define PG8_MMA(ai, bj, At, Bt) do { __builtin_amdgcn_s_setprio(1); _Pragma("unroll") for (int m = 0; m < 4; ++m) _Pragma("unroll") for (int n = 0; n < 2; ++n) _Pragma("unroll") for (int k = 0; k < 2; ++k) \
        acc[ai][bj][m][n] = __builtin_amdgcn_mfma_f32_16x16x32_bf16(Bt[n][k], At[m][k], acc[ai][bj][m][n], 0, 0, 0); __builtin_amdgcn_s_setprio(0); } while (0)
#define PG8_WAIT_V(n) asm volatile("s_waitcnt vmcnt(" #n ")" ::: "memory")
#define PG8_WAIT_L(n) asm volatile("s_waitcnt lgkmcnt(" #n ")" ::: "memory")
#define PG8_BAR __builtin_amdgcn_s_barrier()
#define PG8_SCHED __builtin_amdgcn_sched_barrier(0)
    Unit cur, nxt; int ui = 0;
    if (!S.next(0, cur)) return;
    f32x4 acc[2][2][4][2];
#pragma unroll
    for (int a = 0; a < 2; ++a)
#pragma unroll
        for (int b = 0; b < 2; ++b)
#pragma unroll
            for (int m = 0; m < 4; ++m)
#pragma unroll
                for (int n = 0; n < 2; ++n) acc[a][b][m][n] = (f32x4){0.f, 0.f, 0.f, 0.f};
    bf16x8 At[4][2], B0[2][2], B1[2][2];
    const char* cA = (const char*)g.A + (size_t)cur.pm * tstep; const char* cB = (const char*)g.Bt + (size_t)cur.pn * tstep;
    S.a_ready(cur);
    if constexpr (SP2) {
        PG8_STAGE(PG8_SB(0, 0), cB, voffB); PG8_STAGE(PG8_SB(0, 1), cB + hstep, voffB); PG8_STAGE(PG8_SA(0, 0), cA, voffA); PG8_STAGE(PG8_SA(0, 1), cA + hstep, voffA);
        if (wr == 1) PG8_BAR;
        PG8_WAIT_V(2); PG8_BAR;
        PG8_STAGE(PG8_SB(1, 0), cB + kstep, voffB); PG8_STAGE(PG8_SA(1, 0), cA + kstep, voffA); PG8_STAGE(PG8_SB(1, 1), cB + hstep + kstep, voffB);
        PG8_WAIT_V(6); PG8_BAR;
    } else {
        PG8_STAGE(PG8_SB(0, 0), cB, voffB); PG8_STAGE(PG8_SA(0, 0), cA, voffA); PG8_STAGE(PG8_SB(0, 1), cB + hstep, voffB); PG8_STAGE(PG8_SA(0, 1), cA + hstep, voffA);
        if (wr == 1) PG8_BAR;
        PG8_WAIT_V(4); PG8_BAR;
        PG8_STAGE(PG8_SB(1, 0), cB + kstep, voffB); PG8_STAGE(PG8_SA(1, 0), cA + kstep, voffA); PG8_STAGE(PG8_SB(1, 1), cB + hstep + kstep, voffB);
        PG8_WAIT_V(6); PG8_BAR;
    }
    for (;;) {
        const bool has_next = S.next(ui + 1, nxt);
        const char* nA = has_next ? (const char*)g.A + (size_t)nxt.pm * tstep : cA; const char* nB = has_next ? (const char*)g.Bt + (size_t)nxt.pn * tstep : cB;
        for (int t = 0; t < nt; t += 2) {
            const bool last = (t == nt - 2);
            const char* a1 = cA + (size_t)(t + 1) * kstep;
            const char* a2 = last ? nA : cA + (size_t)(t + 2) * kstep; const char* b2 = last ? nB : cB + (size_t)(t + 2) * kstep;
            const char* a3 = a2 + kstep; const char* b3 = b2 + kstep;
            if (last && has_next) S.a_ready(nxt);
            if constexpr (SP2) {
            PG8_LDB(B0, 0, 0); PG8_LDB(B1, 0, 1); PG8_SCHED; PG8_LDA(At, 0, 0); PG8_STAGE(PG8_SA(1, 1), a1 + hstep, voffA);
            PG8_WAIT_V(8); PG8_WAIT_L(0); PG8_BAR; PG8_MMA(0, 0, At, B0); PG8_MMA(0, 1, At, B1); PG8_BAR; PG8_SCHED;
            PG8_LDA(At, 0, 1); PG8_STAGE(PG8_SB(0, 0), b2, voffB); PG8_STAGE(PG8_SB(0, 1), b2 + hstep, voffB); PG8_STAGE(PG8_SA(0, 0), a2, voffA);
            PG8_WAIT_V(8); PG8_WAIT_L(0); PG8_BAR; PG8_MMA(1, 0, At, B0); PG8_MMA(1, 1, At, B1); PG8_BAR; PG8_SCHED;
            PG8_LDB(B0, 1, 0); PG8_LDB(B1, 1, 1); PG8_SCHED; PG8_LDA(At, 1, 0); PG8_STAGE(PG8_SA(0, 1), a2 + hstep, voffA);
            PG8_WAIT_V(8); PG8_WAIT_L(0); PG8_BAR; PG8_MMA(0, 0, At, B0); PG8_MMA(0, 1, At, B1); PG8_BAR; PG8_SCHED;
            PG8_LDA(At, 1, 1); PG8_STAGE(PG8_SB(1, 0), b3, voffB); PG8_STAGE(PG8_SB(1, 1), b3 + hstep, voffB); PG8_STAGE(PG8_SA(1, 0), a3, voffA);
            PG8_WAIT_V(8); PG8_WAIT_L(0); PG8_BAR; PG8_MMA(1, 0, At, B0); PG8_MMA(1, 1, At, B1); PG8_BAR; PG8_SCHED;
            } else {
            PG8_LDB(B0, 0, 0); PG8_SCHED; PG8_LDA(At, 0, 0); PG8_STAGE(PG8_SA(1, 1), a1 + hstep, voffA);
            PG8_WAIT_L(8); PG8_BAR; PG8_WAIT_L(0); PG8_MMA(0, 0, At, B0); PG8_BAR; PG8_SCHED;
            PG8_LDB(B1, 0, 1); PG8_STAGE(PG8_SB(0, 0), b2, voffB);
            PG8_BAR; PG8_WAIT_L(0); PG8_MMA(0, 1, At, B1); PG8_BAR;
            PG8_LDA(At, 0, 1); PG8_STAGE(PG8_SA(0, 0), a2, voffA);
            PG8_BAR; PG8_WAIT_L(0); PG8_MMA(1, 0, At, B0); PG8_BAR; PG8_SCHED;
            PG8_STAGE(PG8_SB(0, 1), b2 + hstep, voffB);
            PG8_WAIT_V(6); PG8_BAR; PG8_MMA(1, 1, At, B1); PG8_BAR;
            PG8_LDB(B0, 1, 0); PG8_SCHED; PG8_LDA(At, 1, 0); PG8_STAGE(PG8_SA(0, 1), a2 + hstep, voffA);
            PG8_WAIT_L(8); PG8_BAR; PG8_WAIT_L(0); PG8_MMA(0, 0, At, B0); PG8_BAR; PG8_SCHED;
            PG8_LDB(B1, 1, 1); PG8_STAGE(PG8_SB(1, 0), b3, voffB);
            PG8_BAR; PG8_WAIT_L(0); PG8_MMA(0, 1, At, B1); PG8_BAR;
            PG8_LDA(At, 1, 1); PG8_STAGE(PG8_SA(1, 0), a3, voffA);
            PG8_BAR; PG8_WAIT_L(0); PG8_MMA(1, 0, At, B0); PG8_BAR; PG8_SCHED;
            PG8_STAGE(PG8_SB(1, 1), b3 + hstep, voffB);
            PG8_WAIT_V(6); PG8_BAR; PG8_MMA(1, 1, At, B1); PG8_BAR;
            }
        }
        if constexpr (ALIGN_EPI) { if (wr == 0) PG8_BAR; }
        if constexpr (!Epi::AFTER_DRAIN) { E(acc, cur, wr, wc, fr, fq); S.done(cur); }
        if (!has_next) break;
        if (!E.keep(cur)) {
#pragma unroll
        for (int a = 0; a < 2; ++a)
#pragma unroll
            for (int b = 0; b < 2; ++b)
#pragma unroll
                for (int m = 0; m < 4; ++m)
#pragma unroll
                    for (int n = 0; n < 2; ++n) acc[a][b][m][n] = (f32x4){0.f, 0.f, 0.f, 0.f};
        }
        cur = nxt; cA = nA; cB = nB; ++ui;
        if constexpr (ALIGN_EPI) { if (wr == 1) PG8_BAR; }
    }
    PG8_WAIT_V(0);
    if constexpr (!ALIGN_EPI) { if (wr == 0) PG8_BAR; }
    PG8_BAR;
    if constexpr (Epi::AFTER_DRAIN) { E.fused(acc, cur, wr, wc, fr, fq, lds, wid, lane); S.done(cur); }
#undef PG8_SA
#undef PG8_SB
#undef PG8_STAGE
#undef PG8_LDA
#undef PG8_LDB
#undef PG8_MMA
#undef PG8_WAIT_V
#undef PG8_WAIT_L
#undef PG8_BAR
#undef PG8_SCHED
}
}
#ifndef FAST_SWA
#define FAST_SWA 1
#endif
#ifndef FAST_DN
#define FAST_DN 1
#endif

constexpr int NWAVES = 8;
#ifndef MK_N_LAUNCHES
#define MK_N_LAUNCHES 1
#endif
constexpr int PER_PHASE = 9;
constexpr int N_LAUNCHES = MK_N_LAUNCHES;

constexpr int BATCH = 4, SEQ = 4096, D = 1024, M = BATCH * SEQ;
constexpr int DN_H = 4, DN_D = 128, DN_W = 512, DN_QKV = 1536;
constexpr int SW_H = 8, SW_KV = 2, SW_D = 64, SW_W = 512, SW_KVW = 128, WINDOW = 128;
constexpr int FF = 2816;
constexpr int D_IN = 4872;
constexpr int NP = 4864;
constexpr int PC_Z = 1536, PC_SQ = 2048, PC_SK = 2560, PC_SV = 2688, PC_G = 2816;
constexpr float EPS = 1e-6f;

constexpr size_t MiB = 1u << 20;
constexpr size_t WS_CTL = 0, CTL_ZERO_BYTES = 1 * MiB;
constexpr size_t WS_WIN = 1 * MiB;
constexpr size_t WS_WAB = 11 * MiB;
constexpr size_t WS_WOUT = 13 * MiB;
constexpr size_t WS_WGU = 15 * MiB;
constexpr size_t WS_WD = 26 * MiB;
constexpr size_t WS_RSTD = 32 * MiB;
constexpr size_t WS_GB = WS_RSTD + 64 * 1024;
constexpr size_t WS_SSQ = 33 * MiB;
constexpr size_t WS_XB = 34 * MiB;
constexpr size_t WS_Y = 66 * MiB;
constexpr size_t WS_PROJ = 98 * MiB;
constexpr size_t WS_END = 250 * MiB;
static_assert(WS_PROJ + (size_t)M * NP * 2 <= WS_END, "ws map");
constexpr int CW_TMO = 0, CW_BAR = 4096;

constexpr int RING_OFF = 0, RING_BYTES = 131072;
constexpr int LDSCTL_OFF = RING_BYTES, MISC_OFF = LDSCTL_OFF + 320;
constexpr int LDS_BYTES = 147456;

#define GAS __attribute__((address_space(1)))
#define LAS __attribute__((address_space(3)))
typedef unsigned short bf16;
typedef unsigned v4u __attribute__((ext_vector_type(4)));
typedef float f32x4 __attribute__((ext_vector_type(4)));
typedef float f32x2 __attribute__((ext_vector_type(2)));
typedef GAS unsigned gu32;
#define RLX_AGENT __ATOMIC_RELAXED, __HIP_MEMORY_SCOPE_AGENT
#define LDS_WAIT() asm volatile("s_waitcnt lgkmcnt(0)" ::: "memory")
#define VM_WAIT() asm volatile("s_waitcnt vmcnt(0)" ::: "memory")
__device__ __forceinline__ unsigned f2bf(float f) { unsigned u = __builtin_bit_cast(unsigned, f); return (u + 0x7fffu + ((u >> 16) & 1u)) >> 16; }
__device__ __forceinline__ unsigned pk2(float lo, float hi) { return f2bf(lo) | (f2bf(hi) << 16); }
__device__ __forceinline__ float bflo(unsigned w) { return __builtin_bit_cast(float, w << 16); }
__device__ __forceinline__ float bfhi(unsigned w) { return __builtin_bit_cast(float, w & 0xffff0000u); }
__device__ __forceinline__ float bf1(bf16 h) { return __builtin_bit_cast(float, (unsigned)h << 16); }
__device__ __forceinline__ float sigm(float x) { return 1.0f / (1.0f + __expf(-x)); }
__device__ __forceinline__ float wave_sum(float v) {
#pragma unroll
    for (int o = 1; o < 64; o <<= 1) v += __shfl_xor(v, o);
    return v;
}
__device__ __forceinline__ float wave_max(float v) {
#pragma unroll
    for (int o = 1; o < 64; o <<= 1) v = fmaxf(v, __shfl_xor(v, o));
    return v;
}

#define XB_TMO      128
#define XB_XCNT(j)  (256  + 64 * (j))
#define XB_XSUB(j)  (1280 + 64 * (j))
#define XB_XGEN(j)  (2304 + 64 * (j))
#define XB_TOP      3328
#define XB_TOPGEN   3392
#define XCD_BAR_WORDS 3456
#define XB_SPIN_CAP (1u << 18)
__device__ __forceinline__ unsigned xb_ld(unsigned* p)              { return __hip_atomic_load(p, __ATOMIC_RELAXED, __HIP_MEMORY_SCOPE_AGENT); }
__device__ __forceinline__ unsigned xb_add(unsigned* p, unsigned v) { return __hip_atomic_fetch_add(p, v, __ATOMIC_RELAXED, __HIP_MEMORY_SCOPE_AGENT); }
__device__ __forceinline__ unsigned xb_xcc_id() { return (unsigned)__builtin_amdgcn_s_getreg((3 << 11) | 20) & 0xFu; }
#define XB_SPIN(cond, bar) do { unsigned _sp = 0; while (cond) { __builtin_amdgcn_s_sleep(1); \
    if ((++_sp & 255u) == 0u) { if (xb_ld(&(bar)[XB_TMO])) break; if (_sp > XB_SPIN_CAP) { atomicAdd(&(bar)[XB_TMO], 1u); break; } } } } while (0)
struct XcdBarrier { unsigned* bar; unsigned x; volatile LAS unsigned* st; };
__device__ __forceinline__ XcdBarrier xcd_barrier_post(unsigned* bar, volatile LAS unsigned* st) {
    XcdBarrier b; b.bar = bar; b.x = xb_xcc_id(); b.st = st;
    if (threadIdx.x == 0) (void)xb_add(&bar[XB_XCNT(b.x)], 1u);
    return b;
}
__device__ __forceinline__ void xcd_barrier_complete(unsigned* bar, unsigned x, unsigned& nloc, unsigned& nx) {
    const unsigned G = gridDim.x * gridDim.y * gridDim.z;
    unsigned sum, cnt, mine, sp = 0u;
    for (;;) {
        sum = 0u; cnt = 0u; mine = 0u;
#pragma unroll
        for (unsigned j = 0; j < 16; ++j) { const unsigned c = xb_ld(&bar[XB_XCNT(j)]); sum += c; cnt += (c > 0u) ? 1u : 0u; mine = (j == x) ? c : mine; }
        if (sum == G) break;
        __builtin_amdgcn_s_sleep(1);
        if ((++sp & 255u) == 0u) { if (xb_ld(&bar[XB_TMO])) break; if (sp > XB_SPIN_CAP) { atomicAdd(&bar[XB_TMO], 1u); break; } }
    }
    nloc = mine > 0u ? mine : 1u; nx = cnt > 0u ? cnt : 1u;
}
__device__ __forceinline__ void xcd_barrier(const XcdBarrier& b) {
    asm volatile("s_waitcnt vmcnt(0)" ::: "memory");
    __syncthreads();
    if (threadIdx.x == 0) {
        unsigned* bar = b.bar;
        __builtin_amdgcn_s_waitcnt(0);
        unsigned nloc = b.st[0], nx = b.st[1];
        if (nloc == 0u) { xcd_barrier_complete(bar, b.x, nloc, nx); b.st[0] = nloc; b.st[1] = nx; }
        const unsigned old = xb_add(&bar[XB_XSUB(b.x)], 1u);
        const unsigned gen = old / nloc;
        if (old + 1u == (gen + 1u) * nloc) {
            __builtin_amdgcn_fence(__ATOMIC_RELEASE, "agent");
            asm volatile("s_waitcnt vmcnt(0)" ::: "memory");
            const unsigned og = xb_add(&bar[XB_TOP], 1u);
            const unsigned tg = og / nx;
            if (og + 1u == (tg + 1u) * nx) xb_add(&bar[XB_TOPGEN], 1u);
            else XB_SPIN(xb_ld(&bar[XB_TOPGEN]) == tg, bar);
            __builtin_amdgcn_fence(__ATOMIC_ACQUIRE, "agent");
            xb_add(&bar[XB_XGEN(b.x)], 1u);
            asm volatile("s_waitcnt vmcnt(0)" ::: "memory");
        } else {
            XB_SPIN(xb_ld(&bar[XB_XGEN(b.x)]) == gen, bar);
            __builtin_amdgcn_fence(__ATOMIC_ACQUIRE, "agent");
            asm volatile("s_waitcnt vmcnt(0)" ::: "memory");
        }
    }
    __syncthreads();
}

struct Frame {
    LAS unsigned char* lds;
    volatile LAS unsigned* MISC;
    gu32* ctl;
    int tid, lane, wave;
    int vcu, G;
    const float* in[18]; float* out; unsigned char* ws;
};
__device__ const unsigned char T5_BUCKET[128] = {0,1,2,3,4,5,6,7,8,9,10,11,12,13,14,15,16,16,16,17,17,18,18,18,19,19,19,20,20,20,20,21,21,21,21,22,22,22,22,22,23,23,23,23,23,23,24,24,24,24,24,24,25,25,25,25,25,25,25,26,26,26,26,26,26,26,26,27,27,27,27,27,27,27,27,27,27,28,28,28,28,28,28,28,28,28,28,29,29,29,29,29,29,29,29,29,29,29,29,30,30,30,30,30,30,30,30,30,30,30,30,30,30,31,31,31,31,31,31,31,31,31,31,31,31,31,31,31};

__device__ __forceinline__ void p0_transpose_item(const float* W, int ldw, int src_col0, int K, bf16* WT, int dst_row0, const float* gain, LAS float* scr, int kb, int lane) {
    const int k0 = 64 * kb;
#pragma unroll 8
    for (int i = 0; i < 32; ++i) { const int kk = 2 * i + (lane >> 5); float v = W[(size_t)(k0 + kk) * ldw + src_col0 + (lane & 31)]; if (gain) v *= gain[k0 + kk]; scr[kk * 33 + (lane & 31)] = v; }
    LDS_WAIT(); asm volatile("" ::: "memory");
    const int c = lane & 7;
#pragma unroll
    for (int j = 0; j < 4; ++j) { const int n = (lane >> 3) + 8 * j; const LAS float* s = scr + (8 * c) * 33 + n;
        v4u o; o.x = pk2(s[0 * 33], s[1 * 33]); o.y = pk2(s[2 * 33], s[3 * 33]); o.z = pk2(s[4 * 33], s[5 * 33]); o.w = pk2(s[6 * 33], s[7 * 33]);
        *(GAS v4u*)(WT + (size_t)(dst_row0 + n) * K + k0 + 8 * c) = o; }
    LDS_WAIT(); asm volatile("" ::: "memory");
}
__device__ __forceinline__ void p0_prologue(Frame& F) {
    LAS float* scr = (LAS float*)(F.lds + RING_OFF + F.wave * 16384);
    const int gw = F.vcu * NWAVES + F.wave, NGW = F.G * NWAVES;
    unsigned char* ws = F.ws;
    bf16* WinT = (bf16*)(ws + WS_WIN); bf16* WabT = (bf16*)(ws + WS_WAB); bf16* WoutT = (bf16*)(ws + WS_WOUT); bf16* WguT = (bf16*)(ws + WS_WGU); bf16* WdT = (bf16*)(ws + WS_WD);
    constexpr int I_IN = 16 * (NP / 32), I_AB = 8 * 32, I_OUT = 16 * 32, I_GU = 16 * (2 * FF / 32), I_D = (FF / 64) * 32;
    constexpr int NITEMS = I_IN + 2 * I_AB + I_OUT + I_GU + I_D;
    for (int it = gw; it < NITEMS; it += NGW) {
        int r = it;
        if (r < I_IN) { const int nb = r % (NP / 32), kb = r / (NP / 32), dr = 32 * nb; p0_transpose_item(F.in[2], D_IN, dr < 2048 ? dr : dr + 8, D, WinT, dr, F.in[1], scr, kb, F.lane); continue; } r -= I_IN;
        if (r < I_AB) { const int nb = r % 32, kb = r / 32; p0_transpose_item(F.in[11], D, 32 * nb, DN_W, WabT, 32 * nb, nullptr, scr, kb, F.lane); continue; } r -= I_AB;
        if (r < I_AB) { const int nb = r % 32, kb = r / 32; p0_transpose_item(F.in[12], D, 32 * nb, SW_W, WabT, 1024 + 32 * nb, nullptr, scr, kb, F.lane); continue; } r -= I_AB;
        if (r < I_OUT) { const int nb = r % 32, kb = r / 32; p0_transpose_item(F.in[13], D, 32 * nb, D, WoutT, 32 * nb, nullptr, scr, kb, F.lane); continue; } r -= I_OUT;
        if (r < I_GU) { const int nb = r % (2 * FF / 32), kb = r / (2 * FF / 32), dr = 32 * nb, pn = dr >> 8, j = dr & 255;
            const float* W = (j < 128) ? F.in[15] : F.in[16]; p0_transpose_item(W, FF, 128 * pn + (j & 127), D, WguT, dr, F.in[14], scr, kb, F.lane); continue; } r -= I_GU;
        { const int nb = r % 32, kb = r / 32; p0_transpose_item(F.in[17], D, 32 * nb, FF, WdT, 32 * nb, nullptr, scr, kb, F.lane); }
    }
    __syncthreads();
    LAS float* wba = (LAS float*)(F.lds + RING_OFF);
    for (int idx = F.tid; idx < 8 * D; idx += NWAVES * 64) { const int k = idx >> 3, j = idx & 7; wba[j * D + k] = F.in[2][(size_t)k * D_IN + 2048 + j] * F.in[1][k]; }
    __syncthreads();
    const float* x = F.in[0]; bf16* XB = (bf16*)(ws + WS_XB); float* rstd1 = (float*)(ws + WS_RSTD); float* gbp = (float*)(ws + WS_GB);
    for (int m = gw; m < M; m += NGW) {
        const GAS f32x4* xr = (const GAS f32x4*)(x + (size_t)m * D) + F.lane;
        f32x4 v[4]; float ss = 0.f;
#pragma unroll
        for (int j = 0; j < 4; ++j) { v[j] = xr[64 * j]; ss += (v[j].x * v[j].x + v[j].y * v[j].y) + (v[j].z * v[j].z + v[j].w * v[j].w); }
        const float rstd = 1.0f / sqrtf(wave_sum(ss) * (1.0f / D) + EPS);
        GAS unsigned long long* o8 = (GAS unsigned long long*)(XB + (size_t)m * D) + F.lane;
#pragma unroll
        for (int j = 0; j < 4; ++j) o8[64 * j] = (unsigned long long)pk2(v[j].x, v[j].y) | ((unsigned long long)pk2(v[j].z, v[j].w) << 32);
        float acc[8];
#pragma unroll
        for (int c = 0; c < 8; ++c) { float a = 0.f;
#pragma unroll
            for (int j = 0; j < 4; ++j) { const f32x4 w = *(const LAS f32x4*)(wba + c * D + 256 * j + 4 * F.lane); a += (v[j].x * w.x + v[j].y * w.y) + (v[j].z * w.z + v[j].w * w.w); }
            acc[c] = wave_sum(a) * rstd; }
        if (F.lane == 0) {
            rstd1[m] = rstd;
#pragma unroll
            for (int h = 0; h < 4; ++h) {
                const float beta = 1.0f / (1.0f + expf(-acc[h]));
                const float xx = acc[4 + h] + F.in[5][h]; const float sp = xx > 20.f ? xx : log1pf(expf(xx));
                gbp[(size_t)m * 8 + h] = beta; gbp[(size_t)m * 8 + 4 + h] = -expf(F.in[4][h]) * sp; }
        }
    }
}

__device__ __forceinline__ void dn_pre(Frame& F) {
    const int gw = F.vcu * NWAVES + F.wave, NGW = F.G * NWAVES;
    const bf16* proj = (const bf16*)(F.ws + WS_PROJ); const float* conv = F.in[3];
    float* QN = F.out; float* KN = F.out + (size_t)M * DN_W; float* VV = (float*)(F.ws + WS_XB);
    for (int task = gw; task < M * DN_H; task += NGW) {
        const int m = task >> 2, h = task & 3, t = m & (SEQ - 1);
        float val[3][2];
#pragma unroll
        for (int part = 0; part < 3; ++part) { const int col = part * DN_W + h * DN_D + 2 * F.lane; float a0 = 0.f, a1 = 0.f;
#pragma unroll
            for (int j = 0; j < 4; ++j) { if (t - 3 + j >= 0) { const unsigned w = *(const unsigned*)(proj + (size_t)(m - 3 + j) * NP + col); a0 += conv[j * DN_QKV + col] * bflo(w); a1 += conv[j * DN_QKV + col + 1] * bfhi(w); } }
            val[part][0] = a0 * sigm(a0); val[part][1] = a1 * sigm(a1); }
        const float rq = 1.0f / sqrtf(wave_sum(val[0][0] * val[0][0] + val[0][1] * val[0][1]) + EPS) * 0.08838834764831845f;
        const float rk = 1.0f / sqrtf(wave_sum(val[1][0] * val[1][0] + val[1][1] * val[1][1]) + EPS);
        const size_t o = (size_t)m * DN_W + h * DN_D + 2 * F.lane;
        *(f32x2*)(QN + o) = (f32x2){val[0][0] * rq, val[0][1] * rq};
        *(f32x2*)(KN + o) = (f32x2){val[1][0] * rk, val[1][1] * rk};
        *(f32x2*)(VV + o) = (f32x2){val[2][0], val[2][1]};
    }
}
__device__ __forceinline__ void dn_scan_naive(Frame& F, int bh) {
    const int b = bh >> 2, h = bh & 3, tid = F.tid, dvi = tid >> 2, kq = tid & 3;
    LAS float* kL = (LAS float*)(F.lds + RING_OFF); LAS float* qL = kL + 32 * 128; LAS float* vL = qL + 32 * 128; LAS float* gL = vL + 32 * 128; LAS float* bL = gL + 32;
    const float* QN = F.out; const float* KN = F.out + (size_t)M * DN_W; float* VV = (float*)(F.ws + WS_XB); const float* gbp = (const float*)(F.ws + WS_GB);
    float S[32];
#pragma unroll
    for (int j = 0; j < 32; ++j) S[j] = 0.f;
    for (int t0 = 0; t0 < SEQ; t0 += 32) {
#pragma unroll
        for (int r = 0; r < 2; ++r) { const int idx = tid + 512 * r, tok = idx >> 5, c4 = idx & 31; const size_t src = (size_t)(b * SEQ + t0 + tok) * DN_W + h * DN_D + c4 * 4;
            *(LAS f32x4*)(kL + tok * 128 + c4 * 4) = *(const f32x4*)(KN + src); *(LAS f32x4*)(qL + tok * 128 + c4 * 4) = *(const f32x4*)(QN + src); *(LAS f32x4*)(vL + tok * 128 + c4 * 4) = *(const f32x4*)(VV + src); }
        if (tid < 32) { const size_t mm = (size_t)(b * SEQ + t0 + tid); bL[tid] = gbp[mm * 8 + h]; gL[tid] = gbp[mm * 8 + 4 + h]; }
        __syncthreads();
        for (int i = 0; i < 32; ++i) {
            const float eg = __expf(gL[i]), be = bL[i];
            float kk[32];
#pragma unroll
            for (int j = 0; j < 8; ++j) { const f32x4 w = *(const LAS f32x4*)(kL + i * 128 + kq * 32 + 4 * j); kk[4 * j] = w.x; kk[4 * j + 1] = w.y; kk[4 * j + 2] = w.z; kk[4 * j + 3] = w.w; }
            float part = 0.f;
#pragma unroll
            for (int j = 0; j < 32; ++j) part += kk[j] * S[j];
            part += __shfl_xor(part, 1); part += __shfl_xor(part, 2);
            const float c = be * (vL[i * 128 + dvi] - eg * part);
#pragma unroll
            for (int j = 0; j < 32; ++j) S[j] = eg * S[j] + c * kk[j];
            float po = 0.f;
#pragma unroll
            for (int j = 0; j < 8; ++j) { const f32x4 w = *(const LAS f32x4*)(qL + i * 128 + kq * 32 + 4 * j); po += (w.x * S[4 * j] + w.y * S[4 * j + 1]) + (w.z * S[4 * j + 2] + w.w * S[4 * j + 3]); }
            po += __shfl_xor(po, 1); po += __shfl_xor(po, 2);
            if (kq == 0) vL[i * 128 + dvi] = po;
        }
        __syncthreads();
#pragma unroll
        for (int r = 0; r < 2; ++r) { const int idx = tid + 512 * r, tok = idx >> 5, c4 = idx & 31; const size_t src = (size_t)(b * SEQ + t0 + tok) * DN_W + h * DN_D + c4 * 4;
            *(f32x4*)(VV + src) = *(const LAS f32x4*)(vL + tok * 128 + c4 * 4); }
        __syncthreads();
    }
}
__device__ __forceinline__ void swa_naive(Frame& F, int wv, int nworkers) {
    const bf16* proj = (const bf16*)(F.ws + WS_PROJ); bf16* YSWA = (bf16*)(F.ws + WS_Y) + (size_t)M * SW_W;
    LAS float* qs = (LAS float*)(F.lds + RING_OFF + 65536 + F.wave * 1024); LAS float* ps = qs + 64;
    const float* qg = F.in[7]; const float* kg = F.in[8]; const float* sinks = F.in[9]; const float* relb = F.in[10];
    const int lane = F.lane;
    for (int task = wv; task < M * SW_H; task += nworkers) {
        const int m = task >> 3, qh = task & 7, kvh = qh >> 2, t = m & (SEQ - 1);
        const float q = bf1(proj[(size_t)m * NP + PC_SQ + qh * SW_D + lane]);
        const float qn = q * (1.0f / sqrtf(wave_sum(q * q) * (1.0f / SW_D) + EPS)) * qg[lane];
        qs[lane] = qn * kg[lane];
        LDS_WAIT(); asm volatile("" ::: "memory");
        float lg[2];
#pragma unroll
        for (int hf = 0; hf < 2; ++hf) { const int j = lane + 64 * hf; lg[hf] = -INFINITY;
            if (t - 127 + j >= 0) { const v4u* kr = (const v4u*)(proj + (size_t)(m - 127 + j) * NP + PC_SK + kvh * SW_D); float ssk = 0.f, dot = 0.f;
#pragma unroll
                for (int c = 0; c < 8; ++c) { const v4u w = kr[c];
#pragma unroll
                    for (int e = 0; e < 4; ++e) { const float k0 = bflo(w[e]), k1 = bfhi(w[e]); ssk += k0 * k0 + k1 * k1; dot += qs[8 * c + 2 * e] * k0 + qs[8 * c + 2 * e + 1] * k1; } }
                lg[hf] = dot * (1.0f / sqrtf(ssk * (1.0f / SW_D) + EPS)) * 0.125f + relb[(int)T5_BUCKET[127 - j] * SW_H + qh]; } }
        const float sink = sinks[qh];
        const float mx = fmaxf(wave_max(fmaxf(lg[0], lg[1])), sink);
        const float p0 = (lg[0] == -INFINITY) ? 0.f : __expf(lg[0] - mx), p1 = (lg[1] == -INFINITY) ? 0.f : __expf(lg[1] - mx);
        const float den = wave_sum(p0 + p1) + __expf(sink - mx);
        ps[lane] = p0; ps[lane + 64] = p1;
        LDS_WAIT(); asm volatile("" ::: "memory");
        float o = 0.f; const int jmin = (127 - t) > 0 ? (127 - t) : 0;
        for (int j = jmin; j < 128; ++j) o += ps[j] * bf1(proj[(size_t)(m - 127 + j) * NP + PC_SV + kvh * SW_D + lane]);
        YSWA[(size_t)m * SW_W + qh * SW_D + lane] = (bf16)f2bf(o / den);
        LDS_WAIT(); asm volatile("" ::: "memory");
    }
}
__device__ __forceinline__ void dn_out(Frame& F) {
    const int gw = F.vcu * NWAVES + F.wave, NGW = F.G * NWAVES;
    const bf16* proj = (const bf16*)(F.ws + WS_PROJ); const float* VV = (const float*)(F.ws + WS_XB); bf16* YDN = (bf16*)(F.ws + WS_Y); const float* gain = F.in[6];
    for (int task = gw; task < M * DN_H; task += NGW) {
        const int m = task >> 2, h = task & 3;
        const f32x2 o = *(const f32x2*)(VV + (size_t)m * DN_W + h * DN_D + 2 * F.lane);
        const float r = 1.0f / sqrtf(wave_sum(o.x * o.x + o.y * o.y) * (1.0f / DN_D) + EPS);
        const unsigned zw = *(const unsigned*)(proj + (size_t)m * NP + PC_Z + h * DN_D + 2 * F.lane); const float z0 = bflo(zw), z1 = bfhi(zw);
        *(unsigned*)(YDN + (size_t)m * DN_W + h * DN_D + 2 * F.lane) = pk2(o.x * r * gain[2 * F.lane] * z0 * sigm(z0), o.y * r * gain[2 * F.lane + 1] * z1 * sigm(z1));
    }
}

typedef short bf16x8 __attribute__((ext_vector_type(8)));
typedef float f32x16 __attribute__((ext_vector_type(16)));
typedef unsigned u32x2 __attribute__((ext_vector_type(2)));
typedef __bf16 bf16x2_t __attribute__((ext_vector_type(2)));
__device__ __forceinline__ unsigned cvtpk(float lo, float hi) { f32x2 v = {lo, hi}; return __builtin_bit_cast(unsigned, __builtin_convertvector(v, bf16x2_t)); }
__device__ __forceinline__ bf16x8 pack8(f32x4 a, f32x4 b) { v4u w; w.x = cvtpk(a[0], a[1]); w.y = cvtpk(a[2], a[3]); w.z = cvtpk(b[0], b[1]); w.w = cvtpk(b[2], b[3]); return __builtin_bit_cast(bf16x8, w); }
__device__ __forceinline__ bf16x8 pack8z(f32x4 a) { v4u w; w.x = cvtpk(a[0], a[1]); w.y = cvtpk(a[2], a[3]); w.z = 0u; w.w = 0u; return __builtin_bit_cast(bf16x8, w); }
#define MFMA16(a, b, c) __builtin_amdgcn_mfma_f32_16x16x32_bf16((a), (b), (c), 0, 0, 0)
#define MFMA32(a, b, c) __builtin_amdgcn_mfma_f32_32x32x16_bf16((a), (b), (c), 0, 0, 0)
constexpr float LOG2E = 1.4426950408889634f;

__device__ __forceinline__ void swa_pre(Frame& F) {
    const int gw = F.vcu * NWAVES + F.wave, NGW = F.G * NWAVES, lane = F.lane;
    const bf16* proj = (const bf16*)(F.ws + WS_PROJ);
    bf16* KS = (bf16*)(F.ws + WS_Y); bf16* VT = KS + 2 * 1024 * 1024; bf16* QS = (bf16*)(F.ws + WS_Y) + (size_t)M * SW_W;
    const float* qg = F.in[7]; const float* kg = F.in[8];
    for (int m = gw; m < M; m += NGW) {
        {
            const v4u w = *(const v4u*)(proj + (size_t)m * NP + PC_SQ + 8 * lane); float x[8];
#pragma unroll
            for (int j = 0; j < 4; ++j) { x[2 * j] = bflo(w[j]); x[2 * j + 1] = bfhi(w[j]); }
            float ss = 0.f;
#pragma unroll
            for (int j = 0; j < 8; ++j) ss += x[j] * x[j];
            ss += __shfl_xor(ss, 1); ss += __shfl_xor(ss, 2); ss += __shfl_xor(ss, 4);
            const float r = (1.0f / sqrtf(ss * (1.0f / SW_D) + EPS)) * (0.125f * LOG2E);
            const f32x4 g0 = *(const f32x4*)(qg + 8 * (lane & 7)), g1 = *(const f32x4*)(qg + 8 * (lane & 7) + 4);
            v4u o; o.x = cvtpk(x[0] * r * g0[0], x[1] * r * g0[1]); o.y = cvtpk(x[2] * r * g0[2], x[3] * r * g0[3]); o.z = cvtpk(x[4] * r * g1[0], x[5] * r * g1[1]); o.w = cvtpk(x[6] * r * g1[2], x[7] * r * g1[3]);
            *(v4u*)(QS + (size_t)m * SW_W + 8 * lane) = o;
        }
        {
            const unsigned w = *(const unsigned*)(proj + (size_t)m * NP + PC_SK + 2 * lane); const float k0 = bflo(w), k1 = bfhi(w);
            float ss = k0 * k0 + k1 * k1;
#pragma unroll
            for (int o = 1; o < 32; o <<= 1) ss += __shfl_xor(ss, o);
            const float r = 1.0f / sqrtf(ss * (1.0f / SW_D) + EPS); const int d = 2 * (lane & 31), b = m >> 12, t = m & (SEQ - 1), kvh = lane >> 5;
            *(unsigned*)(KS + ((size_t)(b * 2 + kvh) * SEQ + t) * SW_D + d) = cvtpk(k0 * r * kg[d], k1 * r * kg[d + 1]);
        }
    }
    for (int task = gw; task < BATCH * SW_KV * (SEQ / 32); task += NGW) {
        const int bk = task >> 7, tile = task & 127, b = bk >> 1, kvh = bk & 1; const size_t m0 = (size_t)b * SEQ + tile * 32;
        unsigned v[32];
#pragma unroll
        for (int i = 0; i < 32; ++i) v[i] = proj[(m0 + i) * NP + PC_SV + kvh * SW_D + lane];
        bf16* dst = VT + ((size_t)(bk * 128 + tile) * 64 + lane) * 32;
#pragma unroll
        for (int q4 = 0; q4 < 4; ++q4) { v4u o;
#pragma unroll
            for (int jj = 0; jj < 4; ++jj) { const int p0 = 8 * q4 + 2 * jj, p1 = p0 + 1;
                const int k0 = 16 * (p0 >> 4) + 8 * ((p0 & 7) >> 2) + 4 * ((p0 >> 3) & 1) + (p0 & 3), k1 = 16 * (p1 >> 4) + 8 * ((p1 & 7) >> 2) + 4 * ((p1 >> 3) & 1) + (p1 & 3);
                o[jj] = v[k0] | (v[k1] << 16); }
            *(v4u*)(dst + 8 * q4) = o; }
    }
}
__device__ __forceinline__ void swa_bias_table(Frame& F) {
    LAS float* biasT = (LAS float*)(F.lds + RING_OFF);
    for (int idx = F.tid; idx < SW_H * 128; idx += NWAVES * 64) { const int h = idx >> 7, dist = idx & 127; biasT[idx] = F.in[10][(int)T5_BUCKET[dist] * SW_H + h] * LOG2E; }
}
__device__ __forceinline__ void swa_main(Frame& F, int worker, int nworkers) {
    const LAS float* biasT = (const LAS float*)(F.lds + RING_OFF);
    const bf16* KS = (const bf16*)(F.ws + WS_Y); const bf16* VT = KS + 2 * 1024 * 1024; bf16* QS = (bf16*)(F.ws + WS_Y) + (size_t)M * SW_W;
    const int lane = F.lane, l31 = lane & 31, hh = lane >> 5;
    for (int u = worker; u < BATCH * SW_H * (SEQ / 32); u += nworkers) {
        const int qblk = u & 127, h = (u >> 7) & 7, b = u >> 10, kvh = h >> 2, bk = b * 2 + kvh, q0 = qblk * 32; const size_t m0 = (size_t)b * SEQ + q0;
        bf16x8 qf[4];
#pragma unroll
        for (int ks = 0; ks < 4; ++ks) qf[ks] = *(const bf16x8*)(QS + (m0 + l31) * SW_W + h * SW_D + 16 * ks + 8 * hh);
        f32x16 s[5];
#pragma unroll
        for (int i = 0; i < 5; ++i) {
            const int ts = q0 - 128 + 32 * i;
            if (ts < 0) {
#pragma unroll
                for (int r = 0; r < 16; ++r) s[i][r] = -INFINITY;
            } else {
                f32x16 acc;
#pragma unroll
                for (int r = 0; r < 16; ++r) acc[r] = 0.f;
#pragma unroll
                for (int ks = 0; ks < 4; ++ks) { const bf16x8 kf = *(const bf16x8*)(KS + ((size_t)bk * SEQ + ts + l31) * SW_D + 16 * ks + 8 * hh); acc = MFMA32(kf, qf[ks], acc); }
#pragma unroll
                for (int r = 0; r < 16; ++r) { const int row = (r & 3) + 8 * (r >> 2) + 4 * hh, dist = 128 - 32 * i + l31 - row; const bool ok = dist >= 0 && dist <= 127;
                    s[i][r] = ok ? acc[r] + biasT[h * 128 + (dist & 127)] : -INFINITY; }
            }
        }
        const float sink2 = F.in[9][h] * LOG2E;
        float mx = sink2;
#pragma unroll
        for (int i = 0; i < 5; ++i)
#pragma unroll
            for (int r = 0; r < 16; ++r) mx = fmaxf(mx, s[i][r]);
        mx = fmaxf(mx, __shfl_xor(mx, 32));
        float sum = 0.f;
#pragma unroll
        for (int i = 0; i < 5; ++i)
#pragma unroll
            for (int r = 0; r < 16; ++r) { const float p = __builtin_amdgcn_exp2f(s[i][r] - mx); s[i][r] = p; sum += p; }
        sum += __shfl_xor(sum, 32);
        const float inv = 1.0f / (sum + __builtin_amdgcn_exp2f(sink2 - mx));
        f32x16 O[2];
#pragma unroll
        for (int r = 0; r < 16; ++r) { O[0][r] = 0.f; O[1][r] = 0.f; }
#pragma unroll
        for (int i = 0; i < 5; ++i) {
            const int ts = q0 - 128 + 32 * i;
            if (ts >= 0) {
#pragma unroll
                for (int s2 = 0; s2 < 2; ++s2) {
                    v4u w; w.x = cvtpk(s[i][8 * s2] * inv, s[i][8 * s2 + 1] * inv); w.y = cvtpk(s[i][8 * s2 + 2] * inv, s[i][8 * s2 + 3] * inv); w.z = cvtpk(s[i][8 * s2 + 4] * inv, s[i][8 * s2 + 5] * inv); w.w = cvtpk(s[i][8 * s2 + 6] * inv, s[i][8 * s2 + 7] * inv);
                    const bf16x8 pa = __builtin_bit_cast(bf16x8, w);
#pragma unroll
                    for (int nt = 0; nt < 2; ++nt) { const bf16x8 vf = *(const bf16x8*)(VT + ((size_t)(bk * 128 + (ts >> 5)) * 64 + 32 * nt + l31) * 32 + s2 * 16 + hh * 8); O[nt] = MFMA32(pa, vf, O[nt]); }
                }
            }
        }
#pragma unroll
        for (int nt = 0; nt < 2; ++nt)
#pragma unroll
            for (int r = 0; r < 16; ++r) { const int q = (r & 3) + 8 * (r >> 2) + 4 * hh; QS[(m0 + q) * SW_W + h * SW_D + 32 * nt + l31] = (bf16)(cvtpk(O[nt][r], 0.f) & 0xffffu); }
    }
}

constexpr int DNL_QT = 0, DNL_KT = 17408, DNL_VT = 34816, DNL_WL = 52224, DNL_NA = 69632, DNL_QKM = 78848, DNL_DB = 88064, DNL_TIB = 92160, DNL_GC = 94208, DNL_BETA = 94464;
constexpr int TP = 272;
constexpr int NP2 = 144;
struct DnRec { float* U; bf16* W; bf16* QG; bf16* KD; bf16* QK; float* EGL; };
__device__ __forceinline__ DnRec dn_rec(Frame& F) {
    DnRec r; r.U = (float*)(F.ws + WS_XB); r.W = (bf16*)F.out; r.QG = r.W + 8 * 1024 * 1024; r.KD = r.W + 16 * 1024 * 1024; r.QK = r.W + 24 * 1024 * 1024; r.EGL = (float*)(F.ws + WS_SSQ); return r;
}
__device__ __forceinline__ void dn_chunk_prep(Frame& F) {
    const DnRec R = dn_rec(F);
    const bf16* proj = (const bf16*)(F.ws + WS_PROJ); const float* conv = F.in[3]; const float* gbp = (const float*)(F.ws + WS_GB);
    LAS unsigned char* L = F.lds + RING_OFF;
    LAS float* GC = (LAS float*)(L + DNL_GC); LAS float* BETA = (LAS float*)(L + DNL_BETA); LAS float* DB = (LAS float*)(L + DNL_DB);
    const int lane = F.lane, wave = F.wave, r16 = lane & 15, g = lane >> 4;
    for (int ch = F.vcu; ch < 1024; ch += F.G) {
        const int bh = ch >> 6, c = ch & 63, b = bh >> 2, h = bh & 3; const size_t m0 = (size_t)b * SEQ + 64 * c;
        {
            float x = gbp[(m0 + lane) * 8 + 4 + h]; const float bl = gbp[(m0 + lane) * 8 + h];
#pragma unroll
            for (int off = 1; off < 64; off <<= 1) { const float t = __shfl_up(x, off); if (lane >= off) x += t; }
            if (wave == 0) { GC[lane] = x; BETA[lane] = bl; }
            const int tk0 = 8 * wave;
            unsigned raw[3][11]; float cw[3][4][2];
#pragma unroll
            for (int p = 0; p < 3; ++p) { const int col = p * DN_W + h * DN_D + 2 * lane;
#pragma unroll
                for (int r = 0; r < 11; ++r) raw[p][r] = (64 * c + tk0 - 3 + r >= 0) ? *(const unsigned*)(proj + (m0 + tk0 - 3 + r) * NP + col) : 0u;
#pragma unroll
                for (int j = 0; j < 4; ++j) { cw[p][j][0] = conv[j * DN_QKV + col]; cw[p][j][1] = conv[j * DN_QKV + col + 1]; } }
#pragma unroll
            for (int i = 0; i < 8; ++i) {
                float val[3][2];
#pragma unroll
                for (int p = 0; p < 3; ++p) { float a0 = 0.f, a1 = 0.f;
#pragma unroll
                    for (int j = 0; j < 4; ++j) { a0 += cw[p][j][0] * bflo(raw[p][i + j]); a1 += cw[p][j][1] * bfhi(raw[p][i + j]); }
                    val[p][0] = a0 * sigm(a0); val[p][1] = a1 * sigm(a1); }
                const float rq = 1.0f / sqrtf(wave_sum(val[0][0] * val[0][0] + val[0][1] * val[0][1]) + EPS) * 0.08838834764831845f;
                const float rk = 1.0f / sqrtf(wave_sum(val[1][0] * val[1][0] + val[1][1] * val[1][1]) + EPS);
                const int o = (tk0 + i) * TP + 4 * lane;
                *(LAS unsigned*)(L + DNL_QT + o) = cvtpk(val[0][0] * rq, val[0][1] * rq);
                *(LAS unsigned*)(L + DNL_KT + o) = cvtpk(val[1][0] * rk, val[1][1] * rk);
                *(LAS unsigned*)(L + DNL_VT + o) = cvtpk(val[2][0], val[2][1]);
            }
        }
        __syncthreads();
        for (int id = wave; id < 20; id += 8) {
            const int e = id % 10, isqk = id / 10, ti = (e >= 6) ? 3 : (e >= 3) ? 2 : (e >= 1) ? 1 : 0, tj = e - ti * (ti + 1) / 2;
            f32x4 acc = {0.f, 0.f, 0.f, 0.f};
            const int xoff = isqk ? DNL_QT : DNL_KT;
#pragma unroll
            for (int ks = 0; ks < 4; ++ks) {
                const bf16x8 a = *(const LAS bf16x8*)(L + DNL_KT + (16 * tj + r16) * TP + (32 * ks + 8 * g) * 2);
                const bf16x8 bq = *(const LAS bf16x8*)(L + xoff + (16 * ti + r16) * TP + (32 * ks + 8 * g) * 2);
                acc = MFMA16(a, bq, acc); }
            const int i = 16 * ti + r16; const float gi = GC[i], bi = BETA[i]; const f32x4 gj = *(const LAS f32x4*)(GC + 16 * tj + 4 * g);
            f32x4 v;
#pragma unroll
            for (int r = 0; r < 4; ++r) { const int jp = 16 * tj + 4 * g + r; const float d = __expf(fminf(gi - gj[r], 0.f));
                v[r] = isqk ? ((i >= jp) ? acc[r] * d : 0.f) : ((i > jp) ? bi * acc[r] * d : 0.f); }
            if (!isqk) {
                u32x2 w; w.x = cvtpk(-v[0], -v[1]); w.y = cvtpk(-v[2], -v[3]);
                *(LAS u32x2*)(L + DNL_NA + i * NP2 + (16 * tj + 4 * g) * 2) = w;
                if (ti == tj) *(LAS f32x4*)(DB + (ti * 16 + r16) * 16 + 4 * g) = v;
            } else { u32x2 w; w.x = cvtpk(v[0], v[1]); w.y = cvtpk(v[2], v[3]); *(LAS u32x2*)(L + DNL_QKM + i * NP2 + (16 * tj + 4 * g) * 2) = w; }
        }
        __syncthreads();
        if (wave < 4) {
            const int I = wave; float x[16];
#pragma unroll
            for (int i = 0; i < 16; ++i) { float a = (i == r16) ? 1.f : 0.f;
#pragma unroll
                for (int j4 = 0; j4 < (i + 3) / 4; ++j4) { const f32x4 d = *(const LAS f32x4*)(DB + (I * 16 + i) * 16 + 4 * j4);
#pragma unroll
                    for (int jj = 0; jj < 4; ++jj) if (4 * j4 + jj < i) a -= d[jj] * x[4 * j4 + jj]; }
                x[i] = a; }
            if (lane < 16) {
#pragma unroll
                for (int i = 0; i < 16; ++i) *(LAS unsigned short*)(L + DNL_TIB + ((I * 16 + i) * 16 + r16) * 2) = (unsigned short)(cvtpk(x[i], 0.f) & 0xffffu);
            }
        }
        __syncthreads();
        {
            const int part = wave >> 2, colbase = 32 * (wave & 3);
            f32x4 X[2][4];
#pragma unroll
            for (int I = 0; I < 4; ++I)
#pragma unroll
                for (int nt = 0; nt < 2; ++nt) {
                    const int col = colbase + 16 * nt + r16;
                    f32x4 acc;
#pragma unroll
                    for (int r = 0; r < 4; ++r) { const int tok = 16 * I + 4 * g + r;
                        acc[r] = part == 0 ? BETA[tok] * bf1(*(const LAS unsigned short*)(L + DNL_VT + tok * TP + col * 2))
                                           : -(BETA[tok] * __expf(GC[tok])) * bf1(*(const LAS unsigned short*)(L + DNL_KT + tok * TP + col * 2)); }
                    if (I >= 1) {
                        const u32x2 lo = *(const LAS u32x2*)(L + DNL_NA + (16 * I + r16) * NP2 + (4 * g) * 2);
                        u32x2 hi = {0u, 0u}; if (I >= 2) hi = *(const LAS u32x2*)(L + DNL_NA + (16 * I + r16) * NP2 + (16 + 4 * g) * 2);
                        const v4u aw = {lo.x, lo.y, hi.x, hi.y};
                        const bf16x8 bb = (I >= 2) ? pack8(X[nt][0], X[nt][1]) : pack8z(X[nt][0]);
                        acc = MFMA16(__builtin_bit_cast(bf16x8, aw), bb, acc);
                    }
                    if (I == 3) {
                        const u32x2 lo = *(const LAS u32x2*)(L + DNL_NA + (16 * I + r16) * NP2 + (32 + 4 * g) * 2);
                        const v4u aw = {lo.x, lo.y, 0u, 0u};
                        acc = MFMA16(__builtin_bit_cast(bf16x8, aw), pack8z(X[nt][2]), acc);
                    }
                    const u32x2 tl = *(const LAS u32x2*)(L + DNL_TIB + ((I * 16 + r16) * 16 + 4 * g) * 2);
                    const v4u tw = {tl.x, tl.y, 0u, 0u};
                    const f32x4 zero = {0.f, 0.f, 0.f, 0.f};
                    X[nt][I] = MFMA16(__builtin_bit_cast(bf16x8, tw), pack8z(acc), zero);
                    if (part == 0) *(f32x4*)(R.U + ((size_t)(ch * 8 + 2 * (wave & 3) + nt) * 4 + I) * 256 + lane * 4) = X[nt][I];
                    else {
#pragma unroll
                        for (int r = 0; r < 4; ++r) *(LAS unsigned short*)(L + DNL_WL + (16 * I + 4 * g + r) * TP + col * 2) = (unsigned short)(cvtpk(X[nt][I][r], 0.f) & 0xffffu);
                    }
                }
        }
        __syncthreads();
        for (int it = wave; it < 54; it += 8) {
            if (it < 32) {
                const int f = it & 15, mt = f >> 2, ks = f & 3, base = (it < 16 ? DNL_WL : DNL_QT) + (16 * mt + r16) * TP;
                const u32x2 lo = *(const LAS u32x2*)(L + base + (32 * ks + 4 * g) * 2), hi = *(const LAS u32x2*)(L + base + (32 * ks + 16 + 4 * g) * 2);
                v4u w = {lo.x, lo.y, hi.x, hi.y};
                if (it >= 16) { const float e = __expf(GC[16 * mt + r16]);
#pragma unroll
                    for (int j = 0; j < 4; ++j) w[j] = cvtpk(bflo(w[j]) * e, bfhi(w[j]) * e); }
                *(v4u*)((it < 16 ? R.W : R.QG) + ((size_t)(ch * 16 + f) * 64 + lane) * 8) = w;
            } else if (it < 48) {
                const int f = it - 32, mt8 = f >> 1, kt = f & 1, dk = 16 * mt8 + r16; const float gl = GC[63];
                float v[8];
#pragma unroll
                for (int j = 0; j < 8; ++j) { const int tok = 32 * kt + (j < 4 ? 4 * g + j : 16 + 4 * g + j - 4); v[j] = bf1(*(const LAS unsigned short*)(L + DNL_KT + tok * TP + dk * 2)) * __expf(gl - GC[tok]); }
                v4u w; w.x = cvtpk(v[0], v[1]); w.y = cvtpk(v[2], v[3]); w.z = cvtpk(v[4], v[5]); w.w = cvtpk(v[6], v[7]);
                *(v4u*)(R.KD + ((size_t)(ch * 16 + f) * 64 + lane) * 8) = w;
            } else {
                const int q = it - 48, mt = (q == 0) ? 0 : (q == 1) ? 1 : (q < 4) ? 2 : 3, kt = (q == 3 || q == 5) ? 1 : 0;
                const u32x2 lo = *(const LAS u32x2*)(L + DNL_QKM + (16 * mt + r16) * NP2 + (32 * kt + 4 * g) * 2);
                u32x2 hi = {0u, 0u}; if (2 * kt + 1 <= mt) hi = *(const LAS u32x2*)(L + DNL_QKM + (16 * mt + r16) * NP2 + (32 * kt + 16 + 4 * g) * 2);
                const v4u w = {lo.x, lo.y, hi.x, hi.y};
                *(v4u*)(R.QK + ((size_t)(ch * 8 + mt * 2 + kt) * 64 + lane) * 8) = w;
            }
        }
        if (F.tid == 0) R.EGL[ch] = __expf(GC[63]);
        __syncthreads();
    }
}
__device__ __forceinline__ void dn_scan(Frame& F, int task) {
    const DnRec R = dn_rec(F);
    const int bh = task >> 3, sl = task & 7, lane = F.lane;
    f32x4 S[8];
#pragma unroll
    for (int i = 0; i < 8; ++i) S[i] = (f32x4){0.f, 0.f, 0.f, 0.f};
    bf16x8 Wf[16]; f32x4 Uf[4];
    {
        const int ch = bh * 64;
#pragma unroll
        for (int f = 0; f < 16; ++f) Wf[f] = *(const bf16x8*)(R.W + ((size_t)(ch * 16 + f) * 64 + lane) * 8);
#pragma unroll
        for (int mt = 0; mt < 4; ++mt) Uf[mt] = *(const f32x4*)(R.U + ((size_t)(ch * 8 + sl) * 4 + mt) * 256 + lane * 4);
    }
    for (int c = 0; c < 64; ++c) {
        const int ch = bh * 64 + c;
        bf16x8 QGf[16];
#pragma unroll
        for (int f = 0; f < 16; ++f) QGf[f] = *(const bf16x8*)(R.QG + ((size_t)(ch * 16 + f) * 64 + lane) * 8);
        bf16x8 Sb[4];
#pragma unroll
        for (int ks = 0; ks < 4; ++ks) Sb[ks] = pack8(S[2 * ks], S[2 * ks + 1]);
        f32x4 vn[4];
#pragma unroll
        for (int mt = 0; mt < 4; ++mt) { vn[mt] = Uf[mt];
#pragma unroll
            for (int ks = 0; ks < 4; ++ks) vn[mt] = MFMA16(Wf[mt * 4 + ks], Sb[ks], vn[mt]); }
        bf16x8 QKf[8], KDf[16];
        QKf[0] = *(const bf16x8*)(R.QK + ((size_t)(ch * 8 + 0) * 64 + lane) * 8); QKf[2] = *(const bf16x8*)(R.QK + ((size_t)(ch * 8 + 2) * 64 + lane) * 8);
#pragma unroll
        for (int f = 4; f < 8; ++f) QKf[f] = *(const bf16x8*)(R.QK + ((size_t)(ch * 8 + f) * 64 + lane) * 8);
#pragma unroll
        for (int f = 0; f < 16; ++f) KDf[f] = *(const bf16x8*)(R.KD + ((size_t)(ch * 16 + f) * 64 + lane) * 8);
        const float egl = R.EGL[ch];
        f32x4 o[4];
#pragma unroll
        for (int mt = 0; mt < 4; ++mt) { o[mt] = (f32x4){0.f, 0.f, 0.f, 0.f};
#pragma unroll
            for (int ks = 0; ks < 4; ++ks) o[mt] = MFMA16(QGf[mt * 4 + ks], Sb[ks], o[mt]); }
        const bf16x8 vb0 = pack8(vn[0], vn[1]), vb1 = pack8(vn[2], vn[3]);
        if (c + 1 < 64) {
#pragma unroll
            for (int f = 0; f < 16; ++f) Wf[f] = *(const bf16x8*)(R.W + ((size_t)((ch + 1) * 16 + f) * 64 + lane) * 8);
#pragma unroll
            for (int mt = 0; mt < 4; ++mt) Uf[mt] = *(const f32x4*)(R.U + ((size_t)((ch + 1) * 8 + sl) * 4 + mt) * 256 + lane * 4);
        }
        o[0] = MFMA16(QKf[0], vb0, o[0]); o[1] = MFMA16(QKf[2], vb0, o[1]);
        o[2] = MFMA16(QKf[4], vb0, o[2]); o[2] = MFMA16(QKf[5], vb1, o[2]);
        o[3] = MFMA16(QKf[6], vb0, o[3]); o[3] = MFMA16(QKf[7], vb1, o[3]);
#pragma unroll
        for (int i = 0; i < 8; ++i) { S[i] = S[i] * egl; S[i] = MFMA16(KDf[2 * i], vb0, S[i]); S[i] = MFMA16(KDf[2 * i + 1], vb1, S[i]); }
#pragma unroll
        for (int mt = 0; mt < 4; ++mt) *(f32x4*)(R.U + ((size_t)(ch * 8 + sl) * 4 + mt) * 256 + lane * 4) = o[mt];
    }
}
__device__ __forceinline__ void dn_out2(Frame& F) {
    const DnRec R = dn_rec(F);
    const int gw = F.vcu * NWAVES + F.wave, NGW = F.G * NWAVES, lane = F.lane, r16 = lane & 15, g = lane >> 4;
    const bf16* proj = (const bf16*)(F.ws + WS_PROJ); bf16* YDN = (bf16*)(F.ws + WS_Y); const float* gain = F.in[6];
    for (int task = gw; task < 4096; task += NGW) {
        const int ch = task >> 2, mt = task & 3, bh = ch >> 6, c = ch & 63, b = bh >> 2, h = bh & 3;
        f32x4 o[8]; float ss[4] = {0.f, 0.f, 0.f, 0.f};
#pragma unroll
        for (int sl = 0; sl < 8; ++sl) { o[sl] = *(const f32x4*)(R.U + ((size_t)(ch * 8 + sl) * 4 + mt) * 256 + lane * 4);
#pragma unroll
            for (int r = 0; r < 4; ++r) ss[r] += o[sl][r] * o[sl][r]; }
#pragma unroll
        for (int r = 0; r < 4; ++r) { float s = ss[r]; s += __shfl_xor(s, 1); s += __shfl_xor(s, 2); s += __shfl_xor(s, 4); s += __shfl_xor(s, 8); ss[r] = 1.0f / sqrtf(s * (1.0f / DN_D) + EPS); }
#pragma unroll
        for (int sl = 0; sl < 8; ++sl) { const int d = 16 * sl + r16; const float gd = gain[d];
#pragma unroll
            for (int r = 0; r < 4; ++r) { const size_t m = (size_t)b * SEQ + 64 * c + 16 * mt + 4 * g + r; const float z = bf1(proj[m * NP + PC_Z + h * DN_D + d]);
                YDN[m * DN_W + h * DN_D + d] = (bf16)(cvtpk(o[sl][r] * ss[r] * gd * z * sigm(z), 0.f) & 0xffffu); } }
    }
}
struct Args { const float* in[18]; float* out; unsigned char* ws; int ph_lo, ph_hi, li, pad; };
__global__ void __launch_bounds__(NWAVES * 64, 2) fwd_kernel(Args args) {
    extern __shared__ __attribute__((aligned(16))) unsigned char lds[];
    Frame F;
    F.lds = (LAS unsigned char*)lds;
    F.MISC = (volatile LAS unsigned*)(F.lds + MISC_OFF);
    F.tid = threadIdx.x; F.lane = F.tid & 63; F.wave = __builtin_amdgcn_readfirstlane(F.tid >> 6);
    F.G = gridDim.x; { const int bx = blockIdx.x; F.vcu = (F.G % 8 == 0) ? (bx % 8) * (F.G / 8) + bx / 8 : bx; }
#pragma unroll
    for (int i = 0; i < 18; ++i) F.in[i] = args.in[i];
    F.out = args.out; F.ws = args.ws; unsigned char* ws = args.ws;
    F.ctl = (gu32*)(ws + WS_CTL);
    for (int u = F.tid; u < (LDS_BYTES - LDSCTL_OFF) / 4; u += NWAVES * 64) ((LAS unsigned*)(F.lds + LDSCTL_OFF))[u] = 0u;
    __syncthreads();
    const int lo = args.ph_lo, hi = args.ph_hi;
    XcdBarrier bar; bar.bar = (unsigned*)(F.ctl + CW_BAR) + args.li * XCD_BAR_WORDS; bar.x = 0; bar.st = nullptr;
    if (hi - lo > 1) bar = xcd_barrier_post((unsigned*)(F.ctl + CW_BAR) + args.li * XCD_BAR_WORDS, F.MISC + 8);
#define IN(k) (lo <= (k) && (k) < hi)
#define BOTH(k) (IN(k) && IN((k) + 1))
    bf16* XB = (bf16*)(ws + WS_XB); bf16* Y = (bf16*)(ws + WS_Y); bf16* PROJ = (bf16*)(ws + WS_PROJ);

    if (IN(0)) { p0_prologue(F); if (BOTH(0)) xcd_barrier(bar); }
    if (IN(1)) {
        pg8::Gemm g{XB, (const bf16*)(ws + WS_WIN), M, NP, D}; pg8::StaticOrder S; S.init(M, NP, F.G, (int)blockIdx.x);
        pg8::EpiProj E{PROJ, NP, (const float*)(ws + WS_RSTD)};
        pg8::gemm_phase<pg8::EpiProj, pg8::StaticOrder, true, true>(F.lds + RING_OFF, g, S, E);
        if (BOTH(1)) xcd_barrier(bar);
    }
    if (IN(2)) {
#if FAST_DN
        dn_chunk_prep(F);
#else
        dn_pre(F);
#endif
#if FAST_SWA
        swa_pre(F);
#endif
        if (BOTH(2)) xcd_barrier(bar);
    }
    if (IN(3)) {
#if FAST_DN
        swa_bias_table(F); __syncthreads();
        {
            const int nscan = F.G < 128 ? F.G : 128;
            if (F.wave == 0 && F.vcu < nscan) { for (int task = F.vcu; task < 128; task += nscan) dn_scan(F, task); }
            else { const int worker = F.vcu < nscan ? F.vcu * 7 + F.wave - 1 : nscan * 7 + (F.vcu - nscan) * 8 + F.wave; swa_main(F, worker, nscan * 7 + (F.G - nscan) * 8); }
        }
#elif FAST_SWA
        if (F.vcu < 16) dn_scan_naive(F, F.vcu);
        else { swa_bias_table(F); __syncthreads(); swa_main(F, (F.vcu - 16) * NWAVES + F.wave, (F.G - 16) * NWAVES); }
#else
        if (F.G > 16) { if (F.vcu < 16) dn_scan_naive(F, F.vcu); else swa_naive(F, (F.vcu - 16) * NWAVES + F.wave, (F.G - 16) * NWAVES); }
        else { for (int bh = F.vcu; bh < 16; bh += F.G) dn_scan_naive(F, bh); swa_naive(F, F.vcu * NWAVES + F.wave, F.G * NWAVES); }
#endif
        if (BOTH(3)) xcd_barrier(bar);
    }
    if (IN(4)) {
#if FAST_DN
        dn_out2(F);
#else
        dn_out(F);
#endif
        if (BOTH(4)) xcd_barrier(bar);
    }
    if (IN(5)) {
        pg8::Gemm g{Y, (const bf16*)(ws + WS_WAB), 2 * M, 2 * D, DN_W}; pg8::PairedOrder S; S.init(M, D, F.G, (int)blockIdx.x);
        pg8::EpiMerge E{PROJ + PC_G, NP, XB, D, M / 256, D / 256};
        pg8::gemm_phase<pg8::EpiMerge, pg8::PairedOrder, false, true>(F.lds + RING_OFF, g, S, E);
        if (BOTH(5)) xcd_barrier(bar);
    }
    if (IN(6)) {
        pg8::Gemm g{XB, (const bf16*)(ws + WS_WOUT), M, D, D}; pg8::StaticOrder S; S.init(M, D, F.G, (int)blockIdx.x);
        pg8::EpiX1 E{F.in[0], F.out, Y, (float*)(ws + WS_SSQ), D};
        pg8::gemm_phase<pg8::EpiX1, pg8::StaticOrder, false, true>(F.lds + RING_OFF, g, S, E);
        if (BOTH(6)) xcd_barrier(bar);
    }
    if (IN(7)) {
        pg8::Gemm g{Y, (const bf16*)(ws + WS_WGU), M, 2 * FF, D}; pg8::StaticOrder S; S.init(M, 2 * FF, F.G, (int)blockIdx.x);
        pg8::EpiSwiGLU E{PROJ, FF, (const float*)(ws + WS_SSQ), EPS};
        pg8::gemm_phase<pg8::EpiSwiGLU, pg8::StaticOrder, true, true>(F.lds + RING_OFF, g, S, E);
        if (BOTH(7)) xcd_barrier(bar);
    }
    if (IN(8)) {
        pg8::Gemm g{PROJ, (const bf16*)(ws + WS_WD), M, D, FF}; pg8::StaticOrder S; S.init(M, D, F.G, (int)blockIdx.x);
        pg8::EpiOut E{F.out, D};
        pg8::gemm_phase<pg8::EpiOut, pg8::StaticOrder, false, true>(F.lds + RING_OFF, g, S, E);
    }
#undef IN
#undef BOTH
}

extern "C" void kernel_launch(void* const* d_in, const int* in_sizes, int n_in, void* d_out, int out_size, void* d_ws, size_t ws_size, hipStream_t stream) {
    static int grid = 0;
    if (grid == 0) {
        if (n_in != 18 || in_sizes[0] != M * D || out_size != M * D || ws_size < WS_END) { fprintf(stderr, "kernel_launch: unexpected shapes (n_in %d, in0 %d, out %d, ws %zu)\n", n_in, n_in > 0 ? in_sizes[0] : -1, out_size, ws_size); grid = -1; return; }
        int dev = 0, cus = 0;
        if (hipGetDevice(&dev) != hipSuccess || hipDeviceGetAttribute(&cus, hipDeviceAttributeMultiprocessorCount, dev) != hipSuccess) { grid = -1; return; }
        if (hipFuncSetAttribute((const void*)fwd_kernel, hipFuncAttributeMaxDynamicSharedMemorySize, LDS_BYTES) != hipSuccess) { fprintf(stderr, "kernel_launch: hipFuncSetAttribute failed\n"); grid = -1; return; }
        int per_cu = 0;
        if (hipOccupancyMaxActiveBlocksPerMultiprocessor(&per_cu, (const void*)fwd_kernel, NWAVES * 64, LDS_BYTES) != hipSuccess || per_cu < 1) fprintf(stderr, "kernel_launch: occupancy query reports %d\n", per_cu);
        (void)hipGetLastError();
        grid = cus;
    }
    if (grid < 0) return;
    if (hipMemsetAsync((char*)d_ws + WS_CTL, 0, CTL_ZERO_BYTES, stream) != hipSuccess) return;
    Args a{};
    for (int i = 0; i < 18; ++i) a.in[i] = (const float*)d_in[i];
    a.out = (float*)d_out; a.ws = (unsigned char*)d_ws;
    for (int li = 0; li < N_LAUNCHES; ++li) {
        if (N_LAUNCHES == 1) { a.ph_lo = 0; a.ph_hi = PER_PHASE; } else { a.ph_lo = li * PER_PHASE / N_LAUNCHES; a.ph_hi = (li + 1) * PER_PHASE / N_LAUNCHES; }
        a.li = li;
        hipLaunchKernelGGL(fwd_kernel, dim3(grid), dim3(NWAVES * 64), LDS_BYTES, stream, a);
        const hipError_t le = hipPeekAtLastError();
        if (le != hipSuccess) { fprintf(stderr, "kernel_launch: launch %d failed: %s\n", li, hipGetErrorName(le)); break; }
    }
}
```

```cpp
#include <hip/hip_runtime.h>
#include <cstdio>
#include <cstdint>

namespace pg8 {
#define PG8_LAS __attribute__((address_space(3)))
typedef unsigned short bf16_t;
typedef short bf16x8 __attribute__((ext_vector_type(8)));
typedef float f32x4 __attribute__((ext_vector_type(4)));
typedef unsigned u32x4 __attribute__((ext_vector_type(4)));
typedef unsigned u32x2 __attribute__((ext_vector_type(2)));
constexpr int BM = 256, BK = 64, HALF = 128, HTB = HALF * BK * 2  , STAGE_BYTES = 8 * HTB, NXCD = 8, WGM = 8;

__host__ __device__ __forceinline__ int lds_byte(int r, int c) { const int st = (r >> 4) * 2 + (c >> 5), rr = r & 15, cc = c & 31, ob = rr * 64 + cc * 2; return st * 1024 + (ob ^ (((ob >> 9) & 1) << 5)); }
__host__ __device__ __forceinline__ void stage_rc(int b, int& R, int& C) { const int st = b / 1024, sb = b % 1024, swz = sb ^ (((sb >> 9) & 1) << 5); R = (st >> 1) * 16 + swz / 64; C = (st & 1) * 32 + (swz % 64) / 2; }
__host__ __device__ __forceinline__ int perm32(int rho) { const int n = rho >> 4, i = rho & 15; return 8 * (i >> 2) + 4 * n + (i & 3); }

struct Unit { int pm, pn; };
struct Gemm { const bf16_t* A; const bf16_t* Bt; int M, N, K; };

struct StaticOrder {
    int nM, nN, nwg, G, c;
    __host__ __device__ void init(int M, int N, int G_, int c_) { nM = M / BM; nN = N / BM; nwg = nM * nN; G = G_; c = c_; }
    __host__ __device__ bool next(int i, Unit& u) const {
        const long L = (long)i * G + c; if (L >= nwg) return false;
        int wgid = (int)L; { const int q = nwg / NXCD, r = nwg % NXCD, xcd = wgid % NXCD, off = wgid / NXCD; wgid = (xcd < r ? xcd * (q + 1) : r * (q + 1) + (xcd - r) * q) + off; }
        const int nig = WGM * nN, gid = wgid / nig, fm = gid * WGM, gsz = (nM - fm) < WGM ? (nM - fm) : WGM;
        u.pm = fm + ((wgid % nig) % gsz); u.pn = (wgid % nig) / gsz; return true;
    }
    __device__ __forceinline__ void a_ready(const Unit&) const {}
    __device__ __forceinline__ void done(const Unit&) const {}
};
struct PairedOrder {
    StaticOrder so;
    __host__ __device__ void init(int M, int N, int G_, int c_) { so.init(M, N, G_, c_); }
    __host__ __device__ bool next(int i, Unit& u) const { if (!so.next(i >> 1, u)) return false; if (i & 1) { u.pm += so.nM; u.pn += so.nN; } return true; }
    __device__ __forceinline__ void a_ready(const Unit&) const {}
    __device__ __forceinline__ void done(const Unit&) const {}
};

__device__ __forceinline__ unsigned cvt_pk_bf16(float lo, float hi) { unsigned r; asm volatile("v_cvt_pk_bf16_f32 %0, %1, %2" : "=v"(r) : "v"(lo), "v"(hi)); return r; }
__device__ __forceinline__ float bf_lo(unsigned w) { return __builtin_bit_cast(float, w << 16); }
__device__ __forceinline__ float bf_hi(unsigned w) { return __builtin_bit_cast(float, w & 0xffff0000u); }
__device__ __forceinline__ float sigmoidf_(float x) { return 1.0f / (1.0f + __expf(-x)); }


struct EpiProj {
    static constexpr bool PERM = true, AFTER_DRAIN = false;
    bf16_t* O; int ldc; const float* rstd; int gate_pn0;
    __device__ __forceinline__ bool keep(const Unit&) const { return false; }
    __device__ __forceinline__ void operator()(f32x4 (&acc)[2][2][4][2], const Unit& u, int wr, int wc, int fr, int fq) const {
        const int row0 = u.pm * BM + wr * 64 + fr, col0 = u.pn * BM + wc * 32 + 8 * fq; const bool gate = u.pn >= gate_pn0;
#pragma unroll
        for (int ai = 0; ai < 2; ++ai)
#pragma unroll
            for (int m = 0; m < 4; ++m) { const int row = row0 + ai * HALF + m * 16; const float s = rstd[row]; bf16_t* rowp = O + (size_t)row * ldc + col0;
#pragma unroll
                for (int bj = 0; bj < 2; ++bj) { f32x4 v0 = acc[ai][bj][m][0] * s, v1 = acc[ai][bj][m][1] * s;
                    if (gate) {
#pragma unroll
                        for (int j = 0; j < 4; ++j) { v0[j] = __builtin_amdgcn_rcpf(1.0f + __expf(-v0[j])); v1[j] = __builtin_amdgcn_rcpf(1.0f + __expf(-v1[j])); } }
                    u32x4 w; w.x = cvt_pk_bf16(v0[0], v0[1]); w.y = cvt_pk_bf16(v0[2], v0[3]); w.z = cvt_pk_bf16(v1[0], v1[1]); w.w = cvt_pk_bf16(v1[2], v1[3]);
                    *(u32x4*)(rowp + bj * HALF) = w; } }
    }
};
struct EpiMerge {
    static constexpr bool PERM = true, AFTER_DRAIN = false;
    const bf16_t* G; int ldg; bf16_t* O; int ldc; int nM, nN;
    __device__ __forceinline__ bool keep(const Unit& u) const { return u.pm < nM; }
    __device__ __forceinline__ void operator()(f32x4 (&acc)[2][2][4][2], const Unit& u, int wr, int wc, int fr, int fq) const {
        const bool second = u.pm >= nM; const int pm = second ? u.pm - nM : u.pm, pn = second ? u.pn - nN : u.pn;
        const int row0 = pm * BM + wr * 64 + fr, col0 = pn * BM + wc * 32 + 8 * fq;
#pragma unroll
        for (int ai = 0; ai < 2; ++ai)
#pragma unroll
            for (int m = 0; m < 4; ++m) { const int row = row0 + ai * HALF + m * 16;
#pragma unroll
                for (int bj = 0; bj < 2; ++bj) { const int col = col0 + bj * HALF;
                    const u32x4 ga = *(const u32x4*)(G + (size_t)row * ldg + col), gb = *(const u32x4*)(G + (size_t)row * ldg + 1024 + col);
                    float sa[8], sb[8];
#pragma unroll
                    for (int j = 0; j < 4; ++j) { sa[2 * j] = bf_lo(ga[j]); sa[2 * j + 1] = bf_hi(ga[j]); sb[2 * j] = bf_lo(gb[j]); sb[2 * j + 1] = bf_hi(gb[j]); }
                    if (!second) {
#pragma unroll
                        for (int j = 0; j < 4; ++j) { acc[ai][bj][m][0][j] *= sa[j] * __builtin_amdgcn_rcpf(sb[j]); acc[ai][bj][m][1][j] *= sa[4 + j] * __builtin_amdgcn_rcpf(sb[4 + j]); }
                    } else {
                        f32x4 v0, v1;
#pragma unroll
                        for (int j = 0; j < 4; ++j) { v0[j] = acc[ai][bj][m][0][j] * sb[j]; v1[j] = acc[ai][bj][m][1][j] * sb[4 + j]; }
                        u32x4 w; w.x = cvt_pk_bf16(v0[0], v0[1]); w.y = cvt_pk_bf16(v0[2], v0[3]); w.z = cvt_pk_bf16(v1[0], v1[1]); w.w = cvt_pk_bf16(v1[2], v1[3]);
                        *(u32x4*)(O + (size_t)row * ldc + col) = w; } } }
    }
};
struct EpiX1 {
    static constexpr bool PERM = false, AFTER_DRAIN = false;
    const float* X; float* out; bf16_t* xb; float* ssq; int ldc;
    __device__ __forceinline__ bool keep(const Unit&) const { return false; }
    __device__ __forceinline__ void operator()(f32x4 (&acc)[2][2][4][2], const Unit& u, int wr, int wc, int fr, int fq) const {
        const int row0 = u.pm * BM + wr * 64 + fr, col0 = u.pn * BM + wc * 32 + 4 * fq;
#pragma unroll
        for (int ai = 0; ai < 2; ++ai)
#pragma unroll
            for (int m = 0; m < 4; ++m) { const int row = row0 + ai * HALF + m * 16; const size_t off = (size_t)row * ldc + col0; float ss = 0.f;
#pragma unroll
                for (int bj = 0; bj < 2; ++bj)
#pragma unroll
                    for (int n = 0; n < 2; ++n) { const f32x4 xv = *(const f32x4*)(X + off + bj * HALF + n * 16); const f32x4 o = xv + acc[ai][bj][m][n];
                        *(f32x4*)(out + off + bj * HALF + n * 16) = o; ss += (o[0] * o[0] + o[1] * o[1]) + (o[2] * o[2] + o[3] * o[3]);
                        u32x2 w; w.x = cvt_pk_bf16(o[0], o[1]); w.y = cvt_pk_bf16(o[2], o[3]); *(u32x2*)(xb + off + bj * HALF + n * 16) = w; }
                ss += __shfl_xor(ss, 16); ss += __shfl_xor(ss, 32);
                if (fq == 0) ssq[(size_t)row * 16 + u.pn * 4 + wc] = ss; }
    }
};
struct EpiSwiGLU {
    static constexpr bool PERM = true, AFTER_DRAIN = false;
    bf16_t* O; int ldc; const float* ssq; float eps;
    __device__ __forceinline__ bool keep(const Unit&) const { return false; }
    __device__ __forceinline__ void operator()(f32x4 (&acc)[2][2][4][2], const Unit& u, int wr, int wc, int fr, int fq) const {
        const int row0 = u.pm * BM + wr * 64 + fr, col0 = u.pn * HALF + wc * 32 + 8 * fq;
#pragma unroll
        for (int ai = 0; ai < 2; ++ai)
#pragma unroll
            for (int m = 0; m < 4; ++m) { const int row = row0 + ai * HALF + m * 16;
                const f32x4* sp = (const f32x4*)(ssq + (size_t)row * 16); const f32x4 s0 = sp[0], s1 = sp[1], s2 = sp[2], s3 = sp[3];
                const float tot = ((s0[0] + s0[1]) + (s0[2] + s0[3])) + ((s1[0] + s1[1]) + (s1[2] + s1[3])) + ((s2[0] + s2[1]) + (s2[2] + s2[3])) + ((s3[0] + s3[1]) + (s3[2] + s3[3]));
                const float s = __builtin_amdgcn_rsqf(tot * (1.0f / 1024.0f) + eps);
                float a[8];
#pragma unroll
                for (int n = 0; n < 2; ++n)
#pragma unroll
                    for (int j = 0; j < 4; ++j) { const float g = acc[ai][0][m][n][j] * s, up = acc[ai][1][m][n][j] * s; a[4 * n + j] = g * up * __builtin_amdgcn_rcpf(1.0f + __expf(-g)); }
                u32x4 w; w.x = cvt_pk_bf16(a[0], a[1]); w.y = cvt_pk_bf16(a[2], a[3]); w.z = cvt_pk_bf16(a[4], a[5]); w.w = cvt_pk_bf16(a[6], a[7]);
                *(u32x4*)(O + (size_t)row * ldc + col0) = w; }
    }
};
struct EpiOut {
    static constexpr bool PERM = false, AFTER_DRAIN = false;
    float* out; int ldc;
    __device__ __forceinline__ bool keep(const Unit&) const { return false; }
    __device__ __forceinline__ void operator()(f32x4 (&acc)[2][2][4][2], const Unit& u, int wr, int wc, int fr, int fq) const {
        const int row0 = u.pm * BM + wr * 64 + fr, col0 = u.pn * BM + wc * 32 + 4 * fq;
#pragma unroll
        for (int ai = 0; ai < 2; ++ai)
#pragma unroll
            for (int m = 0; m < 4; ++m) { float* rowp = out + (size_t)(row0 + ai * HALF + m * 16) * ldc + col0;
#pragma unroll
                for (int bj = 0; bj < 2; ++bj)
#pragma unroll
                    for (int n = 0; n < 2; ++n) { const f32x4 b = *(const f32x4*)(rowp + bj * HALF + n * 16); *(f32x4*)(rowp + bj * HALF + n * 16) = b + acc[ai][bj][m][n]; } }
    }
};

template <class Epi, class Sched, bool ALIGN_EPI = false, bool SP2 = false>
__device__ __forceinline__ void gemm_phase(PG8_LAS unsigned char* lds, const Gemm g, const Sched& S, const Epi& E) {
    const int tid = threadIdx.x, wid = __builtin_amdgcn_readfirstlane(tid >> 6), lane = tid & 63, wr = wid >> 2, wc = wid & 3, fr = lane & 15, fq = lane >> 4;
    const int K = g.K, nt = K / BK;
    unsigned voffA[2], voffB[2];
#pragma unroll
    for (int i = 0; i < 2; ++i) { int R, C; stage_rc(tid * 16 + i * 8192, R, C); const int Rb = Epi::PERM ? ((R & ~31) + perm32(R & 31)) : R;
        voffA[i] = (unsigned)(R * K + C) * 2u; voffB[i] = (unsigned)(Rb * K + C) * 2u; }
    const size_t kstep = (size_t)(BK * 2);
    const size_t hstep = (size_t)HALF * K * 2;
    const size_t tstep = 2 * hstep;
    const unsigned ldsw = (unsigned)wid * 1024u;
    const int aoff = lds_byte(wr * 64 + fr, fq * 8), boff = lds_byte(wc * 32 + fr, fq * 8);
#define PG8_SA(b, h) (((b) * 2 + (h)) * HTB)
#define PG8_SB(b, h) ((4 + (b) * 2 + (h)) * HTB)
#define PG8_STAGE(bufoff, gbase, voff) do { _Pragma("unroll") for (int _i = 0; _i < 2; ++_i) \
        __builtin_amdgcn_global_load_lds((const unsigned*)((const char*)(gbase) + (voff)[_i]), (PG8_LAS unsigned*)(lds + (bufoff) + ldsw + _i * 8192), 16, 0, 0); } while (0)
#define PG8_LDA(dst, b, h) do { _Pragma("unroll") for (int m = 0; m < 4; ++m) _Pragma("unroll") for (int k = 0; k < 2; ++k) dst[m][k] = *(const PG8_LAS bf16x8*)(lds + PG8_SA(b, h) + aoff + m * 2048 + k * 1024); } while (0)
#define PG8_LDB(dst, b, h) do { _Pragma("unroll") for (int n = 0; n < 2; ++n) _Pragma("unroll") for (int k = 0; k < 2; ++k) dst[n][k] = *(const PG8_LAS bf16x8*)(lds + PG8_SB(b, h) + boff + n * 2048 + k * 1024); } while (0)
#define PG8_MMA(ai, bj, At, Bt) do { __builtin_amdgcn_s_setprio(1); _Pragma("unroll") for (int m = 0; m < 4; ++m) _Pragma("unroll") for (int n = 0; n < 2; ++n) _Pragma("unroll") for (int k = 0; k < 2; ++k) \
        acc[ai][bj][m][n] = __builtin_amdgcn_mfma_f32_16x16x32_bf16(Bt[n][k], At[m][k], acc[ai][bj][m][n], 0, 0, 0); __builtin_amdgcn_s_setprio(0); } while (0)
#define PG8_WAIT_V(n) asm volatile("s_waitcnt vmcnt(" #n ")" ::: "memory")
#define PG8_WAIT_L(n) asm volatile("s_waitcnt lgkmcnt(" #n ")" ::: "memory")
#define PG8_BAR __builtin_amdgcn_s_barrier()
#define PG8_SCHED __builtin_amdgcn_sched_barrier(0)
    Unit cur, nxt; int ui = 0;
    if (!S.next(0, cur)) return;
    f32x4 acc[2][2][4][2];
#pragma unroll
    for (int a = 0; a < 2; ++a)
#pragma unroll
        for (int b = 0; b < 2; ++b)
#pragma unroll
            for (int m = 0; m < 4; ++m)
#pragma unroll
                for (int n = 0; n < 2; ++n) acc[a][b][m][n] = (f32x4){0.f, 0.f, 0.f, 0.f};
    bf16x8 At[4][2], B0[2][2], B1[2][2];
    const char* cA = (const char*)g.A + (size_t)cur.pm * tstep; const char* cB = (const char*)g.Bt + (size_t)cur.pn * tstep;
    S.a_ready(cur);
    if constexpr (SP2) {
        PG8_STAGE(PG8_SB(0, 0), cB, voffB); PG8_STAGE(PG8_SB(0, 1), cB + hstep, voffB); PG8_STAGE(PG8_SA(0, 0), cA, voffA); PG8_STAGE(PG8_SA(0, 1), cA + hstep, voffA);
        if (wr == 1) PG8_BAR;
        PG8_WAIT_V(2); PG8_BAR;
        PG8_STAGE(PG8_SB(1, 0), cB + kstep, voffB); PG8_STAGE(PG8_SA(1, 0), cA + kstep, voffA); PG8_STAGE(PG8_SB(1, 1), cB + hstep + kstep, voffB);
        PG8_WAIT_V(6); PG8_BAR;
    } else {
        PG8_STAGE(PG8_SB(0, 0), cB, voffB); PG8_STAGE(PG8_SA(0, 0), cA, voffA); PG8_STAGE(PG8_SB(0, 1), cB + hstep, voffB); PG8_STAGE(PG8_SA(0, 1), cA + hstep, voffA);
        if (wr == 1) PG8_BAR;
        PG8_WAIT_V(4); PG8_BAR;
        PG8_STAGE(PG8_SB(1, 0), cB + kstep, voffB); PG8_STAGE(PG8_SA(1, 0), cA + kstep, voffA); PG8_STAGE(PG8_SB(1, 1), cB + hstep + kstep, voffB);
        PG8_WAIT_V(6); PG8_BAR;
    }
    for (;;) {
        const bool has_next = S.next(ui + 1, nxt);
        const char* nA = has_next ? (const char*)g.A + (size_t)nxt.pm * tstep : cA; const char* nB = has_next ? (const char*)g.Bt + (size_t)nxt.pn * tstep : cB;
        for (int t = 0; t < nt; t += 2) {
            const bool last = (t == nt - 2);
            const char* a1 = cA + (size_t)(t + 1) * kstep;
            const char* a2 = last ? nA : cA + (size_t)(t + 2) * kstep; const char* b2 = last ? nB : cB + (size_t)(t + 2) * kstep;
            const char* a3 = a2 + kstep; const char* b3 = b2 + kstep;
            if (last && has_next) S.a_ready(nxt);
            if constexpr (SP2) {
            PG8_LDB(B0, 0, 0); PG8_LDB(B1, 0, 1); PG8_SCHED; PG8_LDA(At, 0, 0); PG8_STAGE(PG8_SA(1, 1), a1 + hstep, voffA);
            PG8_WAIT_V(8); PG8_WAIT_L(0); PG8_BAR; PG8_MMA(0, 0, At, B0); PG8_MMA(0, 1, At, B1); PG8_BAR; PG8_SCHED;
            PG8_LDA(At, 0, 1); PG8_STAGE(PG8_SB(0, 0), b2, voffB); PG8_STAGE(PG8_SB(0, 1), b2 + hstep, voffB); PG8_STAGE(PG8_SA(0, 0), a2, voffA);
            PG8_WAIT_V(8); PG8_WAIT_L(0); PG8_BAR; PG8_MMA(1, 0, At, B0); PG8_MMA(1, 1, At, B1); PG8_BAR; PG8_SCHED;
            PG8_LDB(B0, 1, 0); PG8_LDB(B1, 1, 1); PG8_SCHED; PG8_LDA(At, 1, 0); PG8_STAGE(PG8_SA(0, 1), a2 + hstep, voffA);
            PG8_WAIT_V(8); PG8_WAIT_L(0); PG8_BAR; PG8_MMA(0, 0, At, B0); PG8_MMA(0, 1, At, B1); PG8_BAR; PG8_SCHED;
            PG8_LDA(At, 1, 1); PG8_STAGE(PG8_SB(1, 0), b3, voffB); PG8_STAGE(PG8_SB(1, 1), b3 + hstep, voffB); PG8_STAGE(PG8_SA(1, 0), a3, voffA);
            PG8_WAIT_V(8); PG8_WAIT_L(0); PG8_BAR; PG8_MMA(1, 0, At, B0); PG8_MMA(1, 1, At, B1); PG8_BAR; PG8_SCHED;
            } else {
            PG8_LDB(B0, 0, 0); PG8_SCHED; PG8_LDA(At, 0, 0); PG8_STAGE(PG8_SA(1, 1), a1 + hstep, voffA);
            PG8_WAIT_L(8); PG8_BAR; PG8_WAIT_L(0); PG8_MMA(0, 0, At, B0); PG8_BAR; PG8_SCHED;
            PG8_LDB(B1, 0, 1); PG8_STAGE(PG8_SB(0, 0), b2, voffB);
            PG8_BAR; PG8_WAIT_L(0); PG8_MMA(0, 1, At, B1); PG8_BAR;
            PG8_LDA(At, 0, 1); PG8_STAGE(PG8_SA(0, 0), a2, voffA);
            PG8_BAR; PG8_WAIT_L(0); PG8_MMA(1, 0, At, B0); PG8_BAR; PG8_SCHED;
            PG8_STAGE(PG8_SB(0, 1), b2 + hstep, voffB);
            PG8_WAIT_V(6); PG8_BAR; PG8_MMA(1, 1, At, B1); PG8_BAR;
            PG8_LDB(B0, 1, 0); PG8_SCHED; PG8_LDA(At, 1, 0); PG8_STAGE(PG8_SA(0, 1), a2 + hstep, voffA);
            PG8_WAIT_L(8); PG8_BAR; PG8_WAIT_L(0); PG8_MMA(0, 0, At, B0); PG8_BAR; PG8_SCHED;
            PG8_LDB(B1, 1, 1); PG8_STAGE(PG8_SB(1, 0), b3, voffB);
            PG8_BAR; PG8_WAIT_L(0); PG8_MMA(0, 1, At, B1); PG8_BAR;
            PG8_LDA(At, 1, 1); PG8_STAGE(PG8_SA(1, 0), a3, voffA);
            PG8_BAR; PG8_WAIT_L(0); PG8_MMA(1, 0, At, B0); PG8_BAR; PG8_SCHED;
            PG8_STAGE(PG8_SB(1, 1), b3 + hstep, voffB);
            PG8_WAIT_V(6); PG8_BAR; PG8_MMA(1, 1, At, B1); PG8_BAR;
            }
        }
        if constexpr (ALIGN_EPI) { if (wr == 0) PG8_BAR; }
        if constexpr (!Epi::AFTER_DRAIN) { E(acc, cur, wr, wc, fr, fq); S.done(cur); }
        if (!has_next) break;
        if (!E.keep(cur)) {
#pragma unroll
        for (int a = 0; a < 2; ++a)
#pragma unroll
            for (int b = 0; b < 2; ++b)
#pragma unroll
                for (int m = 0; m < 4; ++m)
#pragma unroll
                    for (int n = 0; n < 2; ++n) acc[a][b][m][n] = (f32x4){0.f, 0.f, 0.f, 0.f};
        }
        cur = nxt; cA = nA; cB = nB; ++ui;
        if constexpr (ALIGN_EPI) { if (wr == 1) PG8_BAR; }
    }
    PG8_WAIT_V(0);
    if constexpr (!ALIGN_EPI) { if (wr == 0) PG8_BAR; }
    PG8_BAR;
    if constexpr (Epi::AFTER_DRAIN) { E.fused(acc, cur, wr, wc, fr, fq, lds, wid, lane); S.done(cur); }
#undef PG8_SA
#undef PG8_SB
#undef PG8_STAGE
#undef PG8_LDA
#undef PG8_LDB
#undef PG8_MMA
#undef PG8_WAIT_V
#undef PG8_WAIT_L
#undef PG8_BAR
#undef PG8_SCHED
}
}
#ifndef FAST_SWA
#define FAST_SWA 1
#endif
#ifndef FAST_DN
#define FAST_DN 1
#endif
#ifndef REP_DNA
#define REP_DNA 1
#endif
#ifndef REP_SWAPRE
#define REP_SWAPRE 1
#endif

constexpr int NWAVES = 8;
#ifndef MK_N_LAUNCHES
#define MK_N_LAUNCHES 1
#endif
constexpr int PER_PHASE = 9;
constexpr int N_LAUNCHES = MK_N_LAUNCHES;

constexpr int BATCH = 4, SEQ = 4096, D = 1024, M = BATCH * SEQ;
constexpr int DN_H = 4, DN_D = 128, DN_W = 512, DN_QKV = 1536;
constexpr int SW_H = 8, SW_KV = 2, SW_D = 64, SW_W = 512, SW_KVW = 128, WINDOW = 128;
constexpr int FF = 2816;
constexpr int D_IN = 4872;
constexpr int NP = 4864;
constexpr int PC_Z = 1536, PC_SQ = 2048, PC_SK = 2560, PC_SV = 2688, PC_G = 2816;
constexpr float EPS = 1e-6f;

constexpr size_t MiB = 1u << 20;
constexpr size_t WS_CTL = 0, CTL_ZERO_BYTES = 1 * MiB;
constexpr size_t WS_WIN = 1 * MiB;
constexpr size_t WS_WAB = 11 * MiB;
constexpr size_t WS_WOUT = 13 * MiB;
constexpr size_t WS_WGU = 15 * MiB;
constexpr size_t WS_WD = 26 * MiB;
constexpr size_t WS_RSTD = 32 * MiB;
constexpr size_t WS_GB = WS_RSTD + 64 * 1024;
constexpr size_t WS_SSQ = 33 * MiB;
constexpr size_t WS_XB = 34 * MiB;
constexpr size_t WS_Y = 66 * MiB;
constexpr size_t WS_PROJ = 98 * MiB;
constexpr size_t WS_END = 250 * MiB;
static_assert(WS_PROJ + (size_t)M * NP * 2 <= WS_END, "ws map");
constexpr int CW_TMO = 0, CW_BAR = 4096;

constexpr int RING_OFF = 0, RING_BYTES = 131072;
constexpr int LDSCTL_OFF = RING_BYTES, MISC_OFF = LDSCTL_OFF + 320;
constexpr int LDS_BYTES = 147456;

#define GAS __attribute__((address_space(1)))
#define LAS __attribute__((address_space(3)))
typedef unsigned short bf16;
typedef unsigned v4u __attribute__((ext_vector_type(4)));
typedef float f32x4 __attribute__((ext_vector_type(4)));
typedef float f32x2 __attribute__((ext_vector_type(2)));
typedef GAS unsigned gu32;
#define RLX_AGENT __ATOMIC_RELAXED, __HIP_MEMORY_SCOPE_AGENT
#define LDS_WAIT() asm volatile("s_waitcnt lgkmcnt(0)" ::: "memory")
#define VM_WAIT() asm volatile("s_waitcnt vmcnt(0)" ::: "memory")
__device__ __forceinline__ unsigned f2bf(float f) { unsigned u = __builtin_bit_cast(unsigned, f); return (u + 0x7fffu + ((u >> 16) & 1u)) >> 16; }
__device__ __forceinline__ unsigned pk2(float lo, float hi) { return f2bf(lo) | (f2bf(hi) << 16); }
__device__ __forceinline__ float bflo(unsigned w) { return __builtin_bit_cast(float, w << 16); }
__device__ __forceinline__ float bfhi(unsigned w) { return __builtin_bit_cast(float, w & 0xffff0000u); }
__device__ __forceinline__ float bf1(bf16 h) { return __builtin_bit_cast(float, (unsigned)h << 16); }
__device__ __forceinline__ float sigm(float x) { return __builtin_amdgcn_rcpf(1.0f + __expf(-x)); }
__device__ __forceinline__ float frsq(float x) { return __builtin_amdgcn_rsqf(x); }
__device__ __forceinline__ float wave_sum(float v) {
#pragma unroll
    for (int o = 1; o < 64; o <<= 1) v += __shfl_xor(v, o);
    return v;
}
__device__ __forceinline__ float wave_max(float v) {
#pragma unroll
    for (int o = 1; o < 64; o <<= 1) v = fmaxf(v, __shfl_xor(v, o));
    return v;
}

#define XB_TMO      128
#define XB_XCNT(j)  (256  + 64 * (j))
#define XB_XSUB(j)  (1280 + 64 * (j))
#define XB_XGEN(j)  (2304 + 64 * (j))
#define XB_TOP      3328
#define XB_TOPGEN   3392
#define XCD_BAR_WORDS 3456
#define XB_SPIN_CAP (1u << 18)
__device__ __forceinline__ unsigned xb_ld(unsigned* p)              { return __hip_atomic_load(p, __ATOMIC_RELAXED, __HIP_MEMORY_SCOPE_AGENT); }
__device__ __forceinline__ unsigned xb_add(unsigned* p, unsigned v) { return __hip_atomic_fetch_add(p, v, __ATOMIC_RELAXED, __HIP_MEMORY_SCOPE_AGENT); }
__device__ __forceinline__ unsigned xb_xcc_id() { return (unsigned)__builtin_amdgcn_s_getreg((3 << 11) | 20) & 0xFu; }
#define XB_SPIN(cond, bar) do { unsigned _sp = 0; while (cond) { __builtin_amdgcn_s_sleep(1); \
    if ((++_sp & 255u) == 0u) { if (xb_ld(&(bar)[XB_TMO])) break; if (_sp > XB_SPIN_CAP) { atomicAdd(&(bar)[XB_TMO], 1u); break; } } } } while (0)
struct XcdBarrier { unsigned* bar; unsigned x; volatile LAS unsigned* st; };
__device__ __forceinline__ XcdBarrier xcd_barrier_post(unsigned* bar, volatile LAS unsigned* st) {
    XcdBarrier b; b.bar = bar; b.x = xb_xcc_id(); b.st = st;
    if (threadIdx.x == 0) (void)xb_add(&bar[XB_XCNT(b.x)], 1u);
    return b;
}
__device__ __forceinline__ void xcd_barrier_complete(unsigned* bar, unsigned x, unsigned& nloc, unsigned& nx) {
    const unsigned G = gridDim.x * gridDim.y * gridDim.z;
    unsigned sum, cnt, mine, sp = 0u;
    for (;;) {
        sum = 0u; cnt = 0u; mine = 0u;
#pragma unroll
        for (unsigned j = 0; j < 16; ++j) { const unsigned c = xb_ld(&bar[XB_XCNT(j)]); sum += c; cnt += (c > 0u) ? 1u : 0u; mine = (j == x) ? c : mine; }
        if (sum == G) break;
        __builtin_amdgcn_s_sleep(1);
        if ((++sp & 255u) == 0u) { if (xb_ld(&bar[XB_TMO])) break; if (sp > XB_SPIN_CAP) { atomicAdd(&bar[XB_TMO], 1u); break; } }
    }
    nloc = mine > 0u ? mine : 1u; nx = cnt > 0u ? cnt : 1u;
}
__device__ __forceinline__ void xcd_barrier(const XcdBarrier& b) {
    asm volatile("s_waitcnt vmcnt(0)" ::: "memory");
    __syncthreads();
    if (threadIdx.x == 0) {
        unsigned* bar = b.bar;
        __builtin_amdgcn_s_waitcnt(0);
        unsigned nloc = b.st[0], nx = b.st[1];
        if (nloc == 0u) { xcd_barrier_complete(bar, b.x, nloc, nx); b.st[0] = nloc; b.st[1] = nx; }
        const unsigned old = xb_add(&bar[XB_XSUB(b.x)], 1u);
        const unsigned gen = old / nloc;
        if (old + 1u == (gen + 1u) * nloc) {
            __builtin_amdgcn_fence(__ATOMIC_RELEASE, "agent");
            asm volatile("s_waitcnt vmcnt(0)" ::: "memory");
            const unsigned og = xb_add(&bar[XB_TOP], 1u);
            const unsigned tg = og / nx;
            if (og + 1u == (tg + 1u) * nx) xb_add(&bar[XB_TOPGEN], 1u);
            else XB_SPIN(xb_ld(&bar[XB_TOPGEN]) == tg, bar);
            __builtin_amdgcn_fence(__ATOMIC_ACQUIRE, "agent");
            xb_add(&bar[XB_XGEN(b.x)], 1u);
            asm volatile("s_waitcnt vmcnt(0)" ::: "memory");
        } else {
            XB_SPIN(xb_ld(&bar[XB_XGEN(b.x)]) == gen, bar);
            __builtin_amdgcn_fence(__ATOMIC_ACQUIRE, "agent");
            asm volatile("s_waitcnt vmcnt(0)" ::: "memory");
        }
    }
    __syncthreads();
}

struct Frame {
    LAS unsigned char* lds;
    volatile LAS unsigned* MISC;
    gu32* ctl;
    int tid, lane, wave;
    int vcu, G;
    const float* in[18]; float* out; unsigned char* ws;
};
__device__ const unsigned char T5_BUCKET[128] = {0,1,2,3,4,5,6,7,8,9,10,11,12,13,14,15,16,16,16,17,17,18,18,18,19,19,19,20,20,20,20,21,21,21,21,22,22,22,22,22,23,23,23,23,23,23,24,24,24,24,24,24,25,25,25,25,25,25,25,26,26,26,26,26,26,26,26,27,27,27,27,27,27,27,27,27,27,28,28,28,28,28,28,28,28,28,28,29,29,29,29,29,29,29,29,29,29,29,29,30,30,30,30,30,30,30,30,30,30,30,30,30,30,31,31,31,31,31,31,31,31,31,31,31,31,31,31,31};

__device__ __forceinline__ void p0_transpose_item(const float* W, int ldw, int src_col0, int K, bf16* WT, int dst_row0, const float* gain, LAS float* scr, int kb, int lane) {
    const int k0 = 64 * kb, c4 = 4 * (lane & 7);
    f32x4 v[8];
#pragma unroll
    for (int i = 0; i < 8; ++i) v[i] = *(const f32x4*)(W + (size_t)(k0 + 8 * i + (lane >> 3)) * ldw + src_col0 + c4);
#pragma unroll
    for (int i = 0; i < 8; ++i) { const int kk = 8 * i + (lane >> 3); const float gn = gain ? gain[k0 + kk] : 1.0f;
        scr[kk * 33 + c4] = v[i].x * gn; scr[kk * 33 + c4 + 1] = v[i].y * gn; scr[kk * 33 + c4 + 2] = v[i].z * gn; scr[kk * 33 + c4 + 3] = v[i].w * gn; }
    LDS_WAIT(); asm volatile("" ::: "memory");
    const int c = lane & 7;
#pragma unroll
    for (int j = 0; j < 4; ++j) { const int n = (lane >> 3) + 8 * j; const LAS float* s = scr + (8 * c) * 33 + n;
        v4u o; o.x = pk2(s[0 * 33], s[1 * 33]); o.y = pk2(s[2 * 33], s[3 * 33]); o.z = pk2(s[4 * 33], s[5 * 33]); o.w = pk2(s[6 * 33], s[7 * 33]);
        *(GAS v4u*)(WT + (size_t)(dst_row0 + n) * K + k0 + 8 * c) = o; }
    LDS_WAIT(); asm volatile("" ::: "memory");
}
__device__ __forceinline__ void p0_prologue(Frame& F) {
    LAS float* scr = (LAS float*)(F.lds + RING_OFF + F.wave * 16384);
    const int gw = F.vcu * NWAVES + F.wave, NGW = F.G * NWAVES;
    unsigned char* ws = F.ws;
    bf16* WinT = (bf16*)(ws + WS_WIN); bf16* WabT = (bf16*)(ws + WS_WAB); bf16* WoutT = (bf16*)(ws + WS_WOUT); bf16* WguT = (bf16*)(ws + WS_WGU); bf16* WdT = (bf16*)(ws + WS_WD);
    constexpr int I_IN = 16 * (NP / 32), I_AB = 8 * 32, I_OUT = 16 * 32, I_GU = 16 * (2 * FF / 32), I_D = (FF / 64) * 32;
    constexpr int NITEMS = I_IN + 2 * I_AB + I_OUT + I_GU + I_D;
    for (int it = gw; it < NITEMS; it += NGW) {
        int r = it;
        if (r < I_IN) { const int nb = r % (NP / 32), kb = r / (NP / 32), dr = 32 * nb; p0_transpose_item(F.in[2], D_IN, dr < 2048 ? dr : dr + 8, D, WinT, dr, F.in[1], scr, kb, F.lane); continue; } r -= I_IN;
        if (r < I_AB) { const int nb = r % 32, kb = r / 32; p0_transpose_item(F.in[11], D, 32 * nb, DN_W, WabT, 32 * nb, nullptr, scr, kb, F.lane); continue; } r -= I_AB;
        if (r < I_AB) { const int nb = r % 32, kb = r / 32; p0_transpose_item(F.in[12], D, 32 * nb, SW_W, WabT, 1024 + 32 * nb, nullptr, scr, kb, F.lane); continue; } r -= I_AB;
        if (r < I_OUT) { const int nb = r % 32, kb = r / 32; p0_transpose_item(F.in[13], D, 32 * nb, D, WoutT, 32 * nb, nullptr, scr, kb, F.lane); continue; } r -= I_OUT;
        if (r < I_GU) { const int nb = r % (2 * FF / 32), kb = r / (2 * FF / 32), dr = 32 * nb, pn = dr >> 8, j = dr & 255;
            const float* W = (j < 128) ? F.in[15] : F.in[16]; p0_transpose_item(W, FF, 128 * pn + (j & 127), D, WguT, dr, F.in[14], scr, kb, F.lane); continue; } r -= I_GU;
        { const int nb = r % 32, kb = r / 32; p0_transpose_item(F.in[17], D, 32 * nb, FF, WdT, 32 * nb, nullptr, scr, kb, F.lane); }
    }
    __syncthreads();
    LAS float* wba = (LAS float*)(F.lds + RING_OFF);
    for (int idx = F.tid; idx < 8 * D; idx += NWAVES * 64) { const int k = idx >> 3, j = idx & 7; wba[j * D + k] = F.in[2][(size_t)k * D_IN + 2048 + j] * F.in[1][k]; }
    __syncthreads();
    const float* x = F.in[0]; bf16* XB = (bf16*)(ws + WS_XB); float* rstd1 = (float*)(ws + WS_RSTD); float* gbp = (float*)(ws + WS_GB);
    const float alog_or_dt = (F.lane & 32) ? F.in[5][(F.lane >> 3) & 3] : 0.f;
    const float negA = -expf(F.in[4][(F.lane >> 3) & 3]);
    for (int m = gw; m < M; m += NGW) {
        const GAS f32x4* xr = (const GAS f32x4*)(x + (size_t)m * D) + F.lane;
        f32x4 v[4]; float ss = 0.f;
#pragma unroll
        for (int j = 0; j < 4; ++j) { v[j] = xr[64 * j]; ss += (v[j].x * v[j].x + v[j].y * v[j].y) + (v[j].z * v[j].z + v[j].w * v[j].w); }
        GAS unsigned long long* o8 = (GAS unsigned long long*)(XB + (size_t)m * D) + F.lane;
#pragma unroll
        for (int j = 0; j < 4; ++j) o8[64 * j] = (unsigned long long)pk2(v[j].x, v[j].y) | ((unsigned long long)pk2(v[j].z, v[j].w) << 32);
        float acc[8];
#pragma unroll
        for (int c = 0; c < 8; ++c) { float a = 0.f;
#pragma unroll
            for (int j = 0; j < 4; ++j) { const f32x4 w = *(const LAS f32x4*)(wba + c * D + 256 * j + 4 * F.lane); a += (v[j].x * w.x + v[j].y * w.y) + (v[j].z * w.z + v[j].w * w.w); }
            acc[c] = a; }
#pragma unroll
        for (int o = 1; o < 64; o <<= 1) ss += __shfl_xor(ss, o);
        float r4[4], r2[2], r1;
        { const bool up = (F.lane & 32) != 0;
#pragma unroll
          for (int i = 0; i < 4; ++i) { const float keep = up ? acc[4 + i] : acc[i], send = up ? acc[i] : acc[4 + i]; r4[i] = keep + __shfl_xor(send, 32); } }
        { const bool up = (F.lane & 16) != 0;
#pragma unroll
          for (int i = 0; i < 2; ++i) { const float keep = up ? r4[2 + i] : r4[i], send = up ? r4[i] : r4[2 + i]; r2[i] = keep + __shfl_xor(send, 16); } }
        { const bool up = (F.lane & 8) != 0; const float keep = up ? r2[1] : r2[0], send = up ? r2[0] : r2[1]; r1 = keep + __shfl_xor(send, 8); }
        r1 += __shfl_xor(r1, 4); r1 += __shfl_xor(r1, 2); r1 += __shfl_xor(r1, 1);
        const float rstd = frsq(ss * (1.0f / D) + EPS);
        if (F.lane == 0) rstd1[m] = rstd;
        if ((F.lane & 7) == 0) {
            const float val = r1 * rstd; float res;
            if (F.lane < 32) res = 1.0f / (1.0f + expf(-val));
            else { const float xx = val + alog_or_dt; const float sp = xx > 20.f ? xx : log1pf(expf(xx)); res = negA * sp; }
            gbp[(size_t)m * 8 + (F.lane >> 3)] = res;
        }
    }
}

__device__ __forceinline__ void dn_pre(Frame& F) {
    const int gw = F.vcu * NWAVES + F.wave, NGW = F.G * NWAVES;
    const bf16* proj = (const bf16*)(F.ws + WS_PROJ); const float* conv = F.in[3];
    float* QN = F.out; float* KN = F.out + (size_t)M * DN_W; float* VV = (float*)(F.ws + WS_XB);
    for (int task = gw; task < M * DN_H; task += NGW) {
        const int m = task >> 2, h = task & 3, t = m & (SEQ - 1);
        float val[3][2];
#pragma unroll
        for (int part = 0; part < 3; ++part) { const int col = part * DN_W + h * DN_D + 2 * F.lane; float a0 = 0.f, a1 = 0.f;
#pragma unroll
            for (int j = 0; j < 4; ++j) { if (t - 3 + j >= 0) { const unsigned w = *(const unsigned*)(proj + (size_t)(m - 3 + j) * NP + col); a0 += conv[j * DN_QKV + col] * bflo(w); a1 += conv[j * DN_QKV + col + 1] * bfhi(w); } }
            val[part][0] = a0 * sigm(a0); val[part][1] = a1 * sigm(a1); }
        const float rq = 1.0f / sqrtf(wave_sum(val[0][0] * val[0][0] + val[0][1] * val[0][1]) + EPS) * 0.08838834764831845f;
        const float rk = 1.0f / sqrtf(wave_sum(val[1][0] * val[1][0] + val[1][1] * val[1][1]) + EPS);
        const size_t o = (size_t)m * DN_W + h * DN_D + 2 * F.lane;
        *(f32x2*)(QN + o) = (f32x2){val[0][0] * rq, val[0][1] * rq};
        *(f32x2*)(KN + o) = (f32x2){val[1][0] * rk, val[1][1] * rk};
        *(f32x2*)(VV + o) = (f32x2){val[2][0], val[2][1]};
    }
}
__device__ __forceinline__ void dn_scan_naive(Frame& F, int bh) {
    const int b = bh >> 2, h = bh & 3, tid = F.tid, dvi = tid >> 2, kq = tid & 3;
    LAS float* kL = (LAS float*)(F.lds + RING_OFF); LAS float* qL = kL + 32 * 128; LAS float* vL = qL + 32 * 128; LAS float* gL = vL + 32 * 128; LAS float* bL = gL + 32;
    const float* QN = F.out; const float* KN = F.out + (size_t)M * DN_W; float* VV = (float*)(F.ws + WS_XB); const float* gbp = (const float*)(F.ws + WS_GB);
    float S[32];
#pragma unroll
    for (int j = 0; j < 32; ++j) S[j] = 0.f;
    for (int t0 = 0; t0 < SEQ; t0 += 32) {
#pragma unroll
        for (int r = 0; r < 2; ++r) { const int idx = tid + 512 * r, tok = idx >> 5, c4 = idx & 31; const size_t src = (size_t)(b * SEQ + t0 + tok) * DN_W + h * DN_D + c4 * 4;
            *(LAS f32x4*)(kL + tok * 128 + c4 * 4) = *(const f32x4*)(KN + src); *(LAS f32x4*)(qL + tok * 128 + c4 * 4) = *(const f32x4*)(QN + src); *(LAS f32x4*)(vL + tok * 128 + c4 * 4) = *(const f32x4*)(VV + src); }
        if (tid < 32) { const size_t mm = (size_t)(b * SEQ + t0 + tid); bL[tid] = gbp[mm * 8 + h]; gL[tid] = gbp[mm * 8 + 4 + h]; }
        __syncthreads();
        for (int i = 0; i < 32; ++i) {
            const float eg = __expf(gL[i]), be = bL[i];
            float kk[32];
#pragma unroll
            for (int j = 0; j < 8; ++j) { const f32x4 w = *(const LAS f32x4*)(kL + i * 128 + kq * 32 + 4 * j); kk[4 * j] = w.x; kk[4 * j + 1] = w.y; kk[4 * j + 2] = w.z; kk[4 * j + 3] = w.w; }
            float part = 0.f;
#pragma unroll
            for (int j = 0; j < 32; ++j) part += kk[j] * S[j];
            part += __shfl_xor(part, 1); part += __shfl_xor(part, 2);
            const float c = be * (vL[i * 128 + dvi] - eg * part);
#pragma unroll
            for (int j = 0; j < 32; ++j) S[j] = eg * S[j] + c * kk[j];
            float po = 0.f;
#pragma unroll
            for (int j = 0; j < 8; ++j) { const f32x4 w = *(const LAS f32x4*)(qL + i * 128 + kq * 32 + 4 * j); po += (w.x * S[4 * j] + w.y * S[4 * j + 1]) + (w.z * S[4 * j + 2] + w.w * S[4 * j + 3]); }
            po += __shfl_xor(po, 1); po += __shfl_xor(po, 2);
            if (kq == 0) vL[i * 128 + dvi] = po;
        }
        __syncthreads();
#pragma unroll
        for (int r = 0; r < 2; ++r) { const int idx = tid + 512 * r, tok = idx >> 5, c4 = idx & 31; const size_t src = (size_t)(b * SEQ + t0 + tok) * DN_W + h * DN_D + c4 * 4;
            *(f32x4*)(VV + src) = *(const LAS f32x4*)(vL + tok * 128 + c4 * 4); }
        __syncthreads();
    }
}
__device__ __forceinline__ void swa_naive(Frame& F, int wv, int nworkers) {
    const bf16* proj = (const bf16*)(F.ws + WS_PROJ); bf16* YSWA = (bf16*)(F.ws + WS_Y) + (size_t)M * SW_W;
    LAS float* qs = (LAS float*)(F.lds + RING_OFF + 65536 + F.wave * 1024); LAS float* ps = qs + 64;
    const float* qg = F.in[7]; const float* kg = F.in[8]; const float* sinks = F.in[9]; const float* relb = F.in[10];
    const int lane = F.lane;
    for (int task = wv; task < M * SW_H; task += nworkers) {
        const int m = task >> 3, qh = task & 7, kvh = qh >> 2, t = m & (SEQ - 1);
        const float q = bf1(proj[(size_t)m * NP + PC_SQ + qh * SW_D + lane]);
        const float qn = q * (1.0f / sqrtf(wave_sum(q * q) * (1.0f / SW_D) + EPS)) * qg[lane];
        qs[lane] = qn * kg[lane];
        LDS_WAIT(); asm volatile("" ::: "memory");
        float lg[2];
#pragma unroll
        for (int hf = 0; hf < 2; ++hf) { const int j = lane + 64 * hf; lg[hf] = -INFINITY;
            if (t - 127 + j >= 0) { const v4u* kr = (const v4u*)(proj + (size_t)(m - 127 + j) * NP + PC_SK + kvh * SW_D); float ssk = 0.f, dot = 0.f;
#pragma unroll
                for (int c = 0; c < 8; ++c) { const v4u w = kr[c];
#pragma unroll
                    for (int e = 0; e < 4; ++e) { const float k0 = bflo(w[e]), k1 = bfhi(w[e]); ssk += k0 * k0 + k1 * k1; dot += qs[8 * c + 2 * e] * k0 + qs[8 * c + 2 * e + 1] * k1; } }
                lg[hf] = dot * (1.0f / sqrtf(ssk * (1.0f / SW_D) + EPS)) * 0.125f + relb[(int)T5_BUCKET[127 - j] * SW_H + qh]; } }
        const float sink = sinks[qh];
        const float mx = fmaxf(wave_max(fmaxf(lg[0], lg[1])), sink);
        const float p0 = (lg[0] == -INFINITY) ? 0.f : __expf(lg[0] - mx), p1 = (lg[1] == -INFINITY) ? 0.f : __expf(lg[1] - mx);
        const float den = wave_sum(p0 + p1) + __expf(sink - mx);
        ps[lane] = p0; ps[lane + 64] = p1;
        LDS_WAIT(); asm volatile("" ::: "memory");
        float o = 0.f; const int jmin = (127 - t) > 0 ? (127 - t) : 0;
        for (int j = jmin; j < 128; ++j) o += ps[j] * bf1(proj[(size_t)(m - 127 + j) * NP + PC_SV + kvh * SW_D + lane]);
        YSWA[(size_t)m * SW_W + qh * SW_D + lane] = (bf16)f2bf(o / den);
        LDS_WAIT(); asm volatile("" ::: "memory");
    }
}
__device__ __forceinline__ void dn_out(Frame& F) {
    const int gw = F.vcu * NWAVES + F.wave, NGW = F.G * NWAVES;
    const bf16* proj = (const bf16*)(F.ws + WS_PROJ); const float* VV = (const float*)(F.ws + WS_XB); bf16* YDN = (bf16*)(F.ws + WS_Y); const float* gain = F.in[6];
    for (int task = gw; task < M * DN_H; task += NGW) {
        const int m = task >> 2, h = task & 3;
        const f32x2 o = *(const f32x2*)(VV + (size_t)m * DN_W + h * DN_D + 2 * F.lane);
        const float r = 1.0f / sqrtf(wave_sum(o.x * o.x + o.y * o.y) * (1.0f / DN_D) + EPS);
        const unsigned zw = *(const unsigned*)(proj + (size_t)m * NP + PC_Z + h * DN_D + 2 * F.lane); const float z0 = bflo(zw), z1 = bfhi(zw);
        *(unsigned*)(YDN + (size_t)m * DN_W + h * DN_D + 2 * F.lane) = pk2(o.x * r * gain[2 * F.lane] * z0 * sigm(z0), o.y * r * gain[2 * F.lane + 1] * z1 * sigm(z1));
    }
}

typedef short bf16x8 __attribute__((ext_vector_type(8)));
typedef float f32x16 __attribute__((ext_vector_type(16)));
typedef unsigned u32x2 __attribute__((ext_vector_type(2)));
typedef __bf16 bf16x2_t __attribute__((ext_vector_type(2)));
__device__ __forceinline__ unsigned cvtpk(float lo, float hi) { f32x2 v = {lo, hi}; return __builtin_bit_cast(unsigned, __builtin_convertvector(v, bf16x2_t)); }
__device__ __forceinline__ bf16x8 pack8(f32x4 a, f32x4 b) { v4u w; w.x = cvtpk(a[0], a[1]); w.y = cvtpk(a[2], a[3]); w.z = cvtpk(b[0], b[1]); w.w = cvtpk(b[2], b[3]); return __builtin_bit_cast(bf16x8, w); }
__device__ __forceinline__ bf16x8 pack8z(f32x4 a) { v4u w; w.x = cvtpk(a[0], a[1]); w.y = cvtpk(a[2], a[3]); w.z = 0u; w.w = 0u; return __builtin_bit_cast(bf16x8, w); }
#define MFMA16(a, b, c) __builtin_amdgcn_mfma_f32_16x16x32_bf16((a), (b), (c), 0, 0, 0)
#define MFMA32(a, b, c) __builtin_amdgcn_mfma_f32_32x32x16_bf16((a), (b), (c), 0, 0, 0)
constexpr float LOG2E = 1.4426950408889634f;

__device__ __forceinline__ void swa_pre(Frame& F) {
    const int gw = F.vcu * NWAVES + F.wave, NGW = F.G * NWAVES, lane = F.lane;
    const bf16* proj = (const bf16*)(F.ws + WS_PROJ);
    bf16* KS = (bf16*)(F.ws + WS_Y); bf16* VT = KS + 2 * 1024 * 1024; bf16* QS = (bf16*)(F.ws + WS_Y) + (size_t)M * SW_W;
    const float* qg = F.in[7]; const float* kg = F.in[8];
    for (int m = gw; m < M; m += NGW) {
        {
            const v4u w = *(const v4u*)(proj + (size_t)m * NP + PC_SQ + 8 * lane); float x[8];
#pragma unroll
            for (int j = 0; j < 4; ++j) { x[2 * j] = bflo(w[j]); x[2 * j + 1] = bfhi(w[j]); }
            float ss = 0.f;
#pragma unroll
            for (int j = 0; j < 8; ++j) ss += x[j] * x[j];
            ss += __shfl_xor(ss, 1); ss += __shfl_xor(ss, 2); ss += __shfl_xor(ss, 4);
            const float r = frsq(ss * (1.0f / SW_D) + EPS) * (0.125f * LOG2E);
            const f32x4 g0 = *(const f32x4*)(qg + 8 * (lane & 7)), g1 = *(const f32x4*)(qg + 8 * (lane & 7) + 4);
            v4u o; o.x = cvtpk(x[0] * r * g0[0], x[1] * r * g0[1]); o.y = cvtpk(x[2] * r * g0[2], x[3] * r * g0[3]); o.z = cvtpk(x[4] * r * g1[0], x[5] * r * g1[1]); o.w = cvtpk(x[6] * r * g1[2], x[7] * r * g1[3]);
            *(v4u*)(QS + (size_t)m * SW_W + 8 * lane) = o;
        }
        {
            const unsigned w = *(const unsigned*)(proj + (size_t)m * NP + PC_SK + 2 * lane); const float k0 = bflo(w), k1 = bfhi(w);
            float ss = k0 * k0 + k1 * k1;
#pragma unroll
            for (int o = 1; o < 32; o <<= 1) ss += __shfl_xor(ss, o);
            const float r = frsq(ss * (1.0f / SW_D) + EPS); const int d = 2 * (lane & 31), b = m >> 12, t = m & (SEQ - 1), kvh = lane >> 5;
            *(unsigned*)(KS + ((size_t)(b * 2 + kvh) * SEQ + t) * SW_D + d) = cvtpk(k0 * r * kg[d], k1 * r * kg[d + 1]);
        }
    }
    for (int task = gw; task < BATCH * SW_KV * (SEQ / 32); task += NGW) {
        const int bk = task >> 7, tile = task & 127, b = bk >> 1, kvh = bk & 1; const size_t m0 = (size_t)b * SEQ + tile * 32;
        unsigned v[32];
#pragma unroll
        for (int i = 0; i < 32; ++i) v[i] = proj[(m0 + i) * NP + PC_SV + kvh * SW_D + lane];
        bf16* dst = VT + ((size_t)(bk * 128 + tile) * 64 + lane) * 32;
#pragma unroll
        for (int q4 = 0; q4 < 4; ++q4) { v4u o;
#pragma unroll
            for (int jj = 0; jj < 4; ++jj) { const int p0 = 8 * q4 + 2 * jj, p1 = p0 + 1;
                const int k0 = 16 * (p0 >> 4) + 8 * ((p0 & 7) >> 2) + 4 * ((p0 >> 3) & 1) + (p0 & 3), k1 = 16 * (p1 >> 4) + 8 * ((p1 & 7) >> 2) + 4 * ((p1 >> 3) & 1) + (p1 & 3);
                o[jj] = v[k0] | (v[k1] << 16); }
            *(v4u*)(dst + 8 * q4) = o; }
    }
}
__device__ __forceinline__ void swa_bias_table(Frame& F) {
    LAS float* biasT = (LAS float*)(F.lds + RING_OFF);
    for (int idx = F.tid; idx < SW_H * 128; idx += NWAVES * 64) { const int h = idx >> 7, dist = idx & 127; biasT[idx] = F.in[10][(int)T5_BUCKET[dist] * SW_H + h] * LOG2E; }
}
__device__ __forceinline__ void swa_main(Frame& F, int worker, int nworkers) {
    const LAS float* biasT = (const LAS float*)(F.lds + RING_OFF);
    const bf16* KS = (const bf16*)(F.ws + WS_Y); const bf16* VT = KS + 2 * 1024 * 1024; bf16* QS = (bf16*)(F.ws + WS_Y) + (size_t)M * SW_W;
    const int lane = F.lane, l31 = lane & 31, hh = lane >> 5;
    for (int u = worker; u < BATCH * SW_H * (SEQ / 32); u += nworkers) {
        const int qblk = u & 127, h = (u >> 7) & 7, b = u >> 10, kvh = h >> 2, bk = b * 2 + kvh, q0 = qblk * 32; const size_t m0 = (size_t)b * SEQ + q0;
        bf16x8 qf[4];
#pragma unroll
        for (int ks = 0; ks < 4; ++ks) qf[ks] = *(const bf16x8*)(QS + (m0 + l31) * SW_W + h * SW_D + 16 * ks + 8 * hh);
        f32x16 s[5];
#pragma unroll
        for (int i = 0; i < 5; ++i) {
            const int ts = q0 - 128 + 32 * i;
            if (ts < 0) {
#pragma unroll
                for (int r = 0; r < 16; ++r) s[i][r] = -INFINITY;
            } else {
                f32x16 acc;
#pragma unroll
                for (int r = 0; r < 16; ++r) acc[r] = 0.f;
#pragma unroll
                for (int ks = 0; ks < 4; ++ks) { const bf16x8 kf = *(const bf16x8*)(KS + ((size_t)bk * SEQ + ts + l31) * SW_D + 16 * ks + 8 * hh); acc = MFMA32(kf, qf[ks], acc); }
#pragma unroll
                for (int r = 0; r < 16; ++r) { const int row = (r & 3) + 8 * (r >> 2) + 4 * hh, dist = 128 - 32 * i + l31 - row; const bool ok = dist >= 0 && dist <= 127;
                    s[i][r] = ok ? acc[r] + biasT[h * 128 + (dist & 127)] : -INFINITY; }
            }
        }
        const float sink2 = F.in[9][h] * LOG2E;
        float mx = sink2;
#pragma unroll
        for (int i = 0; i < 5; ++i)
#pragma unroll
            for (int r = 0; r < 16; ++r) mx = fmaxf(mx, s[i][r]);
        mx = fmaxf(mx, __shfl_xor(mx, 32));
        float sum = 0.f;
#pragma unroll
        for (int i = 0; i < 5; ++i)
#pragma unroll
            for (int r = 0; r < 16; ++r) { const float p = __builtin_amdgcn_exp2f(s[i][r] - mx); s[i][r] = p; sum += p; }
        sum += __shfl_xor(sum, 32);
        const float inv = __builtin_amdgcn_rcpf(sum + __builtin_amdgcn_exp2f(sink2 - mx));
        f32x16 O[2];
#pragma unroll
        for (int r = 0; r < 16; ++r) { O[0][r] = 0.f; O[1][r] = 0.f; }
#pragma unroll
        for (int i = 0; i < 5; ++i) {
            const int ts = q0 - 128 + 32 * i;
            if (ts >= 0) {
#pragma unroll
                for (int s2 = 0; s2 < 2; ++s2) {
                    v4u w; w.x = cvtpk(s[i][8 * s2] * inv, s[i][8 * s2 + 1] * inv); w.y = cvtpk(s[i][8 * s2 + 2] * inv, s[i][8 * s2 + 3] * inv); w.z = cvtpk(s[i][8 * s2 + 4] * inv, s[i][8 * s2 + 5] * inv); w.w = cvtpk(s[i][8 * s2 + 6] * inv, s[i][8 * s2 + 7] * inv);
                    const bf16x8 pa = __builtin_bit_cast(bf16x8, w);
#pragma unroll
                    for (int nt = 0; nt < 2; ++nt) { const bf16x8 vf = *(const bf16x8*)(VT + ((size_t)(bk * 128 + (ts >> 5)) * 64 + 32 * nt + l31) * 32 + s2 * 16 + hh * 8); O[nt] = MFMA32(pa, vf, O[nt]); }
                }
            }
        }
#pragma unroll
        for (int nt = 0; nt < 2; ++nt)
#pragma unroll
            for (int r = 0; r < 16; ++r) { const int q = (r & 3) + 8 * (r >> 2) + 4 * hh; QS[(m0 + q) * SW_W + h * SW_D + 32 * nt + l31] = (bf16)(cvtpk(O[nt][r], 0.f) & 0xffffu); }
    }
}

constexpr int DNL_QT = 0, DNL_KT = 17408, DNL_VT = 34816, DNL_WL = 52224, DNL_NA = 69632, DNL_QKM = 78848, DNL_DB = 88064, DNL_TIB = 92160, DNL_GC = 94208, DNL_BETA = 94464;
constexpr int TP = 272;
constexpr int NP2 = 144;
struct DnRec { float* U; bf16* W; bf16* QG; bf16* KD; bf16* QK; float* EGL; };
__device__ __forceinline__ DnRec dn_rec(Frame& F) {
    DnRec r; r.U = (float*)(F.ws + WS_XB); r.W = (bf16*)F.out; r.QG = r.W + 8 * 1024 * 1024; r.KD = r.W + 16 * 1024 * 1024; r.QK = r.W + 24 * 1024 * 1024; r.EGL = (float*)(F.ws + WS_SSQ); return r;
}
__device__ __forceinline__ void dn_chunk_prep(Frame& F) {
    const DnRec R = dn_rec(F);
    const bf16* proj = (const bf16*)(F.ws + WS_PROJ); const float* conv = F.in[3]; const float* gbp = (const float*)(F.ws + WS_GB);
    LAS unsigned char* L = F.lds + RING_OFF;
    LAS float* GC = (LAS float*)(L + DNL_GC); LAS float* BETA = (LAS float*)(L + DNL_BETA); LAS float* DB = (LAS float*)(L + DNL_DB);
    const int lane = F.lane, wave = F.wave, r16 = lane & 15, g = lane >> 4;
    for (int ch = F.vcu; ch < 1024; ch += F.G) {
        const int bh = ch >> 6, c = ch & 63, b = bh >> 2, h = bh & 3; const size_t m0 = (size_t)b * SEQ + 64 * c;
        {
            float x = gbp[(m0 + lane) * 8 + 4 + h]; const float bl = gbp[(m0 + lane) * 8 + h];
#pragma unroll
            for (int off = 1; off < 64; off <<= 1) { const float t = __shfl_up(x, off); if (lane >= off) x += t; }
            if (wave == 0) { GC[lane] = x; BETA[lane] = bl; }
            const int tk0 = 8 * wave;
            unsigned raw[3][11]; float cw[3][4][2];
#pragma unroll
            for (int p = 0; p < 3; ++p) { const int col = p * DN_W + h * DN_D + 2 * lane;
#pragma unroll
                for (int r = 0; r < 11; ++r) raw[p][r] = (64 * c + tk0 - 3 + r >= 0) ? *(const unsigned*)(proj + (m0 + tk0 - 3 + r) * NP + col) : 0u;
#pragma unroll
                for (int j = 0; j < 4; ++j) { cw[p][j][0] = conv[j * DN_QKV + col]; cw[p][j][1] = conv[j * DN_QKV + col + 1]; } }
            float val[8][3][2], sq[8], sk[8];
#pragma unroll
            for (int i = 0; i < 8; ++i) {
#pragma unroll
                for (int p = 0; p < 3; ++p) { float a0 = 0.f, a1 = 0.f;
#pragma unroll
                    for (int j = 0; j < 4; ++j) { a0 += cw[p][j][0] * bflo(raw[p][i + j]); a1 += cw[p][j][1] * bfhi(raw[p][i + j]); }
                    val[i][p][0] = a0 * sigm(a0); val[i][p][1] = a1 * sigm(a1); }
                sq[i] = val[i][0][0] * val[i][0][0] + val[i][0][1] * val[i][0][1]; sk[i] = val[i][1][0] * val[i][1][0] + val[i][1][1] * val[i][1][1]; }
#pragma unroll
            for (int o = 1; o < 64; o <<= 1) {
#pragma unroll
                for (int i = 0; i < 8; ++i) { sq[i] += __shfl_xor(sq[i], o); sk[i] += __shfl_xor(sk[i], o); } }
#pragma unroll
            for (int i = 0; i < 8; ++i) {
                const float rq = frsq(sq[i] + EPS) * 0.08838834764831845f, rk = frsq(sk[i] + EPS);
                const int o = (tk0 + i) * TP + 4 * lane;
                *(LAS unsigned*)(L + DNL_QT + o) = cvtpk(val[i][0][0] * rq, val[i][0][1] * rq);
                *(LAS unsigned*)(L + DNL_KT + o) = cvtpk(val[i][1][0] * rk, val[i][1][1] * rk);
                *(LAS unsigned*)(L + DNL_VT + o) = cvtpk(val[i][2][0], val[i][2][1]);
            }
        }
        __syncthreads();
        for (int id = wave; id < 20; id += 8) {
            const int e = id % 10, isqk = id / 10, ti = (e >= 6) ? 3 : (e >= 3) ? 2 : (e >= 1) ? 1 : 0, tj = e - ti * (ti + 1) / 2;
            f32x4 acc = {0.f, 0.f, 0.f, 0.f};
            const int xoff = isqk ? DNL_QT : DNL_KT;
#pragma unroll
            for (int ks = 0; ks < 4; ++ks) {
                const bf16x8 a = *(const LAS bf16x8*)(L + DNL_KT + (16 * tj + r16) * TP + (32 * ks + 8 * g) * 2);
                const bf16x8 bq = *(const LAS bf16x8*)(L + xoff + (16 * ti + r16) * TP + (32 * ks + 8 * g) * 2);
                acc = MFMA16(a, bq, acc); }
            const int i = 16 * ti + r16; const float gi = GC[i], bi = BETA[i]; const f32x4 gj = *(const LAS f32x4*)(GC + 16 * tj + 4 * g);
            f32x4 v;
#pragma unroll
            for (int r = 0; r < 4; ++r) { const int jp = 16 * tj + 4 * g + r; const float d = __expf(fminf(gi - gj[r], 0.f));
                v[r] = isqk ? ((i >= jp) ? acc[r] * d : 0.f) : ((i > jp) ? bi * acc[r] * d : 0.f); }
            if (!isqk) {
                u32x2 w; w.x = cvtpk(-v[0], -v[1]); w.y = cvtpk(-v[2], -v[3]);
                *(LAS u32x2*)(L + DNL_NA + i * NP2 + (16 * tj + 4 * g) * 2) = w;
                if (ti == tj) *(LAS f32x4*)(DB + (ti * 16 + r16) * 16 + 4 * g) = v;
            } else { u32x2 w; w.x = cvtpk(v[0], v[1]); w.y = cvtpk(v[2], v[3]); *(LAS u32x2*)(L + DNL_QKM + i * NP2 + (16 * tj + 4 * g) * 2) = w; }
        }
        __syncthreads();
        if (wave < 4) {
            const int I = wave; float x[16];
#pragma unroll
            for (int i = 0; i < 16; ++i) { float a = (i == r16) ? 1.f : 0.f;
#pragma unroll
                for (int j4 = 0; j4 < (i + 3) / 4; ++j4) { const f32x4 d = *(const LAS f32x4*)(DB + (I * 16 + i) * 16 + 4 * j4);
#pragma unroll
                    for (int jj = 0; jj < 4; ++jj) if (4 * j4 + jj < i) a -= d[jj] * x[4 * j4 + jj]; }
                x[i] = a; }
            if (lane < 16) {
#pragma unroll
                for (int i = 0; i < 16; ++i) *(LAS unsigned short*)(L + DNL_TIB + ((I * 16 + i) * 16 + r16) * 2) = (unsigned short)(cvtpk(x[i], 0.f) & 0xffffu);
            }
        }
        __syncthreads();
        {
            const int part = wave >> 2, colbase = 32 * (wave & 3);
            f32x4 X[2][4];
#pragma unroll
            for (int I = 0; I < 4; ++I)
#pragma unroll
                for (int nt = 0; nt < 2; ++nt) {
                    const int col = colbase + 16 * nt + r16;
                    f32x4 acc;
#pragma unroll
                    for (int r = 0; r < 4; ++r) { const int tok = 16 * I + 4 * g + r;
                        acc[r] = part == 0 ? BETA[tok] * bf1(*(const LAS unsigned short*)(L + DNL_VT + tok * TP + col * 2))
                                           : -(BETA[tok] * __expf(GC[tok])) * bf1(*(const LAS unsigned short*)(L + DNL_KT + tok * TP + col * 2)); }
                    if (I >= 1) {
                        const u32x2 lo = *(const LAS u32x2*)(L + DNL_NA + (16 * I + r16) * NP2 + (4 * g) * 2);
                        u32x2 hi = {0u, 0u}; if (I >= 2) hi = *(const LAS u32x2*)(L + DNL_NA + (16 * I + r16) * NP2 + (16 + 4 * g) * 2);
                        const v4u aw = {lo.x, lo.y, hi.x, hi.y};
                        const bf16x8 bb = (I >= 2) ? pack8(X[nt][0], X[nt][1]) : pack8z(X[nt][0]);
                        acc = MFMA16(__builtin_bit_cast(bf16x8, aw), bb, acc);
                    }
                    if (I == 3) {
                        const u32x2 lo = *(const LAS u32x2*)(L + DNL_NA + (16 * I + r16) * NP2 + (32 + 4 * g) * 2);
                        const v4u aw = {lo.x, lo.y, 0u, 0u};
                        acc = MFMA16(__builtin_bit_cast(bf16x8, aw), pack8z(X[nt][2]), acc);
                    }
                    const u32x2 tl = *(const LAS u32x2*)(L + DNL_TIB + ((I * 16 + r16) * 16 + 4 * g) * 2);
                    const v4u tw = {tl.x, tl.y, 0u, 0u};
                    const f32x4 zero = {0.f, 0.f, 0.f, 0.f};
                    X[nt][I] = MFMA16(__builtin_bit_cast(bf16x8, tw), pack8z(acc), zero);
                    if (part == 0) *(f32x4*)(R.U + ((size_t)(ch * 8 + 2 * (wave & 3) + nt) * 4 + I) * 256 + lane * 4) = X[nt][I];
                    else {
#pragma unroll
                        for (int r = 0; r < 4; ++r) *(LAS unsigned short*)(L + DNL_WL + (16 * I + 4 * g + r) * TP + col * 2) = (unsigned short)(cvtpk(X[nt][I][r], 0.f) & 0xffffu);
                    }
                }
        }
        __syncthreads();
        for (int it = wave; it < 54; it += 8) {
            if (it < 32) {
                const int f = it & 15, mt = f >> 2, ks = f & 3, base = (it < 16 ? DNL_WL : DNL_QT) + (16 * mt + r16) * TP;
                const u32x2 lo = *(const LAS u32x2*)(L + base + (32 * ks + 4 * g) * 2), hi = *(const LAS u32x2*)(L + base + (32 * ks + 16 + 4 * g) * 2);
                v4u w = {lo.x, lo.y, hi.x, hi.y};
                if (it >= 16) { const float e = __expf(GC[16 * mt + r16]);
#pragma unroll
                    for (int j = 0; j < 4; ++j) w[j] = cvtpk(bflo(w[j]) * e, bfhi(w[j]) * e); }
                *(v4u*)((it < 16 ? R.W : R.QG) + ((size_t)(ch * 16 + f) * 64 + lane) * 8) = w;
            } else if (it < 48) {
                const int f = it - 32, mt8 = f >> 1, kt = f & 1, dk = 16 * mt8 + r16; const float gl = GC[63];
                float v[8];
#pragma unroll
                for (int j = 0; j < 8; ++j) { const int tok = 32 * kt + (j < 4 ? 4 * g + j : 16 + 4 * g + j - 4); v[j] = bf1(*(const LAS unsigned short*)(L + DNL_KT + tok * TP + dk * 2)) * __expf(gl - GC[tok]); }
                v4u w; w.x = cvtpk(v[0], v[1]); w.y = cvtpk(v[2], v[3]); w.z = cvtpk(v[4], v[5]); w.w = cvtpk(v[6], v[7]);
                *(v4u*)(R.KD + ((size_t)(ch * 16 + f) * 64 + lane) * 8) = w;
            } else {
                const int q = it - 48, mt = (q == 0) ? 0 : (q == 1) ? 1 : (q < 4) ? 2 : 3, kt = (q == 3 || q == 5) ? 1 : 0;
                const u32x2 lo = *(const LAS u32x2*)(L + DNL_QKM + (16 * mt + r16) * NP2 + (32 * kt + 4 * g) * 2);
                u32x2 hi = {0u, 0u}; if (2 * kt + 1 <= mt) hi = *(const LAS u32x2*)(L + DNL_QKM + (16 * mt + r16) * NP2 + (32 * kt + 16 + 4 * g) * 2);
                const v4u w = {lo.x, lo.y, hi.x, hi.y};
                *(v4u*)(R.QK + ((size_t)(ch * 8 + mt * 2 + kt) * 64 + lane) * 8) = w;
            }
        }
        if (F.tid == 0) R.EGL[ch] = __expf(GC[63]);
        __syncthreads();
    }
}
__device__ __forceinline__ void dn_scan(Frame& F, int task) {
    const DnRec R = dn_rec(F);
    const int bh = task >> 3, sl = task & 7, lane = F.lane;
    f32x4 S[8];
#pragma unroll
    for (int i = 0; i < 8; ++i) S[i] = (f32x4){0.f, 0.f, 0.f, 0.f};
    bf16x8 Wf[16]; f32x4 Uf[4];
    {
        const int ch = bh * 64;
#pragma unroll
        for (int f = 0; f < 16; ++f) Wf[f] = *(const bf16x8*)(R.W + ((size_t)(ch * 16 + f) * 64 + lane) * 8);
#pragma unroll
        for (int mt = 0; mt < 4; ++mt) Uf[mt] = *(const f32x4*)(R.U + ((size_t)(ch * 8 + sl) * 4 + mt) * 256 + lane * 4);
    }
    for (int c = 0; c < 64; ++c) {
        const int ch = bh * 64 + c;
        bf16x8 QGf[16];
#pragma unroll
        for (int f = 0; f < 16; ++f) QGf[f] = *(const bf16x8*)(R.QG + ((size_t)(ch * 16 + f) * 64 + lane) * 8);
        bf16x8 Sb[4];
#pragma unroll
        for (int ks = 0; ks < 4; ++ks) Sb[ks] = pack8(S[2 * ks], S[2 * ks + 1]);
        f32x4 vn[4];
#pragma unroll
        for (int mt = 0; mt < 4; ++mt) { vn[mt] = Uf[mt];
#pragma unroll
            for (int ks = 0; ks < 4; ++ks) vn[mt] = MFMA16(Wf[mt * 4 + ks], Sb[ks], vn[mt]); }
        bf16x8 QKf[8], KDf[16];
        QKf[0] = *(const bf16x8*)(R.QK + ((size_t)(ch * 8 + 0) * 64 + lane) * 8); QKf[2] = *(const bf16x8*)(R.QK + ((size_t)(ch * 8 + 2) * 64 + lane) * 8);
#pragma unroll
        for (int f = 4; f < 8; ++f) QKf[f] = *(const bf16x8*)(R.QK + ((size_t)(ch * 8 + f) * 64 + lane) * 8);
#pragma unroll
        for (int f = 0; f < 16; ++f) KDf[f] = *(const bf16x8*)(R.KD + ((size_t)(ch * 16 + f) * 64 + lane) * 8);
        const float egl = R.EGL[ch];
        f32x4 o[4];
#pragma unroll
        for (int mt = 0; mt < 4; ++mt) { o[mt] = (f32x4){0.f, 0.f, 0.f, 0.f};
#pragma unroll
            for (int ks = 0; ks < 4; ++ks) o[mt] = MFMA16(QGf[mt * 4 + ks], Sb[ks], o[mt]); }
        const bf16x8 vb0 = pack8(vn[0], vn[1]), vb1 = pack8(vn[2], vn[3]);
        if (c + 1 < 64) {
#pragma unroll
            for (int f = 0; f < 16; ++f) Wf[f] = *(const bf16x8*)(R.W + ((size_t)((ch + 1) * 16 + f) * 64 + lane) * 8);
#pragma unroll
            for (int mt = 0; mt < 4; ++mt) Uf[mt] = *(const f32x4*)(R.U + ((size_t)((ch + 1) * 8 + sl) * 4 + mt) * 256 + lane * 4);
        }
        o[0] = MFMA16(QKf[0], vb0, o[0]); o[1] = MFMA16(QKf[2], vb0, o[1]);
        o[2] = MFMA16(QKf[4], vb0, o[2]); o[2] = MFMA16(QKf[5], vb1, o[2]);
        o[3] = MFMA16(QKf[6], vb0, o[3]); o[3] = MFMA16(QKf[7], vb1, o[3]);
#pragma unroll
        for (int i = 0; i < 8; ++i) { S[i] = S[i] * egl; S[i] = MFMA16(KDf[2 * i], vb0, S[i]); S[i] = MFMA16(KDf[2 * i + 1], vb1, S[i]); }
#pragma unroll
        for (int mt = 0; mt < 4; ++mt) *(f32x4*)(R.U + ((size_t)(ch * 8 + sl) * 4 + mt) * 256 + lane * 4) = o[mt];
    }
}
__device__ __forceinline__ void dn_out2(Frame& F) {
    const DnRec R = dn_rec(F);
    const int gw = F.vcu * NWAVES + F.wave, NGW = F.G * NWAVES, lane = F.lane, r16 = lane & 15, g = lane >> 4;
    const bf16* proj = (const bf16*)(F.ws + WS_PROJ); bf16* YDN = (bf16*)(F.ws + WS_Y); const float* gain = F.in[6];
    for (int task = gw; task < 4096; task += NGW) {
        const int ch = task >> 2, mt = task & 3, bh = ch >> 6, c = ch & 63, b = bh >> 2, h = bh & 3;
        f32x4 o[8]; float ss[4] = {0.f, 0.f, 0.f, 0.f};
#pragma unroll
        for (int sl = 0; sl < 8; ++sl) { o[sl] = *(const f32x4*)(R.U + ((size_t)(ch * 8 + sl) * 4 + mt) * 256 + lane * 4);
#pragma unroll
            for (int r = 0; r < 4; ++r) ss[r] += o[sl][r] * o[sl][r]; }
#pragma unroll
        for (int r = 0; r < 4; ++r) { float s = ss[r]; s += __shfl_xor(s, 1); s += __shfl_xor(s, 2); s += __shfl_xor(s, 4); s += __shfl_xor(s, 8); ss[r] = frsq(s * (1.0f / DN_D) + EPS); }
#pragma unroll
        for (int sl = 0; sl < 8; ++sl) { const int d = 16 * sl + r16; const float gd = gain[d];
#pragma unroll
            for (int r = 0; r < 4; ++r) { const size_t m = (size_t)b * SEQ + 64 * c + 16 * mt + 4 * g + r; const float z = bf1(proj[m * NP + PC_Z + h * DN_D + d]);
                YDN[m * DN_W + h * DN_D + d] = (bf16)(cvtpk(o[sl][r] * ss[r] * gd * z * sigm(z), 0.f) & 0xffffu); } }
    }
}
__device__ __forceinline__ void run_phase0(Frame& F) {
    unsigned char* ws = F.ws; bf16* XB = (bf16*)(ws + WS_XB); bf16* Y = (bf16*)(ws + WS_Y); bf16* PROJ = (bf16*)(ws + WS_PROJ); (void)XB; (void)Y; (void)PROJ;
        p0_prologue(F);
}
__device__ __forceinline__ void run_phase1(Frame& F) {
    unsigned char* ws = F.ws; bf16* XB = (bf16*)(ws + WS_XB); bf16* Y = (bf16*)(ws + WS_Y); bf16* PROJ = (bf16*)(ws + WS_PROJ); (void)XB; (void)Y; (void)PROJ;
        pg8::Gemm g{XB, (const bf16*)(ws + WS_WIN), M, NP, D}; pg8::StaticOrder S; S.init(M, NP, F.G, (int)blockIdx.x);
        pg8::EpiProj E{PROJ, NP, (const float*)(ws + WS_RSTD), PC_G / 256};
        pg8::gemm_phase<pg8::EpiProj, pg8::StaticOrder, true, true>(F.lds + RING_OFF, g, S, E);
}
__device__ __forceinline__ void run_phase2(Frame& F) {
    unsigned char* ws = F.ws; bf16* XB = (bf16*)(ws + WS_XB); bf16* Y = (bf16*)(ws + WS_Y); bf16* PROJ = (bf16*)(ws + WS_PROJ); (void)XB; (void)Y; (void)PROJ;
#if FAST_DN
        for (int rep_ = 0; rep_ < REP_DNA; ++rep_) dn_chunk_prep(F);
#else
        dn_pre(F);
#endif
#if FAST_SWA
        for (int rep_ = 0; rep_ < REP_SWAPRE; ++rep_) swa_pre(F);
#endif
}
__device__ __forceinline__ void run_phase3(Frame& F) {
    unsigned char* ws = F.ws; bf16* XB = (bf16*)(ws + WS_XB); bf16* Y = (bf16*)(ws + WS_Y); bf16* PROJ = (bf16*)(ws + WS_PROJ); (void)XB; (void)Y; (void)PROJ;
#if FAST_DN
        swa_bias_table(F); __syncthreads();
        {
            const int nscan = F.G < 128 ? F.G : 128;
            if (F.wave == 0 && F.vcu < nscan) { for (int task = F.vcu; task < 128; task += nscan) dn_scan(F, task); }
            else { const int worker = F.vcu < nscan ? F.vcu * 7 + F.wave - 1 : nscan * 7 + (F.vcu - nscan) * 8 + F.wave; swa_main(F, worker, nscan * 7 + (F.G - nscan) * 8); }
        }
#elif FAST_SWA
        if (F.vcu < 16) dn_scan_naive(F, F.vcu);
        else { swa_bias_table(F); __syncthreads(); swa_main(F, (F.vcu - 16) * NWAVES + F.wave, (F.G - 16) * NWAVES); }
#else
        if (F.G > 16) { if (F.vcu < 16) dn_scan_naive(F, F.vcu); else swa_naive(F, (F.vcu - 16) * NWAVES + F.wave, (F.G - 16) * NWAVES); }
        else { for (int bh = F.vcu; bh < 16; bh += F.G) dn_scan_naive(F, bh); swa_naive(F, F.vcu * NWAVES + F.wave, F.G * NWAVES); }
#endif
}
__device__ __forceinline__ void run_phase4(Frame& F) {
    unsigned char* ws = F.ws; bf16* XB = (bf16*)(ws + WS_XB); bf16* Y = (bf16*)(ws + WS_Y); bf16* PROJ = (bf16*)(ws + WS_PROJ); (void)XB; (void)Y; (void)PROJ;
#if FAST_DN
        dn_out2(F);
#else
        dn_out(F);
#endif
}
__device__ __forceinline__ void run_phase5(Frame& F) {
    unsigned char* ws = F.ws; bf16* XB = (bf16*)(ws + WS_XB); bf16* Y = (bf16*)(ws + WS_Y); bf16* PROJ = (bf16*)(ws + WS_PROJ); (void)XB; (void)Y; (void)PROJ;
        pg8::Gemm g{Y, (const bf16*)(ws + WS_WAB), 2 * M, 2 * D, DN_W}; pg8::PairedOrder S; S.init(M, D, F.G, (int)blockIdx.x);
        pg8::EpiMerge E{PROJ + PC_G, NP, XB, D, M / 256, D / 256};
        pg8::gemm_phase<pg8::EpiMerge, pg8::PairedOrder, false, true>(F.lds + RING_OFF, g, S, E);
}
__device__ __forceinline__ void run_phase6(Frame& F) {
    unsigned char* ws = F.ws; bf16* XB = (bf16*)(ws + WS_XB); bf16* Y = (bf16*)(ws + WS_Y); bf16* PROJ = (bf16*)(ws + WS_PROJ); (void)XB; (void)Y; (void)PROJ;
        pg8::Gemm g{XB, (const bf16*)(ws + WS_WOUT), M, D, D}; pg8::StaticOrder S; S.init(M, D, F.G, (int)blockIdx.x);
        pg8::EpiX1 E{F.in[0], F.out, Y, (float*)(ws + WS_SSQ), D};
        pg8::gemm_phase<pg8::EpiX1, pg8::StaticOrder, false, true>(F.lds + RING_OFF, g, S, E);
}
__device__ __forceinline__ void run_phase7(Frame& F) {
    unsigned char* ws = F.ws; bf16* XB = (bf16*)(ws + WS_XB); bf16* Y = (bf16*)(ws + WS_Y); bf16* PROJ = (bf16*)(ws + WS_PROJ); (void)XB; (void)Y; (void)PROJ;
        pg8::Gemm g{Y, (const bf16*)(ws + WS_WGU), M, 2 * FF, D}; pg8::StaticOrder S; S.init(M, 2 * FF, F.G, (int)blockIdx.x);
        pg8::EpiSwiGLU E{PROJ, FF, (const float*)(ws + WS_SSQ), EPS};
        pg8::gemm_phase<pg8::EpiSwiGLU, pg8::StaticOrder, true, true>(F.lds + RING_OFF, g, S, E);
}
__device__ __forceinline__ void run_phase8(Frame& F) {
    unsigned char* ws = F.ws; bf16* XB = (bf16*)(ws + WS_XB); bf16* Y = (bf16*)(ws + WS_Y); bf16* PROJ = (bf16*)(ws + WS_PROJ); (void)XB; (void)Y; (void)PROJ;
        pg8::Gemm g{PROJ, (const bf16*)(ws + WS_WD), M, D, FF}; pg8::StaticOrder S; S.init(M, D, F.G, (int)blockIdx.x);
        pg8::EpiOut E{F.out, D};
        pg8::gemm_phase<pg8::EpiOut, pg8::StaticOrder, false, true>(F.lds + RING_OFF, g, S, E);
}
#ifndef PROGRAM
#define PROGRAM RUN(0) BAR RUN(1) BAR RUN(2) BAR RUN(3) BAR RUN(4) BAR RUN(5) BAR RUN(6) BAR RUN(7) BAR RUN(8)
#endif
struct Args { const float* in[18]; float* out; unsigned char* ws; int ph_lo, ph_hi, li, pad; };
__global__ void __launch_bounds__(NWAVES * 64, 2) fwd_kernel(Args args) {
    extern __shared__ __attribute__((aligned(16))) unsigned char lds[];
    Frame F;
    F.lds = (LAS unsigned char*)lds;
    F.MISC = (volatile LAS unsigned*)(F.lds + MISC_OFF);
    F.tid = threadIdx.x; F.lane = F.tid & 63; F.wave = __builtin_amdgcn_readfirstlane(F.tid >> 6);
    F.G = gridDim.x; { const int bx = blockIdx.x; F.vcu = (F.G % 8 == 0) ? (bx % 8) * (F.G / 8) + bx / 8 : bx; }
#pragma unroll
    for (int i = 0; i < 18; ++i) F.in[i] = args.in[i];
    F.out = args.out; F.ws = args.ws; unsigned char* ws = args.ws;
    F.ctl = (gu32*)(ws + WS_CTL);
    for (int u = F.tid; u < (LDS_BYTES - LDSCTL_OFF) / 4; u += NWAVES * 64) ((LAS unsigned*)(F.lds + LDSCTL_OFF))[u] = 0u;
    __syncthreads();
    XcdBarrier bar; bar.bar = (unsigned*)(F.ctl + CW_BAR) + args.li * XCD_BAR_WORDS; bar.x = 0; bar.st = nullptr;
    bar = xcd_barrier_post((unsigned*)(F.ctl + CW_BAR) + args.li * XCD_BAR_WORDS, F.MISC + 8);
#define RUN(k) run_phase##k(F);
#define BAR xcd_barrier(bar);
    PROGRAM
#undef RUN
#undef BAR
}

extern "C" void kernel_launch(void* const* d_in, const int* in_sizes, int n_in, void* d_out, int out_size, void* d_ws, size_t ws_size, hipStream_t stream) {
    static int grid = 0;
    if (grid == 0) {
        if (n_in != 18 || in_sizes[0] != M * D || out_size != M * D || ws_size < WS_END) { fprintf(stderr, "kernel_launch: unexpected shapes (n_in %d, in0 %d, out %d, ws %zu)\n", n_in, n_in > 0 ? in_sizes[0] : -1, out_size, ws_size); grid = -1; return; }
        int dev = 0, cus = 0;
        if (hipGetDevice(&dev) != hipSuccess || hipDeviceGetAttribute(&cus, hipDeviceAttributeMultiprocessorCount, dev) != hipSuccess) { grid = -1; return; }
        if (hipFuncSetAttribute((const void*)fwd_kernel, hipFuncAttributeMaxDynamicSharedMemorySize, LDS_BYTES) != hipSuccess) { fprintf(stderr, "kernel_launch: hipFuncSetAttribute failed\n"); grid = -1; return; }
        int per_cu = 0;
        if (hipOccupancyMaxActiveBlocksPerMultiprocessor(&per_cu, (const void*)fwd_kernel, NWAVES * 64, LDS_BYTES) != hipSuccess || per_cu < 1) fprintf(stderr, "kernel_launch: occupancy query reports %d\n", per_cu);
        (void)hipGetLastError();
        grid = cus;
    }
    if (grid < 0) return;
    if (hipMemsetAsync((char*)d_ws + WS_CTL, 0, CTL_ZERO_BYTES, stream) != hipSuccess) return;
    Args a{};
    for (int i = 0; i < 18; ++i) a.in[i] = (const float*)d_in[i];
    a.out = (float*)d_out; a.ws = (unsigned char*)d_ws;
    for (int li = 0; li < 1; ++li) {
        a.ph_lo = 0; a.ph_hi = 0;
        a.li = li;
        hipLaunchKernelGGL(fwd_kernel, dim3(grid), dim3(NWAVES * 64), LDS_BYTES, stream, a);
        const hipError_t le = hipPeekAtLastError();
        if (le != hipSuccess) { fprintf(stderr, "kernel_launch: launch %d failed: %s\n", li, hipGetErrorName(le)); break; }
    }
}
```

```cpp
#ifndef FAST_SWA
#define FAST_SWA 1
#endif
#ifndef FAST_DN
#define FAST_DN 1
#endif
#ifndef REP_DNA
#define REP_DNA 1
#endif
#ifndef REP_SWAPRE
#define REP_SWAPRE 1
#endif
#ifndef REP_S1
#define REP_S1 1
#endif
#ifndef REP_S2
#define REP_S2 1
#endif
#ifndef REP_S3A
#define REP_S3A 1
#endif
#ifndef REP_S3B
#define REP_S3B 1
#endif
#ifndef REP_S4
#define REP_S4 1
#endif
#ifndef S1_RELOAD
#define S1_RELOAD 0
#endif
#ifndef S1_OPAQUE
#define S1_OPAQUE 0
#endif
#ifndef P1_TILES
#define P1_TILES 12
#endif
#include <hip/hip_runtime.h>
#include <cstdio>
#include <cstdint>

#ifndef EPI_REP
#define EPI_REP 1
#endif
#ifndef EPI_REP_WHICH
#define EPI_REP_WHICH 0
#endif
namespace pg8 {
#define PG8_LAS __attribute__((address_space(3)))
typedef unsigned short bf16_t;
typedef short bf16x8 __attribute__((ext_vector_type(8)));
typedef float f32x4 __attribute__((ext_vector_type(4)));
typedef unsigned u32x4 __attribute__((ext_vector_type(4)));
typedef unsigned u32x2 __attribute__((ext_vector_type(2)));
constexpr int BM = 256, BK = 64, HALF = 128, HTB = HALF * BK * 2  , STAGE_BYTES = 8 * HTB, NXCD = 8, WGM = 8;

__host__ __device__ __forceinline__ int lds_byte(int r, int c) { const int st = (r >> 4) * 2 + (c >> 5), rr = r & 15, cc = c & 31, ob = rr * 64 + cc * 2; return st * 1024 + (ob ^ (((ob >> 9) & 1) << 5)); }
__host__ __device__ __forceinline__ void stage_rc(int b, int& R, int& C) { const int st = b / 1024, sb = b % 1024, swz = sb ^ (((sb >> 9) & 1) << 5); R = (st >> 1) * 16 + swz / 64; C = (st & 1) * 32 + (swz % 64) / 2; }
__host__ __device__ __forceinline__ int perm32(int rho) { const int n = rho >> 4, i = rho & 15; return 8 * (i >> 2) + 4 * n + (i & 3); }

struct Unit { int pm, pn; };
struct Gemm { const bf16_t* A; const bf16_t* Bt; int M, N, K; };

struct StaticOrder {
    int nM, nN, nwg, G, c;
    __host__ __device__ void init(int M, int N, int G_, int c_) { nM = M / BM; nN = N / BM; nwg = nM * nN; G = G_; c = c_; }
    __host__ __device__ bool next(int i, Unit& u) const {
        const long L = (long)i * G + c; if (L >= nwg) return false;
        int wgid = (int)L; { const int q = nwg / NXCD, r = nwg % NXCD, xcd = wgid % NXCD, off = wgid / NXCD; wgid = (xcd < r ? xcd * (q + 1) : r * (q + 1) + (xcd - r) * q) + off; }
        const int nig = WGM * nN, gid = wgid / nig, fm = gid * WGM, gsz = (nM - fm) < WGM ? (nM - fm) : WGM;
        u.pm = fm + ((wgid % nig) % gsz); u.pn = (wgid % nig) / gsz; return true;
    }
    __device__ __forceinline__ void a_ready(const Unit&) const {}
    __device__ __forceinline__ void done(const Unit&) const {}
};
struct PairedOrder {
    StaticOrder so;
    __host__ __device__ void init(int M, int N, int G_, int c_) { so.init(M, N, G_, c_); }
    __host__ __device__ bool next(int i, Unit& u) const { if (!so.next(i >> 1, u)) return false; if (i & 1) { u.pm += so.nM; u.pn += so.nN; } return true; }
    __device__ __forceinline__ void a_ready(const Unit&) const {}
    __device__ __forceinline__ void done(const Unit&) const {}
};

__device__ __forceinline__ unsigned cvt_pk_bf16(float lo, float hi) { unsigned r; asm volatile("v_cvt_pk_bf16_f32 %0, %1, %2" : "=v"(r) : "v"(lo), "v"(hi)); return r; }
__device__ __forceinline__ float bf_lo(unsigned w) { return __builtin_bit_cast(float, w << 16); }
__device__ __forceinline__ float bf_hi(unsigned w) { return __builtin_bit_cast(float, w & 0xffff0000u); }
__device__ __forceinline__ float sigmoidf_(float x) { return 1.0f / (1.0f + __expf(-x)); }


struct EpiProj {
    static constexpr bool PERM = true, AFTER_DRAIN = false, PROBE_REP = (EPI_REP_WHICH == 1);
    bf16_t* O; int ldc; const float* rstd; int gate_pn0, pn_off;
    __device__ __forceinline__ bool keep(const Unit&) const { return false; }
    __device__ __forceinline__ void operator()(f32x4 (&acc)[2][2][4][2], const Unit& u, int wr, int wc, int fr, int fq) const {
        const int row0 = u.pm * BM + wr * 64 + fr, col0 = (u.pn + pn_off) * BM + wc * 32 + 8 * fq; const bool gate = (u.pn + pn_off) >= gate_pn0;
#pragma unroll
        for (int ai = 0; ai < 2; ++ai)
#pragma unroll
            for (int m = 0; m < 4; ++m) { const int row = row0 + ai * HALF + m * 16; const float s = rstd[row]; bf16_t* rowp = O + (size_t)row * ldc + col0;
#pragma unroll
                for (int bj = 0; bj < 2; ++bj) { f32x4 v0 = acc[ai][bj][m][0] * s, v1 = acc[ai][bj][m][1] * s;
                    if (gate) {
#pragma unroll
                        for (int j = 0; j < 4; ++j) { v0[j] = __builtin_amdgcn_rcpf(1.0f + __expf(-v0[j])); v1[j] = __builtin_amdgcn_rcpf(1.0f + __expf(-v1[j])); } }
                    u32x4 w; w.x = cvt_pk_bf16(v0[0], v0[1]); w.y = cvt_pk_bf16(v0[2], v0[3]); w.z = cvt_pk_bf16(v1[0], v1[1]); w.w = cvt_pk_bf16(v1[2], v1[3]);
                    *(u32x4*)(rowp + bj * HALF) = w; } }
    }
};
struct EpiMerge {
    static constexpr bool PERM = true, AFTER_DRAIN = false, PROBE_REP = false;
    const bf16_t* G; int ldg; bf16_t* O; int ldc; int nM, nN;
    __device__ __forceinline__ bool keep(const Unit& u) const { return u.pm < nM; }
    __device__ __forceinline__ void operator()(f32x4 (&acc)[2][2][4][2], const Unit& u, int wr, int wc, int fr, int fq) const {
        const bool second = u.pm >= nM; const int pm = second ? u.pm - nM : u.pm, pn = second ? u.pn - nN : u.pn;
        const int row0 = pm * BM + wr * 64 + fr, col0 = pn * BM + wc * 32 + 8 * fq;
#pragma unroll
        for (int ai = 0; ai < 2; ++ai)
#pragma unroll
            for (int m = 0; m < 4; ++m) { const int row = row0 + ai * HALF + m * 16;
#pragma unroll
                for (int bj = 0; bj < 2; ++bj) { const int col = col0 + bj * HALF;
                    const u32x4 ga = *(const u32x4*)(G + (size_t)row * ldg + col), gb = *(const u32x4*)(G + (size_t)row * ldg + 1024 + col);
                    float sa[8], sb[8];
#pragma unroll
                    for (int j = 0; j < 4; ++j) { sa[2 * j] = bf_lo(ga[j]); sa[2 * j + 1] = bf_hi(ga[j]); sb[2 * j] = bf_lo(gb[j]); sb[2 * j + 1] = bf_hi(gb[j]); }
                    if (!second) {
#pragma unroll
                        for (int j = 0; j < 4; ++j) { acc[ai][bj][m][0][j] *= sa[j] * __builtin_amdgcn_rcpf(sb[j]); acc[ai][bj][m][1][j] *= sa[4 + j] * __builtin_amdgcn_rcpf(sb[4 + j]); }
                    } else {
                        f32x4 v0, v1;
#pragma unroll
                        for (int j = 0; j < 4; ++j) { v0[j] = acc[ai][bj][m][0][j] * sb[j]; v1[j] = acc[ai][bj][m][1][j] * sb[4 + j]; }
                        u32x4 w; w.x = cvt_pk_bf16(v0[0], v0[1]); w.y = cvt_pk_bf16(v0[2], v0[3]); w.z = cvt_pk_bf16(v1[0], v1[1]); w.w = cvt_pk_bf16(v1[2], v1[3]);
                        *(u32x4*)(O + (size_t)row * ldc + col) = w; } } }
    }
};
struct EpiX1 {
    static constexpr bool PERM = false, AFTER_DRAIN = false, PROBE_REP = (EPI_REP_WHICH == 6);
    const float* X; float* out; bf16_t* xb; float* ssq; int ldc;
    __device__ __forceinline__ bool keep(const Unit&) const { return false; }
    __device__ __forceinline__ void operator()(f32x4 (&acc)[2][2][4][2], const Unit& u, int wr, int wc, int fr, int fq) const {
        const int row0 = u.pm * BM + wr * 64 + fr, col0 = u.pn * BM + wc * 32 + 4 * fq;
#pragma unroll
        for (int ai = 0; ai < 2; ++ai)
#pragma unroll
            for (int m = 0; m < 4; ++m) { const int row = row0 + ai * HALF + m * 16; const size_t off = (size_t)row * ldc + col0; float ss = 0.f;
#pragma unroll
                for (int bj = 0; bj < 2; ++bj)
#pragma unroll
                    for (int n = 0; n < 2; ++n) { const f32x4 xv = *(const f32x4*)(X + off + bj * HALF + n * 16); const f32x4 o = xv + acc[ai][bj][m][n];
                        *(f32x4*)(out + off + bj * HALF + n * 16) = o; ss += (o[0] * o[0] + o[1] * o[1]) + (o[2] * o[2] + o[3] * o[3]);
                        u32x2 w; w.x = cvt_pk_bf16(o[0], o[1]); w.y = cvt_pk_bf16(o[2], o[3]); *(u32x2*)(xb + off + bj * HALF + n * 16) = w; }
                ss += __shfl_xor(ss, 16); ss += __shfl_xor(ss, 32);
                if (fq == 0) ssq[(size_t)row * 16 + u.pn * 4 + wc] = ss; }
    }
};
struct EpiSwiGLU {
    static constexpr bool PERM = true, AFTER_DRAIN = false, PROBE_REP = (EPI_REP_WHICH == 7);
    bf16_t* O; int ldc; const float* ssq; float eps;
    __device__ __forceinline__ bool keep(const Unit&) const { return false; }
    __device__ __forceinline__ void operator()(f32x4 (&acc)[2][2][4][2], const Unit& u, int wr, int wc, int fr, int fq) const {
        const int row0 = u.pm * BM + wr * 64 + fr, col0 = u.pn * HALF + wc * 32 + 8 * fq;
#pragma unroll
        for (int ai = 0; ai < 2; ++ai)
#pragma unroll
            for (int m = 0; m < 4; ++m) { const int row = row0 + ai * HALF + m * 16;
                const f32x4* sp = (const f32x4*)(ssq + (size_t)row * 16); const f32x4 s0 = sp[0], s1 = sp[1], s2 = sp[2], s3 = sp[3];
                const float tot = ((s0[0] + s0[1]) + (s0[2] + s0[3])) + ((s1[0] + s1[1]) + (s1[2] + s1[3])) + ((s2[0] + s2[1]) + (s2[2] + s2[3])) + ((s3[0] + s3[1]) + (s3[2] + s3[3]));
                const float s = __builtin_amdgcn_rsqf(tot * (1.0f / 1024.0f) + eps);
                float a[8];
#pragma unroll
                for (int n = 0; n < 2; ++n)
#pragma unroll
                    for (int j = 0; j < 4; ++j) { const float g = acc[ai][0][m][n][j] * s, up = acc[ai][1][m][n][j] * s; a[4 * n + j] = g * up * __builtin_amdgcn_rcpf(1.0f + __expf(-g)); }
                u32x4 w; w.x = cvt_pk_bf16(a[0], a[1]); w.y = cvt_pk_bf16(a[2], a[3]); w.z = cvt_pk_bf16(a[4], a[5]); w.w = cvt_pk_bf16(a[6], a[7]);
                *(u32x4*)(O + (size_t)row * ldc + col0) = w; }
    }
};
struct EpiOut {
    static constexpr bool PERM = false, AFTER_DRAIN = false, PROBE_REP = false;
    float* out; int ldc;
    __device__ __forceinline__ bool keep(const Unit&) const { return false; }
    __device__ __forceinline__ void operator()(f32x4 (&acc)[2][2][4][2], const Unit& u, int wr, int wc, int fr, int fq) const {
        const int row0 = u.pm * BM + wr * 64 + fr, col0 = u.pn * BM + wc * 32 + 4 * fq;
#pragma unroll
        for (int ai = 0; ai < 2; ++ai)
#pragma unroll
            for (int m = 0; m < 4; ++m) { float* rowp = out + (size_t)(row0 + ai * HALF + m * 16) * ldc + col0;
#pragma unroll
                for (int bj = 0; bj < 2; ++bj)
#pragma unroll
                    for (int n = 0; n < 2; ++n) { const f32x4 b = *(const f32x4*)(rowp + bj * HALF + n * 16); *(f32x4*)(rowp + bj * HALF + n * 16) = b + acc[ai][bj][m][n]; } }
    }
};

template <class Epi, class Sched, bool ALIGN_EPI = false, bool SP2 = false>
__device__ __forceinline__ void gemm_phase(PG8_LAS unsigned char* lds, const Gemm g, const Sched& S, const Epi& E) {
    const int tid = threadIdx.x, wid = __builtin_amdgcn_readfirstlane(tid >> 6), lane = tid & 63, wr = wid >> 2, wc = wid & 3, fr = lane & 15, fq = lane >> 4;
    const int K = g.K, nt = K / BK;
    unsigned voffA[2], voffB[2];
#pragma unroll
    for (int i = 0; i < 2; ++i) { int R, C; stage_rc(tid * 16 + i * 8192, R, C); const int Rb = Epi::PERM ? ((R & ~31) + perm32(R & 31)) : R;
        voffA[i] = (unsigned)(R * K + C) * 2u; voffB[i] = (unsigned)(Rb * K + C) * 2u; }
    const size_t kstep = (size_t)(BK * 2);
    const size_t hstep = (size_t)HALF * K * 2;
    const size_t tstep = 2 * hstep;
    const unsigned ldsw = (unsigned)wid * 1024u;
    const int aoff = lds_byte(wr * 64 + fr, fq * 8), boff = lds_byte(wc * 32 + fr, fq * 8);
#define PG8_SA(b, h) (((b) * 2 + (h)) * HTB)
#define PG8_SB(b, h) ((4 + (b) * 2 + (h)) * HTB)
#define PG8_STAGE(bufoff, gbase, voff) do { _Pragma("unroll") for (int _i = 0; _i < 2; ++_i) \
        __builtin_amdgcn_global_load_lds((const unsigned*)((const char*)(gbase) + (voff)[_i]), (PG8_LAS unsigned*)(lds + (bufoff) + ldsw + _i * 8192), 16, 0, 0); } while (0)
#define PG8_LDA(dst, b, h) do { _Pragma("unroll") for (int m = 0; m < 4; ++m) _Pragma("unroll") for (int k = 0; k < 2; ++k) dst[m][k] = *(const PG8_LAS bf16x8*)(lds + PG8_SA(b, h) + aoff + m * 2048 + k * 1024); } while (0)
#define PG8_LDB(dst, b, h) do { _Pragma("unroll") for (int n = 0; n < 2; ++n) _Pragma("unroll") for (int k = 0; k < 2; ++k) dst[n][k] = *(const PG8_LAS bf16x8*)(lds + PG8_SB(b, h) + boff + n * 2048 + k * 1024); } while (0)
#define PG8_MMA(ai, bj, At, Bt) do { __builtin_amdgcn_s_setprio(1); _Pragma("unroll") for (int m = 0; m < 4; ++m) _Pragma("unroll") for (int n = 0; n < 2; ++n) _Pragma("unroll") for (int k = 0; k < 2; ++k) \
        acc[ai][bj][m][n] = __builtin_amdgcn_mfma_f32_16x16x32_bf16(Bt[n][k], At[m][k], acc[ai][bj][m][n], 0, 0, 0); __builtin_amdgcn_s_setprio(0); } while (0)
#define PG8_WAIT_V(n) asm volatile("s_waitcnt vmcnt(" #n ")" ::: "memory")
#define PG8_WAIT_L(n) asm volatile("s_waitcnt lgkmcnt(" #n ")" ::: "memory")
#define PG8_BAR __builtin_amdgcn_s_barrier()
#define PG8_SCHED __builtin_amdgcn_sched_barrier(0)
    Unit cur, nxt; int ui = 0;
    if (!S.next(0, cur)) return;
    f32x4 acc[2][2][4][2];
#pragma unroll
    for (int a = 0; a < 2; ++a)
#pragma unroll
        for (int b = 0; b < 2; ++b)
#pragma unroll
            for (int m = 0; m < 4; ++m)
#pragma unroll
                for (int n = 0; n < 2; ++n) acc[a][b][m][n] = (f32x4){0.f, 0.f, 0.f, 0.f};
    bf16x8 At[4][2], B0[2][2], B1[2][2];
    const char* cA = (const char*)g.A + (size_t)cur.pm * tstep; const char* cB = (const char*)g.Bt + (size_t)cur.pn * tstep;
    S.a_ready(cur);
    if constexpr (SP2) {
        PG8_STAGE(PG8_SB(0, 0), cB, voffB); PG8_STAGE(PG8_SB(0, 1), cB + hstep, voffB); PG8_STAGE(PG8_SA(0, 0), cA, voffA); PG8_STAGE(PG8_SA(0, 1), cA + hstep, voffA);
        if (wr == 1) PG8_BAR;
        PG8_WAIT_V(2); PG8_BAR;
        PG8_STAGE(PG8_SB(1, 0), cB + kstep, voffB); PG8_STAGE(PG8_SA(1, 0), cA + kstep, voffA); PG8_STAGE(PG8_SB(1, 1), cB + hstep + kstep, voffB);
        PG8_WAIT_V(6); PG8_BAR;
    } else {
        PG8_STAGE(PG8_SB(0, 0), cB, voffB); PG8_STAGE(PG8_SA(0, 0), cA, voffA); PG8_STAGE(PG8_SB(0, 1), cB + hstep, voffB); PG8_STAGE(PG8_SA(0, 1), cA + hstep, voffA);
        if (wr == 1) PG8_BAR;
        PG8_WAIT_V(4); PG8_BAR;
        PG8_STAGE(PG8_SB(1, 0), cB + kstep, voffB); PG8_STAGE(PG8_SA(1, 0), cA + kstep, voffA); PG8_STAGE(PG8_SB(1, 1), cB + hstep + kstep, voffB);
        PG8_WAIT_V(6); PG8_BAR;
    }
    for (;;) {
        const bool has_next = S.next(ui + 1, nxt);
        const char* nA = has_next ? (const char*)g.A + (size_t)nxt.pm * tstep : cA; const char* nB = has_next ? (const char*)g.Bt + (size_t)nxt.pn * tstep : cB;
        for (int t = 0; t < nt; t += 2) {
            const bool last = (t == nt - 2);
            const char* a1 = cA + (size_t)(t + 1) * kstep;
            const char* a2 = last ? nA : cA + (size_t)(t + 2) * kstep; const char* b2 = last ? nB : cB + (size_t)(t + 2) * kstep;
            const char* a3 = a2 + kstep; const char* b3 = b2 + kstep;
            if (last && has_next) S.a_ready(nxt);
            if constexpr (SP2) {
            PG8_LDB(B0, 0, 0); PG8_LDB(B1, 0, 1); PG8_SCHED; PG8_LDA(At, 0, 0); PG8_STAGE(PG8_SA(1, 1), a1 + hstep, voffA);
            PG8_WAIT_V(8); PG8_WAIT_L(0); PG8_BAR; PG8_MMA(0, 0, At, B0); PG8_MMA(0, 1, At, B1); PG8_BAR; PG8_SCHED;
            PG8_LDA(At, 0, 1); PG8_STAGE(PG8_SB(0, 0), b2, voffB); PG8_STAGE(PG8_SB(0, 1), b2 + hstep, voffB); PG8_STAGE(PG8_SA(0, 0), a2, voffA);
            PG8_WAIT_V(8); PG8_WAIT_L(0); PG8_BAR; PG8_MMA(1, 0, At, B0); PG8_MMA(1, 1, At, B1); PG8_BAR; PG8_SCHED;
            PG8_LDB(B0, 1, 0); PG8_LDB(B1, 1, 1); PG8_SCHED; PG8_LDA(At, 1, 0); PG8_STAGE(PG8_SA(0, 1), a2 + hstep, voffA);
            PG8_WAIT_V(8); PG8_WAIT_L(0); PG8_BAR; PG8_MMA(0, 0, At, B0); PG8_MMA(0, 1, At, B1); PG8_BAR; PG8_SCHED;
            PG8_LDA(At, 1, 1); PG8_STAGE(PG8_SB(1, 0), b3, voffB); PG8_STAGE(PG8_SB(1, 1), b3 + hstep, voffB); PG8_STAGE(PG8_SA(1, 0), a3, voffA);
            PG8_WAIT_V(8); PG8_WAIT_L(0); PG8_BAR; PG8_MMA(1, 0, At, B0); PG8_MMA(1, 1, At, B1); PG8_BAR; PG8_SCHED;
            } else {
            PG8_LDB(B0, 0, 0); PG8_SCHED; PG8_LDA(At, 0, 0); PG8_STAGE(PG8_SA(1, 1), a1 + hstep, voffA);
            PG8_WAIT_L(8); PG8_BAR; PG8_WAIT_L(0); PG8_MMA(0, 0, At, B0); PG8_BAR; PG8_SCHED;
            PG8_LDB(B1, 0, 1); PG8_STAGE(PG8_SB(0, 0), b2, voffB);
            PG8_BAR; PG8_WAIT_L(0); PG8_MMA(0, 1, At, B1); PG8_BAR;
            PG8_LDA(At, 0, 1); PG8_STAGE(PG8_SA(0, 0), a2, voffA);
            PG8_BAR; PG8_WAIT_L(0); PG8_MMA(1, 0, At, B0); PG8_BAR; PG8_SCHED;
            PG8_STAGE(PG8_SB(0, 1), b2 + hstep, voffB);
            PG8_WAIT_V(6); PG8_BAR; PG8_MMA(1, 1, At, B1); PG8_BAR;
            PG8_LDB(B0, 1, 0); PG8_SCHED; PG8_LDA(At, 1, 0); PG8_STAGE(PG8_SA(0, 1), a2 + hstep, voffA);
            PG8_WAIT_L(8); PG8_BAR; PG8_WAIT_L(0); PG8_MMA(0, 0, At, B0); PG8_BAR; PG8_SCHED;
            PG8_LDB(B1, 1, 1); PG8_STAGE(PG8_SB(1, 0), b3, voffB);
            PG8_BAR; PG8_WAIT_L(0); PG8_MMA(0, 1, At, B1); PG8_BAR;
            PG8_LDA(At, 1, 1); PG8_STAGE(PG8_SA(1, 0), a3, voffA);
            PG8_BAR; PG8_WAIT_L(0); PG8_MMA(1, 0, At, B0); PG8_BAR; PG8_SCHED;
            PG8_STAGE(PG8_SB(1, 1), b3 + hstep, voffB);
            PG8_WAIT_V(6); PG8_BAR; PG8_MMA(1, 1, At, B1); PG8_BAR;
            }
        }
        if constexpr (ALIGN_EPI) { if (wr == 0) PG8_BAR; }
        if constexpr (!Epi::AFTER_DRAIN) { for (int er_ = 0; er_ < (Epi::PROBE_REP ? EPI_REP : 1); ++er_) { E(acc, cur, wr, wc, fr, fq); if (Epi::PROBE_REP && EPI_REP > 1) asm volatile("" ::: "memory"); } S.done(cur); }
        if (!has_next) break;
        if (!E.keep(cur)) {
#pragma unroll
        for (int a = 0; a < 2; ++a)
#pragma unroll
            for (int b = 0; b < 2; ++b)
#pragma unroll
                for (int m = 0; m < 4; ++m)
#pragma unroll
                    for (int n = 0; n < 2; ++n) acc[a][b][m][n] = (f32x4){0.f, 0.f, 0.f, 0.f};
        }
        cur = nxt; cA = nA; cB = nB; ++ui;
        if constexpr (ALIGN_EPI) { if (wr == 1) PG8_BAR; }
    }
    PG8_WAIT_V(0);
    if constexpr (!ALIGN_EPI) { if (wr == 0) PG8_BAR; }
    PG8_BAR;
    if constexpr (Epi::AFTER_DRAIN) { E.fused(acc, cur, wr, wc, fr, fq, lds, wid, lane); S.done(cur); }
#undef PG8_SA
#undef PG8_SB
#undef PG8_STAGE
#undef PG8_LDA
#undef PG8_LDB
#undef PG8_MMA
#undef PG8_WAIT_V
#undef PG8_WAIT_L
#undef PG8_BAR
#undef PG8_SCHED
}
}

constexpr int NWAVES = 8;
#ifndef MK_N_LAUNCHES
#define MK_N_LAUNCHES 1
#endif
constexpr int PER_PHASE = 9;
constexpr int N_LAUNCHES = MK_N_LAUNCHES;

constexpr int BATCH = 4, SEQ = 4096, D = 1024, M = BATCH * SEQ;
constexpr int DN_H = 4, DN_D = 128, DN_W = 512, DN_QKV = 1536;
constexpr int SW_H = 8, SW_KV = 2, SW_D = 64, SW_W = 512, SW_KVW = 128, WINDOW = 128;
constexpr int FF = 2816;
constexpr int D_IN = 4872;
constexpr int NP = 4864;
constexpr int PC_Z = 1536, PC_SQ = 2048, PC_SK = 2560, PC_SV = 2688, PC_G = 2816;
constexpr float EPS = 1e-6f;

constexpr size_t MiB = 1u << 20;
constexpr size_t WS_CTL = 0, CTL_ZERO_BYTES = 1 * MiB;
constexpr size_t WS_WIN = 1 * MiB;
constexpr size_t WS_WAB = 11 * MiB;
constexpr size_t WS_WOUT = 13 * MiB;
constexpr size_t WS_WGU = 15 * MiB;
constexpr size_t WS_WD = 26 * MiB;
constexpr size_t WS_RSTD = 32 * MiB;
constexpr size_t WS_GB = WS_RSTD + 64 * 1024;
constexpr size_t WS_SSQ = 33 * MiB;
constexpr size_t WS_XB = 34 * MiB;
constexpr size_t WS_Y = 66 * MiB;
constexpr size_t WS_PROJ = 98 * MiB;
constexpr size_t WS_UB = 250 * MiB;
constexpr size_t WS_END = 256 * MiB;
static_assert(WS_PROJ + (size_t)M * NP * 2 <= WS_UB, "ws map");
constexpr int CW_TMO = 0, CW_BAR = 4096;

constexpr int RING_OFF = 0, RING_BYTES = 131072;
constexpr int LDSCTL_OFF = RING_BYTES, MISC_OFF = LDSCTL_OFF + 320;
constexpr int LDS_BYTES = 147456;

#define GAS __attribute__((address_space(1)))
#define LAS __attribute__((address_space(3)))
typedef unsigned short bf16;
typedef unsigned v4u __attribute__((ext_vector_type(4)));
typedef float f32x4 __attribute__((ext_vector_type(4)));
typedef float f32x2 __attribute__((ext_vector_type(2)));
typedef GAS unsigned gu32;
#define RLX_AGENT __ATOMIC_RELAXED, __HIP_MEMORY_SCOPE_AGENT
#define LDS_WAIT() asm volatile("s_waitcnt lgkmcnt(0)" ::: "memory")
#define VM_WAIT() asm volatile("s_waitcnt vmcnt(0)" ::: "memory")
__device__ __forceinline__ unsigned f2bf(float f) { unsigned u = __builtin_bit_cast(unsigned, f); return (u + 0x7fffu + ((u >> 16) & 1u)) >> 16; }
__device__ __forceinline__ unsigned pk2(float lo, float hi) { return f2bf(lo) | (f2bf(hi) << 16); }
__device__ __forceinline__ float bflo(unsigned w) { return __builtin_bit_cast(float, w << 16); }
__device__ __forceinline__ float bfhi(unsigned w) { return __builtin_bit_cast(float, w & 0xffff0000u); }
__device__ __forceinline__ float bf1(bf16 h) { return __builtin_bit_cast(float, (unsigned)h << 16); }
__device__ __forceinline__ float sigm(float x) { return __builtin_amdgcn_rcpf(1.0f + __expf(-x)); }
__device__ __forceinline__ float frsq(float x) { return __builtin_amdgcn_rsqf(x); }
template <int CTRL> __device__ __forceinline__ float dpp_mov(float v) { return __builtin_bit_cast(float, __builtin_amdgcn_update_dpp(0, __builtin_bit_cast(int, v), CTRL, 0xf, 0xf, true)); }
__device__ __forceinline__ float sum4(float v) { v += dpp_mov<0xB1>(v); v += dpp_mov<0x4E>(v); return v; }
__device__ __forceinline__ float sum8(float v) { v = sum4(v); v += dpp_mov<0x141>(v); return v; }
__device__ __forceinline__ float sum16(float v) { v = sum8(v); v += dpp_mov<0x140>(v); return v; }
__device__ __forceinline__ float rdlane(float v, int l) { return __builtin_bit_cast(float, __builtin_amdgcn_readlane(__builtin_bit_cast(int, v), l)); }
__device__ __forceinline__ float wave_sum(float v) { v = sum16(v); return (rdlane(v, 0) + rdlane(v, 16)) + (rdlane(v, 32) + rdlane(v, 48)); }
__device__ __forceinline__ float sum32(float v, int lane) { v = sum16(v); const float lo = rdlane(v, 0) + rdlane(v, 16), hi = rdlane(v, 32) + rdlane(v, 48); return (lane & 32) ? hi : lo; }
__device__ __forceinline__ float wave_max(float v) {
#pragma unroll
    for (int o = 1; o < 64; o <<= 1) v = fmaxf(v, __shfl_xor(v, o));
    return v;
}

#define XB_TMO      128
#define XB_XCNT(j)  (256  + 64 * (j))
#define XB_XSUB(j)  (1280 + 64 * (j))
#define XB_XGEN(j)  (2304 + 64 * (j))
#define XB_TOP      3328
#define XB_TOPGEN   3392
#define XCD_BAR_WORDS 3456
#define XB_SPIN_CAP (1u << 18)
__device__ __forceinline__ unsigned xb_ld(unsigned* p)              { return __hip_atomic_load(p, __ATOMIC_RELAXED, __HIP_MEMORY_SCOPE_AGENT); }
__device__ __forceinline__ unsigned xb_add(unsigned* p, unsigned v) { return __hip_atomic_fetch_add(p, v, __ATOMIC_RELAXED, __HIP_MEMORY_SCOPE_AGENT); }
__device__ __forceinline__ unsigned xb_xcc_id() { return (unsigned)__builtin_amdgcn_s_getreg((3 << 11) | 20) & 0xFu; }
#define XB_SPIN(cond, bar) do { unsigned _sp = 0; while (cond) { __builtin_amdgcn_s_sleep(1); \
    if ((++_sp & 255u) == 0u) { if (xb_ld(&(bar)[XB_TMO])) break; if (_sp > XB_SPIN_CAP) { atomicAdd(&(bar)[XB_TMO], 1u); break; } } } } while (0)
struct XcdBarrier { unsigned* bar; unsigned x; volatile LAS unsigned* st; };
__device__ __forceinline__ XcdBarrier xcd_barrier_post(unsigned* bar, volatile LAS unsigned* st) {
    XcdBarrier b; b.bar = bar; b.x = xb_xcc_id(); b.st = st;
    if (threadIdx.x == 0) (void)xb_add(&bar[XB_XCNT(b.x)], 1u);
    return b;
}
__device__ __forceinline__ void xcd_barrier_complete(unsigned* bar, unsigned x, unsigned& nloc, unsigned& nx) {
    const unsigned G = gridDim.x * gridDim.y * gridDim.z;
    unsigned sum, cnt, mine, sp = 0u;
    for (;;) {
        sum = 0u; cnt = 0u; mine = 0u;
#pragma unroll
        for (unsigned j = 0; j < 16; ++j) { const unsigned c = xb_ld(&bar[XB_XCNT(j)]); sum += c; cnt += (c > 0u) ? 1u : 0u; mine = (j == x) ? c : mine; }
        if (sum == G) break;
        __builtin_amdgcn_s_sleep(1);
        if ((++sp & 255u) == 0u) { if (xb_ld(&bar[XB_TMO])) break; if (sp > XB_SPIN_CAP) { atomicAdd(&bar[XB_TMO], 1u); break; } }
    }
    nloc = mine > 0u ? mine : 1u; nx = cnt > 0u ? cnt : 1u;
}
__device__ __forceinline__ void xcd_barrier(const XcdBarrier& b) {
    asm volatile("s_waitcnt vmcnt(0)" ::: "memory");
    __syncthreads();
    if (threadIdx.x == 0) {
        unsigned* bar = b.bar;
        __builtin_amdgcn_s_waitcnt(0);
        unsigned nloc = b.st[0], nx = b.st[1];
        if (nloc == 0u) { xcd_barrier_complete(bar, b.x, nloc, nx); b.st[0] = nloc; b.st[1] = nx; }
        const unsigned old = xb_add(&bar[XB_XSUB(b.x)], 1u);
        const unsigned gen = old / nloc;
        if (old + 1u == (gen + 1u) * nloc) {
            __builtin_amdgcn_fence(__ATOMIC_RELEASE, "agent");
            asm volatile("s_waitcnt vmcnt(0)" ::: "memory");
            const unsigned og = xb_add(&bar[XB_TOP], 1u);
            const unsigned tg = og / nx;
            if (og + 1u == (tg + 1u) * nx) xb_add(&bar[XB_TOPGEN], 1u);
            else XB_SPIN(xb_ld(&bar[XB_TOPGEN]) == tg, bar);
            __builtin_amdgcn_fence(__ATOMIC_ACQUIRE, "agent");
            xb_add(&bar[XB_XGEN(b.x)], 1u);
            asm volatile("s_waitcnt vmcnt(0)" ::: "memory");
        } else {
            XB_SPIN(xb_ld(&bar[XB_XGEN(b.x)]) == gen, bar);
            __builtin_amdgcn_fence(__ATOMIC_ACQUIRE, "agent");
            asm volatile("s_waitcnt vmcnt(0)" ::: "memory");
        }
    }
    __syncthreads();
}

struct Frame {
    LAS unsigned char* lds;
    volatile LAS unsigned* MISC;
    gu32* ctl;
    int tid, lane, wave;
    int vcu, G;
    const float* in[18]; float* out; unsigned char* ws;
};
__device__ const unsigned char T5_BUCKET[128] = {0,1,2,3,4,5,6,7,8,9,10,11,12,13,14,15,16,16,16,17,17,18,18,18,19,19,19,20,20,20,20,21,21,21,21,22,22,22,22,22,23,23,23,23,23,23,24,24,24,24,24,24,25,25,25,25,25,25,25,26,26,26,26,26,26,26,26,27,27,27,27,27,27,27,27,27,27,28,28,28,28,28,28,28,28,28,28,29,29,29,29,29,29,29,29,29,29,29,29,30,30,30,30,30,30,30,30,30,30,30,30,30,30,31,31,31,31,31,31,31,31,31,31,31,31,31,31,31};

__device__ __forceinline__ void p0_transpose_item(const float* W, int ldw, int src_col0, int K, bf16* WT, int dst_row0, const float* gain, LAS float* scr, int kb, int lane) {
    const int k0 = 64 * kb, c4 = 4 * (lane & 7);
    f32x4 v[8];
#pragma unroll
    for (int i = 0; i < 8; ++i) v[i] = *(const f32x4*)(W + (size_t)(k0 + 8 * i + (lane >> 3)) * ldw + src_col0 + c4);
#pragma unroll
    for (int i = 0; i < 8; ++i) { const int kk = 8 * i + (lane >> 3); const float gn = gain ? gain[k0 + kk] : 1.0f;
        scr[kk * 33 + c4] = v[i].x * gn; scr[kk * 33 + c4 + 1] = v[i].y * gn; scr[kk * 33 + c4 + 2] = v[i].z * gn; scr[kk * 33 + c4 + 3] = v[i].w * gn; }
    LDS_WAIT(); asm volatile("" ::: "memory");
    const int c = lane & 7;
#pragma unroll
    for (int j = 0; j < 4; ++j) { const int n = (lane >> 3) + 8 * j; const LAS float* s = scr + (8 * c) * 33 + n;
        v4u o; o.x = pk2(s[0 * 33], s[1 * 33]); o.y = pk2(s[2 * 33], s[3 * 33]); o.z = pk2(s[4 * 33], s[5 * 33]); o.w = pk2(s[6 * 33], s[7 * 33]);
        *(GAS v4u*)(WT + (size_t)(dst_row0 + n) * K + k0 + 8 * c) = o; }
    LDS_WAIT(); asm volatile("" ::: "memory");
}
__device__ __forceinline__ void p0_prologue(Frame& F) {
    LAS float* scr = (LAS float*)(F.lds + RING_OFF + F.wave * 16384);
    const int gw = F.vcu * NWAVES + F.wave, NGW = F.G * NWAVES;
    unsigned char* ws = F.ws;
    bf16* WinT = (bf16*)(ws + WS_WIN); bf16* WabT = (bf16*)(ws + WS_WAB); bf16* WoutT = (bf16*)(ws + WS_WOUT); bf16* WguT = (bf16*)(ws + WS_WGU); bf16* WdT = (bf16*)(ws + WS_WD);
    constexpr int I_IN = 16 * (NP / 32), I_AB = 8 * 32, I_OUT = 16 * 32, I_GU = 16 * (2 * FF / 32), I_D = (FF / 64) * 32;
    constexpr int NITEMS = I_IN + 2 * I_AB + I_OUT + I_GU + I_D;
    for (int it = gw; it < NITEMS; it += NGW) {
        int r = it;
        if (r < I_IN) { const int nb = r % (NP / 32), kb = r / (NP / 32), dr = 32 * nb; p0_transpose_item(F.in[2], D_IN, dr < 2048 ? dr : dr + 8, D, WinT, dr, F.in[1], scr, kb, F.lane); continue; } r -= I_IN;
        if (r < I_AB) { const int nb = r % 32, kb = r / 32; p0_transpose_item(F.in[11], D, 32 * nb, DN_W, WabT, 32 * nb, nullptr, scr, kb, F.lane); continue; } r -= I_AB;
        if (r < I_AB) { const int nb = r % 32, kb = r / 32; p0_transpose_item(F.in[12], D, 32 * nb, SW_W, WabT, 1024 + 32 * nb, nullptr, scr, kb, F.lane); continue; } r -= I_AB;
        if (r < I_OUT) { const int nb = r % 32, kb = r / 32; p0_transpose_item(F.in[13], D, 32 * nb, D, WoutT, 32 * nb, nullptr, scr, kb, F.lane); continue; } r -= I_OUT;
        if (r < I_GU) { const int nb = r % (2 * FF / 32), kb = r / (2 * FF / 32), dr = 32 * nb, pn = dr >> 8, j = dr & 255;
            const float* W = (j < 128) ? F.in[15] : F.in[16]; p0_transpose_item(W, FF, 128 * pn + (j & 127), D, WguT, dr, F.in[14], scr, kb, F.lane); continue; } r -= I_GU;
        { const int nb = r % 32, kb = r / 32; p0_transpose_item(F.in[17], D, 32 * nb, FF, WdT, 32 * nb, nullptr, scr, kb, F.lane); }
    }
    __syncthreads();
    LAS float* wba = (LAS float*)(F.lds + RING_OFF);
    for (int idx = F.tid; idx < 8 * D; idx += NWAVES * 64) { const int k = idx >> 3, j = idx & 7; wba[j * D + k] = F.in[2][(size_t)k * D_IN + 2048 + j] * F.in[1][k]; }
    __syncthreads();
    const float* x = F.in[0]; bf16* XB = (bf16*)(ws + WS_XB); float* rstd1 = (float*)(ws + WS_RSTD); float* gbp = (float*)(ws + WS_GB);
    const float alog_or_dt = (F.lane & 32) ? F.in[5][(F.lane >> 3) & 3] : 0.f;
    const float negA = -expf(F.in[4][(F.lane >> 3) & 3]);
    for (int m = gw; m < M; m += NGW) {
        const GAS f32x4* xr = (const GAS f32x4*)(x + (size_t)m * D) + F.lane;
        f32x4 v[4]; float ss = 0.f;
#pragma unroll
        for (int j = 0; j < 4; ++j) { v[j] = xr[64 * j]; ss += (v[j].x * v[j].x + v[j].y * v[j].y) + (v[j].z * v[j].z + v[j].w * v[j].w); }
        GAS unsigned long long* o8 = (GAS unsigned long long*)(XB + (size_t)m * D) + F.lane;
#pragma unroll
        for (int j = 0; j < 4; ++j) o8[64 * j] = (unsigned long long)pk2(v[j].x, v[j].y) | ((unsigned long long)pk2(v[j].z, v[j].w) << 32);
        float acc[8];
#pragma unroll
        for (int c = 0; c < 8; ++c) { float a = 0.f;
#pragma unroll
            for (int j = 0; j < 4; ++j) { const f32x4 w = *(const LAS f32x4*)(wba + c * D + 256 * j + 4 * F.lane); a += (v[j].x * w.x + v[j].y * w.y) + (v[j].z * w.z + v[j].w * w.w); }
            acc[c] = a; }
        ss = wave_sum(ss);
        float r4[4], r2[2], r1;
        { const bool up = (F.lane & 32) != 0;
#pragma unroll
          for (int i = 0; i < 4; ++i) { const float keep = up ? acc[4 + i] : acc[i], send = up ? acc[i] : acc[4 + i]; r4[i] = keep + __shfl_xor(send, 32); } }
        { const bool up = (F.lane & 16) != 0;
#pragma unroll
          for (int i = 0; i < 2; ++i) { const float keep = up ? r4[2 + i] : r4[i], send = up ? r4[i] : r4[2 + i]; r2[i] = keep + __shfl_xor(send, 16); } }
        { const bool up = (F.lane & 8) != 0; const float keep = up ? r2[1] : r2[0], send = up ? r2[0] : r2[1]; r1 = keep + __shfl_xor(send, 8); }
        r1 = sum8(r1);
        const float rstd = frsq(ss * (1.0f / D) + EPS);
        if (F.lane == 0) rstd1[m] = rstd;
        if ((F.lane & 7) == 0) {
            const float val = r1 * rstd; float res;
            if (F.lane < 32) res = 1.0f / (1.0f + expf(-val));
            else { const float xx = val + alog_or_dt; const float sp = xx > 20.f ? xx : log1pf(expf(xx)); res = negA * sp; }
            gbp[(size_t)m * 8 + (F.lane >> 3)] = res;
        }
    }
}

__device__ __forceinline__ void dn_pre(Frame& F) {
    const int gw = F.vcu * NWAVES + F.wave, NGW = F.G * NWAVES;
    const bf16* proj = (const bf16*)(F.ws + WS_PROJ); const float* conv = F.in[3];
    float* QN = F.out; float* KN = F.out + (size_t)M * DN_W; float* VV = (float*)(F.ws + WS_XB);
    for (int task = gw; task < M * DN_H; task += NGW) {
        const int m = task >> 2, h = task & 3, t = m & (SEQ - 1);
        float val[3][2];
#pragma unroll
        for (int part = 0; part < 3; ++part) { const int col = part * DN_W + h * DN_D + 2 * F.lane; float a0 = 0.f, a1 = 0.f;
#pragma unroll
            for (int j = 0; j < 4; ++j) { if (t - 3 + j >= 0) { const unsigned w = *(const unsigned*)(proj + (size_t)(m - 3 + j) * NP + col); a0 += conv[j * DN_QKV + col] * bflo(w); a1 += conv[j * DN_QKV + col + 1] * bfhi(w); } }
            val[part][0] = a0 * sigm(a0); val[part][1] = a1 * sigm(a1); }
        const float rq = 1.0f / sqrtf(wave_sum(val[0][0] * val[0][0] + val[0][1] * val[0][1]) + EPS) * 0.08838834764831845f;
        const float rk = 1.0f / sqrtf(wave_sum(val[1][0] * val[1][0] + val[1][1] * val[1][1]) + EPS);
        const size_t o = (size_t)m * DN_W + h * DN_D + 2 * F.lane;
        *(f32x2*)(QN + o) = (f32x2){val[0][0] * rq, val[0][1] * rq};
        *(f32x2*)(KN + o) = (f32x2){val[1][0] * rk, val[1][1] * rk};
        *(f32x2*)(VV + o) = (f32x2){val[2][0], val[2][1]};
    }
}
__device__ __forceinline__ void dn_scan_naive(Frame& F, int bh) {
    const int b = bh >> 2, h = bh & 3, tid = F.tid, dvi = tid >> 2, kq = tid & 3;
    LAS float* kL = (LAS float*)(F.lds + RING_OFF); LAS float* qL = kL + 32 * 128; LAS float* vL = qL + 32 * 128; LAS float* gL = vL + 32 * 128; LAS float* bL = gL + 32;
    const float* QN = F.out; const float* KN = F.out + (size_t)M * DN_W; float* VV = (float*)(F.ws + WS_XB); const float* gbp = (const float*)(F.ws + WS_GB);
    float S[32];
#pragma unroll
    for (int j = 0; j < 32; ++j) S[j] = 0.f;
    for (int t0 = 0; t0 < SEQ; t0 += 32) {
#pragma unroll
        for (int r = 0; r < 2; ++r) { const int idx = tid + 512 * r, tok = idx >> 5, c4 = idx & 31; const size_t src = (size_t)(b * SEQ + t0 + tok) * DN_W + h * DN_D + c4 * 4;
            *(LAS f32x4*)(kL + tok * 128 + c4 * 4) = *(const f32x4*)(KN + src); *(LAS f32x4*)(qL + tok * 128 + c4 * 4) = *(const f32x4*)(QN + src); *(LAS f32x4*)(vL + tok * 128 + c4 * 4) = *(const f32x4*)(VV + src); }
        if (tid < 32) { const size_t mm = (size_t)(b * SEQ + t0 + tid); bL[tid] = gbp[mm * 8 + h]; gL[tid] = gbp[mm * 8 + 4 + h]; }
        __syncthreads();
        for (int i = 0; i < 32; ++i) {
            const float eg = __expf(gL[i]), be = bL[i];
            float kk[32];
#pragma unroll
            for (int j = 0; j < 8; ++j) { const f32x4 w = *(const LAS f32x4*)(kL + i * 128 + kq * 32 + 4 * j); kk[4 * j] = w.x; kk[4 * j + 1] = w.y; kk[4 * j + 2] = w.z; kk[4 * j + 3] = w.w; }
            float part = 0.f;
#pragma unroll
            for (int j = 0; j < 32; ++j) part += kk[j] * S[j];
            part += __shfl_xor(part, 1); part += __shfl_xor(part, 2);
            const float c = be * (vL[i * 128 + dvi] - eg * part);
#pragma unroll
            for (int j = 0; j < 32; ++j) S[j] = eg * S[j] + c * kk[j];
            float po = 0.f;
#pragma unroll
            for (int j = 0; j < 8; ++j) { const f32x4 w = *(const LAS f32x4*)(qL + i * 128 + kq * 32 + 4 * j); po += (w.x * S[4 * j] + w.y * S[4 * j + 1]) + (w.z * S[4 * j + 2] + w.w * S[4 * j + 3]); }
            po += __shfl_xor(po, 1); po += __shfl_xor(po, 2);
            if (kq == 0) vL[i * 128 + dvi] = po;
        }
        __syncthreads();
#pragma unroll
        for (int r = 0; r < 2; ++r) { const int idx = tid + 512 * r, tok = idx >> 5, c4 = idx & 31; const size_t src = (size_t)(b * SEQ + t0 + tok) * DN_W + h * DN_D + c4 * 4;
            *(f32x4*)(VV + src) = *(const LAS f32x4*)(vL + tok * 128 + c4 * 4); }
        __syncthreads();
    }
}
__device__ __forceinline__ void swa_naive(Frame& F, int wv, int nworkers) {
    const bf16* proj = (const bf16*)(F.ws + WS_PROJ); bf16* YSWA = (bf16*)(F.ws + WS_Y) + (size_t)M * SW_W;
    LAS float* qs = (LAS float*)(F.lds + RING_OFF + 65536 + F.wave * 1024); LAS float* ps = qs + 64;
    const float* qg = F.in[7]; const float* kg = F.in[8]; const float* sinks = F.in[9]; const float* relb = F.in[10];
    const int lane = F.lane;
    for (int task = wv; task < M * SW_H; task += nworkers) {
        const int m = task >> 3, qh = task & 7, kvh = qh >> 2, t = m & (SEQ - 1);
        const float q = bf1(proj[(size_t)m * NP + PC_SQ + qh * SW_D + lane]);
        const float qn = q * (1.0f / sqrtf(wave_sum(q * q) * (1.0f / SW_D) + EPS)) * qg[lane];
        qs[lane] = qn * kg[lane];
        LDS_WAIT(); asm volatile("" ::: "memory");
        float lg[2];
#pragma unroll
        for (int hf = 0; hf < 2; ++hf) { const int j = lane + 64 * hf; lg[hf] = -INFINITY;
            if (t - 127 + j >= 0) { const v4u* kr = (const v4u*)(proj + (size_t)(m - 127 + j) * NP + PC_SK + kvh * SW_D); float ssk = 0.f, dot = 0.f;
#pragma unroll
                for (int c = 0; c < 8; ++c) { const v4u w = kr[c];
#pragma unroll
                    for (int e = 0; e < 4; ++e) { const float k0 = bflo(w[e]), k1 = bfhi(w[e]); ssk += k0 * k0 + k1 * k1; dot += qs[8 * c + 2 * e] * k0 + qs[8 * c + 2 * e + 1] * k1; } }
                lg[hf] = dot * (1.0f / sqrtf(ssk * (1.0f / SW_D) + EPS)) * 0.125f + relb[(int)T5_BUCKET[127 - j] * SW_H + qh]; } }
        const float sink = sinks[qh];
        const float mx = fmaxf(wave_max(fmaxf(lg[0], lg[1])), sink);
        const float p0 = (lg[0] == -INFINITY) ? 0.f : __expf(lg[0] - mx), p1 = (lg[1] == -INFINITY) ? 0.f : __expf(lg[1] - mx);
        const float den = wave_sum(p0 + p1) + __expf(sink - mx);
        ps[lane] = p0; ps[lane + 64] = p1;
        LDS_WAIT(); asm volatile("" ::: "memory");
        float o = 0.f; const int jmin = (127 - t) > 0 ? (127 - t) : 0;
        for (int j = jmin; j < 128; ++j) o += ps[j] * bf1(proj[(size_t)(m - 127 + j) * NP + PC_SV + kvh * SW_D + lane]);
        YSWA[(size_t)m * SW_W + qh * SW_D + lane] = (bf16)f2bf(o / den);
        LDS_WAIT(); asm volatile("" ::: "memory");
    }
}
__device__ __forceinline__ void dn_out(Frame& F) {
    const int gw = F.vcu * NWAVES + F.wave, NGW = F.G * NWAVES;
    const bf16* proj = (const bf16*)(F.ws + WS_PROJ); const float* VV = (const float*)(F.ws + WS_XB); bf16* YDN = (bf16*)(F.ws + WS_Y); const float* gain = F.in[6];
    for (int task = gw; task < M * DN_H; task += NGW) {
        const int m = task >> 2, h = task & 3;
        const f32x2 o = *(const f32x2*)(VV + (size_t)m * DN_W + h * DN_D + 2 * F.lane);
        const float r = 1.0f / sqrtf(wave_sum(o.x * o.x + o.y * o.y) * (1.0f / DN_D) + EPS);
        const unsigned zw = *(const unsigned*)(proj + (size_t)m * NP + PC_Z + h * DN_D + 2 * F.lane); const float z0 = bflo(zw), z1 = bfhi(zw);
        *(unsigned*)(YDN + (size_t)m * DN_W + h * DN_D + 2 * F.lane) = pk2(o.x * r * gain[2 * F.lane] * z0 * sigm(z0), o.y * r * gain[2 * F.lane + 1] * z1 * sigm(z1));
    }
}

typedef short bf16x8 __attribute__((ext_vector_type(8)));
typedef float f32x16 __attribute__((ext_vector_type(16)));
typedef unsigned u32x2 __attribute__((ext_vector_type(2)));
typedef __bf16 bf16x2_t __attribute__((ext_vector_type(2)));
__device__ __forceinline__ unsigned cvtpk(float lo, float hi) { f32x2 v = {lo, hi}; return __builtin_bit_cast(unsigned, __builtin_convertvector(v, bf16x2_t)); }
__device__ __forceinline__ bf16x8 pack8(f32x4 a, f32x4 b) { v4u w; w.x = cvtpk(a[0], a[1]); w.y = cvtpk(a[2], a[3]); w.z = cvtpk(b[0], b[1]); w.w = cvtpk(b[2], b[3]); return __builtin_bit_cast(bf16x8, w); }
__device__ __forceinline__ bf16x8 pack8z(f32x4 a) { v4u w; w.x = cvtpk(a[0], a[1]); w.y = cvtpk(a[2], a[3]); w.z = 0u; w.w = 0u; return __builtin_bit_cast(bf16x8, w); }
#define MFMA16(a, b, c) __builtin_amdgcn_mfma_f32_16x16x32_bf16((a), (b), (c), 0, 0, 0)
#define MFMA32(a, b, c) __builtin_amdgcn_mfma_f32_32x32x16_bf16((a), (b), (c), 0, 0, 0)
constexpr float LOG2E = 1.4426950408889634f;

__device__ __forceinline__ void swa_pre(Frame& F) {
    const int gw = F.vcu * NWAVES + F.wave, NGW = F.G * NWAVES, lane = F.lane;
    const bf16* proj = (const bf16*)(F.ws + WS_PROJ);
    bf16* KS = (bf16*)(F.ws + WS_Y); bf16* VT = KS + 2 * 1024 * 1024; bf16* QS = (bf16*)(F.ws + WS_Y) + (size_t)M * SW_W;
    const float* qg = F.in[7]; const float* kg = F.in[8];
    for (int m = gw; m < M; m += NGW) {
        {
            const v4u w = *(const v4u*)(proj + (size_t)m * NP + PC_SQ + 8 * lane); float x[8];
#pragma unroll
            for (int j = 0; j < 4; ++j) { x[2 * j] = bflo(w[j]); x[2 * j + 1] = bfhi(w[j]); }
            float ss = 0.f;
#pragma unroll
            for (int j = 0; j < 8; ++j) ss += x[j] * x[j];
            ss = sum8(ss);
            const float r = frsq(ss * (1.0f / SW_D) + EPS) * (0.125f * LOG2E);
            const f32x4 g0 = *(const f32x4*)(qg + 8 * (lane & 7)), g1 = *(const f32x4*)(qg + 8 * (lane & 7) + 4);
            v4u o; o.x = cvtpk(x[0] * r * g0[0], x[1] * r * g0[1]); o.y = cvtpk(x[2] * r * g0[2], x[3] * r * g0[3]); o.z = cvtpk(x[4] * r * g1[0], x[5] * r * g1[1]); o.w = cvtpk(x[6] * r * g1[2], x[7] * r * g1[3]);
            *(v4u*)(QS + (size_t)m * SW_W + 8 * lane) = o;
        }
        {
            const unsigned w = *(const unsigned*)(proj + (size_t)m * NP + PC_SK + 2 * lane); const float k0 = bflo(w), k1 = bfhi(w);
            float ss = k0 * k0 + k1 * k1;
            ss = sum32(ss, lane);
            const float r = frsq(ss * (1.0f / SW_D) + EPS); const int d = 2 * (lane & 31), b = m >> 12, t = m & (SEQ - 1), kvh = lane >> 5;
            *(unsigned*)(KS + ((size_t)(b * 2 + kvh) * SEQ + t) * SW_D + d) = cvtpk(k0 * r * kg[d], k1 * r * kg[d + 1]);
        }
    }
    for (int task = gw; task < BATCH * SW_KV * (SEQ / 32); task += NGW) {
        const int bk = task >> 7, tile = task & 127, b = bk >> 1, kvh = bk & 1; const size_t m0 = (size_t)b * SEQ + tile * 32;
        unsigned v[32];
#pragma unroll
        for (int i = 0; i < 32; ++i) v[i] = proj[(m0 + i) * NP + PC_SV + kvh * SW_D + lane];
        bf16* dst = VT + ((size_t)(bk * 128 + tile) * 64 + lane) * 32;
#pragma unroll
        for (int q4 = 0; q4 < 4; ++q4) { v4u o;
#pragma unroll
            for (int jj = 0; jj < 4; ++jj) { const int p0 = 8 * q4 + 2 * jj, p1 = p0 + 1;
                const int k0 = 16 * (p0 >> 4) + 8 * ((p0 & 7) >> 2) + 4 * ((p0 >> 3) & 1) + (p0 & 3), k1 = 16 * (p1 >> 4) + 8 * ((p1 & 7) >> 2) + 4 * ((p1 >> 3) & 1) + (p1 & 3);
                o[jj] = v[k0] | (v[k1] << 16); }
            *(v4u*)(dst + 8 * q4) = o; }
    }
}
__device__ __forceinline__ void swa_bias_table(Frame& F) {
    LAS float* biasT = (LAS float*)(F.lds + RING_OFF);
    for (int idx = F.tid; idx < SW_H * 128; idx += NWAVES * 64) { const int h = idx >> 7, dist = idx & 127; biasT[idx] = F.in[10][(int)T5_BUCKET[dist] * SW_H + h] * LOG2E; }
}
__device__ __forceinline__ void swa_main(Frame& F, int worker, int nworkers) {
    const LAS float* biasT = (const LAS float*)(F.lds + RING_OFF);
    const bf16* KS = (const bf16*)(F.ws + WS_Y); const bf16* VT = KS + 2 * 1024 * 1024; bf16* QS = (bf16*)(F.ws + WS_Y) + (size_t)M * SW_W;
    const int lane = F.lane, l31 = lane & 31, hh = lane >> 5;
    for (int u = worker; u < BATCH * SW_H * (SEQ / 32); u += nworkers) {
        const int qblk = u & 127, h = (u >> 7) & 7, b = u >> 10, kvh = h >> 2, bk = b * 2 + kvh, q0 = qblk * 32; const size_t m0 = (size_t)b * SEQ + q0;
        bf16x8 qf[4];
#pragma unroll
        for (int ks = 0; ks < 4; ++ks) qf[ks] = *(const bf16x8*)(QS + (m0 + l31) * SW_W + h * SW_D + 16 * ks + 8 * hh);
        f32x16 s[5];
#pragma unroll
        for (int i = 0; i < 5; ++i) {
            const int ts = q0 - 128 + 32 * i;
            if (ts < 0) {
#pragma unroll
                for (int r = 0; r < 16; ++r) s[i][r] = -INFINITY;
            } else {
                f32x16 acc;
#pragma unroll
                for (int r = 0; r < 16; ++r) acc[r] = 0.f;
#pragma unroll
                for (int ks = 0; ks < 4; ++ks) { const bf16x8 kf = *(const bf16x8*)(KS + ((size_t)bk * SEQ + ts + l31) * SW_D + 16 * ks + 8 * hh); acc = MFMA32(kf, qf[ks], acc); }
#pragma unroll
                for (int r = 0; r < 16; ++r) { const int row = (r & 3) + 8 * (r >> 2) + 4 * hh, dist = 128 - 32 * i + l31 - row; const bool ok = dist >= 0 && dist <= 127;
                    s[i][r] = ok ? acc[r] + biasT[h * 128 + (dist & 127)] : -INFINITY; }
            }
        }
        const float sink2 = F.in[9][h] * LOG2E;
        float mx = sink2;
#pragma unroll
        for (int i = 0; i < 5; ++i)
#pragma unroll
            for (int r = 0; r < 16; ++r) mx = fmaxf(mx, s[i][r]);
        mx = fmaxf(mx, __shfl_xor(mx, 32));
        float sum = 0.f;
#pragma unroll
        for (int i = 0; i < 5; ++i)
#pragma unroll
            for (int r = 0; r < 16; ++r) { const float p = __builtin_amdgcn_exp2f(s[i][r] - mx); s[i][r] = p; sum += p; }
        sum += __shfl_xor(sum, 32);
        const float inv = __builtin_amdgcn_rcpf(sum + __builtin_amdgcn_exp2f(sink2 - mx));
        f32x16 O[2];
#pragma unroll
        for (int r = 0; r < 16; ++r) { O[0][r] = 0.f; O[1][r] = 0.f; }
#pragma unroll
        for (int i = 0; i < 5; ++i) {
            const int ts = q0 - 128 + 32 * i;
            if (ts >= 0) {
#pragma unroll
                for (int s2 = 0; s2 < 2; ++s2) {
                    v4u w; w.x = cvtpk(s[i][8 * s2] * inv, s[i][8 * s2 + 1] * inv); w.y = cvtpk(s[i][8 * s2 + 2] * inv, s[i][8 * s2 + 3] * inv); w.z = cvtpk(s[i][8 * s2 + 4] * inv, s[i][8 * s2 + 5] * inv); w.w = cvtpk(s[i][8 * s2 + 6] * inv, s[i][8 * s2 + 7] * inv);
                    const bf16x8 pa = __builtin_bit_cast(bf16x8, w);
#pragma unroll
                    for (int nt = 0; nt < 2; ++nt) { const bf16x8 vf = *(const bf16x8*)(VT + ((size_t)(bk * 128 + (ts >> 5)) * 64 + 32 * nt + l31) * 32 + s2 * 16 + hh * 8); O[nt] = MFMA32(pa, vf, O[nt]); }
                }
            }
        }
#pragma unroll
        for (int nt = 0; nt < 2; ++nt)
#pragma unroll
            for (int r = 0; r < 16; ++r) { const int q = (r & 3) + 8 * (r >> 2) + 4 * hh; QS[(m0 + q) * SW_W + h * SW_D + 32 * nt + l31] = (bf16)(cvtpk(O[nt][r], 0.f) & 0xffffu); }
    }
}

constexpr int DNL_QT = 0, DNL_KT = 17408, DNL_VT = 34816, DNL_WL = 52224, DNL_NA = 69632, DNL_QKM = 78848, DNL_DB = 88064, DNL_TIB = 92160, DNL_GC = 94208, DNL_BETA = 94464;
constexpr int TP = 272;
constexpr int NP2 = 144;
struct DnRec { bf16* UA; bf16* UB; bf16* W; bf16* QG; bf16* KD; bf16* QK; float* EGL;
    __device__ __forceinline__ bf16* u(int ch, int sl, int mt, int lane) const { return (ch < 640 ? UA + (size_t)ch * 8192 : UB + (size_t)(ch - 640) * 8192) + ((sl * 4 + mt) * 64 + lane) * 4; } };
__device__ __forceinline__ DnRec dn_rec(Frame& F) {
    DnRec r; r.W = (bf16*)F.out; r.QG = r.W + 8 * 1024 * 1024; r.KD = r.W + 16 * 1024 * 1024; r.QK = r.W + 24 * 1024 * 1024; r.UA = r.W + 27 * 1024 * 1024; r.UB = (bf16*)(F.ws + WS_UB); r.EGL = (float*)(F.ws + WS_SSQ); return r;
}
__device__ __forceinline__ void dn_chunk_prep(Frame& F) {
    const DnRec R = dn_rec(F);
    const bf16* proj = (const bf16*)(F.ws + WS_PROJ); const float* conv = F.in[3]; const float* gbp = (const float*)(F.ws + WS_GB);
    LAS unsigned char* L = F.lds + RING_OFF;
    LAS float* GC = (LAS float*)(L + DNL_GC); LAS float* BETA = (LAS float*)(L + DNL_BETA); LAS float* DB = (LAS float*)(L + DNL_DB);
    const int lane = F.lane, wave = F.wave, r16 = lane & 15, g = lane >> 4;
    const int tk0 = 8 * wave;
    unsigned raw[3][11]; float gx, gbl;
#define DN_LOAD_INPUTS(ch_) do { const int bh_ = (ch_) >> 6, c_ = (ch_) & 63, b_ = bh_ >> 2, h_ = bh_ & 3; const size_t m0_ = (size_t)b_ * SEQ + 64 * c_; \
        gx = gbp[(m0_ + lane) * 8 + 4 + h_]; gbl = gbp[(m0_ + lane) * 8 + h_]; \
        _Pragma("unroll") for (int p = 0; p < 3; ++p) { const int col_ = p * DN_W + h_ * DN_D + 2 * lane; \
            _Pragma("unroll") for (int r = 0; r < 11; ++r) { const int tr_ = 64 * c_ + tk0 - 3 + r; raw[p][r] = *(const unsigned*)(proj + (m0_ - 64 * c_ + (tr_ < 0 ? 0 : tr_)) * NP + col_); } } } while (0)
    if (F.vcu < 1024) DN_LOAD_INPUTS(F.vcu);
    for (int ch = F.vcu; ch < 1024; ch += F.G) {
        const int bh = ch >> 6, c = ch & 63, b = bh >> 2, h = bh & 3; const size_t m0 = (size_t)b * SEQ + 64 * c;
        {
            float cw[3][4][2];
#pragma unroll
            for (int p = 0; p < 3; ++p) { const int col = p * DN_W + h * DN_D + 2 * lane;
#pragma unroll
                for (int j = 0; j < 4; ++j) { cw[p][j][0] = conv[j * DN_QKV + col]; cw[p][j][1] = conv[j * DN_QKV + col + 1]; } }
            if (wave == 0) { float x = gx;
#pragma unroll
                for (int off = 1; off < 64; off <<= 1) { const float t = __shfl_up(x, off); if (lane >= off) x += t; }
                GC[lane] = x; BETA[lane] = gbl; }
            if (64 * c + tk0 < 3) {
#pragma unroll
                for (int p = 0; p < 3; ++p)
#pragma unroll
                    for (int r = 0; r < 3; ++r) if (64 * c + tk0 - 3 + r < 0) raw[p][r] = 0u;
            }
            float val[8][3][2], sq[8], sk[8];
#pragma unroll
            for (int i = 0; i < 8; ++i) {
#pragma unroll
                for (int p = 0; p < 3; ++p) { float a0 = 0.f, a1 = 0.f;
#pragma unroll
                    for (int j = 0; j < 4; ++j) { a0 += cw[p][j][0] * bflo(raw[p][i + j]); a1 += cw[p][j][1] * bfhi(raw[p][i + j]); }
                    val[i][p][0] = a0 * sigm(a0); val[i][p][1] = a1 * sigm(a1); }
                sq[i] = val[i][0][0] * val[i][0][0] + val[i][0][1] * val[i][0][1]; sk[i] = val[i][1][0] * val[i][1][0] + val[i][1][1] * val[i][1][1]; }
#pragma unroll
            for (int i = 0; i < 8; ++i) { sq[i] = wave_sum(sq[i]); sk[i] = wave_sum(sk[i]); }
#pragma unroll
            for (int i = 0; i < 8; ++i) {
                const float rq = frsq(sq[i] + EPS) * 0.08838834764831845f, rk = frsq(sk[i] + EPS);
                const int o = (tk0 + i) * TP + 4 * lane;
                *(LAS unsigned*)(L + DNL_QT + o) = cvtpk(val[i][0][0] * rq, val[i][0][1] * rq);
                *(LAS unsigned*)(L + DNL_KT + o) = cvtpk(val[i][1][0] * rk, val[i][1][1] * rk);
                *(LAS unsigned*)(L + DNL_VT + o) = cvtpk(val[i][2][0], val[i][2][1]);
            }
        }
        __syncthreads();
        if (ch + F.G < 1024) DN_LOAD_INPUTS(ch + F.G);
        for (int id = wave; id < 20 * REP_S2; id += 8) {
            const int e = id % 10, isqk = (id / 10) & 1, ti = (e >= 6) ? 3 : (e >= 3) ? 2 : (e >= 1) ? 1 : 0, tj = e - ti * (ti + 1) / 2;
            f32x4 acc = {0.f, 0.f, 0.f, 0.f};
            const int xoff = isqk ? DNL_QT : DNL_KT;
#pragma unroll
            for (int ks = 0; ks < 4; ++ks) {
                const bf16x8 a = *(const LAS bf16x8*)(L + DNL_KT + (16 * tj + r16) * TP + (32 * ks + 8 * g) * 2);
                const bf16x8 bq = *(const LAS bf16x8*)(L + xoff + (16 * ti + r16) * TP + (32 * ks + 8 * g) * 2);
                acc = MFMA16(a, bq, acc); }
            const int i = 16 * ti + r16; const float gi = GC[i], bi = BETA[i]; const f32x4 gj = *(const LAS f32x4*)(GC + 16 * tj + 4 * g);
            f32x4 v;
#pragma unroll
            for (int r = 0; r < 4; ++r) { const int jp = 16 * tj + 4 * g + r; const float d = __expf(fminf(gi - gj[r], 0.f));
                v[r] = isqk ? ((i >= jp) ? acc[r] * d : 0.f) : ((i > jp) ? bi * acc[r] * d : 0.f); }
            if (!isqk) {
                u32x2 w; w.x = cvtpk(-v[0], -v[1]); w.y = cvtpk(-v[2], -v[3]);
                *(LAS u32x2*)(L + DNL_NA + i * NP2 + (16 * tj + 4 * g) * 2) = w;
                if (ti == tj) *(LAS f32x4*)(DB + (ti * 16 + r16) * 16 + 4 * g) = v;
            } else { u32x2 w; w.x = cvtpk(v[0], v[1]); w.y = cvtpk(v[2], v[3]); *(LAS u32x2*)(L + DNL_QKM + i * NP2 + (16 * tj + 4 * g) * 2) = w; }
        }
        __syncthreads();
        for (int rep3_ = 0; rep3_ < REP_S3A; ++rep3_) if (wave < 4) {
            const int I = wave; float x[16];
#pragma unroll
            for (int i = 0; i < 16; ++i) { float a = (i == r16) ? 1.f : 0.f;
#pragma unroll
                for (int j4 = 0; j4 < (i + 3) / 4; ++j4) { const f32x4 d = *(const LAS f32x4*)(DB + (I * 16 + i) * 16 + 4 * j4);
#pragma unroll
                    for (int jj = 0; jj < 4; ++jj) if (4 * j4 + jj < i) a -= d[jj] * x[4 * j4 + jj]; }
                x[i] = a; }
            if (lane < 16) {
#pragma unroll
                for (int i = 0; i < 16; ++i) *(LAS unsigned short*)(L + DNL_TIB + ((I * 16 + i) * 16 + r16) * 2) = (unsigned short)(cvtpk(x[i], 0.f) & 0xffffu);
            }
        }
        __syncthreads();
        for (int rep4_ = 0; rep4_ < REP_S3B; ++rep4_) {
            const int part = wave >> 2, colbase = 32 * (wave & 3);
            f32x4 X[2][4];
#pragma unroll
            for (int I = 0; I < 4; ++I)
#pragma unroll
                for (int nt = 0; nt < 2; ++nt) {
                    const int col = colbase + 16 * nt + r16;
                    f32x4 acc;
#pragma unroll
                    for (int r = 0; r < 4; ++r) { const int tok = 16 * I + 4 * g + r;
                        acc[r] = part == 0 ? BETA[tok] * bf1(*(const LAS unsigned short*)(L + DNL_VT + tok * TP + col * 2))
                                           : -(BETA[tok] * __expf(GC[tok])) * bf1(*(const LAS unsigned short*)(L + DNL_KT + tok * TP + col * 2)); }
                    if (I >= 1) {
                        const u32x2 lo = *(const LAS u32x2*)(L + DNL_NA + (16 * I + r16) * NP2 + (4 * g) * 2);
                        u32x2 hi = {0u, 0u}; if (I >= 2) hi = *(const LAS u32x2*)(L + DNL_NA + (16 * I + r16) * NP2 + (16 + 4 * g) * 2);
                        const v4u aw = {lo.x, lo.y, hi.x, hi.y};
                        const bf16x8 bb = (I >= 2) ? pack8(X[nt][0], X[nt][1]) : pack8z(X[nt][0]);
                        acc = MFMA16(__builtin_bit_cast(bf16x8, aw), bb, acc);
                    }
                    if (I == 3) {
                        const u32x2 lo = *(const LAS u32x2*)(L + DNL_NA + (16 * I + r16) * NP2 + (32 + 4 * g) * 2);
                        const v4u aw = {lo.x, lo.y, 0u, 0u};
                        acc = MFMA16(__builtin_bit_cast(bf16x8, aw), pack8z(X[nt][2]), acc);
                    }
                    const u32x2 tl = *(const LAS u32x2*)(L + DNL_TIB + ((I * 16 + r16) * 16 + 4 * g) * 2);
                    const v4u tw = {tl.x, tl.y, 0u, 0u};
                    const f32x4 zero = {0.f, 0.f, 0.f, 0.f};
                    X[nt][I] = MFMA16(__builtin_bit_cast(bf16x8, tw), pack8z(acc), zero);
                    if (part == 0) { u32x2 w; w.x = cvtpk(X[nt][I][0], X[nt][I][1]); w.y = cvtpk(X[nt][I][2], X[nt][I][3]); *(u32x2*)R.u(ch, 2 * (wave & 3) + nt, I, lane) = w; }
                    else {
#pragma unroll
                        for (int r = 0; r < 4; ++r) *(LAS unsigned short*)(L + DNL_WL + (16 * I + 4 * g + r) * TP + col * 2) = (unsigned short)(cvtpk(X[nt][I][r], 0.f) & 0xffffu);
                    }
                }
        }
        __syncthreads();
        for (int it0 = wave; it0 < 54 * REP_S4; it0 += 8) { const int it = it0 % 54;
            if (it < 32) {
                const int f = it & 15, mt = f >> 2, ks = f & 3, base = (it < 16 ? DNL_WL : DNL_QT) + (16 * mt + r16) * TP;
                const u32x2 lo = *(const LAS u32x2*)(L + base + (32 * ks + 4 * g) * 2), hi = *(const LAS u32x2*)(L + base + (32 * ks + 16 + 4 * g) * 2);
                v4u w = {lo.x, lo.y, hi.x, hi.y};
                if (it >= 16) { const float e = __expf(GC[16 * mt + r16]);
#pragma unroll
                    for (int j = 0; j < 4; ++j) w[j] = cvtpk(bflo(w[j]) * e, bfhi(w[j]) * e); }
                *(v4u*)((it < 16 ? R.W : R.QG) + ((size_t)(ch * 16 + f) * 64 + lane) * 8) = w;
            } else if (it < 48) {
                const int f = it - 32, mt8 = f >> 1, kt = f & 1, dk = 16 * mt8 + r16; const float gl = GC[63];
                float v[8];
#pragma unroll
                for (int j = 0; j < 8; ++j) { const int tok = 32 * kt + (j < 4 ? 4 * g + j : 16 + 4 * g + j - 4); v[j] = bf1(*(const LAS unsigned short*)(L + DNL_KT + tok * TP + dk * 2)) * __expf(gl - GC[tok]); }
                v4u w; w.x = cvtpk(v[0], v[1]); w.y = cvtpk(v[2], v[3]); w.z = cvtpk(v[4], v[5]); w.w = cvtpk(v[6], v[7]);
                *(v4u*)(R.KD + ((size_t)(ch * 16 + f) * 64 + lane) * 8) = w;
            } else {
                const int q = it - 48, mt = (q == 0) ? 0 : (q == 1) ? 1 : (q < 4) ? 2 : 3, kt = (q == 3 || q == 5) ? 1 : 0;
                const u32x2 lo = *(const LAS u32x2*)(L + DNL_QKM + (16 * mt + r16) * NP2 + (32 * kt + 4 * g) * 2);
                u32x2 hi = {0u, 0u}; if (2 * kt + 1 <= mt) hi = *(const LAS u32x2*)(L + DNL_QKM + (16 * mt + r16) * NP2 + (32 * kt + 16 + 4 * g) * 2);
                const v4u w = {lo.x, lo.y, hi.x, hi.y};
                *(v4u*)(R.QK + ((size_t)(ch * 6 + q) * 64 + lane) * 8) = w;
            }
        }
        if (F.tid == 0) R.EGL[ch] = __expf(GC[63]);
        __syncthreads();
    }
}
__device__ __forceinline__ void dn_scan(Frame& F, int task) {
    const DnRec R = dn_rec(F);
    const int bh = task >> 3, sl = task & 7, lane = F.lane;
    f32x4 S[8];
#pragma unroll
    for (int i = 0; i < 8; ++i) S[i] = (f32x4){0.f, 0.f, 0.f, 0.f};
    bf16x8 Wf[16]; u32x2 Uf[4];
    {
        const int ch = bh * 64;
#pragma unroll
        for (int f = 0; f < 16; ++f) Wf[f] = *(const bf16x8*)(R.W + ((size_t)(ch * 16 + f) * 64 + lane) * 8);
#pragma unroll
        for (int mt = 0; mt < 4; ++mt) Uf[mt] = *(const u32x2*)R.u(ch, sl, mt, lane);
    }
    for (int c = 0; c < 64; ++c) {
        const int ch = bh * 64 + c;
        bf16x8 QGf[16];
#pragma unroll
        for (int f = 0; f < 16; ++f) QGf[f] = *(const bf16x8*)(R.QG + ((size_t)(ch * 16 + f) * 64 + lane) * 8);
        bf16x8 Sb[4];
#pragma unroll
        for (int ks = 0; ks < 4; ++ks) Sb[ks] = pack8(S[2 * ks], S[2 * ks + 1]);
        f32x4 vn[4];
#pragma unroll
        for (int mt = 0; mt < 4; ++mt) { vn[mt] = (f32x4){bflo(Uf[mt].x), bfhi(Uf[mt].x), bflo(Uf[mt].y), bfhi(Uf[mt].y)};
#pragma unroll
            for (int ks = 0; ks < 4; ++ks) vn[mt] = MFMA16(Wf[mt * 4 + ks], Sb[ks], vn[mt]); }
        bf16x8 QKf[6], KDf[16];
#pragma unroll
        for (int f = 0; f < 6; ++f) QKf[f] = *(const bf16x8*)(R.QK + ((size_t)(ch * 6 + f) * 64 + lane) * 8);
#pragma unroll
        for (int f = 0; f < 16; ++f) KDf[f] = *(const bf16x8*)(R.KD + ((size_t)(ch * 16 + f) * 64 + lane) * 8);
        const float egl = R.EGL[ch];
        f32x4 o[4];
#pragma unroll
        for (int mt = 0; mt < 4; ++mt) { o[mt] = (f32x4){0.f, 0.f, 0.f, 0.f};
#pragma unroll
            for (int ks = 0; ks < 4; ++ks) o[mt] = MFMA16(QGf[mt * 4 + ks], Sb[ks], o[mt]); }
        const bf16x8 vb0 = pack8(vn[0], vn[1]), vb1 = pack8(vn[2], vn[3]);
        if (c + 1 < 64) {
#pragma unroll
            for (int f = 0; f < 16; ++f) Wf[f] = *(const bf16x8*)(R.W + ((size_t)((ch + 1) * 16 + f) * 64 + lane) * 8);
#pragma unroll
            for (int mt = 0; mt < 4; ++mt) Uf[mt] = *(const u32x2*)R.u(ch + 1, sl, mt, lane);
        }
        o[0] = MFMA16(QKf[0], vb0, o[0]); o[1] = MFMA16(QKf[1], vb0, o[1]);
        o[2] = MFMA16(QKf[2], vb0, o[2]); o[2] = MFMA16(QKf[3], vb1, o[2]);
        o[3] = MFMA16(QKf[4], vb0, o[3]); o[3] = MFMA16(QKf[5], vb1, o[3]);
#pragma unroll
        for (int i = 0; i < 8; ++i) { S[i] = S[i] * egl; S[i] = MFMA16(KDf[2 * i], vb0, S[i]); S[i] = MFMA16(KDf[2 * i + 1], vb1, S[i]); }
#pragma unroll
        for (int mt = 0; mt < 4; ++mt) { u32x2 w; w.x = cvtpk(o[mt][0], o[mt][1]); w.y = cvtpk(o[mt][2], o[mt][3]); *(u32x2*)R.u(ch, sl, mt, lane) = w; }
    }
}
__device__ __forceinline__ void dn_out2(Frame& F) {
    const DnRec R = dn_rec(F);
    const int gw = F.vcu * NWAVES + F.wave, NGW = F.G * NWAVES, lane = F.lane, r16 = lane & 15, g = lane >> 4;
    const bf16* proj = (const bf16*)(F.ws + WS_PROJ); bf16* YDN = (bf16*)(F.ws + WS_Y); const float* gain = F.in[6];
    for (int task = gw; task < 4096; task += NGW) {
        const int ch = task >> 2, mt = task & 3, bh = ch >> 6, c = ch & 63, b = bh >> 2, h = bh & 3;
        f32x4 o[8]; float ss[4] = {0.f, 0.f, 0.f, 0.f};
#pragma unroll
        for (int sl = 0; sl < 8; ++sl) { const u32x2 w = *(const u32x2*)R.u(ch, sl, mt, lane); o[sl] = (f32x4){bflo(w.x), bfhi(w.x), bflo(w.y), bfhi(w.y)};
#pragma unroll
            for (int r = 0; r < 4; ++r) ss[r] += o[sl][r] * o[sl][r]; }
#pragma unroll
        for (int r = 0; r < 4; ++r) { float s = sum16(ss[r]); ss[r] = frsq(s * (1.0f / DN_D) + EPS); }
#pragma unroll
        for (int sl = 0; sl < 8; ++sl) { const int d = 16 * sl + r16; const float gd = gain[d];
#pragma unroll
            for (int r = 0; r < 4; ++r) { const size_t m = (size_t)b * SEQ + 64 * c + 16 * mt + 4 * g + r; const float z = bf1(proj[m * NP + PC_Z + h * DN_D + d]);
                YDN[m * DN_W + h * DN_D + d] = (bf16)(cvtpk(o[sl][r] * ss[r] * gd * z * sigm(z), 0.f) & 0xffffu); } }
    }
}
constexpr int SCAN_SLOT = 55296;
__device__ __forceinline__ void dn_scan_wg(Frame& F, int bh, int half) {
    const DnRec R = dn_rec(F);
    const int lane = F.lane, wave = F.wave;
    LAS unsigned char* ring = F.lds + RING_OFF;
    if (wave >= 4) {
        const int lw = wave - 4;
        for (int c = -1; c < 63; ++c) {
            const int ch = bh * 64 + c + 1; LAS unsigned char* slot = ring + ((c + 1) & 1) * SCAN_SLOT;
            for (int p = lw; p < 54; p += 4) {
                const bf16* src = p < 16 ? R.W + (size_t)ch * 8192 + p * 512 : p < 32 ? R.QG + (size_t)ch * 8192 + (p - 16) * 512 : p < 48 ? R.KD + (size_t)ch * 8192 + (p - 32) * 512 : R.QK + (size_t)ch * 3072 + (p - 48) * 512;
                __builtin_amdgcn_global_load_lds((const unsigned*)(src + lane * 8), (LAS unsigned*)(slot + p * 1024), 16, 0, 0);
            }
            asm volatile("s_waitcnt vmcnt(0)" ::: "memory");
            __builtin_amdgcn_s_barrier();
            asm volatile("" ::: "memory");
        }
        __builtin_amdgcn_s_barrier();
    } else {
        const int sl = half * 4 + wave;
        f32x4 S[8];
#pragma unroll
        for (int i = 0; i < 8; ++i) S[i] = (f32x4){0.f, 0.f, 0.f, 0.f};
        u32x2 Uf[4];
#pragma unroll
        for (int mt = 0; mt < 4; ++mt) Uf[mt] = *(const u32x2*)R.u(bh * 64, sl, mt, lane);
        float egl = R.EGL[bh * 64];
        asm volatile("" ::: "memory");
        __builtin_amdgcn_s_barrier();
        asm volatile("" ::: "memory");
        for (int c = 0; c < 64; ++c) {
            const int ch = bh * 64 + c;
            const LAS unsigned char* slot = ring + (c & 1) * SCAN_SLOT + lane * 16;
            bf16x8 Sb[4];
#pragma unroll
            for (int ks = 0; ks < 4; ++ks) Sb[ks] = pack8(S[2 * ks], S[2 * ks + 1]);
            f32x4 vn[4], o[4];
#pragma unroll
            for (int mt = 0; mt < 4; ++mt) { vn[mt] = (f32x4){bflo(Uf[mt].x), bfhi(Uf[mt].x), bflo(Uf[mt].y), bfhi(Uf[mt].y)};
#pragma unroll
                for (int ks = 0; ks < 4; ++ks) vn[mt] = MFMA16(*(const LAS bf16x8*)(slot + (mt * 4 + ks) * 1024), Sb[ks], vn[mt]); }
            u32x2 Un[4]; float egln = 0.f;
            if (c + 1 < 64) {
#pragma unroll
                for (int mt = 0; mt < 4; ++mt) Un[mt] = *(const u32x2*)R.u(ch + 1, sl, mt, lane);
                egln = R.EGL[ch + 1];
            } else {
#pragma unroll
                for (int mt = 0; mt < 4; ++mt) Un[mt] = (u32x2){0u, 0u};
            }
#pragma unroll
            for (int mt = 0; mt < 4; ++mt) { o[mt] = (f32x4){0.f, 0.f, 0.f, 0.f};
#pragma unroll
                for (int ks = 0; ks < 4; ++ks) o[mt] = MFMA16(*(const LAS bf16x8*)(slot + 16384 + (mt * 4 + ks) * 1024), Sb[ks], o[mt]); }
            const bf16x8 vb0 = pack8(vn[0], vn[1]), vb1 = pack8(vn[2], vn[3]);
            const LAS unsigned char* qk = slot + 49152;
            o[0] = MFMA16(*(const LAS bf16x8*)(qk + 0 * 1024), vb0, o[0]); o[1] = MFMA16(*(const LAS bf16x8*)(qk + 1 * 1024), vb0, o[1]);
            o[2] = MFMA16(*(const LAS bf16x8*)(qk + 2 * 1024), vb0, o[2]); o[2] = MFMA16(*(const LAS bf16x8*)(qk + 3 * 1024), vb1, o[2]);
            o[3] = MFMA16(*(const LAS bf16x8*)(qk + 4 * 1024), vb0, o[3]); o[3] = MFMA16(*(const LAS bf16x8*)(qk + 5 * 1024), vb1, o[3]);
#pragma unroll
            for (int i = 0; i < 8; ++i) { S[i] = S[i] * egl; S[i] = MFMA16(*(const LAS bf16x8*)(slot + 32768 + (2 * i) * 1024), vb0, S[i]); S[i] = MFMA16(*(const LAS bf16x8*)(slot + 32768 + (2 * i + 1) * 1024), vb1, S[i]); }
#pragma unroll
            for (int mt = 0; mt < 4; ++mt) { u32x2 w; w.x = cvtpk(o[mt][0], o[mt][1]); w.y = cvtpk(o[mt][2], o[mt][3]); *(u32x2*)R.u(ch, sl, mt, lane) = w; }
#pragma unroll
            for (int mt = 0; mt < 4; ++mt) Uf[mt] = Un[mt];
            egl = egln;
            asm volatile("s_waitcnt lgkmcnt(0)" ::: "memory");
            __builtin_amdgcn_s_barrier();
            asm volatile("" ::: "memory");
        }
    }
}
__device__ __forceinline__ void run_phase0(Frame& F) {
    unsigned char* ws = F.ws; bf16* XB = (bf16*)(ws + WS_XB); bf16* Y = (bf16*)(ws + WS_Y); bf16* PROJ = (bf16*)(ws + WS_PROJ); (void)XB; (void)Y; (void)PROJ;
        p0_prologue(F);
}
__device__ __forceinline__ void run_phase1(Frame& F) {
    unsigned char* ws = F.ws; bf16* XB = (bf16*)(ws + WS_XB); bf16* Y = (bf16*)(ws + WS_Y); bf16* PROJ = (bf16*)(ws + WS_PROJ); (void)XB; (void)Y; (void)PROJ;
        const int N1 = (F.G == 256) ? P1_TILES * 256 : NP;
        pg8::Gemm g{XB, (const bf16*)(ws + WS_WIN), M, N1, D}; pg8::StaticOrder S; S.init(M, N1, F.G, (int)blockIdx.x);
        pg8::EpiProj E{PROJ, NP, (const float*)(ws + WS_RSTD), PC_G / 256, 0};
        pg8::gemm_phase<pg8::EpiProj, pg8::StaticOrder, true, true>(F.lds + RING_OFF, g, S, E);
}
__device__ __forceinline__ void run_phase2(Frame& F) {
    unsigned char* ws = F.ws; bf16* XB = (bf16*)(ws + WS_XB); bf16* Y = (bf16*)(ws + WS_Y); bf16* PROJ = (bf16*)(ws + WS_PROJ); (void)XB; (void)Y; (void)PROJ;
#if FAST_DN
        for (int rep_ = 0; rep_ < REP_DNA; ++rep_) dn_chunk_prep(F);
#else
        dn_pre(F);
#endif
#if FAST_SWA
        for (int rep_ = 0; rep_ < REP_SWAPRE; ++rep_) swa_pre(F);
#endif
}
__device__ __forceinline__ void run_phase3(Frame& F) {
    unsigned char* ws = F.ws; bf16* XB = (bf16*)(ws + WS_XB); bf16* Y = (bf16*)(ws + WS_Y); bf16* PROJ = (bf16*)(ws + WS_PROJ); (void)XB; (void)Y; (void)PROJ;
#if FAST_DN
        if (F.G == 256) {
            const int bx = (int)blockIdx.x;
            if (((bx >> 3) & 7) == 0) {
                const int xcd = bx & 7, j = bx >> 6;
                dn_scan_wg(F, xcd * 2 + (j >> 1), j & 1);
            } else {
                const int gi = (bx >> 6) * 56 + (bx & 63) - 8, NG = NP - P1_TILES * 256;
                pg8::Gemm g{XB, (const bf16*)(ws + WS_WIN) + (size_t)P1_TILES * 256 * D, M, NG, D}; pg8::StaticOrder S; S.init(M, NG, 224, gi);
                pg8::EpiProj E{PROJ, NP, (const float*)(ws + WS_RSTD), PC_G / 256, P1_TILES};
                pg8::gemm_phase<pg8::EpiProj, pg8::StaticOrder, true, true>(F.lds + RING_OFF, g, S, E);
                swa_bias_table(F); __syncthreads();
                swa_main(F, gi * NWAVES + F.wave, 224 * NWAVES);
            }
        } else {
        swa_bias_table(F); __syncthreads();
        {
            const int nscan = F.G < 128 ? F.G : 128;
            if (F.wave == 0 && F.vcu < nscan) { for (int task = F.vcu; task < 128; task += nscan) dn_scan(F, task); }
            else { const int worker = F.vcu < nscan ? F.vcu * 7 + F.wave - 1 : nscan * 7 + (F.vcu - nscan) * 8 + F.wave; swa_main(F, worker, nscan * 7 + (F.G - nscan) * 8); }
        }
        }
#elif FAST_SWA
        if (F.vcu < 16) dn_scan_naive(F, F.vcu);
        else { swa_bias_table(F); __syncthreads(); swa_main(F, (F.vcu - 16) * NWAVES + F.wave, (F.G - 16) * NWAVES); }
#else
        if (F.G > 16) { if (F.vcu < 16) dn_scan_naive(F, F.vcu); else swa_naive(F, (F.vcu - 16) * NWAVES + F.wave, (F.G - 16) * NWAVES); }
        else { for (int bh = F.vcu; bh < 16; bh += F.G) dn_scan_naive(F, bh); swa_naive(F, F.vcu * NWAVES + F.wave, F.G * NWAVES); }
#endif
}
__device__ __forceinline__ void run_phase4(Frame& F) {
    unsigned char* ws = F.ws; bf16* XB = (bf16*)(ws + WS_XB); bf16* Y = (bf16*)(ws + WS_Y); bf16* PROJ = (bf16*)(ws + WS_PROJ); (void)XB; (void)Y; (void)PROJ;
#if FAST_DN
        dn_out2(F);
#else
        dn_out(F);
#endif
}
__device__ __forceinline__ void run_phase5(Frame& F) {
    unsigned char* ws = F.ws; bf16* XB = (bf16*)(ws + WS_XB); bf16* Y = (bf16*)(ws + WS_Y); bf16* PROJ = (bf16*)(ws + WS_PROJ); (void)XB; (void)Y; (void)PROJ;
        pg8::Gemm g{Y, (const bf16*)(ws + WS_WAB), 2 * M, 2 * D, DN_W}; pg8::PairedOrder S; S.init(M, D, F.G, (int)blockIdx.x);
        pg8::EpiMerge E{PROJ + PC_G, NP, XB, D, M / 256, D / 256};
        pg8::gemm_phase<pg8::EpiMerge, pg8::PairedOrder, false, true>(F.lds + RING_OFF, g, S, E);
}
__device__ __forceinline__ void run_phase6(Frame& F) {
    unsigned char* ws = F.ws; bf16* XB = (bf16*)(ws + WS_XB); bf16* Y = (bf16*)(ws + WS_Y); bf16* PROJ = (bf16*)(ws + WS_PROJ); (void)XB; (void)Y; (void)PROJ;
        pg8::Gemm g{XB, (const bf16*)(ws + WS_WOUT), M, D, D}; pg8::StaticOrder S; S.init(M, D, F.G, (int)blockIdx.x);
        pg8::EpiX1 E{F.in[0], F.out, Y, (float*)(ws + WS_SSQ), D};
        pg8::gemm_phase<pg8::EpiX1, pg8::StaticOrder, false, true>(F.lds + RING_OFF, g, S, E);
}
__device__ __forceinline__ void run_phase7(Frame& F) {
    unsigned char* ws = F.ws; bf16* XB = (bf16*)(ws + WS_XB); bf16* Y = (bf16*)(ws + WS_Y); bf16* PROJ = (bf16*)(ws + WS_PROJ); (void)XB; (void)Y; (void)PROJ;
        pg8::Gemm g{Y, (const bf16*)(ws + WS_WGU), M, 2 * FF, D}; pg8::StaticOrder S; S.init(M, 2 * FF, F.G, (int)blockIdx.x);
        pg8::EpiSwiGLU E{PROJ, FF, (const float*)(ws + WS_SSQ), EPS};
        pg8::gemm_phase<pg8::EpiSwiGLU, pg8::StaticOrder, true, true>(F.lds + RING_OFF, g, S, E);
}
__device__ __forceinline__ void run_phase8(Frame& F) {
    unsigned char* ws = F.ws; bf16* XB = (bf16*)(ws + WS_XB); bf16* Y = (bf16*)(ws + WS_Y); bf16* PROJ = (bf16*)(ws + WS_PROJ); (void)XB; (void)Y; (void)PROJ;
        pg8::Gemm g{PROJ, (const bf16*)(ws + WS_WD), M, D, FF}; pg8::StaticOrder S; S.init(M, D, F.G, (int)blockIdx.x);
        pg8::EpiOut E{F.out, D};
        pg8::gemm_phase<pg8::EpiOut, pg8::StaticOrder, false, true>(F.lds + RING_OFF, g, S, E);
}
#ifndef PROGRAM
#define PROGRAM RUN(0) BAR RUN(1) BAR RUN(2) BAR RUN(3) BAR RUN(4) BAR RUN(5) BAR RUN(6) BAR RUN(7) BAR RUN(8)
#endif
struct Args { const float* in[18]; float* out; unsigned char* ws; int ph_lo, ph_hi, li, pad; };
__global__ void __launch_bounds__(NWAVES * 64, 2) fwd_kernel(Args args) {
    extern __shared__ __attribute__((aligned(16))) unsigned char lds[];
    Frame F;
    F.lds = (LAS unsigned char*)lds;
    F.MISC = (volatile LAS unsigned*)(F.lds + MISC_OFF);
    F.tid = threadIdx.x; F.lane = F.tid & 63; F.wave = __builtin_amdgcn_readfirstlane(F.tid >> 6);
    F.G = gridDim.x; { const int bx = blockIdx.x; F.vcu = (F.G % 8 == 0) ? (bx % 8) * (F.G / 8) + bx / 8 : bx; }
#pragma unroll
    for (int i = 0; i < 18; ++i) F.in[i] = args.in[i];
    F.out = args.out; F.ws = args.ws; unsigned char* ws = args.ws;
    F.ctl = (gu32*)(ws + WS_CTL);
    for (int u = F.tid; u < (LDS_BYTES - LDSCTL_OFF) / 4; u += NWAVES * 64) ((LAS unsigned*)(F.lds + LDSCTL_OFF))[u] = 0u;
    __syncthreads();
    XcdBarrier bar; bar.bar = (unsigned*)(F.ctl + CW_BAR) + args.li * XCD_BAR_WORDS; bar.x = 0; bar.st = nullptr;
    bar = xcd_barrier_post((unsigned*)(F.ctl + CW_BAR) + args.li * XCD_BAR_WORDS, F.MISC + 8);
#define RUN(k) run_phase##k(F);
#define BAR xcd_barrier(bar);
    PROGRAM
#undef RUN
#undef BAR
}

extern "C" void kernel_launch(void* const* d_in, const int* in_sizes, int n_in, void* d_out, int out_size, void* d_ws, size_t ws_size, hipStream_t stream) {
    static int grid = 0;
    if (grid == 0) {
        if (n_in != 18 || in_sizes[0] != M * D || out_size != M * D || ws_size < WS_END) { fprintf(stderr, "kernel_launch: unexpected shapes (n_in %d, in0 %d, out %d, ws %zu)\n", n_in, n_in > 0 ? in_sizes[0] : -1, out_size, ws_size); grid = -1; return; }
        int dev = 0, cus = 0;
        if (hipGetDevice(&dev) != hipSuccess || hipDeviceGetAttribute(&cus, hipDeviceAttributeMultiprocessorCount, dev) != hipSuccess) { grid = -1; return; }
        if (hipFuncSetAttribute((const void*)fwd_kernel, hipFuncAttributeMaxDynamicSharedMemorySize, LDS_BYTES) != hipSuccess) { fprintf(stderr, "kernel_launch: hipFuncSetAttribute failed\n"); grid = -1; return; }
        int per_cu = 0;
        if (hipOccupancyMaxActiveBlocksPerMultiprocessor(&per_cu, (const void*)fwd_kernel, NWAVES * 64, LDS_BYTES) != hipSuccess || per_cu < 1) fprintf(stderr, "kernel_launch: occupancy query reports %d\n", per_cu);
        (void)hipGetLastError();
        grid = cus;
    }
    if (grid < 0) return;
    if (hipMemsetAsync((char*)d_ws + WS_CTL, 0, CTL_ZERO_BYTES, stream) != hipSuccess) return;
    Args a{};
    for (int i = 0; i < 18; ++i) a.in[i] = (const float*)d_in[i];
    a.out = (float*)d_out; a.ws = (unsigned char*)d_ws;
    for (int li = 0; li < 1; ++li) {
        a.ph_lo = 0; a.ph_hi = 0;
        a.li = li;
        hipLaunchKernelGGL(fwd_kernel, dim3(grid), dim3(NWAVES * 64), LDS_BYTES, stream, a);
        const hipError_t le = hipPeekAtLastError();
        if (le != hipSuccess) { fprintf(stderr, "kernel_launch: launch %d failed: %s\n", li, hipGetErrorName(le)); break; }
    }
}
```

```cpp
#ifndef FAST_SWA
#define FAST_SWA 1
#endif
#ifndef FAST_DN
#define FAST_DN 1
#endif
#ifndef REP_DNA
#define REP_DNA 1
#endif
#ifndef REP_SWAPRE
#define REP_SWAPRE 1
#endif
#ifndef REP_S1
#define REP_S1 1
#endif
#ifndef REP_S2
#define REP_S2 1
#endif
#ifndef REP_S3A
#define REP_S3A 1
#endif
#ifndef REP_S3B
#define REP_S3B 1
#endif
#ifndef REP_S4
#define REP_S4 1
#endif
#ifndef S1_RELOAD
#define S1_RELOAD 0
#endif
#ifndef S1_OPAQUE
#define S1_OPAQUE 0
#endif
#ifndef P1_TILES
#define P1_TILES 12
#endif
#include <hip/hip_runtime.h>
#include <cstdio>
#include <cstdint>

#ifndef EPI_REP
#define EPI_REP 1
#endif
#ifndef EPI_REP_WHICH
#define EPI_REP_WHICH 0
#endif
#ifndef RES_F32
#define RES_F32 0
#endif
namespace pg8 {
#define PG8_LAS __attribute__((address_space(3)))
typedef unsigned short bf16_t;
typedef short bf16x8 __attribute__((ext_vector_type(8)));
typedef float f32x4 __attribute__((ext_vector_type(4)));
typedef unsigned u32x4 __attribute__((ext_vector_type(4)));
typedef unsigned u32x2 __attribute__((ext_vector_type(2)));
constexpr int BM = 256, BK = 64, HALF = 128, HTB = HALF * BK * 2  , STAGE_BYTES = 8 * HTB, NXCD = 8, WGM = 8;

__host__ __device__ __forceinline__ int lds_byte(int r, int c) { const int st = (r >> 4) * 2 + (c >> 5), rr = r & 15, cc = c & 31, ob = rr * 64 + cc * 2; return st * 1024 + (ob ^ (((ob >> 9) & 1) << 5)); }
__host__ __device__ __forceinline__ void stage_rc(int b, int& R, int& C) { const int st = b / 1024, sb = b % 1024, swz = sb ^ (((sb >> 9) & 1) << 5); R = (st >> 1) * 16 + swz / 64; C = (st & 1) * 32 + (swz % 64) / 2; }
__host__ __device__ __forceinline__ int perm32(int rho) { const int n = rho >> 4, i = rho & 15; return 8 * (i >> 2) + 4 * n + (i & 3); }

struct Unit { int pm, pn; };
struct Gemm { const bf16_t* A; const bf16_t* Bt; int M, N, K; };

struct StaticOrder {
    int nM, nN, nwg, G, c;
    __host__ __device__ void init(int M, int N, int G_, int c_) { nM = M / BM; nN = N / BM; nwg = nM * nN; G = G_; c = c_; }
    __host__ __device__ bool next(int i, Unit& u) const {
        const long L = (long)i * G + c; if (L >= nwg) return false;
        int wgid = (int)L; { const int q = nwg / NXCD, r = nwg % NXCD, xcd = wgid % NXCD, off = wgid / NXCD; wgid = (xcd < r ? xcd * (q + 1) : r * (q + 1) + (xcd - r) * q) + off; }
        const int nig = WGM * nN, gid = wgid / nig, fm = gid * WGM, gsz = (nM - fm) < WGM ? (nM - fm) : WGM;
        u.pm = fm + ((wgid % nig) % gsz); u.pn = (wgid % nig) / gsz; return true;
    }
    __device__ __forceinline__ void a_ready(const Unit&) const {}
    __device__ __forceinline__ void done(const Unit&) const {}
};
struct PairedOrder {
    StaticOrder so;
    __host__ __device__ void init(int M, int N, int G_, int c_) { so.init(M, N, G_, c_); }
    __host__ __device__ bool next(int i, Unit& u) const { if (!so.next(i >> 1, u)) return false; if (i & 1) { u.pm += so.nM; u.pn += so.nN; } return true; }
    __device__ __forceinline__ void a_ready(const Unit&) const {}
    __device__ __forceinline__ void done(const Unit&) const {}
};

__device__ __forceinline__ unsigned cvt_pk_bf16(float lo, float hi) { unsigned r; asm volatile("v_cvt_pk_bf16_f32 %0, %1, %2" : "=v"(r) : "v"(lo), "v"(hi)); return r; }
__device__ __forceinline__ float bf_lo(unsigned w) { return __builtin_bit_cast(float, w << 16); }
__device__ __forceinline__ float bf_hi(unsigned w) { return __builtin_bit_cast(float, w & 0xffff0000u); }
__device__ __forceinline__ float sigmoidf_(float x) { return 1.0f / (1.0f + __expf(-x)); }


struct EpiProj {
    static constexpr bool PERM = true, AFTER_DRAIN = false, PROBE_REP = (EPI_REP_WHICH == 1);
    bf16_t* O; int ldc; const float* rstd; int gate_pn0, pn_off;
    __device__ __forceinline__ bool keep(const Unit&) const { return false; }
    __device__ __forceinline__ void operator()(f32x4 (&acc)[2][2][4][2], const Unit& u, int wr, int wc, int fr, int fq) const {
        const int row0 = u.pm * BM + wr * 64 + fr, col0 = (u.pn + pn_off) * BM + wc * 64 + 8 * fq; const bool gate = (u.pn + pn_off) >= gate_pn0;
#pragma unroll
        for (int ai = 0; ai < 2; ++ai)
#pragma unroll
            for (int m = 0; m < 4; ++m) { const int row = row0 + ai * HALF + m * 16; const float s = rstd[row]; bf16_t* rowp = O + (size_t)row * ldc + col0;
#pragma unroll
                for (int bj = 0; bj < 2; ++bj) { f32x4 v0 = acc[ai][bj][m][0] * s, v1 = acc[ai][bj][m][1] * s;
                    if (gate) {
#pragma unroll
                        for (int j = 0; j < 4; ++j) { v0[j] = __builtin_amdgcn_rcpf(1.0f + __expf(-v0[j])); v1[j] = __builtin_amdgcn_rcpf(1.0f + __expf(-v1[j])); } }
                    u32x4 w; w.x = cvt_pk_bf16(v0[0], v0[1]); w.y = cvt_pk_bf16(v0[2], v0[3]); w.z = cvt_pk_bf16(v1[0], v1[1]); w.w = cvt_pk_bf16(v1[2], v1[3]);
                    *(u32x4*)(rowp + bj * 32) = w; } }
    }
};
struct EpiMerge {
    static constexpr bool PERM = true, AFTER_DRAIN = false, PROBE_REP = false;
    const bf16_t* G; int ldg; bf16_t* O; int ldc; int nM, nN;
    __device__ __forceinline__ bool keep(const Unit& u) const { return u.pm < nM; }
    __device__ __forceinline__ void operator()(f32x4 (&acc)[2][2][4][2], const Unit& u, int wr, int wc, int fr, int fq) const {
        const bool second = u.pm >= nM; const int pm = second ? u.pm - nM : u.pm, pn = second ? u.pn - nN : u.pn;
        const int row0 = pm * BM + wr * 64 + fr, col0 = pn * BM + wc * 64 + 8 * fq;
#pragma unroll
        for (int ai = 0; ai < 2; ++ai)
#pragma unroll
            for (int m = 0; m < 4; ++m) { const int row = row0 + ai * HALF + m * 16;
#pragma unroll
                for (int bj = 0; bj < 2; ++bj) { const int col = col0 + bj * 32;
                    const u32x4 ga = *(const u32x4*)(G + (size_t)row * ldg + col), gb = *(const u32x4*)(G + (size_t)row * ldg + 1024 + col);
                    float sa[8], sb[8];
#pragma unroll
                    for (int j = 0; j < 4; ++j) { sa[2 * j] = bf_lo(ga[j]); sa[2 * j + 1] = bf_hi(ga[j]); sb[2 * j] = bf_lo(gb[j]); sb[2 * j + 1] = bf_hi(gb[j]); }
                    if (!second) {
#pragma unroll
                        for (int j = 0; j < 4; ++j) { acc[ai][bj][m][0][j] *= sa[j] * __builtin_amdgcn_rcpf(sb[j]); acc[ai][bj][m][1][j] *= sa[4 + j] * __builtin_amdgcn_rcpf(sb[4 + j]); }
                    } else {
                        f32x4 v0, v1;
#pragma unroll
                        for (int j = 0; j < 4; ++j) { v0[j] = acc[ai][bj][m][0][j] * sb[j]; v1[j] = acc[ai][bj][m][1][j] * sb[4 + j]; }
                        u32x4 w; w.x = cvt_pk_bf16(v0[0], v0[1]); w.y = cvt_pk_bf16(v0[2], v0[3]); w.z = cvt_pk_bf16(v1[0], v1[1]); w.w = cvt_pk_bf16(v1[2], v1[3]);
                        *(u32x4*)(O + (size_t)row * ldc + col) = w; } } }
    }
};
struct EpiX1 {
    static constexpr bool PERM = false, AFTER_DRAIN = false, PROBE_REP = (EPI_REP_WHICH == 6);
    const float* X; float* out; bf16_t* xb; float* ssq; int ldc;
    __device__ __forceinline__ bool keep(const Unit&) const { return false; }
    __device__ __forceinline__ void operator()(f32x4 (&acc)[2][2][4][2], const Unit& u, int wr, int wc, int fr, int fq) const {
        const int row0 = u.pm * BM + wr * 64 + fr, col0 = u.pn * BM + wc * 32 + 4 * fq;
#pragma unroll
        for (int ai = 0; ai < 2; ++ai)
#pragma unroll
            for (int m = 0; m < 4; ++m) { const int row = row0 + ai * HALF + m * 16; const size_t off = (size_t)row * ldc + col0; float ss = 0.f;
#pragma unroll
                for (int bj = 0; bj < 2; ++bj)
#pragma unroll
                    for (int n = 0; n < 2; ++n) { const f32x4 xv = *(const f32x4*)(X + off + bj * HALF + n * 16); const f32x4 o = xv + acc[ai][bj][m][n];
                        if (RES_F32) *(f32x4*)(out + off + bj * HALF + n * 16) = o; ss += (o[0] * o[0] + o[1] * o[1]) + (o[2] * o[2] + o[3] * o[3]);
                        u32x2 w; w.x = cvt_pk_bf16(o[0], o[1]); w.y = cvt_pk_bf16(o[2], o[3]); *(u32x2*)(xb + off + bj * HALF + n * 16) = w; }
                ss += __shfl_xor(ss, 16); ss += __shfl_xor(ss, 32);
                if (fq == 0) ssq[(size_t)row * 16 + u.pn * 4 + wc] = ss; }
    }
};
struct EpiSwiGLU {
    static constexpr bool PERM = true, AFTER_DRAIN = false, PROBE_REP = (EPI_REP_WHICH == 7);
    bf16_t* O; int ldc; const float* ssq; float eps;
    __device__ __forceinline__ bool keep(const Unit&) const { return false; }
    __device__ __forceinline__ void operator()(f32x4 (&acc)[2][2][4][2], const Unit& u, int wr, int wc, int fr, int fq) const {
        const int row0 = u.pm * BM + wr * 64 + fr, col0 = u.pn * HALF + wc * 32 + 8 * fq;
#pragma unroll
        for (int ai = 0; ai < 2; ++ai)
#pragma unroll
            for (int m = 0; m < 4; ++m) { const int row = row0 + ai * HALF + m * 16;
                const f32x4* sp = (const f32x4*)(ssq + (size_t)row * 16); const f32x4 s0 = sp[0], s1 = sp[1], s2 = sp[2], s3 = sp[3];
                const float tot = ((s0[0] + s0[1]) + (s0[2] + s0[3])) + ((s1[0] + s1[1]) + (s1[2] + s1[3])) + ((s2[0] + s2[1]) + (s2[2] + s2[3])) + ((s3[0] + s3[1]) + (s3[2] + s3[3]));
                const float s = __builtin_amdgcn_rsqf(tot * (1.0f / 1024.0f) + eps);
                float a[8];
#pragma unroll
                for (int n = 0; n < 2; ++n)
#pragma unroll
                    for (int j = 0; j < 4; ++j) { const float g = acc[ai][0][m][n][j] * s, up = acc[ai][1][m][n][j] * s; a[4 * n + j] = g * up * __builtin_amdgcn_rcpf(1.0f + __expf(-g)); }
                u32x4 w; w.x = cvt_pk_bf16(a[0], a[1]); w.y = cvt_pk_bf16(a[2], a[3]); w.z = cvt_pk_bf16(a[4], a[5]); w.w = cvt_pk_bf16(a[6], a[7]);
                *(u32x4*)(O + (size_t)row * ldc + col0) = w; }
    }
};
struct EpiOut {
    static constexpr bool PERM = false, AFTER_DRAIN = false, PROBE_REP = false;
    float* out; int ldc; const bf16_t* xb;
    __device__ __forceinline__ bool keep(const Unit&) const { return false; }
    __device__ __forceinline__ void operator()(f32x4 (&acc)[2][2][4][2], const Unit& u, int wr, int wc, int fr, int fq) const {
        const int row0 = u.pm * BM + wr * 64 + fr, col0 = u.pn * BM + wc * 32 + 4 * fq;
#pragma unroll
        for (int ai = 0; ai < 2; ++ai)
#pragma unroll
            for (int m = 0; m < 4; ++m) { const size_t off = (size_t)(row0 + ai * HALF + m * 16) * ldc + col0;
#pragma unroll
                for (int bj = 0; bj < 2; ++bj)
#pragma unroll
                    for (int n = 0; n < 2; ++n) { f32x4 b;
                        if (RES_F32) b = *(const f32x4*)(out + off + bj * HALF + n * 16);
                        else { const u32x2 w = *(const u32x2*)(xb + off + bj * HALF + n * 16); b = (f32x4){bf_lo(w.x), bf_hi(w.x), bf_lo(w.y), bf_hi(w.y)}; }
                        *(f32x4*)(out + off + bj * HALF + n * 16) = b + acc[ai][bj][m][n]; } }
    }
};

template <class Epi, class Sched, bool ALIGN_EPI = false, bool SP2 = false>
__device__ __forceinline__ void gemm_phase(PG8_LAS unsigned char* lds, const Gemm g, const Sched& S, const Epi& E) {
    const int tid = threadIdx.x, wid = __builtin_amdgcn_readfirstlane(tid >> 6), lane = tid & 63, wr = wid >> 2, wc = wid & 3, fr = lane & 15, fq = lane >> 4;
    const int K = g.K, nt = K / BK;
    unsigned voffA[2], voffB[2];
#pragma unroll
    for (int i = 0; i < 2; ++i) { int R, C; stage_rc(tid * 16 + i * 8192, R, C); const int Rb = Epi::PERM ? ((R & ~31) + perm32(R & 31)) : R;
        voffA[i] = (unsigned)(R * K + C) * 2u; voffB[i] = (unsigned)(Rb * K + C) * 2u; }
    const size_t kstep = (size_t)(BK * 2);
    const size_t hstep = (size_t)HALF * K * 2;
    const size_t tstep = 2 * hstep;
    const unsigned ldsw = (unsigned)wid * 1024u;
    const int aoff = lds_byte(wr * 64 + fr, fq * 8), boff = lds_byte(wc * 32 + fr, fq * 8);
#define PG8_SA(b, h) (((b) * 2 + (h)) * HTB)
#define PG8_SB(b, h) ((4 + (b) * 2 + (h)) * HTB)
#define PG8_STAGE(bufoff, gbase, voff) do { _Pragma("unroll") for (int _i = 0; _i < 2; ++_i) \
        __builtin_amdgcn_global_load_lds((const unsigned*)((const char*)(gbase) + (voff)[_i]), (PG8_LAS unsigned*)(lds + (bufoff) + ldsw + _i * 8192), 16, 0, 0); } while (0)
#define PG8_LDA(dst, b, h) do { _Pragma("unroll") for (int m = 0; m < 4; ++m) _Pragma("unroll") for (int k = 0; k < 2; ++k) dst[m][k] = *(const PG8_LAS bf16x8*)(lds + PG8_SA(b, h) + aoff + m * 2048 + k * 1024); } while (0)
#define PG8_LDB(dst, b, h) do { _Pragma("unroll") for (int n = 0; n < 2; ++n) _Pragma("unroll") for (int k = 0; k < 2; ++k) dst[n][k] = *(const PG8_LAS bf16x8*)(lds + PG8_SB(b, h) + boff + n * 2048 + k * 1024); } while (0)
#define PG8_MMA(ai, bj, At, Bt) do { __builtin_amdgcn_s_setprio(1); _Pragma("unroll") for (int m = 0; m < 4; ++m) _Pragma("unroll") for (int n = 0; n < 2; ++n) _Pragma("unroll") for (int k = 0; k < 2; ++k) \
        acc[ai][bj][m][n] = __builtin_amdgcn_mfma_f32_16x16x32_bf16(Bt[n][k], At[m][k], acc[ai][bj][m][n], 0, 0, 0); __builtin_amdgcn_s_setprio(0); } while (0)
#define PG8_WAIT_V(n) asm volatile("s_waitcnt vmcnt(" #n ")" ::: "memory")
#define PG8_WAIT_L(n) asm volatile("s_waitcnt lgkmcnt(" #n ")" ::: "memory")
#define PG8_BAR __builtin_amdgcn_s_barrier()
#define PG8_SCHED __builtin_amdgcn_sched_barrier(0)
    Unit cur, nxt; int ui = 0;
    if (!S.next(0, cur)) return;
    f32x4 acc[2][2][4][2];
#pragma unroll
    for (int a = 0; a < 2; ++a)
#pragma unroll
        for (int b = 0; b < 2; ++b)
#pragma unroll
            for (int m = 0; m < 4; ++m)
#pragma unroll
                for (int n = 0; n < 2; ++n) acc[a][b][m][n] = (f32x4){0.f, 0.f, 0.f, 0.f};
    bf16x8 At[4][2], B0[2][2], B1[2][2];
    const char* cA = (const char*)g.A + (size_t)cur.pm * tstep; const char* cB = (const char*)g.Bt + (size_t)cur.pn * tstep;
    S.a_ready(cur);
    if constexpr (SP2) {
        PG8_STAGE(PG8_SB(0, 0), cB, voffB); PG8_STAGE(PG8_SB(0, 1), cB + hstep, voffB); PG8_STAGE(PG8_SA(0, 0), cA, voffA); PG8_STAGE(PG8_SA(0, 1), cA + hstep, voffA);
        if (wr == 1) PG8_BAR;
        PG8_WAIT_V(2); PG8_BAR;
        PG8_STAGE(PG8_SB(1, 0), cB + kstep, voffB); PG8_STAGE(PG8_SA(1, 0), cA + kstep, voffA); PG8_STAGE(PG8_SB(1, 1), cB + hstep + kstep, voffB);
        PG8_WAIT_V(6); PG8_BAR;
    } else {
        PG8_STAGE(PG8_SB(0, 0), cB, voffB); PG8_STAGE(PG8_SA(0, 0), cA, voffA); PG8_STAGE(PG8_SB(0, 1), cB + hstep, voffB); PG8_STAGE(PG8_SA(0, 1), cA + hstep, voffA);
        if (wr == 1) PG8_BAR;
        PG8_WAIT_V(4); PG8_BAR;
        PG8_STAGE(PG8_SB(1, 0), cB + kstep, voffB); PG8_STAGE(PG8_SA(1, 0), cA + kstep, voffA); PG8_STAGE(PG8_SB(1, 1), cB + hstep + kstep, voffB);
        PG8_WAIT_V(6); PG8_BAR;
    }
    for (;;) {
        const bool has_next = S.next(ui + 1, nxt);
        const char* nA = has_next ? (const char*)g.A + (size_t)nxt.pm * tstep : cA; const char* nB = has_next ? (const char*)g.Bt + (size_t)nxt.pn * tstep : cB;
        for (int t = 0; t < nt; t += 2) {
            const bool last = (t == nt - 2);
            const char* a1 = cA + (size_t)(t + 1) * kstep;
            const char* a2 = last ? nA : cA + (size_t)(t + 2) * kstep; const char* b2 = last ? nB : cB + (size_t)(t + 2) * kstep;
            const char* a3 = a2 + kstep; const char* b3 = b2 + kstep;
            if (last && has_next) S.a_ready(nxt);
            if constexpr (SP2) {
            PG8_LDB(B0, 0, 0); PG8_LDB(B1, 0, 1); PG8_SCHED; PG8_LDA(At, 0, 0); PG8_STAGE(PG8_SA(1, 1), a1 + hstep, voffA);
            PG8_WAIT_V(8); PG8_WAIT_L(0); PG8_BAR; PG8_MMA(0, 0, At, B0); PG8_MMA(0, 1, At, B1); PG8_BAR; PG8_SCHED;
            PG8_LDA(At, 0, 1); PG8_STAGE(PG8_SB(0, 0), b2, voffB); PG8_STAGE(PG8_SB(0, 1), b2 + hstep, voffB); PG8_STAGE(PG8_SA(0, 0), a2, voffA);
            PG8_WAIT_V(8); PG8_WAIT_L(0); PG8_BAR; PG8_MMA(1, 0, At, B0); PG8_MMA(1, 1, At, B1); PG8_BAR; PG8_SCHED;
            PG8_LDB(B0, 1, 0); PG8_LDB(B1, 1, 1); PG8_SCHED; PG8_LDA(At, 1, 0); PG8_STAGE(PG8_SA(0, 1), a2 + hstep, voffA);
            PG8_WAIT_V(8); PG8_WAIT_L(0); PG8_BAR; PG8_MMA(0, 0, At, B0); PG8_MMA(0, 1, At, B1); PG8_BAR; PG8_SCHED;
            PG8_LDA(At, 1, 1); PG8_STAGE(PG8_SB(1, 0), b3, voffB); PG8_STAGE(PG8_SB(1, 1), b3 + hstep, voffB); PG8_STAGE(PG8_SA(1, 0), a3, voffA);
            PG8_WAIT_V(8); PG8_WAIT_L(0); PG8_BAR; PG8_MMA(1, 0, At, B0); PG8_MMA(1, 1, At, B1); PG8_BAR; PG8_SCHED;
            } else {
            PG8_LDB(B0, 0, 0); PG8_SCHED; PG8_LDA(At, 0, 0); PG8_STAGE(PG8_SA(1, 1), a1 + hstep, voffA);
            PG8_WAIT_L(8); PG8_BAR; PG8_WAIT_L(0); PG8_MMA(0, 0, At, B0); PG8_BAR; PG8_SCHED;
            PG8_LDB(B1, 0, 1); PG8_STAGE(PG8_SB(0, 0), b2, voffB);
            PG8_BAR; PG8_WAIT_L(0); PG8_MMA(0, 1, At, B1); PG8_BAR;
            PG8_LDA(At, 0, 1); PG8_STAGE(PG8_SA(0, 0), a2, voffA);
            PG8_BAR; PG8_WAIT_L(0); PG8_MMA(1, 0, At, B0); PG8_BAR; PG8_SCHED;
            PG8_STAGE(PG8_SB(0, 1), b2 + hstep, voffB);
            PG8_WAIT_V(6); PG8_BAR; PG8_MMA(1, 1, At, B1); PG8_BAR;
            PG8_LDB(B0, 1, 0); PG8_SCHED; PG8_LDA(At, 1, 0); PG8_STAGE(PG8_SA(0, 1), a2 + hstep, voffA);
            PG8_WAIT_L(8); PG8_BAR; PG8_WAIT_L(0); PG8_MMA(0, 0, At, B0); PG8_BAR; PG8_SCHED;
            PG8_LDB(B1, 1, 1); PG8_STAGE(PG8_SB(1, 0), b3, voffB);
            PG8_BAR; PG8_WAIT_L(0); PG8_MMA(0, 1, At, B1); PG8_BAR;
            PG8_LDA(At, 1, 1); PG8_STAGE(PG8_SA(1, 0), a3, voffA);
            PG8_BAR; PG8_WAIT_L(0); PG8_MMA(1, 0, At, B0); PG8_BAR; PG8_SCHED;
            PG8_STAGE(PG8_SB(1, 1), b3 + hstep, voffB);
            PG8_WAIT_V(6); PG8_BAR; PG8_MMA(1, 1, At, B1); PG8_BAR;
            }
        }
        if constexpr (ALIGN_EPI) { if (wr == 0) PG8_BAR; }
        if constexpr (!Epi::AFTER_DRAIN) { for (int er_ = 0; er_ < (Epi::PROBE_REP ? EPI_REP : 1); ++er_) { E(acc, cur, wr, wc, fr, fq); if (Epi::PROBE_REP && EPI_REP > 1) asm volatile("" ::: "memory"); } S.done(cur); }
        if (!has_next) break;
        if (!E.keep(cur)) {
#pragma unroll
        for (int a = 0; a < 2; ++a)
#pragma unroll
            for (int b = 0; b < 2; ++b)
#pragma unroll
                for (int m = 0; m < 4; ++m)
#pragma unroll
                    for (int n = 0; n < 2; ++n) acc[a][b][m][n] = (f32x4){0.f, 0.f, 0.f, 0.f};
        }
        cur = nxt; cA = nA; cB = nB; ++ui;
        if constexpr (ALIGN_EPI) { if (wr == 1) PG8_BAR; }
    }
    PG8_WAIT_V(0);
    if constexpr (!ALIGN_EPI) { if (wr == 0) PG8_BAR; }
    PG8_BAR;
    if constexpr (Epi::AFTER_DRAIN) { E.fused(acc, cur, wr, wc, fr, fq, lds, wid, lane); S.done(cur); }
#undef PG8_SA
#undef PG8_SB
#undef PG8_STAGE
#undef PG8_LDA
#undef PG8_LDB
#undef PG8_MMA
#undef PG8_WAIT_V
#undef PG8_WAIT_L
#undef PG8_BAR
#undef PG8_SCHED
}
}

constexpr int NWAVES = 8;
#ifndef MK_N_LAUNCHES
#define MK_N_LAUNCHES 1
#endif
constexpr int PER_PHASE = 9;
constexpr int N_LAUNCHES = MK_N_LAUNCHES;

constexpr int BATCH = 4, SEQ = 4096, D = 1024, M = BATCH * SEQ;
constexpr int DN_H = 4, DN_D = 128, DN_W = 512, DN_QKV = 1536;
constexpr int SW_H = 8, SW_KV = 2, SW_D = 64, SW_W = 512, SW_KVW = 128, WINDOW = 128;
constexpr int FF = 2816;
constexpr int D_IN = 4872;
constexpr int NP = 4864;
constexpr int PC_Z = 1536, PC_SQ = 2048, PC_SK = 2560, PC_SV = 2688, PC_G = 2816;
constexpr float EPS = 1e-6f;

constexpr size_t MiB = 1u << 20;
constexpr size_t WS_CTL = 0, CTL_ZERO_BYTES = 1 * MiB;
constexpr size_t WS_WIN = 1 * MiB;
constexpr size_t WS_WAB = 11 * MiB;
constexpr size_t WS_WOUT = 13 * MiB;
constexpr size_t WS_WGU = 15 * MiB;
constexpr size_t WS_WD = 26 * MiB;
constexpr size_t WS_RSTD = 32 * MiB;
constexpr size_t WS_GB = WS_RSTD + 64 * 1024;
constexpr size_t WS_SSQ = 33 * MiB;
constexpr size_t WS_XB = 34 * MiB;
constexpr size_t WS_Y = 66 * MiB;
constexpr size_t WS_PROJ = 98 * MiB;
constexpr size_t WS_UB = 250 * MiB;
constexpr size_t WS_END = 256 * MiB;
static_assert(WS_PROJ + (size_t)M * NP * 2 <= WS_UB, "ws map");
constexpr int CW_TMO = 0, CW_BAR = 4096;

constexpr int RING_OFF = 0, RING_BYTES = 131072;
constexpr int LDSCTL_OFF = RING_BYTES, MISC_OFF = LDSCTL_OFF + 320;
constexpr int LDS_BYTES = 147456;

#define GAS __attribute__((address_space(1)))
#define LAS __attribute__((address_space(3)))
typedef unsigned short bf16;
typedef unsigned v4u __attribute__((ext_vector_type(4)));
typedef float f32x4 __attribute__((ext_vector_type(4)));
typedef float f32x2 __attribute__((ext_vector_type(2)));
typedef GAS unsigned gu32;
#define RLX_AGENT __ATOMIC_RELAXED, __HIP_MEMORY_SCOPE_AGENT
#define LDS_WAIT() asm volatile("s_waitcnt lgkmcnt(0)" ::: "memory")
#define VM_WAIT() asm volatile("s_waitcnt vmcnt(0)" ::: "memory")
__device__ __forceinline__ unsigned f2bf(float f) { unsigned u = __builtin_bit_cast(unsigned, f); return (u + 0x7fffu + ((u >> 16) & 1u)) >> 16; }
__device__ __forceinline__ unsigned pk2(float lo, float hi) { return f2bf(lo) | (f2bf(hi) << 16); }
__device__ __forceinline__ float bflo(unsigned w) { return __builtin_bit_cast(float, w << 16); }
__device__ __forceinline__ float bfhi(unsigned w) { return __builtin_bit_cast(float, w & 0xffff0000u); }
__device__ __forceinline__ float bf1(bf16 h) { return __builtin_bit_cast(float, (unsigned)h << 16); }
__device__ __forceinline__ float sigm(float x) { return __builtin_amdgcn_rcpf(1.0f + __expf(-x)); }
__device__ __forceinline__ float frsq(float x) { return __builtin_amdgcn_rsqf(x); }
template <int CTRL> __device__ __forceinline__ float dpp_mov(float v) { return __builtin_bit_cast(float, __builtin_amdgcn_update_dpp(0, __builtin_bit_cast(int, v), CTRL, 0xf, 0xf, true)); }
__device__ __forceinline__ float sum4(float v) { v += dpp_mov<0xB1>(v); v += dpp_mov<0x4E>(v); return v; }
__device__ __forceinline__ float sum8(float v) { v = sum4(v); v += dpp_mov<0x141>(v); return v; }
__device__ __forceinline__ float sum16(float v) { v = sum8(v); v += dpp_mov<0x140>(v); return v; }
__device__ __forceinline__ float rdlane(float v, int l) { return __builtin_bit_cast(float, __builtin_amdgcn_readlane(__builtin_bit_cast(int, v), l)); }
__device__ __forceinline__ float wave_sum(float v) { v = sum16(v); return (rdlane(v, 0) + rdlane(v, 16)) + (rdlane(v, 32) + rdlane(v, 48)); }
__device__ __forceinline__ float sum32(float v, int lane) { v = sum16(v); const float lo = rdlane(v, 0) + rdlane(v, 16), hi = rdlane(v, 32) + rdlane(v, 48); return (lane & 32) ? hi : lo; }
__device__ __forceinline__ float wave_max(float v) {
#pragma unroll
    for (int o = 1; o < 64; o <<= 1) v = fmaxf(v, __shfl_xor(v, o));
    return v;
}

#define XB_TMO      128
#define XB_XCNT(j)  (256  + 64 * (j))
#define XB_XSUB(j)  (1280 + 64 * (j))
#define XB_XGEN(j)  (2304 + 64 * (j))
#define XB_TOP      3328
#define XB_TOPGEN   3392
#define XCD_BAR_WORDS 3456
#define XB_SPIN_CAP (1u << 18)
__device__ __forceinline__ unsigned xb_ld(unsigned* p)              { return __hip_atomic_load(p, __ATOMIC_RELAXED, __HIP_MEMORY_SCOPE_AGENT); }
__device__ __forceinline__ unsigned xb_add(unsigned* p, unsigned v) { return __hip_atomic_fetch_add(p, v, __ATOMIC_RELAXED, __HIP_MEMORY_SCOPE_AGENT); }
__device__ __forceinline__ unsigned xb_xcc_id() { return (unsigned)__builtin_amdgcn_s_getreg((3 << 11) | 20) & 0xFu; }
#define XB_SPIN(cond, bar) do { unsigned _sp = 0; while (cond) { __builtin_amdgcn_s_sleep(1); \
    if ((++_sp & 255u) == 0u) { if (xb_ld(&(bar)[XB_TMO])) break; if (_sp > XB_SPIN_CAP) { atomicAdd(&(bar)[XB_TMO], 1u); break; } } } } while (0)
struct XcdBarrier { unsigned* bar; unsigned x; volatile LAS unsigned* st; };
__device__ __forceinline__ XcdBarrier xcd_barrier_post(unsigned* bar, volatile LAS unsigned* st) {
    XcdBarrier b; b.bar = bar; b.x = xb_xcc_id(); b.st = st;
    if (threadIdx.x == 0) (void)xb_add(&bar[XB_XCNT(b.x)], 1u);
    return b;
}
__device__ __forceinline__ void xcd_barrier_complete(unsigned* bar, unsigned x, unsigned& nloc, unsigned& nx) {
    const unsigned G = gridDim.x * gridDim.y * gridDim.z;
    unsigned sum, cnt, mine, sp = 0u;
    for (;;) {
        sum = 0u; cnt = 0u; mine = 0u;
#pragma unroll
        for (unsigned j = 0; j < 16; ++j) { const unsigned c = xb_ld(&bar[XB_XCNT(j)]); sum += c; cnt += (c > 0u) ? 1u : 0u; mine = (j == x) ? c : mine; }
        if (sum == G) break;
        __builtin_amdgcn_s_sleep(1);
        if ((++sp & 255u) == 0u) { if (xb_ld(&bar[XB_TMO])) break; if (sp > XB_SPIN_CAP) { atomicAdd(&bar[XB_TMO], 1u); break; } }
    }
    nloc = mine > 0u ? mine : 1u; nx = cnt > 0u ? cnt : 1u;
}
__device__ __forceinline__ void xcd_barrier(const XcdBarrier& b) {
    asm volatile("s_waitcnt vmcnt(0)" ::: "memory");
    __syncthreads();
    if (threadIdx.x == 0) {
        unsigned* bar = b.bar;
        __builtin_amdgcn_s_waitcnt(0);
        unsigned nloc = b.st[0], nx = b.st[1];
        if (nloc == 0u) { xcd_barrier_complete(bar, b.x, nloc, nx); b.st[0] = nloc; b.st[1] = nx; }
        const unsigned old = xb_add(&bar[XB_XSUB(b.x)], 1u);
        const unsigned gen = old / nloc;
        if (old + 1u == (gen + 1u) * nloc) {
            __builtin_amdgcn_fence(__ATOMIC_RELEASE, "agent");
            asm volatile("s_waitcnt vmcnt(0)" ::: "memory");
            const unsigned og = xb_add(&bar[XB_TOP], 1u);
            const unsigned tg = og / nx;
            if (og + 1u == (tg + 1u) * nx) xb_add(&bar[XB_TOPGEN], 1u);
            else XB_SPIN(xb_ld(&bar[XB_TOPGEN]) == tg, bar);
            __builtin_amdgcn_fence(__ATOMIC_ACQUIRE, "agent");
            xb_add(&bar[XB_XGEN(b.x)], 1u);
            asm volatile("s_waitcnt vmcnt(0)" ::: "memory");
        } else {
            XB_SPIN(xb_ld(&bar[XB_XGEN(b.x)]) == gen, bar);
            __builtin_amdgcn_fence(__ATOMIC_ACQUIRE, "agent");
            asm volatile("s_waitcnt vmcnt(0)" ::: "memory");
        }
    }
    __syncthreads();
}

struct Frame {
    LAS unsigned char* lds;
    volatile LAS unsigned* MISC;
    gu32* ctl;
    int tid, lane, wave;
    int vcu, G;
    const float* in[18]; float* out; unsigned char* ws;
};
__device__ const unsigned char T5_BUCKET[128] = {0,1,2,3,4,5,6,7,8,9,10,11,12,13,14,15,16,16,16,17,17,18,18,18,19,19,19,20,20,20,20,21,21,21,21,22,22,22,22,22,23,23,23,23,23,23,24,24,24,24,24,24,25,25,25,25,25,25,25,26,26,26,26,26,26,26,26,27,27,27,27,27,27,27,27,27,27,28,28,28,28,28,28,28,28,28,28,29,29,29,29,29,29,29,29,29,29,29,29,30,30,30,30,30,30,30,30,30,30,30,30,30,30,31,31,31,31,31,31,31,31,31,31,31,31,31,31,31};

__device__ __forceinline__ void p0_transpose_item(const float* W, int ldw, int src_col0, int K, bf16* WT, int dst_row0, const float* gain, LAS float* scr, int kb, int lane) {
    const int k0 = 64 * kb, c4 = 4 * (lane & 7);
    f32x4 v[8];
#pragma unroll
    for (int i = 0; i < 8; ++i) v[i] = *(const f32x4*)(W + (size_t)(k0 + 8 * i + (lane >> 3)) * ldw + src_col0 + c4);
#pragma unroll
    for (int i = 0; i < 8; ++i) { const int kk = 8 * i + (lane >> 3); const float gn = gain ? gain[k0 + kk] : 1.0f;
        scr[kk * 33 + c4] = v[i].x * gn; scr[kk * 33 + c4 + 1] = v[i].y * gn; scr[kk * 33 + c4 + 2] = v[i].z * gn; scr[kk * 33 + c4 + 3] = v[i].w * gn; }
    LDS_WAIT(); asm volatile("" ::: "memory");
    const int c = lane & 7;
#pragma unroll
    for (int j = 0; j < 4; ++j) { const int n = (lane >> 3) + 8 * j; const LAS float* s = scr + (8 * c) * 33 + n;
        v4u o; o.x = pk2(s[0 * 33], s[1 * 33]); o.y = pk2(s[2 * 33], s[3 * 33]); o.z = pk2(s[4 * 33], s[5 * 33]); o.w = pk2(s[6 * 33], s[7 * 33]);
        *(GAS v4u*)(WT + (size_t)(dst_row0 + n) * K + k0 + 8 * c) = o; }
    LDS_WAIT(); asm volatile("" ::: "memory");
}
__device__ __forceinline__ int lcol32(int nb) { return 256 * (nb >> 3) + 32 * (2 * (nb & 3) + ((nb >> 2) & 1)); }
__device__ __forceinline__ void p0_prologue(Frame& F) {
    LAS float* scr = (LAS float*)(F.lds + RING_OFF + F.wave * 16384);
    const int gw = F.vcu * NWAVES + F.wave, NGW = F.G * NWAVES;
    unsigned char* ws = F.ws;
    bf16* WinT = (bf16*)(ws + WS_WIN); bf16* WabT = (bf16*)(ws + WS_WAB); bf16* WoutT = (bf16*)(ws + WS_WOUT); bf16* WguT = (bf16*)(ws + WS_WGU); bf16* WdT = (bf16*)(ws + WS_WD);
    constexpr int I_IN = 16 * (NP / 32), I_AB = 8 * 32, I_OUT = 16 * 32, I_GU = 16 * (2 * FF / 32), I_D = (FF / 64) * 32;
    constexpr int NITEMS = I_IN + 2 * I_AB + I_OUT + I_GU + I_D;
    for (int it = gw; it < NITEMS; it += NGW) {
        int r = it;
        if (r < I_IN) { const int nb = r % (NP / 32), kb = r / (NP / 32), dr = 32 * nb, lc = lcol32(nb); p0_transpose_item(F.in[2], D_IN, lc < 2048 ? lc : lc + 8, D, WinT, dr, F.in[1], scr, kb, F.lane); continue; } r -= I_IN;
        if (r < I_AB) { const int nb = r % 32, kb = r / 32; p0_transpose_item(F.in[11], D, lcol32(nb), DN_W, WabT, 32 * nb, nullptr, scr, kb, F.lane); continue; } r -= I_AB;
        if (r < I_AB) { const int nb = r % 32, kb = r / 32; p0_transpose_item(F.in[12], D, lcol32(nb), SW_W, WabT, 1024 + 32 * nb, nullptr, scr, kb, F.lane); continue; } r -= I_AB;
        if (r < I_OUT) { const int nb = r % 32, kb = r / 32; p0_transpose_item(F.in[13], D, 32 * nb, D, WoutT, 32 * nb, nullptr, scr, kb, F.lane); continue; } r -= I_OUT;
        if (r < I_GU) { const int nb = r % (2 * FF / 32), kb = r / (2 * FF / 32), dr = 32 * nb, pn = dr >> 8, j = dr & 255;
            const float* W = (j < 128) ? F.in[15] : F.in[16]; p0_transpose_item(W, FF, 128 * pn + (j & 127), D, WguT, dr, F.in[14], scr, kb, F.lane); continue; } r -= I_GU;
        { const int nb = r % 32, kb = r / 32; p0_transpose_item(F.in[17], D, 32 * nb, FF, WdT, 32 * nb, nullptr, scr, kb, F.lane); }
    }
    __syncthreads();
    LAS float* wba = (LAS float*)(F.lds + RING_OFF);
    for (int idx = F.tid; idx < 8 * D; idx += NWAVES * 64) { const int k = idx >> 3, j = idx & 7; wba[j * D + k] = F.in[2][(size_t)k * D_IN + 2048 + j] * F.in[1][k]; }
    __syncthreads();
    const float* x = F.in[0]; bf16* XB = (bf16*)(ws + WS_XB); float* rstd1 = (float*)(ws + WS_RSTD); float* gbp = (float*)(ws + WS_GB);
    const float alog_or_dt = (F.lane & 32) ? F.in[5][(F.lane >> 3) & 3] : 0.f;
    const float negA = -expf(F.in[4][(F.lane >> 3) & 3]);
    for (int m = gw; m < M; m += NGW) {
        const GAS f32x4* xr = (const GAS f32x4*)(x + (size_t)m * D) + F.lane;
        f32x4 v[4]; float ss = 0.f;
#pragma unroll
        for (int j = 0; j < 4; ++j) { v[j] = xr[64 * j]; ss += (v[j].x * v[j].x + v[j].y * v[j].y) + (v[j].z * v[j].z + v[j].w * v[j].w); }
        GAS unsigned long long* o8 = (GAS unsigned long long*)(XB + (size_t)m * D) + F.lane;
#pragma unroll
        for (int j = 0; j < 4; ++j) o8[64 * j] = (unsigned long long)pk2(v[j].x, v[j].y) | ((unsigned long long)pk2(v[j].z, v[j].w) << 32);
        float acc[8];
#pragma unroll
        for (int c = 0; c < 8; ++c) { float a = 0.f;
#pragma unroll
            for (int j = 0; j < 4; ++j) { const f32x4 w = *(const LAS f32x4*)(wba + c * D + 256 * j + 4 * F.lane); a += (v[j].x * w.x + v[j].y * w.y) + (v[j].z * w.z + v[j].w * w.w); }
            acc[c] = a; }
        ss = wave_sum(ss);
        float r4[4], r2[2], r1;
        { const bool up = (F.lane & 32) != 0;
#pragma unroll
          for (int i = 0; i < 4; ++i) { const float keep = up ? acc[4 + i] : acc[i], send = up ? acc[i] : acc[4 + i]; r4[i] = keep + __shfl_xor(send, 32); } }
        { const bool up = (F.lane & 16) != 0;
#pragma unroll
          for (int i = 0; i < 2; ++i) { const float keep = up ? r4[2 + i] : r4[i], send = up ? r4[i] : r4[2 + i]; r2[i] = keep + __shfl_xor(send, 16); } }
        { const bool up = (F.lane & 8) != 0; const float keep = up ? r2[1] : r2[0], send = up ? r2[0] : r2[1]; r1 = keep + __shfl_xor(send, 8); }
        r1 = sum8(r1);
        const float rstd = frsq(ss * (1.0f / D) + EPS);
        if (F.lane == 0) rstd1[m] = rstd;
        if ((F.lane & 7) == 0) {
            const float val = r1 * rstd; float res;
            if (F.lane < 32) res = 1.0f / (1.0f + expf(-val));
            else { const float xx = val + alog_or_dt; const float sp = xx > 20.f ? xx : log1pf(expf(xx)); res = negA * sp; }
            gbp[(size_t)m * 8 + (F.lane >> 3)] = res;
        }
    }
}

__device__ __forceinline__ void dn_pre(Frame& F) {
    const int gw = F.vcu * NWAVES + F.wave, NGW = F.G * NWAVES;
    const bf16* proj = (const bf16*)(F.ws + WS_PROJ); const float* conv = F.in[3];
    float* QN = F.out; float* KN = F.out + (size_t)M * DN_W; float* VV = (float*)(F.ws + WS_XB);
    for (int task = gw; task < M * DN_H; task += NGW) {
        const int m = task >> 2, h = task & 3, t = m & (SEQ - 1);
        float val[3][2];
#pragma unroll
        for (int part = 0; part < 3; ++part) { const int col = part * DN_W + h * DN_D + 2 * F.lane; float a0 = 0.f, a1 = 0.f;
#pragma unroll
            for (int j = 0; j < 4; ++j) { if (t - 3 + j >= 0) { const unsigned w = *(const unsigned*)(proj + (size_t)(m - 3 + j) * NP + col); a0 += conv[j * DN_QKV + col] * bflo(w); a1 += conv[j * DN_QKV + col + 1] * bfhi(w); } }
            val[part][0] = a0 * sigm(a0); val[part][1] = a1 * sigm(a1); }
        const float rq = 1.0f / sqrtf(wave_sum(val[0][0] * val[0][0] + val[0][1] * val[0][1]) + EPS) * 0.08838834764831845f;
        const float rk = 1.0f / sqrtf(wave_sum(val[1][0] * val[1][0] + val[1][1] * val[1][1]) + EPS);
        const size_t o = (size_t)m * DN_W + h * DN_D + 2 * F.lane;
        *(f32x2*)(QN + o) = (f32x2){val[0][0] * rq, val[0][1] * rq};
        *(f32x2*)(KN + o) = (f32x2){val[1][0] * rk, val[1][1] * rk};
        *(f32x2*)(VV + o) = (f32x2){val[2][0], val[2][1]};
    }
}
__device__ __forceinline__ void dn_scan_naive(Frame& F, int bh) {
    const int b = bh >> 2, h = bh & 3, tid = F.tid, dvi = tid >> 2, kq = tid & 3;
    LAS float* kL = (LAS float*)(F.lds + RING_OFF); LAS float* qL = kL + 32 * 128; LAS float* vL = qL + 32 * 128; LAS float* gL = vL + 32 * 128; LAS float* bL = gL + 32;
    const float* QN = F.out; const float* KN = F.out + (size_t)M * DN_W; float* VV = (float*)(F.ws + WS_XB); const float* gbp = (const float*)(F.ws + WS_GB);
    float S[32];
#pragma unroll
    for (int j = 0; j < 32; ++j) S[j] = 0.f;
    for (int t0 = 0; t0 < SEQ; t0 += 32) {
#pragma unroll
        for (int r = 0; r < 2; ++r) { const int idx = tid + 512 * r, tok = idx >> 5, c4 = idx & 31; const size_t src = (size_t)(b * SEQ + t0 + tok) * DN_W + h * DN_D + c4 * 4;
            *(LAS f32x4*)(kL + tok * 128 + c4 * 4) = *(const f32x4*)(KN + src); *(LAS f32x4*)(qL + tok * 128 + c4 * 4) = *(const f32x4*)(QN + src); *(LAS f32x4*)(vL + tok * 128 + c4 * 4) = *(const f32x4*)(VV + src); }
        if (tid < 32) { const size_t mm = (size_t)(b * SEQ + t0 + tid); bL[tid] = gbp[mm * 8 + h]; gL[tid] = gbp[mm * 8 + 4 + h]; }
        __syncthreads();
        for (int i = 0; i < 32; ++i) {
            const float eg = __expf(gL[i]), be = bL[i];
            float kk[32];
#pragma unroll
            for (int j = 0; j < 8; ++j) { const f32x4 w = *(const LAS f32x4*)(kL + i * 128 + kq * 32 + 4 * j); kk[4 * j] = w.x; kk[4 * j + 1] = w.y; kk[4 * j + 2] = w.z; kk[4 * j + 3] = w.w; }
            float part = 0.f;
#pragma unroll
            for (int j = 0; j < 32; ++j) part += kk[j] * S[j];
            part += __shfl_xor(part, 1); part += __shfl_xor(part, 2);
            const float c = be * (vL[i * 128 + dvi] - eg * part);
#pragma unroll
            for (int j = 0; j < 32; ++j) S[j] = eg * S[j] + c * kk[j];
            float po = 0.f;
#pragma unroll
            for (int j = 0; j < 8; ++j) { const f32x4 w = *(const LAS f32x4*)(qL + i * 128 + kq * 32 + 4 * j); po += (w.x * S[4 * j] + w.y * S[4 * j + 1]) + (w.z * S[4 * j + 2] + w.w * S[4 * j + 3]); }
            po += __shfl_xor(po, 1); po += __shfl_xor(po, 2);
            if (kq == 0) vL[i * 128 + dvi] = po;
        }
        __syncthreads();
#pragma unroll
        for (int r = 0; r < 2; ++r) { const int idx = tid + 512 * r, tok = idx >> 5, c4 = idx & 31; const size_t src = (size_t)(b * SEQ + t0 + tok) * DN_W + h * DN_D + c4 * 4;
            *(f32x4*)(VV + src) = *(const LAS f32x4*)(vL + tok * 128 + c4 * 4); }
        __syncthreads();
    }
}
__device__ __forceinline__ void swa_naive(Frame& F, int wv, int nworkers) {
    const bf16* proj = (const bf16*)(F.ws + WS_PROJ); bf16* YSWA = (bf16*)(F.ws + WS_Y) + (size_t)M * SW_W;
    LAS float* qs = (LAS float*)(F.lds + RING_OFF + 65536 + F.wave * 1024); LAS float* ps = qs + 64;
    const float* qg = F.in[7]; const float* kg = F.in[8]; const float* sinks = F.in[9]; const float* relb = F.in[10];
    const int lane = F.lane;
    for (int task = wv; task < M * SW_H; task += nworkers) {
        const int m = task >> 3, qh = task & 7, kvh = qh >> 2, t = m & (SEQ - 1);
        const float q = bf1(proj[(size_t)m * NP + PC_SQ + qh * SW_D + lane]);
        const float qn = q * (1.0f / sqrtf(wave_sum(q * q) * (1.0f / SW_D) + EPS)) * qg[lane];
        qs[lane] = qn * kg[lane];
        LDS_WAIT(); asm volatile("" ::: "memory");
        float lg[2];
#pragma unroll
        for (int hf = 0; hf < 2; ++hf) { const int j = lane + 64 * hf; lg[hf] = -INFINITY;
            if (t - 127 + j >= 0) { const v4u* kr = (const v4u*)(proj + (size_t)(m - 127 + j) * NP + PC_SK + kvh * SW_D); float ssk = 0.f, dot = 0.f;
#pragma unroll
                for (int c = 0; c < 8; ++c) { const v4u w = kr[c];
#pragma unroll
                    for (int e = 0; e < 4; ++e) { const float k0 = bflo(w[e]), k1 = bfhi(w[e]); ssk += k0 * k0 + k1 * k1; dot += qs[8 * c + 2 * e] * k0 + qs[8 * c + 2 * e + 1] * k1; } }
                lg[hf] = dot * (1.0f / sqrtf(ssk * (1.0f / SW_D) + EPS)) * 0.125f + relb[(int)T5_BUCKET[127 - j] * SW_H + qh]; } }
        const float sink = sinks[qh];
        const float mx = fmaxf(wave_max(fmaxf(lg[0], lg[1])), sink);
        const float p0 = (lg[0] == -INFINITY) ? 0.f : __expf(lg[0] - mx), p1 = (lg[1] == -INFINITY) ? 0.f : __expf(lg[1] - mx);
        const float den = wave_sum(p0 + p1) + __expf(sink - mx);
        ps[lane] = p0; ps[lane + 64] = p1;
        LDS_WAIT(); asm volatile("" ::: "memory");
        float o = 0.f; const int jmin = (127 - t) > 0 ? (127 - t) : 0;
        for (int j = jmin; j < 128; ++j) o += ps[j] * bf1(proj[(size_t)(m - 127 + j) * NP + PC_SV + kvh * SW_D + lane]);
        YSWA[(size_t)m * SW_W + qh * SW_D + lane] = (bf16)f2bf(o / den);
        LDS_WAIT(); asm volatile("" ::: "memory");
    }
}
__device__ __forceinline__ void dn_out(Frame& F) {
    const int gw = F.vcu * NWAVES + F.wave, NGW = F.G * NWAVES;
    const bf16* proj = (const bf16*)(F.ws + WS_PROJ); const float* VV = (const float*)(F.ws + WS_XB); bf16* YDN = (bf16*)(F.ws + WS_Y); const float* gain = F.in[6];
    for (int task = gw; task < M * DN_H; task += NGW) {
        const int m = task >> 2, h = task & 3;
        const f32x2 o = *(const f32x2*)(VV + (size_t)m * DN_W + h * DN_D + 2 * F.lane);
        const float r = 1.0f / sqrtf(wave_sum(o.x * o.x + o.y * o.y) * (1.0f / DN_D) + EPS);
        const unsigned zw = *(const unsigned*)(proj + (size_t)m * NP + PC_Z + h * DN_D + 2 * F.lane); const float z0 = bflo(zw), z1 = bfhi(zw);
        *(unsigned*)(YDN + (size_t)m * DN_W + h * DN_D + 2 * F.lane) = pk2(o.x * r * gain[2 * F.lane] * z0 * sigm(z0), o.y * r * gain[2 * F.lane + 1] * z1 * sigm(z1));
    }
}

typedef short bf16x8 __attribute__((ext_vector_type(8)));
typedef float f32x16 __attribute__((ext_vector_type(16)));
typedef unsigned u32x2 __attribute__((ext_vector_type(2)));
typedef __bf16 bf16x2_t __attribute__((ext_vector_type(2)));
__device__ __forceinline__ unsigned cvtpk(float lo, float hi) { f32x2 v = {lo, hi}; return __builtin_bit_cast(unsigned, __builtin_convertvector(v, bf16x2_t)); }
__device__ __forceinline__ bf16x8 pack8(f32x4 a, f32x4 b) { v4u w; w.x = cvtpk(a[0], a[1]); w.y = cvtpk(a[2], a[3]); w.z = cvtpk(b[0], b[1]); w.w = cvtpk(b[2], b[3]); return __builtin_bit_cast(bf16x8, w); }
__device__ __forceinline__ bf16x8 pack8z(f32x4 a) { v4u w; w.x = cvtpk(a[0], a[1]); w.y = cvtpk(a[2], a[3]); w.z = 0u; w.w = 0u; return __builtin_bit_cast(bf16x8, w); }
#define MFMA16(a, b, c) __builtin_amdgcn_mfma_f32_16x16x32_bf16((a), (b), (c), 0, 0, 0)
#define MFMA32(a, b, c) __builtin_amdgcn_mfma_f32_32x32x16_bf16((a), (b), (c), 0, 0, 0)
constexpr float LOG2E = 1.4426950408889634f;

__device__ __forceinline__ void swa_pre(Frame& F) {
    const int gw = F.vcu * NWAVES + F.wave, NGW = F.G * NWAVES, lane = F.lane;
    const bf16* proj = (const bf16*)(F.ws + WS_PROJ);
    bf16* KS = (bf16*)(F.ws + WS_Y); bf16* VT = KS + 2 * 1024 * 1024; bf16* QS = (bf16*)(F.ws + WS_Y) + (size_t)M * SW_W;
    const float* qg = F.in[7]; const float* kg = F.in[8];
    for (int m = gw; m < M; m += NGW) {
        {
            const v4u w = *(const v4u*)(proj + (size_t)m * NP + PC_SQ + 8 * lane); float x[8];
#pragma unroll
            for (int j = 0; j < 4; ++j) { x[2 * j] = bflo(w[j]); x[2 * j + 1] = bfhi(w[j]); }
            float ss = 0.f;
#pragma unroll
            for (int j = 0; j < 8; ++j) ss += x[j] * x[j];
            ss = sum8(ss);
            const float r = frsq(ss * (1.0f / SW_D) + EPS) * (0.125f * LOG2E);
            const f32x4 g0 = *(const f32x4*)(qg + 8 * (lane & 7)), g1 = *(const f32x4*)(qg + 8 * (lane & 7) + 4);
            v4u o; o.x = cvtpk(x[0] * r * g0[0], x[1] * r * g0[1]); o.y = cvtpk(x[2] * r * g0[2], x[3] * r * g0[3]); o.z = cvtpk(x[4] * r * g1[0], x[5] * r * g1[1]); o.w = cvtpk(x[6] * r * g1[2], x[7] * r * g1[3]);
            *(v4u*)(QS + (size_t)m * SW_W + 8 * lane) = o;
        }
        {
            const unsigned w = *(const unsigned*)(proj + (size_t)m * NP + PC_SK + 2 * lane); const float k0 = bflo(w), k1 = bfhi(w);
            float ss = k0 * k0 + k1 * k1;
            ss = sum32(ss, lane);
            const float r = frsq(ss * (1.0f / SW_D) + EPS); const int d = 2 * (lane & 31), b = m >> 12, t = m & (SEQ - 1), kvh = lane >> 5;
            *(unsigned*)(KS + ((size_t)(b * 2 + kvh) * SEQ + t) * SW_D + d) = cvtpk(k0 * r * kg[d], k1 * r * kg[d + 1]);
        }
    }
    for (int task = gw; task < BATCH * SW_KV * (SEQ / 32); task += NGW) {
        const int bk = task >> 7, tile = task & 127, b = bk >> 1, kvh = bk & 1; const size_t m0 = (size_t)b * SEQ + tile * 32;
        unsigned v[32];
#pragma unroll
        for (int i = 0; i < 32; ++i) v[i] = proj[(m0 + i) * NP + PC_SV + kvh * SW_D + lane];
        bf16* dst = VT + ((size_t)(bk * 128 + tile) * 64 + lane) * 32;
#pragma unroll
        for (int q4 = 0; q4 < 4; ++q4) { v4u o;
#pragma unroll
            for (int jj = 0; jj < 4; ++jj) { const int p0 = 8 * q4 + 2 * jj, p1 = p0 + 1;
                const int k0 = 16 * (p0 >> 4) + 8 * ((p0 & 7) >> 2) + 4 * ((p0 >> 3) & 1) + (p0 & 3), k1 = 16 * (p1 >> 4) + 8 * ((p1 & 7) >> 2) + 4 * ((p1 >> 3) & 1) + (p1 & 3);
                o[jj] = v[k0] | (v[k1] << 16); }
            *(v4u*)(dst + 8 * q4) = o; }
    }
}
__device__ __forceinline__ void swa_bias_table(Frame& F) {
    LAS float* biasT = (LAS float*)(F.lds + RING_OFF);
    for (int idx = F.tid; idx < SW_H * 128; idx += NWAVES * 64) { const int h = idx >> 7, dist = idx & 127; biasT[idx] = F.in[10][(int)T5_BUCKET[dist] * SW_H + h] * LOG2E; }
}
__device__ __forceinline__ void swa_main(Frame& F, int worker, int nworkers) {
    const LAS float* biasT = (const LAS float*)(F.lds + RING_OFF);
    const bf16* KS = (const bf16*)(F.ws + WS_Y); const bf16* VT = KS + 2 * 1024 * 1024; bf16* QS = (bf16*)(F.ws + WS_Y) + (size_t)M * SW_W;
    const int lane = F.lane, l31 = lane & 31, hh = lane >> 5;
    for (int u = worker; u < BATCH * SW_H * (SEQ / 32); u += nworkers) {
        const int qblk = u & 127, h = (u >> 7) & 7, b = u >> 10, kvh = h >> 2, bk = b * 2 + kvh, q0 = qblk * 32; const size_t m0 = (size_t)b * SEQ + q0;
        bf16x8 qf[4];
#pragma unroll
        for (int ks = 0; ks < 4; ++ks) qf[ks] = *(const bf16x8*)(QS + (m0 + l31) * SW_W + h * SW_D + 16 * ks + 8 * hh);
        f32x16 s[5];
#pragma unroll
        for (int i = 0; i < 5; ++i) {
            const int ts = q0 - 128 + 32 * i;
            if (ts < 0) {
#pragma unroll
                for (int r = 0; r < 16; ++r) s[i][r] = -INFINITY;
            } else {
                f32x16 acc;
#pragma unroll
                for (int r = 0; r < 16; ++r) acc[r] = 0.f;
#pragma unroll
                for (int ks = 0; ks < 4; ++ks) { const bf16x8 kf = *(const bf16x8*)(KS + ((size_t)bk * SEQ + ts + l31) * SW_D + 16 * ks + 8 * hh); acc = MFMA32(kf, qf[ks], acc); }
#pragma unroll
                for (int r = 0; r < 16; ++r) { const int row = (r & 3) + 8 * (r >> 2) + 4 * hh, dist = 128 - 32 * i + l31 - row; const bool ok = dist >= 0 && dist <= 127;
                    s[i][r] = ok ? acc[r] + biasT[h * 128 + (dist & 127)] : -INFINITY; }
            }
        }
        const float sink2 = F.in[9][h] * LOG2E;
        float mx = sink2;
#pragma unroll
        for (int i = 0; i < 5; ++i)
#pragma unroll
            for (int r = 0; r < 16; ++r) mx = fmaxf(mx, s[i][r]);
        mx = fmaxf(mx, __shfl_xor(mx, 32));
        float sum = 0.f;
#pragma unroll
        for (int i = 0; i < 5; ++i)
#pragma unroll
            for (int r = 0; r < 16; ++r) { const float p = __builtin_amdgcn_exp2f(s[i][r] - mx); s[i][r] = p; sum += p; }
        sum += __shfl_xor(sum, 32);
        const float inv = __builtin_amdgcn_rcpf(sum + __builtin_amdgcn_exp2f(sink2 - mx));
        f32x16 O[2];
#pragma unroll
        for (int r = 0; r < 16; ++r) { O[0][r] = 0.f; O[1][r] = 0.f; }
#pragma unroll
        for (int i = 0; i < 5; ++i) {
            const int ts = q0 - 128 + 32 * i;
            if (ts >= 0) {
#pragma unroll
                for (int s2 = 0; s2 < 2; ++s2) {
                    v4u w; w.x = cvtpk(s[i][8 * s2] * inv, s[i][8 * s2 + 1] * inv); w.y = cvtpk(s[i][8 * s2 + 2] * inv, s[i][8 * s2 + 3] * inv); w.z = cvtpk(s[i][8 * s2 + 4] * inv, s[i][8 * s2 + 5] * inv); w.w = cvtpk(s[i][8 * s2 + 6] * inv, s[i][8 * s2 + 7] * inv);
                    const bf16x8 pa = __builtin_bit_cast(bf16x8, w);
#pragma unroll
                    for (int nt = 0; nt < 2; ++nt) { const bf16x8 vf = *(const bf16x8*)(VT + ((size_t)(bk * 128 + (ts >> 5)) * 64 + 32 * nt + l31) * 32 + s2 * 16 + hh * 8); O[nt] = MFMA32(pa, vf, O[nt]); }
                }
            }
        }
#pragma unroll
        for (int nt = 0; nt < 2; ++nt)
#pragma unroll
            for (int r = 0; r < 16; ++r) { const int q = (r & 3) + 8 * (r >> 2) + 4 * hh; QS[(m0 + q) * SW_W + h * SW_D + 32 * nt + l31] = (bf16)(cvtpk(O[nt][r], 0.f) & 0xffffu); }
    }
}

constexpr int DNL_QT = 0, DNL_KT = 17408, DNL_VT = 34816, DNL_WL = 52224, DNL_NA = 69632, DNL_QKM = 78848, DNL_DB = 88064, DNL_TIB = 92160, DNL_GC = 94208, DNL_BETA = 94464;
constexpr int TP = 272;
constexpr int NP2 = 144;
struct DnRec { bf16* UA; bf16* UB; bf16* W; bf16* QG; bf16* KD; bf16* QK; float* EGL;
    __device__ __forceinline__ bf16* u(int ch, int sl, int mt, int lane) const { return (ch < 640 ? UA + (size_t)ch * 8192 : UB + (size_t)(ch - 640) * 8192) + ((sl * 4 + mt) * 64 + lane) * 4; } };
__device__ __forceinline__ DnRec dn_rec(Frame& F) {
    DnRec r; r.W = (bf16*)F.out; r.QG = r.W + 8 * 1024 * 1024; r.KD = r.W + 16 * 1024 * 1024; r.QK = r.W + 24 * 1024 * 1024; r.UA = r.W + 27 * 1024 * 1024; r.UB = (bf16*)(F.ws + WS_UB); r.EGL = (float*)(F.ws + WS_SSQ); return r;
}
__device__ __forceinline__ void dn_chunk_prep(Frame& F) {
    const DnRec R = dn_rec(F);
    const bf16* proj = (const bf16*)(F.ws + WS_PROJ); const float* conv = F.in[3]; const float* gbp = (const float*)(F.ws + WS_GB);
    LAS unsigned char* L = F.lds + RING_OFF;
    LAS float* GC = (LAS float*)(L + DNL_GC); LAS float* BETA = (LAS float*)(L + DNL_BETA); LAS float* DB = (LAS float*)(L + DNL_DB);
    const int lane = F.lane, wave = F.wave, r16 = lane & 15, g = lane >> 4;
    const int tk0 = 8 * wave;
    unsigned raw[3][11]; float gx, gbl;
#define DN_LOAD_INPUTS(ch_) do { const int bh_ = (ch_) >> 6, c_ = (ch_) & 63, b_ = bh_ >> 2, h_ = bh_ & 3; const size_t m0_ = (size_t)b_ * SEQ + 64 * c_; \
        gx = gbp[(m0_ + lane) * 8 + 4 + h_]; gbl = gbp[(m0_ + lane) * 8 + h_]; \
        _Pragma("unroll") for (int p = 0; p < 3; ++p) { const int col_ = p * DN_W + h_ * DN_D + 2 * lane; \
            _Pragma("unroll") for (int r = 0; r < 11; ++r) { const int tr_ = 64 * c_ + tk0 - 3 + r; raw[p][r] = *(const unsigned*)(proj + (m0_ - 64 * c_ + (tr_ < 0 ? 0 : tr_)) * NP + col_); } } } while (0)
    if (F.vcu < 1024) DN_LOAD_INPUTS(F.vcu);
    for (int ch = F.vcu; ch < 1024; ch += F.G) {
        const int bh = ch >> 6, c = ch & 63, b = bh >> 2, h = bh & 3; const size_t m0 = (size_t)b * SEQ + 64 * c;
        {
            float cw[3][4][2];
#pragma unroll
            for (int p = 0; p < 3; ++p) { const int col = p * DN_W + h * DN_D + 2 * lane;
#pragma unroll
                for (int j = 0; j < 4; ++j) { cw[p][j][0] = conv[j * DN_QKV + col]; cw[p][j][1] = conv[j * DN_QKV + col + 1]; } }
            if (wave == 0) { float x = gx;
#pragma unroll
                for (int off = 1; off < 64; off <<= 1) { const float t = __shfl_up(x, off); if (lane >= off) x += t; }
                GC[lane] = x; BETA[lane] = gbl; }
            if (64 * c + tk0 < 3) {
#pragma unroll
                for (int p = 0; p < 3; ++p)
#pragma unroll
                    for (int r = 0; r < 3; ++r) if (64 * c + tk0 - 3 + r < 0) raw[p][r] = 0u;
            }
            float val[8][3][2], sq[8], sk[8];
#pragma unroll
            for (int i = 0; i < 8; ++i) {
#pragma unroll
                for (int p = 0; p < 3; ++p) { float a0 = 0.f, a1 = 0.f;
#pragma unroll
                    for (int j = 0; j < 4; ++j) { a0 += cw[p][j][0] * bflo(raw[p][i + j]); a1 += cw[p][j][1] * bfhi(raw[p][i + j]); }
                    val[i][p][0] = a0 * sigm(a0); val[i][p][1] = a1 * sigm(a1); }
                sq[i] = val[i][0][0] * val[i][0][0] + val[i][0][1] * val[i][0][1]; sk[i] = val[i][1][0] * val[i][1][0] + val[i][1][1] * val[i][1][1]; }
#pragma unroll
            for (int i = 0; i < 8; ++i) { sq[i] = wave_sum(sq[i]); sk[i] = wave_sum(sk[i]); }
#pragma unroll
            for (int i = 0; i < 8; ++i) {
                const float rq = frsq(sq[i] + EPS) * 0.08838834764831845f, rk = frsq(sk[i] + EPS);
                const int o = (tk0 + i) * TP + 4 * lane;
                *(LAS unsigned*)(L + DNL_QT + o) = cvtpk(val[i][0][0] * rq, val[i][0][1] * rq);
                *(LAS unsigned*)(L + DNL_KT + o) = cvtpk(val[i][1][0] * rk, val[i][1][1] * rk);
                *(LAS unsigned*)(L + DNL_VT + o) = cvtpk(val[i][2][0], val[i][2][1]);
            }
        }
        __syncthreads();
        if (ch + F.G < 1024) DN_LOAD_INPUTS(ch + F.G);
        for (int id = wave; id < 20 * REP_S2; id += 8) {
            const int e = id % 10, isqk = (id / 10) & 1, ti = (e >= 6) ? 3 : (e >= 3) ? 2 : (e >= 1) ? 1 : 0, tj = e - ti * (ti + 1) / 2;
            f32x4 acc = {0.f, 0.f, 0.f, 0.f};
            const int xoff = isqk ? DNL_QT : DNL_KT;
#pragma unroll
            for (int ks = 0; ks < 4; ++ks) {
                const bf16x8 a = *(const LAS bf16x8*)(L + DNL_KT + (16 * tj + r16) * TP + (32 * ks + 8 * g) * 2);
                const bf16x8 bq = *(const LAS bf16x8*)(L + xoff + (16 * ti + r16) * TP + (32 * ks + 8 * g) * 2);
                acc = MFMA16(a, bq, acc); }
            const int i = 16 * ti + r16; const float gi = GC[i], bi = BETA[i]; const f32x4 gj = *(const LAS f32x4*)(GC + 16 * tj + 4 * g);
            f32x4 v;
#pragma unroll
            for (int r = 0; r < 4; ++r) { const int jp = 16 * tj + 4 * g + r; const float d = __expf(fminf(gi - gj[r], 0.f));
                v[r] = isqk ? ((i >= jp) ? acc[r] * d : 0.f) : ((i > jp) ? bi * acc[r] * d : 0.f); }
            if (!isqk) {
                u32x2 w; w.x = cvtpk(-v[0], -v[1]); w.y = cvtpk(-v[2], -v[3]);
                *(LAS u32x2*)(L + DNL_NA + i * NP2 + (16 * tj + 4 * g) * 2) = w;
                if (ti == tj) *(LAS f32x4*)(DB + (ti * 16 + r16) * 16 + 4 * g) = v;
            } else { u32x2 w; w.x = cvtpk(v[0], v[1]); w.y = cvtpk(v[2], v[3]); *(LAS u32x2*)(L + DNL_QKM + i * NP2 + (16 * tj + 4 * g) * 2) = w; }
        }
        __syncthreads();
        for (int rep3_ = 0; rep3_ < REP_S3A; ++rep3_) if (wave < 4) {
            const int I = wave; float x[16];
#pragma unroll
            for (int i = 0; i < 16; ++i) { float a = (i == r16) ? 1.f : 0.f;
#pragma unroll
                for (int j4 = 0; j4 < (i + 3) / 4; ++j4) { const f32x4 d = *(const LAS f32x4*)(DB + (I * 16 + i) * 16 + 4 * j4);
#pragma unroll
                    for (int jj = 0; jj < 4; ++jj) if (4 * j4 + jj < i) a -= d[jj] * x[4 * j4 + jj]; }
                x[i] = a; }
            if (lane < 16) {
#pragma unroll
                for (int i = 0; i < 16; ++i) *(LAS unsigned short*)(L + DNL_TIB + ((I * 16 + i) * 16 + r16) * 2) = (unsigned short)(cvtpk(x[i], 0.f) & 0xffffu);
            }
        }
        __syncthreads();
        for (int rep4_ = 0; rep4_ < REP_S3B; ++rep4_) {
            const int part = wave >> 2, colbase = 32 * (wave & 3);
            f32x4 X[2][4];
#pragma unroll
            for (int I = 0; I < 4; ++I)
#pragma unroll
                for (int nt = 0; nt < 2; ++nt) {
                    const int col = colbase + 16 * nt + r16;
                    f32x4 acc;
#pragma unroll
                    for (int r = 0; r < 4; ++r) { const int tok = 16 * I + 4 * g + r;
                        acc[r] = part == 0 ? BETA[tok] * bf1(*(const LAS unsigned short*)(L + DNL_VT + tok * TP + col * 2))
                                           : -(BETA[tok] * __expf(GC[tok])) * bf1(*(const LAS unsigned short*)(L + DNL_KT + tok * TP + col * 2)); }
                    if (I >= 1) {
                        const u32x2 lo = *(const LAS u32x2*)(L + DNL_NA + (16 * I + r16) * NP2 + (4 * g) * 2);
                        u32x2 hi = {0u, 0u}; if (I >= 2) hi = *(const LAS u32x2*)(L + DNL_NA + (16 * I + r16) * NP2 + (16 + 4 * g) * 2);
                        const v4u aw = {lo.x, lo.y, hi.x, hi.y};
                        const bf16x8 bb = (I >= 2) ? pack8(X[nt][0], X[nt][1]) : pack8z(X[nt][0]);
                        acc = MFMA16(__builtin_bit_cast(bf16x8, aw), bb, acc);
                    }
                    if (I == 3) {
                        const u32x2 lo = *(const LAS u32x2*)(L + DNL_NA + (16 * I + r16) * NP2 + (32 + 4 * g) * 2);
                        const v4u aw = {lo.x, lo.y, 0u, 0u};
                        acc = MFMA16(__builtin_bit_cast(bf16x8, aw), pack8z(X[nt][2]), acc);
                    }
                    const u32x2 tl = *(const LAS u32x2*)(L + DNL_TIB + ((I * 16 + r16) * 16 + 4 * g) * 2);
                    const v4u tw = {tl.x, tl.y, 0u, 0u};
                    const f32x4 zero = {0.f, 0.f, 0.f, 0.f};
                    X[nt][I] = MFMA16(__builtin_bit_cast(bf16x8, tw), pack8z(acc), zero);
                    if (part == 0) { u32x2 w; w.x = cvtpk(X[nt][I][0], X[nt][I][1]); w.y = cvtpk(X[nt][I][2], X[nt][I][3]); *(u32x2*)R.u(ch, 2 * (wave & 3) + nt, I, lane) = w; }
                    else {
#pragma unroll
                        for (int r = 0; r < 4; ++r) *(LAS unsigned short*)(L + DNL_WL + (16 * I + 4 * g + r) * TP + col * 2) = (unsigned short)(cvtpk(X[nt][I][r], 0.f) & 0xffffu);
                    }
                }
        }
        __syncthreads();
        for (int it0 = wave; it0 < 54 * REP_S4; it0 += 8) { const int it = it0 % 54;
            if (it < 32) {
                const int f = it & 15, mt = f >> 2, ks = f & 3, base = (it < 16 ? DNL_WL : DNL_QT) + (16 * mt + r16) * TP;
                const u32x2 lo = *(const LAS u32x2*)(L + base + (32 * ks + 4 * g) * 2), hi = *(const LAS u32x2*)(L + base + (32 * ks + 16 + 4 * g) * 2);
                v4u w = {lo.x, lo.y, hi.x, hi.y};
                if (it >= 16) { const float e = __expf(GC[16 * mt + r16]);
#pragma unroll
                    for (int j = 0; j < 4; ++j) w[j] = cvtpk(bflo(w[j]) * e, bfhi(w[j]) * e); }
                *(v4u*)((it < 16 ? R.W : R.QG) + ((size_t)(ch * 16 + f) * 64 + lane) * 8) = w;
            } else if (it < 48) {
                const int f = it - 32, mt8 = f >> 1, kt = f & 1, dk = 16 * mt8 + r16; const float gl = GC[63];
                float v[8];
#pragma unroll
                for (int j = 0; j < 8; ++j) { const int tok = 32 * kt + (j < 4 ? 4 * g + j : 16 + 4 * g + j - 4); v[j] = bf1(*(const LAS unsigned short*)(L + DNL_KT + tok * TP + dk * 2)) * __expf(gl - GC[tok]); }
                v4u w; w.x = cvtpk(v[0], v[1]); w.y = cvtpk(v[2], v[3]); w.z = cvtpk(v[4], v[5]); w.w = cvtpk(v[6], v[7]);
                *(v4u*)(R.KD + ((size_t)(ch * 16 + f) * 64 + lane) * 8) = w;
            } else {
                const int q = it - 48, mt = (q == 0) ? 0 : (q == 1) ? 1 : (q < 4) ? 2 : 3, kt = (q == 3 || q == 5) ? 1 : 0;
                const u32x2 lo = *(const LAS u32x2*)(L + DNL_QKM + (16 * mt + r16) * NP2 + (32 * kt + 4 * g) * 2);
                u32x2 hi = {0u, 0u}; if (2 * kt + 1 <= mt) hi = *(const LAS u32x2*)(L + DNL_QKM + (16 * mt + r16) * NP2 + (32 * kt + 16 + 4 * g) * 2);
                const v4u w = {lo.x, lo.y, hi.x, hi.y};
                *(v4u*)(R.QK + ((size_t)(ch * 6 + q) * 64 + lane) * 8) = w;
            }
        }
        if (F.tid == 0) R.EGL[ch] = __expf(GC[63]);
        __syncthreads();
    }
}
__device__ __forceinline__ void dn_scan(Frame& F, int task) {
    const DnRec R = dn_rec(F);
    const int bh = task >> 3, sl = task & 7, lane = F.lane;
    f32x4 S[8];
#pragma unroll
    for (int i = 0; i < 8; ++i) S[i] = (f32x4){0.f, 0.f, 0.f, 0.f};
    bf16x8 Wf[16]; u32x2 Uf[4];
    {
        const int ch = bh * 64;
#pragma unroll
        for (int f = 0; f < 16; ++f) Wf[f] = *(const bf16x8*)(R.W + ((size_t)(ch * 16 + f) * 64 + lane) * 8);
#pragma unroll
        for (int mt = 0; mt < 4; ++mt) Uf[mt] = *(const u32x2*)R.u(ch, sl, mt, lane);
    }
    for (int c = 0; c < 64; ++c) {
        const int ch = bh * 64 + c;
        bf16x8 QGf[16];
#pragma unroll
        for (int f = 0; f < 16; ++f) QGf[f] = *(const bf16x8*)(R.QG + ((size_t)(ch * 16 + f) * 64 + lane) * 8);
        bf16x8 Sb[4];
#pragma unroll
        for (int ks = 0; ks < 4; ++ks) Sb[ks] = pack8(S[2 * ks], S[2 * ks + 1]);
        f32x4 vn[4];
#pragma unroll
        for (int mt = 0; mt < 4; ++mt) { vn[mt] = (f32x4){bflo(Uf[mt].x), bfhi(Uf[mt].x), bflo(Uf[mt].y), bfhi(Uf[mt].y)};
#pragma unroll
            for (int ks = 0; ks < 4; ++ks) vn[mt] = MFMA16(Wf[mt * 4 + ks], Sb[ks], vn[mt]); }
        bf16x8 QKf[6], KDf[16];
#pragma unroll
        for (int f = 0; f < 6; ++f) QKf[f] = *(const bf16x8*)(R.QK + ((size_t)(ch * 6 + f) * 64 + lane) * 8);
#pragma unroll
        for (int f = 0; f < 16; ++f) KDf[f] = *(const bf16x8*)(R.KD + ((size_t)(ch * 16 + f) * 64 + lane) * 8);
        const float egl = R.EGL[ch];
        f32x4 o[4];
#pragma unroll
        for (int mt = 0; mt < 4; ++mt) { o[mt] = (f32x4){0.f, 0.f, 0.f, 0.f};
#pragma unroll
            for (int ks = 0; ks < 4; ++ks) o[mt] = MFMA16(QGf[mt * 4 + ks], Sb[ks], o[mt]); }
        const bf16x8 vb0 = pack8(vn[0], vn[1]), vb1 = pack8(vn[2], vn[3]);
        if (c + 1 < 64) {
#pragma unroll
            for (int f = 0; f < 16; ++f) Wf[f] = *(const bf16x8*)(R.W + ((size_t)((ch + 1) * 16 + f) * 64 + lane) * 8);
#pragma unroll
            for (int mt = 0; mt < 4; ++mt) Uf[mt] = *(const u32x2*)R.u(ch + 1, sl, mt, lane);
        }
        o[0] = MFMA16(QKf[0], vb0, o[0]); o[1] = MFMA16(QKf[1], vb0, o[1]);
        o[2] = MFMA16(QKf[2], vb0, o[2]); o[2] = MFMA16(QKf[3], vb1, o[2]);
        o[3] = MFMA16(QKf[4], vb0, o[3]); o[3] = MFMA16(QKf[5], vb1, o[3]);
#pragma unroll
        for (int i = 0; i < 8; ++i) { S[i] = S[i] * egl; S[i] = MFMA16(KDf[2 * i], vb0, S[i]); S[i] = MFMA16(KDf[2 * i + 1], vb1, S[i]); }
#pragma unroll
        for (int mt = 0; mt < 4; ++mt) { u32x2 w; w.x = cvtpk(o[mt][0], o[mt][1]); w.y = cvtpk(o[mt][2], o[mt][3]); *(u32x2*)R.u(ch, sl, mt, lane) = w; }
    }
}
__device__ __forceinline__ void dn_out2(Frame& F) {
    const DnRec R = dn_rec(F);
    const int gw = F.vcu * NWAVES + F.wave, NGW = F.G * NWAVES, lane = F.lane, r16 = lane & 15, g = lane >> 4;
    const bf16* proj = (const bf16*)(F.ws + WS_PROJ); bf16* YDN = (bf16*)(F.ws + WS_Y); const float* gain = F.in[6];
    for (int task = gw; task < 4096; task += NGW) {
        const int ch = task >> 2, mt = task & 3, bh = ch >> 6, c = ch & 63, b = bh >> 2, h = bh & 3;
        f32x4 o[8]; float ss[4] = {0.f, 0.f, 0.f, 0.f};
#pragma unroll
        for (int sl = 0; sl < 8; ++sl) { const u32x2 w = *(const u32x2*)R.u(ch, sl, mt, lane); o[sl] = (f32x4){bflo(w.x), bfhi(w.x), bflo(w.y), bfhi(w.y)};
#pragma unroll
            for (int r = 0; r < 4; ++r) ss[r] += o[sl][r] * o[sl][r]; }
#pragma unroll
        for (int r = 0; r < 4; ++r) { float s = sum16(ss[r]); ss[r] = frsq(s * (1.0f / DN_D) + EPS); }
#pragma unroll
        for (int sl = 0; sl < 8; ++sl) { const int d = 16 * sl + r16; const float gd = gain[d];
#pragma unroll
            for (int r = 0; r < 4; ++r) { const size_t m = (size_t)b * SEQ + 64 * c + 16 * mt + 4 * g + r; const float z = bf1(proj[m * NP + PC_Z + h * DN_D + d]);
                YDN[m * DN_W + h * DN_D + d] = (bf16)(cvtpk(o[sl][r] * ss[r] * gd * z * sigm(z), 0.f) & 0xffffu); } }
    }
}
constexpr int SCAN_SLOT = 55296;
__device__ __forceinline__ void dn_scan_wg(Frame& F, int bh, int half) {
    const DnRec R = dn_rec(F);
    const int lane = F.lane, wave = F.wave;
    LAS unsigned char* ring = F.lds + RING_OFF;
    if (wave >= 4) {
        const int lw = wave - 4;
        for (int c = -1; c < 63; ++c) {
            const int ch = bh * 64 + c + 1; LAS unsigned char* slot = ring + ((c + 1) & 1) * SCAN_SLOT;
            for (int p = lw; p < 54; p += 4) {
                const bf16* src = p < 16 ? R.W + (size_t)ch * 8192 + p * 512 : p < 32 ? R.QG + (size_t)ch * 8192 + (p - 16) * 512 : p < 48 ? R.KD + (size_t)ch * 8192 + (p - 32) * 512 : R.QK + (size_t)ch * 3072 + (p - 48) * 512;
                __builtin_amdgcn_global_load_lds((const unsigned*)(src + lane * 8), (LAS unsigned*)(slot + p * 1024), 16, 0, 0);
            }
            asm volatile("s_waitcnt vmcnt(0)" ::: "memory");
            __builtin_amdgcn_s_barrier();
            asm volatile("" ::: "memory");
        }
        __builtin_amdgcn_s_barrier();
    } else {
        const int sl = half * 4 + wave;
        f32x4 S[8];
#pragma unroll
        for (int i = 0; i < 8; ++i) S[i] = (f32x4){0.f, 0.f, 0.f, 0.f};
        u32x2 Uf[4];
#pragma unroll
        for (int mt = 0; mt < 4; ++mt) Uf[mt] = *(const u32x2*)R.u(bh * 64, sl, mt, lane);
        float egl = R.EGL[bh * 64];
        asm volatile("" ::: "memory");
        __builtin_amdgcn_s_barrier();
        asm volatile("" ::: "memory");
        for (int c = 0; c < 64; ++c) {
            const int ch = bh * 64 + c;
            const LAS unsigned char* slot = ring + (c & 1) * SCAN_SLOT + lane * 16;
            bf16x8 Sb[4];
#pragma unroll
            for (int ks = 0; ks < 4; ++ks) Sb[ks] = pack8(S[2 * ks], S[2 * ks + 1]);
            f32x4 vn[4], o[4];
#pragma unroll
            for (int mt = 0; mt < 4; ++mt) { vn[mt] = (f32x4){bflo(Uf[mt].x), bfhi(Uf[mt].x), bflo(Uf[mt].y), bfhi(Uf[mt].y)};
#pragma unroll
                for (int ks = 0; ks < 4; ++ks) vn[mt] = MFMA16(*(const LAS bf16x8*)(slot + (mt * 4 + ks) * 1024), Sb[ks], vn[mt]); }
            u32x2 Un[4]; float egln = 0.f;
            if (c + 1 < 64) {
#pragma unroll
                for (int mt = 0; mt < 4; ++mt) Un[mt] = *(const u32x2*)R.u(ch + 1, sl, mt, lane);
                egln = R.EGL[ch + 1];
            } else {
#pragma unroll
                for (int mt = 0; mt < 4; ++mt) Un[mt] = (u32x2){0u, 0u};
            }
#pragma unroll
            for (int mt = 0; mt < 4; ++mt) { o[mt] = (f32x4){0.f, 0.f, 0.f, 0.f};
#pragma unroll
                for (int ks = 0; ks < 4; ++ks) o[mt] = MFMA16(*(const LAS bf16x8*)(slot + 16384 + (mt * 4 + ks) * 1024), Sb[ks], o[mt]); }
            const bf16x8 vb0 = pack8(vn[0], vn[1]), vb1 = pack8(vn[2], vn[3]);
            const LAS unsigned char* qk = slot + 49152;
            o[0] = MFMA16(*(const LAS bf16x8*)(qk + 0 * 1024), vb0, o[0]); o[1] = MFMA16(*(const LAS bf16x8*)(qk + 1 * 1024), vb0, o[1]);
            o[2] = MFMA16(*(const LAS bf16x8*)(qk + 2 * 1024), vb0, o[2]); o[2] = MFMA16(*(const LAS bf16x8*)(qk + 3 * 1024), vb1, o[2]);
            o[3] = MFMA16(*(const LAS bf16x8*)(qk + 4 * 1024), vb0, o[3]); o[3] = MFMA16(*(const LAS bf16x8*)(qk + 5 * 1024), vb1, o[3]);
#pragma unroll
            for (int i = 0; i < 8; ++i) { S[i] = S[i] * egl; S[i] = MFMA16(*(const LAS bf16x8*)(slot + 32768 + (2 * i) * 1024), vb0, S[i]); S[i] = MFMA16(*(const LAS bf16x8*)(slot + 32768 + (2 * i + 1) * 1024), vb1, S[i]); }
#pragma unroll
            for (int mt = 0; mt < 4; ++mt) { u32x2 w; w.x = cvtpk(o[mt][0], o[mt][1]); w.y = cvtpk(o[mt][2], o[mt][3]); *(u32x2*)R.u(ch, sl, mt, lane) = w; }
#pragma unroll
            for (int mt = 0; mt < 4; ++mt) Uf[mt] = Un[mt];
            egl = egln;
            asm volatile("s_waitcnt lgkmcnt(0)" ::: "memory");
            __builtin_amdgcn_s_barrier();
            asm volatile("" ::: "memory");
        }
    }
}
__device__ __forceinline__ void run_phase0(Frame& F) {
    unsigned char* ws = F.ws; bf16* XB = (bf16*)(ws + WS_XB); bf16* Y = (bf16*)(ws + WS_Y); bf16* PROJ = (bf16*)(ws + WS_PROJ); (void)XB; (void)Y; (void)PROJ;
        p0_prologue(F);
}
__device__ __forceinline__ void run_phase1(Frame& F) {
    unsigned char* ws = F.ws; bf16* XB = (bf16*)(ws + WS_XB); bf16* Y = (bf16*)(ws + WS_Y); bf16* PROJ = (bf16*)(ws + WS_PROJ); (void)XB; (void)Y; (void)PROJ;
        const int N1 = (F.G == 256) ? P1_TILES * 256 : NP;
        pg8::Gemm g{XB, (const bf16*)(ws + WS_WIN), M, N1, D}; pg8::StaticOrder S; S.init(M, N1, F.G, (int)blockIdx.x);
        pg8::EpiProj E{PROJ, NP, (const float*)(ws + WS_RSTD), PC_G / 256, 0};
        pg8::gemm_phase<pg8::EpiProj, pg8::StaticOrder, true, true>(F.lds + RING_OFF, g, S, E);
}
__device__ __forceinline__ void run_phase2(Frame& F) {
    unsigned char* ws = F.ws; bf16* XB = (bf16*)(ws + WS_XB); bf16* Y = (bf16*)(ws + WS_Y); bf16* PROJ = (bf16*)(ws + WS_PROJ); (void)XB; (void)Y; (void)PROJ;
#if FAST_DN
        for (int rep_ = 0; rep_ < REP_DNA; ++rep_) dn_chunk_prep(F);
#else
        dn_pre(F);
#endif
#if FAST_SWA
        for (int rep_ = 0; rep_ < REP_SWAPRE; ++rep_) swa_pre(F);
#endif
}
__device__ __forceinline__ void run_phase3(Frame& F) {
    unsigned char* ws = F.ws; bf16* XB = (bf16*)(ws + WS_XB); bf16* Y = (bf16*)(ws + WS_Y); bf16* PROJ = (bf16*)(ws + WS_PROJ); (void)XB; (void)Y; (void)PROJ;
#if FAST_DN
        if (F.G == 256) {
            const int bx = (int)blockIdx.x;
            if (((bx >> 3) & 7) == 0) {
                const int xcd = bx & 7, j = bx >> 6;
                dn_scan_wg(F, xcd * 2 + (j >> 1), j & 1);
            } else {
                const int gi = (bx >> 6) * 56 + (bx & 63) - 8, NG = NP - P1_TILES * 256;
                pg8::Gemm g{XB, (const bf16*)(ws + WS_WIN) + (size_t)P1_TILES * 256 * D, M, NG, D}; pg8::StaticOrder S; S.init(M, NG, 224, gi);
                pg8::EpiProj E{PROJ, NP, (const float*)(ws + WS_RSTD), PC_G / 256, P1_TILES};
                pg8::gemm_phase<pg8::EpiProj, pg8::StaticOrder, true, true>(F.lds + RING_OFF, g, S, E);
                swa_bias_table(F); __syncthreads();
                swa_main(F, gi * NWAVES + F.wave, 224 * NWAVES);
            }
        } else {
        swa_bias_table(F); __syncthreads();
        {
            const int nscan = F.G < 128 ? F.G : 128;
            if (F.wave == 0 && F.vcu < nscan) { for (int task = F.vcu; task < 128; task += nscan) dn_scan(F, task); }
            else { const int worker = F.vcu < nscan ? F.vcu * 7 + F.wave - 1 : nscan * 7 + (F.vcu - nscan) * 8 + F.wave; swa_main(F, worker, nscan * 7 + (F.G - nscan) * 8); }
        }
        }
#elif FAST_SWA
        if (F.vcu < 16) dn_scan_naive(F, F.vcu);
        else { swa_bias_table(F); __syncthreads(); swa_main(F, (F.vcu - 16) * NWAVES + F.wave, (F.G - 16) * NWAVES); }
#else
        if (F.G > 16) { if (F.vcu < 16) dn_scan_naive(F, F.vcu); else swa_naive(F, (F.vcu - 16) * NWAVES + F.wave, (F.G - 16) * NWAVES); }
        else { for (int bh = F.vcu; bh < 16; bh += F.G) dn_scan_naive(F, bh); swa_naive(F, F.vcu * NWAVES + F.wave, F.G * NWAVES); }
#endif
}
__device__ __forceinline__ void run_phase4(Frame& F) {
    unsigned char* ws = F.ws; bf16* XB = (bf16*)(ws + WS_XB); bf16* Y = (bf16*)(ws + WS_Y); bf16* PROJ = (bf16*)(ws + WS_PROJ); (void)XB; (void)Y; (void)PROJ;
#if FAST_DN
        dn_out2(F);
#else
        dn_out(F);
#endif
}
__device__ __forceinline__ void run_phase5(Frame& F) {
    unsigned char* ws = F.ws; bf16* XB = (bf16*)(ws + WS_XB); bf16* Y = (bf16*)(ws + WS_Y); bf16* PROJ = (bf16*)(ws + WS_PROJ); (void)XB; (void)Y; (void)PROJ;
        pg8::Gemm g{Y, (const bf16*)(ws + WS_WAB), 2 * M, 2 * D, DN_W}; pg8::PairedOrder S; S.init(M, D, F.G, (int)blockIdx.x);
        pg8::EpiMerge E{PROJ + PC_G, NP, XB, D, M / 256, D / 256};
        pg8::gemm_phase<pg8::EpiMerge, pg8::PairedOrder, false, true>(F.lds + RING_OFF, g, S, E);
}
__device__ __forceinline__ void run_phase6(Frame& F) {
    unsigned char* ws = F.ws; bf16* XB = (bf16*)(ws + WS_XB); bf16* Y = (bf16*)(ws + WS_Y); bf16* PROJ = (bf16*)(ws + WS_PROJ); (void)XB; (void)Y; (void)PROJ;
        pg8::Gemm g{XB, (const bf16*)(ws + WS_WOUT), M, D, D}; pg8::StaticOrder S; S.init(M, D, F.G, (int)blockIdx.x);
        pg8::EpiX1 E{F.in[0], F.out, Y, (float*)(ws + WS_SSQ), D};
        pg8::gemm_phase<pg8::EpiX1, pg8::StaticOrder, false, true>(F.lds + RING_OFF, g, S, E);
}
__device__ __forceinline__ void run_phase7(Frame& F) {
    unsigned char* ws = F.ws; bf16* XB = (bf16*)(ws + WS_XB); bf16* Y = (bf16*)(ws + WS_Y); bf16* PROJ = (bf16*)(ws + WS_PROJ); (void)XB; (void)Y; (void)PROJ;
        pg8::Gemm g{Y, (const bf16*)(ws + WS_WGU), M, 2 * FF, D}; pg8::StaticOrder S; S.init(M, 2 * FF, F.G, (int)blockIdx.x);
        pg8::EpiSwiGLU E{PROJ, FF, (const float*)(ws + WS_SSQ), EPS};
        pg8::gemm_phase<pg8::EpiSwiGLU, pg8::StaticOrder, true, true>(F.lds + RING_OFF, g, S, E);
}
__device__ __forceinline__ void run_phase8(Frame& F) {
    unsigned char* ws = F.ws; bf16* XB = (bf16*)(ws + WS_XB); bf16* Y = (bf16*)(ws + WS_Y); bf16* PROJ = (bf16*)(ws + WS_PROJ); (void)XB; (void)Y; (void)PROJ;
        pg8::Gemm g{PROJ, (const bf16*)(ws + WS_WD), M, D, FF}; pg8::StaticOrder S; S.init(M, D, F.G, (int)blockIdx.x);
        pg8::EpiOut E{F.out, D, Y};
        pg8::gemm_phase<pg8::EpiOut, pg8::StaticOrder, false, true>(F.lds + RING_OFF, g, S, E);
}
#ifndef PROGRAM
#define PROGRAM RUN(0) BAR RUN(1) BAR RUN(2) BAR RUN(3) BAR RUN(4) BAR RUN(5) BAR RUN(6) BAR RUN(7) BAR RUN(8)
#endif
struct Args { const float* in[18]; float* out; unsigned char* ws; int ph_lo, ph_hi, li, pad; };
__global__ void __launch_bounds__(NWAVES * 64, 2) fwd_kernel(Args args) {
    extern __shared__ __attribute__((aligned(16))) unsigned char lds[];
    Frame F;
    F.lds = (LAS unsigned char*)lds;
    F.MISC = (volatile LAS unsigned*)(F.lds + MISC_OFF);
    F.tid = threadIdx.x; F.lane = F.tid & 63; F.wave = __builtin_amdgcn_readfirstlane(F.tid >> 6);
    F.G = gridDim.x; { const int bx = blockIdx.x; F.vcu = (F.G % 8 == 0) ? (bx % 8) * (F.G / 8) + bx / 8 : bx; }
#pragma unroll
    for (int i = 0; i < 18; ++i) F.in[i] = args.in[i];
    F.out = args.out; F.ws = args.ws; unsigned char* ws = args.ws;
    F.ctl = (gu32*)(ws + WS_CTL);
    for (int u = F.tid; u < (LDS_BYTES - LDSCTL_OFF) / 4; u += NWAVES * 64) ((LAS unsigned*)(F.lds + LDSCTL_OFF))[u] = 0u;
    __syncthreads();
    XcdBarrier bar; bar.bar = (unsigned*)(F.ctl + CW_BAR) + args.li * XCD_BAR_WORDS; bar.x = 0; bar.st = nullptr;
    bar = xcd_barrier_post((unsigned*)(F.ctl + CW_BAR) + args.li * XCD_BAR_WORDS, F.MISC + 8);
#define RUN(k) run_phase##k(F);
#define BAR xcd_barrier(bar);
    PROGRAM
#undef RUN
#undef BAR
}

extern "C" void kernel_launch(void* const* d_in, const int* in_sizes, int n_in, void* d_out, int out_size, void* d_ws, size_t ws_size, hipStream_t stream) {
    static int grid = 0;
    if (grid == 0) {
        if (n_in != 18 || in_sizes[0] != M * D || out_size != M * D || ws_size < WS_END) { fprintf(stderr, "kernel_launch: unexpected shapes (n_in %d, in0 %d, out %d, ws %zu)\n", n_in, n_in > 0 ? in_sizes[0] : -1, out_size, ws_size); grid = -1; return; }
        int dev = 0, cus = 0;
        if (hipGetDevice(&dev) != hipSuccess || hipDeviceGetAttribute(&cus, hipDeviceAttributeMultiprocessorCount, dev) != hipSuccess) { grid = -1; return; }
        if (hipFuncSetAttribute((const void*)fwd_kernel, hipFuncAttributeMaxDynamicSharedMemorySize, LDS_BYTES) != hipSuccess) { fprintf(stderr, "kernel_launch: hipFuncSetAttribute failed\n"); grid = -1; return; }
        int per_cu = 0;
        if (hipOccupancyMaxActiveBlocksPerMultiprocessor(&per_cu, (const void*)fwd_kernel, NWAVES * 64, LDS_BYTES) != hipSuccess || per_cu < 1) fprintf(stderr, "kernel_launch: occupancy query reports %d\n", per_cu);
        (void)hipGetLastError();
        grid = cus;
    }
    if (grid < 0) return;
    if (hipMemsetAsync((char*)d_ws + WS_CTL, 0, CTL_ZERO_BYTES, stream) != hipSuccess) return;
    Args a{};
    for (int i = 0; i < 18; ++i) a.in[i] = (const float*)d_in[i];
    a.out = (float*)d_out; a.ws = (unsigned char*)d_ws;
    for (int li = 0; li < 1; ++li) {
        a.ph_lo = 0; a.ph_hi = 0;
        a.li = li;
        hipLaunchKernelGGL(fwd_kernel, dim3(grid), dim3(NWAVES * 64), LDS_BYTES, stream, a);
        const hipError_t le = hipPeekAtLastError();
        if (le != hipSuccess) { fprintf(stderr, "kernel_launch: launch %d failed: %s\n", li, hipGetErrorName(le)); break; }
    }
}
```

```cpp
#ifndef FAST_SWA
#define FAST_SWA 1
#endif
#ifndef FAST_DN
#define FAST_DN 1
#endif
#ifndef REP_DNA
#define REP_DNA 1
#endif
#ifndef REP_SWAPRE
#define REP_SWAPRE 1
#endif
#ifndef REP_S1
#define REP_S1 1
#endif
#ifndef REP_S2
#define REP_S2 1
#endif
#ifndef REP_S3A
#define REP_S3A 1
#endif
#ifndef REP_S3B
#define REP_S3B 1
#endif
#ifndef REP_S4
#define REP_S4 1
#endif
#ifndef S1_RELOAD
#define S1_RELOAD 0
#endif
#ifndef S1_OPAQUE
#define S1_OPAQUE 0
#endif
#ifndef P1_TILES
#define P1_TILES 12
#endif
#ifndef STAMP_PHASE
#define STAMP_PHASE -1
#endif
#ifndef STAMP_SUB
#define STAMP_SUB -1
#endif
#ifndef STAMP_BLOCK
#define STAMP_BLOCK 0
#endif
#ifndef STAMP_DN
#define STAMP_DN -1
#endif
#ifndef STAMP_WS
#define STAMP_WS 0
#endif
#ifndef P3_SKIP_SCAN
#define P3_SKIP_SCAN 0
#endif
#ifndef P3_SKIP_GEMM
#define P3_SKIP_GEMM 0
#endif
#ifndef SCAN_HOT
#define SCAN_HOT 0
#endif
#ifndef STAMP_Q
#define STAMP_Q 8.0f
#endif
#ifndef SCAN_AHEAD
#define SCAN_AHEAD 6
#endif
#ifndef SCAN_TOUCH_EN
#define SCAN_TOUCH_EN 0
#endif
#ifndef DEFER_WEIGHTS
#define DEFER_WEIGHTS 1
#endif
#ifndef P3_ONLY_SCAN
#define P3_ONLY_SCAN 0
#endif
#ifndef ALIGN_P7
#define ALIGN_P7 true
#endif
#ifndef ALIGN_P1
#define ALIGN_P1 true
#endif
#ifndef ALIGN_P5
#define ALIGN_P5 true
#endif
#ifndef ALIGN_P6
#define ALIGN_P6 true
#endif
#ifndef ALIGN_P8
#define ALIGN_P8 true
#endif
#ifndef SP2_P7
#define SP2_P7 true
#endif
#ifndef P3_ORDER
#define P3_ORDER 0
#endif
#ifndef SCAN_SETS
#define SCAN_SETS 4
#endif
#ifndef DNA_PREFETCH
#define DNA_PREFETCH 0
#endif
#ifndef SCAN_NT
#define SCAN_NT 0
#endif
#ifndef FUSE_QKNORM
#define FUSE_QKNORM 1
#endif
#ifndef STAMP_SUBB
#define STAMP_SUBB (STAMP_SUB + 1)
#endif
#ifndef SCAN_UPRE
#define SCAN_UPRE 2
#endif
#ifndef SCAN_PUBLISH
#define SCAN_PUBLISH 1
#endif
#ifndef SCAN_DRAIN_CNT
#define SCAN_DRAIN_CNT 0
#endif
#ifndef SCAN_O_SC1
#define SCAN_O_SC1 1
#endif
#ifndef SCAN_REFILL_LATE
#define SCAN_REFILL_LATE 1
#endif
#ifndef SCAN_O16
#define SCAN_O16 1
#endif
#ifndef STAMP_OFF
#define STAMP_OFF 0.0f
#endif
#ifndef DNO_SLEEP
#define DNO_SLEEP 8
#endif
#ifndef DNO_SKIPWORK
#define DNO_SKIPWORK 0
#endif
#ifndef DNO_SKIPALL
#define DNO_SKIPALL 0
#endif
#ifndef SCAN_PUB_LOADER
#define SCAN_PUB_LOADER 1
#endif
#ifndef SCAN_PUB_EVERY
#define SCAN_PUB_EVERY 1
#endif
#ifndef DNO_FENCE
#define DNO_FENCE 0
#endif
#ifndef SCAN_DRAIN_NONE
#define SCAN_DRAIN_NONE 0
#endif
#ifndef DNO_LAG
#define DNO_LAG 0
#endif
#ifndef EPI_WT
#define EPI_WT 0
#endif
#ifndef TAIL_SPLIT
#define TAIL_SPLIT 0
#endif
#ifndef GEMM_SAMETILE
#define GEMM_SAMETILE 0
#endif
#ifndef STAMP_EPI
#define STAMP_EPI 0
#endif
#ifndef SEAM56
#define SEAM56 1
#endif
#ifndef SCAN_QG_EARLY
#define SCAN_QG_EARLY 0
#endif
#ifndef BAR_EARLY_WB
#define BAR_EARLY_WB 0
#endif
#ifndef P0_DEEP
#define P0_DEEP 0
#endif
#ifndef DNO_STAGE
#define DNO_STAGE 1
#endif
#ifndef SEAM35
#define SEAM35 1
#endif
#ifndef P6_TOUCH_AB
#define P6_TOUCH_AB 0
#endif
#ifndef P5_TOUCH_G
#define P5_TOUCH_G 0
#endif
#ifndef P6_TOUCH_X
#define P6_TOUCH_X 0
#endif
#ifndef SEAM67
#define SEAM67 1
#endif
#ifndef SKEW_TAIL
#define SKEW_TAIL 1
#endif
#ifndef SEAM78
#define SEAM78 0
#endif
#include <hip/hip_runtime.h>
#include <cstdio>
#include <cstdint>

#ifndef WGM_KNOB
#define WGM_KNOB 8
#endif
#ifndef EPI_REP
#define EPI_REP 1
#endif
#ifndef EPI_REP_WHICH
#define EPI_REP_WHICH 0
#endif
#ifndef RES_F32
#define RES_F32 0
#endif
#if STAMP_SUB >= 0
__device__ unsigned long long g_sub[8];
#define SUBSTAMP(i) if (blockIdx.x == STAMP_BLOCK && threadIdx.x == 0) g_sub[i] = __builtin_amdgcn_s_memrealtime();
#else
#define SUBSTAMP(i)
#endif
namespace pg8 {
#define PG8_LAS __attribute__((address_space(3)))
typedef unsigned short bf16_t;
typedef short bf16x8 __attribute__((ext_vector_type(8)));
typedef float f32x4 __attribute__((ext_vector_type(4)));
typedef unsigned u32x4 __attribute__((ext_vector_type(4)));
typedef unsigned u32x2 __attribute__((ext_vector_type(2)));
constexpr int BM = 256, BK = 64, HALF = 128, HTB = HALF * BK * 2  , STAGE_BYTES = 8 * HTB, NXCD = 8, WGM = WGM_KNOB;

__host__ __device__ __forceinline__ int lds_byte(int r, int c) { const int st = (r >> 4) * 2 + (c >> 5), rr = r & 15, cc = c & 31, ob = rr * 64 + cc * 2; return st * 1024 + (ob ^ (((ob >> 9) & 1) << 5)); }
__host__ __device__ __forceinline__ void stage_rc(int b, int& R, int& C) { const int st = b / 1024, sb = b % 1024, swz = sb ^ (((sb >> 9) & 1) << 5); R = (st >> 1) * 16 + swz / 64; C = (st & 1) * 32 + (swz % 64) / 2; }
__host__ __device__ __forceinline__ int perm32(int rho) { const int n = rho >> 4, i = rho & 15; return 8 * (i >> 2) + 4 * n + (i & 3); }

struct Unit { int pm, pn, hm, chk; };
struct Gemm { const bf16_t* A; const bf16_t* Bt; int M, N, K; int lda = 0, nMA = 1 << 30, a2off = 0; };

struct StaticOrder {
    int nM, nN, nwg, G, c;
    __host__ __device__ void init(int M, int N, int G_, int c_) { nM = M / BM; nN = N / BM; nwg = nM * nN; G = G_; c = c_; }
    __host__ __device__ bool next(int i, Unit& u) const { return nextL((long)i * G + c, u); }
    __host__ __device__ bool nextL(long L, Unit& u) const {
        if (L >= nwg) return false;
        u.hm = 0; u.chk = 0;
        int wgid = (int)L; { const int q = nwg / NXCD, r = nwg % NXCD, xcd = wgid % NXCD, off = wgid / NXCD; wgid = (xcd < r ? xcd * (q + 1) : r * (q + 1) + (xcd - r) * q) + off; }
        const int nig = WGM * nN, gid = wgid / nig, fm = gid * WGM, gsz = (nM - fm) < WGM ? (nM - fm) : WGM;
        u.pm = fm + ((wgid % nig) % gsz); u.pn = (wgid % nig) / gsz; return true;
    }
    __device__ __forceinline__ void a_ready(const Unit&) const {}
    __device__ __forceinline__ void done(const Unit&) const {}
};
struct TailSplitOrder {
    StaticOrder so; int full, rem; bool split;
    __host__ __device__ void init(int M, int N, int G_, int c_) { so.init(M, N, G_, c_); full = so.nwg / G_; rem = so.nwg - full * G_; split = TAIL_SPLIT && rem > 0 && 2 * rem <= G_; }
    __host__ __device__ bool next(int i, Unit& u) const {
        if (i < full || !split) return so.next(i, u);
        if (i > full || so.c >= 2 * rem) return false;
        if (!so.nextL((long)full * so.G + (so.c >> 1), u)) return false;
        u.hm = 1 + (so.c & 1); return true;
    }
    __device__ __forceinline__ void a_ready(const Unit&) const {}
    __device__ __forceinline__ void done(const Unit&) const {}
};
struct SkewOrder {
    StaticOrder so; const unsigned* pan; const unsigned* p56; int act_row_bytes, proj_row_bytes;
    __host__ __device__ void init(int M, int N, int G_, int c_) { so.init(M, N, G_, c_); }
    __host__ __device__ bool next(int i, Unit& u) const {
        const int full = so.nwg / so.G;
        if (i < full || !SKEW_TAIL) return so.next(i, u);
        if (i > full) return false;
        const int x = so.c & 7, off = so.c >> 3; if (x & 1) return false;
        if (!so.nextL((long)full * so.G + 8 * (off >> 1) + x + (off & 1), u)) return false;
        u.chk = off & 1; return true;
    }
    __device__ __forceinline__ bool panel_ready(int pm) const {
        bool ok = (unsigned)__builtin_amdgcn_readfirstlane((int)__hip_atomic_load(pan + 64 * pm + 3, __ATOMIC_RELAXED, __HIP_MEMORY_SCOPE_AGENT)) >= 4u;
        const int lo = (pm * act_row_bytes) / proj_row_bytes, hi = ((pm + 1) * act_row_bytes - 1) / proj_row_bytes;
        for (int q = lo; q <= hi; ++q) ok = ok && (unsigned)__builtin_amdgcn_readfirstlane((int)__hip_atomic_load(p56 + 64 * q, __ATOMIC_RELAXED, __HIP_MEMORY_SCOPE_AGENT)) >= 4u;
        return ok;
    }
    __device__ __forceinline__ void a_ready(const Unit& u) const {
        if (u.chk) {
            if (threadIdx.x < 64) {
                for (unsigned sp = 0; !panel_ready(u.pm) && sp < (1u << 18); ++sp) __builtin_amdgcn_s_sleep(2);
                __builtin_amdgcn_fence(__ATOMIC_ACQUIRE, "agent"); asm volatile("s_waitcnt vmcnt(0)" ::: "memory"); }
            asm volatile("" ::: "memory"); __builtin_amdgcn_s_barrier(); asm volatile("" ::: "memory");
        }
    }
    __device__ __forceinline__ void done(const Unit&) const {}
};
struct PairedOrder {
    StaticOrder so;
    __host__ __device__ void init(int M, int N, int G_, int c_) { so.init(M, N, G_, c_); }
    __host__ __device__ bool next(int i, Unit& u) const { if (!so.next(i >> 1, u)) return false; if (i & 1) { u.pm += so.nM; u.pn += so.nN; } return true; }
    __device__ __forceinline__ void a_ready(const Unit&) const {}
    __device__ __forceinline__ void done(const Unit&) const {}
};

__device__ __forceinline__ unsigned cvt_pk_bf16(float lo, float hi) { unsigned r; asm volatile("v_cvt_pk_bf16_f32 %0, %1, %2" : "=v"(r) : "v"(lo), "v"(hi)); return r; }
__device__ __forceinline__ float bf_lo(unsigned w) { return __builtin_bit_cast(float, w << 16); }
__device__ __forceinline__ float bf_hi(unsigned w) { return __builtin_bit_cast(float, w & 0xffff0000u); }
__device__ __forceinline__ float sigmoidf_(float x) { return 1.0f / (1.0f + __expf(-x)); }
template <class V> __device__ __forceinline__ void st16wt(void* p, V v) {
    asm volatile("global_store_dwordx4 %0, %1, off sc1\n\ts_nop 1" :: "v"((__attribute__((address_space(1))) V*)p), "v"(v) : "memory");
}
template <class V> __device__ __forceinline__ void st16(void* p, V v) {
#if EPI_WT
    asm volatile("global_store_dwordx4 %0, %1, off sc1\n\ts_nop 1" :: "v"((__attribute__((address_space(1))) V*)p), "v"(v) : "memory");
#else
    *(V*)p = v;
#endif
}


struct EpiProj {
    static constexpr bool SUBST = false, PERM = true, AFTER_DRAIN = false, PROBE_REP = (EPI_REP_WHICH == 1);
    bf16_t* O; int ldc; const float* rstd; int gate_pn0, pn_off;
    bf16_t* QS; bf16_t* KS; const float* qg; const float* kg; int q_pn0, k_pn;
    float qscale; int seq; int wt = 0;
    __device__ __forceinline__ bool keep(const Unit&) const { return false; }
    __device__ __forceinline__ void operator()(f32x4 (&acc)[2][2][4][2], const Unit& u, int wr, int wc, int fr, int fq) const {
        const int pna = u.pn + pn_off;
        const int row0 = u.pm * BM + wr * 64 + fr, col0 = pna * BM + wc * 64 + 8 * fq; const bool gate = pna >= gate_pn0;
        float sr[2][4];
#pragma unroll
        for (int ai = 0; ai < 2; ++ai)
#pragma unroll
            for (int m = 0; m < 4; ++m) sr[ai][m] = rstd[row0 + ai * HALF + m * 16];
        const bool isq = QS != nullptr && (pna == q_pn0 || pna == q_pn0 + 1), isk = QS != nullptr && pna == k_pn && wc < 2;
        if (isq || isk) {
            f32x4 gn[2][2];
#pragma unroll
            for (int bj = 0; bj < 2; ++bj)
#pragma unroll
                for (int n = 0; n < 2; ++n) { const int d = 32 * bj + 8 * fq + 4 * n; gn[bj][n] = isq ? *(const f32x4*)(qg + d) * qscale : *(const f32x4*)(kg + d); }
#pragma unroll
            for (int ai = 0; ai < 2; ++ai)
#pragma unroll
                for (int m = 0; m < 4; ++m) { const int row = row0 + ai * HALF + m * 16; const float s = sr[ai][m];
                    float ss = 0.f;
#pragma unroll
                    for (int bj = 0; bj < 2; ++bj)
#pragma unroll
                        for (int n = 0; n < 2; ++n) { const f32x4 v = acc[ai][bj][m][n] * s; ss += (v[0] * v[0] + v[1] * v[1]) + (v[2] * v[2] + v[3] * v[3]); }
                    ss += __shfl_xor(ss, 16); ss += __shfl_xor(ss, 32);
                    const float r = s * __builtin_amdgcn_rsqf(ss * (1.0f / 64.0f) + 1e-6f);
                    bf16_t* dst = isq ? QS + (size_t)row * 512 + (pna - q_pn0) * 256 + wc * 64 + 8 * fq
                                      : KS + ((size_t)((row / seq) * 2 + wc) * seq + (row % seq)) * 64 + 8 * fq;
#pragma unroll
                    for (int bj = 0; bj < 2; ++bj) { const f32x4 v0 = acc[ai][bj][m][0] * r * gn[bj][0], v1 = acc[ai][bj][m][1] * r * gn[bj][1];
                        u32x4 w; w.x = cvt_pk_bf16(v0[0], v0[1]); w.y = cvt_pk_bf16(v0[2], v0[3]); w.z = cvt_pk_bf16(v1[0], v1[1]); w.w = cvt_pk_bf16(v1[2], v1[3]);
                        st16(dst + bj * 32, w); } }
            return;
        }
#pragma unroll
        for (int ai = 0; ai < 2; ++ai)
#pragma unroll
            for (int m = 0; m < 4; ++m) { const int row = row0 + ai * HALF + m * 16; const float s = sr[ai][m]; bf16_t* rowp = O + (size_t)row * ldc + col0;
#pragma unroll
                for (int bj = 0; bj < 2; ++bj) { f32x4 v0 = acc[ai][bj][m][0] * s, v1 = acc[ai][bj][m][1] * s;
                    if (gate) {
#pragma unroll
                        for (int j = 0; j < 4; ++j) { v0[j] = __builtin_amdgcn_rcpf(1.0f + __expf(-v0[j])); v1[j] = __builtin_amdgcn_rcpf(1.0f + __expf(-v1[j])); } }
                    u32x4 w; w.x = cvt_pk_bf16(v0[0], v0[1]); w.y = cvt_pk_bf16(v0[2], v0[3]); w.z = cvt_pk_bf16(v1[0], v1[1]); w.w = cvt_pk_bf16(v1[2], v1[3]);
                    if (wt) st16wt(rowp + bj * 32, w); else st16(rowp + bj * 32, w); } }
    }
};
struct EpiMerge {
    static constexpr bool SUBST = false, PERM = true, AFTER_DRAIN = false, PROBE_REP = false;
    const bf16_t* G; int ldg; bf16_t* O; int ldc; int nM, nN;
    __device__ __forceinline__ bool keep(const Unit& u) const { return u.pm < nM; }
    __device__ __forceinline__ void operator()(f32x4 (&acc)[2][2][4][2], const Unit& u, int wr, int wc, int fr, int fq) const {
        const bool second = u.pm >= nM; const int pm = second ? u.pm - nM : u.pm, pn = second ? u.pn - nN : u.pn;
        const int row0 = pm * BM + wr * 64 + fr, col0 = pn * BM + wc * 64 + 8 * fq;
#pragma unroll
        for (int ai = 0; ai < 2; ++ai) {
            u32x4 gA[4][2], gB[4][2];
#pragma unroll
            for (int m = 0; m < 4; ++m)
#pragma unroll
                for (int bj = 0; bj < 2; ++bj) { const size_t o = (size_t)(row0 + ai * HALF + m * 16) * ldg + col0 + bj * 32; if (!second) gA[m][bj] = *(const u32x4*)(G + o); gB[m][bj] = *(const u32x4*)(G + o + 1024); }
#pragma unroll
            for (int m = 0; m < 4; ++m) { const int row = row0 + ai * HALF + m * 16;
#pragma unroll
                for (int bj = 0; bj < 2; ++bj) { const int col = col0 + bj * 32;
                    float sb[8];
#pragma unroll
                    for (int j = 0; j < 4; ++j) { sb[2 * j] = bf_lo(gB[m][bj][j]); sb[2 * j + 1] = bf_hi(gB[m][bj][j]); }
                    if (!second) {
                        float sa[8];
#pragma unroll
                        for (int j = 0; j < 4; ++j) { sa[2 * j] = bf_lo(gA[m][bj][j]); sa[2 * j + 1] = bf_hi(gA[m][bj][j]); }
#pragma unroll
                        for (int j = 0; j < 4; ++j) { acc[ai][bj][m][0][j] *= sa[j] * __builtin_amdgcn_rcpf(sb[j]); acc[ai][bj][m][1][j] *= sa[4 + j] * __builtin_amdgcn_rcpf(sb[4 + j]); }
                    } else {
                        f32x4 v0, v1;
#pragma unroll
                        for (int j = 0; j < 4; ++j) { v0[j] = acc[ai][bj][m][0][j] * sb[j]; v1[j] = acc[ai][bj][m][1][j] * sb[4 + j]; }
                        u32x4 w; w.x = cvt_pk_bf16(v0[0], v0[1]); w.y = cvt_pk_bf16(v0[2], v0[3]); w.z = cvt_pk_bf16(v1[0], v1[1]); w.w = cvt_pk_bf16(v1[2], v1[3]);
                        if (SEAM56) st16wt(O + (size_t)row * ldc + col, w); else st16(O + (size_t)row * ldc + col, w); } } }
            asm volatile("" ::: "memory"); }
    }
};
struct EpiX1 {
    static constexpr bool SUBST = (STAMP_EPI == 6), PERM = (SEAM67 != 0), AFTER_DRAIN = false, PROBE_REP = (EPI_REP_WHICH == 6);
    const float* X; float* out; bf16_t* xb; float* ssq; int ldc;
    __device__ __forceinline__ bool keep(const Unit&) const { return false; }
    __device__ __forceinline__ void operator()(f32x4 (&acc)[2][2][4][2], const Unit& u, int wr, int wc, int fr, int fq) const {
        const int row0 = u.pm * BM + wr * 64 + fr, col0 = u.pn * BM + wc * 32 + (PERM ? 8 : 4) * fq; constexpr int NOFF = PERM ? 4 : 16;
#pragma unroll
        for (int ai = 0; ai < 2; ++ai) {
            f32x4 xv[4][2][2];
#pragma unroll
            for (int m = 0; m < 4; ++m)
#pragma unroll
                for (int bj = 0; bj < 2; ++bj)
#pragma unroll
                    for (int n = 0; n < 2; ++n) xv[m][bj][n] = *(const f32x4*)(X + (size_t)(row0 + ai * HALF + m * 16) * ldc + col0 + bj * HALF + n * NOFF);
#pragma unroll
            for (int m = 0; m < 4; ++m) { const int row = row0 + ai * HALF + m * 16; const size_t off = (size_t)row * ldc + col0; float ss = 0.f;
#pragma unroll
                for (int bj = 0; bj < 2; ++bj) { u32x4 w4;
#pragma unroll
                    for (int n = 0; n < 2; ++n) { const f32x4 o = xv[m][bj][n] + acc[ai][bj][m][n];
                        if (RES_F32) *(f32x4*)(out + off + bj * HALF + n * NOFF) = o; ss += (o[0] * o[0] + o[1] * o[1]) + (o[2] * o[2] + o[3] * o[3]);
                        u32x2 w; w.x = cvt_pk_bf16(o[0], o[1]); w.y = cvt_pk_bf16(o[2], o[3]);
                        if (PERM) { if (n == 0) { w4.x = w.x; w4.y = w.y; } else { w4.z = w.x; w4.w = w.y; } }
                        else *(u32x2*)(xb + off + bj * HALF + n * 16) = w; }
                    if (PERM) st16wt(xb + off + bj * HALF, w4); }
                ss += __shfl_xor(ss, 16); ss += __shfl_xor(ss, 32);
                if (fq == 0) atomicAdd(ssq + row, ss); }
            asm volatile("" ::: "memory"); }
    }
};
struct EpiSwiGLU {
    static constexpr bool SUBST = false, PERM = true, AFTER_DRAIN = false, PROBE_REP = (EPI_REP_WHICH == 7);
    bf16_t* O; int ldc; const float* ssq; float eps;
    __device__ __forceinline__ bool keep(const Unit&) const { return false; }
    __device__ __forceinline__ void operator()(f32x4 (&acc)[2][2][4][2], const Unit& u, int wr, int wc, int fr, int fq) const {
        const int row0 = u.pm * BM + (u.hm == 2 ? HALF : 0) + wr * 64 + fr, col0 = u.pn * HALF + wc * 32 + 8 * fq;
        float sr[2][4];
#pragma unroll
        for (int ai = 0; ai < 2; ++ai)
#pragma unroll
            for (int m = 0; m < 4; ++m) sr[ai][m] = ssq[row0 + (u.hm ? 0 : ai * HALF) + m * 16];
#pragma unroll
        for (int ai = 0; ai < 2; ++ai)
#pragma unroll
            for (int m = 0; m < 4; ++m) { const int row = row0 + ai * HALF + m * 16;
                if (ai == 1 && u.hm) continue;
                const float s = __builtin_amdgcn_rsqf(sr[ai][m] * (1.0f / 1024.0f) + eps);
                float a[8];
#pragma unroll
                for (int n = 0; n < 2; ++n)
#pragma unroll
                    for (int j = 0; j < 4; ++j) { const float g = acc[ai][0][m][n][j] * s, up = acc[ai][1][m][n][j] * s; a[4 * n + j] = g * up * __builtin_amdgcn_rcpf(1.0f + __expf(-g)); }
                u32x4 w; w.x = cvt_pk_bf16(a[0], a[1]); w.y = cvt_pk_bf16(a[2], a[3]); w.z = cvt_pk_bf16(a[4], a[5]); w.w = cvt_pk_bf16(a[6], a[7]);
                if (SEAM78) st16wt(O + (size_t)row * ldc + col0, w); else st16(O + (size_t)row * ldc + col0, w); }
    }
};
struct EpiOut {
    static constexpr bool SUBST = (STAMP_EPI == 8), PERM = false, AFTER_DRAIN = false, PROBE_REP = false;
    float* out; int ldc; const bf16_t* xb;
    __device__ __forceinline__ bool keep(const Unit&) const { return false; }
    __device__ __forceinline__ void operator()(f32x4 (&acc)[2][2][4][2], const Unit& u, int wr, int wc, int fr, int fq) const {
        const int row0 = u.pm * BM + wr * 64 + fr, col0 = u.pn * BM + wc * 32 + 4 * fq;
#pragma unroll
        for (int ai = 0; ai < 2; ++ai) {
            u32x2 rb[4][2][2]; f32x4 rf[4][2][2];
#pragma unroll
            for (int m = 0; m < 4; ++m)
#pragma unroll
                for (int bj = 0; bj < 2; ++bj)
#pragma unroll
                    for (int n = 0; n < 2; ++n) { const size_t o = (size_t)(row0 + ai * HALF + m * 16) * ldc + col0 + bj * HALF + n * 16;
                        if (RES_F32) rf[m][bj][n] = *(const f32x4*)(out + o); else rb[m][bj][n] = *(const u32x2*)(xb + o); }
#pragma unroll
            for (int m = 0; m < 4; ++m) { const size_t off = (size_t)(row0 + ai * HALF + m * 16) * ldc + col0;
#pragma unroll
                for (int bj = 0; bj < 2; ++bj)
#pragma unroll
                    for (int n = 0; n < 2; ++n) { f32x4 b;
                        if (RES_F32) b = rf[m][bj][n]; else { const u32x2 w = rb[m][bj][n]; b = (f32x4){bf_lo(w.x), bf_hi(w.x), bf_lo(w.y), bf_hi(w.y)}; }
                        *(f32x4*)(out + off + bj * HALF + n * 16) = b + acc[ai][bj][m][n]; } }
            asm volatile("" ::: "memory"); }
    }
};

template <class Epi, class Sched, bool ALIGN_EPI = false, bool SP2 = false, bool HM = false>
__device__ __forceinline__ void gemm_phase(PG8_LAS unsigned char* lds, const Gemm g, const Sched& S, const Epi& E) {
    int tid_ = threadIdx.x; asm volatile("" : "+v"(tid_));
    const int tid = tid_, wid = __builtin_amdgcn_readfirstlane(tid >> 6), lane = tid & 63, wr = wid >> 2, wc = wid & 3, fr = lane & 15, fq = lane >> 4;
    const int K = g.K, nt = K / BK, LDA = g.lda ? g.lda : g.K;
    unsigned voffA[2], voffB[2];
#pragma unroll
    for (int i = 0; i < 2; ++i) { int R, C; stage_rc(tid * 16 + i * 8192, R, C); const int Rb = Epi::PERM ? ((R & ~31) + perm32(R & 31)) : R;
        voffA[i] = (unsigned)(R * LDA + C) * 2u; voffB[i] = (unsigned)(Rb * K + C) * 2u; }
    const size_t kstep = (size_t)(BK * 2);
    const size_t hstep = (size_t)HALF * K * 2;
    const size_t tstep = 2 * hstep;
    const size_t hstepA = (size_t)HALF * LDA * 2, tstepA = 2 * hstepA;
#define PG8_ABASE(pm_) ((const char*)g.A + (GEMM_SAMETILE ? (size_t)0 : ((pm_) < g.nMA ? (size_t)(pm_) * tstepA : (size_t)((pm_) - g.nMA) * tstepA + (size_t)g.a2off)))
    const unsigned ldsw = (unsigned)wid * 1024u;
    const int aoff = lds_byte(wr * 64 + fr, fq * 8), boff = lds_byte(wc * 32 + fr, fq * 8);
#define PG8_SA(b, h) (((b) * 2 + (h)) * HTB)
#define PG8_SB(b, h) ((4 + (b) * 2 + (h)) * HTB)
#define PG8_STAGE(bufoff, gbase, voff) do { _Pragma("unroll") for (int _i = 0; _i < 2; ++_i) \
        __builtin_amdgcn_global_load_lds((const unsigned*)((const char*)(gbase) + (voff)[_i]), (PG8_LAS unsigned*)(lds + (bufoff) + ldsw + _i * 8192), 16, 0, 0); } while (0)
#define PG8_LDA(dst, b, h) do { _Pragma("unroll") for (int m = 0; m < 4; ++m) _Pragma("unroll") for (int k = 0; k < 2; ++k) dst[m][k] = *(const PG8_LAS bf16x8*)(lds + PG8_SA(b, h) + aoff + m * 2048 + k * 1024); } while (0)
#define PG8_LDB(dst, b, h) do { _Pragma("unroll") for (int n = 0; n < 2; ++n) _Pragma("unroll") for (int k = 0; k < 2; ++k) dst[n][k] = *(const PG8_LAS bf16x8*)(lds + PG8_SB(b, h) + boff + n * 2048 + k * 1024); } while (0)
#define PG8_MMA(ai, bj, At, Bt) do { __builtin_amdgcn_s_setprio(1); _Pragma("unroll") for (int m = 0; m < 4; ++m) _Pragma("unroll") for (int n = 0; n < 2; ++n) _Pragma("unroll") for (int k = 0; k < 2; ++k) \
        acc[ai][bj][m][n] = __builtin_amdgcn_mfma_f32_16x16x32_bf16(Bt[n][k], At[m][k], acc[ai][bj][m][n], 0, 0, 0); __builtin_amdgcn_s_setprio(0); } while (0)
#define PG8_WAIT_V(n) asm volatile("s_waitcnt vmcnt(" #n ")" ::: "memory")
#define PG8_WAIT_L(n) asm volatile("s_waitcnt lgkmcnt(" #n ")" ::: "memory")
#define PG8_BAR __builtin_amdgcn_s_barrier()
#define PG8_SCHED __builtin_amdgcn_sched_barrier(0)
    Unit cur, nxt; int ui = 0;
    if (!S.next(0, cur)) return;
    f32x4 acc[2][2][4][2];
#pragma unroll
    for (int a = 0; a < 2; ++a)
#pragma unroll
        for (int b = 0; b < 2; ++b)
#pragma unroll
            for (int m = 0; m < 4; ++m)
#pragma unroll
                for (int n = 0; n < 2; ++n) acc[a][b][m][n] = (f32x4){0.f, 0.f, 0.f, 0.f};
    bf16x8 At[4][2], B0[2][2], B1[2][2];
    static_assert(!HM || SP2, "half units: SP2 schedule only");
    bool chalf = HM && cur.hm != 0; size_t cH = chalf ? 0 : hstepA;
    const char* cA = PG8_ABASE(cur.pm) + ((HM && cur.hm == 2) ? hstepA : 0); const char* cB = (const char*)g.Bt + (GEMM_SAMETILE ? (size_t)0 : (size_t)cur.pn * tstep);
    S.a_ready(cur);
    if constexpr (SP2) {
        PG8_STAGE(PG8_SB(0, 0), cB, voffB); PG8_STAGE(PG8_SB(0, 1), cB + hstep, voffB); PG8_STAGE(PG8_SA(0, 0), cA, voffA); PG8_STAGE(PG8_SA(0, 1), cA + cH, voffA);
        if (wr == 1) PG8_BAR;
        PG8_WAIT_V(2); PG8_BAR;
        PG8_STAGE(PG8_SB(1, 0), cB + kstep, voffB); PG8_STAGE(PG8_SA(1, 0), cA + kstep, voffA); PG8_STAGE(PG8_SB(1, 1), cB + hstep + kstep, voffB);
        PG8_WAIT_V(6); PG8_BAR;
    } else {
        PG8_STAGE(PG8_SB(0, 0), cB, voffB); PG8_STAGE(PG8_SA(0, 0), cA, voffA); PG8_STAGE(PG8_SB(0, 1), cB + hstep, voffB); PG8_STAGE(PG8_SA(0, 1), cA + cH, voffA);
        if (wr == 1) PG8_BAR;
        PG8_WAIT_V(4); PG8_BAR;
        PG8_STAGE(PG8_SB(1, 0), cB + kstep, voffB); PG8_STAGE(PG8_SA(1, 0), cA + kstep, voffA); PG8_STAGE(PG8_SB(1, 1), cB + hstep + kstep, voffB);
        PG8_WAIT_V(6); PG8_BAR;
    }
    for (;;) {
        const bool has_next = S.next(ui + 1, nxt);
        const bool nhalf = has_next ? (HM && nxt.hm != 0) : chalf; const size_t nH = nhalf ? 0 : hstepA;
        const char* nA = has_next ? PG8_ABASE(nxt.pm) + ((HM && nxt.hm == 2) ? hstepA : 0) : cA; const char* nB = has_next ? (const char*)g.Bt + (GEMM_SAMETILE ? (size_t)0 : (size_t)nxt.pn * tstep) : cB;
        for (int t = 0; t < nt; t += 2) {
            const bool last = (t == nt - 2);
            const char* a1 = cA + (size_t)(t + 1) * kstep;
            const char* a2 = last ? nA : cA + (size_t)(t + 2) * kstep; const char* b2 = last ? nB : cB + (size_t)(t + 2) * kstep;
            const char* a3 = a2 + kstep; const char* b3 = b2 + kstep;
            const size_t h2 = last ? nH : cH;
            if (last && has_next) S.a_ready(nxt);
            if constexpr (SP2) {
            PG8_LDB(B0, 0, 0); PG8_LDB(B1, 0, 1); PG8_SCHED; PG8_LDA(At, 0, 0); PG8_STAGE(PG8_SA(1, 1), a1 + cH, voffA);
            PG8_WAIT_V(8); PG8_WAIT_L(0); PG8_BAR; PG8_MMA(0, 0, At, B0); PG8_MMA(0, 1, At, B1); PG8_BAR; PG8_SCHED;
            if (!chalf) PG8_LDA(At, 0, 1); PG8_STAGE(PG8_SB(0, 0), b2, voffB); PG8_STAGE(PG8_SB(0, 1), b2 + hstep, voffB); PG8_STAGE(PG8_SA(0, 0), a2, voffA);
            PG8_WAIT_V(8); PG8_WAIT_L(0); PG8_BAR; if (!chalf) { PG8_MMA(1, 0, At, B0); PG8_MMA(1, 1, At, B1); } PG8_BAR; PG8_SCHED;
            PG8_LDB(B0, 1, 0); PG8_LDB(B1, 1, 1); PG8_SCHED; PG8_LDA(At, 1, 0); PG8_STAGE(PG8_SA(0, 1), a2 + h2, voffA);
            PG8_WAIT_V(8); PG8_WAIT_L(0); PG8_BAR; PG8_MMA(0, 0, At, B0); PG8_MMA(0, 1, At, B1); PG8_BAR; PG8_SCHED;
            if (!chalf) PG8_LDA(At, 1, 1); PG8_STAGE(PG8_SB(1, 0), b3, voffB); PG8_STAGE(PG8_SB(1, 1), b3 + hstep, voffB); PG8_STAGE(PG8_SA(1, 0), a3, voffA);
            PG8_WAIT_V(8); PG8_WAIT_L(0); PG8_BAR; if (!chalf) { PG8_MMA(1, 0, At, B0); PG8_MMA(1, 1, At, B1); } PG8_BAR; PG8_SCHED;
            } else {
            PG8_LDB(B0, 0, 0); PG8_SCHED; PG8_LDA(At, 0, 0); PG8_STAGE(PG8_SA(1, 1), a1 + cH, voffA);
            PG8_WAIT_L(8); PG8_BAR; PG8_WAIT_L(0); PG8_MMA(0, 0, At, B0); PG8_BAR; PG8_SCHED;
            PG8_LDB(B1, 0, 1); PG8_STAGE(PG8_SB(0, 0), b2, voffB);
            PG8_BAR; PG8_WAIT_L(0); PG8_MMA(0, 1, At, B1); PG8_BAR;
            PG8_LDA(At, 0, 1); PG8_STAGE(PG8_SA(0, 0), a2, voffA);
            PG8_BAR; PG8_WAIT_L(0); PG8_MMA(1, 0, At, B0); PG8_BAR; PG8_SCHED;
            PG8_STAGE(PG8_SB(0, 1), b2 + hstep, voffB);
            PG8_WAIT_V(6); PG8_BAR; PG8_MMA(1, 1, At, B1); PG8_BAR;
            PG8_LDB(B0, 1, 0); PG8_SCHED; PG8_LDA(At, 1, 0); PG8_STAGE(PG8_SA(0, 1), a2 + h2, voffA);
            PG8_WAIT_L(8); PG8_BAR; PG8_WAIT_L(0); PG8_MMA(0, 0, At, B0); PG8_BAR; PG8_SCHED;
            PG8_LDB(B1, 1, 1); PG8_STAGE(PG8_SB(1, 0), b3, voffB);
            PG8_BAR; PG8_WAIT_L(0); PG8_MMA(0, 1, At, B1); PG8_BAR;
            PG8_LDA(At, 1, 1); PG8_STAGE(PG8_SA(1, 0), a3, voffA);
            PG8_BAR; PG8_WAIT_L(0); PG8_MMA(1, 0, At, B0); PG8_BAR; PG8_SCHED;
            PG8_STAGE(PG8_SB(1, 1), b3 + hstep, voffB);
            PG8_WAIT_V(6); PG8_BAR; PG8_MMA(1, 1, At, B1); PG8_BAR;
            }
        }
        if (Epi::SUBST) { SUBSTAMP(5) }
        if constexpr (ALIGN_EPI) { if (wr == 0) PG8_BAR; }
        if constexpr (!Epi::AFTER_DRAIN) { for (int er_ = 0; er_ < (Epi::PROBE_REP ? EPI_REP : 1); ++er_) { E(acc, cur, wr, wc, fr, fq); if (Epi::PROBE_REP && EPI_REP > 1) asm volatile("" ::: "memory"); } S.done(cur); }
        if (Epi::SUBST) { SUBSTAMP(6) }
        if (!has_next) break;
        if (!E.keep(cur)) {
#pragma unroll
        for (int a = 0; a < 2; ++a)
#pragma unroll
            for (int b = 0; b < 2; ++b)
#pragma unroll
                for (int m = 0; m < 4; ++m)
#pragma unroll
                    for (int n = 0; n < 2; ++n) acc[a][b][m][n] = (f32x4){0.f, 0.f, 0.f, 0.f};
        }
        cur = nxt; cA = nA; cB = nB; chalf = nhalf; cH = nH; ++ui;
        if constexpr (ALIGN_EPI) { if (wr == 1) PG8_BAR; }
    }
    PG8_WAIT_V(0);
    if constexpr (!ALIGN_EPI) { if (wr == 0) PG8_BAR; }
    PG8_BAR;
    if constexpr (Epi::AFTER_DRAIN) { E.fused(acc, cur, wr, wc, fr, fq, lds, wid, lane); S.done(cur); }
#undef PG8_ABASE
#undef PG8_SA
#undef PG8_SB
#undef PG8_STAGE
#undef PG8_LDA
#undef PG8_LDB
#undef PG8_MMA
#undef PG8_WAIT_V
#undef PG8_WAIT_L
#undef PG8_BAR
#undef PG8_SCHED
}
}

constexpr int NWAVES = 8;
#ifndef MK_N_LAUNCHES
#define MK_N_LAUNCHES 1
#endif
constexpr int PER_PHASE = 9;
constexpr int N_LAUNCHES = MK_N_LAUNCHES;

constexpr int BATCH = 4, SEQ = 4096, D = 1024, M = BATCH * SEQ;
constexpr int DN_H = 4, DN_D = 128, DN_W = 512, DN_QKV = 1536;
constexpr int SW_H = 8, SW_KV = 2, SW_D = 64, SW_W = 512, SW_KVW = 128, WINDOW = 128;
constexpr int FF = 2816;
constexpr int D_IN = 4872;
constexpr int NP = 4864;
constexpr int PC_Z = 1536, PC_SQ = 2048, PC_SK = 2560, PC_SV = 2688, PC_G = 2816;
constexpr int PC_YDN = 0, PC_YSW = 512;
constexpr float EPS = 1e-6f;

constexpr size_t MiB = 1u << 20;
constexpr size_t WS_CTL = 0, CTL_ZERO_BYTES = 65536;
constexpr size_t WS_WIN = 1 * MiB;
constexpr size_t WS_WAB = 11 * MiB;
constexpr size_t WS_WOUT = 13 * MiB;
constexpr size_t WS_WGU = 15 * MiB;
constexpr size_t WS_WD = 26 * MiB;
constexpr size_t WS_RSTD = 32 * MiB;
constexpr size_t WS_GB = WS_RSTD + 64 * 1024;
constexpr size_t WS_SSQ = 33 * MiB;
constexpr size_t WS_SSQ2 = WS_SSQ + 65536;
constexpr size_t WS_XB = 34 * MiB;
constexpr size_t WS_Y = 66 * MiB;
constexpr size_t WS_PROJ = 98 * MiB;
constexpr size_t WS_UB = 250 * MiB;
constexpr size_t WS_END = 256 * MiB;
static_assert(WS_PROJ + (size_t)M * NP * 2 <= WS_UB, "ws map");
constexpr int CW_TMO = 0, CW_SCAN = 1024  , CW_WCOPY = 3201  , CW_NORMDONE = 3202  , CW_SWADONE = 3200  , CW_BAR = 4096, CW_P56 = 8192  , CW_P67 = 12288, CW_PAN = 12288  ;

constexpr int RING_OFF = 0, RING_BYTES = 131072;
constexpr int LDSCTL_OFF = RING_BYTES, MISC_OFF = LDSCTL_OFF + 320;
constexpr int LDS_BYTES = 147456;

#define GAS __attribute__((address_space(1)))
#define LAS __attribute__((address_space(3)))
typedef unsigned short bf16;
typedef unsigned v4u __attribute__((ext_vector_type(4)));
typedef float f32x4 __attribute__((ext_vector_type(4)));
typedef float f32x2 __attribute__((ext_vector_type(2)));
typedef GAS unsigned gu32;
#define RLX_AGENT __ATOMIC_RELAXED, __HIP_MEMORY_SCOPE_AGENT
#define LDS_WAIT() asm volatile("s_waitcnt lgkmcnt(0)" ::: "memory")
#define VM_WAIT() asm volatile("s_waitcnt vmcnt(0)" ::: "memory")
__device__ __forceinline__ unsigned f2bf(float f) { unsigned u = __builtin_bit_cast(unsigned, f); return (u + 0x7fffu + ((u >> 16) & 1u)) >> 16; }
__device__ __forceinline__ unsigned pk2(float lo, float hi) { return f2bf(lo) | (f2bf(hi) << 16); }
__device__ __forceinline__ float bflo(unsigned w) { return __builtin_bit_cast(float, w << 16); }
__device__ __forceinline__ float bfhi(unsigned w) { return __builtin_bit_cast(float, w & 0xffff0000u); }
__device__ __forceinline__ float bf1(bf16 h) { return __builtin_bit_cast(float, (unsigned)h << 16); }
__device__ __forceinline__ float sigm(float x) { return __builtin_amdgcn_rcpf(1.0f + __expf(-x)); }
__device__ __forceinline__ float frsq(float x) { return __builtin_amdgcn_rsqf(x); }
template <int CTRL> __device__ __forceinline__ float dpp_mov(float v) { return __builtin_bit_cast(float, __builtin_amdgcn_update_dpp(0, __builtin_bit_cast(int, v), CTRL, 0xf, 0xf, true)); }
__device__ __forceinline__ float sum4(float v) { v += dpp_mov<0xB1>(v); v += dpp_mov<0x4E>(v); return v; }
__device__ __forceinline__ float sum8(float v) { v = sum4(v); v += dpp_mov<0x141>(v); return v; }
__device__ __forceinline__ float sum16(float v) { v = sum8(v); v += dpp_mov<0x140>(v); return v; }
__device__ __forceinline__ float rdlane(float v, int l) { return __builtin_bit_cast(float, __builtin_amdgcn_readlane(__builtin_bit_cast(int, v), l)); }
__device__ __forceinline__ float wave_sum(float v) { v = sum16(v); return (rdlane(v, 0) + rdlane(v, 16)) + (rdlane(v, 32) + rdlane(v, 48)); }
__device__ __forceinline__ float sum32(float v, int lane) { v = sum16(v); const float lo = rdlane(v, 0) + rdlane(v, 16), hi = rdlane(v, 32) + rdlane(v, 48); return (lane & 32) ? hi : lo; }
__device__ __forceinline__ float wave_max(float v) {
#pragma unroll
    for (int o = 1; o < 64; o <<= 1) v = fmaxf(v, __shfl_xor(v, o));
    return v;
}

#define XB_TMO      128
#define XB_XCNT(j)  (256  + 64 * (j))
#define XB_XSUB(j)  (1280 + 64 * (j))
#define XB_XGEN(j)  (2304 + 64 * (j))
#define XB_TOP      3328
#define XB_TOPGEN   3392
#define XCD_BAR_WORDS 3456
#define XB_SPIN_CAP (1u << 18)
__device__ __forceinline__ unsigned xb_ld(unsigned* p)              { return __hip_atomic_load(p, __ATOMIC_RELAXED, __HIP_MEMORY_SCOPE_AGENT); }
__device__ __forceinline__ unsigned xb_add(unsigned* p, unsigned v) { return __hip_atomic_fetch_add(p, v, __ATOMIC_RELAXED, __HIP_MEMORY_SCOPE_AGENT); }
__device__ __forceinline__ unsigned xb_xcc_id() { return (unsigned)__builtin_amdgcn_s_getreg((3 << 11) | 20) & 0xFu; }
#define XB_SPIN(cond, bar) do { unsigned _sp = 0; while (cond) { __builtin_amdgcn_s_sleep(1); \
    if ((++_sp & 255u) == 0u) { if (xb_ld(&(bar)[XB_TMO])) break; if (_sp > XB_SPIN_CAP) { atomicAdd(&(bar)[XB_TMO], 1u); break; } } } } while (0)
struct XcdBarrier { unsigned* bar; unsigned x; volatile LAS unsigned* st; };
__device__ __forceinline__ XcdBarrier xcd_barrier_post(unsigned* bar, volatile LAS unsigned* st) {
    XcdBarrier b; b.bar = bar; b.x = xb_xcc_id(); b.st = st;
    if (threadIdx.x == 0) (void)xb_add(&bar[XB_XCNT(b.x)], 1u);
    return b;
}
__device__ __forceinline__ void xcd_barrier_complete(unsigned* bar, unsigned x, unsigned& nloc, unsigned& nx) {
    const unsigned G = gridDim.x * gridDim.y * gridDim.z;
    unsigned sum, cnt, mine, sp = 0u;
    for (;;) {
        sum = 0u; cnt = 0u; mine = 0u;
#pragma unroll
        for (unsigned j = 0; j < 16; ++j) { const unsigned c = xb_ld(&bar[XB_XCNT(j)]); sum += c; cnt += (c > 0u) ? 1u : 0u; mine = (j == x) ? c : mine; }
        if (sum == G) break;
        __builtin_amdgcn_s_sleep(1);
        if ((++sp & 255u) == 0u) { if (xb_ld(&bar[XB_TMO])) break; if (sp > XB_SPIN_CAP) { atomicAdd(&bar[XB_TMO], 1u); break; } }
    }
    nloc = mine > 0u ? mine : 1u; nx = cnt > 0u ? cnt : 1u;
}
__device__ __forceinline__ void xcd_barrier(const XcdBarrier& b) {
    asm volatile("s_waitcnt vmcnt(0)" ::: "memory");
    __syncthreads();
    if (threadIdx.x == 0) {
        unsigned* bar = b.bar;
        __builtin_amdgcn_s_waitcnt(0);
        unsigned nloc = b.st[0], nx = b.st[1];
        if (nloc == 0u) { xcd_barrier_complete(bar, b.x, nloc, nx); b.st[0] = nloc; b.st[1] = nx; }
#if BAR_EARLY_WB
        asm volatile("buffer_wbl2 sc1" ::: "memory");
#endif
        const unsigned old = xb_add(&bar[XB_XSUB(b.x)], 1u);
        const unsigned gen = old / nloc;
        if (old + 1u == (gen + 1u) * nloc) {
            __builtin_amdgcn_fence(__ATOMIC_RELEASE, "agent");
            asm volatile("s_waitcnt vmcnt(0)" ::: "memory");
            const unsigned og = xb_add(&bar[XB_TOP], 1u);
            const unsigned tg = og / nx;
            if (og + 1u == (tg + 1u) * nx) xb_add(&bar[XB_TOPGEN], 1u);
            else XB_SPIN(xb_ld(&bar[XB_TOPGEN]) == tg, bar);
            __builtin_amdgcn_fence(__ATOMIC_ACQUIRE, "agent");
            xb_add(&bar[XB_XGEN(b.x)], 1u);
            asm volatile("s_waitcnt vmcnt(0)" ::: "memory");
        } else {
            XB_SPIN(xb_ld(&bar[XB_XGEN(b.x)]) == gen, bar);
            __builtin_amdgcn_fence(__ATOMIC_ACQUIRE, "agent");
            asm volatile("s_waitcnt vmcnt(0)" ::: "memory");
        }
    }
    __syncthreads();
}

struct Args { const float* in[18]; float* out; unsigned char* ws; int ph_lo, ph_hi, li, ws_mib; };
typedef const __attribute__((address_space(4))) Args* KArgs;
#define FIN(k) (F.ka->in[k])
struct Frame {
    LAS unsigned char* lds;
    volatile LAS unsigned* MISC;
    gu32* ctl;
    int tid, lane, wave;
    int vcu, G;
    KArgs ka; float* out; unsigned char* ws;
};
__device__ const unsigned char T5_BUCKET[128] = {0,1,2,3,4,5,6,7,8,9,10,11,12,13,14,15,16,16,16,17,17,18,18,18,19,19,19,20,20,20,20,21,21,21,21,22,22,22,22,22,23,23,23,23,23,23,24,24,24,24,24,24,25,25,25,25,25,25,25,26,26,26,26,26,26,26,26,27,27,27,27,27,27,27,27,27,27,28,28,28,28,28,28,28,28,28,28,29,29,29,29,29,29,29,29,29,29,29,29,30,30,30,30,30,30,30,30,30,30,30,30,30,30,31,31,31,31,31,31,31,31,31,31,31,31,31,31,31};

__device__ __forceinline__ int lcol32(int nb) { return 256 * (nb >> 3) + 32 * (2 * (nb & 3) + ((nb >> 2) & 1)); }
constexpr int WI_IN = 16 * (NP / 32), WI_AB = 8 * 32, WI_OUT = 16 * 32, WI_GU = 16 * (2 * FF / 32), WI_D = (FF / 64) * 32, WI_ALL = WI_IN + 2 * WI_AB + WI_OUT + WI_GU + WI_D, WI_P0 = SEAM35 ? (SEAM56 ? WI_IN + 2 * WI_AB + WI_OUT : WI_IN + 2 * WI_AB) : WI_IN;
struct WItem { const float* W; int ldw, src_col0, K; bf16* WT; int dst_row0; const float* gain; int kb; };
__device__ __forceinline__ WItem weight_item(Frame& F, int it) {
    unsigned char* ws = F.ws;
    bf16* WinT = (bf16*)(ws + WS_WIN); bf16* WabT = (bf16*)(ws + WS_WAB); bf16* WoutT = (bf16*)(ws + WS_WOUT); bf16* WguT = (bf16*)(ws + WS_WGU); bf16* WdT = (bf16*)(ws + WS_WD);
    int r = it;
    if (r < WI_IN) { const int nb = r % (NP / 32), kb = r / (NP / 32), dr = 32 * nb, lc = lcol32(nb); return WItem{FIN(2), D_IN, lc < 2048 ? lc : lc + 8, D, WinT, dr, FIN(1), kb}; } r -= WI_IN;
    if (r < WI_AB) { const int nb = r % 32, kb = r / 32; return WItem{FIN(11), D, lcol32(nb), DN_W, WabT, 32 * nb, nullptr, kb}; } r -= WI_AB;
    if (r < WI_AB) { const int nb = r % 32, kb = r / 32; return WItem{FIN(12), D, lcol32(nb), SW_W, WabT, 1024 + 32 * nb, nullptr, kb}; } r -= WI_AB;
    if (r < WI_OUT) { const int nb = r % 32, kb = r / 32; return WItem{FIN(13), D, 32 * nb, D, WoutT, 32 * nb, nullptr, kb}; } r -= WI_OUT;
    if (r < WI_GU) { const int nb = r % (2 * FF / 32), kb = r / (2 * FF / 32), dr = 32 * nb, pn = dr >> 8, j = dr & 255;
        return WItem{(j < 128) ? FIN(15) : FIN(16), FF, 128 * pn + (j & 127), D, WguT, dr, FIN(14), kb}; } r -= WI_GU;
    { const int nb = r % 32, kb = r / 32; return WItem{FIN(17), D, 32 * nb, FF, WdT, 32 * nb, nullptr, kb}; }
}
__device__ __forceinline__ void witem_load(const WItem& w, int lane, f32x4 (&v)[8], float (&gn)[8]) {
    const int k0 = 64 * w.kb, c4 = 4 * (lane & 7);
#pragma unroll
    for (int i = 0; i < 8; ++i) { const int kk = 8 * i + (lane >> 3); v[i] = *(const f32x4*)(w.W + (size_t)(k0 + kk) * w.ldw + w.src_col0 + c4); gn[i] = w.gain ? w.gain[k0 + kk] : 1.0f; }
}
__device__ __forceinline__ void witem_store(const WItem& w, int lane, const f32x4 (&v)[8], const float (&gn)[8], LAS float* scr) {
    const int k0 = 64 * w.kb, c4 = 4 * (lane & 7);
#pragma unroll
    for (int i = 0; i < 8; ++i) { const int kk = 8 * i + (lane >> 3);
        scr[kk * 33 + c4] = v[i].x * gn[i]; scr[kk * 33 + c4 + 1] = v[i].y * gn[i]; scr[kk * 33 + c4 + 2] = v[i].z * gn[i]; scr[kk * 33 + c4 + 3] = v[i].w * gn[i]; }
    LDS_WAIT(); asm volatile("" ::: "memory");
    const int c = lane & 7;
#pragma unroll
    for (int j = 0; j < 4; ++j) { const int n = (lane >> 3) + 8 * j; const LAS float* s = scr + (8 * c) * 33 + n;
        v4u o; o.x = pk2(s[0 * 33], s[1 * 33]); o.y = pk2(s[2 * 33], s[3 * 33]); o.z = pk2(s[4 * 33], s[5 * 33]); o.w = pk2(s[6 * 33], s[7 * 33]);
        if (SEAM67) asm volatile("global_store_dwordx4 %0, %1, off sc1\n\ts_nop 2" :: "v"((GAS v4u*)(w.WT + (size_t)(w.dst_row0 + n) * w.K + k0 + 8 * c)), "v"(o) : "memory");
        else *(GAS v4u*)(w.WT + (size_t)(w.dst_row0 + n) * w.K + k0 + 8 * c) = o; }
    LDS_WAIT(); asm volatile("" ::: "memory");
}
__device__ __forceinline__ void weight_copies(Frame& F, int lo, int hi, int gw, int NGW) {
    LAS float* scr = (LAS float*)(F.lds + RING_OFF + F.wave * 16384);
    int it = lo + gw; if (it >= hi) return;
    f32x4 vc[8]; float gc[8];
    WItem cur = weight_item(F, it); witem_load(cur, F.lane, vc, gc);
    for (;;) {
        const int nx = it + NGW; const bool more = nx < hi;
        f32x4 vn[8]; float gnx[8]; WItem nxt = cur;
        if (more) { nxt = weight_item(F, nx); witem_load(nxt, F.lane, vn, gnx); }
        witem_store(cur, F.lane, vc, gc, scr);
        if (!more) break;
#pragma unroll
        for (int i = 0; i < 8; ++i) { vc[i] = vn[i]; gc[i] = gnx[i]; }
        cur = nxt; it = nx;
    }
}
__device__ __forceinline__ void p0_prologue(Frame& F) {
    const int gw = F.vcu * NWAVES + F.wave, NGW = F.G * NWAVES;
    unsigned char* ws = F.ws;
    weight_copies(F, 0, (F.G == 256 && DEFER_WEIGHTS) ? WI_P0 : WI_ALL, gw, NGW);
    __syncthreads();
    LAS float* wba = (LAS float*)(F.lds + RING_OFF);
    for (int idx = F.tid; idx < 8 * D; idx += NWAVES * 64) { const int k = idx >> 3, j = idx & 7; wba[j * D + k] = FIN(2)[(size_t)k * D_IN + 2048 + j] * FIN(1)[k]; }
    __syncthreads();
    const float* x = FIN(0); bf16* XB = (bf16*)(ws + WS_XB); float* rstd1 = (float*)(ws + WS_RSTD); float* gbp = (float*)(ws + WS_GB); float* ssq2 = (float*)(ws + WS_SSQ2);
    const float alog_or_dt = (F.lane & 32) ? FIN(5)[(F.lane >> 3) & 3] : 0.f;
    const float negA = -expf(FIN(4)[(F.lane >> 3) & 3]);
#if P0_DEEP
    auto do_row = [&](const f32x4 (&v)[4], int m) {
        float ss = 0.f;
#pragma unroll
        for (int j = 0; j < 4; ++j) ss += (v[j].x * v[j].x + v[j].y * v[j].y) + (v[j].z * v[j].z + v[j].w * v[j].w);
        GAS unsigned long long* o8 = (GAS unsigned long long*)(XB + (size_t)m * D) + F.lane;
#pragma unroll
        for (int j = 0; j < 4; ++j) { const unsigned long long w = (unsigned long long)pk2(v[j].x, v[j].y) | ((unsigned long long)pk2(v[j].z, v[j].w) << 32);
            asm volatile("global_store_dwordx2 %0, %1, off" :: "v"(o8 + 64 * j), "v"(w) : "memory"); }
        float acc[8];
#pragma unroll
        for (int c = 0; c < 8; ++c) { float a = 0.f;
#pragma unroll
            for (int j = 0; j < 4; ++j) { const f32x4 w = *(const LAS f32x4*)(wba + c * D + 256 * j + 4 * F.lane); a += (v[j].x * w.x + v[j].y * w.y) + (v[j].z * w.z + v[j].w * w.w); }
            acc[c] = a; }
        ss = wave_sum(ss);
        float r4[4], r2[2], r1;
        { const bool up = (F.lane & 32) != 0;
#pragma unroll
          for (int i = 0; i < 4; ++i) { const float keep = up ? acc[4 + i] : acc[i], send = up ? acc[i] : acc[4 + i]; r4[i] = keep + __shfl_xor(send, 32); } }
        { const bool up = (F.lane & 16) != 0;
#pragma unroll
          for (int i = 0; i < 2; ++i) { const float keep = up ? r4[2 + i] : r4[i], send = up ? r4[i] : r4[2 + i]; r2[i] = keep + __shfl_xor(send, 16); } }
        { const bool up = (F.lane & 8) != 0; const float keep = up ? r2[1] : r2[0], send = up ? r2[0] : r2[1]; r1 = keep + __shfl_xor(send, 8); }
        r1 = sum8(r1);
        const float rstd = frsq(ss * (1.0f / D) + EPS);
        if (F.lane == 0) { asm volatile("global_store_dword %0, %1, off" :: "v"((GAS float*)(rstd1 + m)), "v"(rstd) : "memory"); asm volatile("global_store_dword %0, %1, off" :: "v"((GAS float*)(ssq2 + m)), "v"(0.f) : "memory"); }
        if ((F.lane & 7) == 0) {
            const float val = r1 * rstd; float res;
            if (F.lane < 32) res = 1.0f / (1.0f + expf(-val));
            else { const float xx = val + alog_or_dt; const float sp = xx > 20.f ? xx : log1pf(expf(xx)); res = negA * sp; }
            asm volatile("global_store_dword %0, %1, off" :: "v"((GAS float*)(gbp + (size_t)m * 8 + (F.lane >> 3))), "v"(res) : "memory");
        }
    };
    f32x4 qa[4], qb[4];
#pragma unroll
    for (int j = 0; j < 4; ++j) { qa[j] = (f32x4){0.f, 0.f, 0.f, 0.f}; qb[j] = qa[j]; }
    if (gw < M) {
#pragma unroll
        for (int j = 0; j < 4; ++j) qa[j] = ((const GAS f32x4*)(x + (size_t)gw * D) + F.lane)[64 * j]; }
    if (gw + NGW < M) {
#pragma unroll
        for (int j = 0; j < 4; ++j) qb[j] = ((const GAS f32x4*)(x + (size_t)(gw + NGW) * D) + F.lane)[64 * j]; }
    for (int m = gw; m < M; m += 2 * NGW) {
        f32x4 v[4];
#pragma unroll
        for (int j = 0; j < 4; ++j) v[j] = qa[j];
        if (m + 2 * NGW < M) {
#pragma unroll
            for (int j = 0; j < 4; ++j) qa[j] = ((const GAS f32x4*)(x + (size_t)(m + 2 * NGW) * D) + F.lane)[64 * j]; }
        do_row(v, m);
        if (m + NGW < M) {
#pragma unroll
            for (int j = 0; j < 4; ++j) v[j] = qb[j];
            if (m + 3 * NGW < M) {
#pragma unroll
                for (int j = 0; j < 4; ++j) qb[j] = ((const GAS f32x4*)(x + (size_t)(m + 3 * NGW) * D) + F.lane)[64 * j]; }
            do_row(v, m + NGW);
        }
    }
}
#else
    f32x4 vnx[4];
    if (gw < M) {
#pragma unroll
        for (int j = 0; j < 4; ++j) vnx[j] = ((const GAS f32x4*)(x + (size_t)gw * D) + F.lane)[64 * j]; }
    for (int m = gw; m < M; m += NGW) {
        f32x4 v[4]; float ss = 0.f;
#pragma unroll
        for (int j = 0; j < 4; ++j) { v[j] = vnx[j]; ss += (v[j].x * v[j].x + v[j].y * v[j].y) + (v[j].z * v[j].z + v[j].w * v[j].w); }
        if (m + NGW < M) {
#pragma unroll
            for (int j = 0; j < 4; ++j) vnx[j] = ((const GAS f32x4*)(x + (size_t)(m + NGW) * D) + F.lane)[64 * j]; }
        GAS unsigned long long* o8 = (GAS unsigned long long*)(XB + (size_t)m * D) + F.lane;
#pragma unroll
        for (int j = 0; j < 4; ++j) o8[64 * j] = (unsigned long long)pk2(v[j].x, v[j].y) | ((unsigned long long)pk2(v[j].z, v[j].w) << 32);
        float acc[8];
#pragma unroll
        for (int c = 0; c < 8; ++c) { float a = 0.f;
#pragma unroll
            for (int j = 0; j < 4; ++j) { const f32x4 w = *(const LAS f32x4*)(wba + c * D + 256 * j + 4 * F.lane); a += (v[j].x * w.x + v[j].y * w.y) + (v[j].z * w.z + v[j].w * w.w); }
            acc[c] = a; }
        ss = wave_sum(ss);
        float r4[4], r2[2], r1;
        { const bool up = (F.lane & 32) != 0;
#pragma unroll
          for (int i = 0; i < 4; ++i) { const float keep = up ? acc[4 + i] : acc[i], send = up ? acc[i] : acc[4 + i]; r4[i] = keep + __shfl_xor(send, 32); } }
        { const bool up = (F.lane & 16) != 0;
#pragma unroll
          for (int i = 0; i < 2; ++i) { const float keep = up ? r4[2 + i] : r4[i], send = up ? r4[i] : r4[2 + i]; r2[i] = keep + __shfl_xor(send, 16); } }
        { const bool up = (F.lane & 8) != 0; const float keep = up ? r2[1] : r2[0], send = up ? r2[0] : r2[1]; r1 = keep + __shfl_xor(send, 8); }
        r1 = sum8(r1);
        const float rstd = frsq(ss * (1.0f / D) + EPS);
        if (F.lane == 0) { rstd1[m] = rstd; ssq2[m] = 0.f; }
        if ((F.lane & 7) == 0) {
            const float val = r1 * rstd; float res;
            if (F.lane < 32) res = 1.0f / (1.0f + expf(-val));
            else { const float xx = val + alog_or_dt; const float sp = xx > 20.f ? xx : log1pf(expf(xx)); res = negA * sp; }
            gbp[(size_t)m * 8 + (F.lane >> 3)] = res;
        }
    }
}
#endif

__device__ __forceinline__ void dn_pre(Frame& F) {
    const int gw = F.vcu * NWAVES + F.wave, NGW = F.G * NWAVES;
    const bf16* proj = (const bf16*)(F.ws + WS_PROJ); const float* conv = FIN(3);
    float* QN = F.out; float* KN = F.out + (size_t)M * DN_W; float* VV = (float*)(F.ws + WS_XB);
    for (int task = gw; task < M * DN_H; task += NGW) {
        const int m = task >> 2, h = task & 3, t = m & (SEQ - 1);
        float val[3][2];
#pragma unroll
        for (int part = 0; part < 3; ++part) { const int col = part * DN_W + h * DN_D + 2 * F.lane; float a0 = 0.f, a1 = 0.f;
#pragma unroll
            for (int j = 0; j < 4; ++j) { if (t - 3 + j >= 0) { const unsigned w = *(const unsigned*)(proj + (size_t)(m - 3 + j) * NP + col); a0 += conv[j * DN_QKV + col] * bflo(w); a1 += conv[j * DN_QKV + col + 1] * bfhi(w); } }
            val[part][0] = a0 * sigm(a0); val[part][1] = a1 * sigm(a1); }
        const float rq = 1.0f / sqrtf(wave_sum(val[0][0] * val[0][0] + val[0][1] * val[0][1]) + EPS) * 0.08838834764831845f;
        const float rk = 1.0f / sqrtf(wave_sum(val[1][0] * val[1][0] + val[1][1] * val[1][1]) + EPS);
        const size_t o = (size_t)m * DN_W + h * DN_D + 2 * F.lane;
        *(f32x2*)(QN + o) = (f32x2){val[0][0] * rq, val[0][1] * rq};
        *(f32x2*)(KN + o) = (f32x2){val[1][0] * rk, val[1][1] * rk};
        *(f32x2*)(VV + o) = (f32x2){val[2][0], val[2][1]};
    }
}
__device__ __forceinline__ void dn_scan_naive(Frame& F, int bh) {
    const int b = bh >> 2, h = bh & 3, tid = F.tid, dvi = tid >> 2, kq = tid & 3;
    LAS float* kL = (LAS float*)(F.lds + RING_OFF); LAS float* qL = kL + 32 * 128; LAS float* vL = qL + 32 * 128; LAS float* gL = vL + 32 * 128; LAS float* bL = gL + 32;
    const float* QN = F.out; const float* KN = F.out + (size_t)M * DN_W; float* VV = (float*)(F.ws + WS_XB); const float* gbp = (const float*)(F.ws + WS_GB);
    float S[32];
#pragma unroll
    for (int j = 0; j < 32; ++j) S[j] = 0.f;
    for (int t0 = 0; t0 < SEQ; t0 += 32) {
#pragma unroll
        for (int r = 0; r < 2; ++r) { const int idx = tid + 512 * r, tok = idx >> 5, c4 = idx & 31; const size_t src = (size_t)(b * SEQ + t0 + tok) * DN_W + h * DN_D + c4 * 4;
            *(LAS f32x4*)(kL + tok * 128 + c4 * 4) = *(const f32x4*)(KN + src); *(LAS f32x4*)(qL + tok * 128 + c4 * 4) = *(const f32x4*)(QN + src); *(LAS f32x4*)(vL + tok * 128 + c4 * 4) = *(const f32x4*)(VV + src); }
        if (tid < 32) { const size_t mm = (size_t)(b * SEQ + t0 + tid); bL[tid] = gbp[mm * 8 + h]; gL[tid] = gbp[mm * 8 + 4 + h]; }
        __syncthreads();
        for (int i = 0; i < 32; ++i) {
            const float eg = __expf(gL[i]), be = bL[i];
            float kk[32];
#pragma unroll
            for (int j = 0; j < 8; ++j) { const f32x4 w = *(const LAS f32x4*)(kL + i * 128 + kq * 32 + 4 * j); kk[4 * j] = w.x; kk[4 * j + 1] = w.y; kk[4 * j + 2] = w.z; kk[4 * j + 3] = w.w; }
            float part = 0.f;
#pragma unroll
            for (int j = 0; j < 32; ++j) part += kk[j] * S[j];
            part += __shfl_xor(part, 1); part += __shfl_xor(part, 2);
            const float c = be * (vL[i * 128 + dvi] - eg * part);
#pragma unroll
            for (int j = 0; j < 32; ++j) S[j] = eg * S[j] + c * kk[j];
            float po = 0.f;
#pragma unroll
            for (int j = 0; j < 8; ++j) { const f32x4 w = *(const LAS f32x4*)(qL + i * 128 + kq * 32 + 4 * j); po += (w.x * S[4 * j] + w.y * S[4 * j + 1]) + (w.z * S[4 * j + 2] + w.w * S[4 * j + 3]); }
            po += __shfl_xor(po, 1); po += __shfl_xor(po, 2);
            if (kq == 0) vL[i * 128 + dvi] = po;
        }
        __syncthreads();
#pragma unroll
        for (int r = 0; r < 2; ++r) { const int idx = tid + 512 * r, tok = idx >> 5, c4 = idx & 31; const size_t src = (size_t)(b * SEQ + t0 + tok) * DN_W + h * DN_D + c4 * 4;
            *(f32x4*)(VV + src) = *(const LAS f32x4*)(vL + tok * 128 + c4 * 4); }
        __syncthreads();
    }
}
__device__ __forceinline__ void swa_naive(Frame& F, int wv, int nworkers) {
    const bf16* proj = (const bf16*)(F.ws + WS_PROJ); bf16* YSWA = (bf16*)(F.ws + WS_Y) + (size_t)M * SW_W;
    LAS float* qs = (LAS float*)(F.lds + RING_OFF + 65536 + F.wave * 1024); LAS float* ps = qs + 64;
    const float* qg = FIN(7); const float* kg = FIN(8); const float* sinks = FIN(9); const float* relb = FIN(10);
    const int lane = F.lane;
    for (int task = wv; task < M * SW_H; task += nworkers) {
        const int m = task >> 3, qh = task & 7, kvh = qh >> 2, t = m & (SEQ - 1);
        const float q = bf1(proj[(size_t)m * NP + PC_SQ + qh * SW_D + lane]);
        const float qn = q * (1.0f / sqrtf(wave_sum(q * q) * (1.0f / SW_D) + EPS)) * qg[lane];
        qs[lane] = qn * kg[lane];
        LDS_WAIT(); asm volatile("" ::: "memory");
        float lg[2];
#pragma unroll
        for (int hf = 0; hf < 2; ++hf) { const int j = lane + 64 * hf; lg[hf] = -INFINITY;
            if (t - 127 + j >= 0) { const v4u* kr = (const v4u*)(proj + (size_t)(m - 127 + j) * NP + PC_SK + kvh * SW_D); float ssk = 0.f, dot = 0.f;
#pragma unroll
                for (int c = 0; c < 8; ++c) { const v4u w = kr[c];
#pragma unroll
                    for (int e = 0; e < 4; ++e) { const float k0 = bflo(w[e]), k1 = bfhi(w[e]); ssk += k0 * k0 + k1 * k1; dot += qs[8 * c + 2 * e] * k0 + qs[8 * c + 2 * e + 1] * k1; } }
                lg[hf] = dot * (1.0f / sqrtf(ssk * (1.0f / SW_D) + EPS)) * 0.125f + relb[(int)T5_BUCKET[127 - j] * SW_H + qh]; } }
        const float sink = sinks[qh];
        const float mx = fmaxf(wave_max(fmaxf(lg[0], lg[1])), sink);
        const float p0 = (lg[0] == -INFINITY) ? 0.f : __expf(lg[0] - mx), p1 = (lg[1] == -INFINITY) ? 0.f : __expf(lg[1] - mx);
        const float den = wave_sum(p0 + p1) + __expf(sink - mx);
        ps[lane] = p0; ps[lane + 64] = p1;
        LDS_WAIT(); asm volatile("" ::: "memory");
        float o = 0.f; const int jmin = (127 - t) > 0 ? (127 - t) : 0;
        for (int j = jmin; j < 128; ++j) o += ps[j] * bf1(proj[(size_t)(m - 127 + j) * NP + PC_SV + kvh * SW_D + lane]);
        YSWA[(size_t)m * SW_W + qh * SW_D + lane] = (bf16)f2bf(o / den);
        LDS_WAIT(); asm volatile("" ::: "memory");
    }
}
__device__ __forceinline__ void dn_out(Frame& F) {
    const int gw = F.vcu * NWAVES + F.wave, NGW = F.G * NWAVES;
    const bf16* proj = (const bf16*)(F.ws + WS_PROJ); const float* VV = (const float*)(F.ws + WS_XB); bf16* YDN = (bf16*)(F.ws + WS_Y); const float* gain = FIN(6);
    for (int task = gw; task < M * DN_H; task += NGW) {
        const int m = task >> 2, h = task & 3;
        const f32x2 o = *(const f32x2*)(VV + (size_t)m * DN_W + h * DN_D + 2 * F.lane);
        const float r = 1.0f / sqrtf(wave_sum(o.x * o.x + o.y * o.y) * (1.0f / DN_D) + EPS);
        const unsigned zw = *(const unsigned*)(proj + (size_t)m * NP + PC_Z + h * DN_D + 2 * F.lane); const float z0 = bflo(zw), z1 = bfhi(zw);
        *(unsigned*)(YDN + (size_t)m * DN_W + h * DN_D + 2 * F.lane) = pk2(o.x * r * gain[2 * F.lane] * z0 * sigm(z0), o.y * r * gain[2 * F.lane + 1] * z1 * sigm(z1));
    }
}

typedef short bf16x8 __attribute__((ext_vector_type(8)));
typedef float f32x16 __attribute__((ext_vector_type(16)));
typedef unsigned u32x2 __attribute__((ext_vector_type(2)));
typedef __bf16 bf16x2_t __attribute__((ext_vector_type(2)));
__device__ __forceinline__ unsigned cvtpk(float lo, float hi) { f32x2 v = {lo, hi}; return __builtin_bit_cast(unsigned, __builtin_convertvector(v, bf16x2_t)); }
__device__ __forceinline__ bf16x8 pack8(f32x4 a, f32x4 b) { v4u w; w.x = cvtpk(a[0], a[1]); w.y = cvtpk(a[2], a[3]); w.z = cvtpk(b[0], b[1]); w.w = cvtpk(b[2], b[3]); return __builtin_bit_cast(bf16x8, w); }
__device__ __forceinline__ bf16x8 pack8z(f32x4 a) { v4u w; w.x = cvtpk(a[0], a[1]); w.y = cvtpk(a[2], a[3]); w.z = 0u; w.w = 0u; return __builtin_bit_cast(bf16x8, w); }
#define MFMA16(a, b, c) __builtin_amdgcn_mfma_f32_16x16x32_bf16((a), (b), (c), 0, 0, 0)
#define MFMA32(a, b, c) __builtin_amdgcn_mfma_f32_32x32x16_bf16((a), (b), (c), 0, 0, 0)
constexpr float LOG2E = 1.4426950408889634f;

__device__ __forceinline__ void swa_pre(Frame& F) {
    const int gw = F.vcu * NWAVES + F.wave, NGW = F.G * NWAVES, lane = F.lane;
    const bf16* proj = (const bf16*)(F.ws + WS_PROJ);
    bf16* KS = (bf16*)(F.ws + WS_Y); bf16* VT = KS + 2 * 1024 * 1024; bf16* QS = (bf16*)(F.ws + WS_Y) + (size_t)M * SW_W;
    const float* qg = FIN(7); const float* kg = FIN(8);
    v4u wq_n = {0u, 0u, 0u, 0u}; unsigned wk_n = 0u;
    if (!FUSE_QKNORM && gw < M) { wq_n = *(const v4u*)(proj + (size_t)gw * NP + PC_SQ + 8 * lane); wk_n = *(const unsigned*)(proj + (size_t)gw * NP + PC_SK + 2 * lane); }
    const f32x4 g0 = *(const f32x4*)(qg + 8 * (lane & 7)), g1 = *(const f32x4*)(qg + 8 * (lane & 7) + 4);
    const float kg0 = kg[2 * (lane & 31)], kg1 = kg[2 * (lane & 31) + 1];
    if (!FUSE_QKNORM)
    for (int m = gw; m < M; m += NGW) {
        const v4u w = wq_n; const unsigned wk = wk_n;
        if (m + NGW < M) { wq_n = *(const v4u*)(proj + (size_t)(m + NGW) * NP + PC_SQ + 8 * lane); wk_n = *(const unsigned*)(proj + (size_t)(m + NGW) * NP + PC_SK + 2 * lane); }
        {
            float x[8];
#pragma unroll
            for (int j = 0; j < 4; ++j) { x[2 * j] = bflo(w[j]); x[2 * j + 1] = bfhi(w[j]); }
            float ss = 0.f;
#pragma unroll
            for (int j = 0; j < 8; ++j) ss += x[j] * x[j];
            ss = sum8(ss);
            const float r = frsq(ss * (1.0f / SW_D) + EPS) * (0.125f * LOG2E);
            v4u o; o.x = cvtpk(x[0] * r * g0[0], x[1] * r * g0[1]); o.y = cvtpk(x[2] * r * g0[2], x[3] * r * g0[3]); o.z = cvtpk(x[4] * r * g1[0], x[5] * r * g1[1]); o.w = cvtpk(x[6] * r * g1[2], x[7] * r * g1[3]);
            *(v4u*)(QS + (size_t)m * SW_W + 8 * lane) = o;
        }
        {
            const float k0 = bflo(wk), k1 = bfhi(wk);
            float ss = k0 * k0 + k1 * k1;
            ss = sum32(ss, lane);
            const float r = frsq(ss * (1.0f / SW_D) + EPS); const int d = 2 * (lane & 31), b = m >> 12, t = m & (SEQ - 1), kvh = lane >> 5;
            *(unsigned*)(KS + ((size_t)(b * 2 + kvh) * SEQ + t) * SW_D + d) = cvtpk(k0 * r * kg0, k1 * r * kg1);
        }
    }
    for (int task = gw; task < BATCH * SW_KV * (SEQ / 32); task += NGW) {
        const int bk = task >> 7, tile = task & 127, b = bk >> 1, kvh = bk & 1; const size_t m0 = (size_t)b * SEQ + tile * 32;
        unsigned v[32];
#pragma unroll
        for (int i = 0; i < 32; ++i) v[i] = proj[(m0 + i) * NP + PC_SV + kvh * SW_D + lane];
        bf16* dst = VT + ((size_t)(bk * 128 + tile) * 64 + lane) * 32;
#pragma unroll
        for (int q4 = 0; q4 < 4; ++q4) { v4u o;
#pragma unroll
            for (int jj = 0; jj < 4; ++jj) { const int p0 = 8 * q4 + 2 * jj, p1 = p0 + 1;
                const int k0 = 16 * (p0 >> 4) + 8 * ((p0 & 7) >> 2) + 4 * ((p0 >> 3) & 1) + (p0 & 3), k1 = 16 * (p1 >> 4) + 8 * ((p1 & 7) >> 2) + 4 * ((p1 >> 3) & 1) + (p1 & 3);
                o[jj] = v[k0] | (v[k1] << 16); }
            *(v4u*)(dst + 8 * q4) = o; }
    }
}
__device__ __forceinline__ void swa_bias_table(Frame& F) {
    LAS float* biasT = (LAS float*)(F.lds + RING_OFF);
    for (int idx = F.tid; idx < SW_H * 128; idx += NWAVES * 64) { const int h = idx >> 7, dist = idx & 127; biasT[idx] = FIN(10)[(int)T5_BUCKET[dist] * SW_H + h] * LOG2E; }
}
__device__ __forceinline__ void swa_main(Frame& F, int worker, int nworkers) {
    const LAS float* biasT = (const LAS float*)(F.lds + RING_OFF);
    const bf16* KS = (const bf16*)(F.ws + WS_Y); const bf16* VT = KS + 2 * 1024 * 1024; const bf16* QS = (const bf16*)(F.ws + WS_Y) + (size_t)M * SW_W;
    bf16* YSW = (bf16*)(F.ws + WS_PROJ) + PC_YSW;
    const int lane = F.lane, l31 = lane & 31, hh = lane >> 5;
    for (int u = worker; u < BATCH * SW_H * (SEQ / 32); u += nworkers) {
        const int qblk = u & 127, h = (u >> 7) & 7, b = u >> 10, kvh = h >> 2, bk = b * 2 + kvh, q0 = qblk * 32; const size_t m0 = (size_t)b * SEQ + q0;
        bf16x8 qf[4], kf[5][4];
#pragma unroll
        for (int ks = 0; ks < 4; ++ks) qf[ks] = *(const bf16x8*)(QS + (m0 + l31) * SW_W + h * SW_D + 16 * ks + 8 * hh);
#pragma unroll
        for (int i = 0; i < 5; ++i) { const int ts = q0 - 128 + 32 * i, tsc = ts < 0 ? 0 : ts;
#pragma unroll
            for (int ks = 0; ks < 4; ++ks) kf[i][ks] = *(const bf16x8*)(KS + ((size_t)bk * SEQ + tsc + l31) * SW_D + 16 * ks + 8 * hh); }
        __builtin_amdgcn_sched_barrier(0);
        f32x16 s[5];
#pragma unroll
        for (int i = 0; i < 5; ++i) {
            const int ts = q0 - 128 + 32 * i;
            f32x16 acc;
#pragma unroll
            for (int r = 0; r < 16; ++r) acc[r] = 0.f;
#pragma unroll
            for (int ks = 0; ks < 4; ++ks) acc = MFMA32(kf[i][ks], qf[ks], acc);
#pragma unroll
            for (int r = 0; r < 16; ++r) { const int row = (r & 3) + 8 * (r >> 2) + 4 * hh, dist = 128 - 32 * i + l31 - row; const bool ok = ts >= 0 && dist >= 0 && dist <= 127;
                s[i][r] = ok ? acc[r] + biasT[h * 128 + (dist & 127)] : -INFINITY; }
        }
        bf16x8 vf[5][2][2];
#pragma unroll
        for (int i = 0; i < 5; ++i) { const int ts = q0 - 128 + 32 * i, tsc = ts < 0 ? 0 : ts;
#pragma unroll
            for (int s2 = 0; s2 < 2; ++s2)
#pragma unroll
                for (int nt = 0; nt < 2; ++nt) vf[i][s2][nt] = *(const bf16x8*)(VT + ((size_t)(bk * 128 + (tsc >> 5)) * 64 + 32 * nt + l31) * 32 + s2 * 16 + hh * 8); }
        __builtin_amdgcn_sched_barrier(0);
        const float sink2 = FIN(9)[h] * LOG2E;
        float mx = sink2;
#pragma unroll
        for (int i = 0; i < 5; ++i)
#pragma unroll
            for (int r = 0; r < 16; ++r) mx = fmaxf(mx, s[i][r]);
        mx = fmaxf(mx, __shfl_xor(mx, 32));
        float sum = 0.f;
#pragma unroll
        for (int i = 0; i < 5; ++i)
#pragma unroll
            for (int r = 0; r < 16; ++r) { const float p = __builtin_amdgcn_exp2f(s[i][r] - mx); s[i][r] = p; sum += p; }
        sum += __shfl_xor(sum, 32);
        const float inv = __builtin_amdgcn_rcpf(sum + __builtin_amdgcn_exp2f(sink2 - mx));
        f32x16 O[2];
#pragma unroll
        for (int r = 0; r < 16; ++r) { O[0][r] = 0.f; O[1][r] = 0.f; }
#pragma unroll
        for (int i = 0; i < 5; ++i) {
#pragma unroll
            for (int s2 = 0; s2 < 2; ++s2) {
                v4u w; w.x = cvtpk(s[i][8 * s2] * inv, s[i][8 * s2 + 1] * inv); w.y = cvtpk(s[i][8 * s2 + 2] * inv, s[i][8 * s2 + 3] * inv); w.z = cvtpk(s[i][8 * s2 + 4] * inv, s[i][8 * s2 + 5] * inv); w.w = cvtpk(s[i][8 * s2 + 6] * inv, s[i][8 * s2 + 7] * inv);
                const bf16x8 pa = __builtin_bit_cast(bf16x8, w);
#pragma unroll
                for (int nt = 0; nt < 2; ++nt) O[nt] = MFMA32(pa, vf[i][s2][nt], O[nt]);
            }
        }
        {
            LAS unsigned char* stg = F.lds + RING_OFF + 8192 + F.wave * 4608;
#pragma unroll
            for (int nt = 0; nt < 2; ++nt)
#pragma unroll
                for (int r = 0; r < 16; ++r) { const int q = (r & 3) + 8 * (r >> 2) + 4 * hh; *(LAS unsigned short*)(stg + q * 144 + (32 * nt + l31) * 2) = (unsigned short)(cvtpk(O[nt][r], 0.f) & 0xffffu); }
            asm volatile("s_waitcnt lgkmcnt(0)" ::: "memory");
#pragma unroll
            for (int i = 0; i < 4; ++i) { const int row = 8 * i + (lane >> 3), ch16 = lane & 7; const v4u v = *(const LAS v4u*)(stg + row * 144 + ch16 * 16);
                if (SEAM35) { GAS v4u* dst = (GAS v4u*)(YSW + (m0 + row) * NP + h * SW_D + ch16 * 8); asm volatile("global_store_dwordx4 %0, %1, off sc1\n\ts_nop 2" :: "v"(dst), "v"(v) : "memory"); }
                else *(v4u*)(YSW + (m0 + row) * NP + h * SW_D + ch16 * 8) = v; }
            asm volatile("s_waitcnt lgkmcnt(0)" ::: "memory");
        }
    }
#if SEAM35
    asm volatile("s_waitcnt vmcnt(0)" ::: "memory");
    unsigned nun = 0u;
    for (int u = worker; u < BATCH * SW_H * (SEQ / 32); u += nworkers) { const int qblk = u & 127, b = u >> 10; ++nun;
        if (lane == 0) __hip_atomic_fetch_add(F.ctl + CW_PAN + 64 * (b * 16 + (qblk >> 3)) + 1, 1u, RLX_AGENT); }
    if (lane == 0 && nun) __hip_atomic_fetch_add(F.ctl + CW_SWADONE + 64 * (worker & 7), nun, RLX_AGENT);
#endif
}

constexpr int DNL_QT = 0, DNL_KT = 17408, DNL_VT = 34816, DNL_WL = 52224, DNL_NA = 69632, DNL_QKM = 78848, DNL_DB = 88064, DNL_TIB = 92160, DNL_GC = 94208, DNL_BETA = 94464;
constexpr int TP = 272;
constexpr int NP2 = 144;
struct DnRec { bf16* UA; bf16* UB; bf16* W; bf16* QG; bf16* KD; bf16* QK; float* EGL;
    __device__ __forceinline__ bf16* u(int ch, int sl, int mt, int lane) const { return (ch < 640 ? UA + (size_t)ch * 8192 : UB + (size_t)(ch - 640) * 8192) + ((sl * 4 + mt) * 64 + lane) * 4; } };
__device__ __forceinline__ DnRec dn_rec(Frame& F) {
    DnRec r; r.W = (bf16*)F.out; r.QG = r.W + 8 * 1024 * 1024; r.KD = r.W + 16 * 1024 * 1024; r.QK = r.W + 24 * 1024 * 1024; r.UA = r.W + 27 * 1024 * 1024; r.UB = (bf16*)(F.ws + WS_UB); r.EGL = (float*)(F.ws + WS_SSQ); return r;
}
#if STAMP_DN >= 0
__device__ unsigned long long g_dn[8];
#define DNSTAMP(i) if (blockIdx.x == STAMP_BLOCK && threadIdx.x == 0) { const unsigned long long now_ = __builtin_amdgcn_s_memrealtime(); dnacc_[i] += now_ - dnlast_; dnlast_ = now_; }
#else
#define DNSTAMP(i)
#endif
__device__ __forceinline__ void dn_chunk_prep(Frame& F) {
#if STAMP_DN >= 0
    unsigned long long dnacc_[8] = {0, 0, 0, 0, 0, 0, 0, 0}; unsigned long long dnlast_ = __builtin_amdgcn_s_memrealtime();
#endif
    const DnRec R = dn_rec(F);
    const bf16* proj = (const bf16*)(F.ws + WS_PROJ); const float* conv = FIN(3); const float* gbp = (const float*)(F.ws + WS_GB);
    LAS unsigned char* L = F.lds + RING_OFF;
    LAS float* GC = (LAS float*)(L + DNL_GC); LAS float* BETA = (LAS float*)(L + DNL_BETA); LAS float* DB = (LAS float*)(L + DNL_DB);
    const int lane = F.lane, wave = F.wave, r16 = lane & 15, g = lane >> 4;
    const int tk0 = 8 * wave;
    unsigned raw[3][11]; float gx, gbl;
#define DN_LOAD_INPUTS(ch_) do { const int bh_ = (ch_) >> 6, c_ = (ch_) & 63, b_ = bh_ >> 2, h_ = bh_ & 3; const size_t m0_ = (size_t)b_ * SEQ + 64 * c_; \
        gx = gbp[(m0_ + lane) * 8 + 4 + h_]; gbl = gbp[(m0_ + lane) * 8 + h_]; \
        _Pragma("unroll") for (int p = 0; p < 3; ++p) { const int col_ = p * DN_W + h_ * DN_D + 2 * lane; \
            _Pragma("unroll") for (int r = 0; r < 11; ++r) { const int tr_ = 64 * c_ + tk0 - 3 + r; raw[p][r] = *(const unsigned*)(proj + (m0_ - 64 * c_ + (tr_ < 0 ? 0 : tr_)) * NP + col_); } } } while (0)
#if DNA_PREFETCH
    if (F.vcu < 1024) DN_LOAD_INPUTS(F.vcu);
#endif
    for (int ch = F.vcu; ch < 1024; ch += F.G) {
        const int bh = ch >> 6, c = ch & 63, b = bh >> 2, h = bh & 3; const size_t m0 = (size_t)b * SEQ + 64 * c;
        {
#if !DNA_PREFETCH
            DN_LOAD_INPUTS(ch);
#endif
            float cw[3][4][2];
#pragma unroll
            for (int p = 0; p < 3; ++p) { const int col = p * DN_W + h * DN_D + 2 * lane;
#pragma unroll
                for (int j = 0; j < 4; ++j) { cw[p][j][0] = conv[j * DN_QKV + col]; cw[p][j][1] = conv[j * DN_QKV + col + 1]; } }
            if (wave == 0) { float x = gx;
#pragma unroll
                for (int off = 1; off < 64; off <<= 1) { const float t = __shfl_up(x, off); if (lane >= off) x += t; }
                GC[lane] = x; BETA[lane] = gbl; }
            if (64 * c + tk0 < 3) {
#pragma unroll
                for (int p = 0; p < 3; ++p)
#pragma unroll
                    for (int r = 0; r < 3; ++r) if (64 * c + tk0 - 3 + r < 0) raw[p][r] = 0u;
            }
#pragma unroll
            for (int hb = 0; hb < 2; ++hb) {
                float val[4][3][2], sq[4], sk[4];
#pragma unroll
                for (int i4 = 0; i4 < 4; ++i4) { const int i = 4 * hb + i4;
#pragma unroll
                    for (int p = 0; p < 3; ++p) { float a0 = 0.f, a1 = 0.f;
#pragma unroll
                        for (int j = 0; j < 4; ++j) { a0 += cw[p][j][0] * bflo(raw[p][i + j]); a1 += cw[p][j][1] * bfhi(raw[p][i + j]); }
                        val[i4][p][0] = a0 * sigm(a0); val[i4][p][1] = a1 * sigm(a1); }
                    sq[i4] = val[i4][0][0] * val[i4][0][0] + val[i4][0][1] * val[i4][0][1]; sk[i4] = val[i4][1][0] * val[i4][1][0] + val[i4][1][1] * val[i4][1][1]; }
#pragma unroll
                for (int i4 = 0; i4 < 4; ++i4) { sq[i4] = wave_sum(sq[i4]); sk[i4] = wave_sum(sk[i4]); }
#pragma unroll
                for (int i4 = 0; i4 < 4; ++i4) {
                    const float rq = frsq(sq[i4] + EPS) * 0.08838834764831845f, rk = frsq(sk[i4] + EPS);
                    const int o = (tk0 + 4 * hb + i4) * TP + 4 * lane;
                    *(LAS unsigned*)(L + DNL_QT + o) = cvtpk(val[i4][0][0] * rq, val[i4][0][1] * rq);
                    *(LAS unsigned*)(L + DNL_KT + o) = cvtpk(val[i4][1][0] * rk, val[i4][1][1] * rk);
                    *(LAS unsigned*)(L + DNL_VT + o) = cvtpk(val[i4][2][0], val[i4][2][1]);
                }
            }
        }
        __syncthreads(); DNSTAMP(0)
#pragma unroll
        for (int k_ = 0; k_ < 3; ++k_) { const int id = wave + 8 * k_; if (id < 20) {
            const int e = id % 10, isqk = (id / 10) & 1, ti = (e >= 6) ? 3 : (e >= 3) ? 2 : (e >= 1) ? 1 : 0, tj = e - ti * (ti + 1) / 2;
            f32x4 acc = {0.f, 0.f, 0.f, 0.f};
            const int xoff = isqk ? DNL_QT : DNL_KT;
#pragma unroll
            for (int ks = 0; ks < 4; ++ks) {
                const bf16x8 a = *(const LAS bf16x8*)(L + DNL_KT + (16 * tj + r16) * TP + (32 * ks + 8 * g) * 2);
                const bf16x8 bq = *(const LAS bf16x8*)(L + xoff + (16 * ti + r16) * TP + (32 * ks + 8 * g) * 2);
                acc = MFMA16(a, bq, acc); }
            const int i = 16 * ti + r16; const float gi = GC[i], bi = BETA[i]; const f32x4 gj = *(const LAS f32x4*)(GC + 16 * tj + 4 * g);
            f32x4 v;
#pragma unroll
            for (int r = 0; r < 4; ++r) { const int jp = 16 * tj + 4 * g + r; const float d = __expf(fminf(gi - gj[r], 0.f));
                v[r] = isqk ? ((i >= jp) ? acc[r] * d : 0.f) : ((i > jp) ? bi * acc[r] * d : 0.f); }
            if (!isqk) {
                u32x2 w; w.x = cvtpk(-v[0], -v[1]); w.y = cvtpk(-v[2], -v[3]);
                *(LAS u32x2*)(L + DNL_NA + i * NP2 + (16 * tj + 4 * g) * 2) = w;
                if (ti == tj) *(LAS f32x4*)(DB + (ti * 16 + r16) * 16 + 4 * g) = v;
            } else { u32x2 w; w.x = cvtpk(v[0], v[1]); w.y = cvtpk(v[2], v[3]); *(LAS u32x2*)(L + DNL_QKM + i * NP2 + (16 * tj + 4 * g) * 2) = w; }
        } }
        __syncthreads(); DNSTAMP(1)
        if (wave < 4) {
            const int I = wave; float x[16];
#pragma unroll
            for (int i = 0; i < 16; ++i) { float a = (i == r16) ? 1.f : 0.f;
#pragma unroll
                for (int j4 = 0; j4 < (i + 3) / 4; ++j4) { const f32x4 d = *(const LAS f32x4*)(DB + (I * 16 + i) * 16 + 4 * j4);
#pragma unroll
                    for (int jj = 0; jj < 4; ++jj) if (4 * j4 + jj < i) a -= d[jj] * x[4 * j4 + jj]; }
                x[i] = a; }
            if (lane < 16) {
#pragma unroll
                for (int i = 0; i < 16; ++i) *(LAS unsigned short*)(L + DNL_TIB + ((I * 16 + i) * 16 + r16) * 2) = (unsigned short)(cvtpk(x[i], 0.f) & 0xffffu);
            }
        } else {
            const int w4 = wave - 4;
            {
                const int mt = w4; const float e = __expf(GC[16 * mt + r16]); const int base = DNL_QT + (16 * mt + r16) * TP;
                u32x2 lo[4], hi[4];
#pragma unroll
                for (int ks = 0; ks < 4; ++ks) { lo[ks] = *(const LAS u32x2*)(L + base + (32 * ks + 4 * g) * 2); hi[ks] = *(const LAS u32x2*)(L + base + (32 * ks + 16 + 4 * g) * 2); }
#pragma unroll
                for (int ks = 0; ks < 4; ++ks) { v4u w; w.x = cvtpk(bflo(lo[ks].x) * e, bfhi(lo[ks].x) * e); w.y = cvtpk(bflo(lo[ks].y) * e, bfhi(lo[ks].y) * e); w.z = cvtpk(bflo(hi[ks].x) * e, bfhi(hi[ks].x) * e); w.w = cvtpk(bflo(hi[ks].y) * e, bfhi(hi[ks].y) * e);
                    *(v4u*)(R.QG + ((size_t)(ch * 16 + mt * 4 + ks) * 64 + lane) * 8) = w; }
            }
            {
                const float gl = GC[63]; float ed[2][8];
#pragma unroll
                for (int kt = 0; kt < 2; ++kt)
#pragma unroll
                    for (int j = 0; j < 8; ++j) { const int tok = 32 * kt + (j < 4 ? 4 * g + j : 16 + 4 * g + j - 4); ed[kt][j] = __expf(gl - GC[tok]); }
#pragma unroll
                for (int i = 0; i < 4; ++i) { const int f = 4 * w4 + i, mt8 = f >> 1, kt = i & 1, dk = 16 * mt8 + r16; float v[8];
#pragma unroll
                    for (int j = 0; j < 8; ++j) { const int tok = 32 * kt + (j < 4 ? 4 * g + j : 16 + 4 * g + j - 4); v[j] = bf1(*(const LAS unsigned short*)(L + DNL_KT + tok * TP + dk * 2)) * ed[kt][j]; }
                    v4u w; w.x = cvtpk(v[0], v[1]); w.y = cvtpk(v[2], v[3]); w.z = cvtpk(v[4], v[5]); w.w = cvtpk(v[6], v[7]);
                    *(v4u*)(R.KD + ((size_t)(ch * 16 + f) * 64 + lane) * 8) = w; }
            }
#pragma unroll
            for (int i = 0; i < 2; ++i) { const int q = w4 + 4 * i;
                if (q < 6) { const int mt = (q == 0) ? 0 : (q == 1) ? 1 : (q < 4) ? 2 : 3, kt = (q == 3 || q == 5) ? 1 : 0;
                    const u32x2 lo = *(const LAS u32x2*)(L + DNL_QKM + (16 * mt + r16) * NP2 + (32 * kt + 4 * g) * 2);
                    u32x2 hi = {0u, 0u}; if (2 * kt + 1 <= mt) hi = *(const LAS u32x2*)(L + DNL_QKM + (16 * mt + r16) * NP2 + (32 * kt + 16 + 4 * g) * 2);
                    const v4u w = {lo.x, lo.y, hi.x, hi.y};
                    *(v4u*)(R.QK + ((size_t)(ch * 6 + q) * 64 + lane) * 8) = w; } }
            if (lane == 0 && w4 == 0) R.EGL[ch] = __expf(GC[63]);
        }
        __syncthreads(); DNSTAMP(2)
#if DNA_PREFETCH
        if (ch + F.G < 1024) DN_LOAD_INPUTS(ch + F.G);
#endif
        {
            const int part = wave >> 2, colbase = 32 * (wave & 3);
            f32x4 rhs[4][2];
#pragma unroll
            for (int I = 0; I < 4; ++I) { float sc[4];
#pragma unroll
                for (int r = 0; r < 4; ++r) { const int tok = 16 * I + 4 * g + r; sc[r] = part == 0 ? BETA[tok] : -(BETA[tok] * __expf(GC[tok])); }
#pragma unroll
                for (int nt = 0; nt < 2; ++nt) { const int col = colbase + 16 * nt + r16;
#pragma unroll
                    for (int r = 0; r < 4; ++r) { const int tok = 16 * I + 4 * g + r; rhs[I][nt][r] = sc[r] * bf1(*(const LAS unsigned short*)(L + (part == 0 ? DNL_VT : DNL_KT) + tok * TP + col * 2)); } } }
            u32x2 na10, na20l, na20h, na30l, na30h, na31l, ti[4];
            na10 = *(const LAS u32x2*)(L + DNL_NA + (16 * 1 + r16) * NP2 + (4 * g) * 2);
            na20l = *(const LAS u32x2*)(L + DNL_NA + (16 * 2 + r16) * NP2 + (4 * g) * 2); na20h = *(const LAS u32x2*)(L + DNL_NA + (16 * 2 + r16) * NP2 + (16 + 4 * g) * 2);
            na30l = *(const LAS u32x2*)(L + DNL_NA + (16 * 3 + r16) * NP2 + (4 * g) * 2); na30h = *(const LAS u32x2*)(L + DNL_NA + (16 * 3 + r16) * NP2 + (16 + 4 * g) * 2);
            na31l = *(const LAS u32x2*)(L + DNL_NA + (16 * 3 + r16) * NP2 + (32 + 4 * g) * 2);
#pragma unroll
            for (int I = 0; I < 4; ++I) ti[I] = *(const LAS u32x2*)(L + DNL_TIB + ((I * 16 + r16) * 16 + 4 * g) * 2);
            const bf16x8 A10 = __builtin_bit_cast(bf16x8, (v4u){na10.x, na10.y, 0u, 0u}), A20 = __builtin_bit_cast(bf16x8, (v4u){na20l.x, na20l.y, na20h.x, na20h.y}),
                         A30 = __builtin_bit_cast(bf16x8, (v4u){na30l.x, na30l.y, na30h.x, na30h.y}), A31 = __builtin_bit_cast(bf16x8, (v4u){na31l.x, na31l.y, 0u, 0u});
            const f32x4 zero = {0.f, 0.f, 0.f, 0.f};
            f32x4 X[2][4];
#pragma unroll
            for (int nt = 0; nt < 2; ++nt) {
                X[nt][0] = MFMA16(__builtin_bit_cast(bf16x8, (v4u){ti[0].x, ti[0].y, 0u, 0u}), pack8z(rhs[0][nt]), zero);
                f32x4 a1 = MFMA16(A10, pack8z(X[nt][0]), rhs[1][nt]);
                X[nt][1] = MFMA16(__builtin_bit_cast(bf16x8, (v4u){ti[1].x, ti[1].y, 0u, 0u}), pack8z(a1), zero);
                f32x4 a2 = MFMA16(A20, pack8(X[nt][0], X[nt][1]), rhs[2][nt]);
                X[nt][2] = MFMA16(__builtin_bit_cast(bf16x8, (v4u){ti[2].x, ti[2].y, 0u, 0u}), pack8z(a2), zero);
                f32x4 a3 = MFMA16(A30, pack8(X[nt][0], X[nt][1]), rhs[3][nt]); a3 = MFMA16(A31, pack8z(X[nt][2]), a3);
                X[nt][3] = MFMA16(__builtin_bit_cast(bf16x8, (v4u){ti[3].x, ti[3].y, 0u, 0u}), pack8z(a3), zero);
            }
#pragma unroll
            for (int nt = 0; nt < 2; ++nt)
#pragma unroll
                for (int I = 0; I < 4; ++I) {
                    if (part == 0) { u32x2 w; w.x = cvtpk(X[nt][I][0], X[nt][I][1]); w.y = cvtpk(X[nt][I][2], X[nt][I][3]); *(u32x2*)R.u(ch, 2 * (wave & 3) + nt, I, lane) = w; }
                    else { const int col = colbase + 16 * nt + r16;
#pragma unroll
                        for (int r = 0; r < 4; ++r) *(LAS unsigned short*)(L + DNL_WL + (16 * I + 4 * g + r) * TP + col * 2) = (unsigned short)(cvtpk(X[nt][I][r], 0.f) & 0xffffu); }
                }
        }
        __syncthreads(); DNSTAMP(3)
        {
            const int mt = wave >> 1, base = DNL_WL + (16 * mt + r16) * TP;
            u32x2 lo[2], hi[2];
#pragma unroll
            for (int i = 0; i < 2; ++i) { const int ks = 2 * (wave & 1) + i; lo[i] = *(const LAS u32x2*)(L + base + (32 * ks + 4 * g) * 2); hi[i] = *(const LAS u32x2*)(L + base + (32 * ks + 16 + 4 * g) * 2); }
#pragma unroll
            for (int i = 0; i < 2; ++i) { const int ks = 2 * (wave & 1) + i; const v4u w = {lo[i].x, lo[i].y, hi[i].x, hi[i].y}; *(v4u*)(R.W + ((size_t)(ch * 16 + mt * 4 + ks) * 64 + lane) * 8) = w; }
        }
        __syncthreads(); DNSTAMP(4)
    }
#if STAMP_DN >= 0
    if (blockIdx.x == STAMP_BLOCK && threadIdx.x == 0) { for (int i = 0; i < 8; ++i) g_dn[i] = dnacc_[i]; }
#endif
}
__device__ __forceinline__ void dn_out2(Frame& F, int worker, int nworkers) {
    const DnRec R = dn_rec(F);
    const int lane = F.lane, r16 = lane & 15, g = lane >> 4;
    bf16* proj = (bf16*)(F.ws + WS_PROJ); const float* gain = FIN(6);
    int pub_pm = -1;
    for (int task = worker; task < (DNO_SKIPALL ? 0 : 4096); task += nworkers) {
        const int c = task >> 6, bh = (task >> 2) & 15, mt = task & 3, ch = bh * 64 + c, b = bh >> 2, h = bh & 3;
        {   gu32* f0 = F.ctl + CW_SCAN + 64 * (bh * 2);
            for (unsigned sp = 0;; ++sp) {
                const unsigned p0 = (unsigned)__builtin_amdgcn_readfirstlane((int)__hip_atomic_load(f0, RLX_AGENT)), p1 = (unsigned)__builtin_amdgcn_readfirstlane((int)__hip_atomic_load(f0 + 64, RLX_AGENT));
                if ((p0 < p1 ? p0 : p1) > (unsigned)(c + DNO_LAG < 63 ? c + DNO_LAG : 63) || sp > (1u << 16)) break;
                __builtin_amdgcn_s_sleep(DNO_SLEEP);
            }
            if (DNO_FENCE) __builtin_amdgcn_fence(__ATOMIC_ACQUIRE, "agent"); else asm volatile("" ::: "memory"); }
        if (DNO_SKIPWORK) continue;
        if (SEAM35 && pub_pm >= 0) { asm volatile("s_waitcnt vmcnt(0)" ::: "memory"); if (lane == 0) __hip_atomic_fetch_add(F.ctl + CW_PAN + 64 * pub_pm, 1u, RLX_AGENT); }
        pub_pm = (bh >> 2) * 16 + (c >> 2);
        f32x4 o[8]; float ss[4] = {0.f, 0.f, 0.f, 0.f};
#pragma unroll
        for (int sl = 0; sl < 8; ++sl) { u32x2 w;
            if (DNO_FENCE) w = *(const u32x2*)R.u(ch, sl, mt, lane);
            else { const unsigned long long q = __hip_atomic_load((GAS unsigned long long*)R.u(ch, sl, mt, lane), RLX_AGENT); w.x = (unsigned)q; w.y = (unsigned)(q >> 32); }
            o[sl] = (f32x4){bflo(w.x), bfhi(w.x), bflo(w.y), bfhi(w.y)};
#pragma unroll
            for (int r = 0; r < 4; ++r) ss[r] += o[sl][r] * o[sl][r]; }
#pragma unroll
        for (int r = 0; r < 4; ++r) { float s = sum16(ss[r]); ss[r] = frsq(s * (1.0f / DN_D) + EPS); }
        float gdv[8];
#pragma unroll
        for (int sl = 0; sl < 8; ++sl) gdv[sl] = gain[16 * sl + r16];
        unsigned short zz[8][4];
#pragma unroll
        for (int sl = 0; sl < 8; ++sl)
#pragma unroll
            for (int r = 0; r < 4; ++r) zz[sl][r] = proj[((size_t)b * SEQ + 64 * c + 16 * mt + 4 * g + r) * NP + PC_Z + h * DN_D + 16 * sl + r16];
#if DNO_STAGE
        {   LAS unsigned char* stg = F.lds + RING_OFF + F.wave * 16384;
#pragma unroll
            for (int sl = 0; sl < 8; ++sl) { const float gd = gdv[sl];
#pragma unroll
                for (int r = 0; r < 4; ++r) { const float z = bf1(zz[sl][r]);
                    *(LAS unsigned short*)(stg + (4 * g + r) * 272 + (16 * sl + r16) * 2) = (unsigned short)(cvtpk(o[sl][r] * ss[r] * gd * z * sigm(z), 0.f) & 0xffffu); } }
            asm volatile("s_waitcnt lgkmcnt(0)" ::: "memory");
            const size_t m0 = (size_t)b * SEQ + 64 * c + 16 * mt;
#pragma unroll
            for (int i = 0; i < 4; ++i) { const int q = lane + 64 * i, row = q >> 4, cc = q & 15; const v4u v = *(const LAS v4u*)(stg + row * 272 + cc * 16);
                GAS v4u* dst = (GAS v4u*)(proj + (m0 + row) * NP + PC_YDN + h * DN_D + cc * 8);
                asm volatile("global_store_dwordx4 %0, %1, off sc1\n\ts_nop 2" :: "v"(dst), "v"(v) : "memory"); }
            asm volatile("s_waitcnt lgkmcnt(0)" ::: "memory");
        }
#else
#pragma unroll
        for (int sl = 0; sl < 8; ++sl) { const int d = 16 * sl + r16; const float gd = gdv[sl];
#pragma unroll
            for (int r = 0; r < 4; ++r) { const size_t m = (size_t)b * SEQ + 64 * c + 16 * mt + 4 * g + r; const float z = bf1(zz[sl][r]);
                proj[m * NP + PC_YDN + h * DN_D + d] = (bf16)(cvtpk(o[sl][r] * ss[r] * gd * z * sigm(z), 0.f) & 0xffffu); } }
#endif
    }
    if (SEAM35 && pub_pm >= 0) { asm volatile("s_waitcnt vmcnt(0)" ::: "memory"); if (lane == 0) __hip_atomic_fetch_add(F.ctl + CW_PAN + 64 * pub_pm, 1u, RLX_AGENT); }
    if (SEAM78 && lane == 0) { unsigned nt_ = 0u; for (int task = worker; task < 4096; task += nworkers) ++nt_;
        if (nt_) __hip_atomic_fetch_add(F.ctl + CW_NORMDONE + 64 * (worker & 7), nt_, RLX_AGENT); }
}
constexpr int SCAN_H0 = 32768, SCAN_H1 = 24576;
__device__ __forceinline__ void dn_scan_wg(Frame& F, int bh, int half) {
    const DnRec R = dn_rec(F);
    const int lane = F.lane, wave = F.wave;
    LAS unsigned char* ring = F.lds + RING_OFF;
    if (wave >= 4) {
        const int lw = wave - 4;
        v4u r0[8], r1[6], r2[8], r3[6];
#if SCAN_SETS == 6
        v4u r4[8], r5[6];
#endif
#define LD_H0(set_, k_) do { const int ch_ = bh * 64 + ((k_) >> 1); _Pragma("unroll") for (int i_ = 0; i_ < 8; ++i_) { const int p_ = lw + 4 * i_; \
            const bf16* src_ = p_ < 16 ? R.W + (size_t)ch_ * 8192 + p_ * 512 : R.QG + (size_t)ch_ * 8192 + (p_ - 16) * 512; set_[i_] = SCAN_NT ? __builtin_nontemporal_load((const v4u*)(src_ + lane * 8)) : *(const v4u*)(src_ + lane * 8); } } while (0)
#define LD_H1(set_, k_) do { const int ch_ = bh * 64 + ((k_) >> 1); _Pragma("unroll") for (int i_ = 0; i_ < 6; ++i_) { const int p_ = lw + 4 * i_, q_ = p_ < 22 ? p_ : p_ - 22; \
            const bf16* src_ = q_ < 6 ? R.QK + (size_t)ch_ * 3072 + q_ * 512 : R.KD + (size_t)ch_ * 8192 + (q_ - 6) * 512; set_[i_] = SCAN_NT ? __builtin_nontemporal_load((const v4u*)(src_ + lane * 8)) : *(const v4u*)(src_ + lane * 8); } } while (0)
#define ST_H0(set_, k_) do { LAS unsigned char* slot_ = ring + (((k_) >> 1) & 1) * (SCAN_H0 + SCAN_H1) + lane * 16; _Pragma("unroll") for (int i_ = 0; i_ < 8; ++i_) *(LAS v4u*)(slot_ + (lw + 4 * i_) * 1024) = set_[i_]; } while (0)
#define ST_H1(set_, k_) do { LAS unsigned char* slot_ = ring + (((k_) >> 1) & 1) * (SCAN_H0 + SCAN_H1) + SCAN_H0 + lane * 16; _Pragma("unroll") for (int i_ = 0; i_ < 6; ++i_) *(LAS v4u*)(slot_ + (lw + 4 * i_) * 1024) = set_[i_]; } while (0)
#define LD_BAR() do { asm volatile("s_waitcnt lgkmcnt(0)" ::: "memory"); __builtin_amdgcn_s_barrier(); asm volatile("" ::: "memory"); } while (0)
#if SCAN_SETS == 6
        LD_H0(r0, 0); LD_H1(r1, 1); LD_H0(r2, 2); LD_H1(r3, 3); LD_H0(r4, 4); LD_H1(r5, 5);
        ST_H0(r0, 0); LD_H0(r0, 6); ST_H1(r1, 1); LD_H1(r1, 7); ST_H0(r2, 2); LD_H0(r2, 8);
        for (int k = 0; k < 128; k += 6) {
            if (k + 0 < 128) { LD_BAR(); if (k + 3 < 128) { ST_H1(r3, k + 3); if (k + 9 < 128) LD_H1(r3, k + 9); } }
            if (k + 1 < 128) { LD_BAR(); if (k + 4 < 128) { ST_H0(r4, k + 4); if (k + 10 < 128) LD_H0(r4, k + 10); } }
            if (k + 2 < 128) { LD_BAR(); if (k + 5 < 128) { ST_H1(r5, k + 5); if (k + 11 < 128) LD_H1(r5, k + 11); } }
            if (k + 3 < 128) { LD_BAR(); if (k + 6 < 128) { ST_H0(r0, k + 6); if (k + 12 < 128) LD_H0(r0, k + 12); } }
            if (k + 4 < 128) { LD_BAR(); if (k + 7 < 128) { ST_H1(r1, k + 7); if (k + 13 < 128) LD_H1(r1, k + 13); } }
            if (k + 5 < 128) { LD_BAR(); if (k + 8 < 128) { ST_H0(r2, k + 8); if (k + 14 < 128) LD_H0(r2, k + 14); } }
        }
#else
        LD_H0(r0, 0); LD_H1(r1, 1); LD_H0(r2, 2); LD_H1(r3, 3);
        ST_H0(r0, 0); LD_H0(r0, 4); ST_H1(r1, 1); LD_H1(r1, 5); ST_H0(r2, 2); LD_H0(r2, 6);
#define PUB(k_) do { if (SCAN_PUBLISH && SCAN_PUB_LOADER && lw == 0 && lane == 0 && (k_) >= 4 && (((k_) >> 1) % SCAN_PUB_EVERY) == 0) asm volatile("global_store_dword %0, %1, off sc1" :: "v"(F.ctl + CW_SCAN + 64 * (bh * 2 + half)), "v"((unsigned)(((k_) >> 1) - 1)) : "memory"); } while (0)
        for (int k = 0; k < 128; k += 4) {
            LD_BAR(); PUB(k); ST_H1(r3, k + 3); if (k + 7 < 128) LD_H1(r3, k + 7);
            LD_BAR(); if (k + 4 < 128) { ST_H0(r0, k + 4); if (k + 8 < 128) LD_H0(r0, k + 8); }
            LD_BAR(); PUB(k + 2); if (k + 5 < 128) { ST_H1(r1, k + 5); if (k + 9 < 128) LD_H1(r1, k + 9); }
            LD_BAR(); if (k + 6 < 128) { ST_H0(r2, k + 6); if (k + 10 < 128) LD_H0(r2, k + 10); }
        }
#endif
#undef LD_H0
#undef LD_H1
#undef ST_H0
#undef ST_H1
#undef LD_BAR
#undef PUB
    } else {
        const int sl = half * 4 + wave;
        f32x4 S[8];
#pragma unroll
        for (int i = 0; i < 8; ++i) S[i] = (f32x4){0.f, 0.f, 0.f, 0.f};
        constexpr int UPRE = SCAN_UPRE;
        u32x2 Uq[UPRE][4]; float eq[UPRE];
#pragma unroll
        for (int d = 0; d < UPRE; ++d) { eq[d] = R.EGL[bh * 64 + d];
#pragma unroll
            for (int mt = 0; mt < 4; ++mt) Uq[d][mt] = *(const u32x2*)R.u(bh * 64 + d, sl, mt, lane); }
        for (int c4 = 0; c4 < 64; c4 += UPRE) {
#pragma unroll
        for (int j4 = 0; j4 < UPRE; ++j4) {
            const int c = c4 + j4, ch = bh * 64 + c;
            const LAS unsigned char* h0 = ring + (c & 1) * (SCAN_H0 + SCAN_H1) + lane * 16; const LAS unsigned char* h1 = h0 + SCAN_H0;
            asm volatile("s_waitcnt lgkmcnt(0)" ::: "memory");
            __builtin_amdgcn_s_barrier();
            asm volatile("" ::: "memory");
#if SCAN_PUBLISH && !SCAN_PUB_LOADER
            if (wave == 0 && c >= 2 && lane == 0) __hip_atomic_store(F.ctl + CW_SCAN + 64 * (bh * 2 + half), (unsigned)(c - 1), RLX_AGENT);
#endif
            bf16x8 fa[16];
#pragma unroll
            for (int f = 0; f < 16; ++f) fa[f] = *(const LAS bf16x8*)(h0 + f * 1024);
#if SCAN_QG_EARLY
            bf16x8 fb[8];
#pragma unroll
            for (int f = 0; f < 8; ++f) fb[f] = *(const LAS bf16x8*)(h0 + 16384 + f * 1024);
#endif
            bf16x8 Sb[4];
#pragma unroll
            for (int ks = 0; ks < 4; ++ks) Sb[ks] = pack8(S[2 * ks], S[2 * ks + 1]);
            const float egl = eq[j4];
            u32x2 Uf[4];
#pragma unroll
            for (int mt = 0; mt < 4; ++mt) Uf[mt] = Uq[j4][mt];
            __builtin_amdgcn_sched_barrier(0);
            f32x4 vn[4], o[4];
#pragma unroll
            for (int mt = 0; mt < 4; ++mt) { vn[mt] = (f32x4){bflo(Uf[mt].x), bfhi(Uf[mt].x), bflo(Uf[mt].y), bfhi(Uf[mt].y)};
#pragma unroll
                for (int ks = 0; ks < 4; ++ks) vn[mt] = MFMA16(fa[mt * 4 + ks], Sb[ks], vn[mt]); }
            __builtin_amdgcn_sched_barrier(0);
#if SCAN_QG_EARLY
#pragma unroll
            for (int f = 8; f < 16; ++f) fa[f] = *(const LAS bf16x8*)(h0 + 16384 + f * 1024);
            __builtin_amdgcn_sched_barrier(0);
#pragma unroll
            for (int mt = 0; mt < 2; ++mt) { o[mt] = (f32x4){0.f, 0.f, 0.f, 0.f};
#pragma unroll
                for (int ks = 0; ks < 4; ++ks) o[mt] = MFMA16(fb[mt * 4 + ks], Sb[ks], o[mt]); }
#pragma unroll
            for (int mt = 2; mt < 4; ++mt) { o[mt] = (f32x4){0.f, 0.f, 0.f, 0.f};
#pragma unroll
                for (int ks = 0; ks < 4; ++ks) o[mt] = MFMA16(fa[mt * 4 + ks], Sb[ks], o[mt]); }
#else
#pragma unroll
            for (int f = 0; f < 16; ++f) fa[f] = *(const LAS bf16x8*)(h0 + 16384 + f * 1024);
            __builtin_amdgcn_sched_barrier(0);
#pragma unroll
            for (int mt = 0; mt < 4; ++mt) { o[mt] = (f32x4){0.f, 0.f, 0.f, 0.f};
#pragma unroll
                for (int ks = 0; ks < 4; ++ks) o[mt] = MFMA16(fa[mt * 4 + ks], Sb[ks], o[mt]); }
#endif
            const bf16x8 vb0 = pack8(vn[0], vn[1]), vb1 = pack8(vn[2], vn[3]);
#if !SCAN_PUBLISH || !SCAN_REFILL_LATE
            { const int cn = (c + UPRE < 64) ? c + UPRE : 63;
#pragma unroll
                for (int mt = 0; mt < 4; ++mt) Uq[j4][mt] = *(const u32x2*)R.u(bh * 64 + cn, sl, mt, lane);
                eq[j4] = R.EGL[bh * 64 + cn]; }
#endif
            asm volatile("s_waitcnt lgkmcnt(0)" ::: "memory");
            __builtin_amdgcn_s_barrier();
            asm volatile("" ::: "memory");
            bf16x8 fq_[6];
#pragma unroll
            for (int f = 0; f < 6; ++f) fq_[f] = *(const LAS bf16x8*)(h1 + f * 1024);
#pragma unroll
            for (int f = 0; f < 16; ++f) fa[f] = *(const LAS bf16x8*)(h1 + 6144 + f * 1024);
            __builtin_amdgcn_sched_barrier(0);
            o[0] = MFMA16(fq_[0], vb0, o[0]); o[1] = MFMA16(fq_[1], vb0, o[1]);
            o[2] = MFMA16(fq_[2], vb0, o[2]); o[2] = MFMA16(fq_[3], vb1, o[2]);
            o[3] = MFMA16(fq_[4], vb0, o[3]); o[3] = MFMA16(fq_[5], vb1, o[3]);
#pragma unroll
            for (int i = 0; i < 8; ++i) { S[i] = S[i] * egl; S[i] = MFMA16(fa[2 * i], vb0, S[i]); S[i] = MFMA16(fa[2 * i + 1], vb1, S[i]); }
#if SCAN_PUBLISH
#if !SCAN_DRAIN_NONE
            VM_WAIT();
#endif
#if SCAN_O16
#pragma unroll
            for (int p2 = 0; p2 < 2; ++p2) {
                const unsigned a0 = cvtpk(o[2 * p2][0], o[2 * p2][1]), a1 = cvtpk(o[2 * p2][2], o[2 * p2][3]), b0 = cvtpk(o[2 * p2 + 1][0], o[2 * p2 + 1][1]), b1 = cvtpk(o[2 * p2 + 1][2], o[2 * p2 + 1][3]);
                const bool odd = (lane & 1) != 0;
                const unsigned r0 = (unsigned)__builtin_amdgcn_update_dpp(0, (int)(odd ? a0 : b0), 0xB1, 0xf, 0xf, true), r1 = (unsigned)__builtin_amdgcn_update_dpp(0, (int)(odd ? a1 : b1), 0xB1, 0xf, 0xf, true);
                v4u w; w.x = odd ? r0 : a0; w.y = odd ? r1 : a1; w.z = odd ? b0 : r0; w.w = odd ? b1 : r1;
                GAS v4u* dst = (GAS v4u*)R.u(ch, sl, 2 * p2 + (odd ? 1 : 0), lane & ~1);
                asm volatile("global_store_dwordx4 %0, %1, off sc1\n\ts_nop 2" :: "v"(dst), "v"(w) : "memory"); }
#else
#pragma unroll
            for (int mt = 0; mt < 4; ++mt) { const unsigned long long w = (unsigned long long)cvtpk(o[mt][0], o[mt][1]) | ((unsigned long long)cvtpk(o[mt][2], o[mt][3]) << 32);
                if (SCAN_O_SC1) __hip_atomic_store((GAS unsigned long long*)R.u(ch, sl, mt, lane), w, RLX_AGENT); else *(unsigned long long*)R.u(ch, sl, mt, lane) = w; }
#endif
            if (SCAN_REFILL_LATE) { const int cn = (c + UPRE < 64) ? c + UPRE : 63;
#pragma unroll
                for (int mt = 0; mt < 4; ++mt) Uq[j4][mt] = *(const u32x2*)R.u(bh * 64 + cn, sl, mt, lane);
                eq[j4] = R.EGL[bh * 64 + cn]; }
#else
#pragma unroll
            for (int mt = 0; mt < 4; ++mt) { u32x2 w; w.x = cvtpk(o[mt][0], o[mt][1]); w.y = cvtpk(o[mt][2], o[mt][3]); *(u32x2*)R.u(ch, sl, mt, lane) = w; }
#endif
        }
        }
    }
#if SCAN_PUBLISH
    VM_WAIT(); __syncthreads();
    if (F.tid == 0) __hip_atomic_store(F.ctl + CW_SCAN + 64 * (bh * 2 + half), 64u, RLX_AGENT);
#endif
}
__device__ unsigned long long g_ts[16];
__device__ __forceinline__ void run_phase0(Frame& F0) {
    Frame F = F0; asm volatile("" : "+v"(F.tid)); F.lane = F.tid & 63;
    unsigned char* ws = F.ws; bf16* XB = (bf16*)(ws + WS_XB); bf16* Y = (bf16*)(ws + WS_Y); bf16* PROJ = (bf16*)(ws + WS_PROJ); (void)XB; (void)Y; (void)PROJ;
        p0_prologue(F);
}
__device__ __forceinline__ void run_phase1(Frame& F0) {
    Frame F = F0; asm volatile("" : "+v"(F.tid)); F.lane = F.tid & 63;
    unsigned char* ws = F.ws; bf16* XB = (bf16*)(ws + WS_XB); bf16* Y = (bf16*)(ws + WS_Y); bf16* PROJ = (bf16*)(ws + WS_PROJ); (void)XB; (void)Y; (void)PROJ;
        const int N1 = (F.G == 256) ? P1_TILES * 256 : NP;
        pg8::Gemm g{XB, (const bf16*)(ws + WS_WIN), M, N1, D}; pg8::StaticOrder S; S.init(M, N1, F.G, (int)blockIdx.x);
        pg8::EpiProj E{PROJ, NP, (const float*)(ws + WS_RSTD), PC_G / 256, 0, FUSE_QKNORM ? Y + (size_t)M * SW_W : nullptr, Y, FIN(7), FIN(8), PC_SQ / 256, PC_SK / 256, 0.125f * 1.4426950408889634f, SEQ};
        pg8::gemm_phase<pg8::EpiProj, pg8::StaticOrder, ALIGN_P1, true>(F.lds + RING_OFF, g, S, E);
}
__device__ __forceinline__ void run_phase2(Frame& F0) {
    Frame F = F0; asm volatile("" : "+v"(F.tid)); F.lane = F.tid & 63;
    unsigned char* ws = F.ws; bf16* XB = (bf16*)(ws + WS_XB); bf16* Y = (bf16*)(ws + WS_Y); bf16* PROJ = (bf16*)(ws + WS_PROJ); (void)XB; (void)Y; (void)PROJ;
#if FAST_DN
        SUBSTAMP(0) for (int rep_ = 0; rep_ < REP_DNA; ++rep_) dn_chunk_prep(F); SUBSTAMP(1)
#else
        dn_pre(F);
#endif
#if FAST_SWA
        for (int rep_ = 0; rep_ < REP_SWAPRE; ++rep_) swa_pre(F); SUBSTAMP(2)
#endif
}
__device__ __forceinline__ void run_phase3(Frame& F0) {
    Frame F = F0; asm volatile("" : "+v"(F.tid)); F.lane = F.tid & 63;
    unsigned char* ws = F.ws; bf16* XB = (bf16*)(ws + WS_XB); bf16* Y = (bf16*)(ws + WS_Y); bf16* PROJ = (bf16*)(ws + WS_PROJ); (void)XB; (void)Y; (void)PROJ;
#if FAST_DN
        if (F.G == 256) {
            const int bx = (int)blockIdx.x;
            SUBSTAMP(3)
            if (((bx >> 3) & 7) == 0) {
                const int xcd = bx & 7, j = bx >> 6;
                if (!P3_SKIP_SCAN) dn_scan_wg(F, xcd * 2 + (j >> 1), j & 1);
                SUBSTAMP(4)
            } else if (!P3_SKIP_GEMM) {
                const int gi = (bx >> 6) * 56 + (bx & 63) - 8, NG = NP - P1_TILES * 256;
#if P3_ORDER == 1
                if (DEFER_WEIGHTS) { weight_copies(F, WI_P0, WI_ALL, gi * NWAVES + F.wave, 224 * NWAVES); __syncthreads(); }
                swa_bias_table(F); __syncthreads();
                swa_main(F, gi * NWAVES + F.wave, 224 * NWAVES);
                __syncthreads();
#endif
                pg8::Gemm g{XB, (const bf16*)(ws + WS_WIN) + (size_t)P1_TILES * 256 * D, M, NG, D}; pg8::StaticOrder S; S.init(M, NG, 224, gi);
                pg8::EpiProj E{PROJ, NP, (const float*)(ws + WS_RSTD), PC_G / 256, P1_TILES, nullptr, nullptr, nullptr, nullptr, 0, 0, 0.f, SEQ, SEAM35};
                pg8::gemm_phase<pg8::EpiProj, pg8::StaticOrder, true, true>(F.lds + RING_OFF, g, S, E);
                if (SEAM35 && F.tid == 0) {
                    pg8::Unit u_; for (int i_ = 0; S.next(i_, u_); ++i_) __hip_atomic_fetch_add(F.ctl + CW_PAN + 64 * u_.pm + 2, 1u, RLX_AGENT); }
                SUBSTAMP(4)
#if P3_ORDER == 0
                if (!P3_ONLY_SCAN) { swa_bias_table(F); __syncthreads();
                swa_main(F, gi * NWAVES + F.wave, 224 * NWAVES);
                SUBSTAMP(5)
                if (DEFER_WEIGHTS) { __syncthreads(); weight_copies(F, WI_P0, WI_ALL, gi * NWAVES + F.wave, 224 * NWAVES); } }
                if (SEAM67 && DEFER_WEIGHTS) { asm volatile("s_waitcnt vmcnt(0)" ::: "memory"); if (F.lane == 0) __hip_atomic_fetch_add(F.ctl + CW_WCOPY + 64 * (F.wave & 7), 1u, RLX_AGENT); }
                SUBSTAMP(6)
#endif
                dn_out2(F, gi * NWAVES + F.wave, 224 * NWAVES); SUBSTAMP(7)
            }
        } else {
        for (int task = F.vcu; task < 32; task += F.G) { dn_scan_wg(F, task >> 1, task & 1); __syncthreads(); }
        swa_bias_table(F); __syncthreads();
        swa_main(F, F.vcu * NWAVES + F.wave, F.G * NWAVES);
        __syncthreads();
        dn_out2(F, F.vcu * NWAVES + F.wave, F.G * NWAVES);
        }
#elif FAST_SWA
        if (F.vcu < 16) dn_scan_naive(F, F.vcu);
        else { swa_bias_table(F); __syncthreads(); swa_main(F, (F.vcu - 16) * NWAVES + F.wave, (F.G - 16) * NWAVES); }
#else
        if (F.G > 16) { if (F.vcu < 16) dn_scan_naive(F, F.vcu); else swa_naive(F, (F.vcu - 16) * NWAVES + F.wave, (F.G - 16) * NWAVES); }
        else { for (int bh = F.vcu; bh < 16; bh += F.G) dn_scan_naive(F, bh); swa_naive(F, F.vcu * NWAVES + F.wave, F.G * NWAVES); }
#endif
}
__device__ __forceinline__ void run_phase4(Frame& F0) {
    Frame F = F0; asm volatile("" : "+v"(F.tid)); F.lane = F.tid & 63;
    unsigned char* ws = F.ws; bf16* XB = (bf16*)(ws + WS_XB); bf16* Y = (bf16*)(ws + WS_Y); bf16* PROJ = (bf16*)(ws + WS_PROJ); (void)XB; (void)Y; (void)PROJ;
}
__device__ __forceinline__ void run_phase5(Frame& F0) {
    Frame F = F0; asm volatile("" : "+v"(F.tid)); F.lane = F.tid & 63;
    unsigned char* ws = F.ws; bf16* XB = (bf16*)(ws + WS_XB); bf16* Y = (bf16*)(ws + WS_Y); bf16* PROJ = (bf16*)(ws + WS_PROJ); (void)XB; (void)Y; (void)PROJ;
        pg8::Gemm g{PROJ + PC_YDN, (const bf16*)(ws + WS_WAB), 2 * M, 2 * D, DN_W, NP, M / 256, (PC_YSW - PC_YDN) * 2};
        pg8::PairedOrder S; S.init(M, D, F.G, (int)blockIdx.x);
        if (SEAM35 && F.G == 256) {
            pg8::Unit u0;
            if (S.next(0, u0) && F.wave == 0) { gu32* pc = F.ctl + CW_PAN + 64 * u0.pm;
                for (unsigned sp = 0; sp < (1u << 18); ++sp) {
                    const unsigned a0 = (unsigned)__builtin_amdgcn_readfirstlane((int)__hip_atomic_load(pc, RLX_AGENT)), a1 = (unsigned)__builtin_amdgcn_readfirstlane((int)__hip_atomic_load(pc + 1, RLX_AGENT)), a2 = (unsigned)__builtin_amdgcn_readfirstlane((int)__hip_atomic_load(pc + 2, RLX_AGENT));
                    if (a0 >= 64u && a1 >= 64u && a2 >= 7u) break;
                    __builtin_amdgcn_s_sleep(4); }
                __builtin_amdgcn_fence(__ATOMIC_ACQUIRE, "agent"); asm volatile("s_waitcnt vmcnt(0)" ::: "memory"); }
            __syncthreads(); }
#if P5_TOUCH_G
        {
            pg8::Unit u0; if (S.next(0, u0)) { const bf16* gt = PROJ + PC_G + (size_t)u0.pm * 256 * NP + u0.pn * 256;
#pragma unroll
                for (int i = 0; i < 4; ++i) { const int line = i * 512 + F.tid, half = line >> 10, row = (line >> 2) & 255, seg = line & 3;
                    __builtin_amdgcn_global_load_lds((const unsigned*)(gt + (size_t)row * NP + half * 1024 + seg * 64), (LAS unsigned*)(F.lds + LDSCTL_OFF + 1024 + F.wave * 256), 4, 0, 0); } } }
#endif
        pg8::EpiMerge E{PROJ + PC_G, NP, XB, D, M / 256, D / 256};
        pg8::gemm_phase<pg8::EpiMerge, pg8::PairedOrder, ALIGN_P5, true>(F.lds + RING_OFF, g, S, E);
        SUBSTAMP(1)
        if (SEAM56 && F.G == 256) {
            pg8::Unit u0; if (S.next(0, u0) && F.tid == 0) __hip_atomic_fetch_add(F.ctl + CW_P56 + 64 * u0.pm, 1u, RLX_AGENT); }
}
__device__ __forceinline__ void run_phase6(Frame& F0) {
    Frame F = F0; asm volatile("" : "+v"(F.tid)); F.lane = F.tid & 63;
    unsigned char* ws = F.ws; bf16* XB = (bf16*)(ws + WS_XB); bf16* Y = (bf16*)(ws + WS_Y); bf16* PROJ = (bf16*)(ws + WS_PROJ); (void)XB; (void)Y; (void)PROJ;
        SUBSTAMP(0)
        pg8::Gemm g{XB, (const bf16*)(ws + WS_WOUT), M, D, D}; pg8::StaticOrder S; S.init(M, D, F.G, (int)blockIdx.x);
        {
            pg8::Unit u0; if (P6_TOUCH_X && S.next(0, u0)) { const float* xt = FIN(0) + (size_t)u0.pm * 256 * D + u0.pn * 256;
#pragma unroll
                for (int i = 0; i < 4; ++i) { const int line = (F.wave * 4 + i) * 64 + F.lane;
                    __builtin_amdgcn_global_load_lds((const unsigned*)(xt + (size_t)(line >> 3) * D + (line & 7) * 32), (LAS unsigned*)(F.lds + LDSCTL_OFF + 1024 + F.wave * 256), 4, 0, 0); } } }
#if P6_TOUCH_AB
        {
            pg8::Unit u0; if (S.next(0, u0)) {
                const char* bt = (const char*)(ws + WS_WOUT) + (size_t)u0.pn * 256 * D * 2; const char* at = (const char*)XB + (size_t)u0.pm * 256 * D * 2;
#pragma unroll
                for (int i = 0; i < 8; ++i) { const int line = i * 512 + F.tid;
                    __builtin_amdgcn_global_load_lds((const unsigned*)(bt + (size_t)line * 128), (LAS unsigned*)(F.lds + LDSCTL_OFF + 1024 + F.wave * 256), 4, 0, 0); }
#if P6_TOUCH_AB > 1
#pragma unroll
                for (int i = 0; i < 8; ++i) { const int line = i * 512 + F.tid;
                    __builtin_amdgcn_global_load_lds((const unsigned*)(at + (size_t)line * 128), (LAS unsigned*)(F.lds + LDSCTL_OFF + 1024 + F.wave * 256), 4, 0, 0); }
#endif
            } }
#endif
        if (SEAM56 && F.G == 256) {
            pg8::Unit u0;
            if (S.next(0, u0) && F.wave == 0) {
                for (unsigned sp = 0; sp < (1u << 18); ++sp) {
                    bool ok = (unsigned)__builtin_amdgcn_readfirstlane((int)__hip_atomic_load(F.ctl + CW_P56 + 64 * u0.pm, RLX_AGENT)) >= 4u;
                    if (SEAM35 && ok) { unsigned tot = 0u;
                        for (int q = 0; q < 8; ++q) tot += (unsigned)__builtin_amdgcn_readfirstlane((int)__hip_atomic_load(F.ctl + CW_SWADONE + 64 * q, RLX_AGENT));
                        ok = tot >= (unsigned)(BATCH * SW_H * (SEQ / 32)); }
                    if (ok) break;
                    __builtin_amdgcn_s_sleep(2); }
                __builtin_amdgcn_fence(__ATOMIC_ACQUIRE, "agent"); asm volatile("s_waitcnt vmcnt(0)" ::: "memory"); }
            __syncthreads(); }
        pg8::EpiX1 E{FIN(0), F.out, Y, (float*)(ws + WS_SSQ2), D};
        pg8::gemm_phase<pg8::EpiX1, pg8::StaticOrder, ALIGN_P6, true>(F.lds + RING_OFF, g, S, E);
        if (SEAM67 && F.G == 256) { pg8::Unit u0; if (S.next(0, u0) && F.tid == 0) __hip_atomic_fetch_add(F.ctl + CW_PAN + 64 * u0.pm + 3, 1u, RLX_AGENT); }
        SUBSTAMP(2)
}
__device__ __forceinline__ void run_phase7(Frame& F0) {
    Frame F = F0; asm volatile("" : "+v"(F.tid)); F.lane = F.tid & 63;
    unsigned char* ws = F.ws; bf16* XB = (bf16*)(ws + WS_XB); bf16* Y = (bf16*)(ws + WS_Y); bf16* PROJ = (bf16*)(ws + WS_PROJ); (void)XB; (void)Y; (void)PROJ;
        pg8::Gemm g{Y, (const bf16*)(ws + WS_WGU), M, 2 * FF, D};
        pg8::EpiSwiGLU E{PROJ, FF, (const float*)(ws + WS_SSQ2), EPS};
#if SEAM67
        if (F.G == 256) {
            pg8::SkewOrder S; S.init(M, 2 * FF, F.G, (int)blockIdx.x); S.pan = (const unsigned*)(F.ctl + CW_PAN); S.p56 = (const unsigned*)(F.ctl + CW_P56); S.act_row_bytes = FF * 2; S.proj_row_bytes = NP * 2;
            pg8::Unit u0;
            if (S.next(0, u0) && F.wave == 0) {
                const int fm = u0.pm & ~7;
                for (unsigned sp = 0; sp < (1u << 18); ++sp) {
                    unsigned wc_ = 0u;
                    for (int q = 0; q < 8; ++q) wc_ += (unsigned)__builtin_amdgcn_readfirstlane((int)__hip_atomic_load(F.ctl + CW_WCOPY + 64 * q, RLX_AGENT));
                    bool ok = wc_ >= 224u * NWAVES;
                    for (int q = 0; q < 8; ++q) ok = ok && S.panel_ready(fm + q);
                    if (ok) break;
                    __builtin_amdgcn_s_sleep(4); }
                __builtin_amdgcn_fence(__ATOMIC_ACQUIRE, "agent"); asm volatile("s_waitcnt vmcnt(0)" ::: "memory"); }
            __syncthreads();
            pg8::gemm_phase<pg8::EpiSwiGLU, pg8::SkewOrder, ALIGN_P7, true>(F.lds + RING_OFF, g, S, E);
            if (SEAM78 && F.tid == 0) {
                pg8::Unit u_; for (int i_ = 0; S.next(i_, u_); ++i_) __hip_atomic_fetch_add(F.ctl + CW_PAN + 64 * u_.pm + 4, 1u, RLX_AGENT); }
            return;
        }
#endif
#if TAIL_SPLIT
        pg8::TailSplitOrder S; S.init(M, 2 * FF, F.G, (int)blockIdx.x);
#else
        pg8::StaticOrder S; S.init(M, 2 * FF, F.G, (int)blockIdx.x);
#endif
#if TAIL_SPLIT
        pg8::gemm_phase<pg8::EpiSwiGLU, pg8::TailSplitOrder, ALIGN_P7, true, true>(F.lds + RING_OFF, g, S, E);
#else
        pg8::gemm_phase<pg8::EpiSwiGLU, pg8::StaticOrder, ALIGN_P7, SP2_P7>(F.lds + RING_OFF, g, S, E);
#endif
}
__device__ __forceinline__ void run_phase8(Frame& F0) {
    Frame F = F0; asm volatile("" : "+v"(F.tid)); F.lane = F.tid & 63;
    unsigned char* ws = F.ws; bf16* XB = (bf16*)(ws + WS_XB); bf16* Y = (bf16*)(ws + WS_Y); bf16* PROJ = (bf16*)(ws + WS_PROJ); (void)XB; (void)Y; (void)PROJ;
        pg8::Gemm g{PROJ, (const bf16*)(ws + WS_WD), M, D, FF}; pg8::StaticOrder S; S.init(M, D, F.G, (int)blockIdx.x);
        if (SEAM78 && SEAM67 && F.G == 256) {
            pg8::Unit u0;
            if (S.next(0, u0) && F.wave == 0) {
                for (unsigned sp = 0; sp < (1u << 18); ++sp) {
                    bool ok = (unsigned)__builtin_amdgcn_readfirstlane((int)__hip_atomic_load(F.ctl + CW_PAN + 64 * u0.pm + 4, RLX_AGENT)) >= 22u;
                    if (ok) { unsigned tot = 0u;
                        for (int q = 0; q < 8; ++q) tot += (unsigned)__builtin_amdgcn_readfirstlane((int)__hip_atomic_load(F.ctl + CW_NORMDONE + 64 * q, RLX_AGENT));
                        ok = tot >= 4096u; }
                    if (ok) break;
                    __builtin_amdgcn_s_sleep(4); }
                __builtin_amdgcn_fence(__ATOMIC_ACQUIRE, "agent"); asm volatile("s_waitcnt vmcnt(0)" ::: "memory"); }
            __syncthreads(); }
        pg8::EpiOut E{F.out, D, Y};
        pg8::gemm_phase<pg8::EpiOut, pg8::StaticOrder, ALIGN_P8, true>(F.lds + RING_OFF, g, S, E);
}
#ifndef PROGRAM
#define PROGRAM RUN(0) BAR RUN(1) BAR RUN(2) BAR RUN(3) if (!(SEAM35 && F.G == 256)) { BAR } RUN(5) if (!(SEAM56 && F.G == 256)) { BAR } RUN(6) if (!(SEAM67 && F.G == 256)) { BAR } RUN(7) if (!(SEAM78 && SEAM67 && F.G == 256)) { BAR } RUN(8)
#endif
__global__ void __launch_bounds__(NWAVES * 64, 2) fwd_kernel(Args args) {
    extern __shared__ __attribute__((aligned(16))) unsigned char lds[];
    Frame F;
    F.lds = (LAS unsigned char*)lds;
    F.MISC = (volatile LAS unsigned*)(F.lds + MISC_OFF);
    F.tid = threadIdx.x; F.lane = F.tid & 63; F.wave = __builtin_amdgcn_readfirstlane(F.tid >> 6);
    F.G = gridDim.x; { const int bx = blockIdx.x; F.vcu = (F.G % 8 == 0) ? (bx % 8) * (F.G / 8) + bx / 8 : bx; }
    F.ka = (KArgs)__builtin_amdgcn_kernarg_segment_ptr();
    F.out = args.out; F.ws = args.ws; unsigned char* ws = args.ws;
    F.ctl = (gu32*)(ws + WS_CTL);
    for (int u = F.tid; u < (LDS_BYTES - LDSCTL_OFF) / 4; u += NWAVES * 64) ((LAS unsigned*)(F.lds + LDSCTL_OFF))[u] = 0u;
    __syncthreads();
    XcdBarrier bar; bar.bar = (unsigned*)(F.ctl + CW_BAR) + args.li * XCD_BAR_WORDS; bar.x = 0; bar.st = nullptr;
    bar = xcd_barrier_post((unsigned*)(F.ctl + CW_BAR) + args.li * XCD_BAR_WORDS, F.MISC + 8);
#if STAMP_PHASE >= 0
#if STAMP_SUB >= 0 || STAMP_DN >= 0
#define STAMP_()
#else
    int ns_ = 0;
#define STAMP_() { if (ns_ == STAMP_PHASE || ns_ == STAMP_PHASE + 1) { unsigned long long t_; asm volatile("s_memrealtime %0\n\ts_waitcnt lgkmcnt(0)" : "=s"(t_) :: "memory"); g_ts[ns_ - STAMP_PHASE] = t_; } ++ns_; }
#endif
#define RUN(k) run_phase##k(F);
#define BAR xcd_barrier(bar); STAMP_()
    STAMP_()
    PROGRAM
    BAR
#if STAMP_WS
    if (blockIdx.x == 0 && F.tid == 0) F.out[0] += (float)args.ws_mib;
#elif STAMP_DN >= 0
    if (blockIdx.x == STAMP_BLOCK && F.tid == 0) F.out[0] += (float)(g_dn[STAMP_DN]) * 0.01f;
#elif STAMP_SUB >= 0
    if (blockIdx.x == STAMP_BLOCK && F.tid == 0) F.out[0] += floorf((float)(g_sub[STAMP_SUBB] - g_sub[STAMP_SUB]) * 0.01f / STAMP_Q + 0.5f) * STAMP_Q - STAMP_OFF;
#else
    if (blockIdx.x == 0 && F.tid == 0) F.out[0] += floorf((float)(g_ts[1] - g_ts[0]) * 0.01f / STAMP_Q + 0.5f) * STAMP_Q - STAMP_OFF;
#endif
#undef RUN
#undef BAR
#else
#define RUN(k) run_phase##k(F);
#define BAR xcd_barrier(bar);
    PROGRAM
#if STAMP_WS
    BAR
    if (blockIdx.x == 0 && F.tid == 0) F.out[0] += (float)args.ws_mib;
#endif
#undef RUN
#undef BAR
#endif
}

extern "C" void kernel_launch(void* const* d_in, const int* in_sizes, int n_in, void* d_out, int out_size, void* d_ws, size_t ws_size, hipStream_t stream) {
    static int grid = 0;
    if (grid == 0) {
        if (n_in != 18 || in_sizes[0] != M * D || out_size != M * D || ws_size < WS_END) { fprintf(stderr, "kernel_launch: unexpected shapes (n_in %d, in0 %d, out %d, ws %zu)\n", n_in, n_in > 0 ? in_sizes[0] : -1, out_size, ws_size); grid = -1; return; }
        int dev = 0, cus = 0;
        if (hipGetDevice(&dev) != hipSuccess || hipDeviceGetAttribute(&cus, hipDeviceAttributeMultiprocessorCount, dev) != hipSuccess) { grid = -1; return; }
        if (hipFuncSetAttribute((const void*)fwd_kernel, hipFuncAttributeMaxDynamicSharedMemorySize, LDS_BYTES) != hipSuccess) { fprintf(stderr, "kernel_launch: hipFuncSetAttribute failed\n"); grid = -1; return; }
        int per_cu = 0;
        if (hipOccupancyMaxActiveBlocksPerMultiprocessor(&per_cu, (const void*)fwd_kernel, NWAVES * 64, LDS_BYTES) != hipSuccess || per_cu < 1) fprintf(stderr, "kernel_launch: occupancy query reports %d\n", per_cu);
        (void)hipGetLastError();
        grid = cus;
    }
    if (grid < 0) return;
    if (hipMemsetAsync((char*)d_ws + WS_CTL, 0, CTL_ZERO_BYTES, stream) != hipSuccess) return;
    Args a{};
    for (int i = 0; i < 18; ++i) a.in[i] = (const float*)d_in[i];
    a.out = (float*)d_out; a.ws = (unsigned char*)d_ws; a.ws_mib = (int)(ws_size >> 20);
    for (int li = 0; li < 1; ++li) {
        a.ph_lo = 0; a.ph_hi = 0;
        a.li = li;
        hipLaunchKernelGGL(fwd_kernel, dim3(grid), dim3(NWAVES * 64), LDS_BYTES, stream, a);
        const hipError_t le = hipPeekAtLastError();
        if (le != hipSuccess) { fprintf(stderr, "kernel_launch: launch %d failed: %s\n", li, hipGetErrorName(le)); break; }
    }
}
```

```cpp
#ifndef FAST_SWA
#define FAST_SWA 1
#endif
#ifndef FAST_DN
#define FAST_DN 1
#endif
#ifndef REP_DNA
#define REP_DNA 1
#endif
#ifndef REP_SWAPRE
#define REP_SWAPRE 1
#endif
#ifndef REP_S1
#define REP_S1 1
#endif
#ifndef REP_S2
#define REP_S2 1
#endif
#ifndef REP_S3A
#define REP_S3A 1
#endif
#ifndef REP_S3B
#define REP_S3B 1
#endif
#ifndef REP_S4
#define REP_S4 1
#endif
#ifndef S1_RELOAD
#define S1_RELOAD 0
#endif
#ifndef S1_OPAQUE
#define S1_OPAQUE 0
#endif
#ifndef P1_TILES
#define P1_TILES 12
#endif
#ifndef STAMP_PHASE
#define STAMP_PHASE -1
#endif
#ifndef STAMP_SUB
#define STAMP_SUB -1
#endif
#ifndef STAMP_BLOCK
#define STAMP_BLOCK 0
#endif
#ifndef STAMP_DN
#define STAMP_DN -1
#endif
#ifndef STAMP_WS
#define STAMP_WS 0
#endif
#ifndef P3_SKIP_SCAN
#define P3_SKIP_SCAN 0
#endif
#ifndef P3_SKIP_GEMM
#define P3_SKIP_GEMM 0
#endif
#ifndef SCAN_HOT
#define SCAN_HOT 0
#endif
#ifndef STAMP_Q
#define STAMP_Q 8.0f
#endif
#ifndef SCAN_AHEAD
#define SCAN_AHEAD 6
#endif
#ifndef SCAN_TOUCH_EN
#define SCAN_TOUCH_EN 0
#endif
#ifndef DEFER_WEIGHTS
#define DEFER_WEIGHTS 1
#endif
#ifndef P3_ONLY_SCAN
#define P3_ONLY_SCAN 0
#endif
#ifndef ALIGN_P7
#define ALIGN_P7 true
#endif
#ifndef ALIGN_P1
#define ALIGN_P1 true
#endif
#ifndef ALIGN_P5
#define ALIGN_P5 true
#endif
#ifndef ALIGN_P6
#define ALIGN_P6 true
#endif
#ifndef ALIGN_P8
#define ALIGN_P8 true
#endif
#ifndef SP2_P7
#define SP2_P7 true
#endif
#ifndef P3_ORDER
#define P3_ORDER 0
#endif
#ifndef SCAN_SETS
#define SCAN_SETS 4
#endif
#ifndef DNA_PREFETCH
#define DNA_PREFETCH 0
#endif
#ifndef SCAN_NT
#define SCAN_NT 0
#endif
#ifndef FUSE_QKNORM
#define FUSE_QKNORM 1
#endif
#ifndef STAMP_SUBB
#define STAMP_SUBB (STAMP_SUB + 1)
#endif
#ifndef SCAN_UPRE
#define SCAN_UPRE 2
#endif
#ifndef SCAN_PUBLISH
#define SCAN_PUBLISH 1
#endif
#ifndef SCAN_DRAIN_CNT
#define SCAN_DRAIN_CNT 0
#endif
#ifndef SCAN_O_SC1
#define SCAN_O_SC1 1
#endif
#ifndef SCAN_REFILL_LATE
#define SCAN_REFILL_LATE 1
#endif
#ifndef SCAN_O16
#define SCAN_O16 1
#endif
#ifndef STAMP_OFF
#define STAMP_OFF 0.0f
#endif
#ifndef DNO_SLEEP
#define DNO_SLEEP 8
#endif
#ifndef DNO_SKIPWORK
#define DNO_SKIPWORK 0
#endif
#ifndef DNO_SKIPALL
#define DNO_SKIPALL 0
#endif
#ifndef SCAN_PUB_LOADER
#define SCAN_PUB_LOADER 1
#endif
#ifndef SCAN_PUB_EVERY
#define SCAN_PUB_EVERY 1
#endif
#ifndef DNO_FENCE
#define DNO_FENCE 0
#endif
#ifndef SCAN_DRAIN_NONE
#define SCAN_DRAIN_NONE 0
#endif
#ifndef DNO_LAG
#define DNO_LAG 0
#endif
#ifndef EPI_WT
#define EPI_WT 0
#endif
#ifndef TAIL_SPLIT
#define TAIL_SPLIT 0
#endif
#ifndef GEMM_SAMETILE
#define GEMM_SAMETILE 0
#endif
#ifndef STAMP_EPI
#define STAMP_EPI 0
#endif
#ifndef SEAM56
#define SEAM56 1
#endif
#ifndef SCAN_QG_EARLY
#define SCAN_QG_EARLY 0
#endif
#ifndef BAR_EARLY_WB
#define BAR_EARLY_WB 0
#endif
#ifndef P0_DEEP
#define P0_DEEP 0
#endif
#ifndef DNO_STAGE
#define DNO_STAGE 1
#endif
#ifndef SEAM35
#define SEAM35 1
#endif
#ifndef P6_TOUCH_AB
#define P6_TOUCH_AB 0
#endif
#ifndef P5_TOUCH_G
#define P5_TOUCH_G 0
#endif
#ifndef P6_TOUCH_X
#define P6_TOUCH_X 0
#endif
#ifndef SEAM67
#define SEAM67 1
#endif
#ifndef SKEW_TAIL
#define SKEW_TAIL 1
#endif
#ifndef SEAM78
#define SEAM78 0
#endif
#ifndef ASYM_WCOPY
#define ASYM_WCOPY 1
#endif
#include <hip/hip_runtime.h>
#include <cstdio>
#include <cstdint>

#ifndef WGM_KNOB
#define WGM_KNOB 8
#endif
#ifndef EPI_REP
#define EPI_REP 1
#endif
#ifndef EPI_REP_WHICH
#define EPI_REP_WHICH 0
#endif
#ifndef RES_F32
#define RES_F32 0
#endif
#if STAMP_SUB >= 0
__device__ unsigned long long g_sub[8];
#define SUBSTAMP(i) if (blockIdx.x == STAMP_BLOCK && threadIdx.x == 0) g_sub[i] = __builtin_amdgcn_s_memrealtime();
#else
#define SUBSTAMP(i)
#endif
namespace pg8 {
#define PG8_LAS __attribute__((address_space(3)))
typedef unsigned short bf16_t;
typedef short bf16x8 __attribute__((ext_vector_type(8)));
typedef float f32x4 __attribute__((ext_vector_type(4)));
typedef unsigned u32x4 __attribute__((ext_vector_type(4)));
typedef unsigned u32x2 __attribute__((ext_vector_type(2)));
constexpr int BM = 256, BK = 64, HALF = 128, HTB = HALF * BK * 2  , STAGE_BYTES = 8 * HTB, NXCD = 8, WGM = WGM_KNOB;

__host__ __device__ __forceinline__ int lds_byte(int r, int c) { const int st = (r >> 4) * 2 + (c >> 5), rr = r & 15, cc = c & 31, ob = rr * 64 + cc * 2; return st * 1024 + (ob ^ (((ob >> 9) & 1) << 5)); }
__host__ __device__ __forceinline__ void stage_rc(int b, int& R, int& C) { const int st = b / 1024, sb = b % 1024, swz = sb ^ (((sb >> 9) & 1) << 5); R = (st >> 1) * 16 + swz / 64; C = (st & 1) * 32 + (swz % 64) / 2; }
__host__ __device__ __forceinline__ int perm32(int rho) { const int n = rho >> 4, i = rho & 15; return 8 * (i >> 2) + 4 * n + (i & 3); }

struct Unit { int pm, pn, hm, chk; };
struct Gemm { const bf16_t* A; const bf16_t* Bt; int M, N, K; int lda = 0, nMA = 1 << 30, a2off = 0; };

struct StaticOrder {
    int nM, nN, nwg, G, c;
    __host__ __device__ void init(int M, int N, int G_, int c_) { nM = M / BM; nN = N / BM; nwg = nM * nN; G = G_; c = c_; }
    __host__ __device__ bool next(int i, Unit& u) const { return nextL((long)i * G + c, u); }
    __host__ __device__ bool nextL(long L, Unit& u) const {
        if (L >= nwg) return false;
        u.hm = 0; u.chk = 0;
        int wgid = (int)L; { const int q = nwg / NXCD, r = nwg % NXCD, xcd = wgid % NXCD, off = wgid / NXCD; wgid = (xcd < r ? xcd * (q + 1) : r * (q + 1) + (xcd - r) * q) + off; }
        const int nig = WGM * nN, gid = wgid / nig, fm = gid * WGM, gsz = (nM - fm) < WGM ? (nM - fm) : WGM;
        u.pm = fm + ((wgid % nig) % gsz); u.pn = (wgid % nig) / gsz; return true;
    }
    __device__ __forceinline__ void a_ready(const Unit&) const {}
    __device__ __forceinline__ void done(const Unit&) const {}
};
struct TailSplitOrder {
    StaticOrder so; int full, rem; bool split;
    __host__ __device__ void init(int M, int N, int G_, int c_) { so.init(M, N, G_, c_); full = so.nwg / G_; rem = so.nwg - full * G_; split = TAIL_SPLIT && rem > 0 && 2 * rem <= G_; }
    __host__ __device__ bool next(int i, Unit& u) const {
        if (i < full || !split) return so.next(i, u);
        if (i > full || so.c >= 2 * rem) return false;
        if (!so.nextL((long)full * so.G + (so.c >> 1), u)) return false;
        u.hm = 1 + (so.c & 1); return true;
    }
    __device__ __forceinline__ void a_ready(const Unit&) const {}
    __device__ __forceinline__ void done(const Unit&) const {}
};
struct SkewOrder {
    StaticOrder so; const unsigned* pan; const unsigned* p56; int act_row_bytes, proj_row_bytes;
    __host__ __device__ void init(int M, int N, int G_, int c_) { so.init(M, N, G_, c_); }
    __host__ __device__ bool next(int i, Unit& u) const {
        const int full = so.nwg / so.G;
        if (i < full || !SKEW_TAIL) return so.next(i, u);
        if (i > full) return false;
        const int x = so.c & 7, off = so.c >> 3; if (x & 1) return false;
        if (!so.nextL((long)full * so.G + 8 * (off >> 1) + x + (off & 1), u)) return false;
        u.chk = off & 1; return true;
    }
    __device__ __forceinline__ bool panel_ready(int pm) const {
        bool ok = (unsigned)__builtin_amdgcn_readfirstlane((int)__hip_atomic_load(pan + 64 * pm + 3, __ATOMIC_RELAXED, __HIP_MEMORY_SCOPE_AGENT)) >= 4u;
        const int lo = (pm * act_row_bytes) / proj_row_bytes, hi = ((pm + 1) * act_row_bytes - 1) / proj_row_bytes;
        for (int q = lo; q <= hi; ++q) ok = ok && (unsigned)__builtin_amdgcn_readfirstlane((int)__hip_atomic_load(p56 + 64 * q, __ATOMIC_RELAXED, __HIP_MEMORY_SCOPE_AGENT)) >= 4u;
        return ok;
    }
    __device__ __forceinline__ void a_ready(const Unit& u) const {
        if (u.chk) {
            if (threadIdx.x < 64) {
                for (unsigned sp = 0; !panel_ready(u.pm) && sp < (1u << 18); ++sp) __builtin_amdgcn_s_sleep(2);
                __builtin_amdgcn_fence(__ATOMIC_ACQUIRE, "agent"); asm volatile("s_waitcnt vmcnt(0)" ::: "memory"); }
            asm volatile("" ::: "memory"); __builtin_amdgcn_s_barrier(); asm volatile("" ::: "memory");
        }
    }
    __device__ __forceinline__ void done(const Unit&) const {}
};
struct PairedOrder {
    StaticOrder so;
    __host__ __device__ void init(int M, int N, int G_, int c_) { so.init(M, N, G_, c_); }
    __host__ __device__ bool next(int i, Unit& u) const { if (!so.next(i >> 1, u)) return false; if (i & 1) { u.pm += so.nM; u.pn += so.nN; } return true; }
    __device__ __forceinline__ void a_ready(const Unit&) const {}
    __device__ __forceinline__ void done(const Unit&) const {}
};

__device__ __forceinline__ unsigned cvt_pk_bf16(float lo, float hi) { unsigned r; asm volatile("v_cvt_pk_bf16_f32 %0, %1, %2" : "=v"(r) : "v"(lo), "v"(hi)); return r; }
__device__ __forceinline__ float bf_lo(unsigned w) { return __builtin_bit_cast(float, w << 16); }
__device__ __forceinline__ float bf_hi(unsigned w) { return __builtin_bit_cast(float, w & 0xffff0000u); }
__device__ __forceinline__ float sigmoidf_(float x) { return 1.0f / (1.0f + __expf(-x)); }
template <class V> __device__ __forceinline__ void st16wt(void* p, V v) {
    asm volatile("global_store_dwordx4 %0, %1, off sc1\n\ts_nop 1" :: "v"((__attribute__((address_space(1))) V*)p), "v"(v) : "memory");
}
template <class V> __device__ __forceinline__ void st16(void* p, V v) {
#if EPI_WT
    asm volatile("global_store_dwordx4 %0, %1, off sc1\n\ts_nop 1" :: "v"((__attribute__((address_space(1))) V*)p), "v"(v) : "memory");
#else
    *(V*)p = v;
#endif
}


struct EpiProj {
    static constexpr bool SUBST = false, PERM = true, AFTER_DRAIN = false, PROBE_REP = (EPI_REP_WHICH == 1);
    bf16_t* O; int ldc; const float* rstd; int gate_pn0, pn_off;
    bf16_t* QS; bf16_t* KS; const float* qg; const float* kg; int q_pn0, k_pn;
    float qscale; int seq; int wt = 0;
    __device__ __forceinline__ bool keep(const Unit&) const { return false; }
    __device__ __forceinline__ void operator()(f32x4 (&acc)[2][2][4][2], const Unit& u, int wr, int wc, int fr, int fq) const {
        const int pna = u.pn + pn_off;
        const int row0 = u.pm * BM + wr * 64 + fr, col0 = pna * BM + wc * 64 + 8 * fq; const bool gate = pna >= gate_pn0;
        float sr[2][4];
#pragma unroll
        for (int ai = 0; ai < 2; ++ai)
#pragma unroll
            for (int m = 0; m < 4; ++m) sr[ai][m] = rstd[row0 + ai * HALF + m * 16];
        const bool isq = QS != nullptr && (pna == q_pn0 || pna == q_pn0 + 1), isk = QS != nullptr && pna == k_pn && wc < 2;
        if (isq || isk) {
            f32x4 gn[2][2];
#pragma unroll
            for (int bj = 0; bj < 2; ++bj)
#pragma unroll
                for (int n = 0; n < 2; ++n) { const int d = 32 * bj + 8 * fq + 4 * n; gn[bj][n] = isq ? *(const f32x4*)(qg + d) * qscale : *(const f32x4*)(kg + d); }
#pragma unroll
            for (int ai = 0; ai < 2; ++ai)
#pragma unroll
                for (int m = 0; m < 4; ++m) { const int row = row0 + ai * HALF + m * 16; const float s = sr[ai][m];
                    float ss = 0.f;
#pragma unroll
                    for (int bj = 0; bj < 2; ++bj)
#pragma unroll
                        for (int n = 0; n < 2; ++n) { const f32x4 v = acc[ai][bj][m][n] * s; ss += (v[0] * v[0] + v[1] * v[1]) + (v[2] * v[2] + v[3] * v[3]); }
                    ss += __shfl_xor(ss, 16); ss += __shfl_xor(ss, 32);
                    const float r = s * __builtin_amdgcn_rsqf(ss * (1.0f / 64.0f) + 1e-6f);
                    bf16_t* dst = isq ? QS + (size_t)row * 512 + (pna - q_pn0) * 256 + wc * 64 + 8 * fq
                                      : KS + ((size_t)((row / seq) * 2 + wc) * seq + (row % seq)) * 64 + 8 * fq;
#pragma unroll
                    for (int bj = 0; bj < 2; ++bj) { const f32x4 v0 = acc[ai][bj][m][0] * r * gn[bj][0], v1 = acc[ai][bj][m][1] * r * gn[bj][1];
                        u32x4 w; w.x = cvt_pk_bf16(v0[0], v0[1]); w.y = cvt_pk_bf16(v0[2], v0[3]); w.z = cvt_pk_bf16(v1[0], v1[1]); w.w = cvt_pk_bf16(v1[2], v1[3]);
                        st16(dst + bj * 32, w); } }
            return;
        }
#pragma unroll
        for (int ai = 0; ai < 2; ++ai)
#pragma unroll
            for (int m = 0; m < 4; ++m) { const int row = row0 + ai * HALF + m * 16; const float s = sr[ai][m]; bf16_t* rowp = O + (size_t)row * ldc + col0;
#pragma unroll
                for (int bj = 0; bj < 2; ++bj) { f32x4 v0 = acc[ai][bj][m][0] * s, v1 = acc[ai][bj][m][1] * s;
                    if (gate) {
#pragma unroll
                        for (int j = 0; j < 4; ++j) { v0[j] = __builtin_amdgcn_rcpf(1.0f + __expf(-v0[j])); v1[j] = __builtin_amdgcn_rcpf(1.0f + __expf(-v1[j])); } }
                    u32x4 w; w.x = cvt_pk_bf16(v0[0], v0[1]); w.y = cvt_pk_bf16(v0[2], v0[3]); w.z = cvt_pk_bf16(v1[0], v1[1]); w.w = cvt_pk_bf16(v1[2], v1[3]);
                    if (wt) st16wt(rowp + bj * 32, w); else st16(rowp + bj * 32, w); } }
    }
};
struct EpiMerge {
    static constexpr bool SUBST = false, PERM = true, AFTER_DRAIN = false, PROBE_REP = false;
    const bf16_t* G; int ldg; bf16_t* O; int ldc; int nM, nN;
    __device__ __forceinline__ bool keep(const Unit& u) const { return u.pm < nM; }
    __device__ __forceinline__ void operator()(f32x4 (&acc)[2][2][4][2], const Unit& u, int wr, int wc, int fr, int fq) const {
        const bool second = u.pm >= nM; const int pm = second ? u.pm - nM : u.pm, pn = second ? u.pn - nN : u.pn;
        const int row0 = pm * BM + wr * 64 + fr, col0 = pn * BM + wc * 64 + 8 * fq;
#pragma unroll
        for (int ai = 0; ai < 2; ++ai) {
            u32x4 gA[4][2], gB[4][2];
#pragma unroll
            for (int m = 0; m < 4; ++m)
#pragma unroll
                for (int bj = 0; bj < 2; ++bj) { const size_t o = (size_t)(row0 + ai * HALF + m * 16) * ldg + col0 + bj * 32; if (!second) gA[m][bj] = *(const u32x4*)(G + o); gB[m][bj] = *(const u32x4*)(G + o + 1024); }
#pragma unroll
            for (int m = 0; m < 4; ++m) { const int row = row0 + ai * HALF + m * 16;
#pragma unroll
                for (int bj = 0; bj < 2; ++bj) { const int col = col0 + bj * 32;
                    float sb[8];
#pragma unroll
                    for (int j = 0; j < 4; ++j) { sb[2 * j] = bf_lo(gB[m][bj][j]); sb[2 * j + 1] = bf_hi(gB[m][bj][j]); }
                    if (!second) {
                        float sa[8];
#pragma unroll
                        for (int j = 0; j < 4; ++j) { sa[2 * j] = bf_lo(gA[m][bj][j]); sa[2 * j + 1] = bf_hi(gA[m][bj][j]); }
#pragma unroll
                        for (int j = 0; j < 4; ++j) { acc[ai][bj][m][0][j] *= sa[j] * __builtin_amdgcn_rcpf(sb[j]); acc[ai][bj][m][1][j] *= sa[4 + j] * __builtin_amdgcn_rcpf(sb[4 + j]); }
                    } else {
                        f32x4 v0, v1;
#pragma unroll
                        for (int j = 0; j < 4; ++j) { v0[j] = acc[ai][bj][m][0][j] * sb[j]; v1[j] = acc[ai][bj][m][1][j] * sb[4 + j]; }
                        u32x4 w; w.x = cvt_pk_bf16(v0[0], v0[1]); w.y = cvt_pk_bf16(v0[2], v0[3]); w.z = cvt_pk_bf16(v1[0], v1[1]); w.w = cvt_pk_bf16(v1[2], v1[3]);
                        if (SEAM56) st16wt(O + (size_t)row * ldc + col, w); else st16(O + (size_t)row * ldc + col, w); } } }
            asm volatile("" ::: "memory"); }
    }
};
struct EpiX1 {
    static constexpr bool SUBST = (STAMP_EPI == 6), PERM = (SEAM67 != 0), AFTER_DRAIN = false, PROBE_REP = (EPI_REP_WHICH == 6);
    const float* X; float* out; bf16_t* xb; float* ssq; int ldc;
    __device__ __forceinline__ bool keep(const Unit&) const { return false; }
    __device__ __forceinline__ void operator()(f32x4 (&acc)[2][2][4][2], const Unit& u, int wr, int wc, int fr, int fq) const {
        const int row0 = u.pm * BM + wr * 64 + fr, col0 = u.pn * BM + wc * 32 + (PERM ? 8 : 4) * fq; constexpr int NOFF = PERM ? 4 : 16;
#pragma unroll
        for (int ai = 0; ai < 2; ++ai) {
            f32x4 xv[4][2][2];
#pragma unroll
            for (int m = 0; m < 4; ++m)
#pragma unroll
                for (int bj = 0; bj < 2; ++bj)
#pragma unroll
                    for (int n = 0; n < 2; ++n) xv[m][bj][n] = *(const f32x4*)(X + (size_t)(row0 + ai * HALF + m * 16) * ldc + col0 + bj * HALF + n * NOFF);
#pragma unroll
            for (int m = 0; m < 4; ++m) { const int row = row0 + ai * HALF + m * 16; const size_t off = (size_t)row * ldc + col0; float ss = 0.f;
#pragma unroll
                for (int bj = 0; bj < 2; ++bj) { u32x4 w4;
#pragma unroll
                    for (int n = 0; n < 2; ++n) { const f32x4 o = xv[m][bj][n] + acc[ai][bj][m][n];
                        if (RES_F32) *(f32x4*)(out + off + bj * HALF + n * NOFF) = o; ss += (o[0] * o[0] + o[1] * o[1]) + (o[2] * o[2] + o[3] * o[3]);
                        u32x2 w; w.x = cvt_pk_bf16(o[0], o[1]); w.y = cvt_pk_bf16(o[2], o[3]);
                        if (PERM) { if (n == 0) { w4.x = w.x; w4.y = w.y; } else { w4.z = w.x; w4.w = w.y; } }
                        else *(u32x2*)(xb + off + bj * HALF + n * 16) = w; }
                    if (PERM) st16wt(xb + off + bj * HALF, w4); }
                ss += __shfl_xor(ss, 16); ss += __shfl_xor(ss, 32);
                if (fq == 0) atomicAdd(ssq + row, ss); }
            asm volatile("" ::: "memory"); }
    }
};
struct EpiSwiGLU {
    static constexpr bool SUBST = false, PERM = true, AFTER_DRAIN = false, PROBE_REP = (EPI_REP_WHICH == 7);
    bf16_t* O; int ldc; const float* ssq; float eps;
    __device__ __forceinline__ bool keep(const Unit&) const { return false; }
    __device__ __forceinline__ void operator()(f32x4 (&acc)[2][2][4][2], const Unit& u, int wr, int wc, int fr, int fq) const {
        const int row0 = u.pm * BM + (u.hm == 2 ? HALF : 0) + wr * 64 + fr, col0 = u.pn * HALF + wc * 32 + 8 * fq;
        float sr[2][4];
#pragma unroll
        for (int ai = 0; ai < 2; ++ai)
#pragma unroll
            for (int m = 0; m < 4; ++m) sr[ai][m] = ssq[row0 + (u.hm ? 0 : ai * HALF) + m * 16];
#pragma unroll
        for (int ai = 0; ai < 2; ++ai)
#pragma unroll
            for (int m = 0; m < 4; ++m) { const int row = row0 + ai * HALF + m * 16;
                if (ai == 1 && u.hm) continue;
                const float s = __builtin_amdgcn_rsqf(sr[ai][m] * (1.0f / 1024.0f) + eps);
                float a[8];
#pragma unroll
                for (int n = 0; n < 2; ++n)
#pragma unroll
                    for (int j = 0; j < 4; ++j) { const float g = acc[ai][0][m][n][j] * s, up = acc[ai][1][m][n][j] * s; a[4 * n + j] = g * up * __builtin_amdgcn_rcpf(1.0f + __expf(-g)); }
                u32x4 w; w.x = cvt_pk_bf16(a[0], a[1]); w.y = cvt_pk_bf16(a[2], a[3]); w.z = cvt_pk_bf16(a[4], a[5]); w.w = cvt_pk_bf16(a[6], a[7]);
                if (SEAM78) st16wt(O + (size_t)row * ldc + col0, w); else st16(O + (size_t)row * ldc + col0, w); }
    }
};
struct EpiOut {
    static constexpr bool SUBST = (STAMP_EPI == 8), PERM = false, AFTER_DRAIN = false, PROBE_REP = false;
    float* out; int ldc; const bf16_t* xb;
    __device__ __forceinline__ bool keep(const Unit&) const { return false; }
    __device__ __forceinline__ void operator()(f32x4 (&acc)[2][2][4][2], const Unit& u, int wr, int wc, int fr, int fq) const {
        const int row0 = u.pm * BM + wr * 64 + fr, col0 = u.pn * BM + wc * 32 + 4 * fq;
#pragma unroll
        for (int ai = 0; ai < 2; ++ai) {
            u32x2 rb[4][2][2]; f32x4 rf[4][2][2];
#pragma unroll
            for (int m = 0; m < 4; ++m)
#pragma unroll
                for (int bj = 0; bj < 2; ++bj)
#pragma unroll
                    for (int n = 0; n < 2; ++n) { const size_t o = (size_t)(row0 + ai * HALF + m * 16) * ldc + col0 + bj * HALF + n * 16;
                        if (RES_F32) rf[m][bj][n] = *(const f32x4*)(out + o); else rb[m][bj][n] = *(const u32x2*)(xb + o); }
#pragma unroll
            for (int m = 0; m < 4; ++m) { const size_t off = (size_t)(row0 + ai * HALF + m * 16) * ldc + col0;
#pragma unroll
                for (int bj = 0; bj < 2; ++bj)
#pragma unroll
                    for (int n = 0; n < 2; ++n) { f32x4 b;
                        if (RES_F32) b = rf[m][bj][n]; else { const u32x2 w = rb[m][bj][n]; b = (f32x4){bf_lo(w.x), bf_hi(w.x), bf_lo(w.y), bf_hi(w.y)}; }
                        *(f32x4*)(out + off + bj * HALF + n * 16) = b + acc[ai][bj][m][n]; } }
            asm volatile("" ::: "memory"); }
    }
};

template <class Epi, class Sched, bool ALIGN_EPI = false, bool SP2 = false, bool HM = false>
__device__ __forceinline__ void gemm_phase(PG8_LAS unsigned char* lds, const Gemm g, const Sched& S, const Epi& E) {
    int tid_ = threadIdx.x; asm volatile("" : "+v"(tid_));
    const int tid = tid_, wid = __builtin_amdgcn_readfirstlane(tid >> 6), lane = tid & 63, wr = wid >> 2, wc = wid & 3, fr = lane & 15, fq = lane >> 4;
    const int K = g.K, nt = K / BK, LDA = g.lda ? g.lda : g.K;
    unsigned voffA[2], voffB[2];
#pragma unroll
    for (int i = 0; i < 2; ++i) { int R, C; stage_rc(tid * 16 + i * 8192, R, C); const int Rb = Epi::PERM ? ((R & ~31) + perm32(R & 31)) : R;
        voffA[i] = (unsigned)(R * LDA + C) * 2u; voffB[i] = (unsigned)(Rb * K + C) * 2u; }
    const size_t kstep = (size_t)(BK * 2);
    const size_t hstep = (size_t)HALF * K * 2;
    const size_t tstep = 2 * hstep;
    const size_t hstepA = (size_t)HALF * LDA * 2, tstepA = 2 * hstepA;
#define PG8_ABASE(pm_) ((const char*)g.A + (GEMM_SAMETILE ? (size_t)0 : ((pm_) < g.nMA ? (size_t)(pm_) * tstepA : (size_t)((pm_) - g.nMA) * tstepA + (size_t)g.a2off)))
    const unsigned ldsw = (unsigned)wid * 1024u;
    const int aoff = lds_byte(wr * 64 + fr, fq * 8), boff = lds_byte(wc * 32 + fr, fq * 8);
#define PG8_SA(b, h) (((b) * 2 + (h)) * HTB)
#define PG8_SB(b, h) ((4 + (b) * 2 + (h)) * HTB)
#define PG8_STAGE(bufoff, gbase, voff) do { _Pragma("unroll") for (int _i = 0; _i < 2; ++_i) \
        __builtin_amdgcn_global_load_lds((const unsigned*)((const char*)(gbase) + (voff)[_i]), (PG8_LAS unsigned*)(lds + (bufoff) + ldsw + _i * 8192), 16, 0, 0); } while (0)
#define PG8_LDA(dst, b, h) do { _Pragma("unroll") for (int m = 0; m < 4; ++m) _Pragma("unroll") for (int k = 0; k < 2; ++k) dst[m][k] = *(const PG8_LAS bf16x8*)(lds + PG8_SA(b, h) + aoff + m * 2048 + k * 1024); } while (0)
#define PG8_LDB(dst, b, h) do { _Pragma("unroll") for (int n = 0; n < 2; ++n) _Pragma("unroll") for (int k = 0; k < 2; ++k) dst[n][k] = *(const PG8_LAS bf16x8*)(lds + PG8_SB(b, h) + boff + n * 2048 + k * 1024); } while (0)
#define PG8_MMA(ai, bj, At, Bt) do { __builtin_amdgcn_s_setprio(1); _Pragma("unroll") for (int m = 0; m < 4; ++m) _Pragma("unroll") for (int n = 0; n < 2; ++n) _Pragma("unroll") for (int k = 0; k < 2; ++k) \
        acc[ai][bj][m][n] = __builtin_amdgcn_mfma_f32_16x16x32_bf16(Bt[n][k], At[m][k], acc[ai][bj][m][n], 0, 0, 0); __builtin_amdgcn_s_setprio(0); } while (0)
#define PG8_WAIT_V(n) asm volatile("s_waitcnt vmcnt(" #n ")" ::: "memory")
#define PG8_WAIT_L(n) asm volatile("s_waitcnt lgkmcnt(" #n ")" ::: "memory")
#define PG8_BAR __builtin_amdgcn_s_barrier()
#define PG8_SCHED __builtin_amdgcn_sched_barrier(0)
    Unit cur, nxt; int ui = 0;
    if (!S.next(0, cur)) return;
    f32x4 acc[2][2][4][2];
#pragma unroll
    for (int a = 0; a < 2; ++a)
#pragma unroll
        for (int b = 0; b < 2; ++b)
#pragma unroll
            for (int m = 0; m < 4; ++m)
#pragma unroll
                for (int n = 0; n < 2; ++n) acc[a][b][m][n] = (f32x4){0.f, 0.f, 0.f, 0.f};
    bf16x8 At[4][2], B0[2][2], B1[2][2];
    static_assert(!HM || SP2, "half units: SP2 schedule only");
    bool chalf = HM && cur.hm != 0; size_t cH = chalf ? 0 : hstepA;
    const char* cA = PG8_ABASE(cur.pm) + ((HM && cur.hm == 2) ? hstepA : 0); const char* cB = (const char*)g.Bt + (GEMM_SAMETILE ? (size_t)0 : (size_t)cur.pn * tstep);
    S.a_ready(cur);
    if constexpr (SP2) {
        PG8_STAGE(PG8_SB(0, 0), cB, voffB); PG8_STAGE(PG8_SB(0, 1), cB + hstep, voffB); PG8_STAGE(PG8_SA(0, 0), cA, voffA); PG8_STAGE(PG8_SA(0, 1), cA + cH, voffA);
        if (wr == 1) PG8_BAR;
        PG8_WAIT_V(2); PG8_BAR;
        PG8_STAGE(PG8_SB(1, 0), cB + kstep, voffB); PG8_STAGE(PG8_SA(1, 0), cA + kstep, voffA); PG8_STAGE(PG8_SB(1, 1), cB + hstep + kstep, voffB);
        PG8_WAIT_V(6); PG8_BAR;
    } else {
        PG8_STAGE(PG8_SB(0, 0), cB, voffB); PG8_STAGE(PG8_SA(0, 0), cA, voffA); PG8_STAGE(PG8_SB(0, 1), cB + hstep, voffB); PG8_STAGE(PG8_SA(0, 1), cA + cH, voffA);
        if (wr == 1) PG8_BAR;
        PG8_WAIT_V(4); PG8_BAR;
        PG8_STAGE(PG8_SB(1, 0), cB + kstep, voffB); PG8_STAGE(PG8_SA(1, 0), cA + kstep, voffA); PG8_STAGE(PG8_SB(1, 1), cB + hstep + kstep, voffB);
        PG8_WAIT_V(6); PG8_BAR;
    }
    for (;;) {
        const bool has_next = S.next(ui + 1, nxt);
        const bool nhalf = has_next ? (HM && nxt.hm != 0) : chalf; const size_t nH = nhalf ? 0 : hstepA;
        const char* nA = has_next ? PG8_ABASE(nxt.pm) + ((HM && nxt.hm == 2) ? hstepA : 0) : cA; const char* nB = has_next ? (const char*)g.Bt + (GEMM_SAMETILE ? (size_t)0 : (size_t)nxt.pn * tstep) : cB;
        for (int t = 0; t < nt; t += 2) {
            const bool last = (t == nt - 2);
            const char* a1 = cA + (size_t)(t + 1) * kstep;
            const char* a2 = last ? nA : cA + (size_t)(t + 2) * kstep; const char* b2 = last ? nB : cB + (size_t)(t + 2) * kstep;
            const char* a3 = a2 + kstep; const char* b3 = b2 + kstep;
            const size_t h2 = last ? nH : cH;
            if (last && has_next) S.a_ready(nxt);
            if constexpr (SP2) {
            PG8_LDB(B0, 0, 0); PG8_LDB(B1, 0, 1); PG8_SCHED; PG8_LDA(At, 0, 0); PG8_STAGE(PG8_SA(1, 1), a1 + cH, voffA);
            PG8_WAIT_V(8); PG8_WAIT_L(0); PG8_BAR; PG8_MMA(0, 0, At, B0); PG8_MMA(0, 1, At, B1); PG8_BAR; PG8_SCHED;
            if (!chalf) PG8_LDA(At, 0, 1); PG8_STAGE(PG8_SB(0, 0), b2, voffB); PG8_STAGE(PG8_SB(0, 1), b2 + hstep, voffB); PG8_STAGE(PG8_SA(0, 0), a2, voffA);
            PG8_WAIT_V(8); PG8_WAIT_L(0); PG8_BAR; if (!chalf) { PG8_MMA(1, 0, At, B0); PG8_MMA(1, 1, At, B1); } PG8_BAR; PG8_SCHED;
            PG8_LDB(B0, 1, 0); PG8_LDB(B1, 1, 1); PG8_SCHED; PG8_LDA(At, 1, 0); PG8_STAGE(PG8_SA(0, 1), a2 + h2, voffA);
            PG8_WAIT_V(8); PG8_WAIT_L(0); PG8_BAR; PG8_MMA(0, 0, At, B0); PG8_MMA(0, 1, At, B1); PG8_BAR; PG8_SCHED;
            if (!chalf) PG8_LDA(At, 1, 1); PG8_STAGE(PG8_SB(1, 0), b3, voffB); PG8_STAGE(PG8_SB(1, 1), b3 + hstep, voffB); PG8_STAGE(PG8_SA(1, 0), a3, voffA);
            PG8_WAIT_V(8); PG8_WAIT_L(0); PG8_BAR; if (!chalf) { PG8_MMA(1, 0, At, B0); PG8_MMA(1, 1, At, B1); } PG8_BAR; PG8_SCHED;
            } else {
            PG8_LDB(B0, 0, 0); PG8_SCHED; PG8_LDA(At, 0, 0); PG8_STAGE(PG8_SA(1, 1), a1 + cH, voffA);
            PG8_WAIT_L(8); PG8_BAR; PG8_WAIT_L(0); PG8_MMA(0, 0, At, B0); PG8_BAR; PG8_SCHED;
            PG8_LDB(B1, 0, 1); PG8_STAGE(PG8_SB(0, 0), b2, voffB);
            PG8_BAR; PG8_WAIT_L(0); PG8_MMA(0, 1, At, B1); PG8_BAR;
            PG8_LDA(At, 0, 1); PG8_STAGE(PG8_SA(0, 0), a2, voffA);
            PG8_BAR; PG8_WAIT_L(0); PG8_MMA(1, 0, At, B0); PG8_BAR; PG8_SCHED;
            PG8_STAGE(PG8_SB(0, 1), b2 + hstep, voffB);
            PG8_WAIT_V(6); PG8_BAR; PG8_MMA(1, 1, At, B1); PG8_BAR;
            PG8_LDB(B0, 1, 0); PG8_SCHED; PG8_LDA(At, 1, 0); PG8_STAGE(PG8_SA(0, 1), a2 + h2, voffA);
            PG8_WAIT_L(8); PG8_BAR; PG8_WAIT_L(0); PG8_MMA(0, 0, At, B0); PG8_BAR; PG8_SCHED;
            PG8_LDB(B1, 1, 1); PG8_STAGE(PG8_SB(1, 0), b3, voffB);
            PG8_BAR; PG8_WAIT_L(0); PG8_MMA(0, 1, At, B1); PG8_BAR;
            PG8_LDA(At, 1, 1); PG8_STAGE(PG8_SA(1, 0), a3, voffA);
            PG8_BAR; PG8_WAIT_L(0); PG8_MMA(1, 0, At, B0); PG8_BAR; PG8_SCHED;
            PG8_STAGE(PG8_SB(1, 1), b3 + hstep, voffB);
            PG8_WAIT_V(6); PG8_BAR; PG8_MMA(1, 1, At, B1); PG8_BAR;
            }
        }
        if (Epi::SUBST) { SUBSTAMP(5) }
        if constexpr (ALIGN_EPI) { if (wr == 0) PG8_BAR; }
        if constexpr (!Epi::AFTER_DRAIN) { for (int er_ = 0; er_ < (Epi::PROBE_REP ? EPI_REP : 1); ++er_) { E(acc, cur, wr, wc, fr, fq); if (Epi::PROBE_REP && EPI_REP > 1) asm volatile("" ::: "memory"); } S.done(cur); }
        if (Epi::SUBST) { SUBSTAMP(6) }
        if (!has_next) break;
        if (!E.keep(cur)) {
#pragma unroll
        for (int a = 0; a < 2; ++a)
#pragma unroll
            for (int b = 0; b < 2; ++b)
#pragma unroll
                for (int m = 0; m < 4; ++m)
#pragma unroll
                    for (int n = 0; n < 2; ++n) acc[a][b][m][n] = (f32x4){0.f, 0.f, 0.f, 0.f};
        }
        cur = nxt; cA = nA; cB = nB; chalf = nhalf; cH = nH; ++ui;
        if constexpr (ALIGN_EPI) { if (wr == 1) PG8_BAR; }
    }
    PG8_WAIT_V(0);
    if constexpr (!ALIGN_EPI) { if (wr == 0) PG8_BAR; }
    PG8_BAR;
    if constexpr (Epi::AFTER_DRAIN) { E.fused(acc, cur, wr, wc, fr, fq, lds, wid, lane); S.done(cur); }
#undef PG8_ABASE
#undef PG8_SA
#undef PG8_SB
#undef PG8_STAGE
#undef PG8_LDA
#undef PG8_LDB
#undef PG8_MMA
#undef PG8_WAIT_V
#undef PG8_WAIT_L
#undef PG8_BAR
#undef PG8_SCHED
}
}

constexpr int NWAVES = 8;
#ifndef MK_N_LAUNCHES
#define MK_N_LAUNCHES 1
#endif
constexpr int PER_PHASE = 9;
constexpr int N_LAUNCHES = MK_N_LAUNCHES;

constexpr int BATCH = 4, SEQ = 4096, D = 1024, M = BATCH * SEQ;
constexpr int DN_H = 4, DN_D = 128, DN_W = 512, DN_QKV = 1536;
constexpr int SW_H = 8, SW_KV = 2, SW_D = 64, SW_W = 512, SW_KVW = 128, WINDOW = 128;
constexpr int FF = 2816;
constexpr int D_IN = 4872;
constexpr int NP = 4864;
constexpr int PC_Z = 1536, PC_SQ = 2048, PC_SK = 2560, PC_SV = 2688, PC_G = 2816;
constexpr int PC_YDN = 0, PC_YSW = 512;
constexpr float EPS = 1e-6f;

constexpr size_t MiB = 1u << 20;
constexpr size_t WS_CTL = 0, CTL_ZERO_BYTES = 65536;
constexpr size_t WS_WIN = 1 * MiB;
constexpr size_t WS_WAB = 11 * MiB;
constexpr size_t WS_WOUT = 13 * MiB;
constexpr size_t WS_WGU = 15 * MiB;
constexpr size_t WS_WD = 26 * MiB;
constexpr size_t WS_RSTD = 32 * MiB;
constexpr size_t WS_GB = WS_RSTD + 64 * 1024;
constexpr size_t WS_SSQ = 33 * MiB;
constexpr size_t WS_SSQ2 = WS_SSQ + 65536;
constexpr size_t WS_XB = 34 * MiB;
constexpr size_t WS_Y = 66 * MiB;
constexpr size_t WS_PROJ = 98 * MiB;
constexpr size_t WS_UB = 250 * MiB;
constexpr size_t WS_END = 256 * MiB;
static_assert(WS_PROJ + (size_t)M * NP * 2 <= WS_UB, "ws map");
constexpr int CW_TMO = 0, CW_SCAN = 1024  , CW_WCOPY = 3201  , CW_NORMDONE = 3202  , CW_SWADONE = 3200  , CW_BAR = 4096, CW_P56 = 8192  , CW_P67 = 12288, CW_PAN = 12288  ;

constexpr int RING_OFF = 0, RING_BYTES = 131072;
constexpr int LDSCTL_OFF = RING_BYTES, MISC_OFF = LDSCTL_OFF + 320;
constexpr int LDS_BYTES = 147456;

#define GAS __attribute__((address_space(1)))
#define LAS __attribute__((address_space(3)))
typedef unsigned short bf16;
typedef unsigned v4u __attribute__((ext_vector_type(4)));
typedef float f32x4 __attribute__((ext_vector_type(4)));
typedef float f32x2 __attribute__((ext_vector_type(2)));
typedef GAS unsigned gu32;
#define RLX_AGENT __ATOMIC_RELAXED, __HIP_MEMORY_SCOPE_AGENT
#define LDS_WAIT() asm volatile("s_waitcnt lgkmcnt(0)" ::: "memory")
#define VM_WAIT() asm volatile("s_waitcnt vmcnt(0)" ::: "memory")
__device__ __forceinline__ unsigned f2bf(float f) { unsigned u = __builtin_bit_cast(unsigned, f); return (u + 0x7fffu + ((u >> 16) & 1u)) >> 16; }
__device__ __forceinline__ unsigned pk2(float lo, float hi) { return f2bf(lo) | (f2bf(hi) << 16); }
__device__ __forceinline__ float bflo(unsigned w) { return __builtin_bit_cast(float, w << 16); }
__device__ __forceinline__ float bfhi(unsigned w) { return __builtin_bit_cast(float, w & 0xffff0000u); }
__device__ __forceinline__ float bf1(bf16 h) { return __builtin_bit_cast(float, (unsigned)h << 16); }
__device__ __forceinline__ float sigm(float x) { return __builtin_amdgcn_rcpf(1.0f + __expf(-x)); }
__device__ __forceinline__ float frsq(float x) { return __builtin_amdgcn_rsqf(x); }
template <int CTRL> __device__ __forceinline__ float dpp_mov(float v) { return __builtin_bit_cast(float, __builtin_amdgcn_update_dpp(0, __builtin_bit_cast(int, v), CTRL, 0xf, 0xf, true)); }
__device__ __forceinline__ float sum4(float v) { v += dpp_mov<0xB1>(v); v += dpp_mov<0x4E>(v); return v; }
__device__ __forceinline__ float sum8(float v) { v = sum4(v); v += dpp_mov<0x141>(v); return v; }
__device__ __forceinline__ float sum16(float v) { v = sum8(v); v += dpp_mov<0x140>(v); return v; }
__device__ __forceinline__ float rdlane(float v, int l) { return __builtin_bit_cast(float, __builtin_amdgcn_readlane(__builtin_bit_cast(int, v), l)); }
__device__ __forceinline__ float wave_sum(float v) { v = sum16(v); return (rdlane(v, 0) + rdlane(v, 16)) + (rdlane(v, 32) + rdlane(v, 48)); }
__device__ __forceinline__ float sum32(float v, int lane) { v = sum16(v); const float lo = rdlane(v, 0) + rdlane(v, 16), hi = rdlane(v, 32) + rdlane(v, 48); return (lane & 32) ? hi : lo; }
__device__ __forceinline__ float wave_max(float v) {
#pragma unroll
    for (int o = 1; o < 64; o <<= 1) v = fmaxf(v, __shfl_xor(v, o));
    return v;
}

#define XB_TMO      128
#define XB_XCNT(j)  (256  + 64 * (j))
#define XB_XSUB(j)  (1280 + 64 * (j))
#define XB_XGEN(j)  (2304 + 64 * (j))
#define XB_TOP      3328
#define XB_TOPGEN   3392
#define XCD_BAR_WORDS 3456
#define XB_SPIN_CAP (1u << 18)
__device__ __forceinline__ unsigned xb_ld(unsigned* p)              { return __hip_atomic_load(p, __ATOMIC_RELAXED, __HIP_MEMORY_SCOPE_AGENT); }
__device__ __forceinline__ unsigned xb_add(unsigned* p, unsigned v) { return __hip_atomic_fetch_add(p, v, __ATOMIC_RELAXED, __HIP_MEMORY_SCOPE_AGENT); }
__device__ __forceinline__ unsigned xb_xcc_id() { return (unsigned)__builtin_amdgcn_s_getreg((3 << 11) | 20) & 0xFu; }
#define XB_SPIN(cond, bar) do { unsigned _sp = 0; while (cond) { __builtin_amdgcn_s_sleep(1); \
    if ((++_sp & 255u) == 0u) { if (xb_ld(&(bar)[XB_TMO])) break; if (_sp > XB_SPIN_CAP) { atomicAdd(&(bar)[XB_TMO], 1u); break; } } } } while (0)
struct XcdBarrier { unsigned* bar; unsigned x; volatile LAS unsigned* st; };
__device__ __forceinline__ XcdBarrier xcd_barrier_post(unsigned* bar, volatile LAS unsigned* st) {
    XcdBarrier b; b.bar = bar; b.x = xb_xcc_id(); b.st = st;
    if (threadIdx.x == 0) (void)xb_add(&bar[XB_XCNT(b.x)], 1u);
    return b;
}
__device__ __forceinline__ void xcd_barrier_complete(unsigned* bar, unsigned x, unsigned& nloc, unsigned& nx) {
    const unsigned G = gridDim.x * gridDim.y * gridDim.z;
    unsigned sum, cnt, mine, sp = 0u;
    for (;;) {
        sum = 0u; cnt = 0u; mine = 0u;
#pragma unroll
        for (unsigned j = 0; j < 16; ++j) { const unsigned c = xb_ld(&bar[XB_XCNT(j)]); sum += c; cnt += (c > 0u) ? 1u : 0u; mine = (j == x) ? c : mine; }
        if (sum == G) break;
        __builtin_amdgcn_s_sleep(1);
        if ((++sp & 255u) == 0u) { if (xb_ld(&bar[XB_TMO])) break; if (sp > XB_SPIN_CAP) { atomicAdd(&bar[XB_TMO], 1u); break; } }
    }
    nloc = mine > 0u ? mine : 1u; nx = cnt > 0u ? cnt : 1u;
}
__device__ __forceinline__ void xcd_barrier(const XcdBarrier& b) {
    asm volatile("s_waitcnt vmcnt(0)" ::: "memory");
    __syncthreads();
    if (threadIdx.x == 0) {
        unsigned* bar = b.bar;
        __builtin_amdgcn_s_waitcnt(0);
        unsigned nloc = b.st[0], nx = b.st[1];
        if (nloc == 0u) { xcd_barrier_complete(bar, b.x, nloc, nx); b.st[0] = nloc; b.st[1] = nx; }
#if BAR_EARLY_WB
        asm volatile("buffer_wbl2 sc1" ::: "memory");
#endif
        const unsigned old = xb_add(&bar[XB_XSUB(b.x)], 1u);
        const unsigned gen = old / nloc;
        if (old + 1u == (gen + 1u) * nloc) {
            __builtin_amdgcn_fence(__ATOMIC_RELEASE, "agent");
            asm volatile("s_waitcnt vmcnt(0)" ::: "memory");
            const unsigned og = xb_add(&bar[XB_TOP], 1u);
            const unsigned tg = og / nx;
            if (og + 1u == (tg + 1u) * nx) xb_add(&bar[XB_TOPGEN], 1u);
            else XB_SPIN(xb_ld(&bar[XB_TOPGEN]) == tg, bar);
            __builtin_amdgcn_fence(__ATOMIC_ACQUIRE, "agent");
            xb_add(&bar[XB_XGEN(b.x)], 1u);
            asm volatile("s_waitcnt vmcnt(0)" ::: "memory");
        } else {
            XB_SPIN(xb_ld(&bar[XB_XGEN(b.x)]) == gen, bar);
            __builtin_amdgcn_fence(__ATOMIC_ACQUIRE, "agent");
            asm volatile("s_waitcnt vmcnt(0)" ::: "memory");
        }
    }
    __syncthreads();
}

struct Args { const float* in[18]; float* out; unsigned char* ws; int ph_lo, ph_hi, li, ws_mib; };
typedef const __attribute__((address_space(4))) Args* KArgs;
#define FIN(k) (F.ka->in[k])
struct Frame {
    LAS unsigned char* lds;
    volatile LAS unsigned* MISC;
    gu32* ctl;
    int tid, lane, wave;
    int vcu, G;
    KArgs ka; float* out; unsigned char* ws;
};
__device__ const unsigned char T5_BUCKET[128] = {0,1,2,3,4,5,6,7,8,9,10,11,12,13,14,15,16,16,16,17,17,18,18,18,19,19,19,20,20,20,20,21,21,21,21,22,22,22,22,22,23,23,23,23,23,23,24,24,24,24,24,24,25,25,25,25,25,25,25,26,26,26,26,26,26,26,26,27,27,27,27,27,27,27,27,27,27,28,28,28,28,28,28,28,28,28,28,29,29,29,29,29,29,29,29,29,29,29,29,30,30,30,30,30,30,30,30,30,30,30,30,30,30,31,31,31,31,31,31,31,31,31,31,31,31,31,31,31};

__device__ __forceinline__ int lcol32(int nb) { return 256 * (nb >> 3) + 32 * (2 * (nb & 3) + ((nb >> 2) & 1)); }
constexpr int WI_IN = 16 * (NP / 32), WI_AB = 8 * 32, WI_OUT = 16 * 32, WI_GU = 16 * (2 * FF / 32), WI_D = (FF / 64) * 32, WI_ALL = WI_IN + 2 * WI_AB + WI_OUT + WI_GU + WI_D, WI_P0 = SEAM35 ? (SEAM56 ? WI_IN + 2 * WI_AB + WI_OUT : WI_IN + 2 * WI_AB) : WI_IN;
struct WItem { const float* W; int ldw, src_col0, K; bf16* WT; int dst_row0; const float* gain; int kb; };
__device__ __forceinline__ WItem weight_item(Frame& F, int it) {
    unsigned char* ws = F.ws;
    bf16* WinT = (bf16*)(ws + WS_WIN); bf16* WabT = (bf16*)(ws + WS_WAB); bf16* WoutT = (bf16*)(ws + WS_WOUT); bf16* WguT = (bf16*)(ws + WS_WGU); bf16* WdT = (bf16*)(ws + WS_WD);
    int r = it;
    if (r < WI_IN) { const int nb = r % (NP / 32), kb = r / (NP / 32), dr = 32 * nb, lc = lcol32(nb); return WItem{FIN(2), D_IN, lc < 2048 ? lc : lc + 8, D, WinT, dr, FIN(1), kb}; } r -= WI_IN;
    if (r < WI_AB) { const int nb = r % 32, kb = r / 32; return WItem{FIN(11), D, lcol32(nb), DN_W, WabT, 32 * nb, nullptr, kb}; } r -= WI_AB;
    if (r < WI_AB) { const int nb = r % 32, kb = r / 32; return WItem{FIN(12), D, lcol32(nb), SW_W, WabT, 1024 + 32 * nb, nullptr, kb}; } r -= WI_AB;
    if (r < WI_OUT) { const int nb = r % 32, kb = r / 32; return WItem{FIN(13), D, 32 * nb, D, WoutT, 32 * nb, nullptr, kb}; } r -= WI_OUT;
    if (r < WI_GU) { const int nb = r % (2 * FF / 32), kb = r / (2 * FF / 32), dr = 32 * nb, pn = dr >> 8, j = dr & 255;
        return WItem{(j < 128) ? FIN(15) : FIN(16), FF, 128 * pn + (j & 127), D, WguT, dr, FIN(14), kb}; } r -= WI_GU;
    { const int nb = r % 32, kb = r / 32; return WItem{FIN(17), D, 32 * nb, FF, WdT, 32 * nb, nullptr, kb}; }
}
__device__ __forceinline__ void witem_load(const WItem& w, int lane, f32x4 (&v)[8], float (&gn)[8]) {
    const int k0 = 64 * w.kb, c4 = 4 * (lane & 7);
#pragma unroll
    for (int i = 0; i < 8; ++i) { const int kk = 8 * i + (lane >> 3); v[i] = *(const f32x4*)(w.W + (size_t)(k0 + kk) * w.ldw + w.src_col0 + c4); gn[i] = w.gain ? w.gain[k0 + kk] : 1.0f; }
}
__device__ __forceinline__ void witem_store(const WItem& w, int lane, const f32x4 (&v)[8], const float (&gn)[8], LAS float* scr) {
    const int k0 = 64 * w.kb, c4 = 4 * (lane & 7);
#pragma unroll
    for (int i = 0; i < 8; ++i) { const int kk = 8 * i + (lane >> 3);
        scr[kk * 33 + c4] = v[i].x * gn[i]; scr[kk * 33 + c4 + 1] = v[i].y * gn[i]; scr[kk * 33 + c4 + 2] = v[i].z * gn[i]; scr[kk * 33 + c4 + 3] = v[i].w * gn[i]; }
    LDS_WAIT(); asm volatile("" ::: "memory");
    const int c = lane & 7;
#pragma unroll
    for (int j = 0; j < 4; ++j) { const int n = (lane >> 3) + 8 * j; const LAS float* s = scr + (8 * c) * 33 + n;
        v4u o; o.x = pk2(s[0 * 33], s[1 * 33]); o.y = pk2(s[2 * 33], s[3 * 33]); o.z = pk2(s[4 * 33], s[5 * 33]); o.w = pk2(s[6 * 33], s[7 * 33]);
        if (SEAM67) asm volatile("global_store_dwordx4 %0, %1, off sc1\n\ts_nop 2" :: "v"((GAS v4u*)(w.WT + (size_t)(w.dst_row0 + n) * w.K + k0 + 8 * c)), "v"(o) : "memory");
        else *(GAS v4u*)(w.WT + (size_t)(w.dst_row0 + n) * w.K + k0 + 8 * c) = o; }
    LDS_WAIT(); asm volatile("" ::: "memory");
}
__device__ __forceinline__ void weight_copies(Frame& F, int lo, int hi, int gw, int NGW) {
    LAS float* scr = (LAS float*)(F.lds + RING_OFF + F.wave * 16384);
    int it = lo + gw; if (it >= hi) return;
    f32x4 vc[8]; float gc[8];
    WItem cur = weight_item(F, it); witem_load(cur, F.lane, vc, gc);
    for (;;) {
        const int nx = it + NGW; const bool more = nx < hi;
        f32x4 vn[8]; float gnx[8]; WItem nxt = cur;
        if (more) { nxt = weight_item(F, nx); witem_load(nxt, F.lane, vn, gnx); }
        witem_store(cur, F.lane, vc, gc, scr);
        if (!more) break;
#pragma unroll
        for (int i = 0; i < 8; ++i) { vc[i] = vn[i]; gc[i] = gnx[i]; }
        cur = nxt; it = nx;
    }
}
__device__ __forceinline__ void p0_prologue(Frame& F) {
    const int gw = F.vcu * NWAVES + F.wave, NGW = F.G * NWAVES;
    unsigned char* ws = F.ws;
    weight_copies(F, 0, (F.G == 256 && DEFER_WEIGHTS) ? WI_P0 : WI_ALL, gw, NGW);
    __syncthreads();
    LAS float* wba = (LAS float*)(F.lds + RING_OFF);
    for (int idx = F.tid; idx < 8 * D; idx += NWAVES * 64) { const int k = idx >> 3, j = idx & 7; wba[j * D + k] = FIN(2)[(size_t)k * D_IN + 2048 + j] * FIN(1)[k]; }
    __syncthreads();
    const float* x = FIN(0); bf16* XB = (bf16*)(ws + WS_XB); float* rstd1 = (float*)(ws + WS_RSTD); float* gbp = (float*)(ws + WS_GB); float* ssq2 = (float*)(ws + WS_SSQ2);
    const float alog_or_dt = (F.lane & 32) ? FIN(5)[(F.lane >> 3) & 3] : 0.f;
    const float negA = -expf(FIN(4)[(F.lane >> 3) & 3]);
#if P0_DEEP
    auto do_row = [&](const f32x4 (&v)[4], int m) {
        float ss = 0.f;
#pragma unroll
        for (int j = 0; j < 4; ++j) ss += (v[j].x * v[j].x + v[j].y * v[j].y) + (v[j].z * v[j].z + v[j].w * v[j].w);
        GAS unsigned long long* o8 = (GAS unsigned long long*)(XB + (size_t)m * D) + F.lane;
#pragma unroll
        for (int j = 0; j < 4; ++j) { const unsigned long long w = (unsigned long long)pk2(v[j].x, v[j].y) | ((unsigned long long)pk2(v[j].z, v[j].w) << 32);
            asm volatile("global_store_dwordx2 %0, %1, off" :: "v"(o8 + 64 * j), "v"(w) : "memory"); }
        float acc[8];
#pragma unroll
        for (int c = 0; c < 8; ++c) { float a = 0.f;
#pragma unroll
            for (int j = 0; j < 4; ++j) { const f32x4 w = *(const LAS f32x4*)(wba + c * D + 256 * j + 4 * F.lane); a += (v[j].x * w.x + v[j].y * w.y) + (v[j].z * w.z + v[j].w * w.w); }
            acc[c] = a; }
        ss = wave_sum(ss);
        float r4[4], r2[2], r1;
        { const bool up = (F.lane & 32) != 0;
#pragma unroll
          for (int i = 0; i < 4; ++i) { const float keep = up ? acc[4 + i] : acc[i], send = up ? acc[i] : acc[4 + i]; r4[i] = keep + __shfl_xor(send, 32); } }
        { const bool up = (F.lane & 16) != 0;
#pragma unroll
          for (int i = 0; i < 2; ++i) { const float keep = up ? r4[2 + i] : r4[i], send = up ? r4[i] : r4[2 + i]; r2[i] = keep + __shfl_xor(send, 16); } }
        { const bool up = (F.lane & 8) != 0; const float keep = up ? r2[1] : r2[0], send = up ? r2[0] : r2[1]; r1 = keep + __shfl_xor(send, 8); }
        r1 = sum8(r1);
        const float rstd = frsq(ss * (1.0f / D) + EPS);
        if (F.lane == 0) { asm volatile("global_store_dword %0, %1, off" :: "v"((GAS float*)(rstd1 + m)), "v"(rstd) : "memory"); asm volatile("global_store_dword %0, %1, off" :: "v"((GAS float*)(ssq2 + m)), "v"(0.f) : "memory"); }
        if ((F.lane & 7) == 0) {
            const float val = r1 * rstd; float res;
            if (F.lane < 32) res = 1.0f / (1.0f + expf(-val));
            else { const float xx = val + alog_or_dt; const float sp = xx > 20.f ? xx : log1pf(expf(xx)); res = negA * sp; }
            asm volatile("global_store_dword %0, %1, off" :: "v"((GAS float*)(gbp + (size_t)m * 8 + (F.lane >> 3))), "v"(res) : "memory");
        }
    };
    f32x4 qa[4], qb[4];
#pragma unroll
    for (int j = 0; j < 4; ++j) { qa[j] = (f32x4){0.f, 0.f, 0.f, 0.f}; qb[j] = qa[j]; }
    if (gw < M) {
#pragma unroll
        for (int j = 0; j < 4; ++j) qa[j] = ((const GAS f32x4*)(x + (size_t)gw * D) + F.lane)[64 * j]; }
    if (gw + NGW < M) {
#pragma unroll
        for (int j = 0; j < 4; ++j) qb[j] = ((const GAS f32x4*)(x + (size_t)(gw + NGW) * D) + F.lane)[64 * j]; }
    for (int m = gw; m < M; m += 2 * NGW) {
        f32x4 v[4];
#pragma unroll
        for (int j = 0; j < 4; ++j) v[j] = qa[j];
        if (m + 2 * NGW < M) {
#pragma unroll
            for (int j = 0; j < 4; ++j) qa[j] = ((const GAS f32x4*)(x + (size_t)(m + 2 * NGW) * D) + F.lane)[64 * j]; }
        do_row(v, m);
        if (m + NGW < M) {
#pragma unroll
            for (int j = 0; j < 4; ++j) v[j] = qb[j];
            if (m + 3 * NGW < M) {
#pragma unroll
                for (int j = 0; j < 4; ++j) qb[j] = ((const GAS f32x4*)(x + (size_t)(m + 3 * NGW) * D) + F.lane)[64 * j]; }
            do_row(v, m + NGW);
        }
    }
}
#else
    f32x4 vnx[4];
    if (gw < M) {
#pragma unroll
        for (int j = 0; j < 4; ++j) vnx[j] = ((const GAS f32x4*)(x + (size_t)gw * D) + F.lane)[64 * j]; }
    for (int m = gw; m < M; m += NGW) {
        f32x4 v[4]; float ss = 0.f;
#pragma unroll
        for (int j = 0; j < 4; ++j) { v[j] = vnx[j]; ss += (v[j].x * v[j].x + v[j].y * v[j].y) + (v[j].z * v[j].z + v[j].w * v[j].w); }
        if (m + NGW < M) {
#pragma unroll
            for (int j = 0; j < 4; ++j) vnx[j] = ((const GAS f32x4*)(x + (size_t)(m + NGW) * D) + F.lane)[64 * j]; }
        GAS unsigned long long* o8 = (GAS unsigned long long*)(XB + (size_t)m * D) + F.lane;
#pragma unroll
        for (int j = 0; j < 4; ++j) o8[64 * j] = (unsigned long long)pk2(v[j].x, v[j].y) | ((unsigned long long)pk2(v[j].z, v[j].w) << 32);
        float acc[8];
#pragma unroll
        for (int c = 0; c < 8; ++c) { float a = 0.f;
#pragma unroll
            for (int j = 0; j < 4; ++j) { const f32x4 w = *(const LAS f32x4*)(wba + c * D + 256 * j + 4 * F.lane); a += (v[j].x * w.x + v[j].y * w.y) + (v[j].z * w.z + v[j].w * w.w); }
            acc[c] = a; }
        ss = wave_sum(ss);
        float r4[4], r2[2], r1;
        { const bool up = (F.lane & 32) != 0;
#pragma unroll
          for (int i = 0; i < 4; ++i) { const float keep = up ? acc[4 + i] : acc[i], send = up ? acc[i] : acc[4 + i]; r4[i] = keep + __shfl_xor(send, 32); } }
        { const bool up = (F.lane & 16) != 0;
#pragma unroll
          for (int i = 0; i < 2; ++i) { const float keep = up ? r4[2 + i] : r4[i], send = up ? r4[i] : r4[2 + i]; r2[i] = keep + __shfl_xor(send, 16); } }
        { const bool up = (F.lane & 8) != 0; const float keep = up ? r2[1] : r2[0], send = up ? r2[0] : r2[1]; r1 = keep + __shfl_xor(send, 8); }
        r1 = sum8(r1);
        const float rstd = frsq(ss * (1.0f / D) + EPS);
        if (F.lane == 0) { rstd1[m] = rstd; ssq2[m] = 0.f; }
        if ((F.lane & 7) == 0) {
            const float val = r1 * rstd; float res;
            if (F.lane < 32) res = 1.0f / (1.0f + expf(-val));
            else { const float xx = val + alog_or_dt; const float sp = xx > 20.f ? xx : log1pf(expf(xx)); res = negA * sp; }
            gbp[(size_t)m * 8 + (F.lane >> 3)] = res;
        }
    }
}
#endif

__device__ __forceinline__ void dn_pre(Frame& F) {
    const int gw = F.vcu * NWAVES + F.wave, NGW = F.G * NWAVES;
    const bf16* proj = (const bf16*)(F.ws + WS_PROJ); const float* conv = FIN(3);
    float* QN = F.out; float* KN = F.out + (size_t)M * DN_W; float* VV = (float*)(F.ws + WS_XB);
    for (int task = gw; task < M * DN_H; task += NGW) {
        const int m = task >> 2, h = task & 3, t = m & (SEQ - 1);
        float val[3][2];
#pragma unroll
        for (int part = 0; part < 3; ++part) { const int col = part * DN_W + h * DN_D + 2 * F.lane; float a0 = 0.f, a1 = 0.f;
#pragma unroll
            for (int j = 0; j < 4; ++j) { if (t - 3 + j >= 0) { const unsigned w = *(const unsigned*)(proj + (size_t)(m - 3 + j) * NP + col); a0 += conv[j * DN_QKV + col] * bflo(w); a1 += conv[j * DN_QKV + col + 1] * bfhi(w); } }
            val[part][0] = a0 * sigm(a0); val[part][1] = a1 * sigm(a1); }
        const float rq = 1.0f / sqrtf(wave_sum(val[0][0] * val[0][0] + val[0][1] * val[0][1]) + EPS) * 0.08838834764831845f;
        const float rk = 1.0f / sqrtf(wave_sum(val[1][0] * val[1][0] + val[1][1] * val[1][1]) + EPS);
        const size_t o = (size_t)m * DN_W + h * DN_D + 2 * F.lane;
        *(f32x2*)(QN + o) = (f32x2){val[0][0] * rq, val[0][1] * rq};
        *(f32x2*)(KN + o) = (f32x2){val[1][0] * rk, val[1][1] * rk};
        *(f32x2*)(VV + o) = (f32x2){val[2][0], val[2][1]};
    }
}
__device__ __forceinline__ void dn_scan_naive(Frame& F, int bh) {
    const int b = bh >> 2, h = bh & 3, tid = F.tid, dvi = tid >> 2, kq = tid & 3;
    LAS float* kL = (LAS float*)(F.lds + RING_OFF); LAS float* qL = kL + 32 * 128; LAS float* vL = qL + 32 * 128; LAS float* gL = vL + 32 * 128; LAS float* bL = gL + 32;
    const float* QN = F.out; const float* KN = F.out + (size_t)M * DN_W; float* VV = (float*)(F.ws + WS_XB); const float* gbp = (const float*)(F.ws + WS_GB);
    float S[32];
#pragma unroll
    for (int j = 0; j < 32; ++j) S[j] = 0.f;
    for (int t0 = 0; t0 < SEQ; t0 += 32) {
#pragma unroll
        for (int r = 0; r < 2; ++r) { const int idx = tid + 512 * r, tok = idx >> 5, c4 = idx & 31; const size_t src = (size_t)(b * SEQ + t0 + tok) * DN_W + h * DN_D + c4 * 4;
            *(LAS f32x4*)(kL + tok * 128 + c4 * 4) = *(const f32x4*)(KN + src); *(LAS f32x4*)(qL + tok * 128 + c4 * 4) = *(const f32x4*)(QN + src); *(LAS f32x4*)(vL + tok * 128 + c4 * 4) = *(const f32x4*)(VV + src); }
        if (tid < 32) { const size_t mm = (size_t)(b * SEQ + t0 + tid); bL[tid] = gbp[mm * 8 + h]; gL[tid] = gbp[mm * 8 + 4 + h]; }
        __syncthreads();
        for (int i = 0; i < 32; ++i) {
            const float eg = __expf(gL[i]), be = bL[i];
            float kk[32];
#pragma unroll
            for (int j = 0; j < 8; ++j) { const f32x4 w = *(const LAS f32x4*)(kL + i * 128 + kq * 32 + 4 * j); kk[4 * j] = w.x; kk[4 * j + 1] = w.y; kk[4 * j + 2] = w.z; kk[4 * j + 3] = w.w; }
            float part = 0.f;
#pragma unroll
            for (int j = 0; j < 32; ++j) part += kk[j] * S[j];
            part += __shfl_xor(part, 1); part += __shfl_xor(part, 2);
            const float c = be * (vL[i * 128 + dvi] - eg * part);
#pragma unroll
            for (int j = 0; j < 32; ++j) S[j] = eg * S[j] + c * kk[j];
            float po = 0.f;
#pragma unroll
            for (int j = 0; j < 8; ++j) { const f32x4 w = *(const LAS f32x4*)(qL + i * 128 + kq * 32 + 4 * j); po += (w.x * S[4 * j] + w.y * S[4 * j + 1]) + (w.z * S[4 * j + 2] + w.w * S[4 * j + 3]); }
            po += __shfl_xor(po, 1); po += __shfl_xor(po, 2);
            if (kq == 0) vL[i * 128 + dvi] = po;
        }
        __syncthreads();
#pragma unroll
        for (int r = 0; r < 2; ++r) { const int idx = tid + 512 * r, tok = idx >> 5, c4 = idx & 31; const size_t src = (size_t)(b * SEQ + t0 + tok) * DN_W + h * DN_D + c4 * 4;
            *(f32x4*)(VV + src) = *(const LAS f32x4*)(vL + tok * 128 + c4 * 4); }
        __syncthreads();
    }
}
__device__ __forceinline__ void swa_naive(Frame& F, int wv, int nworkers) {
    const bf16* proj = (const bf16*)(F.ws + WS_PROJ); bf16* YSWA = (bf16*)(F.ws + WS_Y) + (size_t)M * SW_W;
    LAS float* qs = (LAS float*)(F.lds + RING_OFF + 65536 + F.wave * 1024); LAS float* ps = qs + 64;
    const float* qg = FIN(7); const float* kg = FIN(8); const float* sinks = FIN(9); const float* relb = FIN(10);
    const int lane = F.lane;
    for (int task = wv; task < M * SW_H; task += nworkers) {
        const int m = task >> 3, qh = task & 7, kvh = qh >> 2, t = m & (SEQ - 1);
        const float q = bf1(proj[(size_t)m * NP + PC_SQ + qh * SW_D + lane]);
        const float qn = q * (1.0f / sqrtf(wave_sum(q * q) * (1.0f / SW_D) + EPS)) * qg[lane];
        qs[lane] = qn * kg[lane];
        LDS_WAIT(); asm volatile("" ::: "memory");
        float lg[2];
#pragma unroll
        for (int hf = 0; hf < 2; ++hf) { const int j = lane + 64 * hf; lg[hf] = -INFINITY;
            if (t - 127 + j >= 0) { const v4u* kr = (const v4u*)(proj + (size_t)(m - 127 + j) * NP + PC_SK + kvh * SW_D); float ssk = 0.f, dot = 0.f;
#pragma unroll
                for (int c = 0; c < 8; ++c) { const v4u w = kr[c];
#pragma unroll
                    for (int e = 0; e < 4; ++e) { const float k0 = bflo(w[e]), k1 = bfhi(w[e]); ssk += k0 * k0 + k1 * k1; dot += qs[8 * c + 2 * e] * k0 + qs[8 * c + 2 * e + 1] * k1; } }
                lg[hf] = dot * (1.0f / sqrtf(ssk * (1.0f / SW_D) + EPS)) * 0.125f + relb[(int)T5_BUCKET[127 - j] * SW_H + qh]; } }
        const float sink = sinks[qh];
        const float mx = fmaxf(wave_max(fmaxf(lg[0], lg[1])), sink);
        const float p0 = (lg[0] == -INFINITY) ? 0.f : __expf(lg[0] - mx), p1 = (lg[1] == -INFINITY) ? 0.f : __expf(lg[1] - mx);
        const float den = wave_sum(p0 + p1) + __expf(sink - mx);
        ps[lane] = p0; ps[lane + 64] = p1;
        LDS_WAIT(); asm volatile("" ::: "memory");
        float o = 0.f; const int jmin = (127 - t) > 0 ? (127 - t) : 0;
        for (int j = jmin; j < 128; ++j) o += ps[j] * bf1(proj[(size_t)(m - 127 + j) * NP + PC_SV + kvh * SW_D + lane]);
        YSWA[(size_t)m * SW_W + qh * SW_D + lane] = (bf16)f2bf(o / den);
        LDS_WAIT(); asm volatile("" ::: "memory");
    }
}
__device__ __forceinline__ void dn_out(Frame& F) {
    const int gw = F.vcu * NWAVES + F.wave, NGW = F.G * NWAVES;
    const bf16* proj = (const bf16*)(F.ws + WS_PROJ); const float* VV = (const float*)(F.ws + WS_XB); bf16* YDN = (bf16*)(F.ws + WS_Y); const float* gain = FIN(6);
    for (int task = gw; task < M * DN_H; task += NGW) {
        const int m = task >> 2, h = task & 3;
        const f32x2 o = *(const f32x2*)(VV + (size_t)m * DN_W + h * DN_D + 2 * F.lane);
        const float r = 1.0f / sqrtf(wave_sum(o.x * o.x + o.y * o.y) * (1.0f / DN_D) + EPS);
        const unsigned zw = *(const unsigned*)(proj + (size_t)m * NP + PC_Z + h * DN_D + 2 * F.lane); const float z0 = bflo(zw), z1 = bfhi(zw);
        *(unsigned*)(YDN + (size_t)m * DN_W + h * DN_D + 2 * F.lane) = pk2(o.x * r * gain[2 * F.lane] * z0 * sigm(z0), o.y * r * gain[2 * F.lane + 1] * z1 * sigm(z1));
    }
}

typedef short bf16x8 __attribute__((ext_vector_type(8)));
typedef float f32x16 __attribute__((ext_vector_type(16)));
typedef unsigned u32x2 __attribute__((ext_vector_type(2)));
typedef __bf16 bf16x2_t __attribute__((ext_vector_type(2)));
__device__ __forceinline__ unsigned cvtpk(float lo, float hi) { f32x2 v = {lo, hi}; return __builtin_bit_cast(unsigned, __builtin_convertvector(v, bf16x2_t)); }
__device__ __forceinline__ bf16x8 pack8(f32x4 a, f32x4 b) { v4u w; w.x = cvtpk(a[0], a[1]); w.y = cvtpk(a[2], a[3]); w.z = cvtpk(b[0], b[1]); w.w = cvtpk(b[2], b[3]); return __builtin_bit_cast(bf16x8, w); }
__device__ __forceinline__ bf16x8 pack8z(f32x4 a) { v4u w; w.x = cvtpk(a[0], a[1]); w.y = cvtpk(a[2], a[3]); w.z = 0u; w.w = 0u; return __builtin_bit_cast(bf16x8, w); }
#define MFMA16(a, b, c) __builtin_amdgcn_mfma_f32_16x16x32_bf16((a), (b), (c), 0, 0, 0)
#define MFMA32(a, b, c) __builtin_amdgcn_mfma_f32_32x32x16_bf16((a), (b), (c), 0, 0, 0)
constexpr float LOG2E = 1.4426950408889634f;

__device__ __forceinline__ void swa_pre(Frame& F) {
    const int gw = F.vcu * NWAVES + F.wave, NGW = F.G * NWAVES, lane = F.lane;
    const bf16* proj = (const bf16*)(F.ws + WS_PROJ);
    bf16* KS = (bf16*)(F.ws + WS_Y); bf16* VT = KS + 2 * 1024 * 1024; bf16* QS = (bf16*)(F.ws + WS_Y) + (size_t)M * SW_W;
    const float* qg = FIN(7); const float* kg = FIN(8);
    v4u wq_n = {0u, 0u, 0u, 0u}; unsigned wk_n = 0u;
    if (!FUSE_QKNORM && gw < M) { wq_n = *(const v4u*)(proj + (size_t)gw * NP + PC_SQ + 8 * lane); wk_n = *(const unsigned*)(proj + (size_t)gw * NP + PC_SK + 2 * lane); }
    const f32x4 g0 = *(const f32x4*)(qg + 8 * (lane & 7)), g1 = *(const f32x4*)(qg + 8 * (lane & 7) + 4);
    const float kg0 = kg[2 * (lane & 31)], kg1 = kg[2 * (lane & 31) + 1];
    if (!FUSE_QKNORM)
    for (int m = gw; m < M; m += NGW) {
        const v4u w = wq_n; const unsigned wk = wk_n;
        if (m + NGW < M) { wq_n = *(const v4u*)(proj + (size_t)(m + NGW) * NP + PC_SQ + 8 * lane); wk_n = *(const unsigned*)(proj + (size_t)(m + NGW) * NP + PC_SK + 2 * lane); }
        {
            float x[8];
#pragma unroll
            for (int j = 0; j < 4; ++j) { x[2 * j] = bflo(w[j]); x[2 * j + 1] = bfhi(w[j]); }
            float ss = 0.f;
#pragma unroll
            for (int j = 0; j < 8; ++j) ss += x[j] * x[j];
            ss = sum8(ss);
            const float r = frsq(ss * (1.0f / SW_D) + EPS) * (0.125f * LOG2E);
            v4u o; o.x = cvtpk(x[0] * r * g0[0], x[1] * r * g0[1]); o.y = cvtpk(x[2] * r * g0[2], x[3] * r * g0[3]); o.z = cvtpk(x[4] * r * g1[0], x[5] * r * g1[1]); o.w = cvtpk(x[6] * r * g1[2], x[7] * r * g1[3]);
            *(v4u*)(QS + (size_t)m * SW_W + 8 * lane) = o;
        }
        {
            const float k0 = bflo(wk), k1 = bfhi(wk);
            float ss = k0 * k0 + k1 * k1;
            ss = sum32(ss, lane);
            const float r = frsq(ss * (1.0f / SW_D) + EPS); const int d = 2 * (lane & 31), b = m >> 12, t = m & (SEQ - 1), kvh = lane >> 5;
            *(unsigned*)(KS + ((size_t)(b * 2 + kvh) * SEQ + t) * SW_D + d) = cvtpk(k0 * r * kg0, k1 * r * kg1);
        }
    }
    for (int task = gw; task < BATCH * SW_KV * (SEQ / 32); task += NGW) {
        const int bk = task >> 7, tile = task & 127, b = bk >> 1, kvh = bk & 1; const size_t m0 = (size_t)b * SEQ + tile * 32;
        unsigned v[32];
#pragma unroll
        for (int i = 0; i < 32; ++i) v[i] = proj[(m0 + i) * NP + PC_SV + kvh * SW_D + lane];
        bf16* dst = VT + ((size_t)(bk * 128 + tile) * 64 + lane) * 32;
#pragma unroll
        for (int q4 = 0; q4 < 4; ++q4) { v4u o;
#pragma unroll
            for (int jj = 0; jj < 4; ++jj) { const int p0 = 8 * q4 + 2 * jj, p1 = p0 + 1;
                const int k0 = 16 * (p0 >> 4) + 8 * ((p0 & 7) >> 2) + 4 * ((p0 >> 3) & 1) + (p0 & 3), k1 = 16 * (p1 >> 4) + 8 * ((p1 & 7) >> 2) + 4 * ((p1 >> 3) & 1) + (p1 & 3);
                o[jj] = v[k0] | (v[k1] << 16); }
            *(v4u*)(dst + 8 * q4) = o; }
    }
}
__device__ __forceinline__ void swa_bias_table(Frame& F) {
    LAS float* biasT = (LAS float*)(F.lds + RING_OFF);
    for (int idx = F.tid; idx < SW_H * 128; idx += NWAVES * 64) { const int h = idx >> 7, dist = idx & 127; biasT[idx] = FIN(10)[(int)T5_BUCKET[dist] * SW_H + h] * LOG2E; }
}
__device__ __forceinline__ void swa_main(Frame& F, int worker, int nworkers) {
    const LAS float* biasT = (const LAS float*)(F.lds + RING_OFF);
    const bf16* KS = (const bf16*)(F.ws + WS_Y); const bf16* VT = KS + 2 * 1024 * 1024; const bf16* QS = (const bf16*)(F.ws + WS_Y) + (size_t)M * SW_W;
    bf16* YSW = (bf16*)(F.ws + WS_PROJ) + PC_YSW;
    const int lane = F.lane, l31 = lane & 31, hh = lane >> 5;
    for (int u = worker; u < BATCH * SW_H * (SEQ / 32); u += nworkers) {
        const int qblk = u & 127, h = (u >> 7) & 7, b = u >> 10, kvh = h >> 2, bk = b * 2 + kvh, q0 = qblk * 32; const size_t m0 = (size_t)b * SEQ + q0;
        bf16x8 qf[4], kf[5][4];
#pragma unroll
        for (int ks = 0; ks < 4; ++ks) qf[ks] = *(const bf16x8*)(QS + (m0 + l31) * SW_W + h * SW_D + 16 * ks + 8 * hh);
#pragma unroll
        for (int i = 0; i < 5; ++i) { const int ts = q0 - 128 + 32 * i, tsc = ts < 0 ? 0 : ts;
#pragma unroll
            for (int ks = 0; ks < 4; ++ks) kf[i][ks] = *(const bf16x8*)(KS + ((size_t)bk * SEQ + tsc + l31) * SW_D + 16 * ks + 8 * hh); }
        __builtin_amdgcn_sched_barrier(0);
        f32x16 s[5];
#pragma unroll
        for (int i = 0; i < 5; ++i) {
            const int ts = q0 - 128 + 32 * i;
            f32x16 acc;
#pragma unroll
            for (int r = 0; r < 16; ++r) acc[r] = 0.f;
#pragma unroll
            for (int ks = 0; ks < 4; ++ks) acc = MFMA32(kf[i][ks], qf[ks], acc);
#pragma unroll
            for (int r = 0; r < 16; ++r) { const int row = (r & 3) + 8 * (r >> 2) + 4 * hh, dist = 128 - 32 * i + l31 - row; const bool ok = ts >= 0 && dist >= 0 && dist <= 127;
                s[i][r] = ok ? acc[r] + biasT[h * 128 + (dist & 127)] : -INFINITY; }
        }
        bf16x8 vf[5][2][2];
#pragma unroll
        for (int i = 0; i < 5; ++i) { const int ts = q0 - 128 + 32 * i, tsc = ts < 0 ? 0 : ts;
#pragma unroll
            for (int s2 = 0; s2 < 2; ++s2)
#pragma unroll
                for (int nt = 0; nt < 2; ++nt) vf[i][s2][nt] = *(const bf16x8*)(VT + ((size_t)(bk * 128 + (tsc >> 5)) * 64 + 32 * nt + l31) * 32 + s2 * 16 + hh * 8); }
        __builtin_amdgcn_sched_barrier(0);
        const float sink2 = FIN(9)[h] * LOG2E;
        float mx = sink2;
#pragma unroll
        for (int i = 0; i < 5; ++i)
#pragma unroll
            for (int r = 0; r < 16; ++r) mx = fmaxf(mx, s[i][r]);
        mx = fmaxf(mx, __shfl_xor(mx, 32));
        float sum = 0.f;
#pragma unroll
        for (int i = 0; i < 5; ++i)
#pragma unroll
            for (int r = 0; r < 16; ++r) { const float p = __builtin_amdgcn_exp2f(s[i][r] - mx); s[i][r] = p; sum += p; }
        sum += __shfl_xor(sum, 32);
        const float inv = __builtin_amdgcn_rcpf(sum + __builtin_amdgcn_exp2f(sink2 - mx));
        f32x16 O[2];
#pragma unroll
        for (int r = 0; r < 16; ++r) { O[0][r] = 0.f; O[1][r] = 0.f; }
#pragma unroll
        for (int i = 0; i < 5; ++i) {
#pragma unroll
            for (int s2 = 0; s2 < 2; ++s2) {
                v4u w; w.x = cvtpk(s[i][8 * s2] * inv, s[i][8 * s2 + 1] * inv); w.y = cvtpk(s[i][8 * s2 + 2] * inv, s[i][8 * s2 + 3] * inv); w.z = cvtpk(s[i][8 * s2 + 4] * inv, s[i][8 * s2 + 5] * inv); w.w = cvtpk(s[i][8 * s2 + 6] * inv, s[i][8 * s2 + 7] * inv);
                const bf16x8 pa = __builtin_bit_cast(bf16x8, w);
#pragma unroll
                for (int nt = 0; nt < 2; ++nt) O[nt] = MFMA32(pa, vf[i][s2][nt], O[nt]);
            }
        }
        {
            LAS unsigned char* stg = F.lds + RING_OFF + 8192 + F.wave * 4608;
#pragma unroll
            for (int nt = 0; nt < 2; ++nt)
#pragma unroll
                for (int r = 0; r < 16; ++r) { const int q = (r & 3) + 8 * (r >> 2) + 4 * hh; *(LAS unsigned short*)(stg + q * 144 + (32 * nt + l31) * 2) = (unsigned short)(cvtpk(O[nt][r], 0.f) & 0xffffu); }
            asm volatile("s_waitcnt lgkmcnt(0)" ::: "memory");
#pragma unroll
            for (int i = 0; i < 4; ++i) { const int row = 8 * i + (lane >> 3), ch16 = lane & 7; const v4u v = *(const LAS v4u*)(stg + row * 144 + ch16 * 16);
                if (SEAM35) { GAS v4u* dst = (GAS v4u*)(YSW + (m0 + row) * NP + h * SW_D + ch16 * 8); asm volatile("global_store_dwordx4 %0, %1, off sc1\n\ts_nop 2" :: "v"(dst), "v"(v) : "memory"); }
                else *(v4u*)(YSW + (m0 + row) * NP + h * SW_D + ch16 * 8) = v; }
            asm volatile("s_waitcnt lgkmcnt(0)" ::: "memory");
        }
    }
#if SEAM35
    asm volatile("s_waitcnt vmcnt(0)" ::: "memory");
    unsigned nun = 0u;
    for (int u = worker; u < BATCH * SW_H * (SEQ / 32); u += nworkers) { const int qblk = u & 127, b = u >> 10; ++nun;
        if (lane == 0) __hip_atomic_fetch_add(F.ctl + CW_PAN + 64 * (b * 16 + (qblk >> 3)) + 1, 1u, RLX_AGENT); }
    if (lane == 0 && nun) __hip_atomic_fetch_add(F.ctl + CW_SWADONE + 64 * (worker & 7), nun, RLX_AGENT);
#endif
}

constexpr int DNL_QT = 0, DNL_KT = 17408, DNL_VT = 34816, DNL_WL = 52224, DNL_NA = 69632, DNL_QKM = 78848, DNL_DB = 88064, DNL_TIB = 92160, DNL_GC = 94208, DNL_BETA = 94464;
constexpr int TP = 272;
constexpr int NP2 = 144;
struct DnRec { bf16* UA; bf16* UB; bf16* W; bf16* QG; bf16* KD; bf16* QK; float* EGL;
    __device__ __forceinline__ bf16* u(int ch, int sl, int mt, int lane) const { return (ch < 640 ? UA + (size_t)ch * 8192 : UB + (size_t)(ch - 640) * 8192) + ((sl * 4 + mt) * 64 + lane) * 4; } };
__device__ __forceinline__ DnRec dn_rec(Frame& F) {
    DnRec r; r.W = (bf16*)F.out; r.QG = r.W + 8 * 1024 * 1024; r.KD = r.W + 16 * 1024 * 1024; r.QK = r.W + 24 * 1024 * 1024; r.UA = r.W + 27 * 1024 * 1024; r.UB = (bf16*)(F.ws + WS_UB); r.EGL = (float*)(F.ws + WS_SSQ); return r;
}
#if STAMP_DN >= 0
__device__ unsigned long long g_dn[8];
#define DNSTAMP(i) if (blockIdx.x == STAMP_BLOCK && threadIdx.x == 0) { const unsigned long long now_ = __builtin_amdgcn_s_memrealtime(); dnacc_[i] += now_ - dnlast_; dnlast_ = now_; }
#else
#define DNSTAMP(i)
#endif
__device__ __forceinline__ void dn_chunk_prep(Frame& F) {
#if STAMP_DN >= 0
    unsigned long long dnacc_[8] = {0, 0, 0, 0, 0, 0, 0, 0}; unsigned long long dnlast_ = __builtin_amdgcn_s_memrealtime();
#endif
    const DnRec R = dn_rec(F);
    const bf16* proj = (const bf16*)(F.ws + WS_PROJ); const float* conv = FIN(3); const float* gbp = (const float*)(F.ws + WS_GB);
    LAS unsigned char* L = F.lds + RING_OFF;
    LAS float* GC = (LAS float*)(L + DNL_GC); LAS float* BETA = (LAS float*)(L + DNL_BETA); LAS float* DB = (LAS float*)(L + DNL_DB);
    const int lane = F.lane, wave = F.wave, r16 = lane & 15, g = lane >> 4;
    const int tk0 = 8 * wave;
    unsigned raw[3][11]; float gx, gbl;
#define DN_LOAD_INPUTS(ch_) do { const int bh_ = (ch_) >> 6, c_ = (ch_) & 63, b_ = bh_ >> 2, h_ = bh_ & 3; const size_t m0_ = (size_t)b_ * SEQ + 64 * c_; \
        gx = gbp[(m0_ + lane) * 8 + 4 + h_]; gbl = gbp[(m0_ + lane) * 8 + h_]; \
        _Pragma("unroll") for (int p = 0; p < 3; ++p) { const int col_ = p * DN_W + h_ * DN_D + 2 * lane; \
            _Pragma("unroll") for (int r = 0; r < 11; ++r) { const int tr_ = 64 * c_ + tk0 - 3 + r; raw[p][r] = *(const unsigned*)(proj + (m0_ - 64 * c_ + (tr_ < 0 ? 0 : tr_)) * NP + col_); } } } while (0)
#if DNA_PREFETCH
    if (F.vcu < 1024) DN_LOAD_INPUTS(F.vcu);
#endif
    for (int ch = F.vcu; ch < 1024; ch += F.G) {
        const int bh = ch >> 6, c = ch & 63, b = bh >> 2, h = bh & 3; const size_t m0 = (size_t)b * SEQ + 64 * c;
        {
#if !DNA_PREFETCH
            DN_LOAD_INPUTS(ch);
#endif
            float cw[3][4][2];
#pragma unroll
            for (int p = 0; p < 3; ++p) { const int col = p * DN_W + h * DN_D + 2 * lane;
#pragma unroll
                for (int j = 0; j < 4; ++j) { cw[p][j][0] = conv[j * DN_QKV + col]; cw[p][j][1] = conv[j * DN_QKV + col + 1]; } }
            if (wave == 0) { float x = gx;
#pragma unroll
                for (int off = 1; off < 64; off <<= 1) { const float t = __shfl_up(x, off); if (lane >= off) x += t; }
                GC[lane] = x; BETA[lane] = gbl; }
            if (64 * c + tk0 < 3) {
#pragma unroll
                for (int p = 0; p < 3; ++p)
#pragma unroll
                    for (int r = 0; r < 3; ++r) if (64 * c + tk0 - 3 + r < 0) raw[p][r] = 0u;
            }
#pragma unroll
            for (int hb = 0; hb < 2; ++hb) {
                float val[4][3][2], sq[4], sk[4];
#pragma unroll
                for (int i4 = 0; i4 < 4; ++i4) { const int i = 4 * hb + i4;
#pragma unroll
                    for (int p = 0; p < 3; ++p) { float a0 = 0.f, a1 = 0.f;
#pragma unroll
                        for (int j = 0; j < 4; ++j) { a0 += cw[p][j][0] * bflo(raw[p][i + j]); a1 += cw[p][j][1] * bfhi(raw[p][i + j]); }
                        val[i4][p][0] = a0 * sigm(a0); val[i4][p][1] = a1 * sigm(a1); }
                    sq[i4] = val[i4][0][0] * val[i4][0][0] + val[i4][0][1] * val[i4][0][1]; sk[i4] = val[i4][1][0] * val[i4][1][0] + val[i4][1][1] * val[i4][1][1]; }
#pragma unroll
                for (int i4 = 0; i4 < 4; ++i4) { sq[i4] = wave_sum(sq[i4]); sk[i4] = wave_sum(sk[i4]); }
#pragma unroll
                for (int i4 = 0; i4 < 4; ++i4) {
                    const float rq = frsq(sq[i4] + EPS) * 0.08838834764831845f, rk = frsq(sk[i4] + EPS);
                    const int o = (tk0 + 4 * hb + i4) * TP + 4 * lane;
                    *(LAS unsigned*)(L + DNL_QT + o) = cvtpk(val[i4][0][0] * rq, val[i4][0][1] * rq);
                    *(LAS unsigned*)(L + DNL_KT + o) = cvtpk(val[i4][1][0] * rk, val[i4][1][1] * rk);
                    *(LAS unsigned*)(L + DNL_VT + o) = cvtpk(val[i4][2][0], val[i4][2][1]);
                }
            }
        }
        __syncthreads(); DNSTAMP(0)
#pragma unroll
        for (int k_ = 0; k_ < 3; ++k_) { const int id = wave + 8 * k_; if (id < 20) {
            const int e = id % 10, isqk = (id / 10) & 1, ti = (e >= 6) ? 3 : (e >= 3) ? 2 : (e >= 1) ? 1 : 0, tj = e - ti * (ti + 1) / 2;
            f32x4 acc = {0.f, 0.f, 0.f, 0.f};
            const int xoff = isqk ? DNL_QT : DNL_KT;
#pragma unroll
            for (int ks = 0; ks < 4; ++ks) {
                const bf16x8 a = *(const LAS bf16x8*)(L + DNL_KT + (16 * tj + r16) * TP + (32 * ks + 8 * g) * 2);
                const bf16x8 bq = *(const LAS bf16x8*)(L + xoff + (16 * ti + r16) * TP + (32 * ks + 8 * g) * 2);
                acc = MFMA16(a, bq, acc); }
            const int i = 16 * ti + r16; const float gi = GC[i], bi = BETA[i]; const f32x4 gj = *(const LAS f32x4*)(GC + 16 * tj + 4 * g);
            f32x4 v;
#pragma unroll
            for (int r = 0; r < 4; ++r) { const int jp = 16 * tj + 4 * g + r; const float d = __expf(fminf(gi - gj[r], 0.f));
                v[r] = isqk ? ((i >= jp) ? acc[r] * d : 0.f) : ((i > jp) ? bi * acc[r] * d : 0.f); }
            if (!isqk) {
                u32x2 w; w.x = cvtpk(-v[0], -v[1]); w.y = cvtpk(-v[2], -v[3]);
                *(LAS u32x2*)(L + DNL_NA + i * NP2 + (16 * tj + 4 * g) * 2) = w;
                if (ti == tj) *(LAS f32x4*)(DB + (ti * 16 + r16) * 16 + 4 * g) = v;
            } else { u32x2 w; w.x = cvtpk(v[0], v[1]); w.y = cvtpk(v[2], v[3]); *(LAS u32x2*)(L + DNL_QKM + i * NP2 + (16 * tj + 4 * g) * 2) = w; }
        } }
        __syncthreads(); DNSTAMP(1)
        if (wave < 4) {
            const int I = wave; float x[16];
#pragma unroll
            for (int i = 0; i < 16; ++i) { float a = (i == r16) ? 1.f : 0.f;
#pragma unroll
                for (int j4 = 0; j4 < (i + 3) / 4; ++j4) { const f32x4 d = *(const LAS f32x4*)(DB + (I * 16 + i) * 16 + 4 * j4);
#pragma unroll
                    for (int jj = 0; jj < 4; ++jj) if (4 * j4 + jj < i) a -= d[jj] * x[4 * j4 + jj]; }
                x[i] = a; }
            if (lane < 16) {
#pragma unroll
                for (int i = 0; i < 16; ++i) *(LAS unsigned short*)(L + DNL_TIB + ((I * 16 + i) * 16 + r16) * 2) = (unsigned short)(cvtpk(x[i], 0.f) & 0xffffu);
            }
        } else {
            const int w4 = wave - 4;
            {
                const int mt = w4; const float e = __expf(GC[16 * mt + r16]); const int base = DNL_QT + (16 * mt + r16) * TP;
                u32x2 lo[4], hi[4];
#pragma unroll
                for (int ks = 0; ks < 4; ++ks) { lo[ks] = *(const LAS u32x2*)(L + base + (32 * ks + 4 * g) * 2); hi[ks] = *(const LAS u32x2*)(L + base + (32 * ks + 16 + 4 * g) * 2); }
#pragma unroll
                for (int ks = 0; ks < 4; ++ks) { v4u w; w.x = cvtpk(bflo(lo[ks].x) * e, bfhi(lo[ks].x) * e); w.y = cvtpk(bflo(lo[ks].y) * e, bfhi(lo[ks].y) * e); w.z = cvtpk(bflo(hi[ks].x) * e, bfhi(hi[ks].x) * e); w.w = cvtpk(bflo(hi[ks].y) * e, bfhi(hi[ks].y) * e);
                    *(v4u*)(R.QG + ((size_t)(ch * 16 + mt * 4 + ks) * 64 + lane) * 8) = w; }
            }
            {
                const float gl = GC[63]; float ed[2][8];
#pragma unroll
                for (int kt = 0; kt < 2; ++kt)
#pragma unroll
                    for (int j = 0; j < 8; ++j) { const int tok = 32 * kt + (j < 4 ? 4 * g + j : 16 + 4 * g + j - 4); ed[kt][j] = __expf(gl - GC[tok]); }
#pragma unroll
                for (int i = 0; i < 4; ++i) { const int f = 4 * w4 + i, mt8 = f >> 1, kt = i & 1, dk = 16 * mt8 + r16; float v[8];
#pragma unroll
                    for (int j = 0; j < 8; ++j) { const int tok = 32 * kt + (j < 4 ? 4 * g + j : 16 + 4 * g + j - 4); v[j] = bf1(*(const LAS unsigned short*)(L + DNL_KT + tok * TP + dk * 2)) * ed[kt][j]; }
                    v4u w; w.x = cvtpk(v[0], v[1]); w.y = cvtpk(v[2], v[3]); w.z = cvtpk(v[4], v[5]); w.w = cvtpk(v[6], v[7]);
                    *(v4u*)(R.KD + ((size_t)(ch * 16 + f) * 64 + lane) * 8) = w; }
            }
#pragma unroll
            for (int i = 0; i < 2; ++i) { const int q = w4 + 4 * i;
                if (q < 6) { const int mt = (q == 0) ? 0 : (q == 1) ? 1 : (q < 4) ? 2 : 3, kt = (q == 3 || q == 5) ? 1 : 0;
                    const u32x2 lo = *(const LAS u32x2*)(L + DNL_QKM + (16 * mt + r16) * NP2 + (32 * kt + 4 * g) * 2);
                    u32x2 hi = {0u, 0u}; if (2 * kt + 1 <= mt) hi = *(const LAS u32x2*)(L + DNL_QKM + (16 * mt + r16) * NP2 + (32 * kt + 16 + 4 * g) * 2);
                    const v4u w = {lo.x, lo.y, hi.x, hi.y};
                    *(v4u*)(R.QK + ((size_t)(ch * 6 + q) * 64 + lane) * 8) = w; } }
            if (lane == 0 && w4 == 0) R.EGL[ch] = __expf(GC[63]);
        }
        __syncthreads(); DNSTAMP(2)
#if DNA_PREFETCH
        if (ch + F.G < 1024) DN_LOAD_INPUTS(ch + F.G);
#endif
        {
            const int part = wave >> 2, colbase = 32 * (wave & 3);
            f32x4 rhs[4][2];
#pragma unroll
            for (int I = 0; I < 4; ++I) { float sc[4];
#pragma unroll
                for (int r = 0; r < 4; ++r) { const int tok = 16 * I + 4 * g + r; sc[r] = part == 0 ? BETA[tok] : -(BETA[tok] * __expf(GC[tok])); }
#pragma unroll
                for (int nt = 0; nt < 2; ++nt) { const int col = colbase + 16 * nt + r16;
#pragma unroll
                    for (int r = 0; r < 4; ++r) { const int tok = 16 * I + 4 * g + r; rhs[I][nt][r] = sc[r] * bf1(*(const LAS unsigned short*)(L + (part == 0 ? DNL_VT : DNL_KT) + tok * TP + col * 2)); } } }
            u32x2 na10, na20l, na20h, na30l, na30h, na31l, ti[4];
            na10 = *(const LAS u32x2*)(L + DNL_NA + (16 * 1 + r16) * NP2 + (4 * g) * 2);
            na20l = *(const LAS u32x2*)(L + DNL_NA + (16 * 2 + r16) * NP2 + (4 * g) * 2); na20h = *(const LAS u32x2*)(L + DNL_NA + (16 * 2 + r16) * NP2 + (16 + 4 * g) * 2);
            na30l = *(const LAS u32x2*)(L + DNL_NA + (16 * 3 + r16) * NP2 + (4 * g) * 2); na30h = *(const LAS u32x2*)(L + DNL_NA + (16 * 3 + r16) * NP2 + (16 + 4 * g) * 2);
            na31l = *(const LAS u32x2*)(L + DNL_NA + (16 * 3 + r16) * NP2 + (32 + 4 * g) * 2);
#pragma unroll
            for (int I = 0; I < 4; ++I) ti[I] = *(const LAS u32x2*)(L + DNL_TIB + ((I * 16 + r16) * 16 + 4 * g) * 2);
            const bf16x8 A10 = __builtin_bit_cast(bf16x8, (v4u){na10.x, na10.y, 0u, 0u}), A20 = __builtin_bit_cast(bf16x8, (v4u){na20l.x, na20l.y, na20h.x, na20h.y}),
                         A30 = __builtin_bit_cast(bf16x8, (v4u){na30l.x, na30l.y, na30h.x, na30h.y}), A31 = __builtin_bit_cast(bf16x8, (v4u){na31l.x, na31l.y, 0u, 0u});
            const f32x4 zero = {0.f, 0.f, 0.f, 0.f};
            f32x4 X[2][4];
#pragma unroll
            for (int nt = 0; nt < 2; ++nt) {
                X[nt][0] = MFMA16(__builtin_bit_cast(bf16x8, (v4u){ti[0].x, ti[0].y, 0u, 0u}), pack8z(rhs[0][nt]), zero);
                f32x4 a1 = MFMA16(A10, pack8z(X[nt][0]), rhs[1][nt]);
                X[nt][1] = MFMA16(__builtin_bit_cast(bf16x8, (v4u){ti[1].x, ti[1].y, 0u, 0u}), pack8z(a1), zero);
                f32x4 a2 = MFMA16(A20, pack8(X[nt][0], X[nt][1]), rhs[2][nt]);
                X[nt][2] = MFMA16(__builtin_bit_cast(bf16x8, (v4u){ti[2].x, ti[2].y, 0u, 0u}), pack8z(a2), zero);
                f32x4 a3 = MFMA16(A30, pack8(X[nt][0], X[nt][1]), rhs[3][nt]); a3 = MFMA16(A31, pack8z(X[nt][2]), a3);
                X[nt][3] = MFMA16(__builtin_bit_cast(bf16x8, (v4u){ti[3].x, ti[3].y, 0u, 0u}), pack8z(a3), zero);
            }
#pragma unroll
            for (int nt = 0; nt < 2; ++nt)
#pragma unroll
                for (int I = 0; I < 4; ++I) {
                    if (part == 0) { u32x2 w; w.x = cvtpk(X[nt][I][0], X[nt][I][1]); w.y = cvtpk(X[nt][I][2], X[nt][I][3]); *(u32x2*)R.u(ch, 2 * (wave & 3) + nt, I, lane) = w; }
                    else { const int col = colbase + 16 * nt + r16;
#pragma unroll
                        for (int r = 0; r < 4; ++r) *(LAS unsigned short*)(L + DNL_WL + (16 * I + 4 * g + r) * TP + col * 2) = (unsigned short)(cvtpk(X[nt][I][r], 0.f) & 0xffffu); }
                }
        }
        __syncthreads(); DNSTAMP(3)
        {
            const int mt = wave >> 1, base = DNL_WL + (16 * mt + r16) * TP;
            u32x2 lo[2], hi[2];
#pragma unroll
            for (int i = 0; i < 2; ++i) { const int ks = 2 * (wave & 1) + i; lo[i] = *(const LAS u32x2*)(L + base + (32 * ks + 4 * g) * 2); hi[i] = *(const LAS u32x2*)(L + base + (32 * ks + 16 + 4 * g) * 2); }
#pragma unroll
            for (int i = 0; i < 2; ++i) { const int ks = 2 * (wave & 1) + i; const v4u w = {lo[i].x, lo[i].y, hi[i].x, hi[i].y}; *(v4u*)(R.W + ((size_t)(ch * 16 + mt * 4 + ks) * 64 + lane) * 8) = w; }
        }
        __syncthreads(); DNSTAMP(4)
    }
#if STAMP_DN >= 0
    if (blockIdx.x == STAMP_BLOCK && threadIdx.x == 0) { for (int i = 0; i < 8; ++i) g_dn[i] = dnacc_[i]; }
#endif
}
__device__ __forceinline__ void dn_out2(Frame& F, int worker, int nworkers, int task_lo = 0, int task_hi = 4096) {
    const DnRec R = dn_rec(F);
    const int lane = F.lane, r16 = lane & 15, g = lane >> 4;
    bf16* proj = (bf16*)(F.ws + WS_PROJ); const float* gain = FIN(6);
    int pub_pm = -1;
    for (int task = worker; task < (DNO_SKIPALL ? 0 : task_hi); task += nworkers) {
        if (task < task_lo) continue;
        const int c = task >> 6, bh = (task >> 2) & 15, mt = task & 3, ch = bh * 64 + c, b = bh >> 2, h = bh & 3;
        {   gu32* f0 = F.ctl + CW_SCAN + 64 * (bh * 2);
            for (unsigned sp = 0;; ++sp) {
                const unsigned p0 = (unsigned)__builtin_amdgcn_readfirstlane((int)__hip_atomic_load(f0, RLX_AGENT)), p1 = (unsigned)__builtin_amdgcn_readfirstlane((int)__hip_atomic_load(f0 + 64, RLX_AGENT));
                if ((p0 < p1 ? p0 : p1) > (unsigned)(c + DNO_LAG < 63 ? c + DNO_LAG : 63) || sp > (1u << 16)) break;
                __builtin_amdgcn_s_sleep(DNO_SLEEP);
            }
            if (DNO_FENCE) __builtin_amdgcn_fence(__ATOMIC_ACQUIRE, "agent"); else asm volatile("" ::: "memory"); }
        if (DNO_SKIPWORK) continue;
        if (SEAM35 && pub_pm >= 0) { asm volatile("s_waitcnt vmcnt(0)" ::: "memory"); if (lane == 0) __hip_atomic_fetch_add(F.ctl + CW_PAN + 64 * pub_pm, 1u, RLX_AGENT); }
        pub_pm = (bh >> 2) * 16 + (c >> 2);
        f32x4 o[8]; float ss[4] = {0.f, 0.f, 0.f, 0.f};
#pragma unroll
        for (int sl = 0; sl < 8; ++sl) { u32x2 w;
            if (DNO_FENCE) w = *(const u32x2*)R.u(ch, sl, mt, lane);
            else { const unsigned long long q = __hip_atomic_load((GAS unsigned long long*)R.u(ch, sl, mt, lane), RLX_AGENT); w.x = (unsigned)q; w.y = (unsigned)(q >> 32); }
            o[sl] = (f32x4){bflo(w.x), bfhi(w.x), bflo(w.y), bfhi(w.y)};
#pragma unroll
            for (int r = 0; r < 4; ++r) ss[r] += o[sl][r] * o[sl][r]; }
#pragma unroll
        for (int r = 0; r < 4; ++r) { float s = sum16(ss[r]); ss[r] = frsq(s * (1.0f / DN_D) + EPS); }
        float gdv[8];
#pragma unroll
        for (int sl = 0; sl < 8; ++sl) gdv[sl] = gain[16 * sl + r16];
        unsigned short zz[8][4];
#pragma unroll
        for (int sl = 0; sl < 8; ++sl)
#pragma unroll
            for (int r = 0; r < 4; ++r) zz[sl][r] = proj[((size_t)b * SEQ + 64 * c + 16 * mt + 4 * g + r) * NP + PC_Z + h * DN_D + 16 * sl + r16];
#if DNO_STAGE
        {   LAS unsigned char* stg = F.lds + RING_OFF + F.wave * 16384;
#pragma unroll
            for (int sl = 0; sl < 8; ++sl) { const float gd = gdv[sl];
#pragma unroll
                for (int r = 0; r < 4; ++r) { const float z = bf1(zz[sl][r]);
                    *(LAS unsigned short*)(stg + (4 * g + r) * 272 + (16 * sl + r16) * 2) = (unsigned short)(cvtpk(o[sl][r] * ss[r] * gd * z * sigm(z), 0.f) & 0xffffu); } }
            asm volatile("s_waitcnt lgkmcnt(0)" ::: "memory");
            const size_t m0 = (size_t)b * SEQ + 64 * c + 16 * mt;
#pragma unroll
            for (int i = 0; i < 4; ++i) { const int q = lane + 64 * i, row = q >> 4, cc = q & 15; const v4u v = *(const LAS v4u*)(stg + row * 272 + cc * 16);
                GAS v4u* dst = (GAS v4u*)(proj + (m0 + row) * NP + PC_YDN + h * DN_D + cc * 8);
                asm volatile("global_store_dwordx4 %0, %1, off sc1\n\ts_nop 2" :: "v"(dst), "v"(v) : "memory"); }
            asm volatile("s_waitcnt lgkmcnt(0)" ::: "memory");
        }
#else
#pragma unroll
        for (int sl = 0; sl < 8; ++sl) { const int d = 16 * sl + r16; const float gd = gdv[sl];
#pragma unroll
            for (int r = 0; r < 4; ++r) { const size_t m = (size_t)b * SEQ + 64 * c + 16 * mt + 4 * g + r; const float z = bf1(zz[sl][r]);
                proj[m * NP + PC_YDN + h * DN_D + d] = (bf16)(cvtpk(o[sl][r] * ss[r] * gd * z * sigm(z), 0.f) & 0xffffu); } }
#endif
    }
    if (SEAM35 && pub_pm >= 0) { asm volatile("s_waitcnt vmcnt(0)" ::: "memory"); if (lane == 0) __hip_atomic_fetch_add(F.ctl + CW_PAN + 64 * pub_pm, 1u, RLX_AGENT); }
    if (SEAM78 && lane == 0) { unsigned nt_ = 0u; for (int task = worker; task < 4096; task += nworkers) ++nt_;
        if (nt_) __hip_atomic_fetch_add(F.ctl + CW_NORMDONE + 64 * (worker & 7), nt_, RLX_AGENT); }
}
constexpr int SCAN_H0 = 32768, SCAN_H1 = 24576;
__device__ __forceinline__ void dn_scan_wg(Frame& F, int bh, int half) {
    const DnRec R = dn_rec(F);
    const int lane = F.lane, wave = F.wave;
    LAS unsigned char* ring = F.lds + RING_OFF;
    if (wave >= 4) {
        const int lw = wave - 4;
        v4u r0[8], r1[6], r2[8], r3[6];
#if SCAN_SETS == 6
        v4u r4[8], r5[6];
#endif
#define LD_H0(set_, k_) do { const int ch_ = bh * 64 + ((k_) >> 1); _Pragma("unroll") for (int i_ = 0; i_ < 8; ++i_) { const int p_ = lw + 4 * i_; \
            const bf16* src_ = p_ < 16 ? R.W + (size_t)ch_ * 8192 + p_ * 512 : R.QG + (size_t)ch_ * 8192 + (p_ - 16) * 512; set_[i_] = SCAN_NT ? __builtin_nontemporal_load((const v4u*)(src_ + lane * 8)) : *(const v4u*)(src_ + lane * 8); } } while (0)
#define LD_H1(set_, k_) do { const int ch_ = bh * 64 + ((k_) >> 1); _Pragma("unroll") for (int i_ = 0; i_ < 6; ++i_) { const int p_ = lw + 4 * i_, q_ = p_ < 22 ? p_ : p_ - 22; \
            const bf16* src_ = q_ < 6 ? R.QK + (size_t)ch_ * 3072 + q_ * 512 : R.KD + (size_t)ch_ * 8192 + (q_ - 6) * 512; set_[i_] = SCAN_NT ? __builtin_nontemporal_load((const v4u*)(src_ + lane * 8)) : *(const v4u*)(src_ + lane * 8); } } while (0)
#define ST_H0(set_, k_) do { LAS unsigned char* slot_ = ring + (((k_) >> 1) & 1) * (SCAN_H0 + SCAN_H1) + lane * 16; _Pragma("unroll") for (int i_ = 0; i_ < 8; ++i_) *(LAS v4u*)(slot_ + (lw + 4 * i_) * 1024) = set_[i_]; } while (0)
#define ST_H1(set_, k_) do { LAS unsigned char* slot_ = ring + (((k_) >> 1) & 1) * (SCAN_H0 + SCAN_H1) + SCAN_H0 + lane * 16; _Pragma("unroll") for (int i_ = 0; i_ < 6; ++i_) *(LAS v4u*)(slot_ + (lw + 4 * i_) * 1024) = set_[i_]; } while (0)
#define LD_BAR() do { asm volatile("s_waitcnt lgkmcnt(0)" ::: "memory"); __builtin_amdgcn_s_barrier(); asm volatile("" ::: "memory"); } while (0)
#if SCAN_SETS == 6
        LD_H0(r0, 0); LD_H1(r1, 1); LD_H0(r2, 2); LD_H1(r3, 3); LD_H0(r4, 4); LD_H1(r5, 5);
        ST_H0(r0, 0); LD_H0(r0, 6); ST_H1(r1, 1); LD_H1(r1, 7); ST_H0(r2, 2); LD_H0(r2, 8);
        for (int k = 0; k < 128; k += 6) {
            if (k + 0 < 128) { LD_BAR(); if (k + 3 < 128) { ST_H1(r3, k + 3); if (k + 9 < 128) LD_H1(r3, k + 9); } }
            if (k + 1 < 128) { LD_BAR(); if (k + 4 < 128) { ST_H0(r4, k + 4); if (k + 10 < 128) LD_H0(r4, k + 10); } }
            if (k + 2 < 128) { LD_BAR(); if (k + 5 < 128) { ST_H1(r5, k + 5); if (k + 11 < 128) LD_H1(r5, k + 11); } }
            if (k + 3 < 128) { LD_BAR(); if (k + 6 < 128) { ST_H0(r0, k + 6); if (k + 12 < 128) LD_H0(r0, k + 12); } }
            if (k + 4 < 128) { LD_BAR(); if (k + 7 < 128) { ST_H1(r1, k + 7); if (k + 13 < 128) LD_H1(r1, k + 13); } }
            if (k + 5 < 128) { LD_BAR(); if (k + 8 < 128) { ST_H0(r2, k + 8); if (k + 14 < 128) LD_H0(r2, k + 14); } }
        }
#else
        LD_H0(r0, 0); LD_H1(r1, 1); LD_H0(r2, 2); LD_H1(r3, 3);
        ST_H0(r0, 0); LD_H0(r0, 4); ST_H1(r1, 1); LD_H1(r1, 5); ST_H0(r2, 2); LD_H0(r2, 6);
#define PUB(k_) do { if (SCAN_PUBLISH && SCAN_PUB_LOADER && lw == 0 && lane == 0 && (k_) >= 4 && (((k_) >> 1) % SCAN_PUB_EVERY) == 0) asm volatile("global_store_dword %0, %1, off sc1" :: "v"(F.ctl + CW_SCAN + 64 * (bh * 2 + half)), "v"((unsigned)(((k_) >> 1) - 1)) : "memory"); } while (0)
        for (int k = 0; k < 128; k += 4) {
            LD_BAR(); PUB(k); ST_H1(r3, k + 3); if (k + 7 < 128) LD_H1(r3, k + 7);
            LD_BAR(); if (k + 4 < 128) { ST_H0(r0, k + 4); if (k + 8 < 128) LD_H0(r0, k + 8); }
            LD_BAR(); PUB(k + 2); if (k + 5 < 128) { ST_H1(r1, k + 5); if (k + 9 < 128) LD_H1(r1, k + 9); }
            LD_BAR(); if (k + 6 < 128) { ST_H0(r2, k + 6); if (k + 10 < 128) LD_H0(r2, k + 10); }
        }
#endif
#undef LD_H0
#undef LD_H1
#undef ST_H0
#undef ST_H1
#undef LD_BAR
#undef PUB
    } else {
        const int sl = half * 4 + wave;
        f32x4 S[8];
#pragma unroll
        for (int i = 0; i < 8; ++i) S[i] = (f32x4){0.f, 0.f, 0.f, 0.f};
        constexpr int UPRE = SCAN_UPRE;
        u32x2 Uq[UPRE][4]; float eq[UPRE];
#pragma unroll
        for (int d = 0; d < UPRE; ++d) { eq[d] = R.EGL[bh * 64 + d];
#pragma unroll
            for (int mt = 0; mt < 4; ++mt) Uq[d][mt] = *(const u32x2*)R.u(bh * 64 + d, sl, mt, lane); }
        for (int c4 = 0; c4 < 64; c4 += UPRE) {
#pragma unroll
        for (int j4 = 0; j4 < UPRE; ++j4) {
            const int c = c4 + j4, ch = bh * 64 + c;
            const LAS unsigned char* h0 = ring + (c & 1) * (SCAN_H0 + SCAN_H1) + lane * 16; const LAS unsigned char* h1 = h0 + SCAN_H0;
            asm volatile("s_waitcnt lgkmcnt(0)" ::: "memory");
            __builtin_amdgcn_s_barrier();
            asm volatile("" ::: "memory");
#if SCAN_PUBLISH && !SCAN_PUB_LOADER
            if (wave == 0 && c >= 2 && lane == 0) __hip_atomic_store(F.ctl + CW_SCAN + 64 * (bh * 2 + half), (unsigned)(c - 1), RLX_AGENT);
#endif
            bf16x8 fa[16];
#pragma unroll
            for (int f = 0; f < 16; ++f) fa[f] = *(const LAS bf16x8*)(h0 + f * 1024);
#if SCAN_QG_EARLY
            bf16x8 fb[8];
#pragma unroll
            for (int f = 0; f < 8; ++f) fb[f] = *(const LAS bf16x8*)(h0 + 16384 + f * 1024);
#endif
            bf16x8 Sb[4];
#pragma unroll
            for (int ks = 0; ks < 4; ++ks) Sb[ks] = pack8(S[2 * ks], S[2 * ks + 1]);
            const float egl = eq[j4];
            u32x2 Uf[4];
#pragma unroll
            for (int mt = 0; mt < 4; ++mt) Uf[mt] = Uq[j4][mt];
            __builtin_amdgcn_sched_barrier(0);
            f32x4 vn[4], o[4];
#pragma unroll
            for (int mt = 0; mt < 4; ++mt) { vn[mt] = (f32x4){bflo(Uf[mt].x), bfhi(Uf[mt].x), bflo(Uf[mt].y), bfhi(Uf[mt].y)};
#pragma unroll
                for (int ks = 0; ks < 4; ++ks) vn[mt] = MFMA16(fa[mt * 4 + ks], Sb[ks], vn[mt]); }
            __builtin_amdgcn_sched_barrier(0);
#if SCAN_QG_EARLY
#pragma unroll
            for (int f = 8; f < 16; ++f) fa[f] = *(const LAS bf16x8*)(h0 + 16384 + f * 1024);
            __builtin_amdgcn_sched_barrier(0);
#pragma unroll
            for (int mt = 0; mt < 2; ++mt) { o[mt] = (f32x4){0.f, 0.f, 0.f, 0.f};
#pragma unroll
                for (int ks = 0; ks < 4; ++ks) o[mt] = MFMA16(fb[mt * 4 + ks], Sb[ks], o[mt]); }
#pragma unroll
            for (int mt = 2; mt < 4; ++mt) { o[mt] = (f32x4){0.f, 0.f, 0.f, 0.f};
#pragma unroll
                for (int ks = 0; ks < 4; ++ks) o[mt] = MFMA16(fa[mt * 4 + ks], Sb[ks], o[mt]); }
#else
#pragma unroll
            for (int f = 0; f < 16; ++f) fa[f] = *(const LAS bf16x8*)(h0 + 16384 + f * 1024);
            __builtin_amdgcn_sched_barrier(0);
#pragma unroll
            for (int mt = 0; mt < 4; ++mt) { o[mt] = (f32x4){0.f, 0.f, 0.f, 0.f};
#pragma unroll
                for (int ks = 0; ks < 4; ++ks) o[mt] = MFMA16(fa[mt * 4 + ks], Sb[ks], o[mt]); }
#endif
            const bf16x8 vb0 = pack8(vn[0], vn[1]), vb1 = pack8(vn[2], vn[3]);
#if !SCAN_PUBLISH || !SCAN_REFILL_LATE
            { const int cn = (c + UPRE < 64) ? c + UPRE : 63;
#pragma unroll
                for (int mt = 0; mt < 4; ++mt) Uq[j4][mt] = *(const u32x2*)R.u(bh * 64 + cn, sl, mt, lane);
                eq[j4] = R.EGL[bh * 64 + cn]; }
#endif
            asm volatile("s_waitcnt lgkmcnt(0)" ::: "memory");
            __builtin_amdgcn_s_barrier();
            asm volatile("" ::: "memory");
            bf16x8 fq_[6];
#pragma unroll
            for (int f = 0; f < 6; ++f) fq_[f] = *(const LAS bf16x8*)(h1 + f * 1024);
#pragma unroll
            for (int f = 0; f < 16; ++f) fa[f] = *(const LAS bf16x8*)(h1 + 6144 + f * 1024);
            __builtin_amdgcn_sched_barrier(0);
            o[0] = MFMA16(fq_[0], vb0, o[0]); o[1] = MFMA16(fq_[1], vb0, o[1]);
            o[2] = MFMA16(fq_[2], vb0, o[2]); o[2] = MFMA16(fq_[3], vb1, o[2]);
            o[3] = MFMA16(fq_[4], vb0, o[3]); o[3] = MFMA16(fq_[5], vb1, o[3]);
#pragma unroll
            for (int i = 0; i < 8; ++i) { S[i] = S[i] * egl; S[i] = MFMA16(fa[2 * i], vb0, S[i]); S[i] = MFMA16(fa[2 * i + 1], vb1, S[i]); }
#if SCAN_PUBLISH
#if !SCAN_DRAIN_NONE
            VM_WAIT();
#endif
#if SCAN_O16
#pragma unroll
            for (int p2 = 0; p2 < 2; ++p2) {
                const unsigned a0 = cvtpk(o[2 * p2][0], o[2 * p2][1]), a1 = cvtpk(o[2 * p2][2], o[2 * p2][3]), b0 = cvtpk(o[2 * p2 + 1][0], o[2 * p2 + 1][1]), b1 = cvtpk(o[2 * p2 + 1][2], o[2 * p2 + 1][3]);
                const bool odd = (lane & 1) != 0;
                const unsigned r0 = (unsigned)__builtin_amdgcn_update_dpp(0, (int)(odd ? a0 : b0), 0xB1, 0xf, 0xf, true), r1 = (unsigned)__builtin_amdgcn_update_dpp(0, (int)(odd ? a1 : b1), 0xB1, 0xf, 0xf, true);
                v4u w; w.x = odd ? r0 : a0; w.y = odd ? r1 : a1; w.z = odd ? b0 : r0; w.w = odd ? b1 : r1;
                GAS v4u* dst = (GAS v4u*)R.u(ch, sl, 2 * p2 + (odd ? 1 : 0), lane & ~1);
                asm volatile("global_store_dwordx4 %0, %1, off sc1\n\ts_nop 2" :: "v"(dst), "v"(w) : "memory"); }
#else
#pragma unroll
            for (int mt = 0; mt < 4; ++mt) { const unsigned long long w = (unsigned long long)cvtpk(o[mt][0], o[mt][1]) | ((unsigned long long)cvtpk(o[mt][2], o[mt][3]) << 32);
                if (SCAN_O_SC1) __hip_atomic_store((GAS unsigned long long*)R.u(ch, sl, mt, lane), w, RLX_AGENT); else *(unsigned long long*)R.u(ch, sl, mt, lane) = w; }
#endif
            if (SCAN_REFILL_LATE) { const int cn = (c + UPRE < 64) ? c + UPRE : 63;
#pragma unroll
                for (int mt = 0; mt < 4; ++mt) Uq[j4][mt] = *(const u32x2*)R.u(bh * 64 + cn, sl, mt, lane);
                eq[j4] = R.EGL[bh * 64 + cn]; }
#else
#pragma unroll
            for (int mt = 0; mt < 4; ++mt) { u32x2 w; w.x = cvtpk(o[mt][0], o[mt][1]); w.y = cvtpk(o[mt][2], o[mt][3]); *(u32x2*)R.u(ch, sl, mt, lane) = w; }
#endif
        }
        }
    }
#if SCAN_PUBLISH
    VM_WAIT(); __syncthreads();
    if (F.tid == 0) __hip_atomic_store(F.ctl + CW_SCAN + 64 * (bh * 2 + half), 64u, RLX_AGENT);
#endif
}
__device__ unsigned long long g_ts[16];
__device__ __forceinline__ void run_phase0(Frame& F0) {
    Frame F = F0; asm volatile("" : "+v"(F.tid)); F.lane = F.tid & 63;
    unsigned char* ws = F.ws; bf16* XB = (bf16*)(ws + WS_XB); bf16* Y = (bf16*)(ws + WS_Y); bf16* PROJ = (bf16*)(ws + WS_PROJ); (void)XB; (void)Y; (void)PROJ;
        p0_prologue(F);
}
__device__ __forceinline__ void run_phase1(Frame& F0) {
    Frame F = F0; asm volatile("" : "+v"(F.tid)); F.lane = F.tid & 63;
    unsigned char* ws = F.ws; bf16* XB = (bf16*)(ws + WS_XB); bf16* Y = (bf16*)(ws + WS_Y); bf16* PROJ = (bf16*)(ws + WS_PROJ); (void)XB; (void)Y; (void)PROJ;
        const int N1 = (F.G == 256) ? P1_TILES * 256 : NP;
        pg8::Gemm g{XB, (const bf16*)(ws + WS_WIN), M, N1, D}; pg8::StaticOrder S; S.init(M, N1, F.G, (int)blockIdx.x);
        pg8::EpiProj E{PROJ, NP, (const float*)(ws + WS_RSTD), PC_G / 256, 0, FUSE_QKNORM ? Y + (size_t)M * SW_W : nullptr, Y, FIN(7), FIN(8), PC_SQ / 256, PC_SK / 256, 0.125f * 1.4426950408889634f, SEQ};
        pg8::gemm_phase<pg8::EpiProj, pg8::StaticOrder, ALIGN_P1, true>(F.lds + RING_OFF, g, S, E);
}
__device__ __forceinline__ void run_phase2(Frame& F0) {
    Frame F = F0; asm volatile("" : "+v"(F.tid)); F.lane = F.tid & 63;
    unsigned char* ws = F.ws; bf16* XB = (bf16*)(ws + WS_XB); bf16* Y = (bf16*)(ws + WS_Y); bf16* PROJ = (bf16*)(ws + WS_PROJ); (void)XB; (void)Y; (void)PROJ;
#if FAST_DN
        SUBSTAMP(0) for (int rep_ = 0; rep_ < REP_DNA; ++rep_) dn_chunk_prep(F); SUBSTAMP(1)
#else
        dn_pre(F);
#endif
#if FAST_SWA
        for (int rep_ = 0; rep_ < REP_SWAPRE; ++rep_) swa_pre(F); SUBSTAMP(2)
#endif
}
__device__ __forceinline__ void run_phase3(Frame& F0) {
    Frame F = F0; asm volatile("" : "+v"(F.tid)); F.lane = F.tid & 63;
    unsigned char* ws = F.ws; bf16* XB = (bf16*)(ws + WS_XB); bf16* Y = (bf16*)(ws + WS_Y); bf16* PROJ = (bf16*)(ws + WS_PROJ); (void)XB; (void)Y; (void)PROJ;
#if FAST_DN
        if (F.G == 256) {
            const int bx = (int)blockIdx.x;
            SUBSTAMP(3)
            if (((bx >> 3) & 7) == 0) {
                const int xcd = bx & 7, j = bx >> 6;
                if (!P3_SKIP_SCAN) dn_scan_wg(F, xcd * 2 + (j >> 1), j & 1);
                SUBSTAMP(4)
            } else if (!P3_SKIP_GEMM) {
                const int gi = (bx >> 6) * 56 + (bx & 63) - 8, NG = NP - P1_TILES * 256;
#if P3_ORDER == 1
                if (DEFER_WEIGHTS) { weight_copies(F, WI_P0, WI_ALL, gi * NWAVES + F.wave, 224 * NWAVES); __syncthreads(); }
                swa_bias_table(F); __syncthreads();
                swa_main(F, gi * NWAVES + F.wave, 224 * NWAVES);
                __syncthreads();
#endif
                pg8::Gemm g{XB, (const bf16*)(ws + WS_WIN) + (size_t)P1_TILES * 256 * D, M, NG, D}; pg8::StaticOrder S; S.init(M, NG, 224, gi);
                pg8::EpiProj E{PROJ, NP, (const float*)(ws + WS_RSTD), PC_G / 256, P1_TILES, nullptr, nullptr, nullptr, nullptr, 0, 0, 0.f, SEQ, SEAM35};
                pg8::gemm_phase<pg8::EpiProj, pg8::StaticOrder, true, true>(F.lds + RING_OFF, g, S, E);
                if (SEAM35 && F.tid == 0) {
                    pg8::Unit u_; for (int i_ = 0; S.next(i_, u_); ++i_) __hip_atomic_fetch_add(F.ctl + CW_PAN + 64 * u_.pm + 2, 1u, RLX_AGENT); }
                SUBSTAMP(4)
#if P3_ORDER == 0
                if (!P3_ONLY_SCAN) { swa_bias_table(F); __syncthreads();
                swa_main(F, gi * NWAVES + F.wave, 224 * NWAVES);
                SUBSTAMP(5)
#if ASYM_WCOPY
                __syncthreads();
                dn_out2(F, gi * NWAVES + F.wave, 224 * NWAVES, 0, 224 * NWAVES);
                if (DEFER_WEIGHTS && (bx & 1)) weight_copies(F, WI_P0, WI_ALL, ((bx >> 6) * 28 + (((bx & 63) - 8) >> 1)) * NWAVES + F.wave, 112 * NWAVES); }
#else
                if (DEFER_WEIGHTS) { __syncthreads(); weight_copies(F, WI_P0, WI_ALL, gi * NWAVES + F.wave, 224 * NWAVES); } }
#endif
                if (SEAM67 && DEFER_WEIGHTS) { asm volatile("s_waitcnt vmcnt(0)" ::: "memory"); if (F.lane == 0) __hip_atomic_fetch_add(F.ctl + CW_WCOPY + 64 * (F.wave & 7), 1u, RLX_AGENT); }
                SUBSTAMP(6)
#endif
                dn_out2(F, gi * NWAVES + F.wave, 224 * NWAVES, ASYM_WCOPY ? 224 * NWAVES : 0, 4096); SUBSTAMP(7)
            }
        } else {
        for (int task = F.vcu; task < 32; task += F.G) { dn_scan_wg(F, task >> 1, task & 1); __syncthreads(); }
        swa_bias_table(F); __syncthreads();
        swa_main(F, F.vcu * NWAVES + F.wave, F.G * NWAVES);
        __syncthreads();
        dn_out2(F, F.vcu * NWAVES + F.wave, F.G * NWAVES);
        }
#elif FAST_SWA
        if (F.vcu < 16) dn_scan_naive(F, F.vcu);
        else { swa_bias_table(F); __syncthreads(); swa_main(F, (F.vcu - 16) * NWAVES + F.wave, (F.G - 16) * NWAVES); }
#else
        if (F.G > 16) { if (F.vcu < 16) dn_scan_naive(F, F.vcu); else swa_naive(F, (F.vcu - 16) * NWAVES + F.wave, (F.G - 16) * NWAVES); }
        else { for (int bh = F.vcu; bh < 16; bh += F.G) dn_scan_naive(F, bh); swa_naive(F, F.vcu * NWAVES + F.wave, F.G * NWAVES); }
#endif
}
__device__ __forceinline__ void run_phase4(Frame& F0) {
    Frame F = F0; asm volatile("" : "+v"(F.tid)); F.lane = F.tid & 63;
    unsigned char* ws = F.ws; bf16* XB = (bf16*)(ws + WS_XB); bf16* Y = (bf16*)(ws + WS_Y); bf16* PROJ = (bf16*)(ws + WS_PROJ); (void)XB; (void)Y; (void)PROJ;
}
__device__ __forceinline__ void run_phase5(Frame& F0) {
    Frame F = F0; asm volatile("" : "+v"(F.tid)); F.lane = F.tid & 63;
    unsigned char* ws = F.ws; bf16* XB = (bf16*)(ws + WS_XB); bf16* Y = (bf16*)(ws + WS_Y); bf16* PROJ = (bf16*)(ws + WS_PROJ); (void)XB; (void)Y; (void)PROJ;
        pg8::Gemm g{PROJ + PC_YDN, (const bf16*)(ws + WS_WAB), 2 * M, 2 * D, DN_W, NP, M / 256, (PC_YSW - PC_YDN) * 2};
        pg8::PairedOrder S; S.init(M, D, F.G, (int)blockIdx.x);
        if (SEAM35 && F.G == 256) {
            pg8::Unit u0;
            if (S.next(0, u0) && F.wave == 0) { gu32* pc = F.ctl + CW_PAN + 64 * u0.pm;
                for (unsigned sp = 0; sp < (1u << 18); ++sp) {
                    const unsigned a0 = (unsigned)__builtin_amdgcn_readfirstlane((int)__hip_atomic_load(pc, RLX_AGENT)), a1 = (unsigned)__builtin_amdgcn_readfirstlane((int)__hip_atomic_load(pc + 1, RLX_AGENT)), a2 = (unsigned)__builtin_amdgcn_readfirstlane((int)__hip_atomic_load(pc + 2, RLX_AGENT));
                    if (a0 >= 64u && a1 >= 64u && a2 >= 7u) break;
                    __builtin_amdgcn_s_sleep(4); }
                __builtin_amdgcn_fence(__ATOMIC_ACQUIRE, "agent"); asm volatile("s_waitcnt vmcnt(0)" ::: "memory"); }
            __syncthreads(); }
#if P5_TOUCH_G
        {
            pg8::Unit u0; if (S.next(0, u0)) { const bf16* gt = PROJ + PC_G + (size_t)u0.pm * 256 * NP + u0.pn * 256;
#pragma unroll
                for (int i = 0; i < 4; ++i) { const int line = i * 512 + F.tid, half = line >> 10, row = (line >> 2) & 255, seg = line & 3;
                    __builtin_amdgcn_global_load_lds((const unsigned*)(gt + (size_t)row * NP + half * 1024 + seg * 64), (LAS unsigned*)(F.lds + LDSCTL_OFF + 1024 + F.wave * 256), 4, 0, 0); } } }
#endif
        pg8::EpiMerge E{PROJ + PC_G, NP, XB, D, M / 256, D / 256};
        pg8::gemm_phase<pg8::EpiMerge, pg8::PairedOrder, ALIGN_P5, true>(F.lds + RING_OFF, g, S, E);
        SUBSTAMP(1)
        if (SEAM56 && F.G == 256) {
            pg8::Unit u0; if (S.next(0, u0) && F.tid == 0) __hip_atomic_fetch_add(F.ctl + CW_P56 + 64 * u0.pm, 1u, RLX_AGENT); }
}
__device__ __forceinline__ void run_phase6(Frame& F0) {
    Frame F = F0; asm volatile("" : "+v"(F.tid)); F.lane = F.tid & 63;
    unsigned char* ws = F.ws; bf16* XB = (bf16*)(ws + WS_XB); bf16* Y = (bf16*)(ws + WS_Y); bf16* PROJ = (bf16*)(ws + WS_PROJ); (void)XB; (void)Y; (void)PROJ;
        SUBSTAMP(0)
        pg8::Gemm g{XB, (const bf16*)(ws + WS_WOUT), M, D, D}; pg8::StaticOrder S; S.init(M, D, F.G, (int)blockIdx.x);
        {
            pg8::Unit u0; if (P6_TOUCH_X && S.next(0, u0)) { const float* xt = FIN(0) + (size_t)u0.pm * 256 * D + u0.pn * 256;
#pragma unroll
                for (int i = 0; i < 4; ++i) { const int line = (F.wave * 4 + i) * 64 + F.lane;
                    __builtin_amdgcn_global_load_lds((const unsigned*)(xt + (size_t)(line >> 3) * D + (line & 7) * 32), (LAS unsigned*)(F.lds + LDSCTL_OFF + 1024 + F.wave * 256), 4, 0, 0); } } }
#if P6_TOUCH_AB
        {
            pg8::Unit u0; if (S.next(0, u0)) {
                const char* bt = (const char*)(ws + WS_WOUT) + (size_t)u0.pn * 256 * D * 2; const char* at = (const char*)XB + (size_t)u0.pm * 256 * D * 2;
#pragma unroll
                for (int i = 0; i < 8; ++i) { const int line = i * 512 + F.tid;
                    __builtin_amdgcn_global_load_lds((const unsigned*)(bt + (size_t)line * 128), (LAS unsigned*)(F.lds + LDSCTL_OFF + 1024 + F.wave * 256), 4, 0, 0); }
#if P6_TOUCH_AB > 1
#pragma unroll
                for (int i = 0; i < 8; ++i) { const int line = i * 512 + F.tid;
                    __builtin_amdgcn_global_load_lds((const unsigned*)(at + (size_t)line * 128), (LAS unsigned*)(F.lds + LDSCTL_OFF + 1024 + F.wave * 256), 4, 0, 0); }
#endif
            } }
#endif
        if (SEAM56 && F.G == 256) {
            pg8::Unit u0;
            if (S.next(0, u0) && F.wave == 0) {
                for (unsigned sp = 0; sp < (1u << 18); ++sp) {
                    bool ok = (unsigned)__builtin_amdgcn_readfirstlane((int)__hip_atomic_load(F.ctl + CW_P56 + 64 * u0.pm, RLX_AGENT)) >= 4u;
                    if (SEAM35 && ok) { unsigned tot = 0u;
                        for (int q = 0; q < 8; ++q) tot += (unsigned)__builtin_amdgcn_readfirstlane((int)__hip_atomic_load(F.ctl + CW_SWADONE + 64 * q, RLX_AGENT));
                        ok = tot >= (unsigned)(BATCH * SW_H * (SEQ / 32)); }
                    if (ok) break;
                    __builtin_amdgcn_s_sleep(2); }
                __builtin_amdgcn_fence(__ATOMIC_ACQUIRE, "agent"); asm volatile("s_waitcnt vmcnt(0)" ::: "memory"); }
            __syncthreads(); }
        pg8::EpiX1 E{FIN(0), F.out, Y, (float*)(ws + WS_SSQ2), D};
        pg8::gemm_phase<pg8::EpiX1, pg8::StaticOrder, ALIGN_P6, true>(F.lds + RING_OFF, g, S, E);
        if (SEAM67 && F.G == 256) { pg8::Unit u0; if (S.next(0, u0) && F.tid == 0) __hip_atomic_fetch_add(F.ctl + CW_PAN + 64 * u0.pm + 3, 1u, RLX_AGENT); }
        SUBSTAMP(2)
}
__device__ __forceinline__ void run_phase7(Frame& F0) {
    Frame F = F0; asm volatile("" : "+v"(F.tid)); F.lane = F.tid & 63;
    unsigned char* ws = F.ws; bf16* XB = (bf16*)(ws + WS_XB); bf16* Y = (bf16*)(ws + WS_Y); bf16* PROJ = (bf16*)(ws + WS_PROJ); (void)XB; (void)Y; (void)PROJ;
        pg8::Gemm g{Y, (const bf16*)(ws + WS_WGU), M, 2 * FF, D};
        pg8::EpiSwiGLU E{PROJ, FF, (const float*)(ws + WS_SSQ2), EPS};
#if SEAM67
        if (F.G == 256) {
            pg8::SkewOrder S; S.init(M, 2 * FF, F.G, (int)blockIdx.x); S.pan = (const unsigned*)(F.ctl + CW_PAN); S.p56 = (const unsigned*)(F.ctl + CW_P56); S.act_row_bytes = FF * 2; S.proj_row_bytes = NP * 2;
            pg8::Unit u0;
            if (S.next(0, u0) && F.wave == 0) {
                const int fm = u0.pm & ~7;
                for (unsigned sp = 0; sp < (1u << 18); ++sp) {
                    unsigned wc_ = 0u;
                    for (int q = 0; q < 8; ++q) wc_ += (unsigned)__builtin_amdgcn_readfirstlane((int)__hip_atomic_load(F.ctl + CW_WCOPY + 64 * q, RLX_AGENT));
                    bool ok = wc_ >= 224u * NWAVES;
                    for (int q = 0; q < 8; ++q) ok = ok && S.panel_ready(fm + q);
                    if (ok) break;
                    __builtin_amdgcn_s_sleep(4); }
                __builtin_amdgcn_fence(__ATOMIC_ACQUIRE, "agent"); asm volatile("s_waitcnt vmcnt(0)" ::: "memory"); }
            __syncthreads();
            pg8::gemm_phase<pg8::EpiSwiGLU, pg8::SkewOrder, ALIGN_P7, true>(F.lds + RING_OFF, g, S, E);
            if (SEAM78 && F.tid == 0) {
                pg8::Unit u_; for (int i_ = 0; S.next(i_, u_); ++i_) __hip_atomic_fetch_add(F.ctl + CW_PAN + 64 * u_.pm + 4, 1u, RLX_AGENT); }
            return;
        }
#endif
#if TAIL_SPLIT
        pg8::TailSplitOrder S; S.init(M, 2 * FF, F.G, (int)blockIdx.x);
#else
        pg8::StaticOrder S; S.init(M, 2 * FF, F.G, (int)blockIdx.x);
#endif
#if TAIL_SPLIT
        pg8::gemm_phase<pg8::EpiSwiGLU, pg8::TailSplitOrder, ALIGN_P7, true, true>(F.lds + RING_OFF, g, S, E);
#else
        pg8::gemm_phase<pg8::EpiSwiGLU, pg8::StaticOrder, ALIGN_P7, SP2_P7>(F.lds + RING_OFF, g, S, E);
#endif
}
__device__ __forceinline__ void run_phase8(Frame& F0) {
    Frame F = F0; asm volatile("" : "+v"(F.tid)); F.lane = F.tid & 63;
    unsigned char* ws = F.ws; bf16* XB = (bf16*)(ws + WS_XB); bf16* Y = (bf16*)(ws + WS_Y); bf16* PROJ = (bf16*)(ws + WS_PROJ); (void)XB; (void)Y; (void)PROJ;
        pg8::Gemm g{PROJ, (const bf16*)(ws + WS_WD), M, D, FF}; pg8::StaticOrder S; S.init(M, D, F.G, (int)blockIdx.x);
        if (SEAM78 && SEAM67 && F.G == 256) {
            pg8::Unit u0;
            if (S.next(0, u0) && F.wave == 0) {
                for (unsigned sp = 0; sp < (1u << 18); ++sp) {
                    bool ok = (unsigned)__builtin_amdgcn_readfirstlane((int)__hip_atomic_load(F.ctl + CW_PAN + 64 * u0.pm + 4, RLX_AGENT)) >= 22u;
                    if (ok) { unsigned tot = 0u;
                        for (int q = 0; q < 8; ++q) tot += (unsigned)__builtin_amdgcn_readfirstlane((int)__hip_atomic_load(F.ctl + CW_NORMDONE + 64 * q, RLX_AGENT));
                        ok = tot >= 4096u; }
                    if (ok) break;
                    __builtin_amdgcn_s_sleep(4); }
                __builtin_amdgcn_fence(__ATOMIC_ACQUIRE, "agent"); asm volatile("s_waitcnt vmcnt(0)" ::: "memory"); }
            __syncthreads(); }
        pg8::EpiOut E{F.out, D, Y};
        pg8::gemm_phase<pg8::EpiOut, pg8::StaticOrder, ALIGN_P8, true>(F.lds + RING_OFF, g, S, E);
}
#ifndef PROGRAM
#define PROGRAM RUN(0) BAR RUN(1) BAR RUN(2) BAR RUN(3) if (!(SEAM35 && F.G == 256)) { BAR } RUN(5) if (!(SEAM56 && F.G == 256)) { BAR } RUN(6) if (!(SEAM67 && F.G == 256)) { BAR } RUN(7) if (!(SEAM78 && SEAM67 && F.G == 256)) { BAR } RUN(8)
#endif
__global__ void __launch_bounds__(NWAVES * 64, 2) fwd_kernel(Args args) {
    extern __shared__ __attribute__((aligned(16))) unsigned char lds[];
    Frame F;
    F.lds = (LAS unsigned char*)lds;
    F.MISC = (volatile LAS unsigned*)(F.lds + MISC_OFF);
    F.tid = threadIdx.x; F.lane = F.tid & 63; F.wave = __builtin_amdgcn_readfirstlane(F.tid >> 6);
    F.G = gridDim.x; { const int bx = blockIdx.x; F.vcu = (F.G % 8 == 0) ? (bx % 8) * (F.G / 8) + bx / 8 : bx; }
    F.ka = (KArgs)__builtin_amdgcn_kernarg_segment_ptr();
    F.out = args.out; F.ws = args.ws; unsigned char* ws = args.ws;
    F.ctl = (gu32*)(ws + WS_CTL);
    for (int u = F.tid; u < (LDS_BYTES - LDSCTL_OFF) / 4; u += NWAVES * 64) ((LAS unsigned*)(F.lds + LDSCTL_OFF))[u] = 0u;
    __syncthreads();
    XcdBarrier bar; bar.bar = (unsigned*)(F.ctl + CW_BAR) + args.li * XCD_BAR_WORDS; bar.x = 0; bar.st = nullptr;
    bar = xcd_barrier_post((unsigned*)(F.ctl + CW_BAR) + args.li * XCD_BAR_WORDS, F.MISC + 8);
#if STAMP_PHASE >= 0
#if STAMP_SUB >= 0 || STAMP_DN >= 0
#define STAMP_()
#else
    int ns_ = 0;
#define STAMP_() { if (ns_ == STAMP_PHASE || ns_ == STAMP_PHASE + 1) { unsigned long long t_; asm volatile("s_memrealtime %0\n\ts_waitcnt lgkmcnt(0)" : "=s"(t_) :: "memory"); g_ts[ns_ - STAMP_PHASE] = t_; } ++ns_; }
#endif
#define RUN(k) run_phase##k(F);
#define BAR xcd_barrier(bar); STAMP_()
    STAMP_()
    PROGRAM
    BAR
#if STAMP_WS
    if (blockIdx.x == 0 && F.tid == 0) F.out[0] += (float)args.ws_mib;
#elif STAMP_DN >= 0
    if (blockIdx.x == STAMP_BLOCK && F.tid == 0) F.out[0] += (float)(g_dn[STAMP_DN]) * 0.01f;
#elif STAMP_SUB >= 0
    if (blockIdx.x == STAMP_BLOCK && F.tid == 0) F.out[0] += floorf((float)(g_sub[STAMP_SUBB] - g_sub[STAMP_SUB]) * 0.01f / STAMP_Q + 0.5f) * STAMP_Q - STAMP_OFF;
#else
    if (blockIdx.x == 0 && F.tid == 0) F.out[0] += floorf((float)(g_ts[1] - g_ts[0]) * 0.01f / STAMP_Q + 0.5f) * STAMP_Q - STAMP_OFF;
#endif
#undef RUN
#undef BAR
#else
#define RUN(k) run_phase##k(F);
#define BAR xcd_barrier(bar);
    PROGRAM
#if STAMP_WS
    BAR
    if (blockIdx.x == 0 && F.tid == 0) F.out[0] += (float)args.ws_mib;
#endif
#undef RUN
#undef BAR
#endif
}

extern "C" void kernel_launch(void* const* d_in, const int* in_sizes, int n_in, void* d_out, int out_size, void* d_ws, size_t ws_size, hipStream_t stream) {
    static int grid = 0;
    if (grid == 0) {
        if (n_in != 18 || in_sizes[0] != M * D || out_size != M * D || ws_size < WS_END) { fprintf(stderr, "kernel_launch: unexpected shapes (n_in %d, in0 %d, out %d, ws %zu)\n", n_in, n_in > 0 ? in_sizes[0] : -1, out_size, ws_size); grid = -1; return; }
        int dev = 0, cus = 0;
        if (hipGetDevice(&dev) != hipSuccess || hipDeviceGetAttribute(&cus, hipDeviceAttributeMultiprocessorCount, dev) != hipSuccess) { grid = -1; return; }
        if (hipFuncSetAttribute((const void*)fwd_kernel, hipFuncAttributeMaxDynamicSharedMemorySize, LDS_BYTES) != hipSuccess) { fprintf(stderr, "kernel_launch: hipFuncSetAttribute failed\n"); grid = -1; return; }
        int per_cu = 0;
        if (hipOccupancyMaxActiveBlocksPerMultiprocessor(&per_cu, (const void*)fwd_kernel, NWAVES * 64, LDS_BYTES) != hipSuccess || per_cu < 1) fprintf(stderr, "kernel_launch: occupancy query reports %d\n", per_cu);
        (void)hipGetLastError();
        grid = cus;
    }
    if (grid < 0) return;
    if (hipMemsetAsync((char*)d_ws + WS_CTL, 0, CTL_ZERO_BYTES, stream) != hipSuccess) return;
    Args a{};
    for (int i = 0; i < 18; ++i) a.in[i] = (const float*)d_in[i];
    a.out = (float*)d_out; a.ws = (unsigned char*)d_ws; a.ws_mib = (int)(ws_size >> 20);
    for (int li = 0; li < 1; ++li) {
        a.ph_lo = 0; a.ph_hi = 0;
        a.li = li;
        hipLaunchKernelGGL(fwd_kernel, dim3(grid), dim3(NWAVES * 64), LDS_BYTES, stream, a);
        const hipError_t le = hipPeekAtLastError();
        if (le != hipSuccess) { fprintf(stderr, "kernel_launch: launch %d failed: %s\n", li, hipGetErrorName(le)); break; }
    }
}
```

```cpp
#ifndef FAST_SWA
#define FAST_SWA 1
#endif
#ifndef FAST_DN
#define FAST_DN 1
#endif
#ifndef REP_DNA
#define REP_DNA 1
#endif
#ifndef REP_SWAPRE
#define REP_SWAPRE 1
#endif
#ifndef REP_S1
#define REP_S1 1
#endif
#ifndef REP_S2
#define REP_S2 1
#endif
#ifndef REP_S3A
#define REP_S3A 1
#endif
#ifndef REP_S3B
#define REP_S3B 1
#endif
#ifndef REP_S4
#define REP_S4 1
#endif
#ifndef S1_RELOAD
#define S1_RELOAD 0
#endif
#ifndef S1_OPAQUE
#define S1_OPAQUE 0
#endif
#ifndef P1_TILES
#define P1_TILES 12
#endif
#ifndef STAMP_PHASE
#define STAMP_PHASE -1
#endif
#ifndef STAMP_SUB
#define STAMP_SUB -1
#endif
#ifndef STAMP_BLOCK
#define STAMP_BLOCK 0
#endif
#ifndef STAMP_DN
#define STAMP_DN -1
#endif
#ifndef STAMP_WS
#define STAMP_WS 0
#endif
#ifndef P3_SKIP_SCAN
#define P3_SKIP_SCAN 0
#endif
#ifndef P3_SKIP_GEMM
#define P3_SKIP_GEMM 0
#endif
#ifndef SCAN_HOT
#define SCAN_HOT 0
#endif
#ifndef STAMP_Q
#define STAMP_Q 8.0f
#endif
#ifndef SCAN_AHEAD
#define SCAN_AHEAD 6
#endif
#ifndef SCAN_TOUCH_EN
#define SCAN_TOUCH_EN 0
#endif
#ifndef DEFER_WEIGHTS
#define DEFER_WEIGHTS 1
#endif
#ifndef P3_ONLY_SCAN
#define P3_ONLY_SCAN 0
#endif
#ifndef ALIGN_P7
#define ALIGN_P7 true
#endif
#ifndef ALIGN_P1
#define ALIGN_P1 true
#endif
#ifndef ALIGN_P5
#define ALIGN_P5 true
#endif
#ifndef ALIGN_P6
#define ALIGN_P6 true
#endif
#ifndef ALIGN_P8
#define ALIGN_P8 true
#endif
#ifndef SP2_P7
#define SP2_P7 true
#endif
#ifndef P3_ORDER
#define P3_ORDER 0
#endif
#ifndef SCAN_SETS
#define SCAN_SETS 4
#endif
#ifndef DNA_PREFETCH
#define DNA_PREFETCH 0
#endif
#ifndef SCAN_NT
#define SCAN_NT 0
#endif
#ifndef FUSE_QKNORM
#define FUSE_QKNORM 1
#endif
#ifndef STAMP_SUBB
#define STAMP_SUBB (STAMP_SUB + 1)
#endif
#ifndef SCAN_UPRE
#define SCAN_UPRE 2
#endif
#ifndef SCAN_PUBLISH
#define SCAN_PUBLISH 1
#endif
#ifndef SCAN_DRAIN_CNT
#define SCAN_DRAIN_CNT 0
#endif
#ifndef SCAN_O_SC1
#define SCAN_O_SC1 1
#endif
#ifndef SCAN_REFILL_LATE
#define SCAN_REFILL_LATE 1
#endif
#ifndef SCAN_O16
#define SCAN_O16 1
#endif
#ifndef STAMP_OFF
#define STAMP_OFF 0.0f
#endif
#ifndef DNO_SLEEP
#define DNO_SLEEP 8
#endif
#ifndef DNO_SKIPWORK
#define DNO_SKIPWORK 0
#endif
#ifndef DNO_SKIPALL
#define DNO_SKIPALL 0
#endif
#ifndef SCAN_PUB_LOADER
#define SCAN_PUB_LOADER 1
#endif
#ifndef SCAN_PUB_EVERY
#define SCAN_PUB_EVERY 1
#endif
#ifndef DNO_FENCE
#define DNO_FENCE 0
#endif
#ifndef SCAN_DRAIN_NONE
#define SCAN_DRAIN_NONE 0
#endif
#ifndef DNO_LAG
#define DNO_LAG 0
#endif
#ifndef EPI_WT
#define EPI_WT 0
#endif
#ifndef TAIL_SPLIT
#define TAIL_SPLIT 0
#endif
#ifndef GEMM_SAMETILE
#define GEMM_SAMETILE 0
#endif
#ifndef STAMP_EPI
#define STAMP_EPI 0
#endif
#ifndef SEAM56
#define SEAM56 1
#endif
#ifndef SCAN_QG_EARLY
#define SCAN_QG_EARLY 0
#endif
#ifndef BAR_EARLY_WB
#define BAR_EARLY_WB 0
#endif
#ifndef P0_DEEP
#define P0_DEEP 0
#endif
#ifndef DNO_STAGE
#define DNO_STAGE 1
#endif
#ifndef SEAM35
#define SEAM35 1
#endif
#ifndef P6_TOUCH_AB
#define P6_TOUCH_AB 0
#endif
#ifndef P5_TOUCH_G
#define P5_TOUCH_G 0
#endif
#ifndef P6_TOUCH_X
#define P6_TOUCH_X 0
#endif
#ifndef SEAM67
#define SEAM67 1
#endif
#ifndef SKEW_TAIL
#define SKEW_TAIL 1
#endif
#ifndef SEAM78
#define SEAM78 0
#endif
#ifndef ASYM_WCOPY
#define ASYM_WCOPY 1
#endif
#ifndef ASYM_DNO
#define ASYM_DNO 1
#endif
#include <hip/hip_runtime.h>
#include <cstdio>
#include <cstdint>

#ifndef WGM_KNOB
#define WGM_KNOB 8
#endif
#ifndef EPI_REP
#define EPI_REP 1
#endif
#ifndef EPI_REP_WHICH
#define EPI_REP_WHICH 0
#endif
#ifndef RES_F32
#define RES_F32 0
#endif
#if STAMP_SUB >= 0
__device__ unsigned long long g_sub[8];
#define SUBSTAMP(i) if (blockIdx.x == STAMP_BLOCK && threadIdx.x == 0) g_sub[i] = __builtin_amdgcn_s_memrealtime();
#else
#define SUBSTAMP(i)
#endif
namespace pg8 {
#define PG8_LAS __attribute__((address_space(3)))
typedef unsigned short bf16_t;
typedef short bf16x8 __attribute__((ext_vector_type(8)));
typedef float f32x4 __attribute__((ext_vector_type(4)));
typedef unsigned u32x4 __attribute__((ext_vector_type(4)));
typedef unsigned u32x2 __attribute__((ext_vector_type(2)));
constexpr int BM = 256, BK = 64, HALF = 128, HTB = HALF * BK * 2  , STAGE_BYTES = 8 * HTB, NXCD = 8, WGM = WGM_KNOB;

__host__ __device__ __forceinline__ int lds_byte(int r, int c) { const int st = (r >> 4) * 2 + (c >> 5), rr = r & 15, cc = c & 31, ob = rr * 64 + cc * 2; return st * 1024 + (ob ^ (((ob >> 9) & 1) << 5)); }
__host__ __device__ __forceinline__ void stage_rc(int b, int& R, int& C) { const int st = b / 1024, sb = b % 1024, swz = sb ^ (((sb >> 9) & 1) << 5); R = (st >> 1) * 16 + swz / 64; C = (st & 1) * 32 + (swz % 64) / 2; }
__host__ __device__ __forceinline__ int perm32(int rho) { const int n = rho >> 4, i = rho & 15; return 8 * (i >> 2) + 4 * n + (i & 3); }

struct Unit { int pm, pn, hm, chk; };
struct Gemm { const bf16_t* A; const bf16_t* Bt; int M, N, K; int lda = 0, nMA = 1 << 30, a2off = 0; };

struct StaticOrder {
    int nM, nN, nwg, G, c;
    __host__ __device__ void init(int M, int N, int G_, int c_) { nM = M / BM; nN = N / BM; nwg = nM * nN; G = G_; c = c_; }
    __host__ __device__ bool next(int i, Unit& u) const { return nextL((long)i * G + c, u); }
    __host__ __device__ bool nextL(long L, Unit& u) const {
        if (L >= nwg) return false;
        u.hm = 0; u.chk = 0;
        int wgid = (int)L; { const int q = nwg / NXCD, r = nwg % NXCD, xcd = wgid % NXCD, off = wgid / NXCD; wgid = (xcd < r ? xcd * (q + 1) : r * (q + 1) + (xcd - r) * q) + off; }
        const int nig = WGM * nN, gid = wgid / nig, fm = gid * WGM, gsz = (nM - fm) < WGM ? (nM - fm) : WGM;
        u.pm = fm + ((wgid % nig) % gsz); u.pn = (wgid % nig) / gsz; return true;
    }
    __device__ __forceinline__ void a_ready(const Unit&) const {}
    __device__ __forceinline__ void done(const Unit&) const {}
};
struct TailSplitOrder {
    StaticOrder so; int full, rem; bool split;
    __host__ __device__ void init(int M, int N, int G_, int c_) { so.init(M, N, G_, c_); full = so.nwg / G_; rem = so.nwg - full * G_; split = TAIL_SPLIT && rem > 0 && 2 * rem <= G_; }
    __host__ __device__ bool next(int i, Unit& u) const {
        if (i < full || !split) return so.next(i, u);
        if (i > full || so.c >= 2 * rem) return false;
        if (!so.nextL((long)full * so.G + (so.c >> 1), u)) return false;
        u.hm = 1 + (so.c & 1); return true;
    }
    __device__ __forceinline__ void a_ready(const Unit&) const {}
    __device__ __forceinline__ void done(const Unit&) const {}
};
struct SkewOrder {
    StaticOrder so; const unsigned* pan; const unsigned* p56; int act_row_bytes, proj_row_bytes;
    __host__ __device__ void init(int M, int N, int G_, int c_) { so.init(M, N, G_, c_); }
    __host__ __device__ bool next(int i, Unit& u) const {
        const int full = so.nwg / so.G;
        if (i < full || !SKEW_TAIL) return so.next(i, u);
        if (i > full) return false;
        const int x = so.c & 7, off = so.c >> 3; if (x & 1) return false;
        if (!so.nextL((long)full * so.G + 8 * (off >> 1) + x + (off & 1), u)) return false;
        u.chk = off & 1; return true;
    }
    __device__ __forceinline__ bool panel_ready(int pm) const {
        bool ok = (unsigned)__builtin_amdgcn_readfirstlane((int)__hip_atomic_load(pan + 64 * pm + 3, __ATOMIC_RELAXED, __HIP_MEMORY_SCOPE_AGENT)) >= 4u;
        const int lo = (pm * act_row_bytes) / proj_row_bytes, hi = ((pm + 1) * act_row_bytes - 1) / proj_row_bytes;
        for (int q = lo; q <= hi; ++q) ok = ok && (unsigned)__builtin_amdgcn_readfirstlane((int)__hip_atomic_load(p56 + 64 * q, __ATOMIC_RELAXED, __HIP_MEMORY_SCOPE_AGENT)) >= 4u;
        return ok;
    }
    __device__ __forceinline__ void a_ready(const Unit& u) const {
        if (u.chk) {
            if (threadIdx.x < 64) {
                for (unsigned sp = 0; !panel_ready(u.pm) && sp < (1u << 18); ++sp) __builtin_amdgcn_s_sleep(2);
                __builtin_amdgcn_fence(__ATOMIC_ACQUIRE, "agent"); asm volatile("s_waitcnt vmcnt(0)" ::: "memory"); }
            asm volatile("" ::: "memory"); __builtin_amdgcn_s_barrier(); asm volatile("" ::: "memory");
        }
    }
    __device__ __forceinline__ void done(const Unit&) const {}
};
struct PairedOrder {
    StaticOrder so;
    __host__ __device__ void init(int M, int N, int G_, int c_) { so.init(M, N, G_, c_); }
    __host__ __device__ bool next(int i, Unit& u) const { if (!so.next(i >> 1, u)) return false; if (i & 1) { u.pm += so.nM; u.pn += so.nN; } return true; }
    __device__ __forceinline__ void a_ready(const Unit&) const {}
    __device__ __forceinline__ void done(const Unit&) const {}
};

__device__ __forceinline__ unsigned cvt_pk_bf16(float lo, float hi) { unsigned r; asm volatile("v_cvt_pk_bf16_f32 %0, %1, %2" : "=v"(r) : "v"(lo), "v"(hi)); return r; }
__device__ __forceinline__ float bf_lo(unsigned w) { return __builtin_bit_cast(float, w << 16); }
__device__ __forceinline__ float bf_hi(unsigned w) { return __builtin_bit_cast(float, w & 0xffff0000u); }
__device__ __forceinline__ float sigmoidf_(float x) { return 1.0f / (1.0f + __expf(-x)); }
template <class V> __device__ __forceinline__ void st16wt(void* p, V v) {
    asm volatile("global_store_dwordx4 %0, %1, off sc1\n\ts_nop 1" :: "v"((__attribute__((address_space(1))) V*)p), "v"(v) : "memory");
}
template <class V> __device__ __forceinline__ void st16(void* p, V v) {
#if EPI_WT
    asm volatile("global_store_dwordx4 %0, %1, off sc1\n\ts_nop 1" :: "v"((__attribute__((address_space(1))) V*)p), "v"(v) : "memory");
#else
    *(V*)p = v;
#endif
}


struct EpiProj {
    static constexpr bool SUBST = false, PERM = true, AFTER_DRAIN = false, PROBE_REP = (EPI_REP_WHICH == 1);
    bf16_t* O; int ldc; const float* rstd; int gate_pn0, pn_off;
    bf16_t* QS; bf16_t* KS; const float* qg; const float* kg; int q_pn0, k_pn;
    float qscale; int seq; int wt = 0;
    __device__ __forceinline__ bool keep(const Unit&) const { return false; }
    __device__ __forceinline__ void operator()(f32x4 (&acc)[2][2][4][2], const Unit& u, int wr, int wc, int fr, int fq) const {
        const int pna = u.pn + pn_off;
        const int row0 = u.pm * BM + wr * 64 + fr, col0 = pna * BM + wc * 64 + 8 * fq; const bool gate = pna >= gate_pn0;
        float sr[2][4];
#pragma unroll
        for (int ai = 0; ai < 2; ++ai)
#pragma unroll
            for (int m = 0; m < 4; ++m) sr[ai][m] = rstd[row0 + ai * HALF + m * 16];
        const bool isq = QS != nullptr && (pna == q_pn0 || pna == q_pn0 + 1), isk = QS != nullptr && pna == k_pn && wc < 2;
        if (isq || isk) {
            f32x4 gn[2][2];
#pragma unroll
            for (int bj = 0; bj < 2; ++bj)
#pragma unroll
                for (int n = 0; n < 2; ++n) { const int d = 32 * bj + 8 * fq + 4 * n; gn[bj][n] = isq ? *(const f32x4*)(qg + d) * qscale : *(const f32x4*)(kg + d); }
#pragma unroll
            for (int ai = 0; ai < 2; ++ai)
#pragma unroll
                for (int m = 0; m < 4; ++m) { const int row = row0 + ai * HALF + m * 16; const float s = sr[ai][m];
                    float ss = 0.f;
#pragma unroll
                    for (int bj = 0; bj < 2; ++bj)
#pragma unroll
                        for (int n = 0; n < 2; ++n) { const f32x4 v = acc[ai][bj][m][n] * s; ss += (v[0] * v[0] + v[1] * v[1]) + (v[2] * v[2] + v[3] * v[3]); }
                    ss += __shfl_xor(ss, 16); ss += __shfl_xor(ss, 32);
                    const float r = s * __builtin_amdgcn_rsqf(ss * (1.0f / 64.0f) + 1e-6f);
                    bf16_t* dst = isq ? QS + (size_t)row * 512 + (pna - q_pn0) * 256 + wc * 64 + 8 * fq
                                      : KS + ((size_t)((row / seq) * 2 + wc) * seq + (row % seq)) * 64 + 8 * fq;
#pragma unroll
                    for (int bj = 0; bj < 2; ++bj) { const f32x4 v0 = acc[ai][bj][m][0] * r * gn[bj][0], v1 = acc[ai][bj][m][1] * r * gn[bj][1];
                        u32x4 w; w.x = cvt_pk_bf16(v0[0], v0[1]); w.y = cvt_pk_bf16(v0[2], v0[3]); w.z = cvt_pk_bf16(v1[0], v1[1]); w.w = cvt_pk_bf16(v1[2], v1[3]);
                        st16(dst + bj * 32, w); } }
            return;
        }
#pragma unroll
        for (int ai = 0; ai < 2; ++ai)
#pragma unroll
            for (int m = 0; m < 4; ++m) { const int row = row0 + ai * HALF + m * 16; const float s = sr[ai][m]; bf16_t* rowp = O + (size_t)row * ldc + col0;
#pragma unroll
                for (int bj = 0; bj < 2; ++bj) { f32x4 v0 = acc[ai][bj][m][0] * s, v1 = acc[ai][bj][m][1] * s;
                    if (gate) {
#pragma unroll
                        for (int j = 0; j < 4; ++j) { v0[j] = __builtin_amdgcn_rcpf(1.0f + __expf(-v0[j])); v1[j] = __builtin_amdgcn_rcpf(1.0f + __expf(-v1[j])); } }
                    u32x4 w; w.x = cvt_pk_bf16(v0[0], v0[1]); w.y = cvt_pk_bf16(v0[2], v0[3]); w.z = cvt_pk_bf16(v1[0], v1[1]); w.w = cvt_pk_bf16(v1[2], v1[3]);
                    if (wt) st16wt(rowp + bj * 32, w); else st16(rowp + bj * 32, w); } }
    }
};
struct EpiMerge {
    static constexpr bool SUBST = false, PERM = true, AFTER_DRAIN = false, PROBE_REP = false;
    const bf16_t* G; int ldg; bf16_t* O; int ldc; int nM, nN;
    __device__ __forceinline__ bool keep(const Unit& u) const { return u.pm < nM; }
    __device__ __forceinline__ void operator()(f32x4 (&acc)[2][2][4][2], const Unit& u, int wr, int wc, int fr, int fq) const {
        const bool second = u.pm >= nM; const int pm = second ? u.pm - nM : u.pm, pn = second ? u.pn - nN : u.pn;
        const int row0 = pm * BM + wr * 64 + fr, col0 = pn * BM + wc * 64 + 8 * fq;
#pragma unroll
        for (int ai = 0; ai < 2; ++ai) {
            u32x4 gA[4][2], gB[4][2];
#pragma unroll
            for (int m = 0; m < 4; ++m)
#pragma unroll
                for (int bj = 0; bj < 2; ++bj) { const size_t o = (size_t)(row0 + ai * HALF + m * 16) * ldg + col0 + bj * 32; if (!second) gA[m][bj] = *(const u32x4*)(G + o); gB[m][bj] = *(const u32x4*)(G + o + 1024); }
#pragma unroll
            for (int m = 0; m < 4; ++m) { const int row = row0 + ai * HALF + m * 16;
#pragma unroll
                for (int bj = 0; bj < 2; ++bj) { const int col = col0 + bj * 32;
                    float sb[8];
#pragma unroll
                    for (int j = 0; j < 4; ++j) { sb[2 * j] = bf_lo(gB[m][bj][j]); sb[2 * j + 1] = bf_hi(gB[m][bj][j]); }
                    if (!second) {
                        float sa[8];
#pragma unroll
                        for (int j = 0; j < 4; ++j) { sa[2 * j] = bf_lo(gA[m][bj][j]); sa[2 * j + 1] = bf_hi(gA[m][bj][j]); }
#pragma unroll
                        for (int j = 0; j < 4; ++j) { acc[ai][bj][m][0][j] *= sa[j] * __builtin_amdgcn_rcpf(sb[j]); acc[ai][bj][m][1][j] *= sa[4 + j] * __builtin_amdgcn_rcpf(sb[4 + j]); }
                    } else {
                        f32x4 v0, v1;
#pragma unroll
                        for (int j = 0; j < 4; ++j) { v0[j] = acc[ai][bj][m][0][j] * sb[j]; v1[j] = acc[ai][bj][m][1][j] * sb[4 + j]; }
                        u32x4 w; w.x = cvt_pk_bf16(v0[0], v0[1]); w.y = cvt_pk_bf16(v0[2], v0[3]); w.z = cvt_pk_bf16(v1[0], v1[1]); w.w = cvt_pk_bf16(v1[2], v1[3]);
                        if (SEAM56) st16wt(O + (size_t)row * ldc + col, w); else st16(O + (size_t)row * ldc + col, w); } } }
            asm volatile("" ::: "memory"); }
    }
};
struct EpiX1 {
    static constexpr bool SUBST = (STAMP_EPI == 6), PERM = (SEAM67 != 0), AFTER_DRAIN = false, PROBE_REP = (EPI_REP_WHICH == 6);
    const float* X; float* out; bf16_t* xb; float* ssq; int ldc;
    __device__ __forceinline__ bool keep(const Unit&) const { return false; }
    __device__ __forceinline__ void operator()(f32x4 (&acc)[2][2][4][2], const Unit& u, int wr, int wc, int fr, int fq) const {
        const int row0 = u.pm * BM + wr * 64 + fr, col0 = u.pn * BM + wc * 32 + (PERM ? 8 : 4) * fq; constexpr int NOFF = PERM ? 4 : 16;
#pragma unroll
        for (int ai = 0; ai < 2; ++ai) {
            f32x4 xv[4][2][2];
#pragma unroll
            for (int m = 0; m < 4; ++m)
#pragma unroll
                for (int bj = 0; bj < 2; ++bj)
#pragma unroll
                    for (int n = 0; n < 2; ++n) xv[m][bj][n] = *(const f32x4*)(X + (size_t)(row0 + ai * HALF + m * 16) * ldc + col0 + bj * HALF + n * NOFF);
#pragma unroll
            for (int m = 0; m < 4; ++m) { const int row = row0 + ai * HALF + m * 16; const size_t off = (size_t)row * ldc + col0; float ss = 0.f;
#pragma unroll
                for (int bj = 0; bj < 2; ++bj) { u32x4 w4;
#pragma unroll
                    for (int n = 0; n < 2; ++n) { const f32x4 o = xv[m][bj][n] + acc[ai][bj][m][n];
                        if (RES_F32) *(f32x4*)(out + off + bj * HALF + n * NOFF) = o; ss += (o[0] * o[0] + o[1] * o[1]) + (o[2] * o[2] + o[3] * o[3]);
                        u32x2 w; w.x = cvt_pk_bf16(o[0], o[1]); w.y = cvt_pk_bf16(o[2], o[3]);
                        if (PERM) { if (n == 0) { w4.x = w.x; w4.y = w.y; } else { w4.z = w.x; w4.w = w.y; } }
                        else *(u32x2*)(xb + off + bj * HALF + n * 16) = w; }
                    if (PERM) st16wt(xb + off + bj * HALF, w4); }
                ss += __shfl_xor(ss, 16); ss += __shfl_xor(ss, 32);
                if (fq == 0) atomicAdd(ssq + row, ss); }
            asm volatile("" ::: "memory"); }
    }
};
struct EpiSwiGLU {
    static constexpr bool SUBST = false, PERM = true, AFTER_DRAIN = false, PROBE_REP = (EPI_REP_WHICH == 7);
    bf16_t* O; int ldc; const float* ssq; float eps;
    __device__ __forceinline__ bool keep(const Unit&) const { return false; }
    __device__ __forceinline__ void operator()(f32x4 (&acc)[2][2][4][2], const Unit& u, int wr, int wc, int fr, int fq) const {
        const int row0 = u.pm * BM + (u.hm == 2 ? HALF : 0) + wr * 64 + fr, col0 = u.pn * HALF + wc * 32 + 8 * fq;
        float sr[2][4];
#pragma unroll
        for (int ai = 0; ai < 2; ++ai)
#pragma unroll
            for (int m = 0; m < 4; ++m) sr[ai][m] = ssq[row0 + (u.hm ? 0 : ai * HALF) + m * 16];
#pragma unroll
        for (int ai = 0; ai < 2; ++ai)
#pragma unroll
            for (int m = 0; m < 4; ++m) { const int row = row0 + ai * HALF + m * 16;
                if (ai == 1 && u.hm) continue;
                const float s = __builtin_amdgcn_rsqf(sr[ai][m] * (1.0f / 1024.0f) + eps);
                float a[8];
#pragma unroll
                for (int n = 0; n < 2; ++n)
#pragma unroll
                    for (int j = 0; j < 4; ++j) { const float g = acc[ai][0][m][n][j] * s, up = acc[ai][1][m][n][j] * s; a[4 * n + j] = g * up * __builtin_amdgcn_rcpf(1.0f + __expf(-g)); }
                u32x4 w; w.x = cvt_pk_bf16(a[0], a[1]); w.y = cvt_pk_bf16(a[2], a[3]); w.z = cvt_pk_bf16(a[4], a[5]); w.w = cvt_pk_bf16(a[6], a[7]);
                if (SEAM78) st16wt(O + (size_t)row * ldc + col0, w); else st16(O + (size_t)row * ldc + col0, w); }
    }
};
struct EpiOut {
    static constexpr bool SUBST = (STAMP_EPI == 8), PERM = false, AFTER_DRAIN = false, PROBE_REP = false;
    float* out; int ldc; const bf16_t* xb;
    __device__ __forceinline__ bool keep(const Unit&) const { return false; }
    __device__ __forceinline__ void operator()(f32x4 (&acc)[2][2][4][2], const Unit& u, int wr, int wc, int fr, int fq) const {
        const int row0 = u.pm * BM + wr * 64 + fr, col0 = u.pn * BM + wc * 32 + 4 * fq;
#pragma unroll
        for (int ai = 0; ai < 2; ++ai) {
            u32x2 rb[4][2][2]; f32x4 rf[4][2][2];
#pragma unroll
            for (int m = 0; m < 4; ++m)
#pragma unroll
                for (int bj = 0; bj < 2; ++bj)
#pragma unroll
                    for (int n = 0; n < 2; ++n) { const size_t o = (size_t)(row0 + ai * HALF + m * 16) * ldc + col0 + bj * HALF + n * 16;
                        if (RES_F32) rf[m][bj][n] = *(const f32x4*)(out + o); else rb[m][bj][n] = *(const u32x2*)(xb + o); }
#pragma unroll
            for (int m = 0; m < 4; ++m) { const size_t off = (size_t)(row0 + ai * HALF + m * 16) * ldc + col0;
#pragma unroll
                for (int bj = 0; bj < 2; ++bj)
#pragma unroll
                    for (int n = 0; n < 2; ++n) { f32x4 b;
                        if (RES_F32) b = rf[m][bj][n]; else { const u32x2 w = rb[m][bj][n]; b = (f32x4){bf_lo(w.x), bf_hi(w.x), bf_lo(w.y), bf_hi(w.y)}; }
                        *(f32x4*)(out + off + bj * HALF + n * 16) = b + acc[ai][bj][m][n]; } }
            asm volatile("" ::: "memory"); }
    }
};

template <class Epi, class Sched, bool ALIGN_EPI = false, bool SP2 = false, bool HM = false>
__device__ __forceinline__ void gemm_phase(PG8_LAS unsigned char* lds, const Gemm g, const Sched& S, const Epi& E) {
    int tid_ = threadIdx.x; asm volatile("" : "+v"(tid_));
    const int tid = tid_, wid = __builtin_amdgcn_readfirstlane(tid >> 6), lane = tid & 63, wr = wid >> 2, wc = wid & 3, fr = lane & 15, fq = lane >> 4;
    const int K = g.K, nt = K / BK, LDA = g.lda ? g.lda : g.K;
    unsigned voffA[2], voffB[2];
#pragma unroll
    for (int i = 0; i < 2; ++i) { int R, C; stage_rc(tid * 16 + i * 8192, R, C); const int Rb = Epi::PERM ? ((R & ~31) + perm32(R & 31)) : R;
        voffA[i] = (unsigned)(R * LDA + C) * 2u; voffB[i] = (unsigned)(Rb * K + C) * 2u; }
    const size_t kstep = (size_t)(BK * 2);
    const size_t hstep = (size_t)HALF * K * 2;
    const size_t tstep = 2 * hstep;
    const size_t hstepA = (size_t)HALF * LDA * 2, tstepA = 2 * hstepA;
#define PG8_ABASE(pm_) ((const char*)g.A + (GEMM_SAMETILE ? (size_t)0 : ((pm_) < g.nMA ? (size_t)(pm_) * tstepA : (size_t)((pm_) - g.nMA) * tstepA + (size_t)g.a2off)))
    const unsigned ldsw = (unsigned)wid * 1024u;
    const int aoff = lds_byte(wr * 64 + fr, fq * 8), boff = lds_byte(wc * 32 + fr, fq * 8);
#define PG8_SA(b, h) (((b) * 2 + (h)) * HTB)
#define PG8_SB(b, h) ((4 + (b) * 2 + (h)) * HTB)
#define PG8_STAGE(bufoff, gbase, voff) do { _Pragma("unroll") for (int _i = 0; _i < 2; ++_i) \
        __builtin_amdgcn_global_load_lds((const unsigned*)((const char*)(gbase) + (voff)[_i]), (PG8_LAS unsigned*)(lds + (bufoff) + ldsw + _i * 8192), 16, 0, 0); } while (0)
#define PG8_LDA(dst, b, h) do { _Pragma("unroll") for (int m = 0; m < 4; ++m) _Pragma("unroll") for (int k = 0; k < 2; ++k) dst[m][k] = *(const PG8_LAS bf16x8*)(lds + PG8_SA(b, h) + aoff + m * 2048 + k * 1024); } while (0)
#define PG8_LDB(dst, b, h) do { _Pragma("unroll") for (int n = 0; n < 2; ++n) _Pragma("unroll") for (int k = 0; k < 2; ++k) dst[n][k] = *(const PG8_LAS bf16x8*)(lds + PG8_SB(b, h) + boff + n * 2048 + k * 1024); } while (0)
#define PG8_MMA(ai, bj, At, Bt) do { __builtin_amdgcn_s_setprio(1); _Pragma("unroll") for (int m = 0; m < 4; ++m) _Pragma("unroll") for (int n = 0; n < 2; ++n) _Pragma("unroll") for (int k = 0; k < 2; ++k) \
        acc[ai][bj][m][n] = __builtin_amdgcn_mfma_f32_16x16x32_bf16(Bt[n][k], At[m][k], acc[ai][bj][m][n], 0, 0, 0); __builtin_amdgcn_s_setprio(0); } while (0)
#define PG8_WAIT_V(n) asm volatile("s_waitcnt vmcnt(" #n ")" ::: "memory")
#define PG8_WAIT_L(n) asm volatile("s_waitcnt lgkmcnt(" #n ")" ::: "memory")
#define PG8_BAR __builtin_amdgcn_s_barrier()
#define PG8_SCHED __builtin_amdgcn_sched_barrier(0)
    Unit cur, nxt; int ui = 0;
    if (!S.next(0, cur)) return;
    f32x4 acc[2][2][4][2];
#pragma unroll
    for (int a = 0; a < 2; ++a)
#pragma unroll
        for (int b = 0; b < 2; ++b)
#pragma unroll
            for (int m = 0; m < 4; ++m)
#pragma unroll
                for (int n = 0; n < 2; ++n) acc[a][b][m][n] = (f32x4){0.f, 0.f, 0.f, 0.f};
    bf16x8 At[4][2], B0[2][2], B1[2][2];
    static_assert(!HM || SP2, "half units: SP2 schedule only");
    bool chalf = HM && cur.hm != 0; size_t cH = chalf ? 0 : hstepA;
    const char* cA = PG8_ABASE(cur.pm) + ((HM && cur.hm == 2) ? hstepA : 0); const char* cB = (const char*)g.Bt + (GEMM_SAMETILE ? (size_t)0 : (size_t)cur.pn * tstep);
    S.a_ready(cur);
    if constexpr (SP2) {
        PG8_STAGE(PG8_SB(0, 0), cB, voffB); PG8_STAGE(PG8_SB(0, 1), cB + hstep, voffB); PG8_STAGE(PG8_SA(0, 0), cA, voffA); PG8_STAGE(PG8_SA(0, 1), cA + cH, voffA);
        if (wr == 1) PG8_BAR;
        PG8_WAIT_V(2); PG8_BAR;
        PG8_STAGE(PG8_SB(1, 0), cB + kstep, voffB); PG8_STAGE(PG8_SA(1, 0), cA + kstep, voffA); PG8_STAGE(PG8_SB(1, 1), cB + hstep + kstep, voffB);
        PG8_WAIT_V(6); PG8_BAR;
    } else {
        PG8_STAGE(PG8_SB(0, 0), cB, voffB); PG8_STAGE(PG8_SA(0, 0), cA, voffA); PG8_STAGE(PG8_SB(0, 1), cB + hstep, voffB); PG8_STAGE(PG8_SA(0, 1), cA + cH, voffA);
        if (wr == 1) PG8_BAR;
        PG8_WAIT_V(4); PG8_BAR;
        PG8_STAGE(PG8_SB(1, 0), cB + kstep, voffB); PG8_STAGE(PG8_SA(1, 0), cA + kstep, voffA); PG8_STAGE(PG8_SB(1, 1), cB + hstep + kstep, voffB);
        PG8_WAIT_V(6); PG8_BAR;
    }
    for (;;) {
        const bool has_next = S.next(ui + 1, nxt);
        const bool nhalf = has_next ? (HM && nxt.hm != 0) : chalf; const size_t nH = nhalf ? 0 : hstepA;
        const char* nA = has_next ? PG8_ABASE(nxt.pm) + ((HM && nxt.hm == 2) ? hstepA : 0) : cA; const char* nB = has_next ? (const char*)g.Bt + (GEMM_SAMETILE ? (size_t)0 : (size_t)nxt.pn * tstep) : cB;
        for (int t = 0; t < nt; t += 2) {
            const bool last = (t == nt - 2);
            const char* a1 = cA + (size_t)(t + 1) * kstep;
            const char* a2 = last ? nA : cA + (size_t)(t + 2) * kstep; const char* b2 = last ? nB : cB + (size_t)(t + 2) * kstep;
            const char* a3 = a2 + kstep; const char* b3 = b2 + kstep;
            const size_t h2 = last ? nH : cH;
            if (last && has_next) S.a_ready(nxt);
            if constexpr (SP2) {
            PG8_LDB(B0, 0, 0); PG8_LDB(B1, 0, 1); PG8_SCHED; PG8_LDA(At, 0, 0); PG8_STAGE(PG8_SA(1, 1), a1 + cH, voffA);
            PG8_WAIT_V(8); PG8_WAIT_L(0); PG8_BAR; PG8_MMA(0, 0, At, B0); PG8_MMA(0, 1, At, B1); PG8_BAR; PG8_SCHED;
            if (!chalf) PG8_LDA(At, 0, 1); PG8_STAGE(PG8_SB(0, 0), b2, voffB); PG8_STAGE(PG8_SB(0, 1), b2 + hstep, voffB); PG8_STAGE(PG8_SA(0, 0), a2, voffA);
            PG8_WAIT_V(8); PG8_WAIT_L(0); PG8_BAR; if (!chalf) { PG8_MMA(1, 0, At, B0); PG8_MMA(1, 1, At, B1); } PG8_BAR; PG8_SCHED;
            PG8_LDB(B0, 1, 0); PG8_LDB(B1, 1, 1); PG8_SCHED; PG8_LDA(At, 1, 0); PG8_STAGE(PG8_SA(0, 1), a2 + h2, voffA);
            PG8_WAIT_V(8); PG8_WAIT_L(0); PG8_BAR; PG8_MMA(0, 0, At, B0); PG8_MMA(0, 1, At, B1); PG8_BAR; PG8_SCHED;
            if (!chalf) PG8_LDA(At, 1, 1); PG8_STAGE(PG8_SB(1, 0), b3, voffB); PG8_STAGE(PG8_SB(1, 1), b3 + hstep, voffB); PG8_STAGE(PG8_SA(1, 0), a3, voffA);
            PG8_WAIT_V(8); PG8_WAIT_L(0); PG8_BAR; if (!chalf) { PG8_MMA(1, 0, At, B0); PG8_MMA(1, 1, At, B1); } PG8_BAR; PG8_SCHED;
            } else {
            PG8_LDB(B0, 0, 0); PG8_SCHED; PG8_LDA(At, 0, 0); PG8_STAGE(PG8_SA(1, 1), a1 + cH, voffA);
            PG8_WAIT_L(8); PG8_BAR; PG8_WAIT_L(0); PG8_MMA(0, 0, At, B0); PG8_BAR; PG8_SCHED;
            PG8_LDB(B1, 0, 1); PG8_STAGE(PG8_SB(0, 0), b2, voffB);
            PG8_BAR; PG8_WAIT_L(0); PG8_MMA(0, 1, At, B1); PG8_BAR;
            PG8_LDA(At, 0, 1); PG8_STAGE(PG8_SA(0, 0), a2, voffA);
            PG8_BAR; PG8_WAIT_L(0); PG8_MMA(1, 0, At, B0); PG8_BAR; PG8_SCHED;
            PG8_STAGE(PG8_SB(0, 1), b2 + hstep, voffB);
            PG8_WAIT_V(6); PG8_BAR; PG8_MMA(1, 1, At, B1); PG8_BAR;
            PG8_LDB(B0, 1, 0); PG8_SCHED; PG8_LDA(At, 1, 0); PG8_STAGE(PG8_SA(0, 1), a2 + h2, voffA);
            PG8_WAIT_L(8); PG8_BAR; PG8_WAIT_L(0); PG8_MMA(0, 0, At, B0); PG8_BAR; PG8_SCHED;
            PG8_LDB(B1, 1, 1); PG8_STAGE(PG8_SB(1, 0), b3, voffB);
            PG8_BAR; PG8_WAIT_L(0); PG8_MMA(0, 1, At, B1); PG8_BAR;
            PG8_LDA(At, 1, 1); PG8_STAGE(PG8_SA(1, 0), a3, voffA);
            PG8_BAR; PG8_WAIT_L(0); PG8_MMA(1, 0, At, B0); PG8_BAR; PG8_SCHED;
            PG8_STAGE(PG8_SB(1, 1), b3 + hstep, voffB);
            PG8_WAIT_V(6); PG8_BAR; PG8_MMA(1, 1, At, B1); PG8_BAR;
            }
        }
        if (Epi::SUBST) { SUBSTAMP(5) }
        if constexpr (ALIGN_EPI) { if (wr == 0) PG8_BAR; }
        if constexpr (!Epi::AFTER_DRAIN) { for (int er_ = 0; er_ < (Epi::PROBE_REP ? EPI_REP : 1); ++er_) { E(acc, cur, wr, wc, fr, fq); if (Epi::PROBE_REP && EPI_REP > 1) asm volatile("" ::: "memory"); } S.done(cur); }
        if (Epi::SUBST) { SUBSTAMP(6) }
        if (!has_next) break;
        if (!E.keep(cur)) {
#pragma unroll
        for (int a = 0; a < 2; ++a)
#pragma unroll
            for (int b = 0; b < 2; ++b)
#pragma unroll
                for (int m = 0; m < 4; ++m)
#pragma unroll
                    for (int n = 0; n < 2; ++n) acc[a][b][m][n] = (f32x4){0.f, 0.f, 0.f, 0.f};
        }
        cur = nxt; cA = nA; cB = nB; chalf = nhalf; cH = nH; ++ui;
        if constexpr (ALIGN_EPI) { if (wr == 1) PG8_BAR; }
    }
    PG8_WAIT_V(0);
    if constexpr (!ALIGN_EPI) { if (wr == 0) PG8_BAR; }
    PG8_BAR;
    if constexpr (Epi::AFTER_DRAIN) { E.fused(acc, cur, wr, wc, fr, fq, lds, wid, lane); S.done(cur); }
#undef PG8_ABASE
#undef PG8_SA
#undef PG8_SB
#undef PG8_STAGE
#undef PG8_LDA
#undef PG8_LDB
#undef PG8_MMA
#undef PG8_WAIT_V
#undef PG8_WAIT_L
#undef PG8_BAR
#undef PG8_SCHED
}
}

constexpr int NWAVES = 8;
#ifndef MK_N_LAUNCHES
#define MK_N_LAUNCHES 1
#endif
constexpr int PER_PHASE = 9;
constexpr int N_LAUNCHES = MK_N_LAUNCHES;

constexpr int BATCH = 4, SEQ = 4096, D = 1024, M = BATCH * SEQ;
constexpr int DN_H = 4, DN_D = 128, DN_W = 512, DN_QKV = 1536;
constexpr int SW_H = 8, SW_KV = 2, SW_D = 64, SW_W = 512, SW_KVW = 128, WINDOW = 128;
constexpr int FF = 2816;
constexpr int D_IN = 4872;
constexpr int NP = 4864;
constexpr int PC_Z = 1536, PC_SQ = 2048, PC_SK = 2560, PC_SV = 2688, PC_G = 2816;
constexpr int PC_YDN = 0, PC_YSW = 512;
constexpr float EPS = 1e-6f;

constexpr size_t MiB = 1u << 20;
constexpr size_t WS_CTL = 0, CTL_ZERO_BYTES = 65536;
constexpr size_t WS_WIN = 1 * MiB;
constexpr size_t WS_WAB = 11 * MiB;
constexpr size_t WS_WOUT = 13 * MiB;
constexpr size_t WS_WGU = 15 * MiB;
constexpr size_t WS_WD = 26 * MiB;
constexpr size_t WS_RSTD = 32 * MiB;
constexpr size_t WS_GB = WS_RSTD + 64 * 1024;
constexpr size_t WS_SSQ = 33 * MiB;
constexpr size_t WS_SSQ2 = WS_SSQ + 65536;
constexpr size_t WS_XB = 34 * MiB;
constexpr size_t WS_Y = 66 * MiB;
constexpr size_t WS_PROJ = 98 * MiB;
constexpr size_t WS_UB = 250 * MiB;
constexpr size_t WS_END = 256 * MiB;
static_assert(WS_PROJ + (size_t)M * NP * 2 <= WS_UB, "ws map");
constexpr int CW_TMO = 0, CW_SCAN = 1024  , CW_WCOPY = 3201  , CW_NORMDONE = 3202  , CW_SWADONE = 3200  , CW_BAR = 4096, CW_P56 = 8192  , CW_P67 = 12288, CW_PAN = 12288  ;

constexpr int RING_OFF = 0, RING_BYTES = 131072;
constexpr int LDSCTL_OFF = RING_BYTES, MISC_OFF = LDSCTL_OFF + 320;
constexpr int LDS_BYTES = 147456;

#define GAS __attribute__((address_space(1)))
#define LAS __attribute__((address_space(3)))
typedef unsigned short bf16;
typedef unsigned v4u __attribute__((ext_vector_type(4)));
typedef float f32x4 __attribute__((ext_vector_type(4)));
typedef float f32x2 __attribute__((ext_vector_type(2)));
typedef GAS unsigned gu32;
#define RLX_AGENT __ATOMIC_RELAXED, __HIP_MEMORY_SCOPE_AGENT
#define LDS_WAIT() asm volatile("s_waitcnt lgkmcnt(0)" ::: "memory")
#define VM_WAIT() asm volatile("s_waitcnt vmcnt(0)" ::: "memory")
__device__ __forceinline__ unsigned f2bf(float f) { unsigned u = __builtin_bit_cast(unsigned, f); return (u + 0x7fffu + ((u >> 16) & 1u)) >> 16; }
__device__ __forceinline__ unsigned pk2(float lo, float hi) { return f2bf(lo) | (f2bf(hi) << 16); }
__device__ __forceinline__ float bflo(unsigned w) { return __builtin_bit_cast(float, w << 16); }
__device__ __forceinline__ float bfhi(unsigned w) { return __builtin_bit_cast(float, w & 0xffff0000u); }
__device__ __forceinline__ float bf1(bf16 h) { return __builtin_bit_cast(float, (unsigned)h << 16); }
__device__ __forceinline__ float sigm(float x) { return __builtin_amdgcn_rcpf(1.0f + __expf(-x)); }
__device__ __forceinline__ float frsq(float x) { return __builtin_amdgcn_rsqf(x); }
template <int CTRL> __device__ __forceinline__ float dpp_mov(float v) { return __builtin_bit_cast(float, __builtin_amdgcn_update_dpp(0, __builtin_bit_cast(int, v), CTRL, 0xf, 0xf, true)); }
__device__ __forceinline__ float sum4(float v) { v += dpp_mov<0xB1>(v); v += dpp_mov<0x4E>(v); return v; }
__device__ __forceinline__ float sum8(float v) { v = sum4(v); v += dpp_mov<0x141>(v); return v; }
__device__ __forceinline__ float sum16(float v) { v = sum8(v); v += dpp_mov<0x140>(v); return v; }
__device__ __forceinline__ float rdlane(float v, int l) { return __builtin_bit_cast(float, __builtin_amdgcn_readlane(__builtin_bit_cast(int, v), l)); }
__device__ __forceinline__ float wave_sum(float v) { v = sum16(v); return (rdlane(v, 0) + rdlane(v, 16)) + (rdlane(v, 32) + rdlane(v, 48)); }
__device__ __forceinline__ float sum32(float v, int lane) { v = sum16(v); const float lo = rdlane(v, 0) + rdlane(v, 16), hi = rdlane(v, 32) + rdlane(v, 48); return (lane & 32) ? hi : lo; }
__device__ __forceinline__ float wave_max(float v) {
#pragma unroll
    for (int o = 1; o < 64; o <<= 1) v = fmaxf(v, __shfl_xor(v, o));
    return v;
}

#define XB_TMO      128
#define XB_XCNT(j)  (256  + 64 * (j))
#define XB_XSUB(j)  (1280 + 64 * (j))
#define XB_XGEN(j)  (2304 + 64 * (j))
#define XB_TOP      3328
#define XB_TOPGEN   3392
#define XCD_BAR_WORDS 3456
#define XB_SPIN_CAP (1u << 18)
__device__ __forceinline__ unsigned xb_ld(unsigned* p)              { return __hip_atomic_load(p, __ATOMIC_RELAXED, __HIP_MEMORY_SCOPE_AGENT); }
__device__ __forceinline__ unsigned xb_add(unsigned* p, unsigned v) { return __hip_atomic_fetch_add(p, v, __ATOMIC_RELAXED, __HIP_MEMORY_SCOPE_AGENT); }
__device__ __forceinline__ unsigned xb_xcc_id() { return (unsigned)__builtin_amdgcn_s_getreg((3 << 11) | 20) & 0xFu; }
#define XB_SPIN(cond, bar) do { unsigned _sp = 0; while (cond) { __builtin_amdgcn_s_sleep(1); \
    if ((++_sp & 255u) == 0u) { if (xb_ld(&(bar)[XB_TMO])) break; if (_sp > XB_SPIN_CAP) { atomicAdd(&(bar)[XB_TMO], 1u); break; } } } } while (0)
struct XcdBarrier { unsigned* bar; unsigned x; volatile LAS unsigned* st; };
__device__ __forceinline__ XcdBarrier xcd_barrier_post(unsigned* bar, volatile LAS unsigned* st) {
    XcdBarrier b; b.bar = bar; b.x = xb_xcc_id(); b.st = st;
    if (threadIdx.x == 0) (void)xb_add(&bar[XB_XCNT(b.x)], 1u);
    return b;
}
__device__ __forceinline__ void xcd_barrier_complete(unsigned* bar, unsigned x, unsigned& nloc, unsigned& nx) {
    const unsigned G = gridDim.x * gridDim.y * gridDim.z;
    unsigned sum, cnt, mine, sp = 0u;
    for (;;) {
        sum = 0u; cnt = 0u; mine = 0u;
#pragma unroll
        for (unsigned j = 0; j < 16; ++j) { const unsigned c = xb_ld(&bar[XB_XCNT(j)]); sum += c; cnt += (c > 0u) ? 1u : 0u; mine = (j == x) ? c : mine; }
        if (sum == G) break;
        __builtin_amdgcn_s_sleep(1);
        if ((++sp & 255u) == 0u) { if (xb_ld(&bar[XB_TMO])) break; if (sp > XB_SPIN_CAP) { atomicAdd(&bar[XB_TMO], 1u); break; } }
    }
    nloc = mine > 0u ? mine : 1u; nx = cnt > 0u ? cnt : 1u;
}
__device__ __forceinline__ void xcd_barrier(const XcdBarrier& b) {
    asm volatile("s_waitcnt vmcnt(0)" ::: "memory");
    __syncthreads();
    if (threadIdx.x == 0) {
        unsigned* bar = b.bar;
        __builtin_amdgcn_s_waitcnt(0);
        unsigned nloc = b.st[0], nx = b.st[1];
        if (nloc == 0u) { xcd_barrier_complete(bar, b.x, nloc, nx); b.st[0] = nloc; b.st[1] = nx; }
#if BAR_EARLY_WB
        asm volatile("buffer_wbl2 sc1" ::: "memory");
#endif
        const unsigned old = xb_add(&bar[XB_XSUB(b.x)], 1u);
        const unsigned gen = old / nloc;
        if (old + 1u == (gen + 1u) * nloc) {
            __builtin_amdgcn_fence(__ATOMIC_RELEASE, "agent");
            asm volatile("s_waitcnt vmcnt(0)" ::: "memory");
            const unsigned og = xb_add(&bar[XB_TOP], 1u);
            const unsigned tg = og / nx;
            if (og + 1u == (tg + 1u) * nx) xb_add(&bar[XB_TOPGEN], 1u);
            else XB_SPIN(xb_ld(&bar[XB_TOPGEN]) == tg, bar);
            __builtin_amdgcn_fence(__ATOMIC_ACQUIRE, "agent");
            xb_add(&bar[XB_XGEN(b.x)], 1u);
            asm volatile("s_waitcnt vmcnt(0)" ::: "memory");
        } else {
            XB_SPIN(xb_ld(&bar[XB_XGEN(b.x)]) == gen, bar);
            __builtin_amdgcn_fence(__ATOMIC_ACQUIRE, "agent");
            asm volatile("s_waitcnt vmcnt(0)" ::: "memory");
        }
    }
    __syncthreads();
}

struct Args { const float* in[18]; float* out; unsigned char* ws; int ph_lo, ph_hi, li, ws_mib; };
typedef const __attribute__((address_space(4))) Args* KArgs;
#define FIN(k) (F.ka->in[k])
struct Frame {
    LAS unsigned char* lds;
    volatile LAS unsigned* MISC;
    gu32* ctl;
    int tid, lane, wave;
    int vcu, G;
    KArgs ka; float* out; unsigned char* ws;
};
__device__ const unsigned char T5_BUCKET[128] = {0,1,2,3,4,5,6,7,8,9,10,11,12,13,14,15,16,16,16,17,17,18,18,18,19,19,19,20,20,20,20,21,21,21,21,22,22,22,22,22,23,23,23,23,23,23,24,24,24,24,24,24,25,25,25,25,25,25,25,26,26,26,26,26,26,26,26,27,27,27,27,27,27,27,27,27,27,28,28,28,28,28,28,28,28,28,28,29,29,29,29,29,29,29,29,29,29,29,29,30,30,30,30,30,30,30,30,30,30,30,30,30,30,31,31,31,31,31,31,31,31,31,31,31,31,31,31,31};

__device__ __forceinline__ int lcol32(int nb) { return 256 * (nb >> 3) + 32 * (2 * (nb & 3) + ((nb >> 2) & 1)); }
constexpr int WI_IN = 16 * (NP / 32), WI_AB = 8 * 32, WI_OUT = 16 * 32, WI_GU = 16 * (2 * FF / 32), WI_D = (FF / 64) * 32, WI_ALL = WI_IN + 2 * WI_AB + WI_OUT + WI_GU + WI_D, WI_P0 = SEAM35 ? (SEAM56 ? WI_IN + 2 * WI_AB + WI_OUT : WI_IN + 2 * WI_AB) : WI_IN;
struct WItem { const float* W; int ldw, src_col0, K; bf16* WT; int dst_row0; const float* gain; int kb; };
__device__ __forceinline__ WItem weight_item(Frame& F, int it) {
    unsigned char* ws = F.ws;
    bf16* WinT = (bf16*)(ws + WS_WIN); bf16* WabT = (bf16*)(ws + WS_WAB); bf16* WoutT = (bf16*)(ws + WS_WOUT); bf16* WguT = (bf16*)(ws + WS_WGU); bf16* WdT = (bf16*)(ws + WS_WD);
    int r = it;
    if (r < WI_IN) { const int nb = r % (NP / 32), kb = r / (NP / 32), dr = 32 * nb, lc = lcol32(nb); return WItem{FIN(2), D_IN, lc < 2048 ? lc : lc + 8, D, WinT, dr, FIN(1), kb}; } r -= WI_IN;
    if (r < WI_AB) { const int nb = r % 32, kb = r / 32; return WItem{FIN(11), D, lcol32(nb), DN_W, WabT, 32 * nb, nullptr, kb}; } r -= WI_AB;
    if (r < WI_AB) { const int nb = r % 32, kb = r / 32; return WItem{FIN(12), D, lcol32(nb), SW_W, WabT, 1024 + 32 * nb, nullptr, kb}; } r -= WI_AB;
    if (r < WI_OUT) { const int nb = r % 32, kb = r / 32; return WItem{FIN(13), D, 32 * nb, D, WoutT, 32 * nb, nullptr, kb}; } r -= WI_OUT;
    if (r < WI_GU) { const int nb = r % (2 * FF / 32), kb = r / (2 * FF / 32), dr = 32 * nb, pn = dr >> 8, j = dr & 255;
        return WItem{(j < 128) ? FIN(15) : FIN(16), FF, 128 * pn + (j & 127), D, WguT, dr, FIN(14), kb}; } r -= WI_GU;
    { const int nb = r % 32, kb = r / 32; return WItem{FIN(17), D, 32 * nb, FF, WdT, 32 * nb, nullptr, kb}; }
}
__device__ __forceinline__ void witem_load(const WItem& w, int lane, f32x4 (&v)[8], float (&gn)[8]) {
    const int k0 = 64 * w.kb, c4 = 4 * (lane & 7);
#pragma unroll
    for (int i = 0; i < 8; ++i) { const int kk = 8 * i + (lane >> 3); v[i] = *(const f32x4*)(w.W + (size_t)(k0 + kk) * w.ldw + w.src_col0 + c4); gn[i] = w.gain ? w.gain[k0 + kk] : 1.0f; }
}
__device__ __forceinline__ void witem_store(const WItem& w, int lane, const f32x4 (&v)[8], const float (&gn)[8], LAS float* scr) {
    const int k0 = 64 * w.kb, c4 = 4 * (lane & 7);
#pragma unroll
    for (int i = 0; i < 8; ++i) { const int kk = 8 * i + (lane >> 3);
        scr[kk * 33 + c4] = v[i].x * gn[i]; scr[kk * 33 + c4 + 1] = v[i].y * gn[i]; scr[kk * 33 + c4 + 2] = v[i].z * gn[i]; scr[kk * 33 + c4 + 3] = v[i].w * gn[i]; }
    LDS_WAIT(); asm volatile("" ::: "memory");
    const int c = lane & 7;
#pragma unroll
    for (int j = 0; j < 4; ++j) { const int n = (lane >> 3) + 8 * j; const LAS float* s = scr + (8 * c) * 33 + n;
        v4u o; o.x = pk2(s[0 * 33], s[1 * 33]); o.y = pk2(s[2 * 33], s[3 * 33]); o.z = pk2(s[4 * 33], s[5 * 33]); o.w = pk2(s[6 * 33], s[7 * 33]);
        if (SEAM67) asm volatile("global_store_dwordx4 %0, %1, off sc1\n\ts_nop 2" :: "v"((GAS v4u*)(w.WT + (size_t)(w.dst_row0 + n) * w.K + k0 + 8 * c)), "v"(o) : "memory");
        else *(GAS v4u*)(w.WT + (size_t)(w.dst_row0 + n) * w.K + k0 + 8 * c) = o; }
    LDS_WAIT(); asm volatile("" ::: "memory");
}
__device__ __forceinline__ void weight_copies(Frame& F, int lo, int hi, int gw, int NGW) {
    LAS float* scr = (LAS float*)(F.lds + RING_OFF + F.wave * 16384);
    int it = lo + gw; if (it >= hi) return;
    f32x4 vc[8]; float gc[8];
    WItem cur = weight_item(F, it); witem_load(cur, F.lane, vc, gc);
    for (;;) {
        const int nx = it + NGW; const bool more = nx < hi;
        f32x4 vn[8]; float gnx[8]; WItem nxt = cur;
        if (more) { nxt = weight_item(F, nx); witem_load(nxt, F.lane, vn, gnx); }
        witem_store(cur, F.lane, vc, gc, scr);
        if (!more) break;
#pragma unroll
        for (int i = 0; i < 8; ++i) { vc[i] = vn[i]; gc[i] = gnx[i]; }
        cur = nxt; it = nx;
    }
}
__device__ __forceinline__ void p0_prologue(Frame& F) {
    const int gw = F.vcu * NWAVES + F.wave, NGW = F.G * NWAVES;
    unsigned char* ws = F.ws;
    weight_copies(F, 0, (F.G == 256 && DEFER_WEIGHTS) ? WI_P0 : WI_ALL, gw, NGW);
    __syncthreads();
    LAS float* wba = (LAS float*)(F.lds + RING_OFF);
    for (int idx = F.tid; idx < 8 * D; idx += NWAVES * 64) { const int k = idx >> 3, j = idx & 7; wba[j * D + k] = FIN(2)[(size_t)k * D_IN + 2048 + j] * FIN(1)[k]; }
    __syncthreads();
    const float* x = FIN(0); bf16* XB = (bf16*)(ws + WS_XB); float* rstd1 = (float*)(ws + WS_RSTD); float* gbp = (float*)(ws + WS_GB); float* ssq2 = (float*)(ws + WS_SSQ2);
    const float alog_or_dt = (F.lane & 32) ? FIN(5)[(F.lane >> 3) & 3] : 0.f;
    const float negA = -expf(FIN(4)[(F.lane >> 3) & 3]);
#if P0_DEEP
    auto do_row = [&](const f32x4 (&v)[4], int m) {
        float ss = 0.f;
#pragma unroll
        for (int j = 0; j < 4; ++j) ss += (v[j].x * v[j].x + v[j].y * v[j].y) + (v[j].z * v[j].z + v[j].w * v[j].w);
        GAS unsigned long long* o8 = (GAS unsigned long long*)(XB + (size_t)m * D) + F.lane;
#pragma unroll
        for (int j = 0; j < 4; ++j) { const unsigned long long w = (unsigned long long)pk2(v[j].x, v[j].y) | ((unsigned long long)pk2(v[j].z, v[j].w) << 32);
            asm volatile("global_store_dwordx2 %0, %1, off" :: "v"(o8 + 64 * j), "v"(w) : "memory"); }
        float acc[8];
#pragma unroll
        for (int c = 0; c < 8; ++c) { float a = 0.f;
#pragma unroll
            for (int j = 0; j < 4; ++j) { const f32x4 w = *(const LAS f32x4*)(wba + c * D + 256 * j + 4 * F.lane); a += (v[j].x * w.x + v[j].y * w.y) + (v[j].z * w.z + v[j].w * w.w); }
            acc[c] = a; }
        ss = wave_sum(ss);
        float r4[4], r2[2], r1;
        { const bool up = (F.lane & 32) != 0;
#pragma unroll
          for (int i = 0; i < 4; ++i) { const float keep = up ? acc[4 + i] : acc[i], send = up ? acc[i] : acc[4 + i]; r4[i] = keep + __shfl_xor(send, 32); } }
        { const bool up = (F.lane & 16) != 0;
#pragma unroll
          for (int i = 0; i < 2; ++i) { const float keep = up ? r4[2 + i] : r4[i], send = up ? r4[i] : r4[2 + i]; r2[i] = keep + __shfl_xor(send, 16); } }
        { const bool up = (F.lane & 8) != 0; const float keep = up ? r2[1] : r2[0], send = up ? r2[0] : r2[1]; r1 = keep + __shfl_xor(send, 8); }
        r1 = sum8(r1);
        const float rstd = frsq(ss * (1.0f / D) + EPS);
        if (F.lane == 0) { asm volatile("global_store_dword %0, %1, off" :: "v"((GAS float*)(rstd1 + m)), "v"(rstd) : "memory"); asm volatile("global_store_dword %0, %1, off" :: "v"((GAS float*)(ssq2 + m)), "v"(0.f) : "memory"); }
        if ((F.lane & 7) == 0) {
            const float val = r1 * rstd; float res;
            if (F.lane < 32) res = 1.0f / (1.0f + expf(-val));
            else { const float xx = val + alog_or_dt; const float sp = xx > 20.f ? xx : log1pf(expf(xx)); res = negA * sp; }
            asm volatile("global_store_dword %0, %1, off" :: "v"((GAS float*)(gbp + (size_t)m * 8 + (F.lane >> 3))), "v"(res) : "memory");
        }
    };
    f32x4 qa[4], qb[4];
#pragma unroll
    for (int j = 0; j < 4; ++j) { qa[j] = (f32x4){0.f, 0.f, 0.f, 0.f}; qb[j] = qa[j]; }
    if (gw < M) {
#pragma unroll
        for (int j = 0; j < 4; ++j) qa[j] = ((const GAS f32x4*)(x + (size_t)gw * D) + F.lane)[64 * j]; }
    if (gw + NGW < M) {
#pragma unroll
        for (int j = 0; j < 4; ++j) qb[j] = ((const GAS f32x4*)(x + (size_t)(gw + NGW) * D) + F.lane)[64 * j]; }
    for (int m = gw; m < M; m += 2 * NGW) {
        f32x4 v[4];
#pragma unroll
        for (int j = 0; j < 4; ++j) v[j] = qa[j];
        if (m + 2 * NGW < M) {
#pragma unroll
            for (int j = 0; j < 4; ++j) qa[j] = ((const GAS f32x4*)(x + (size_t)(m + 2 * NGW) * D) + F.lane)[64 * j]; }
        do_row(v, m);
        if (m + NGW < M) {
#pragma unroll
            for (int j = 0; j < 4; ++j) v[j] = qb[j];
            if (m + 3 * NGW < M) {
#pragma unroll
                for (int j = 0; j < 4; ++j) qb[j] = ((const GAS f32x4*)(x + (size_t)(m + 3 * NGW) * D) + F.lane)[64 * j]; }
            do_row(v, m + NGW);
        }
    }
}
#else
    f32x4 vnx[4];
    if (gw < M) {
#pragma unroll
        for (int j = 0; j < 4; ++j) vnx[j] = ((const GAS f32x4*)(x + (size_t)gw * D) + F.lane)[64 * j]; }
    for (int m = gw; m < M; m += NGW) {
        f32x4 v[4]; float ss = 0.f;
#pragma unroll
        for (int j = 0; j < 4; ++j) { v[j] = vnx[j]; ss += (v[j].x * v[j].x + v[j].y * v[j].y) + (v[j].z * v[j].z + v[j].w * v[j].w); }
        if (m + NGW < M) {
#pragma unroll
            for (int j = 0; j < 4; ++j) vnx[j] = ((const GAS f32x4*)(x + (size_t)(m + NGW) * D) + F.lane)[64 * j]; }
        GAS unsigned long long* o8 = (GAS unsigned long long*)(XB + (size_t)m * D) + F.lane;
#pragma unroll
        for (int j = 0; j < 4; ++j) o8[64 * j] = (unsigned long long)pk2(v[j].x, v[j].y) | ((unsigned long long)pk2(v[j].z, v[j].w) << 32);
        float acc[8];
#pragma unroll
        for (int c = 0; c < 8; ++c) { float a = 0.f;
#pragma unroll
            for (int j = 0; j < 4; ++j) { const f32x4 w = *(const LAS f32x4*)(wba + c * D + 256 * j + 4 * F.lane); a += (v[j].x * w.x + v[j].y * w.y) + (v[j].z * w.z + v[j].w * w.w); }
            acc[c] = a; }
        ss = wave_sum(ss);
        float r4[4], r2[2], r1;
        { const bool up = (F.lane & 32) != 0;
#pragma unroll
          for (int i = 0; i < 4; ++i) { const float keep = up ? acc[4 + i] : acc[i], send = up ? acc[i] : acc[4 + i]; r4[i] = keep + __shfl_xor(send, 32); } }
        { const bool up = (F.lane & 16) != 0;
#pragma unroll
          for (int i = 0; i < 2; ++i) { const float keep = up ? r4[2 + i] : r4[i], send = up ? r4[i] : r4[2 + i]; r2[i] = keep + __shfl_xor(send, 16); } }
        { const bool up = (F.lane & 8) != 0; const float keep = up ? r2[1] : r2[0], send = up ? r2[0] : r2[1]; r1 = keep + __shfl_xor(send, 8); }
        r1 = sum8(r1);
        const float rstd = frsq(ss * (1.0f / D) + EPS);
        if (F.lane == 0) { rstd1[m] = rstd; ssq2[m] = 0.f; }
        if ((F.lane & 7) == 0) {
            const float val = r1 * rstd; float res;
            if (F.lane < 32) res = 1.0f / (1.0f + expf(-val));
            else { const float xx = val + alog_or_dt; const float sp = xx > 20.f ? xx : log1pf(expf(xx)); res = negA * sp; }
            gbp[(size_t)m * 8 + (F.lane >> 3)] = res;
        }
    }
}
#endif

__device__ __forceinline__ void dn_pre(Frame& F) {
    const int gw = F.vcu * NWAVES + F.wave, NGW = F.G * NWAVES;
    const bf16* proj = (const bf16*)(F.ws + WS_PROJ); const float* conv = FIN(3);
    float* QN = F.out; float* KN = F.out + (size_t)M * DN_W; float* VV = (float*)(F.ws + WS_XB);
    for (int task = gw; task < M * DN_H; task += NGW) {
        const int m = task >> 2, h = task & 3, t = m & (SEQ - 1);
        float val[3][2];
#pragma unroll
        for (int part = 0; part < 3; ++part) { const int col = part * DN_W + h * DN_D + 2 * F.lane; float a0 = 0.f, a1 = 0.f;
#pragma unroll
            for (int j = 0; j < 4; ++j) { if (t - 3 + j >= 0) { const unsigned w = *(const unsigned*)(proj + (size_t)(m - 3 + j) * NP + col); a0 += conv[j * DN_QKV + col] * bflo(w); a1 += conv[j * DN_QKV + col + 1] * bfhi(w); } }
            val[part][0] = a0 * sigm(a0); val[part][1] = a1 * sigm(a1); }
        const float rq = 1.0f / sqrtf(wave_sum(val[0][0] * val[0][0] + val[0][1] * val[0][1]) + EPS) * 0.08838834764831845f;
        const float rk = 1.0f / sqrtf(wave_sum(val[1][0] * val[1][0] + val[1][1] * val[1][1]) + EPS);
        const size_t o = (size_t)m * DN_W + h * DN_D + 2 * F.lane;
        *(f32x2*)(QN + o) = (f32x2){val[0][0] * rq, val[0][1] * rq};
        *(f32x2*)(KN + o) = (f32x2){val[1][0] * rk, val[1][1] * rk};
        *(f32x2*)(VV + o) = (f32x2){val[2][0], val[2][1]};
    }
}
__device__ __forceinline__ void dn_scan_naive(Frame& F, int bh) {
    const int b = bh >> 2, h = bh & 3, tid = F.tid, dvi = tid >> 2, kq = tid & 3;
    LAS float* kL = (LAS float*)(F.lds + RING_OFF); LAS float* qL = kL + 32 * 128; LAS float* vL = qL + 32 * 128; LAS float* gL = vL + 32 * 128; LAS float* bL = gL + 32;
    const float* QN = F.out; const float* KN = F.out + (size_t)M * DN_W; float* VV = (float*)(F.ws + WS_XB); const float* gbp = (const float*)(F.ws + WS_GB);
    float S[32];
#pragma unroll
    for (int j = 0; j < 32; ++j) S[j] = 0.f;
    for (int t0 = 0; t0 < SEQ; t0 += 32) {
#pragma unroll
        for (int r = 0; r < 2; ++r) { const int idx = tid + 512 * r, tok = idx >> 5, c4 = idx & 31; const size_t src = (size_t)(b * SEQ + t0 + tok) * DN_W + h * DN_D + c4 * 4;
            *(LAS f32x4*)(kL + tok * 128 + c4 * 4) = *(const f32x4*)(KN + src); *(LAS f32x4*)(qL + tok * 128 + c4 * 4) = *(const f32x4*)(QN + src); *(LAS f32x4*)(vL + tok * 128 + c4 * 4) = *(const f32x4*)(VV + src); }
        if (tid < 32) { const size_t mm = (size_t)(b * SEQ + t0 + tid); bL[tid] = gbp[mm * 8 + h]; gL[tid] = gbp[mm * 8 + 4 + h]; }
        __syncthreads();
        for (int i = 0; i < 32; ++i) {
            const float eg = __expf(gL[i]), be = bL[i];
            float kk[32];
#pragma unroll
            for (int j = 0; j < 8; ++j) { const f32x4 w = *(const LAS f32x4*)(kL + i * 128 + kq * 32 + 4 * j); kk[4 * j] = w.x; kk[4 * j + 1] = w.y; kk[4 * j + 2] = w.z; kk[4 * j + 3] = w.w; }
            float part = 0.f;
#pragma unroll
            for (int j = 0; j < 32; ++j) part += kk[j] * S[j];
            part += __shfl_xor(part, 1); part += __shfl_xor(part, 2);
            const float c = be * (vL[i * 128 + dvi] - eg * part);
#pragma unroll
            for (int j = 0; j < 32; ++j) S[j] = eg * S[j] + c * kk[j];
            float po = 0.f;
#pragma unroll
            for (int j = 0; j < 8; ++j) { const f32x4 w = *(const LAS f32x4*)(qL + i * 128 + kq * 32 + 4 * j); po += (w.x * S[4 * j] + w.y * S[4 * j + 1]) + (w.z * S[4 * j + 2] + w.w * S[4 * j + 3]); }
            po += __shfl_xor(po, 1); po += __shfl_xor(po, 2);
            if (kq == 0) vL[i * 128 + dvi] = po;
        }
        __syncthreads();
#pragma unroll
        for (int r = 0; r < 2; ++r) { const int idx = tid + 512 * r, tok = idx >> 5, c4 = idx & 31; const size_t src = (size_t)(b * SEQ + t0 + tok) * DN_W + h * DN_D + c4 * 4;
            *(f32x4*)(VV + src) = *(const LAS f32x4*)(vL + tok * 128 + c4 * 4); }
        __syncthreads();
    }
}
__device__ __forceinline__ void swa_naive(Frame& F, int wv, int nworkers) {
    const bf16* proj = (const bf16*)(F.ws + WS_PROJ); bf16* YSWA = (bf16*)(F.ws + WS_Y) + (size_t)M * SW_W;
    LAS float* qs = (LAS float*)(F.lds + RING_OFF + 65536 + F.wave * 1024); LAS float* ps = qs + 64;
    const float* qg = FIN(7); const float* kg = FIN(8); const float* sinks = FIN(9); const float* relb = FIN(10);
    const int lane = F.lane;
    for (int task = wv; task < M * SW_H; task += nworkers) {
        const int m = task >> 3, qh = task & 7, kvh = qh >> 2, t = m & (SEQ - 1);
        const float q = bf1(proj[(size_t)m * NP + PC_SQ + qh * SW_D + lane]);
        const float qn = q * (1.0f / sqrtf(wave_sum(q * q) * (1.0f / SW_D) + EPS)) * qg[lane];
        qs[lane] = qn * kg[lane];
        LDS_WAIT(); asm volatile("" ::: "memory");
        float lg[2];
#pragma unroll
        for (int hf = 0; hf < 2; ++hf) { const int j = lane + 64 * hf; lg[hf] = -INFINITY;
            if (t - 127 + j >= 0) { const v4u* kr = (const v4u*)(proj + (size_t)(m - 127 + j) * NP + PC_SK + kvh * SW_D); float ssk = 0.f, dot = 0.f;
#pragma unroll
                for (int c = 0; c < 8; ++c) { const v4u w = kr[c];
#pragma unroll
                    for (int e = 0; e < 4; ++e) { const float k0 = bflo(w[e]), k1 = bfhi(w[e]); ssk += k0 * k0 + k1 * k1; dot += qs[8 * c + 2 * e] * k0 + qs[8 * c + 2 * e + 1] * k1; } }
                lg[hf] = dot * (1.0f / sqrtf(ssk * (1.0f / SW_D) + EPS)) * 0.125f + relb[(int)T5_BUCKET[127 - j] * SW_H + qh]; } }
        const float sink = sinks[qh];
        const float mx = fmaxf(wave_max(fmaxf(lg[0], lg[1])), sink);
        const float p0 = (lg[0] == -INFINITY) ? 0.f : __expf(lg[0] - mx), p1 = (lg[1] == -INFINITY) ? 0.f : __expf(lg[1] - mx);
        const float den = wave_sum(p0 + p1) + __expf(sink - mx);
        ps[lane] = p0; ps[lane + 64] = p1;
        LDS_WAIT(); asm volatile("" ::: "memory");
        float o = 0.f; const int jmin = (127 - t) > 0 ? (127 - t) : 0;
        for (int j = jmin; j < 128; ++j) o += ps[j] * bf1(proj[(size_t)(m - 127 + j) * NP + PC_SV + kvh * SW_D + lane]);
        YSWA[(size_t)m * SW_W + qh * SW_D + lane] = (bf16)f2bf(o / den);
        LDS_WAIT(); asm volatile("" ::: "memory");
    }
}
__device__ __forceinline__ void dn_out(Frame& F) {
    const int gw = F.vcu * NWAVES + F.wave, NGW = F.G * NWAVES;
    const bf16* proj = (const bf16*)(F.ws + WS_PROJ); const float* VV = (const float*)(F.ws + WS_XB); bf16* YDN = (bf16*)(F.ws + WS_Y); const float* gain = FIN(6);
    for (int task = gw; task < M * DN_H; task += NGW) {
        const int m = task >> 2, h = task & 3;
        const f32x2 o = *(const f32x2*)(VV + (size_t)m * DN_W + h * DN_D + 2 * F.lane);
        const float r = 1.0f / sqrtf(wave_sum(o.x * o.x + o.y * o.y) * (1.0f / DN_D) + EPS);
        const unsigned zw = *(const unsigned*)(proj + (size_t)m * NP + PC_Z + h * DN_D + 2 * F.lane); const float z0 = bflo(zw), z1 = bfhi(zw);
        *(unsigned*)(YDN + (size_t)m * DN_W + h * DN_D + 2 * F.lane) = pk2(o.x * r * gain[2 * F.lane] * z0 * sigm(z0), o.y * r * gain[2 * F.lane + 1] * z1 * sigm(z1));
    }
}

typedef short bf16x8 __attribute__((ext_vector_type(8)));
typedef float f32x16 __attribute__((ext_vector_type(16)));
typedef unsigned u32x2 __attribute__((ext_vector_type(2)));
typedef __bf16 bf16x2_t __attribute__((ext_vector_type(2)));
__device__ __forceinline__ unsigned cvtpk(float lo, float hi) { f32x2 v = {lo, hi}; return __builtin_bit_cast(unsigned, __builtin_convertvector(v, bf16x2_t)); }
__device__ __forceinline__ bf16x8 pack8(f32x4 a, f32x4 b) { v4u w; w.x = cvtpk(a[0], a[1]); w.y = cvtpk(a[2], a[3]); w.z = cvtpk(b[0], b[1]); w.w = cvtpk(b[2], b[3]); return __builtin_bit_cast(bf16x8, w); }
__device__ __forceinline__ bf16x8 pack8z(f32x4 a) { v4u w; w.x = cvtpk(a[0], a[1]); w.y = cvtpk(a[2], a[3]); w.z = 0u; w.w = 0u; return __builtin_bit_cast(bf16x8, w); }
#define MFMA16(a, b, c) __builtin_amdgcn_mfma_f32_16x16x32_bf16((a), (b), (c), 0, 0, 0)
#define MFMA32(a, b, c) __builtin_amdgcn_mfma_f32_32x32x16_bf16((a), (b), (c), 0, 0, 0)
constexpr float LOG2E = 1.4426950408889634f;

__device__ __forceinline__ void swa_pre(Frame& F) {
    const int gw = F.vcu * NWAVES + F.wave, NGW = F.G * NWAVES, lane = F.lane;
    const bf16* proj = (const bf16*)(F.ws + WS_PROJ);
    bf16* KS = (bf16*)(F.ws + WS_Y); bf16* VT = KS + 2 * 1024 * 1024; bf16* QS = (bf16*)(F.ws + WS_Y) + (size_t)M * SW_W;
    const float* qg = FIN(7); const float* kg = FIN(8);
    v4u wq_n = {0u, 0u, 0u, 0u}; unsigned wk_n = 0u;
    if (!FUSE_QKNORM && gw < M) { wq_n = *(const v4u*)(proj + (size_t)gw * NP + PC_SQ + 8 * lane); wk_n = *(const unsigned*)(proj + (size_t)gw * NP + PC_SK + 2 * lane); }
    const f32x4 g0 = *(const f32x4*)(qg + 8 * (lane & 7)), g1 = *(const f32x4*)(qg + 8 * (lane & 7) + 4);
    const float kg0 = kg[2 * (lane & 31)], kg1 = kg[2 * (lane & 31) + 1];
    if (!FUSE_QKNORM)
    for (int m = gw; m < M; m += NGW) {
        const v4u w = wq_n; const unsigned wk = wk_n;
        if (m + NGW < M) { wq_n = *(const v4u*)(proj + (size_t)(m + NGW) * NP + PC_SQ + 8 * lane); wk_n = *(const unsigned*)(proj + (size_t)(m + NGW) * NP + PC_SK + 2 * lane); }
        {
            float x[8];
#pragma unroll
            for (int j = 0; j < 4; ++j) { x[2 * j] = bflo(w[j]); x[2 * j + 1] = bfhi(w[j]); }
            float ss = 0.f;
#pragma unroll
            for (int j = 0; j < 8; ++j) ss += x[j] * x[j];
            ss = sum8(ss);
            const float r = frsq(ss * (1.0f / SW_D) + EPS) * (0.125f * LOG2E);
            v4u o; o.x = cvtpk(x[0] * r * g0[0], x[1] * r * g0[1]); o.y = cvtpk(x[2] * r * g0[2], x[3] * r * g0[3]); o.z = cvtpk(x[4] * r * g1[0], x[5] * r * g1[1]); o.w = cvtpk(x[6] * r * g1[2], x[7] * r * g1[3]);
            *(v4u*)(QS + (size_t)m * SW_W + 8 * lane) = o;
        }
        {
            const float k0 = bflo(wk), k1 = bfhi(wk);
            float ss = k0 * k0 + k1 * k1;
            ss = sum32(ss, lane);
            const float r = frsq(ss * (1.0f / SW_D) + EPS); const int d = 2 * (lane & 31), b = m >> 12, t = m & (SEQ - 1), kvh = lane >> 5;
            *(unsigned*)(KS + ((size_t)(b * 2 + kvh) * SEQ + t) * SW_D + d) = cvtpk(k0 * r * kg0, k1 * r * kg1);
        }
    }
    for (int task = gw; task < BATCH * SW_KV * (SEQ / 32); task += NGW) {
        const int bk = task >> 7, tile = task & 127, b = bk >> 1, kvh = bk & 1; const size_t m0 = (size_t)b * SEQ + tile * 32;
        unsigned v[32];
#pragma unroll
        for (int i = 0; i < 32; ++i) v[i] = proj[(m0 + i) * NP + PC_SV + kvh * SW_D + lane];
        bf16* dst = VT + ((size_t)(bk * 128 + tile) * 64 + lane) * 32;
#pragma unroll
        for (int q4 = 0; q4 < 4; ++q4) { v4u o;
#pragma unroll
            for (int jj = 0; jj < 4; ++jj) { const int p0 = 8 * q4 + 2 * jj, p1 = p0 + 1;
                const int k0 = 16 * (p0 >> 4) + 8 * ((p0 & 7) >> 2) + 4 * ((p0 >> 3) & 1) + (p0 & 3), k1 = 16 * (p1 >> 4) + 8 * ((p1 & 7) >> 2) + 4 * ((p1 >> 3) & 1) + (p1 & 3);
                o[jj] = v[k0] | (v[k1] << 16); }
            *(v4u*)(dst + 8 * q4) = o; }
    }
}
__device__ __forceinline__ void swa_bias_table(Frame& F) {
    LAS float* biasT = (LAS float*)(F.lds + RING_OFF);
    for (int idx = F.tid; idx < SW_H * 128; idx += NWAVES * 64) { const int h = idx >> 7, dist = idx & 127; biasT[idx] = FIN(10)[(int)T5_BUCKET[dist] * SW_H + h] * LOG2E; }
}
__device__ __forceinline__ void swa_main(Frame& F, int worker, int nworkers) {
    const LAS float* biasT = (const LAS float*)(F.lds + RING_OFF);
    const bf16* KS = (const bf16*)(F.ws + WS_Y); const bf16* VT = KS + 2 * 1024 * 1024; const bf16* QS = (const bf16*)(F.ws + WS_Y) + (size_t)M * SW_W;
    bf16* YSW = (bf16*)(F.ws + WS_PROJ) + PC_YSW;
    const int lane = F.lane, l31 = lane & 31, hh = lane >> 5;
    for (int u = worker; u < BATCH * SW_H * (SEQ / 32); u += nworkers) {
        const int qblk = u & 127, h = (u >> 7) & 7, b = u >> 10, kvh = h >> 2, bk = b * 2 + kvh, q0 = qblk * 32; const size_t m0 = (size_t)b * SEQ + q0;
        bf16x8 qf[4], kf[5][4];
#pragma unroll
        for (int ks = 0; ks < 4; ++ks) qf[ks] = *(const bf16x8*)(QS + (m0 + l31) * SW_W + h * SW_D + 16 * ks + 8 * hh);
#pragma unroll
        for (int i = 0; i < 5; ++i) { const int ts = q0 - 128 + 32 * i, tsc = ts < 0 ? 0 : ts;
#pragma unroll
            for (int ks = 0; ks < 4; ++ks) kf[i][ks] = *(const bf16x8*)(KS + ((size_t)bk * SEQ + tsc + l31) * SW_D + 16 * ks + 8 * hh); }
        __builtin_amdgcn_sched_barrier(0);
        f32x16 s[5];
#pragma unroll
        for (int i = 0; i < 5; ++i) {
            const int ts = q0 - 128 + 32 * i;
            f32x16 acc;
#pragma unroll
            for (int r = 0; r < 16; ++r) acc[r] = 0.f;
#pragma unroll
            for (int ks = 0; ks < 4; ++ks) acc = MFMA32(kf[i][ks], qf[ks], acc);
#pragma unroll
            for (int r = 0; r < 16; ++r) { const int row = (r & 3) + 8 * (r >> 2) + 4 * hh, dist = 128 - 32 * i + l31 - row; const bool ok = ts >= 0 && dist >= 0 && dist <= 127;
                s[i][r] = ok ? acc[r] + biasT[h * 128 + (dist & 127)] : -INFINITY; }
        }
        bf16x8 vf[5][2][2];
#pragma unroll
        for (int i = 0; i < 5; ++i) { const int ts = q0 - 128 + 32 * i, tsc = ts < 0 ? 0 : ts;
#pragma unroll
            for (int s2 = 0; s2 < 2; ++s2)
#pragma unroll
                for (int nt = 0; nt < 2; ++nt) vf[i][s2][nt] = *(const bf16x8*)(VT + ((size_t)(bk * 128 + (tsc >> 5)) * 64 + 32 * nt + l31) * 32 + s2 * 16 + hh * 8); }
        __builtin_amdgcn_sched_barrier(0);
        const float sink2 = FIN(9)[h] * LOG2E;
        float mx = sink2;
#pragma unroll
        for (int i = 0; i < 5; ++i)
#pragma unroll
            for (int r = 0; r < 16; ++r) mx = fmaxf(mx, s[i][r]);
        mx = fmaxf(mx, __shfl_xor(mx, 32));
        float sum = 0.f;
#pragma unroll
        for (int i = 0; i < 5; ++i)
#pragma unroll
            for (int r = 0; r < 16; ++r) { const float p = __builtin_amdgcn_exp2f(s[i][r] - mx); s[i][r] = p; sum += p; }
        sum += __shfl_xor(sum, 32);
        const float inv = __builtin_amdgcn_rcpf(sum + __builtin_amdgcn_exp2f(sink2 - mx));
        f32x16 O[2];
#pragma unroll
        for (int r = 0; r < 16; ++r) { O[0][r] = 0.f; O[1][r] = 0.f; }
#pragma unroll
        for (int i = 0; i < 5; ++i) {
#pragma unroll
            for (int s2 = 0; s2 < 2; ++s2) {
                v4u w; w.x = cvtpk(s[i][8 * s2] * inv, s[i][8 * s2 + 1] * inv); w.y = cvtpk(s[i][8 * s2 + 2] * inv, s[i][8 * s2 + 3] * inv); w.z = cvtpk(s[i][8 * s2 + 4] * inv, s[i][8 * s2 + 5] * inv); w.w = cvtpk(s[i][8 * s2 + 6] * inv, s[i][8 * s2 + 7] * inv);
                const bf16x8 pa = __builtin_bit_cast(bf16x8, w);
#pragma unroll
                for (int nt = 0; nt < 2; ++nt) O[nt] = MFMA32(pa, vf[i][s2][nt], O[nt]);
            }
        }
        {
            LAS unsigned char* stg = F.lds + RING_OFF + 8192 + F.wave * 4608;
#pragma unroll
            for (int nt = 0; nt < 2; ++nt)
#pragma unroll
                for (int r = 0; r < 16; ++r) { const int q = (r & 3) + 8 * (r >> 2) + 4 * hh; *(LAS unsigned short*)(stg + q * 144 + (32 * nt + l31) * 2) = (unsigned short)(cvtpk(O[nt][r], 0.f) & 0xffffu); }
            asm volatile("s_waitcnt lgkmcnt(0)" ::: "memory");
#pragma unroll
            for (int i = 0; i < 4; ++i) { const int row = 8 * i + (lane >> 3), ch16 = lane & 7; const v4u v = *(const LAS v4u*)(stg + row * 144 + ch16 * 16);
                if (SEAM35) { GAS v4u* dst = (GAS v4u*)(YSW + (m0 + row) * NP + h * SW_D + ch16 * 8); asm volatile("global_store_dwordx4 %0, %1, off sc1\n\ts_nop 2" :: "v"(dst), "v"(v) : "memory"); }
                else *(v4u*)(YSW + (m0 + row) * NP + h * SW_D + ch16 * 8) = v; }
            asm volatile("s_waitcnt lgkmcnt(0)" ::: "memory");
        }
    }
#if SEAM35
    asm volatile("s_waitcnt vmcnt(0)" ::: "memory");
    unsigned nun = 0u;
    for (int u = worker; u < BATCH * SW_H * (SEQ / 32); u += nworkers) { const int qblk = u & 127, b = u >> 10; ++nun;
        if (lane == 0) __hip_atomic_fetch_add(F.ctl + CW_PAN + 64 * (b * 16 + (qblk >> 3)) + 1, 1u, RLX_AGENT); }
    if (lane == 0 && nun) __hip_atomic_fetch_add(F.ctl + CW_SWADONE + 64 * (worker & 7), nun, RLX_AGENT);
#endif
}

constexpr int DNL_QT = 0, DNL_KT = 17408, DNL_VT = 34816, DNL_WL = 52224, DNL_NA = 69632, DNL_QKM = 78848, DNL_DB = 88064, DNL_TIB = 92160, DNL_GC = 94208, DNL_BETA = 94464;
constexpr int TP = 272;
constexpr int NP2 = 144;
struct DnRec { bf16* UA; bf16* UB; bf16* W; bf16* QG; bf16* KD; bf16* QK; float* EGL;
    __device__ __forceinline__ bf16* u(int ch, int sl, int mt, int lane) const { return (ch < 640 ? UA + (size_t)ch * 8192 : UB + (size_t)(ch - 640) * 8192) + ((sl * 4 + mt) * 64 + lane) * 4; } };
__device__ __forceinline__ DnRec dn_rec(Frame& F) {
    DnRec r; r.W = (bf16*)F.out; r.QG = r.W + 8 * 1024 * 1024; r.KD = r.W + 16 * 1024 * 1024; r.QK = r.W + 24 * 1024 * 1024; r.UA = r.W + 27 * 1024 * 1024; r.UB = (bf16*)(F.ws + WS_UB); r.EGL = (float*)(F.ws + WS_SSQ); return r;
}
#if STAMP_DN >= 0
__device__ unsigned long long g_dn[8];
#define DNSTAMP(i) if (blockIdx.x == STAMP_BLOCK && threadIdx.x == 0) { const unsigned long long now_ = __builtin_amdgcn_s_memrealtime(); dnacc_[i] += now_ - dnlast_; dnlast_ = now_; }
#else
#define DNSTAMP(i)
#endif
__device__ __forceinline__ void dn_chunk_prep(Frame& F) {
#if STAMP_DN >= 0
    unsigned long long dnacc_[8] = {0, 0, 0, 0, 0, 0, 0, 0}; unsigned long long dnlast_ = __builtin_amdgcn_s_memrealtime();
#endif
    const DnRec R = dn_rec(F);
    const bf16* proj = (const bf16*)(F.ws + WS_PROJ); const float* conv = FIN(3); const float* gbp = (const float*)(F.ws + WS_GB);
    LAS unsigned char* L = F.lds + RING_OFF;
    LAS float* GC = (LAS float*)(L + DNL_GC); LAS float* BETA = (LAS float*)(L + DNL_BETA); LAS float* DB = (LAS float*)(L + DNL_DB);
    const int lane = F.lane, wave = F.wave, r16 = lane & 15, g = lane >> 4;
    const int tk0 = 8 * wave;
    unsigned raw[3][11]; float gx, gbl;
#define DN_LOAD_INPUTS(ch_) do { const int bh_ = (ch_) >> 6, c_ = (ch_) & 63, b_ = bh_ >> 2, h_ = bh_ & 3; const size_t m0_ = (size_t)b_ * SEQ + 64 * c_; \
        gx = gbp[(m0_ + lane) * 8 + 4 + h_]; gbl = gbp[(m0_ + lane) * 8 + h_]; \
        _Pragma("unroll") for (int p = 0; p < 3; ++p) { const int col_ = p * DN_W + h_ * DN_D + 2 * lane; \
            _Pragma("unroll") for (int r = 0; r < 11; ++r) { const int tr_ = 64 * c_ + tk0 - 3 + r; raw[p][r] = *(const unsigned*)(proj + (m0_ - 64 * c_ + (tr_ < 0 ? 0 : tr_)) * NP + col_); } } } while (0)
#if DNA_PREFETCH
    if (F.vcu < 1024) DN_LOAD_INPUTS(F.vcu);
#endif
    for (int ch = F.vcu; ch < 1024; ch += F.G) {
        const int bh = ch >> 6, c = ch & 63, b = bh >> 2, h = bh & 3; const size_t m0 = (size_t)b * SEQ + 64 * c;
        {
#if !DNA_PREFETCH
            DN_LOAD_INPUTS(ch);
#endif
            float cw[3][4][2];
#pragma unroll
            for (int p = 0; p < 3; ++p) { const int col = p * DN_W + h * DN_D + 2 * lane;
#pragma unroll
                for (int j = 0; j < 4; ++j) { cw[p][j][0] = conv[j * DN_QKV + col]; cw[p][j][1] = conv[j * DN_QKV + col + 1]; } }
            if (wave == 0) { float x = gx;
#pragma unroll
                for (int off = 1; off < 64; off <<= 1) { const float t = __shfl_up(x, off); if (lane >= off) x += t; }
                GC[lane] = x; BETA[lane] = gbl; }
            if (64 * c + tk0 < 3) {
#pragma unroll
                for (int p = 0; p < 3; ++p)
#pragma unroll
                    for (int r = 0; r < 3; ++r) if (64 * c + tk0 - 3 + r < 0) raw[p][r] = 0u;
            }
#pragma unroll
            for (int hb = 0; hb < 2; ++hb) {
                float val[4][3][2], sq[4], sk[4];
#pragma unroll
                for (int i4 = 0; i4 < 4; ++i4) { const int i = 4 * hb + i4;
#pragma unroll
                    for (int p = 0; p < 3; ++p) { float a0 = 0.f, a1 = 0.f;
#pragma unroll
                        for (int j = 0; j < 4; ++j) { a0 += cw[p][j][0] * bflo(raw[p][i + j]); a1 += cw[p][j][1] * bfhi(raw[p][i + j]); }
                        val[i4][p][0] = a0 * sigm(a0); val[i4][p][1] = a1 * sigm(a1); }
                    sq[i4] = val[i4][0][0] * val[i4][0][0] + val[i4][0][1] * val[i4][0][1]; sk[i4] = val[i4][1][0] * val[i4][1][0] + val[i4][1][1] * val[i4][1][1]; }
#pragma unroll
                for (int i4 = 0; i4 < 4; ++i4) { sq[i4] = wave_sum(sq[i4]); sk[i4] = wave_sum(sk[i4]); }
#pragma unroll
                for (int i4 = 0; i4 < 4; ++i4) {
                    const float rq = frsq(sq[i4] + EPS) * 0.08838834764831845f, rk = frsq(sk[i4] + EPS);
                    const int o = (tk0 + 4 * hb + i4) * TP + 4 * lane;
                    *(LAS unsigned*)(L + DNL_QT + o) = cvtpk(val[i4][0][0] * rq, val[i4][0][1] * rq);
                    *(LAS unsigned*)(L + DNL_KT + o) = cvtpk(val[i4][1][0] * rk, val[i4][1][1] * rk);
                    *(LAS unsigned*)(L + DNL_VT + o) = cvtpk(val[i4][2][0], val[i4][2][1]);
                }
            }
        }
        __syncthreads(); DNSTAMP(0)
#pragma unroll
        for (int k_ = 0; k_ < 3; ++k_) { const int id = wave + 8 * k_; if (id < 20) {
            const int e = id % 10, isqk = (id / 10) & 1, ti = (e >= 6) ? 3 : (e >= 3) ? 2 : (e >= 1) ? 1 : 0, tj = e - ti * (ti + 1) / 2;
            f32x4 acc = {0.f, 0.f, 0.f, 0.f};
            const int xoff = isqk ? DNL_QT : DNL_KT;
#pragma unroll
            for (int ks = 0; ks < 4; ++ks) {
                const bf16x8 a = *(const LAS bf16x8*)(L + DNL_KT + (16 * tj + r16) * TP + (32 * ks + 8 * g) * 2);
                const bf16x8 bq = *(const LAS bf16x8*)(L + xoff + (16 * ti + r16) * TP + (32 * ks + 8 * g) * 2);
                acc = MFMA16(a, bq, acc); }
            const int i = 16 * ti + r16; const float gi = GC[i], bi = BETA[i]; const f32x4 gj = *(const LAS f32x4*)(GC + 16 * tj + 4 * g);
            f32x4 v;
#pragma unroll
            for (int r = 0; r < 4; ++r) { const int jp = 16 * tj + 4 * g + r; const float d = __expf(fminf(gi - gj[r], 0.f));
                v[r] = isqk ? ((i >= jp) ? acc[r] * d : 0.f) : ((i > jp) ? bi * acc[r] * d : 0.f); }
            if (!isqk) {
                u32x2 w; w.x = cvtpk(-v[0], -v[1]); w.y = cvtpk(-v[2], -v[3]);
                *(LAS u32x2*)(L + DNL_NA + i * NP2 + (16 * tj + 4 * g) * 2) = w;
                if (ti == tj) *(LAS f32x4*)(DB + (ti * 16 + r16) * 16 + 4 * g) = v;
            } else { u32x2 w; w.x = cvtpk(v[0], v[1]); w.y = cvtpk(v[2], v[3]); *(LAS u32x2*)(L + DNL_QKM + i * NP2 + (16 * tj + 4 * g) * 2) = w; }
        } }
        __syncthreads(); DNSTAMP(1)
        if (wave < 4) {
            const int I = wave; float x[16];
#pragma unroll
            for (int i = 0; i < 16; ++i) { float a = (i == r16) ? 1.f : 0.f;
#pragma unroll
                for (int j4 = 0; j4 < (i + 3) / 4; ++j4) { const f32x4 d = *(const LAS f32x4*)(DB + (I * 16 + i) * 16 + 4 * j4);
#pragma unroll
                    for (int jj = 0; jj < 4; ++jj) if (4 * j4 + jj < i) a -= d[jj] * x[4 * j4 + jj]; }
                x[i] = a; }
            if (lane < 16) {
#pragma unroll
                for (int i = 0; i < 16; ++i) *(LAS unsigned short*)(L + DNL_TIB + ((I * 16 + i) * 16 + r16) * 2) = (unsigned short)(cvtpk(x[i], 0.f) & 0xffffu);
            }
        } else {
            const int w4 = wave - 4;
            {
                const int mt = w4; const float e = __expf(GC[16 * mt + r16]); const int base = DNL_QT + (16 * mt + r16) * TP;
                u32x2 lo[4], hi[4];
#pragma unroll
                for (int ks = 0; ks < 4; ++ks) { lo[ks] = *(const LAS u32x2*)(L + base + (32 * ks + 4 * g) * 2); hi[ks] = *(const LAS u32x2*)(L + base + (32 * ks + 16 + 4 * g) * 2); }
#pragma unroll
                for (int ks = 0; ks < 4; ++ks) { v4u w; w.x = cvtpk(bflo(lo[ks].x) * e, bfhi(lo[ks].x) * e); w.y = cvtpk(bflo(lo[ks].y) * e, bfhi(lo[ks].y) * e); w.z = cvtpk(bflo(hi[ks].x) * e, bfhi(hi[ks].x) * e); w.w = cvtpk(bflo(hi[ks].y) * e, bfhi(hi[ks].y) * e);
                    *(v4u*)(R.QG + ((size_t)(ch * 16 + mt * 4 + ks) * 64 + lane) * 8) = w; }
            }
            {
                const float gl = GC[63]; float ed[2][8];
#pragma unroll
                for (int kt = 0; kt < 2; ++kt)
#pragma unroll
                    for (int j = 0; j < 8; ++j) { const int tok = 32 * kt + (j < 4 ? 4 * g + j : 16 + 4 * g + j - 4); ed[kt][j] = __expf(gl - GC[tok]); }
#pragma unroll
                for (int i = 0; i < 4; ++i) { const int f = 4 * w4 + i, mt8 = f >> 1, kt = i & 1, dk = 16 * mt8 + r16; float v[8];
#pragma unroll
                    for (int j = 0; j < 8; ++j) { const int tok = 32 * kt + (j < 4 ? 4 * g + j : 16 + 4 * g + j - 4); v[j] = bf1(*(const LAS unsigned short*)(L + DNL_KT + tok * TP + dk * 2)) * ed[kt][j]; }
                    v4u w; w.x = cvtpk(v[0], v[1]); w.y = cvtpk(v[2], v[3]); w.z = cvtpk(v[4], v[5]); w.w = cvtpk(v[6], v[7]);
                    *(v4u*)(R.KD + ((size_t)(ch * 16 + f) * 64 + lane) * 8) = w; }
            }
#pragma unroll
            for (int i = 0; i < 2; ++i) { const int q = w4 + 4 * i;
                if (q < 6) { const int mt = (q == 0) ? 0 : (q == 1) ? 1 : (q < 4) ? 2 : 3, kt = (q == 3 || q == 5) ? 1 : 0;
                    const u32x2 lo = *(const LAS u32x2*)(L + DNL_QKM + (16 * mt + r16) * NP2 + (32 * kt + 4 * g) * 2);
                    u32x2 hi = {0u, 0u}; if (2 * kt + 1 <= mt) hi = *(const LAS u32x2*)(L + DNL_QKM + (16 * mt + r16) * NP2 + (32 * kt + 16 + 4 * g) * 2);
                    const v4u w = {lo.x, lo.y, hi.x, hi.y};
                    *(v4u*)(R.QK + ((size_t)(ch * 6 + q) * 64 + lane) * 8) = w; } }
            if (lane == 0 && w4 == 0) R.EGL[ch] = __expf(GC[63]);
        }
        __syncthreads(); DNSTAMP(2)
#if DNA_PREFETCH
        if (ch + F.G < 1024) DN_LOAD_INPUTS(ch + F.G);
#endif
        {
            const int part = wave >> 2, colbase = 32 * (wave & 3);
            f32x4 rhs[4][2];
#pragma unroll
            for (int I = 0; I < 4; ++I) { float sc[4];
#pragma unroll
                for (int r = 0; r < 4; ++r) { const int tok = 16 * I + 4 * g + r; sc[r] = part == 0 ? BETA[tok] : -(BETA[tok] * __expf(GC[tok])); }
#pragma unroll
                for (int nt = 0; nt < 2; ++nt) { const int col = colbase + 16 * nt + r16;
#pragma unroll
                    for (int r = 0; r < 4; ++r) { const int tok = 16 * I + 4 * g + r; rhs[I][nt][r] = sc[r] * bf1(*(const LAS unsigned short*)(L + (part == 0 ? DNL_VT : DNL_KT) + tok * TP + col * 2)); } } }
            u32x2 na10, na20l, na20h, na30l, na30h, na31l, ti[4];
            na10 = *(const LAS u32x2*)(L + DNL_NA + (16 * 1 + r16) * NP2 + (4 * g) * 2);
            na20l = *(const LAS u32x2*)(L + DNL_NA + (16 * 2 + r16) * NP2 + (4 * g) * 2); na20h = *(const LAS u32x2*)(L + DNL_NA + (16 * 2 + r16) * NP2 + (16 + 4 * g) * 2);
            na30l = *(const LAS u32x2*)(L + DNL_NA + (16 * 3 + r16) * NP2 + (4 * g) * 2); na30h = *(const LAS u32x2*)(L + DNL_NA + (16 * 3 + r16) * NP2 + (16 + 4 * g) * 2);
            na31l = *(const LAS u32x2*)(L + DNL_NA + (16 * 3 + r16) * NP2 + (32 + 4 * g) * 2);
#pragma unroll
            for (int I = 0; I < 4; ++I) ti[I] = *(const LAS u32x2*)(L + DNL_TIB + ((I * 16 + r16) * 16 + 4 * g) * 2);
            const bf16x8 A10 = __builtin_bit_cast(bf16x8, (v4u){na10.x, na10.y, 0u, 0u}), A20 = __builtin_bit_cast(bf16x8, (v4u){na20l.x, na20l.y, na20h.x, na20h.y}),
                         A30 = __builtin_bit_cast(bf16x8, (v4u){na30l.x, na30l.y, na30h.x, na30h.y}), A31 = __builtin_bit_cast(bf16x8, (v4u){na31l.x, na31l.y, 0u, 0u});
            const f32x4 zero = {0.f, 0.f, 0.f, 0.f};
            f32x4 X[2][4];
#pragma unroll
            for (int nt = 0; nt < 2; ++nt) {
                X[nt][0] = MFMA16(__builtin_bit_cast(bf16x8, (v4u){ti[0].x, ti[0].y, 0u, 0u}), pack8z(rhs[0][nt]), zero);
                f32x4 a1 = MFMA16(A10, pack8z(X[nt][0]), rhs[1][nt]);
                X[nt][1] = MFMA16(__builtin_bit_cast(bf16x8, (v4u){ti[1].x, ti[1].y, 0u, 0u}), pack8z(a1), zero);
                f32x4 a2 = MFMA16(A20, pack8(X[nt][0], X[nt][1]), rhs[2][nt]);
                X[nt][2] = MFMA16(__builtin_bit_cast(bf16x8, (v4u){ti[2].x, ti[2].y, 0u, 0u}), pack8z(a2), zero);
                f32x4 a3 = MFMA16(A30, pack8(X[nt][0], X[nt][1]), rhs[3][nt]); a3 = MFMA16(A31, pack8z(X[nt][2]), a3);
                X[nt][3] = MFMA16(__builtin_bit_cast(bf16x8, (v4u){ti[3].x, ti[3].y, 0u, 0u}), pack8z(a3), zero);
            }
#pragma unroll
            for (int nt = 0; nt < 2; ++nt)
#pragma unroll
                for (int I = 0; I < 4; ++I) {
                    if (part == 0) { u32x2 w; w.x = cvtpk(X[nt][I][0], X[nt][I][1]); w.y = cvtpk(X[nt][I][2], X[nt][I][3]); *(u32x2*)R.u(ch, 2 * (wave & 3) + nt, I, lane) = w; }
                    else { const int col = colbase + 16 * nt + r16;
#pragma unroll
                        for (int r = 0; r < 4; ++r) *(LAS unsigned short*)(L + DNL_WL + (16 * I + 4 * g + r) * TP + col * 2) = (unsigned short)(cvtpk(X[nt][I][r], 0.f) & 0xffffu); }
                }
        }
        __syncthreads(); DNSTAMP(3)
        {
            const int mt = wave >> 1, base = DNL_WL + (16 * mt + r16) * TP;
            u32x2 lo[2], hi[2];
#pragma unroll
            for (int i = 0; i < 2; ++i) { const int ks = 2 * (wave & 1) + i; lo[i] = *(const LAS u32x2*)(L + base + (32 * ks + 4 * g) * 2); hi[i] = *(const LAS u32x2*)(L + base + (32 * ks + 16 + 4 * g) * 2); }
#pragma unroll
            for (int i = 0; i < 2; ++i) { const int ks = 2 * (wave & 1) + i; const v4u w = {lo[i].x, lo[i].y, hi[i].x, hi[i].y}; *(v4u*)(R.W + ((size_t)(ch * 16 + mt * 4 + ks) * 64 + lane) * 8) = w; }
        }
        __syncthreads(); DNSTAMP(4)
    }
#if STAMP_DN >= 0
    if (blockIdx.x == STAMP_BLOCK && threadIdx.x == 0) { for (int i = 0; i < 8; ++i) g_dn[i] = dnacc_[i]; }
#endif
}
__device__ __forceinline__ void dn_out2(Frame& F, int worker, int nworkers, int task_lo = 0, int task_hi = 4096) {
    const DnRec R = dn_rec(F);
    const int lane = F.lane, r16 = lane & 15, g = lane >> 4;
    bf16* proj = (bf16*)(F.ws + WS_PROJ); const float* gain = FIN(6);
    int pub_pm = -1;
    for (int task = worker; task < (DNO_SKIPALL ? 0 : task_hi); task += nworkers) {
        if (task < task_lo) continue;
        const int c = task >> 6, bh = (task >> 2) & 15, mt = task & 3, ch = bh * 64 + c, b = bh >> 2, h = bh & 3;
        {   gu32* f0 = F.ctl + CW_SCAN + 64 * (bh * 2);
            for (unsigned sp = 0;; ++sp) {
                const unsigned p0 = (unsigned)__builtin_amdgcn_readfirstlane((int)__hip_atomic_load(f0, RLX_AGENT)), p1 = (unsigned)__builtin_amdgcn_readfirstlane((int)__hip_atomic_load(f0 + 64, RLX_AGENT));
                if ((p0 < p1 ? p0 : p1) > (unsigned)(c + DNO_LAG < 63 ? c + DNO_LAG : 63) || sp > (1u << 16)) break;
                __builtin_amdgcn_s_sleep(DNO_SLEEP);
            }
            if (DNO_FENCE) __builtin_amdgcn_fence(__ATOMIC_ACQUIRE, "agent"); else asm volatile("" ::: "memory"); }
        if (DNO_SKIPWORK) continue;
        if (SEAM35 && pub_pm >= 0) { asm volatile("s_waitcnt vmcnt(0)" ::: "memory"); if (lane == 0) __hip_atomic_fetch_add(F.ctl + CW_PAN + 64 * pub_pm, 1u, RLX_AGENT); }
        pub_pm = (bh >> 2) * 16 + (c >> 2);
        f32x4 o[8]; float ss[4] = {0.f, 0.f, 0.f, 0.f};
#pragma unroll
        for (int sl = 0; sl < 8; ++sl) { u32x2 w;
            if (DNO_FENCE) w = *(const u32x2*)R.u(ch, sl, mt, lane);
            else { const unsigned long long q = __hip_atomic_load((GAS unsigned long long*)R.u(ch, sl, mt, lane), RLX_AGENT); w.x = (unsigned)q; w.y = (unsigned)(q >> 32); }
            o[sl] = (f32x4){bflo(w.x), bfhi(w.x), bflo(w.y), bfhi(w.y)};
#pragma unroll
            for (int r = 0; r < 4; ++r) ss[r] += o[sl][r] * o[sl][r]; }
#pragma unroll
        for (int r = 0; r < 4; ++r) { float s = sum16(ss[r]); ss[r] = frsq(s * (1.0f / DN_D) + EPS); }
        float gdv[8];
#pragma unroll
        for (int sl = 0; sl < 8; ++sl) gdv[sl] = gain[16 * sl + r16];
        unsigned short zz[8][4];
#pragma unroll
        for (int sl = 0; sl < 8; ++sl)
#pragma unroll
            for (int r = 0; r < 4; ++r) zz[sl][r] = proj[((size_t)b * SEQ + 64 * c + 16 * mt + 4 * g + r) * NP + PC_Z + h * DN_D + 16 * sl + r16];
#if DNO_STAGE
        {   LAS unsigned char* stg = F.lds + RING_OFF + F.wave * 16384;
#pragma unroll
            for (int sl = 0; sl < 8; ++sl) { const float gd = gdv[sl];
#pragma unroll
                for (int r = 0; r < 4; ++r) { const float z = bf1(zz[sl][r]);
                    *(LAS unsigned short*)(stg + (4 * g + r) * 272 + (16 * sl + r16) * 2) = (unsigned short)(cvtpk(o[sl][r] * ss[r] * gd * z * sigm(z), 0.f) & 0xffffu); } }
            asm volatile("s_waitcnt lgkmcnt(0)" ::: "memory");
            const size_t m0 = (size_t)b * SEQ + 64 * c + 16 * mt;
#pragma unroll
            for (int i = 0; i < 4; ++i) { const int q = lane + 64 * i, row = q >> 4, cc = q & 15; const v4u v = *(const LAS v4u*)(stg + row * 272 + cc * 16);
                GAS v4u* dst = (GAS v4u*)(proj + (m0 + row) * NP + PC_YDN + h * DN_D + cc * 8);
                asm volatile("global_store_dwordx4 %0, %1, off sc1\n\ts_nop 2" :: "v"(dst), "v"(v) : "memory"); }
            asm volatile("s_waitcnt lgkmcnt(0)" ::: "memory");
        }
#else
#pragma unroll
        for (int sl = 0; sl < 8; ++sl) { const int d = 16 * sl + r16; const float gd = gdv[sl];
#pragma unroll
            for (int r = 0; r < 4; ++r) { const size_t m = (size_t)b * SEQ + 64 * c + 16 * mt + 4 * g + r; const float z = bf1(zz[sl][r]);
                proj[m * NP + PC_YDN + h * DN_D + d] = (bf16)(cvtpk(o[sl][r] * ss[r] * gd * z * sigm(z), 0.f) & 0xffffu); } }
#endif
    }
    if (SEAM35 && pub_pm >= 0) { asm volatile("s_waitcnt vmcnt(0)" ::: "memory"); if (lane == 0) __hip_atomic_fetch_add(F.ctl + CW_PAN + 64 * pub_pm, 1u, RLX_AGENT); }
    if (SEAM78 && lane == 0) { unsigned nt_ = 0u; for (int task = worker; task < 4096; task += nworkers) ++nt_;
        if (nt_) __hip_atomic_fetch_add(F.ctl + CW_NORMDONE + 64 * (worker & 7), nt_, RLX_AGENT); }
}
constexpr int SCAN_H0 = 32768, SCAN_H1 = 24576;
__device__ __forceinline__ void dn_scan_wg(Frame& F, int bh, int half) {
    const DnRec R = dn_rec(F);
    const int lane = F.lane, wave = F.wave;
    LAS unsigned char* ring = F.lds + RING_OFF;
    if (wave >= 4) {
        const int lw = wave - 4;
        v4u r0[8], r1[6], r2[8], r3[6];
#if SCAN_SETS == 6
        v4u r4[8], r5[6];
#endif
#define LD_H0(set_, k_) do { const int ch_ = bh * 64 + ((k_) >> 1); _Pragma("unroll") for (int i_ = 0; i_ < 8; ++i_) { const int p_ = lw + 4 * i_; \
            const bf16* src_ = p_ < 16 ? R.W + (size_t)ch_ * 8192 + p_ * 512 : R.QG + (size_t)ch_ * 8192 + (p_ - 16) * 512; set_[i_] = SCAN_NT ? __builtin_nontemporal_load((const v4u*)(src_ + lane * 8)) : *(const v4u*)(src_ + lane * 8); } } while (0)
#define LD_H1(set_, k_) do { const int ch_ = bh * 64 + ((k_) >> 1); _Pragma("unroll") for (int i_ = 0; i_ < 6; ++i_) { const int p_ = lw + 4 * i_, q_ = p_ < 22 ? p_ : p_ - 22; \
            const bf16* src_ = q_ < 6 ? R.QK + (size_t)ch_ * 3072 + q_ * 512 : R.KD + (size_t)ch_ * 8192 + (q_ - 6) * 512; set_[i_] = SCAN_NT ? __builtin_nontemporal_load((const v4u*)(src_ + lane * 8)) : *(const v4u*)(src_ + lane * 8); } } while (0)
#define ST_H0(set_, k_) do { LAS unsigned char* slot_ = ring + (((k_) >> 1) & 1) * (SCAN_H0 + SCAN_H1) + lane * 16; _Pragma("unroll") for (int i_ = 0; i_ < 8; ++i_) *(LAS v4u*)(slot_ + (lw + 4 * i_) * 1024) = set_[i_]; } while (0)
#define ST_H1(set_, k_) do { LAS unsigned char* slot_ = ring + (((k_) >> 1) & 1) * (SCAN_H0 + SCAN_H1) + SCAN_H0 + lane * 16; _Pragma("unroll") for (int i_ = 0; i_ < 6; ++i_) *(LAS v4u*)(slot_ + (lw + 4 * i_) * 1024) = set_[i_]; } while (0)
#define LD_BAR() do { asm volatile("s_waitcnt lgkmcnt(0)" ::: "memory"); __builtin_amdgcn_s_barrier(); asm volatile("" ::: "memory"); } while (0)
#if SCAN_SETS == 6
        LD_H0(r0, 0); LD_H1(r1, 1); LD_H0(r2, 2); LD_H1(r3, 3); LD_H0(r4, 4); LD_H1(r5, 5);
        ST_H0(r0, 0); LD_H0(r0, 6); ST_H1(r1, 1); LD_H1(r1, 7); ST_H0(r2, 2); LD_H0(r2, 8);
        for (int k = 0; k < 128; k += 6) {
            if (k + 0 < 128) { LD_BAR(); if (k + 3 < 128) { ST_H1(r3, k + 3); if (k + 9 < 128) LD_H1(r3, k + 9); } }
            if (k + 1 < 128) { LD_BAR(); if (k + 4 < 128) { ST_H0(r4, k + 4); if (k + 10 < 128) LD_H0(r4, k + 10); } }
            if (k + 2 < 128) { LD_BAR(); if (k + 5 < 128) { ST_H1(r5, k + 5); if (k + 11 < 128) LD_H1(r5, k + 11); } }
            if (k + 3 < 128) { LD_BAR(); if (k + 6 < 128) { ST_H0(r0, k + 6); if (k + 12 < 128) LD_H0(r0, k + 12); } }
            if (k + 4 < 128) { LD_BAR(); if (k + 7 < 128) { ST_H1(r1, k + 7); if (k + 13 < 128) LD_H1(r1, k + 13); } }
            if (k + 5 < 128) { LD_BAR(); if (k + 8 < 128) { ST_H0(r2, k + 8); if (k + 14 < 128) LD_H0(r2, k + 14); } }
        }
#else
        LD_H0(r0, 0); LD_H1(r1, 1); LD_H0(r2, 2); LD_H1(r3, 3);
        ST_H0(r0, 0); LD_H0(r0, 4); ST_H1(r1, 1); LD_H1(r1, 5); ST_H0(r2, 2); LD_H0(r2, 6);
#define PUB(k_) do { if (SCAN_PUBLISH && SCAN_PUB_LOADER && lw == 0 && lane == 0 && (k_) >= 4 && (((k_) >> 1) % SCAN_PUB_EVERY) == 0) asm volatile("global_store_dword %0, %1, off sc1" :: "v"(F.ctl + CW_SCAN + 64 * (bh * 2 + half)), "v"((unsigned)(((k_) >> 1) - 1)) : "memory"); } while (0)
        for (int k = 0; k < 128; k += 4) {
            LD_BAR(); PUB(k); ST_H1(r3, k + 3); if (k + 7 < 128) LD_H1(r3, k + 7);
            LD_BAR(); if (k + 4 < 128) { ST_H0(r0, k + 4); if (k + 8 < 128) LD_H0(r0, k + 8); }
            LD_BAR(); PUB(k + 2); if (k + 5 < 128) { ST_H1(r1, k + 5); if (k + 9 < 128) LD_H1(r1, k + 9); }
            LD_BAR(); if (k + 6 < 128) { ST_H0(r2, k + 6); if (k + 10 < 128) LD_H0(r2, k + 10); }
        }
#endif
#undef LD_H0
#undef LD_H1
#undef ST_H0
#undef ST_H1
#undef LD_BAR
#undef PUB
    } else {
        const int sl = half * 4 + wave;
        f32x4 S[8];
#pragma unroll
        for (int i = 0; i < 8; ++i) S[i] = (f32x4){0.f, 0.f, 0.f, 0.f};
        constexpr int UPRE = SCAN_UPRE;
        u32x2 Uq[UPRE][4]; float eq[UPRE];
#pragma unroll
        for (int d = 0; d < UPRE; ++d) { eq[d] = R.EGL[bh * 64 + d];
#pragma unroll
            for (int mt = 0; mt < 4; ++mt) Uq[d][mt] = *(const u32x2*)R.u(bh * 64 + d, sl, mt, lane); }
        for (int c4 = 0; c4 < 64; c4 += UPRE) {
#pragma unroll
        for (int j4 = 0; j4 < UPRE; ++j4) {
            const int c = c4 + j4, ch = bh * 64 + c;
            const LAS unsigned char* h0 = ring + (c & 1) * (SCAN_H0 + SCAN_H1) + lane * 16; const LAS unsigned char* h1 = h0 + SCAN_H0;
            asm volatile("s_waitcnt lgkmcnt(0)" ::: "memory");
            __builtin_amdgcn_s_barrier();
            asm volatile("" ::: "memory");
#if SCAN_PUBLISH && !SCAN_PUB_LOADER
            if (wave == 0 && c >= 2 && lane == 0) __hip_atomic_store(F.ctl + CW_SCAN + 64 * (bh * 2 + half), (unsigned)(c - 1), RLX_AGENT);
#endif
            bf16x8 fa[16];
#pragma unroll
            for (int f = 0; f < 16; ++f) fa[f] = *(const LAS bf16x8*)(h0 + f * 1024);
#if SCAN_QG_EARLY
            bf16x8 fb[8];
#pragma unroll
            for (int f = 0; f < 8; ++f) fb[f] = *(const LAS bf16x8*)(h0 + 16384 + f * 1024);
#endif
            bf16x8 Sb[4];
#pragma unroll
            for (int ks = 0; ks < 4; ++ks) Sb[ks] = pack8(S[2 * ks], S[2 * ks + 1]);
            const float egl = eq[j4];
            u32x2 Uf[4];
#pragma unroll
            for (int mt = 0; mt < 4; ++mt) Uf[mt] = Uq[j4][mt];
            __builtin_amdgcn_sched_barrier(0);
            f32x4 vn[4], o[4];
#pragma unroll
            for (int mt = 0; mt < 4; ++mt) { vn[mt] = (f32x4){bflo(Uf[mt].x), bfhi(Uf[mt].x), bflo(Uf[mt].y), bfhi(Uf[mt].y)};
#pragma unroll
                for (int ks = 0; ks < 4; ++ks) vn[mt] = MFMA16(fa[mt * 4 + ks], Sb[ks], vn[mt]); }
            __builtin_amdgcn_sched_barrier(0);
#if SCAN_QG_EARLY
#pragma unroll
            for (int f = 8; f < 16; ++f) fa[f] = *(const LAS bf16x8*)(h0 + 16384 + f * 1024);
            __builtin_amdgcn_sched_barrier(0);
#pragma unroll
            for (int mt = 0; mt < 2; ++mt) { o[mt] = (f32x4){0.f, 0.f, 0.f, 0.f};
#pragma unroll
                for (int ks = 0; ks < 4; ++ks) o[mt] = MFMA16(fb[mt * 4 + ks], Sb[ks], o[mt]); }
#pragma unroll
            for (int mt = 2; mt < 4; ++mt) { o[mt] = (f32x4){0.f, 0.f, 0.f, 0.f};
#pragma unroll
                for (int ks = 0; ks < 4; ++ks) o[mt] = MFMA16(fa[mt * 4 + ks], Sb[ks], o[mt]); }
#else
#pragma unroll
            for (int f = 0; f < 16; ++f) fa[f] = *(const LAS bf16x8*)(h0 + 16384 + f * 1024);
            __builtin_amdgcn_sched_barrier(0);
#pragma unroll
            for (int mt = 0; mt < 4; ++mt) { o[mt] = (f32x4){0.f, 0.f, 0.f, 0.f};
#pragma unroll
                for (int ks = 0; ks < 4; ++ks) o[mt] = MFMA16(fa[mt * 4 + ks], Sb[ks], o[mt]); }
#endif
            const bf16x8 vb0 = pack8(vn[0], vn[1]), vb1 = pack8(vn[2], vn[3]);
#if !SCAN_PUBLISH || !SCAN_REFILL_LATE
            { const int cn = (c + UPRE < 64) ? c + UPRE : 63;
#pragma unroll
                for (int mt = 0; mt < 4; ++mt) Uq[j4][mt] = *(const u32x2*)R.u(bh * 64 + cn, sl, mt, lane);
                eq[j4] = R.EGL[bh * 64 + cn]; }
#endif
            asm volatile("s_waitcnt lgkmcnt(0)" ::: "memory");
            __builtin_amdgcn_s_barrier();
            asm volatile("" ::: "memory");
            bf16x8 fq_[6];
#pragma unroll
            for (int f = 0; f < 6; ++f) fq_[f] = *(const LAS bf16x8*)(h1 + f * 1024);
#pragma unroll
            for (int f = 0; f < 16; ++f) fa[f] = *(const LAS bf16x8*)(h1 + 6144 + f * 1024);
            __builtin_amdgcn_sched_barrier(0);
            o[0] = MFMA16(fq_[0], vb0, o[0]); o[1] = MFMA16(fq_[1], vb0, o[1]);
            o[2] = MFMA16(fq_[2], vb0, o[2]); o[2] = MFMA16(fq_[3], vb1, o[2]);
            o[3] = MFMA16(fq_[4], vb0, o[3]); o[3] = MFMA16(fq_[5], vb1, o[3]);
#pragma unroll
            for (int i = 0; i < 8; ++i) { S[i] = S[i] * egl; S[i] = MFMA16(fa[2 * i], vb0, S[i]); S[i] = MFMA16(fa[2 * i + 1], vb1, S[i]); }
#if SCAN_PUBLISH
#if !SCAN_DRAIN_NONE
            VM_WAIT();
#endif
#if SCAN_O16
#pragma unroll
            for (int p2 = 0; p2 < 2; ++p2) {
                const unsigned a0 = cvtpk(o[2 * p2][0], o[2 * p2][1]), a1 = cvtpk(o[2 * p2][2], o[2 * p2][3]), b0 = cvtpk(o[2 * p2 + 1][0], o[2 * p2 + 1][1]), b1 = cvtpk(o[2 * p2 + 1][2], o[2 * p2 + 1][3]);
                const bool odd = (lane & 1) != 0;
                const unsigned r0 = (unsigned)__builtin_amdgcn_update_dpp(0, (int)(odd ? a0 : b0), 0xB1, 0xf, 0xf, true), r1 = (unsigned)__builtin_amdgcn_update_dpp(0, (int)(odd ? a1 : b1), 0xB1, 0xf, 0xf, true);
                v4u w; w.x = odd ? r0 : a0; w.y = odd ? r1 : a1; w.z = odd ? b0 : r0; w.w = odd ? b1 : r1;
                GAS v4u* dst = (GAS v4u*)R.u(ch, sl, 2 * p2 + (odd ? 1 : 0), lane & ~1);
                asm volatile("global_store_dwordx4 %0, %1, off sc1\n\ts_nop 2" :: "v"(dst), "v"(w) : "memory"); }
#else
#pragma unroll
            for (int mt = 0; mt < 4; ++mt) { const unsigned long long w = (unsigned long long)cvtpk(o[mt][0], o[mt][1]) | ((unsigned long long)cvtpk(o[mt][2], o[mt][3]) << 32);
                if (SCAN_O_SC1) __hip_atomic_store((GAS unsigned long long*)R.u(ch, sl, mt, lane), w, RLX_AGENT); else *(unsigned long long*)R.u(ch, sl, mt, lane) = w; }
#endif
            if (SCAN_REFILL_LATE) { const int cn = (c + UPRE < 64) ? c + UPRE : 63;
#pragma unroll
                for (int mt = 0; mt < 4; ++mt) Uq[j4][mt] = *(const u32x2*)R.u(bh * 64 + cn, sl, mt, lane);
                eq[j4] = R.EGL[bh * 64 + cn]; }
#else
#pragma unroll
            for (int mt = 0; mt < 4; ++mt) { u32x2 w; w.x = cvtpk(o[mt][0], o[mt][1]); w.y = cvtpk(o[mt][2], o[mt][3]); *(u32x2*)R.u(ch, sl, mt, lane) = w; }
#endif
        }
        }
    }
#if SCAN_PUBLISH
    VM_WAIT(); __syncthreads();
    if (F.tid == 0) __hip_atomic_store(F.ctl + CW_SCAN + 64 * (bh * 2 + half), 64u, RLX_AGENT);
#endif
}
__device__ unsigned long long g_ts[16];
__device__ __forceinline__ void run_phase0(Frame& F0) {
    Frame F = F0; asm volatile("" : "+v"(F.tid)); F.lane = F.tid & 63;
    unsigned char* ws = F.ws; bf16* XB = (bf16*)(ws + WS_XB); bf16* Y = (bf16*)(ws + WS_Y); bf16* PROJ = (bf16*)(ws + WS_PROJ); (void)XB; (void)Y; (void)PROJ;
        p0_prologue(F);
}
__device__ __forceinline__ void run_phase1(Frame& F0) {
    Frame F = F0; asm volatile("" : "+v"(F.tid)); F.lane = F.tid & 63;
    unsigned char* ws = F.ws; bf16* XB = (bf16*)(ws + WS_XB); bf16* Y = (bf16*)(ws + WS_Y); bf16* PROJ = (bf16*)(ws + WS_PROJ); (void)XB; (void)Y; (void)PROJ;
        const int N1 = (F.G == 256) ? P1_TILES * 256 : NP;
        pg8::Gemm g{XB, (const bf16*)(ws + WS_WIN), M, N1, D}; pg8::StaticOrder S; S.init(M, N1, F.G, (int)blockIdx.x);
        pg8::EpiProj E{PROJ, NP, (const float*)(ws + WS_RSTD), PC_G / 256, 0, FUSE_QKNORM ? Y + (size_t)M * SW_W : nullptr, Y, FIN(7), FIN(8), PC_SQ / 256, PC_SK / 256, 0.125f * 1.4426950408889634f, SEQ};
        pg8::gemm_phase<pg8::EpiProj, pg8::StaticOrder, ALIGN_P1, true>(F.lds + RING_OFF, g, S, E);
}
__device__ __forceinline__ void run_phase2(Frame& F0) {
    Frame F = F0; asm volatile("" : "+v"(F.tid)); F.lane = F.tid & 63;
    unsigned char* ws = F.ws; bf16* XB = (bf16*)(ws + WS_XB); bf16* Y = (bf16*)(ws + WS_Y); bf16* PROJ = (bf16*)(ws + WS_PROJ); (void)XB; (void)Y; (void)PROJ;
#if FAST_DN
        SUBSTAMP(0) for (int rep_ = 0; rep_ < REP_DNA; ++rep_) dn_chunk_prep(F); SUBSTAMP(1)
#else
        dn_pre(F);
#endif
#if FAST_SWA
        for (int rep_ = 0; rep_ < REP_SWAPRE; ++rep_) swa_pre(F); SUBSTAMP(2)
#endif
}
__device__ __forceinline__ void run_phase3(Frame& F0) {
    Frame F = F0; asm volatile("" : "+v"(F.tid)); F.lane = F.tid & 63;
    unsigned char* ws = F.ws; bf16* XB = (bf16*)(ws + WS_XB); bf16* Y = (bf16*)(ws + WS_Y); bf16* PROJ = (bf16*)(ws + WS_PROJ); (void)XB; (void)Y; (void)PROJ;
#if FAST_DN
        if (F.G == 256) {
            const int bx = (int)blockIdx.x;
            SUBSTAMP(3)
            if (((bx >> 3) & 7) == 0) {
                const int xcd = bx & 7, j = bx >> 6;
                if (!P3_SKIP_SCAN) dn_scan_wg(F, xcd * 2 + (j >> 1), j & 1);
                SUBSTAMP(4)
            } else if (!P3_SKIP_GEMM) {
                const int gi = (bx >> 6) * 56 + (bx & 63) - 8, NG = NP - P1_TILES * 256;
#if P3_ORDER == 1
                if (DEFER_WEIGHTS) { weight_copies(F, WI_P0, WI_ALL, gi * NWAVES + F.wave, 224 * NWAVES); __syncthreads(); }
                swa_bias_table(F); __syncthreads();
                swa_main(F, gi * NWAVES + F.wave, 224 * NWAVES);
                __syncthreads();
#endif
                pg8::Gemm g{XB, (const bf16*)(ws + WS_WIN) + (size_t)P1_TILES * 256 * D, M, NG, D}; pg8::StaticOrder S; S.init(M, NG, 224, gi);
                pg8::EpiProj E{PROJ, NP, (const float*)(ws + WS_RSTD), PC_G / 256, P1_TILES, nullptr, nullptr, nullptr, nullptr, 0, 0, 0.f, SEQ, SEAM35};
                pg8::gemm_phase<pg8::EpiProj, pg8::StaticOrder, true, true>(F.lds + RING_OFF, g, S, E);
                if (SEAM35 && F.tid == 0) {
                    pg8::Unit u_; for (int i_ = 0; S.next(i_, u_); ++i_) __hip_atomic_fetch_add(F.ctl + CW_PAN + 64 * u_.pm + 2, 1u, RLX_AGENT); }
                SUBSTAMP(4)
#if P3_ORDER == 0
                if (!P3_ONLY_SCAN) { swa_bias_table(F); __syncthreads();
                swa_main(F, gi * NWAVES + F.wave, 224 * NWAVES);
                SUBSTAMP(5)
#if ASYM_WCOPY
                __syncthreads();
                const int hi_ = (bx >> 6) * 28 + (((bx & 63) - 8) >> 1);
#if ASYM_DNO
                if (!(bx & 1)) dn_out2(F, hi_ * NWAVES + F.wave, 112 * NWAVES, 0, 2048);
#else
                dn_out2(F, gi * NWAVES + F.wave, 224 * NWAVES, 0, 224 * NWAVES);
#endif
                if (DEFER_WEIGHTS && (bx & 1)) weight_copies(F, WI_P0, WI_ALL, hi_ * NWAVES + F.wave, 112 * NWAVES); }
#else
                if (DEFER_WEIGHTS) { __syncthreads(); weight_copies(F, WI_P0, WI_ALL, gi * NWAVES + F.wave, 224 * NWAVES); } }
#endif
                if (SEAM67 && DEFER_WEIGHTS) { asm volatile("s_waitcnt vmcnt(0)" ::: "memory"); if (F.lane == 0) __hip_atomic_fetch_add(F.ctl + CW_WCOPY + 64 * (F.wave & 7), 1u, RLX_AGENT); }
                SUBSTAMP(6)
#endif
#if ASYM_WCOPY && ASYM_DNO
                if (bx & 1) dn_out2(F, 2048 + ((bx >> 6) * 28 + (((bx & 63) - 8) >> 1)) * NWAVES + F.wave, 112 * NWAVES, 0, 4096);
                SUBSTAMP(7)
#else
                dn_out2(F, gi * NWAVES + F.wave, 224 * NWAVES, ASYM_WCOPY ? 224 * NWAVES : 0, 4096); SUBSTAMP(7)
#endif
            }
        } else {
        for (int task = F.vcu; task < 32; task += F.G) { dn_scan_wg(F, task >> 1, task & 1); __syncthreads(); }
        swa_bias_table(F); __syncthreads();
        swa_main(F, F.vcu * NWAVES + F.wave, F.G * NWAVES);
        __syncthreads();
        dn_out2(F, F.vcu * NWAVES + F.wave, F.G * NWAVES);
        }
#elif FAST_SWA
        if (F.vcu < 16) dn_scan_naive(F, F.vcu);
        else { swa_bias_table(F); __syncthreads(); swa_main(F, (F.vcu - 16) * NWAVES + F.wave, (F.G - 16) * NWAVES); }
#else
        if (F.G > 16) { if (F.vcu < 16) dn_scan_naive(F, F.vcu); else swa_naive(F, (F.vcu - 16) * NWAVES + F.wave, (F.G - 16) * NWAVES); }
        else { for (int bh = F.vcu; bh < 16; bh += F.G) dn_scan_naive(F, bh); swa_naive(F, F.vcu * NWAVES + F.wave, F.G * NWAVES); }
#endif
}
__device__ __forceinline__ void run_phase4(Frame& F0) {
    Frame F = F0; asm volatile("" : "+v"(F.tid)); F.lane = F.tid & 63;
    unsigned char* ws = F.ws; bf16* XB = (bf16*)(ws + WS_XB); bf16* Y = (bf16*)(ws + WS_Y); bf16* PROJ = (bf16*)(ws + WS_PROJ); (void)XB; (void)Y; (void)PROJ;
}
__device__ __forceinline__ void run_phase5(Frame& F0) {
    Frame F = F0; asm volatile("" : "+v"(F.tid)); F.lane = F.tid & 63;
    unsigned char* ws = F.ws; bf16* XB = (bf16*)(ws + WS_XB); bf16* Y = (bf16*)(ws + WS_Y); bf16* PROJ = (bf16*)(ws + WS_PROJ); (void)XB; (void)Y; (void)PROJ;
        pg8::Gemm g{PROJ + PC_YDN, (const bf16*)(ws + WS_WAB), 2 * M, 2 * D, DN_W, NP, M / 256, (PC_YSW - PC_YDN) * 2};
        pg8::PairedOrder S; S.init(M, D, F.G, (int)blockIdx.x);
        if (SEAM35 && F.G == 256) {
            pg8::Unit u0;
            if (S.next(0, u0) && F.wave == 0) { gu32* pc = F.ctl + CW_PAN + 64 * u0.pm;
                for (unsigned sp = 0; sp < (1u << 18); ++sp) {
                    const unsigned a0 = (unsigned)__builtin_amdgcn_readfirstlane((int)__hip_atomic_load(pc, RLX_AGENT)), a1 = (unsigned)__builtin_amdgcn_readfirstlane((int)__hip_atomic_load(pc + 1, RLX_AGENT)), a2 = (unsigned)__builtin_amdgcn_readfirstlane((int)__hip_atomic_load(pc + 2, RLX_AGENT));
                    if (a0 >= 64u && a1 >= 64u && a2 >= 7u) break;
                    __builtin_amdgcn_s_sleep(4); }
                __builtin_amdgcn_fence(__ATOMIC_ACQUIRE, "agent"); asm volatile("s_waitcnt vmcnt(0)" ::: "memory"); }
            __syncthreads(); }
#if P5_TOUCH_G
        {
            pg8::Unit u0; if (S.next(0, u0)) { const bf16* gt = PROJ + PC_G + (size_t)u0.pm * 256 * NP + u0.pn * 256;
#pragma unroll
                for (int i = 0; i < 4; ++i) { const int line = i * 512 + F.tid, half = line >> 10, row = (line >> 2) & 255, seg = line & 3;
                    __builtin_amdgcn_global_load_lds((const unsigned*)(gt + (size_t)row * NP + half * 1024 + seg * 64), (LAS unsigned*)(F.lds + LDSCTL_OFF + 1024 + F.wave * 256), 4, 0, 0); } } }
#endif
        pg8::EpiMerge E{PROJ + PC_G, NP, XB, D, M / 256, D / 256};
        pg8::gemm_phase<pg8::EpiMerge, pg8::PairedOrder, ALIGN_P5, true>(F.lds + RING_OFF, g, S, E);
        SUBSTAMP(1)
        if (SEAM56 && F.G == 256) {
            pg8::Unit u0; if (S.next(0, u0) && F.tid == 0) __hip_atomic_fetch_add(F.ctl + CW_P56 + 64 * u0.pm, 1u, RLX_AGENT); }
}
__device__ __forceinline__ void run_phase6(Frame& F0) {
    Frame F = F0; asm volatile("" : "+v"(F.tid)); F.lane = F.tid & 63;
    unsigned char* ws = F.ws; bf16* XB = (bf16*)(ws + WS_XB); bf16* Y = (bf16*)(ws + WS_Y); bf16* PROJ = (bf16*)(ws + WS_PROJ); (void)XB; (void)Y; (void)PROJ;
        pg8::Gemm g{XB, (const bf16*)(ws + WS_WOUT), M, D, D}; pg8::StaticOrder S; S.init(M, D, F.G, (int)blockIdx.x);
        {
            pg8::Unit u0; if (P6_TOUCH_X && S.next(0, u0)) { const float* xt = FIN(0) + (size_t)u0.pm * 256 * D + u0.pn * 256;
#pragma unroll
                for (int i = 0; i < 4; ++i) { const int line = (F.wave * 4 + i) * 64 + F.lane;
                    __builtin_amdgcn_global_load_lds((const unsigned*)(xt + (size_t)(line >> 3) * D + (line & 7) * 32), (LAS unsigned*)(F.lds + LDSCTL_OFF + 1024 + F.wave * 256), 4, 0, 0); } } }
#if P6_TOUCH_AB
        {
            pg8::Unit u0; if (S.next(0, u0)) {
                const char* bt = (const char*)(ws + WS_WOUT) + (size_t)u0.pn * 256 * D * 2; const char* at = (const char*)XB + (size_t)u0.pm * 256 * D * 2;
#pragma unroll
                for (int i = 0; i < 8; ++i) { const int line = i * 512 + F.tid;
                    __builtin_amdgcn_global_load_lds((const unsigned*)(bt + (size_t)line * 128), (LAS unsigned*)(F.lds + LDSCTL_OFF + 1024 + F.wave * 256), 4, 0, 0); }
#if P6_TOUCH_AB > 1
#pragma unroll
                for (int i = 0; i < 8; ++i) { const int line = i * 512 + F.tid;
                    __builtin_amdgcn_global_load_lds((const unsigned*)(at + (size_t)line * 128), (LAS unsigned*)(F.lds + LDSCTL_OFF + 1024 + F.wave * 256), 4, 0, 0); }
#endif
            } }
#endif
        if (SEAM56 && F.G == 256) {
            pg8::Unit u0;
            if (S.next(0, u0) && F.wave == 0) {
                for (unsigned sp = 0; sp < (1u << 18); ++sp) {
                    bool ok = (unsigned)__builtin_amdgcn_readfirstlane((int)__hip_atomic_load(F.ctl + CW_P56 + 64 * u0.pm, RLX_AGENT)) >= 4u;
                    if (SEAM35 && ok) { unsigned tot = 0u;
                        for (int q = 0; q < 8; ++q) tot += (unsigned)__builtin_amdgcn_readfirstlane((int)__hip_atomic_load(F.ctl + CW_SWADONE + 64 * q, RLX_AGENT));
                        ok = tot >= (unsigned)(BATCH * SW_H * (SEQ / 32)); }
                    if (ok) break;
                    __builtin_amdgcn_s_sleep(2); }
                __builtin_amdgcn_fence(__ATOMIC_ACQUIRE, "agent"); asm volatile("s_waitcnt vmcnt(0)" ::: "memory"); }
            __syncthreads(); }
        pg8::EpiX1 E{FIN(0), F.out, Y, (float*)(ws + WS_SSQ2), D};
        pg8::gemm_phase<pg8::EpiX1, pg8::StaticOrder, ALIGN_P6, true>(F.lds + RING_OFF, g, S, E);
        if (SEAM67 && F.G == 256) { pg8::Unit u0; if (S.next(0, u0) && F.tid == 0) __hip_atomic_fetch_add(F.ctl + CW_PAN + 64 * u0.pm + 3, 1u, RLX_AGENT); }
        SUBSTAMP(2)
}
__device__ __forceinline__ void run_phase7(Frame& F0) {
    Frame F = F0; asm volatile("" : "+v"(F.tid)); F.lane = F.tid & 63;
    unsigned char* ws = F.ws; bf16* XB = (bf16*)(ws + WS_XB); bf16* Y = (bf16*)(ws + WS_Y); bf16* PROJ = (bf16*)(ws + WS_PROJ); (void)XB; (void)Y; (void)PROJ;
        pg8::Gemm g{Y, (const bf16*)(ws + WS_WGU), M, 2 * FF, D};
        pg8::EpiSwiGLU E{PROJ, FF, (const float*)(ws + WS_SSQ2), EPS};
#if SEAM67
        if (F.G == 256) {
            pg8::SkewOrder S; S.init(M, 2 * FF, F.G, (int)blockIdx.x); S.pan = (const unsigned*)(F.ctl + CW_PAN); S.p56 = (const unsigned*)(F.ctl + CW_P56); S.act_row_bytes = FF * 2; S.proj_row_bytes = NP * 2;
            pg8::Unit u0;
            if (S.next(0, u0) && F.wave == 0) {
                const int fm = u0.pm & ~7;
                for (unsigned sp = 0; sp < (1u << 18); ++sp) {
                    unsigned wc_ = 0u;
                    for (int q = 0; q < 8; ++q) wc_ += (unsigned)__builtin_amdgcn_readfirstlane((int)__hip_atomic_load(F.ctl + CW_WCOPY + 64 * q, RLX_AGENT));
                    bool ok = wc_ >= 224u * NWAVES;
                    for (int q = 0; q < 8; ++q) ok = ok && S.panel_ready(fm + q);
                    if (ok) break;
                    __builtin_amdgcn_s_sleep(4); }
                __builtin_amdgcn_fence(__ATOMIC_ACQUIRE, "agent"); asm volatile("s_waitcnt vmcnt(0)" ::: "memory"); }
            __syncthreads();
            pg8::gemm_phase<pg8::EpiSwiGLU, pg8::SkewOrder, ALIGN_P7, true>(F.lds + RING_OFF, g, S, E);
            if (SEAM78 && F.tid == 0) {
                pg8::Unit u_; for (int i_ = 0; S.next(i_, u_); ++i_) __hip_atomic_fetch_add(F.ctl + CW_PAN + 64 * u_.pm + 4, 1u, RLX_AGENT); }
            SUBSTAMP(0)
            return;
        }
#endif
#if TAIL_SPLIT
        pg8::TailSplitOrder S; S.init(M, 2 * FF, F.G, (int)blockIdx.x);
#else
        pg8::StaticOrder S; S.init(M, 2 * FF, F.G, (int)blockIdx.x);
#endif
#if TAIL_SPLIT
        pg8::gemm_phase<pg8::EpiSwiGLU, pg8::TailSplitOrder, ALIGN_P7, true, true>(F.lds + RING_OFF, g, S, E);
#else
        pg8::gemm_phase<pg8::EpiSwiGLU, pg8::StaticOrder, ALIGN_P7, SP2_P7>(F.lds + RING_OFF, g, S, E);
#endif
}
__device__ __forceinline__ void run_phase8(Frame& F0) {
    Frame F = F0; asm volatile("" : "+v"(F.tid)); F.lane = F.tid & 63;
    unsigned char* ws = F.ws; bf16* XB = (bf16*)(ws + WS_XB); bf16* Y = (bf16*)(ws + WS_Y); bf16* PROJ = (bf16*)(ws + WS_PROJ); (void)XB; (void)Y; (void)PROJ;
        pg8::Gemm g{PROJ, (const bf16*)(ws + WS_WD), M, D, FF}; pg8::StaticOrder S; S.init(M, D, F.G, (int)blockIdx.x);
        if (SEAM78 && SEAM67 && F.G == 256) {
            pg8::Unit u0;
            if (S.next(0, u0) && F.wave == 0) {
                for (unsigned sp = 0; sp < (1u << 18); ++sp) {
                    bool ok = (unsigned)__builtin_amdgcn_readfirstlane((int)__hip_atomic_load(F.ctl + CW_PAN + 64 * u0.pm + 4, RLX_AGENT)) >= 22u;
                    if (ok) { unsigned tot = 0u;
                        for (int q = 0; q < 8; ++q) tot += (unsigned)__builtin_amdgcn_readfirstlane((int)__hip_atomic_load(F.ctl + CW_NORMDONE + 64 * q, RLX_AGENT));
                        ok = tot >= 4096u; }
                    if (ok) break;
                    __builtin_amdgcn_s_sleep(4); }
                __builtin_amdgcn_fence(__ATOMIC_ACQUIRE, "agent"); asm volatile("s_waitcnt vmcnt(0)" ::: "memory"); }
            __syncthreads(); }
        pg8::EpiOut E{F.out, D, Y};
        pg8::gemm_phase<pg8::EpiOut, pg8::StaticOrder, ALIGN_P8, true>(F.lds + RING_OFF, g, S, E);
}
#ifndef PROGRAM
#define PROGRAM RUN(0) BAR RUN(1) BAR RUN(2) BAR RUN(3) if (!(SEAM35 && F.G == 256)) { BAR } RUN(5) if (!(SEAM56 && F.G == 256)) { BAR } RUN(6) if (!(SEAM67 && F.G == 256)) { BAR } RUN(7) if (!(SEAM78 && SEAM67 && F.G == 256)) { BAR } RUN(8)
#endif
__global__ void __launch_bounds__(NWAVES * 64, 2) fwd_kernel(Args args) {
    extern __shared__ __attribute__((aligned(16))) unsigned char lds[];
    Frame F;
    F.lds = (LAS unsigned char*)lds;
    F.MISC = (volatile LAS unsigned*)(F.lds + MISC_OFF);
    F.tid = threadIdx.x; F.lane = F.tid & 63; F.wave = __builtin_amdgcn_readfirstlane(F.tid >> 6);
    F.G = gridDim.x; { const int bx = blockIdx.x; F.vcu = (F.G % 8 == 0) ? (bx % 8) * (F.G / 8) + bx / 8 : bx; }
    F.ka = (KArgs)__builtin_amdgcn_kernarg_segment_ptr();
    F.out = args.out; F.ws = args.ws; unsigned char* ws = args.ws;
    F.ctl = (gu32*)(ws + WS_CTL);
    for (int u = F.tid; u < (LDS_BYTES - LDSCTL_OFF) / 4; u += NWAVES * 64) ((LAS unsigned*)(F.lds + LDSCTL_OFF))[u] = 0u;
    __syncthreads();
    XcdBarrier bar; bar.bar = (unsigned*)(F.ctl + CW_BAR) + args.li * XCD_BAR_WORDS; bar.x = 0; bar.st = nullptr;
    bar = xcd_barrier_post((unsigned*)(F.ctl + CW_BAR) + args.li * XCD_BAR_WORDS, F.MISC + 8);
#if STAMP_PHASE >= 0
#if STAMP_SUB >= 0 || STAMP_DN >= 0
#define STAMP_()
#else
    int ns_ = 0;
#define STAMP_() { if (ns_ == STAMP_PHASE || ns_ == STAMP_PHASE + 1) { unsigned long long t_; asm volatile("s_memrealtime %0\n\ts_waitcnt lgkmcnt(0)" : "=s"(t_) :: "memory"); g_ts[ns_ - STAMP_PHASE] = t_; } ++ns_; }
#endif
#define RUN(k) run_phase##k(F);
#define BAR xcd_barrier(bar); STAMP_()
    STAMP_()
    PROGRAM
    BAR
#if STAMP_WS
    if (blockIdx.x == 0 && F.tid == 0) F.out[0] += (float)args.ws_mib;
#elif STAMP_DN >= 0
    if (blockIdx.x == STAMP_BLOCK && F.tid == 0) F.out[0] += (float)(g_dn[STAMP_DN]) * 0.01f;
#elif STAMP_SUB >= 0
    if (blockIdx.x == STAMP_BLOCK && F.tid == 0) F.out[0] += floorf((float)(g_sub[STAMP_SUBB] - g_sub[STAMP_SUB]) * 0.01f / STAMP_Q + 0.5f) * STAMP_Q - STAMP_OFF;
#else
    if (blockIdx.x == 0 && F.tid == 0) F.out[0] += floorf((float)(g_ts[1] - g_ts[0]) * 0.01f / STAMP_Q + 0.5f) * STAMP_Q - STAMP_OFF;
#endif
#undef RUN
#undef BAR
#else
#define RUN(k) run_phase##k(F);
#define BAR xcd_barrier(bar);
    PROGRAM
#if STAMP_WS
    BAR
    if (blockIdx.x == 0 && F.tid == 0) F.out[0] += (float)args.ws_mib;
#endif
#undef RUN
#undef BAR
#endif
}

extern "C" void kernel_launch(void* const* d_in, const int* in_sizes, int n_in, void* d_out, int out_size, void* d_ws, size_t ws_size, hipStream_t stream) {
    static int grid = 0;
    if (grid == 0) {
        if (n_in != 18 || in_sizes[0] != M * D || out_size != M * D || ws_size < WS_END) { fprintf(stderr, "kernel_launch: unexpected shapes (n_in %d, in0 %d, out %d, ws %zu)\n", n_in, n_in > 0 ? in_sizes[0] : -1, out_size, ws_size); grid = -1; return; }
        int dev = 0, cus = 0;
        if (hipGetDevice(&dev) != hipSuccess || hipDeviceGetAttribute(&cus, hipDeviceAttributeMultiprocessorCount, dev) != hipSuccess) { grid = -1; return; }
        if (hipFuncSetAttribute((const void*)fwd_kernel, hipFuncAttributeMaxDynamicSharedMemorySize, LDS_BYTES) != hipSuccess) { fprintf(stderr, "kernel_launch: hipFuncSetAttribute failed\n"); grid = -1; return; }
        int per_cu = 0;
        if (hipOccupancyMaxActiveBlocksPerMultiprocessor(&per_cu, (const void*)fwd_kernel, NWAVES * 64, LDS_BYTES) != hipSuccess || per_cu < 1) fprintf(stderr, "kernel_launch: occupancy query reports %d\n", per_cu);
        (void)hipGetLastError();
        grid = cus;
    }
    if (grid < 0) return;
    if (hipMemsetAsync((char*)d_ws + WS_CTL, 0, CTL_ZERO_BYTES, stream) != hipSuccess) return;
    Args a{};
    for (int i = 0; i < 18; ++i) a.in[i] = (const float*)d_in[i];
    a.out = (float*)d_out; a.ws = (unsigned char*)d_ws; a.ws_mib = (int)(ws_size >> 20);
    for (int li = 0; li < 1; ++li) {
        a.ph_lo = 0; a.ph_hi = 0;
        a.li = li;
        hipLaunchKernelGGL(fwd_kernel, dim3(grid), dim3(NWAVES * 64), LDS_BYTES, stream, a);
        const hipError_t le = hipPeekAtLastError();
        if (le != hipSuccess) { fprintf(stderr, "kernel_launch: launch %d failed: %s\n", li, hipGetErrorName(le)); break; }
    }
}
```

```cpp
#ifndef FAST_SWA
#define FAST_SWA 1
#endif
#ifndef FAST_DN
#define FAST_DN 1
#endif
#ifndef REP_DNA
#define REP_DNA 1
#endif
#ifndef REP_SWAPRE
#define REP_SWAPRE 1
#endif
#ifndef REP_S1
#define REP_S1 1
#endif
#ifndef REP_S2
#define REP_S2 1
#endif
#ifndef REP_S3A
#define REP_S3A 1
#endif
#ifndef REP_S3B
#define REP_S3B 1
#endif
#ifndef REP_S4
#define REP_S4 1
#endif
#ifndef S1_RELOAD
#define S1_RELOAD 0
#endif
#ifndef S1_OPAQUE
#define S1_OPAQUE 0
#endif
#ifndef P1_TILES
#define P1_TILES 12
#endif
#ifndef STAMP_PHASE
#define STAMP_PHASE -1
#endif
#ifndef STAMP_SUB
#define STAMP_SUB -1
#endif
#ifndef STAMP_BLOCK
#define STAMP_BLOCK 0
#endif
#ifndef STAMP_DN
#define STAMP_DN -1
#endif
#ifndef STAMP_WS
#define STAMP_WS 0
#endif
#ifndef P3_SKIP_SCAN
#define P3_SKIP_SCAN 0
#endif
#ifndef P3_SKIP_GEMM
#define P3_SKIP_GEMM 0
#endif
#ifndef SCAN_HOT
#define SCAN_HOT 0
#endif
#ifndef STAMP_Q
#define STAMP_Q 8.0f
#endif
#ifndef SCAN_AHEAD
#define SCAN_AHEAD 6
#endif
#ifndef SCAN_TOUCH_EN
#define SCAN_TOUCH_EN 0
#endif
#ifndef DEFER_WEIGHTS
#define DEFER_WEIGHTS 1
#endif
#ifndef P3_ONLY_SCAN
#define P3_ONLY_SCAN 0
#endif
#ifndef ALIGN_P7
#define ALIGN_P7 true
#endif
#ifndef ALIGN_P1
#define ALIGN_P1 true
#endif
#ifndef ALIGN_P5
#define ALIGN_P5 true
#endif
#ifndef ALIGN_P6
#define ALIGN_P6 true
#endif
#ifndef ALIGN_P8
#define ALIGN_P8 true
#endif
#ifndef SP2_P7
#define SP2_P7 true
#endif
#ifndef P3_ORDER
#define P3_ORDER 0
#endif
#ifndef SCAN_SETS
#define SCAN_SETS 4
#endif
#ifndef DNA_PREFETCH
#define DNA_PREFETCH 0
#endif
#ifndef SCAN_NT
#define SCAN_NT 0
#endif
#ifndef FUSE_QKNORM
#define FUSE_QKNORM 1
#endif
#ifndef STAMP_SUBB
#define STAMP_SUBB (STAMP_SUB + 1)
#endif
#ifndef SCAN_UPRE
#define SCAN_UPRE 2
#endif
#ifndef SCAN_PUBLISH
#define SCAN_PUBLISH 1
#endif
#ifndef SCAN_DRAIN_CNT
#define SCAN_DRAIN_CNT 0
#endif
#ifndef SCAN_O_SC1
#define SCAN_O_SC1 1
#endif
#ifndef SCAN_REFILL_LATE
#define SCAN_REFILL_LATE 1
#endif
#ifndef SCAN_O16
#define SCAN_O16 1
#endif
#ifndef STAMP_OFF
#define STAMP_OFF 0.0f
#endif
#ifndef DNO_SLEEP
#define DNO_SLEEP 8
#endif
#ifndef DNO_SKIPWORK
#define DNO_SKIPWORK 0
#endif
#ifndef DNO_SKIPALL
#define DNO_SKIPALL 0
#endif
#ifndef SCAN_PUB_LOADER
#define SCAN_PUB_LOADER 1
#endif
#ifndef SCAN_PUB_EVERY
#define SCAN_PUB_EVERY 1
#endif
#ifndef DNO_FENCE
#define DNO_FENCE 0
#endif
#ifndef SCAN_DRAIN_NONE
#define SCAN_DRAIN_NONE 0
#endif
#ifndef DNO_LAG
#define DNO_LAG 0
#endif
#ifndef EPI_WT
#define EPI_WT 0
#endif
#ifndef TAIL_SPLIT
#define TAIL_SPLIT 0
#endif
#ifndef GEMM_SAMETILE
#define GEMM_SAMETILE 0
#endif
#ifndef STAMP_EPI
#define STAMP_EPI 0
#endif
#ifndef SEAM56
#define SEAM56 1
#endif
#ifndef SCAN_QG_EARLY
#define SCAN_QG_EARLY 0
#endif
#ifndef BAR_EARLY_WB
#define BAR_EARLY_WB 0
#endif
#ifndef P0_DEEP
#define P0_DEEP 0
#endif
#ifndef DNO_STAGE
#define DNO_STAGE 1
#endif
#ifndef SEAM35
#define SEAM35 1
#endif
#ifndef P6_TOUCH_AB
#define P6_TOUCH_AB 0
#endif
#ifndef P5_TOUCH_G
#define P5_TOUCH_G 0
#endif
#ifndef P6_TOUCH_X
#define P6_TOUCH_X 0
#endif
#ifndef SEAM67
#define SEAM67 1
#endif
#ifndef SKEW_TAIL
#define SKEW_TAIL 1
#endif
#ifndef SEAM78
#define SEAM78 1
#endif
#ifndef ASYM_WCOPY
#define ASYM_WCOPY 1
#endif
#ifndef ASYM_DNO
#define ASYM_DNO 1
#endif
#ifndef SKEW_CHK_ALL
#define SKEW_CHK_ALL 1
#endif
#include <hip/hip_runtime.h>
#include <cstdio>
#include <cstdint>

#ifndef WGM_KNOB
#define WGM_KNOB 8
#endif
#ifndef EPI_REP
#define EPI_REP 1
#endif
#ifndef EPI_REP_WHICH
#define EPI_REP_WHICH 0
#endif
#ifndef RES_F32
#define RES_F32 0
#endif
#if STAMP_SUB >= 0
__device__ unsigned long long g_sub[8];
#define SUBSTAMP(i) if (blockIdx.x == STAMP_BLOCK && threadIdx.x == 0) g_sub[i] = __builtin_amdgcn_s_memrealtime();
#else
#define SUBSTAMP(i)
#endif
namespace pg8 {
#define PG8_LAS __attribute__((address_space(3)))
typedef unsigned short bf16_t;
typedef short bf16x8 __attribute__((ext_vector_type(8)));
typedef float f32x4 __attribute__((ext_vector_type(4)));
typedef unsigned u32x4 __attribute__((ext_vector_type(4)));
typedef unsigned u32x2 __attribute__((ext_vector_type(2)));
constexpr int BM = 256, BK = 64, HALF = 128, HTB = HALF * BK * 2  , STAGE_BYTES = 8 * HTB, NXCD = 8, WGM = WGM_KNOB;

__host__ __device__ __forceinline__ int lds_byte(int r, int c) { const int st = (r >> 4) * 2 + (c >> 5), rr = r & 15, cc = c & 31, ob = rr * 64 + cc * 2; return st * 1024 + (ob ^ (((ob >> 9) & 1) << 5)); }
__host__ __device__ __forceinline__ void stage_rc(int b, int& R, int& C) { const int st = b / 1024, sb = b % 1024, swz = sb ^ (((sb >> 9) & 1) << 5); R = (st >> 1) * 16 + swz / 64; C = (st & 1) * 32 + (swz % 64) / 2; }
__host__ __device__ __forceinline__ int perm32(int rho) { const int n = rho >> 4, i = rho & 15; return 8 * (i >> 2) + 4 * n + (i & 3); }

struct Unit { int pm, pn, hm, chk; };
struct Gemm { const bf16_t* A; const bf16_t* Bt; int M, N, K; int lda = 0, nMA = 1 << 30, a2off = 0; };

struct StaticOrder {
    int nM, nN, nwg, G, c;
    __host__ __device__ void init(int M, int N, int G_, int c_) { nM = M / BM; nN = N / BM; nwg = nM * nN; G = G_; c = c_; }
    __host__ __device__ bool next(int i, Unit& u) const { return nextL((long)i * G + c, u); }
    __host__ __device__ bool nextL(long L, Unit& u) const {
        if (L >= nwg) return false;
        u.hm = 0; u.chk = 0;
        int wgid = (int)L; { const int q = nwg / NXCD, r = nwg % NXCD, xcd = wgid % NXCD, off = wgid / NXCD; wgid = (xcd < r ? xcd * (q + 1) : r * (q + 1) + (xcd - r) * q) + off; }
        const int nig = WGM * nN, gid = wgid / nig, fm = gid * WGM, gsz = (nM - fm) < WGM ? (nM - fm) : WGM;
        u.pm = fm + ((wgid % nig) % gsz); u.pn = (wgid % nig) / gsz; return true;
    }
    __device__ __forceinline__ void a_ready(const Unit&) const {}
    __device__ __forceinline__ void done(const Unit&) const {}
};
struct TailSplitOrder {
    StaticOrder so; int full, rem; bool split;
    __host__ __device__ void init(int M, int N, int G_, int c_) { so.init(M, N, G_, c_); full = so.nwg / G_; rem = so.nwg - full * G_; split = TAIL_SPLIT && rem > 0 && 2 * rem <= G_; }
    __host__ __device__ bool next(int i, Unit& u) const {
        if (i < full || !split) return so.next(i, u);
        if (i > full || so.c >= 2 * rem) return false;
        if (!so.nextL((long)full * so.G + (so.c >> 1), u)) return false;
        u.hm = 1 + (so.c & 1); return true;
    }
    __device__ __forceinline__ void a_ready(const Unit&) const {}
    __device__ __forceinline__ void done(const Unit&) const {}
};
struct SkewOrder {
    StaticOrder so; const unsigned* pan; const unsigned* p56; int act_row_bytes, proj_row_bytes;
    __host__ __device__ void init(int M, int N, int G_, int c_) { so.init(M, N, G_, c_); }
    __host__ __device__ bool next(int i, Unit& u) const {
        const int full = so.nwg / so.G;
        if (i < full || !SKEW_TAIL) return so.next(i, u);
        if (i > full) return false;
        const int x = so.c & 7, off = so.c >> 3; if (x & 1) return false;
        if (!so.nextL((long)full * so.G + 8 * (off >> 1) + x + (off & 1), u)) return false;
        u.chk = SKEW_CHK_ALL ? 1 : (off & 1); return true;
    }
    __device__ __forceinline__ bool panel_ready(int pm) const {
        bool ok = (unsigned)__builtin_amdgcn_readfirstlane((int)__hip_atomic_load(pan + 64 * pm + 3, __ATOMIC_RELAXED, __HIP_MEMORY_SCOPE_AGENT)) >= 4u;
        const int lo = (pm * act_row_bytes) / proj_row_bytes, hi = ((pm + 1) * act_row_bytes - 1) / proj_row_bytes;
        for (int q = lo; q <= hi; ++q) ok = ok && (unsigned)__builtin_amdgcn_readfirstlane((int)__hip_atomic_load(p56 + 64 * q, __ATOMIC_RELAXED, __HIP_MEMORY_SCOPE_AGENT)) >= 4u;
        return ok;
    }
    __device__ __forceinline__ void a_ready(const Unit& u) const {
        if (u.chk) {
            if (threadIdx.x < 64) {
                for (unsigned sp = 0; !panel_ready(u.pm) && sp < (1u << 18); ++sp) __builtin_amdgcn_s_sleep(2);
                __builtin_amdgcn_fence(__ATOMIC_ACQUIRE, "agent"); asm volatile("s_waitcnt vmcnt(0)" ::: "memory"); }
            asm volatile("" ::: "memory"); __builtin_amdgcn_s_barrier(); asm volatile("" ::: "memory");
        }
    }
    __device__ __forceinline__ void done(const Unit&) const {}
};
struct PairedOrder {
    StaticOrder so;
    __host__ __device__ void init(int M, int N, int G_, int c_) { so.init(M, N, G_, c_); }
    __host__ __device__ bool next(int i, Unit& u) const { if (!so.next(i >> 1, u)) return false; if (i & 1) { u.pm += so.nM; u.pn += so.nN; } return true; }
    __device__ __forceinline__ void a_ready(const Unit&) const {}
    __device__ __forceinline__ void done(const Unit&) const {}
};

__device__ __forceinline__ unsigned cvt_pk_bf16(float lo, float hi) { unsigned r; asm volatile("v_cvt_pk_bf16_f32 %0, %1, %2" : "=v"(r) : "v"(lo), "v"(hi)); return r; }
__device__ __forceinline__ float bf_lo(unsigned w) { return __builtin_bit_cast(float, w << 16); }
__device__ __forceinline__ float bf_hi(unsigned w) { return __builtin_bit_cast(float, w & 0xffff0000u); }
__device__ __forceinline__ float sigmoidf_(float x) { return 1.0f / (1.0f + __expf(-x)); }
template <class V> __device__ __forceinline__ void st16wt(void* p, V v) {
    asm volatile("global_store_dwordx4 %0, %1, off sc1\n\ts_nop 1" :: "v"((__attribute__((address_space(1))) V*)p), "v"(v) : "memory");
}
template <class V> __device__ __forceinline__ void st16(void* p, V v) {
#if EPI_WT
    asm volatile("global_store_dwordx4 %0, %1, off sc1\n\ts_nop 1" :: "v"((__attribute__((address_space(1))) V*)p), "v"(v) : "memory");
#else
    *(V*)p = v;
#endif
}


struct EpiProj {
    static constexpr bool SUBST = false, PERM = true, AFTER_DRAIN = false, PROBE_REP = (EPI_REP_WHICH == 1);
    bf16_t* O; int ldc; const float* rstd; int gate_pn0, pn_off;
    bf16_t* QS; bf16_t* KS; const float* qg; const float* kg; int q_pn0, k_pn;
    float qscale; int seq; int wt = 0;
    __device__ __forceinline__ bool keep(const Unit&) const { return false; }
    __device__ __forceinline__ void operator()(f32x4 (&acc)[2][2][4][2], const Unit& u, int wr, int wc, int fr, int fq) const {
        const int pna = u.pn + pn_off;
        const int row0 = u.pm * BM + wr * 64 + fr, col0 = pna * BM + wc * 64 + 8 * fq; const bool gate = pna >= gate_pn0;
        float sr[2][4];
#pragma unroll
        for (int ai = 0; ai < 2; ++ai)
#pragma unroll
            for (int m = 0; m < 4; ++m) sr[ai][m] = rstd[row0 + ai * HALF + m * 16];
        const bool isq = QS != nullptr && (pna == q_pn0 || pna == q_pn0 + 1), isk = QS != nullptr && pna == k_pn && wc < 2;
        if (isq || isk) {
            f32x4 gn[2][2];
#pragma unroll
            for (int bj = 0; bj < 2; ++bj)
#pragma unroll
                for (int n = 0; n < 2; ++n) { const int d = 32 * bj + 8 * fq + 4 * n; gn[bj][n] = isq ? *(const f32x4*)(qg + d) * qscale : *(const f32x4*)(kg + d); }
#pragma unroll
            for (int ai = 0; ai < 2; ++ai)
#pragma unroll
                for (int m = 0; m < 4; ++m) { const int row = row0 + ai * HALF + m * 16; const float s = sr[ai][m];
                    float ss = 0.f;
#pragma unroll
                    for (int bj = 0; bj < 2; ++bj)
#pragma unroll
                        for (int n = 0; n < 2; ++n) { const f32x4 v = acc[ai][bj][m][n] * s; ss += (v[0] * v[0] + v[1] * v[1]) + (v[2] * v[2] + v[3] * v[3]); }
                    ss += __shfl_xor(ss, 16); ss += __shfl_xor(ss, 32);
                    const float r = s * __builtin_amdgcn_rsqf(ss * (1.0f / 64.0f) + 1e-6f);
                    bf16_t* dst = isq ? QS + (size_t)row * 512 + (pna - q_pn0) * 256 + wc * 64 + 8 * fq
                                      : KS + ((size_t)((row / seq) * 2 + wc) * seq + (row % seq)) * 64 + 8 * fq;
#pragma unroll
                    for (int bj = 0; bj < 2; ++bj) { const f32x4 v0 = acc[ai][bj][m][0] * r * gn[bj][0], v1 = acc[ai][bj][m][1] * r * gn[bj][1];
                        u32x4 w; w.x = cvt_pk_bf16(v0[0], v0[1]); w.y = cvt_pk_bf16(v0[2], v0[3]); w.z = cvt_pk_bf16(v1[0], v1[1]); w.w = cvt_pk_bf16(v1[2], v1[3]);
                        st16(dst + bj * 32, w); } }
            return;
        }
#pragma unroll
        for (int ai = 0; ai < 2; ++ai)
#pragma unroll
            for (int m = 0; m < 4; ++m) { const int row = row0 + ai * HALF + m * 16; const float s = sr[ai][m]; bf16_t* rowp = O + (size_t)row * ldc + col0;
#pragma unroll
                for (int bj = 0; bj < 2; ++bj) { f32x4 v0 = acc[ai][bj][m][0] * s, v1 = acc[ai][bj][m][1] * s;
                    if (gate) {
#pragma unroll
                        for (int j = 0; j < 4; ++j) { v0[j] = __builtin_amdgcn_rcpf(1.0f + __expf(-v0[j])); v1[j] = __builtin_amdgcn_rcpf(1.0f + __expf(-v1[j])); } }
                    u32x4 w; w.x = cvt_pk_bf16(v0[0], v0[1]); w.y = cvt_pk_bf16(v0[2], v0[3]); w.z = cvt_pk_bf16(v1[0], v1[1]); w.w = cvt_pk_bf16(v1[2], v1[3]);
                    if (wt) st16wt(rowp + bj * 32, w); else st16(rowp + bj * 32, w); } }
    }
};
struct EpiMerge {
    static constexpr bool SUBST = false, PERM = true, AFTER_DRAIN = false, PROBE_REP = false;
    const bf16_t* G; int ldg; bf16_t* O; int ldc; int nM, nN;
    __device__ __forceinline__ bool keep(const Unit& u) const { return u.pm < nM; }
    __device__ __forceinline__ void operator()(f32x4 (&acc)[2][2][4][2], const Unit& u, int wr, int wc, int fr, int fq) const {
        const bool second = u.pm >= nM; const int pm = second ? u.pm - nM : u.pm, pn = second ? u.pn - nN : u.pn;
        const int row0 = pm * BM + wr * 64 + fr, col0 = pn * BM + wc * 64 + 8 * fq;
#pragma unroll
        for (int ai = 0; ai < 2; ++ai) {
            u32x4 gA[4][2], gB[4][2];
#pragma unroll
            for (int m = 0; m < 4; ++m)
#pragma unroll
                for (int bj = 0; bj < 2; ++bj) { const size_t o = (size_t)(row0 + ai * HALF + m * 16) * ldg + col0 + bj * 32; if (!second) gA[m][bj] = *(const u32x4*)(G + o); gB[m][bj] = *(const u32x4*)(G + o + 1024); }
#pragma unroll
            for (int m = 0; m < 4; ++m) { const int row = row0 + ai * HALF + m * 16;
#pragma unroll
                for (int bj = 0; bj < 2; ++bj) { const int col = col0 + bj * 32;
                    float sb[8];
#pragma unroll
                    for (int j = 0; j < 4; ++j) { sb[2 * j] = bf_lo(gB[m][bj][j]); sb[2 * j + 1] = bf_hi(gB[m][bj][j]); }
                    if (!second) {
                        float sa[8];
#pragma unroll
                        for (int j = 0; j < 4; ++j) { sa[2 * j] = bf_lo(gA[m][bj][j]); sa[2 * j + 1] = bf_hi(gA[m][bj][j]); }
#pragma unroll
                        for (int j = 0; j < 4; ++j) { acc[ai][bj][m][0][j] *= sa[j] * __builtin_amdgcn_rcpf(sb[j]); acc[ai][bj][m][1][j] *= sa[4 + j] * __builtin_amdgcn_rcpf(sb[4 + j]); }
                    } else {
                        f32x4 v0, v1;
#pragma unroll
                        for (int j = 0; j < 4; ++j) { v0[j] = acc[ai][bj][m][0][j] * sb[j]; v1[j] = acc[ai][bj][m][1][j] * sb[4 + j]; }
                        u32x4 w; w.x = cvt_pk_bf16(v0[0], v0[1]); w.y = cvt_pk_bf16(v0[2], v0[3]); w.z = cvt_pk_bf16(v1[0], v1[1]); w.w = cvt_pk_bf16(v1[2], v1[3]);
                        if (SEAM56) st16wt(O + (size_t)row * ldc + col, w); else st16(O + (size_t)row * ldc + col, w); } } }
            asm volatile("" ::: "memory"); }
    }
};
struct EpiX1 {
    static constexpr bool SUBST = (STAMP_EPI == 6), PERM = (SEAM67 != 0), AFTER_DRAIN = false, PROBE_REP = (EPI_REP_WHICH == 6);
    const float* X; float* out; bf16_t* xb; float* ssq; int ldc;
    __device__ __forceinline__ bool keep(const Unit&) const { return false; }
    __device__ __forceinline__ void operator()(f32x4 (&acc)[2][2][4][2], const Unit& u, int wr, int wc, int fr, int fq) const {
        const int row0 = u.pm * BM + wr * 64 + fr, col0 = u.pn * BM + wc * 32 + (PERM ? 8 : 4) * fq; constexpr int NOFF = PERM ? 4 : 16;
#pragma unroll
        for (int ai = 0; ai < 2; ++ai) {
            f32x4 xv[4][2][2];
#pragma unroll
            for (int m = 0; m < 4; ++m)
#pragma unroll
                for (int bj = 0; bj < 2; ++bj)
#pragma unroll
                    for (int n = 0; n < 2; ++n) xv[m][bj][n] = *(const f32x4*)(X + (size_t)(row0 + ai * HALF + m * 16) * ldc + col0 + bj * HALF + n * NOFF);
#pragma unroll
            for (int m = 0; m < 4; ++m) { const int row = row0 + ai * HALF + m * 16; const size_t off = (size_t)row * ldc + col0; float ss = 0.f;
#pragma unroll
                for (int bj = 0; bj < 2; ++bj) { u32x4 w4;
#pragma unroll
                    for (int n = 0; n < 2; ++n) { const f32x4 o = xv[m][bj][n] + acc[ai][bj][m][n];
                        if (RES_F32) *(f32x4*)(out + off + bj * HALF + n * NOFF) = o; ss += (o[0] * o[0] + o[1] * o[1]) + (o[2] * o[2] + o[3] * o[3]);
                        u32x2 w; w.x = cvt_pk_bf16(o[0], o[1]); w.y = cvt_pk_bf16(o[2], o[3]);
                        if (PERM) { if (n == 0) { w4.x = w.x; w4.y = w.y; } else { w4.z = w.x; w4.w = w.y; } }
                        else *(u32x2*)(xb + off + bj * HALF + n * 16) = w; }
                    if (PERM) st16wt(xb + off + bj * HALF, w4); }
                ss += __shfl_xor(ss, 16); ss += __shfl_xor(ss, 32);
                if (fq == 0) atomicAdd(ssq + row, ss); }
            asm volatile("" ::: "memory"); }
    }
};
struct EpiSwiGLU {
    static constexpr bool SUBST = false, PERM = true, AFTER_DRAIN = false, PROBE_REP = (EPI_REP_WHICH == 7);
    bf16_t* O; int ldc; const float* ssq; float eps;
    __device__ __forceinline__ bool keep(const Unit&) const { return false; }
    __device__ __forceinline__ void operator()(f32x4 (&acc)[2][2][4][2], const Unit& u, int wr, int wc, int fr, int fq) const {
        const int row0 = u.pm * BM + (u.hm == 2 ? HALF : 0) + wr * 64 + fr, col0 = u.pn * HALF + wc * 32 + 8 * fq;
        float sr[2][4];
#pragma unroll
        for (int ai = 0; ai < 2; ++ai)
#pragma unroll
            for (int m = 0; m < 4; ++m) sr[ai][m] = ssq[row0 + (u.hm ? 0 : ai * HALF) + m * 16];
#pragma unroll
        for (int ai = 0; ai < 2; ++ai)
#pragma unroll
            for (int m = 0; m < 4; ++m) { const int row = row0 + ai * HALF + m * 16;
                if (ai == 1 && u.hm) continue;
                const float s = __builtin_amdgcn_rsqf(sr[ai][m] * (1.0f / 1024.0f) + eps);
                float a[8];
#pragma unroll
                for (int n = 0; n < 2; ++n)
#pragma unroll
                    for (int j = 0; j < 4; ++j) { const float g = acc[ai][0][m][n][j] * s, up = acc[ai][1][m][n][j] * s; a[4 * n + j] = g * up * __builtin_amdgcn_rcpf(1.0f + __expf(-g)); }
                u32x4 w; w.x = cvt_pk_bf16(a[0], a[1]); w.y = cvt_pk_bf16(a[2], a[3]); w.z = cvt_pk_bf16(a[4], a[5]); w.w = cvt_pk_bf16(a[6], a[7]);
                if (SEAM78) st16wt(O + (size_t)row * ldc + col0, w); else st16(O + (size_t)row * ldc + col0, w); }
    }
};
struct EpiOut {
    static constexpr bool SUBST = (STAMP_EPI == 8), PERM = false, AFTER_DRAIN = false, PROBE_REP = false;
    float* out; int ldc; const bf16_t* xb;
    __device__ __forceinline__ bool keep(const Unit&) const { return false; }
    __device__ __forceinline__ void operator()(f32x4 (&acc)[2][2][4][2], const Unit& u, int wr, int wc, int fr, int fq) const {
        const int row0 = u.pm * BM + wr * 64 + fr, col0 = u.pn * BM + wc * 32 + 4 * fq;
#pragma unroll
        for (int ai = 0; ai < 2; ++ai) {
            u32x2 rb[4][2][2]; f32x4 rf[4][2][2];
#pragma unroll
            for (int m = 0; m < 4; ++m)
#pragma unroll
                for (int bj = 0; bj < 2; ++bj)
#pragma unroll
                    for (int n = 0; n < 2; ++n) { const size_t o = (size_t)(row0 + ai * HALF + m * 16) * ldc + col0 + bj * HALF + n * 16;
                        if (RES_F32) rf[m][bj][n] = *(const f32x4*)(out + o); else rb[m][bj][n] = *(const u32x2*)(xb + o); }
#pragma unroll
            for (int m = 0; m < 4; ++m) { const size_t off = (size_t)(row0 + ai * HALF + m * 16) * ldc + col0;
#pragma unroll
                for (int bj = 0; bj < 2; ++bj)
#pragma unroll
                    for (int n = 0; n < 2; ++n) { f32x4 b;
                        if (RES_F32) b = rf[m][bj][n]; else { const u32x2 w = rb[m][bj][n]; b = (f32x4){bf_lo(w.x), bf_hi(w.x), bf_lo(w.y), bf_hi(w.y)}; }
                        *(f32x4*)(out + off + bj * HALF + n * 16) = b + acc[ai][bj][m][n]; } }
            asm volatile("" ::: "memory"); }
    }
};

template <class Epi, class Sched, bool ALIGN_EPI = false, bool SP2 = false, bool HM = false>
__device__ __forceinline__ void gemm_phase(PG8_LAS unsigned char* lds, const Gemm g, const Sched& S, const Epi& E) {
    int tid_ = threadIdx.x; asm volatile("" : "+v"(tid_));
    const int tid = tid_, wid = __builtin_amdgcn_readfirstlane(tid >> 6), lane = tid & 63, wr = wid >> 2, wc = wid & 3, fr = lane & 15, fq = lane >> 4;
    const int K = g.K, nt = K / BK, LDA = g.lda ? g.lda : g.K;
    unsigned voffA[2], voffB[2];
#pragma unroll
    for (int i = 0; i < 2; ++i) { int R, C; stage_rc(tid * 16 + i * 8192, R, C); const int Rb = Epi::PERM ? ((R & ~31) + perm32(R & 31)) : R;
        voffA[i] = (unsigned)(R * LDA + C) * 2u; voffB[i] = (unsigned)(Rb * K + C) * 2u; }
    const size_t kstep = (size_t)(BK * 2);
    const size_t hstep = (size_t)HALF * K * 2;
    const size_t tstep = 2 * hstep;
    const size_t hstepA = (size_t)HALF * LDA * 2, tstepA = 2 * hstepA;
#define PG8_ABASE(pm_) ((const char*)g.A + (GEMM_SAMETILE ? (size_t)0 : ((pm_) < g.nMA ? (size_t)(pm_) * tstepA : (size_t)((pm_) - g.nMA) * tstepA + (size_t)g.a2off)))
    const unsigned ldsw = (unsigned)wid * 1024u;
    const int aoff = lds_byte(wr * 64 + fr, fq * 8), boff = lds_byte(wc * 32 + fr, fq * 8);
#define PG8_SA(b, h) (((b) * 2 + (h)) * HTB)
#define PG8_SB(b, h) ((4 + (b) * 2 + (h)) * HTB)
#define PG8_STAGE(bufoff, gbase, voff) do { _Pragma("unroll") for (int _i = 0; _i < 2; ++_i) \
        __builtin_amdgcn_global_load_lds((const unsigned*)((const char*)(gbase) + (voff)[_i]), (PG8_LAS unsigned*)(lds + (bufoff) + ldsw + _i * 8192), 16, 0, 0); } while (0)
#define PG8_LDA(dst, b, h) do { _Pragma("unroll") for (int m = 0; m < 4; ++m) _Pragma("unroll") for (int k = 0; k < 2; ++k) dst[m][k] = *(const PG8_LAS bf16x8*)(lds + PG8_SA(b, h) + aoff + m * 2048 + k * 1024); } while (0)
#define PG8_LDB(dst, b, h) do { _Pragma("unroll") for (int n = 0; n < 2; ++n) _Pragma("unroll") for (int k = 0; k < 2; ++k) dst[n][k] = *(const PG8_LAS bf16x8*)(lds + PG8_SB(b, h) + boff + n * 2048 + k * 1024); } while (0)
#define PG8_MMA(ai, bj, At, Bt) do { __builtin_amdgcn_s_setprio(1); _Pragma("unroll") for (int m = 0; m < 4; ++m) _Pragma("unroll") for (int n = 0; n < 2; ++n) _Pragma("unroll") for (int k = 0; k < 2; ++k) \
        acc[ai][bj][m][n] = __builtin_amdgcn_mfma_f32_16x16x32_bf16(Bt[n][k], At[m][k], acc[ai][bj][m][n], 0, 0, 0); __builtin_amdgcn_s_setprio(0); } while (0)
#define PG8_WAIT_V(n) asm volatile("s_waitcnt vmcnt(" #n ")" ::: "memory")
#define PG8_WAIT_L(n) asm volatile("s_waitcnt lgkmcnt(" #n ")" ::: "memory")
#define PG8_BAR __builtin_amdgcn_s_barrier()
#define PG8_SCHED __builtin_amdgcn_sched_barrier(0)
    Unit cur, nxt; int ui = 0;
    if (!S.next(0, cur)) return;
    f32x4 acc[2][2][4][2];
#pragma unroll
    for (int a = 0; a < 2; ++a)
#pragma unroll
        for (int b = 0; b < 2; ++b)
#pragma unroll
            for (int m = 0; m < 4; ++m)
#pragma unroll
                for (int n = 0; n < 2; ++n) acc[a][b][m][n] = (f32x4){0.f, 0.f, 0.f, 0.f};
    bf16x8 At[4][2], B0[2][2], B1[2][2];
    static_assert(!HM || SP2, "half units: SP2 schedule only");
    bool chalf = HM && cur.hm != 0; size_t cH = chalf ? 0 : hstepA;
    const char* cA = PG8_ABASE(cur.pm) + ((HM && cur.hm == 2) ? hstepA : 0); const char* cB = (const char*)g.Bt + (GEMM_SAMETILE ? (size_t)0 : (size_t)cur.pn * tstep);
    S.a_ready(cur);
    if constexpr (SP2) {
        PG8_STAGE(PG8_SB(0, 0), cB, voffB); PG8_STAGE(PG8_SB(0, 1), cB + hstep, voffB); PG8_STAGE(PG8_SA(0, 0), cA, voffA); PG8_STAGE(PG8_SA(0, 1), cA + cH, voffA);
        if (wr == 1) PG8_BAR;
        PG8_WAIT_V(2); PG8_BAR;
        PG8_STAGE(PG8_SB(1, 0), cB + kstep, voffB); PG8_STAGE(PG8_SA(1, 0), cA + kstep, voffA); PG8_STAGE(PG8_SB(1, 1), cB + hstep + kstep, voffB);
        PG8_WAIT_V(6); PG8_BAR;
    } else {
        PG8_STAGE(PG8_SB(0, 0), cB, voffB); PG8_STAGE(PG8_SA(0, 0), cA, voffA); PG8_STAGE(PG8_SB(0, 1), cB + hstep, voffB); PG8_STAGE(PG8_SA(0, 1), cA + cH, voffA);
        if (wr == 1) PG8_BAR;
        PG8_WAIT_V(4); PG8_BAR;
        PG8_STAGE(PG8_SB(1, 0), cB + kstep, voffB); PG8_STAGE(PG8_SA(1, 0), cA + kstep, voffA); PG8_STAGE(PG8_SB(1, 1), cB + hstep + kstep, voffB);
        PG8_WAIT_V(6); PG8_BAR;
    }
    for (;;) {
        const bool has_next = S.next(ui + 1, nxt);
        const bool nhalf = has_next ? (HM && nxt.hm != 0) : chalf; const size_t nH = nhalf ? 0 : hstepA;
        const char* nA = has_next ? PG8_ABASE(nxt.pm) + ((HM && nxt.hm == 2) ? hstepA : 0) : cA; const char* nB = has_next ? (const char*)g.Bt + (GEMM_SAMETILE ? (size_t)0 : (size_t)nxt.pn * tstep) : cB;
        for (int t = 0; t < nt; t += 2) {
            const bool last = (t == nt - 2);
            const char* a1 = cA + (size_t)(t + 1) * kstep;
            const char* a2 = last ? nA : cA + (size_t)(t + 2) * kstep; const char* b2 = last ? nB : cB + (size_t)(t + 2) * kstep;
            const char* a3 = a2 + kstep; const char* b3 = b2 + kstep;
            const size_t h2 = last ? nH : cH;
            if (last && has_next) S.a_ready(nxt);
            if constexpr (SP2) {
            PG8_LDB(B0, 0, 0); PG8_LDB(B1, 0, 1); PG8_SCHED; PG8_LDA(At, 0, 0); PG8_STAGE(PG8_SA(1, 1), a1 + cH, voffA);
            PG8_WAIT_V(8); PG8_WAIT_L(0); PG8_BAR; PG8_MMA(0, 0, At, B0); PG8_MMA(0, 1, At, B1); PG8_BAR; PG8_SCHED;
            if (!chalf) PG8_LDA(At, 0, 1); PG8_STAGE(PG8_SB(0, 0), b2, voffB); PG8_STAGE(PG8_SB(0, 1), b2 + hstep, voffB); PG8_STAGE(PG8_SA(0, 0), a2, voffA);
            PG8_WAIT_V(8); PG8_WAIT_L(0); PG8_BAR; if (!chalf) { PG8_MMA(1, 0, At, B0); PG8_MMA(1, 1, At, B1); } PG8_BAR; PG8_SCHED;
            PG8_LDB(B0, 1, 0); PG8_LDB(B1, 1, 1); PG8_SCHED; PG8_LDA(At, 1, 0); PG8_STAGE(PG8_SA(0, 1), a2 + h2, voffA);
            PG8_WAIT_V(8); PG8_WAIT_L(0); PG8_BAR; PG8_MMA(0, 0, At, B0); PG8_MMA(0, 1, At, B1); PG8_BAR; PG8_SCHED;
            if (!chalf) PG8_LDA(At, 1, 1); PG8_STAGE(PG8_SB(1, 0), b3, voffB); PG8_STAGE(PG8_SB(1, 1), b3 + hstep, voffB); PG8_STAGE(PG8_SA(1, 0), a3, voffA);
            PG8_WAIT_V(8); PG8_WAIT_L(0); PG8_BAR; if (!chalf) { PG8_MMA(1, 0, At, B0); PG8_MMA(1, 1, At, B1); } PG8_BAR; PG8_SCHED;
            } else {
            PG8_LDB(B0, 0, 0); PG8_SCHED; PG8_LDA(At, 0, 0); PG8_STAGE(PG8_SA(1, 1), a1 + cH, voffA);
            PG8_WAIT_L(8); PG8_BAR; PG8_WAIT_L(0); PG8_MMA(0, 0, At, B0); PG8_BAR; PG8_SCHED;
            PG8_LDB(B1, 0, 1); PG8_STAGE(PG8_SB(0, 0), b2, voffB);
            PG8_BAR; PG8_WAIT_L(0); PG8_MMA(0, 1, At, B1); PG8_BAR;
            PG8_LDA(At, 0, 1); PG8_STAGE(PG8_SA(0, 0), a2, voffA);
            PG8_BAR; PG8_WAIT_L(0); PG8_MMA(1, 0, At, B0); PG8_BAR; PG8_SCHED;
            PG8_STAGE(PG8_SB(0, 1), b2 + hstep, voffB);
            PG8_WAIT_V(6); PG8_BAR; PG8_MMA(1, 1, At, B1); PG8_BAR;
            PG8_LDB(B0, 1, 0); PG8_SCHED; PG8_LDA(At, 1, 0); PG8_STAGE(PG8_SA(0, 1), a2 + h2, voffA);
            PG8_WAIT_L(8); PG8_BAR; PG8_WAIT_L(0); PG8_MMA(0, 0, At, B0); PG8_BAR; PG8_SCHED;
            PG8_LDB(B1, 1, 1); PG8_STAGE(PG8_SB(1, 0), b3, voffB);
            PG8_BAR; PG8_WAIT_L(0); PG8_MMA(0, 1, At, B1); PG8_BAR;
            PG8_LDA(At, 1, 1); PG8_STAGE(PG8_SA(1, 0), a3, voffA);
            PG8_BAR; PG8_WAIT_L(0); PG8_MMA(1, 0, At, B0); PG8_BAR; PG8_SCHED;
            PG8_STAGE(PG8_SB(1, 1), b3 + hstep, voffB);
            PG8_WAIT_V(6); PG8_BAR; PG8_MMA(1, 1, At, B1); PG8_BAR;
            }
        }
        if (Epi::SUBST) { SUBSTAMP(5) }
        if constexpr (ALIGN_EPI) { if (wr == 0) PG8_BAR; }
        if constexpr (!Epi::AFTER_DRAIN) { for (int er_ = 0; er_ < (Epi::PROBE_REP ? EPI_REP : 1); ++er_) { E(acc, cur, wr, wc, fr, fq); if (Epi::PROBE_REP && EPI_REP > 1) asm volatile("" ::: "memory"); } S.done(cur); }
        if (Epi::SUBST) { SUBSTAMP(6) }
        if (!has_next) break;
        if (!E.keep(cur)) {
#pragma unroll
        for (int a = 0; a < 2; ++a)
#pragma unroll
            for (int b = 0; b < 2; ++b)
#pragma unroll
                for (int m = 0; m < 4; ++m)
#pragma unroll
                    for (int n = 0; n < 2; ++n) acc[a][b][m][n] = (f32x4){0.f, 0.f, 0.f, 0.f};
        }
        cur = nxt; cA = nA; cB = nB; chalf = nhalf; cH = nH; ++ui;
        if constexpr (ALIGN_EPI) { if (wr == 1) PG8_BAR; }
    }
    PG8_WAIT_V(0);
    if constexpr (!ALIGN_EPI) { if (wr == 0) PG8_BAR; }
    PG8_BAR;
    if constexpr (Epi::AFTER_DRAIN) { E.fused(acc, cur, wr, wc, fr, fq, lds, wid, lane); S.done(cur); }
#undef PG8_ABASE
#undef PG8_SA
#undef PG8_SB
#undef PG8_STAGE
#undef PG8_LDA
#undef PG8_LDB
#undef PG8_MMA
#undef PG8_WAIT_V
#undef PG8_WAIT_L
#undef PG8_BAR
#undef PG8_SCHED
}
}

constexpr int NWAVES = 8;
#ifndef MK_N_LAUNCHES
#define MK_N_LAUNCHES 1
#endif
constexpr int PER_PHASE = 9;
constexpr int N_LAUNCHES = MK_N_LAUNCHES;

constexpr int BATCH = 4, SEQ = 4096, D = 1024, M = BATCH * SEQ;
constexpr int DN_H = 4, DN_D = 128, DN_W = 512, DN_QKV = 1536;
constexpr int SW_H = 8, SW_KV = 2, SW_D = 64, SW_W = 512, SW_KVW = 128, WINDOW = 128;
constexpr int FF = 2816;
constexpr int D_IN = 4872;
constexpr int NP = 4864;
constexpr int PC_Z = 1536, PC_SQ = 2048, PC_SK = 2560, PC_SV = 2688, PC_G = 2816;
constexpr int PC_YDN = 0, PC_YSW = 512;
constexpr float EPS = 1e-6f;

constexpr size_t MiB = 1u << 20;
constexpr size_t WS_CTL = 0, CTL_ZERO_BYTES = 65536;
constexpr size_t WS_WIN = 1 * MiB;
constexpr size_t WS_WAB = 11 * MiB;
constexpr size_t WS_WOUT = 13 * MiB;
constexpr size_t WS_WGU = 15 * MiB;
constexpr size_t WS_WD = 26 * MiB;
constexpr size_t WS_RSTD = 32 * MiB;
constexpr size_t WS_GB = WS_RSTD + 64 * 1024;
constexpr size_t WS_SSQ = 33 * MiB;
constexpr size_t WS_SSQ2 = WS_SSQ + 65536;
constexpr size_t WS_XB = 34 * MiB;
constexpr size_t WS_Y = 66 * MiB;
constexpr size_t WS_PROJ = 98 * MiB;
constexpr size_t WS_UB = 250 * MiB;
constexpr size_t WS_END = 256 * MiB;
static_assert(WS_PROJ + (size_t)M * NP * 2 <= WS_UB, "ws map");
constexpr int CW_TMO = 0, CW_SCAN = 1024  , CW_WCOPY = 3201  , CW_NORMDONE = 3202  , CW_SWADONE = 3200  , CW_BAR = 4096, CW_P56 = 8192  , CW_P67 = 12288, CW_PAN = 12288  ;

constexpr int RING_OFF = 0, RING_BYTES = 131072;
constexpr int LDSCTL_OFF = RING_BYTES, MISC_OFF = LDSCTL_OFF + 320;
constexpr int LDS_BYTES = 147456;

#define GAS __attribute__((address_space(1)))
#define LAS __attribute__((address_space(3)))
typedef unsigned short bf16;
typedef unsigned v4u __attribute__((ext_vector_type(4)));
typedef float f32x4 __attribute__((ext_vector_type(4)));
typedef float f32x2 __attribute__((ext_vector_type(2)));
typedef GAS unsigned gu32;
#define RLX_AGENT __ATOMIC_RELAXED, __HIP_MEMORY_SCOPE_AGENT
#define LDS_WAIT() asm volatile("s_waitcnt lgkmcnt(0)" ::: "memory")
#define VM_WAIT() asm volatile("s_waitcnt vmcnt(0)" ::: "memory")
__device__ __forceinline__ unsigned f2bf(float f) { unsigned u = __builtin_bit_cast(unsigned, f); return (u + 0x7fffu + ((u >> 16) & 1u)) >> 16; }
__device__ __forceinline__ unsigned pk2(float lo, float hi) { return f2bf(lo) | (f2bf(hi) << 16); }
__device__ __forceinline__ float bflo(unsigned w) { return __builtin_bit_cast(float, w << 16); }
__device__ __forceinline__ float bfhi(unsigned w) { return __builtin_bit_cast(float, w & 0xffff0000u); }
__device__ __forceinline__ float bf1(bf16 h) { return __builtin_bit_cast(float, (unsigned)h << 16); }
__device__ __forceinline__ float sigm(float x) { return __builtin_amdgcn_rcpf(1.0f + __expf(-x)); }
__device__ __forceinline__ float frsq(float x) { return __builtin_amdgcn_rsqf(x); }
template <int CTRL> __device__ __forceinline__ float dpp_mov(float v) { return __builtin_bit_cast(float, __builtin_amdgcn_update_dpp(0, __builtin_bit_cast(int, v), CTRL, 0xf, 0xf, true)); }
__device__ __forceinline__ float sum4(float v) { v += dpp_mov<0xB1>(v); v += dpp_mov<0x4E>(v); return v; }
__device__ __forceinline__ float sum8(float v) { v = sum4(v); v += dpp_mov<0x141>(v); return v; }
__device__ __forceinline__ float sum16(float v) { v = sum8(v); v += dpp_mov<0x140>(v); return v; }
__device__ __forceinline__ float rdlane(float v, int l) { return __builtin_bit_cast(float, __builtin_amdgcn_readlane(__builtin_bit_cast(int, v), l)); }
__device__ __forceinline__ float wave_sum(float v) { v = sum16(v); return (rdlane(v, 0) + rdlane(v, 16)) + (rdlane(v, 32) + rdlane(v, 48)); }
__device__ __forceinline__ float sum32(float v, int lane) { v = sum16(v); const float lo = rdlane(v, 0) + rdlane(v, 16), hi = rdlane(v, 32) + rdlane(v, 48); return (lane & 32) ? hi : lo; }
__device__ __forceinline__ float wave_max(float v) {
#pragma unroll
    for (int o = 1; o < 64; o <<= 1) v = fmaxf(v, __shfl_xor(v, o));
    return v;
}

#define XB_TMO      128
#define XB_XCNT(j)  (256  + 64 * (j))
#define XB_XSUB(j)  (1280 + 64 * (j))
#define XB_XGEN(j)  (2304 + 64 * (j))
#define XB_TOP      3328
#define XB_TOPGEN   3392
#define XCD_BAR_WORDS 3456
#define XB_SPIN_CAP (1u << 18)
__device__ __forceinline__ unsigned xb_ld(unsigned* p)              { return __hip_atomic_load(p, __ATOMIC_RELAXED, __HIP_MEMORY_SCOPE_AGENT); }
__device__ __forceinline__ unsigned xb_add(unsigned* p, unsigned v) { return __hip_atomic_fetch_add(p, v, __ATOMIC_RELAXED, __HIP_MEMORY_SCOPE_AGENT); }
__device__ __forceinline__ unsigned xb_xcc_id() { return (unsigned)__builtin_amdgcn_s_getreg((3 << 11) | 20) & 0xFu; }
#define XB_SPIN(cond, bar) do { unsigned _sp = 0; while (cond) { __builtin_amdgcn_s_sleep(1); \
    if ((++_sp & 255u) == 0u) { if (xb_ld(&(bar)[XB_TMO])) break; if (_sp > XB_SPIN_CAP) { atomicAdd(&(bar)[XB_TMO], 1u); break; } } } } while (0)
struct XcdBarrier { unsigned* bar; unsigned x; volatile LAS unsigned* st; };
__device__ __forceinline__ XcdBarrier xcd_barrier_post(unsigned* bar, volatile LAS unsigned* st) {
    XcdBarrier b; b.bar = bar; b.x = xb_xcc_id(); b.st = st;
    if (threadIdx.x == 0) (void)xb_add(&bar[XB_XCNT(b.x)], 1u);
    return b;
}
__device__ __forceinline__ void xcd_barrier_complete(unsigned* bar, unsigned x, unsigned& nloc, unsigned& nx) {
    const unsigned G = gridDim.x * gridDim.y * gridDim.z;
    unsigned sum, cnt, mine, sp = 0u;
    for (;;) {
        sum = 0u; cnt = 0u; mine = 0u;
#pragma unroll
        for (unsigned j = 0; j < 16; ++j) { const unsigned c = xb_ld(&bar[XB_XCNT(j)]); sum += c; cnt += (c > 0u) ? 1u : 0u; mine = (j == x) ? c : mine; }
        if (sum == G) break;
        __builtin_amdgcn_s_sleep(1);
        if ((++sp & 255u) == 0u) { if (xb_ld(&bar[XB_TMO])) break; if (sp > XB_SPIN_CAP) { atomicAdd(&bar[XB_TMO], 1u); break; } }
    }
    nloc = mine > 0u ? mine : 1u; nx = cnt > 0u ? cnt : 1u;
}
__device__ __forceinline__ void xcd_barrier(const XcdBarrier& b) {
    asm volatile("s_waitcnt vmcnt(0)" ::: "memory");
    __syncthreads();
    if (threadIdx.x == 0) {
        unsigned* bar = b.bar;
        __builtin_amdgcn_s_waitcnt(0);
        unsigned nloc = b.st[0], nx = b.st[1];
        if (nloc == 0u) { xcd_barrier_complete(bar, b.x, nloc, nx); b.st[0] = nloc; b.st[1] = nx; }
#if BAR_EARLY_WB
        asm volatile("buffer_wbl2 sc1" ::: "memory");
#endif
        const unsigned old = xb_add(&bar[XB_XSUB(b.x)], 1u);
        const unsigned gen = old / nloc;
        if (old + 1u == (gen + 1u) * nloc) {
            __builtin_amdgcn_fence(__ATOMIC_RELEASE, "agent");
            asm volatile("s_waitcnt vmcnt(0)" ::: "memory");
            const unsigned og = xb_add(&bar[XB_TOP], 1u);
            const unsigned tg = og / nx;
            if (og + 1u == (tg + 1u) * nx) xb_add(&bar[XB_TOPGEN], 1u);
            else XB_SPIN(xb_ld(&bar[XB_TOPGEN]) == tg, bar);
            __builtin_amdgcn_fence(__ATOMIC_ACQUIRE, "agent");
            xb_add(&bar[XB_XGEN(b.x)], 1u);
            asm volatile("s_waitcnt vmcnt(0)" ::: "memory");
        } else {
            XB_SPIN(xb_ld(&bar[XB_XGEN(b.x)]) == gen, bar);
            __builtin_amdgcn_fence(__ATOMIC_ACQUIRE, "agent");
            asm volatile("s_waitcnt vmcnt(0)" ::: "memory");
        }
    }
    __syncthreads();
}

struct Args { const float* in[18]; float* out; unsigned char* ws; int ph_lo, ph_hi, li, ws_mib; };
typedef const __attribute__((address_space(4))) Args* KArgs;
#define FIN(k) (F.ka->in[k])
struct Frame {
    LAS unsigned char* lds;
    volatile LAS unsigned* MISC;
    gu32* ctl;
    int tid, lane, wave;
    int vcu, G;
    KArgs ka; float* out; unsigned char* ws;
};
__device__ const unsigned char T5_BUCKET[128] = {0,1,2,3,4,5,6,7,8,9,10,11,12,13,14,15,16,16,16,17,17,18,18,18,19,19,19,20,20,20,20,21,21,21,21,22,22,22,22,22,23,23,23,23,23,23,24,24,24,24,24,24,25,25,25,25,25,25,25,26,26,26,26,26,26,26,26,27,27,27,27,27,27,27,27,27,27,28,28,28,28,28,28,28,28,28,28,29,29,29,29,29,29,29,29,29,29,29,29,30,30,30,30,30,30,30,30,30,30,30,30,30,30,31,31,31,31,31,31,31,31,31,31,31,31,31,31,31};

__device__ __forceinline__ int lcol32(int nb) { return 256 * (nb >> 3) + 32 * (2 * (nb & 3) + ((nb >> 2) & 1)); }
constexpr int WI_IN = 16 * (NP / 32), WI_AB = 8 * 32, WI_OUT = 16 * 32, WI_GU = 16 * (2 * FF / 32), WI_D = (FF / 64) * 32, WI_ALL = WI_IN + 2 * WI_AB + WI_OUT + WI_GU + WI_D, WI_P0 = SEAM35 ? (SEAM56 ? WI_IN + 2 * WI_AB + WI_OUT : WI_IN + 2 * WI_AB) : WI_IN;
struct WItem { const float* W; int ldw, src_col0, K; bf16* WT; int dst_row0; const float* gain; int kb; };
__device__ __forceinline__ WItem weight_item(Frame& F, int it) {
    unsigned char* ws = F.ws;
    bf16* WinT = (bf16*)(ws + WS_WIN); bf16* WabT = (bf16*)(ws + WS_WAB); bf16* WoutT = (bf16*)(ws + WS_WOUT); bf16* WguT = (bf16*)(ws + WS_WGU); bf16* WdT = (bf16*)(ws + WS_WD);
    int r = it;
    if (r < WI_IN) { const int nb = r % (NP / 32), kb = r / (NP / 32), dr = 32 * nb, lc = lcol32(nb); return WItem{FIN(2), D_IN, lc < 2048 ? lc : lc + 8, D, WinT, dr, FIN(1), kb}; } r -= WI_IN;
    if (r < WI_AB) { const int nb = r % 32, kb = r / 32; return WItem{FIN(11), D, lcol32(nb), DN_W, WabT, 32 * nb, nullptr, kb}; } r -= WI_AB;
    if (r < WI_AB) { const int nb = r % 32, kb = r / 32; return WItem{FIN(12), D, lcol32(nb), SW_W, WabT, 1024 + 32 * nb, nullptr, kb}; } r -= WI_AB;
    if (r < WI_OUT) { const int nb = r % 32, kb = r / 32; return WItem{FIN(13), D, 32 * nb, D, WoutT, 32 * nb, nullptr, kb}; } r -= WI_OUT;
    if (r < WI_GU) { const int nb = r % (2 * FF / 32), kb = r / (2 * FF / 32), dr = 32 * nb, pn = dr >> 8, j = dr & 255;
        return WItem{(j < 128) ? FIN(15) : FIN(16), FF, 128 * pn + (j & 127), D, WguT, dr, FIN(14), kb}; } r -= WI_GU;
    { const int nb = r % 32, kb = r / 32; return WItem{FIN(17), D, 32 * nb, FF, WdT, 32 * nb, nullptr, kb}; }
}
__device__ __forceinline__ void witem_load(const WItem& w, int lane, f32x4 (&v)[8], float (&gn)[8]) {
    const int k0 = 64 * w.kb, c4 = 4 * (lane & 7);
#pragma unroll
    for (int i = 0; i < 8; ++i) { const int kk = 8 * i + (lane >> 3); v[i] = *(const f32x4*)(w.W + (size_t)(k0 + kk) * w.ldw + w.src_col0 + c4); gn[i] = w.gain ? w.gain[k0 + kk] : 1.0f; }
}
__device__ __forceinline__ void witem_store(const WItem& w, int lane, const f32x4 (&v)[8], const float (&gn)[8], LAS float* scr) {
    const int k0 = 64 * w.kb, c4 = 4 * (lane & 7);
#pragma unroll
    for (int i = 0; i < 8; ++i) { const int kk = 8 * i + (lane >> 3);
        scr[kk * 33 + c4] = v[i].x * gn[i]; scr[kk * 33 + c4 + 1] = v[i].y * gn[i]; scr[kk * 33 + c4 + 2] = v[i].z * gn[i]; scr[kk * 33 + c4 + 3] = v[i].w * gn[i]; }
    LDS_WAIT(); asm volatile("" ::: "memory");
    const int c = lane & 7;
#pragma unroll
    for (int j = 0; j < 4; ++j) { const int n = (lane >> 3) + 8 * j; const LAS float* s = scr + (8 * c) * 33 + n;
        v4u o; o.x = pk2(s[0 * 33], s[1 * 33]); o.y = pk2(s[2 * 33], s[3 * 33]); o.z = pk2(s[4 * 33], s[5 * 33]); o.w = pk2(s[6 * 33], s[7 * 33]);
        if (SEAM67) asm volatile("global_store_dwordx4 %0, %1, off sc1\n\ts_nop 2" :: "v"((GAS v4u*)(w.WT + (size_t)(w.dst_row0 + n) * w.K + k0 + 8 * c)), "v"(o) : "memory");
        else *(GAS v4u*)(w.WT + (size_t)(w.dst_row0 + n) * w.K + k0 + 8 * c) = o; }
    LDS_WAIT(); asm volatile("" ::: "memory");
}
__device__ __forceinline__ void weight_copies(Frame& F, int lo, int hi, int gw, int NGW) {
    LAS float* scr = (LAS float*)(F.lds + RING_OFF + F.wave * 16384);
    int it = lo + gw; if (it >= hi) return;
    f32x4 vc[8]; float gc[8];
    WItem cur = weight_item(F, it); witem_load(cur, F.lane, vc, gc);
    for (;;) {
        const int nx = it + NGW; const bool more = nx < hi;
        f32x4 vn[8]; float gnx[8]; WItem nxt = cur;
        if (more) { nxt = weight_item(F, nx); witem_load(nxt, F.lane, vn, gnx); }
        witem_store(cur, F.lane, vc, gc, scr);
        if (!more) break;
#pragma unroll
        for (int i = 0; i < 8; ++i) { vc[i] = vn[i]; gc[i] = gnx[i]; }
        cur = nxt; it = nx;
    }
}
__device__ __forceinline__ void p0_prologue(Frame& F) {
    const int gw = F.vcu * NWAVES + F.wave, NGW = F.G * NWAVES;
    unsigned char* ws = F.ws;
    weight_copies(F, 0, (F.G == 256 && DEFER_WEIGHTS) ? WI_P0 : WI_ALL, gw, NGW);
    __syncthreads();
    LAS float* wba = (LAS float*)(F.lds + RING_OFF);
    for (int idx = F.tid; idx < 8 * D; idx += NWAVES * 64) { const int k = idx >> 3, j = idx & 7; wba[j * D + k] = FIN(2)[(size_t)k * D_IN + 2048 + j] * FIN(1)[k]; }
    __syncthreads();
    const float* x = FIN(0); bf16* XB = (bf16*)(ws + WS_XB); float* rstd1 = (float*)(ws + WS_RSTD); float* gbp = (float*)(ws + WS_GB); float* ssq2 = (float*)(ws + WS_SSQ2);
    const float alog_or_dt = (F.lane & 32) ? FIN(5)[(F.lane >> 3) & 3] : 0.f;
    const float negA = -expf(FIN(4)[(F.lane >> 3) & 3]);
#if P0_DEEP
    auto do_row = [&](const f32x4 (&v)[4], int m) {
        float ss = 0.f;
#pragma unroll
        for (int j = 0; j < 4; ++j) ss += (v[j].x * v[j].x + v[j].y * v[j].y) + (v[j].z * v[j].z + v[j].w * v[j].w);
        GAS unsigned long long* o8 = (GAS unsigned long long*)(XB + (size_t)m * D) + F.lane;
#pragma unroll
        for (int j = 0; j < 4; ++j) { const unsigned long long w = (unsigned long long)pk2(v[j].x, v[j].y) | ((unsigned long long)pk2(v[j].z, v[j].w) << 32);
            asm volatile("global_store_dwordx2 %0, %1, off" :: "v"(o8 + 64 * j), "v"(w) : "memory"); }
        float acc[8];
#pragma unroll
        for (int c = 0; c < 8; ++c) { float a = 0.f;
#pragma unroll
            for (int j = 0; j < 4; ++j) { const f32x4 w = *(const LAS f32x4*)(wba + c * D + 256 * j + 4 * F.lane); a += (v[j].x * w.x + v[j].y * w.y) + (v[j].z * w.z + v[j].w * w.w); }
            acc[c] = a; }
        ss = wave_sum(ss);
        float r4[4], r2[2], r1;
        { const bool up = (F.lane & 32) != 0;
#pragma unroll
          for (int i = 0; i < 4; ++i) { const float keep = up ? acc[4 + i] : acc[i], send = up ? acc[i] : acc[4 + i]; r4[i] = keep + __shfl_xor(send, 32); } }
        { const bool up = (F.lane & 16) != 0;
#pragma unroll
          for (int i = 0; i < 2; ++i) { const float keep = up ? r4[2 + i] : r4[i], send = up ? r4[i] : r4[2 + i]; r2[i] = keep + __shfl_xor(send, 16); } }
        { const bool up = (F.lane & 8) != 0; const float keep = up ? r2[1] : r2[0], send = up ? r2[0] : r2[1]; r1 = keep + __shfl_xor(send, 8); }
        r1 = sum8(r1);
        const float rstd = frsq(ss * (1.0f / D) + EPS);
        if (F.lane == 0) { asm volatile("global_store_dword %0, %1, off" :: "v"((GAS float*)(rstd1 + m)), "v"(rstd) : "memory"); asm volatile("global_store_dword %0, %1, off" :: "v"((GAS float*)(ssq2 + m)), "v"(0.f) : "memory"); }
        if ((F.lane & 7) == 0) {
            const float val = r1 * rstd; float res;
            if (F.lane < 32) res = 1.0f / (1.0f + expf(-val));
            else { const float xx = val + alog_or_dt; const float sp = xx > 20.f ? xx : log1pf(expf(xx)); res = negA * sp; }
            asm volatile("global_store_dword %0, %1, off" :: "v"((GAS float*)(gbp + (size_t)m * 8 + (F.lane >> 3))), "v"(res) : "memory");
        }
    };
    f32x4 qa[4], qb[4];
#pragma unroll
    for (int j = 0; j < 4; ++j) { qa[j] = (f32x4){0.f, 0.f, 0.f, 0.f}; qb[j] = qa[j]; }
    if (gw < M) {
#pragma unroll
        for (int j = 0; j < 4; ++j) qa[j] = ((const GAS f32x4*)(x + (size_t)gw * D) + F.lane)[64 * j]; }
    if (gw + NGW < M) {
#pragma unroll
        for (int j = 0; j < 4; ++j) qb[j] = ((const GAS f32x4*)(x + (size_t)(gw + NGW) * D) + F.lane)[64 * j]; }
    for (int m = gw; m < M; m += 2 * NGW) {
        f32x4 v[4];
#pragma unroll
        for (int j = 0; j < 4; ++j) v[j] = qa[j];
        if (m + 2 * NGW < M) {
#pragma unroll
            for (int j = 0; j < 4; ++j) qa[j] = ((const GAS f32x4*)(x + (size_t)(m + 2 * NGW) * D) + F.lane)[64 * j]; }
        do_row(v, m);
        if (m + NGW < M) {
#pragma unroll
            for (int j = 0; j < 4; ++j) v[j] = qb[j];
            if (m + 3 * NGW < M) {
#pragma unroll
                for (int j = 0; j < 4; ++j) qb[j] = ((const GAS f32x4*)(x + (size_t)(m + 3 * NGW) * D) + F.lane)[64 * j]; }
            do_row(v, m + NGW);
        }
    }
}
#else
    f32x4 vnx[4];
    if (gw < M) {
#pragma unroll
        for (int j = 0; j < 4; ++j) vnx[j] = ((const GAS f32x4*)(x + (size_t)gw * D) + F.lane)[64 * j]; }
    for (int m = gw; m < M; m += NGW) {
        f32x4 v[4]; float ss = 0.f;
#pragma unroll
        for (int j = 0; j < 4; ++j) { v[j] = vnx[j]; ss += (v[j].x * v[j].x + v[j].y * v[j].y) + (v[j].z * v[j].z + v[j].w * v[j].w); }
        if (m + NGW < M) {
#pragma unroll
            for (int j = 0; j < 4; ++j) vnx[j] = ((const GAS f32x4*)(x + (size_t)(m + NGW) * D) + F.lane)[64 * j]; }
        GAS unsigned long long* o8 = (GAS unsigned long long*)(XB + (size_t)m * D) + F.lane;
#pragma unroll
        for (int j = 0; j < 4; ++j) o8[64 * j] = (unsigned long long)pk2(v[j].x, v[j].y) | ((unsigned long long)pk2(v[j].z, v[j].w) << 32);
        float acc[8];
#pragma unroll
        for (int c = 0; c < 8; ++c) { float a = 0.f;
#pragma unroll
            for (int j = 0; j < 4; ++j) { const f32x4 w = *(const LAS f32x4*)(wba + c * D + 256 * j + 4 * F.lane); a += (v[j].x * w.x + v[j].y * w.y) + (v[j].z * w.z + v[j].w * w.w); }
            acc[c] = a; }
        ss = wave_sum(ss);
        float r4[4], r2[2], r1;
        { const bool up = (F.lane & 32) != 0;
#pragma unroll
          for (int i = 0; i < 4; ++i) { const float keep = up ? acc[4 + i] : acc[i], send = up ? acc[i] : acc[4 + i]; r4[i] = keep + __shfl_xor(send, 32); } }
        { const bool up = (F.lane & 16) != 0;
#pragma unroll
          for (int i = 0; i < 2; ++i) { const float keep = up ? r4[2 + i] : r4[i], send = up ? r4[i] : r4[2 + i]; r2[i] = keep + __shfl_xor(send, 16); } }
        { const bool up = (F.lane & 8) != 0; const float keep = up ? r2[1] : r2[0], send = up ? r2[0] : r2[1]; r1 = keep + __shfl_xor(send, 8); }
        r1 = sum8(r1);
        const float rstd = frsq(ss * (1.0f / D) + EPS);
        if (F.lane == 0) { rstd1[m] = rstd; ssq2[m] = 0.f; }
        if ((F.lane & 7) == 0) {
            const float val = r1 * rstd; float res;
            if (F.lane < 32) res = 1.0f / (1.0f + expf(-val));
            else { const float xx = val + alog_or_dt; const float sp = xx > 20.f ? xx : log1pf(expf(xx)); res = negA * sp; }
            gbp[(size_t)m * 8 + (F.lane >> 3)] = res;
        }
    }
}
#endif

__device__ __forceinline__ void dn_pre(Frame& F) {
    const int gw = F.vcu * NWAVES + F.wave, NGW = F.G * NWAVES;
    const bf16* proj = (const bf16*)(F.ws + WS_PROJ); const float* conv = FIN(3);
    float* QN = F.out; float* KN = F.out + (size_t)M * DN_W; float* VV = (float*)(F.ws + WS_XB);
    for (int task = gw; task < M * DN_H; task += NGW) {
        const int m = task >> 2, h = task & 3, t = m & (SEQ - 1);
        float val[3][2];
#pragma unroll
        for (int part = 0; part < 3; ++part) { const int col = part * DN_W + h * DN_D + 2 * F.lane; float a0 = 0.f, a1 = 0.f;
#pragma unroll
            for (int j = 0; j < 4; ++j) { if (t - 3 + j >= 0) { const unsigned w = *(const unsigned*)(proj + (size_t)(m - 3 + j) * NP + col); a0 += conv[j * DN_QKV + col] * bflo(w); a1 += conv[j * DN_QKV + col + 1] * bfhi(w); } }
            val[part][0] = a0 * sigm(a0); val[part][1] = a1 * sigm(a1); }
        const float rq = 1.0f / sqrtf(wave_sum(val[0][0] * val[0][0] + val[0][1] * val[0][1]) + EPS) * 0.08838834764831845f;
        const float rk = 1.0f / sqrtf(wave_sum(val[1][0] * val[1][0] + val[1][1] * val[1][1]) + EPS);
        const size_t o = (size_t)m * DN_W + h * DN_D + 2 * F.lane;
        *(f32x2*)(QN + o) = (f32x2){val[0][0] * rq, val[0][1] * rq};
        *(f32x2*)(KN + o) = (f32x2){val[1][0] * rk, val[1][1] * rk};
        *(f32x2*)(VV + o) = (f32x2){val[2][0], val[2][1]};
    }
}
__device__ __forceinline__ void dn_scan_naive(Frame& F, int bh) {
    const int b = bh >> 2, h = bh & 3, tid = F.tid, dvi = tid >> 2, kq = tid & 3;
    LAS float* kL = (LAS float*)(F.lds + RING_OFF); LAS float* qL = kL + 32 * 128; LAS float* vL = qL + 32 * 128; LAS float* gL = vL + 32 * 128; LAS float* bL = gL + 32;
    const float* QN = F.out; const float* KN = F.out + (size_t)M * DN_W; float* VV = (float*)(F.ws + WS_XB); const float* gbp = (const float*)(F.ws + WS_GB);
    float S[32];
#pragma unroll
    for (int j = 0; j < 32; ++j) S[j] = 0.f;
    for (int t0 = 0; t0 < SEQ; t0 += 32) {
#pragma unroll
        for (int r = 0; r < 2; ++r) { const int idx = tid + 512 * r, tok = idx >> 5, c4 = idx & 31; const size_t src = (size_t)(b * SEQ + t0 + tok) * DN_W + h * DN_D + c4 * 4;
            *(LAS f32x4*)(kL + tok * 128 + c4 * 4) = *(const f32x4*)(KN + src); *(LAS f32x4*)(qL + tok * 128 + c4 * 4) = *(const f32x4*)(QN + src); *(LAS f32x4*)(vL + tok * 128 + c4 * 4) = *(const f32x4*)(VV + src); }
        if (tid < 32) { const size_t mm = (size_t)(b * SEQ + t0 + tid); bL[tid] = gbp[mm * 8 + h]; gL[tid] = gbp[mm * 8 + 4 + h]; }
        __syncthreads();
        for (int i = 0; i < 32; ++i) {
            const float eg = __expf(gL[i]), be = bL[i];
            float kk[32];
#pragma unroll
            for (int j = 0; j < 8; ++j) { const f32x4 w = *(const LAS f32x4*)(kL + i * 128 + kq * 32 + 4 * j); kk[4 * j] = w.x; kk[4 * j + 1] = w.y; kk[4 * j + 2] = w.z; kk[4 * j + 3] = w.w; }
            float part = 0.f;
#pragma unroll
            for (int j = 0; j < 32; ++j) part += kk[j] * S[j];
            part += __shfl_xor(part, 1); part += __shfl_xor(part, 2);
            const float c = be * (vL[i * 128 + dvi] - eg * part);
#pragma unroll
            for (int j = 0; j < 32; ++j) S[j] = eg * S[j] + c * kk[j];
            float po = 0.f;
#pragma unroll
            for (int j = 0; j < 8; ++j) { const f32x4 w = *(const LAS f32x4*)(qL + i * 128 + kq * 32 + 4 * j); po += (w.x * S[4 * j] + w.y * S[4 * j + 1]) + (w.z * S[4 * j + 2] + w.w * S[4 * j + 3]); }
            po += __shfl_xor(po, 1); po += __shfl_xor(po, 2);
            if (kq == 0) vL[i * 128 + dvi] = po;
        }
        __syncthreads();
#pragma unroll
        for (int r = 0; r < 2; ++r) { const int idx = tid + 512 * r, tok = idx >> 5, c4 = idx & 31; const size_t src = (size_t)(b * SEQ + t0 + tok) * DN_W + h * DN_D + c4 * 4;
            *(f32x4*)(VV + src) = *(const LAS f32x4*)(vL + tok * 128 + c4 * 4); }
        __syncthreads();
    }
}
__device__ __forceinline__ void swa_naive(Frame& F, int wv, int nworkers) {
    const bf16* proj = (const bf16*)(F.ws + WS_PROJ); bf16* YSWA = (bf16*)(F.ws + WS_Y) + (size_t)M * SW_W;
    LAS float* qs = (LAS float*)(F.lds + RING_OFF + 65536 + F.wave * 1024); LAS float* ps = qs + 64;
    const float* qg = FIN(7); const float* kg = FIN(8); const float* sinks = FIN(9); const float* relb = FIN(10);
    const int lane = F.lane;
    for (int task = wv; task < M * SW_H; task += nworkers) {
        const int m = task >> 3, qh = task & 7, kvh = qh >> 2, t = m & (SEQ - 1);
        const float q = bf1(proj[(size_t)m * NP + PC_SQ + qh * SW_D + lane]);
        const float qn = q * (1.0f / sqrtf(wave_sum(q * q) * (1.0f / SW_D) + EPS)) * qg[lane];
        qs[lane] = qn * kg[lane];
        LDS_WAIT(); asm volatile("" ::: "memory");
        float lg[2];
#pragma unroll
        for (int hf = 0; hf < 2; ++hf) { const int j = lane + 64 * hf; lg[hf] = -INFINITY;
            if (t - 127 + j >= 0) { const v4u* kr = (const v4u*)(proj + (size_t)(m - 127 + j) * NP + PC_SK + kvh * SW_D); float ssk = 0.f, dot = 0.f;
#pragma unroll
                for (int c = 0; c < 8; ++c) { const v4u w = kr[c];
#pragma unroll
                    for (int e = 0; e < 4; ++e) { const float k0 = bflo(w[e]), k1 = bfhi(w[e]); ssk += k0 * k0 + k1 * k1; dot += qs[8 * c + 2 * e] * k0 + qs[8 * c + 2 * e + 1] * k1; } }
                lg[hf] = dot * (1.0f / sqrtf(ssk * (1.0f / SW_D) + EPS)) * 0.125f + relb[(int)T5_BUCKET[127 - j] * SW_H + qh]; } }
        const float sink = sinks[qh];
        const float mx = fmaxf(wave_max(fmaxf(lg[0], lg[1])), sink);
        const float p0 = (lg[0] == -INFINITY) ? 0.f : __expf(lg[0] - mx), p1 = (lg[1] == -INFINITY) ? 0.f : __expf(lg[1] - mx);
        const float den = wave_sum(p0 + p1) + __expf(sink - mx);
        ps[lane] = p0; ps[lane + 64] = p1;
        LDS_WAIT(); asm volatile("" ::: "memory");
        float o = 0.f; const int jmin = (127 - t) > 0 ? (127 - t) : 0;
        for (int j = jmin; j < 128; ++j) o += ps[j] * bf1(proj[(size_t)(m - 127 + j) * NP + PC_SV + kvh * SW_D + lane]);
        YSWA[(size_t)m * SW_W + qh * SW_D + lane] = (bf16)f2bf(o / den);
        LDS_WAIT(); asm volatile("" ::: "memory");
    }
}
__device__ __forceinline__ void dn_out(Frame& F) {
    const int gw = F.vcu * NWAVES + F.wave, NGW = F.G * NWAVES;
    const bf16* proj = (const bf16*)(F.ws + WS_PROJ); const float* VV = (const float*)(F.ws + WS_XB); bf16* YDN = (bf16*)(F.ws + WS_Y); const float* gain = FIN(6);
    for (int task = gw; task < M * DN_H; task += NGW) {
        const int m = task >> 2, h = task & 3;
        const f32x2 o = *(const f32x2*)(VV + (size_t)m * DN_W + h * DN_D + 2 * F.lane);
        const float r = 1.0f / sqrtf(wave_sum(o.x * o.x + o.y * o.y) * (1.0f / DN_D) + EPS);
        const unsigned zw = *(const unsigned*)(proj + (size_t)m * NP + PC_Z + h * DN_D + 2 * F.lane); const float z0 = bflo(zw), z1 = bfhi(zw);
        *(unsigned*)(YDN + (size_t)m * DN_W + h * DN_D + 2 * F.lane) = pk2(o.x * r * gain[2 * F.lane] * z0 * sigm(z0), o.y * r * gain[2 * F.lane + 1] * z1 * sigm(z1));
    }
}

typedef short bf16x8 __attribute__((ext_vector_type(8)));
typedef float f32x16 __attribute__((ext_vector_type(16)));
typedef unsigned u32x2 __attribute__((ext_vector_type(2)));
typedef __bf16 bf16x2_t __attribute__((ext_vector_type(2)));
__device__ __forceinline__ unsigned cvtpk(float lo, float hi) { f32x2 v = {lo, hi}; return __builtin_bit_cast(unsigned, __builtin_convertvector(v, bf16x2_t)); }
__device__ __forceinline__ bf16x8 pack8(f32x4 a, f32x4 b) { v4u w; w.x = cvtpk(a[0], a[1]); w.y = cvtpk(a[2], a[3]); w.z = cvtpk(b[0], b[1]); w.w = cvtpk(b[2], b[3]); return __builtin_bit_cast(bf16x8, w); }
__device__ __forceinline__ bf16x8 pack8z(f32x4 a) { v4u w; w.x = cvtpk(a[0], a[1]); w.y = cvtpk(a[2], a[3]); w.z = 0u; w.w = 0u; return __builtin_bit_cast(bf16x8, w); }
#define MFMA16(a, b, c) __builtin_amdgcn_mfma_f32_16x16x32_bf16((a), (b), (c), 0, 0, 0)
#define MFMA32(a, b, c) __builtin_amdgcn_mfma_f32_32x32x16_bf16((a), (b), (c), 0, 0, 0)
constexpr float LOG2E = 1.4426950408889634f;

__device__ __forceinline__ void swa_pre(Frame& F) {
    const int gw = F.vcu * NWAVES + F.wave, NGW = F.G * NWAVES, lane = F.lane;
    const bf16* proj = (const bf16*)(F.ws + WS_PROJ);
    bf16* KS = (bf16*)(F.ws + WS_Y); bf16* VT = KS + 2 * 1024 * 1024; bf16* QS = (bf16*)(F.ws + WS_Y) + (size_t)M * SW_W;
    const float* qg = FIN(7); const float* kg = FIN(8);
    v4u wq_n = {0u, 0u, 0u, 0u}; unsigned wk_n = 0u;
    if (!FUSE_QKNORM && gw < M) { wq_n = *(const v4u*)(proj + (size_t)gw * NP + PC_SQ + 8 * lane); wk_n = *(const unsigned*)(proj + (size_t)gw * NP + PC_SK + 2 * lane); }
    const f32x4 g0 = *(const f32x4*)(qg + 8 * (lane & 7)), g1 = *(const f32x4*)(qg + 8 * (lane & 7) + 4);
    const float kg0 = kg[2 * (lane & 31)], kg1 = kg[2 * (lane & 31) + 1];
    if (!FUSE_QKNORM)
    for (int m = gw; m < M; m += NGW) {
        const v4u w = wq_n; const unsigned wk = wk_n;
        if (m + NGW < M) { wq_n = *(const v4u*)(proj + (size_t)(m + NGW) * NP + PC_SQ + 8 * lane); wk_n = *(const unsigned*)(proj + (size_t)(m + NGW) * NP + PC_SK + 2 * lane); }
        {
            float x[8];
#pragma unroll
            for (int j = 0; j < 4; ++j) { x[2 * j] = bflo(w[j]); x[2 * j + 1] = bfhi(w[j]); }
            float ss = 0.f;
#pragma unroll
            for (int j = 0; j < 8; ++j) ss += x[j] * x[j];
            ss = sum8(ss);
            const float r = frsq(ss * (1.0f / SW_D) + EPS) * (0.125f * LOG2E);
            v4u o; o.x = cvtpk(x[0] * r * g0[0], x[1] * r * g0[1]); o.y = cvtpk(x[2] * r * g0[2], x[3] * r * g0[3]); o.z = cvtpk(x[4] * r * g1[0], x[5] * r * g1[1]); o.w = cvtpk(x[6] * r * g1[2], x[7] * r * g1[3]);
            *(v4u*)(QS + (size_t)m * SW_W + 8 * lane) = o;
        }
        {
            const float k0 = bflo(wk), k1 = bfhi(wk);
            float ss = k0 * k0 + k1 * k1;
            ss = sum32(ss, lane);
            const float r = frsq(ss * (1.0f / SW_D) + EPS); const int d = 2 * (lane & 31), b = m >> 12, t = m & (SEQ - 1), kvh = lane >> 5;
            *(unsigned*)(KS + ((size_t)(b * 2 + kvh) * SEQ + t) * SW_D + d) = cvtpk(k0 * r * kg0, k1 * r * kg1);
        }
    }
    for (int task = gw; task < BATCH * SW_KV * (SEQ / 32); task += NGW) {
        const int bk = task >> 7, tile = task & 127, b = bk >> 1, kvh = bk & 1; const size_t m0 = (size_t)b * SEQ + tile * 32;
        unsigned v[32];
#pragma unroll
        for (int i = 0; i < 32; ++i) v[i] = proj[(m0 + i) * NP + PC_SV + kvh * SW_D + lane];
        bf16* dst = VT + ((size_t)(bk * 128 + tile) * 64 + lane) * 32;
#pragma unroll
        for (int q4 = 0; q4 < 4; ++q4) { v4u o;
#pragma unroll
            for (int jj = 0; jj < 4; ++jj) { const int p0 = 8 * q4 + 2 * jj, p1 = p0 + 1;
                const int k0 = 16 * (p0 >> 4) + 8 * ((p0 & 7) >> 2) + 4 * ((p0 >> 3) & 1) + (p0 & 3), k1 = 16 * (p1 >> 4) + 8 * ((p1 & 7) >> 2) + 4 * ((p1 >> 3) & 1) + (p1 & 3);
                o[jj] = v[k0] | (v[k1] << 16); }
            *(v4u*)(dst + 8 * q4) = o; }
    }
}
__device__ __forceinline__ void swa_bias_table(Frame& F) {
    LAS float* biasT = (LAS float*)(F.lds + RING_OFF);
    for (int idx = F.tid; idx < SW_H * 128; idx += NWAVES * 64) { const int h = idx >> 7, dist = idx & 127; biasT[idx] = FIN(10)[(int)T5_BUCKET[dist] * SW_H + h] * LOG2E; }
}
__device__ __forceinline__ void swa_main(Frame& F, int worker, int nworkers) {
    const LAS float* biasT = (const LAS float*)(F.lds + RING_OFF);
    const bf16* KS = (const bf16*)(F.ws + WS_Y); const bf16* VT = KS + 2 * 1024 * 1024; const bf16* QS = (const bf16*)(F.ws + WS_Y) + (size_t)M * SW_W;
    bf16* YSW = (bf16*)(F.ws + WS_PROJ) + PC_YSW;
    const int lane = F.lane, l31 = lane & 31, hh = lane >> 5;
    for (int u = worker; u < BATCH * SW_H * (SEQ / 32); u += nworkers) {
        const int qblk = u & 127, h = (u >> 7) & 7, b = u >> 10, kvh = h >> 2, bk = b * 2 + kvh, q0 = qblk * 32; const size_t m0 = (size_t)b * SEQ + q0;
        bf16x8 qf[4], kf[5][4];
#pragma unroll
        for (int ks = 0; ks < 4; ++ks) qf[ks] = *(const bf16x8*)(QS + (m0 + l31) * SW_W + h * SW_D + 16 * ks + 8 * hh);
#pragma unroll
        for (int i = 0; i < 5; ++i) { const int ts = q0 - 128 + 32 * i, tsc = ts < 0 ? 0 : ts;
#pragma unroll
            for (int ks = 0; ks < 4; ++ks) kf[i][ks] = *(const bf16x8*)(KS + ((size_t)bk * SEQ + tsc + l31) * SW_D + 16 * ks + 8 * hh); }
        __builtin_amdgcn_sched_barrier(0);
        f32x16 s[5];
#pragma unroll
        for (int i = 0; i < 5; ++i) {
            const int ts = q0 - 128 + 32 * i;
            f32x16 acc;
#pragma unroll
            for (int r = 0; r < 16; ++r) acc[r] = 0.f;
#pragma unroll
            for (int ks = 0; ks < 4; ++ks) acc = MFMA32(kf[i][ks], qf[ks], acc);
#pragma unroll
            for (int r = 0; r < 16; ++r) { const int row = (r & 3) + 8 * (r >> 2) + 4 * hh, dist = 128 - 32 * i + l31 - row; const bool ok = ts >= 0 && dist >= 0 && dist <= 127;
                s[i][r] = ok ? acc[r] + biasT[h * 128 + (dist & 127)] : -INFINITY; }
        }
        bf16x8 vf[5][2][2];
#pragma unroll
        for (int i = 0; i < 5; ++i) { const int ts = q0 - 128 + 32 * i, tsc = ts < 0 ? 0 : ts;
#pragma unroll
            for (int s2 = 0; s2 < 2; ++s2)
#pragma unroll
                for (int nt = 0; nt < 2; ++nt) vf[i][s2][nt] = *(const bf16x8*)(VT + ((size_t)(bk * 128 + (tsc >> 5)) * 64 + 32 * nt + l31) * 32 + s2 * 16 + hh * 8); }
        __builtin_amdgcn_sched_barrier(0);
        const float sink2 = FIN(9)[h] * LOG2E;
        float mx = sink2;
#pragma unroll
        for (int i = 0; i < 5; ++i)
#pragma unroll
            for (int r = 0; r < 16; ++r) mx = fmaxf(mx, s[i][r]);
        mx = fmaxf(mx, __shfl_xor(mx, 32));
        float sum = 0.f;
#pragma unroll
        for (int i = 0; i < 5; ++i)
#pragma unroll
            for (int r = 0; r < 16; ++r) { const float p = __builtin_amdgcn_exp2f(s[i][r] - mx); s[i][r] = p; sum += p; }
        sum += __shfl_xor(sum, 32);
        const float inv = __builtin_amdgcn_rcpf(sum + __builtin_amdgcn_exp2f(sink2 - mx));
        f32x16 O[2];
#pragma unroll
        for (int r = 0; r < 16; ++r) { O[0][r] = 0.f; O[1][r] = 0.f; }
#pragma unroll
        for (int i = 0; i < 5; ++i) {
#pragma unroll
            for (int s2 = 0; s2 < 2; ++s2) {
                v4u w; w.x = cvtpk(s[i][8 * s2] * inv, s[i][8 * s2 + 1] * inv); w.y = cvtpk(s[i][8 * s2 + 2] * inv, s[i][8 * s2 + 3] * inv); w.z = cvtpk(s[i][8 * s2 + 4] * inv, s[i][8 * s2 + 5] * inv); w.w = cvtpk(s[i][8 * s2 + 6] * inv, s[i][8 * s2 + 7] * inv);
                const bf16x8 pa = __builtin_bit_cast(bf16x8, w);
#pragma unroll
                for (int nt = 0; nt < 2; ++nt) O[nt] = MFMA32(pa, vf[i][s2][nt], O[nt]);
            }
        }
        {
            LAS unsigned char* stg = F.lds + RING_OFF + 8192 + F.wave * 4608;
#pragma unroll
            for (int nt = 0; nt < 2; ++nt)
#pragma unroll
                for (int r = 0; r < 16; ++r) { const int q = (r & 3) + 8 * (r >> 2) + 4 * hh; *(LAS unsigned short*)(stg + q * 144 + (32 * nt + l31) * 2) = (unsigned short)(cvtpk(O[nt][r], 0.f) & 0xffffu); }
            asm volatile("s_waitcnt lgkmcnt(0)" ::: "memory");
#pragma unroll
            for (int i = 0; i < 4; ++i) { const int row = 8 * i + (lane >> 3), ch16 = lane & 7; const v4u v = *(const LAS v4u*)(stg + row * 144 + ch16 * 16);
                if (SEAM35) { GAS v4u* dst = (GAS v4u*)(YSW + (m0 + row) * NP + h * SW_D + ch16 * 8); asm volatile("global_store_dwordx4 %0, %1, off sc1\n\ts_nop 2" :: "v"(dst), "v"(v) : "memory"); }
                else *(v4u*)(YSW + (m0 + row) * NP + h * SW_D + ch16 * 8) = v; }
            asm volatile("s_waitcnt lgkmcnt(0)" ::: "memory");
        }
    }
#if SEAM35
    asm volatile("s_waitcnt vmcnt(0)" ::: "memory");
    unsigned nun = 0u;
    for (int u = worker; u < BATCH * SW_H * (SEQ / 32); u += nworkers) { const int qblk = u & 127, b = u >> 10; ++nun;
        if (lane == 0) __hip_atomic_fetch_add(F.ctl + CW_PAN + 64 * (b * 16 + (qblk >> 3)) + 1, 1u, RLX_AGENT); }
    if (lane == 0 && nun) __hip_atomic_fetch_add(F.ctl + CW_SWADONE + 64 * (worker & 7), nun, RLX_AGENT);
#endif
}

constexpr int DNL_QT = 0, DNL_KT = 17408, DNL_VT = 34816, DNL_WL = 52224, DNL_NA = 69632, DNL_QKM = 78848, DNL_DB = 88064, DNL_TIB = 92160, DNL_GC = 94208, DNL_BETA = 94464;
constexpr int TP = 272;
constexpr int NP2 = 144;
struct DnRec { bf16* UA; bf16* UB; bf16* W; bf16* QG; bf16* KD; bf16* QK; float* EGL;
    __device__ __forceinline__ bf16* u(int ch, int sl, int mt, int lane) const { return (ch < 640 ? UA + (size_t)ch * 8192 : UB + (size_t)(ch - 640) * 8192) + ((sl * 4 + mt) * 64 + lane) * 4; } };
__device__ __forceinline__ DnRec dn_rec(Frame& F) {
    DnRec r; r.W = (bf16*)F.out; r.QG = r.W + 8 * 1024 * 1024; r.KD = r.W + 16 * 1024 * 1024; r.QK = r.W + 24 * 1024 * 1024; r.UA = r.W + 27 * 1024 * 1024; r.UB = (bf16*)(F.ws + WS_UB); r.EGL = (float*)(F.ws + WS_SSQ); return r;
}
#if STAMP_DN >= 0
__device__ unsigned long long g_dn[8];
#define DNSTAMP(i) if (blockIdx.x == STAMP_BLOCK && threadIdx.x == 0) { const unsigned long long now_ = __builtin_amdgcn_s_memrealtime(); dnacc_[i] += now_ - dnlast_; dnlast_ = now_; }
#else
#define DNSTAMP(i)
#endif
__device__ __forceinline__ void dn_chunk_prep(Frame& F) {
#if STAMP_DN >= 0
    unsigned long long dnacc_[8] = {0, 0, 0, 0, 0, 0, 0, 0}; unsigned long long dnlast_ = __builtin_amdgcn_s_memrealtime();
#endif
    const DnRec R = dn_rec(F);
    const bf16* proj = (const bf16*)(F.ws + WS_PROJ); const float* conv = FIN(3); const float* gbp = (const float*)(F.ws + WS_GB);
    LAS unsigned char* L = F.lds + RING_OFF;
    LAS float* GC = (LAS float*)(L + DNL_GC); LAS float* BETA = (LAS float*)(L + DNL_BETA); LAS float* DB = (LAS float*)(L + DNL_DB);
    const int lane = F.lane, wave = F.wave, r16 = lane & 15, g = lane >> 4;
    const int tk0 = 8 * wave;
    unsigned raw[3][11]; float gx, gbl;
#define DN_LOAD_INPUTS(ch_) do { const int bh_ = (ch_) >> 6, c_ = (ch_) & 63, b_ = bh_ >> 2, h_ = bh_ & 3; const size_t m0_ = (size_t)b_ * SEQ + 64 * c_; \
        gx = gbp[(m0_ + lane) * 8 + 4 + h_]; gbl = gbp[(m0_ + lane) * 8 + h_]; \
        _Pragma("unroll") for (int p = 0; p < 3; ++p) { const int col_ = p * DN_W + h_ * DN_D + 2 * lane; \
            _Pragma("unroll") for (int r = 0; r < 11; ++r) { const int tr_ = 64 * c_ + tk0 - 3 + r; raw[p][r] = *(const unsigned*)(proj + (m0_ - 64 * c_ + (tr_ < 0 ? 0 : tr_)) * NP + col_); } } } while (0)
#if DNA_PREFETCH
    if (F.vcu < 1024) DN_LOAD_INPUTS(F.vcu);
#endif
    for (int ch = F.vcu; ch < 1024; ch += F.G) {
        const int bh = ch >> 6, c = ch & 63, b = bh >> 2, h = bh & 3; const size_t m0 = (size_t)b * SEQ + 64 * c;
        {
#if !DNA_PREFETCH
            DN_LOAD_INPUTS(ch);
#endif
            float cw[3][4][2];
#pragma unroll
            for (int p = 0; p < 3; ++p) { const int col = p * DN_W + h * DN_D + 2 * lane;
#pragma unroll
                for (int j = 0; j < 4; ++j) { cw[p][j][0] = conv[j * DN_QKV + col]; cw[p][j][1] = conv[j * DN_QKV + col + 1]; } }
            if (wave == 0) { float x = gx;
#pragma unroll
                for (int off = 1; off < 64; off <<= 1) { const float t = __shfl_up(x, off); if (lane >= off) x += t; }
                GC[lane] = x; BETA[lane] = gbl; }
            if (64 * c + tk0 < 3) {
#pragma unroll
                for (int p = 0; p < 3; ++p)
#pragma unroll
                    for (int r = 0; r < 3; ++r) if (64 * c + tk0 - 3 + r < 0) raw[p][r] = 0u;
            }
#pragma unroll
            for (int hb = 0; hb < 2; ++hb) {
                float val[4][3][2], sq[4], sk[4];
#pragma unroll
                for (int i4 = 0; i4 < 4; ++i4) { const int i = 4 * hb + i4;
#pragma unroll
                    for (int p = 0; p < 3; ++p) { float a0 = 0.f, a1 = 0.f;
#pragma unroll
                        for (int j = 0; j < 4; ++j) { a0 += cw[p][j][0] * bflo(raw[p][i + j]); a1 += cw[p][j][1] * bfhi(raw[p][i + j]); }
                        val[i4][p][0] = a0 * sigm(a0); val[i4][p][1] = a1 * sigm(a1); }
                    sq[i4] = val[i4][0][0] * val[i4][0][0] + val[i4][0][1] * val[i4][0][1]; sk[i4] = val[i4][1][0] * val[i4][1][0] + val[i4][1][1] * val[i4][1][1]; }
#pragma unroll
                for (int i4 = 0; i4 < 4; ++i4) { sq[i4] = wave_sum(sq[i4]); sk[i4] = wave_sum(sk[i4]); }
#pragma unroll
                for (int i4 = 0; i4 < 4; ++i4) {
                    const float rq = frsq(sq[i4] + EPS) * 0.08838834764831845f, rk = frsq(sk[i4] + EPS);
                    const int o = (tk0 + 4 * hb + i4) * TP + 4 * lane;
                    *(LAS unsigned*)(L + DNL_QT + o) = cvtpk(val[i4][0][0] * rq, val[i4][0][1] * rq);
                    *(LAS unsigned*)(L + DNL_KT + o) = cvtpk(val[i4][1][0] * rk, val[i4][1][1] * rk);
                    *(LAS unsigned*)(L + DNL_VT + o) = cvtpk(val[i4][2][0], val[i4][2][1]);
                }
            }
        }
        __syncthreads(); DNSTAMP(0)
#pragma unroll
        for (int k_ = 0; k_ < 3; ++k_) { const int id = wave + 8 * k_; if (id < 20) {
            const int e = id % 10, isqk = (id / 10) & 1, ti = (e >= 6) ? 3 : (e >= 3) ? 2 : (e >= 1) ? 1 : 0, tj = e - ti * (ti + 1) / 2;
            f32x4 acc = {0.f, 0.f, 0.f, 0.f};
            const int xoff = isqk ? DNL_QT : DNL_KT;
#pragma unroll
            for (int ks = 0; ks < 4; ++ks) {
                const bf16x8 a = *(const LAS bf16x8*)(L + DNL_KT + (16 * tj + r16) * TP + (32 * ks + 8 * g) * 2);
                const bf16x8 bq = *(const LAS bf16x8*)(L + xoff + (16 * ti + r16) * TP + (32 * ks + 8 * g) * 2);
                acc = MFMA16(a, bq, acc); }
            const int i = 16 * ti + r16; const float gi = GC[i], bi = BETA[i]; const f32x4 gj = *(const LAS f32x4*)(GC + 16 * tj + 4 * g);
            f32x4 v;
#pragma unroll
            for (int r = 0; r < 4; ++r) { const int jp = 16 * tj + 4 * g + r; const float d = __expf(fminf(gi - gj[r], 0.f));
                v[r] = isqk ? ((i >= jp) ? acc[r] * d : 0.f) : ((i > jp) ? bi * acc[r] * d : 0.f); }
            if (!isqk) {
                u32x2 w; w.x = cvtpk(-v[0], -v[1]); w.y = cvtpk(-v[2], -v[3]);
                *(LAS u32x2*)(L + DNL_NA + i * NP2 + (16 * tj + 4 * g) * 2) = w;
                if (ti == tj) *(LAS f32x4*)(DB + (ti * 16 + r16) * 16 + 4 * g) = v;
            } else { u32x2 w; w.x = cvtpk(v[0], v[1]); w.y = cvtpk(v[2], v[3]); *(LAS u32x2*)(L + DNL_QKM + i * NP2 + (16 * tj + 4 * g) * 2) = w; }
        } }
        __syncthreads(); DNSTAMP(1)
        if (wave < 4) {
            const int I = wave; float x[16];
#pragma unroll
            for (int i = 0; i < 16; ++i) { float a = (i == r16) ? 1.f : 0.f;
#pragma unroll
                for (int j4 = 0; j4 < (i + 3) / 4; ++j4) { const f32x4 d = *(const LAS f32x4*)(DB + (I * 16 + i) * 16 + 4 * j4);
#pragma unroll
                    for (int jj = 0; jj < 4; ++jj) if (4 * j4 + jj < i) a -= d[jj] * x[4 * j4 + jj]; }
                x[i] = a; }
            if (lane < 16) {
#pragma unroll
                for (int i = 0; i < 16; ++i) *(LAS unsigned short*)(L + DNL_TIB + ((I * 16 + i) * 16 + r16) * 2) = (unsigned short)(cvtpk(x[i], 0.f) & 0xffffu);
            }
        } else {
            const int w4 = wave - 4;
            {
                const int mt = w4; const float e = __expf(GC[16 * mt + r16]); const int base = DNL_QT + (16 * mt + r16) * TP;
                u32x2 lo[4], hi[4];
#pragma unroll
                for (int ks = 0; ks < 4; ++ks) { lo[ks] = *(const LAS u32x2*)(L + base + (32 * ks + 4 * g) * 2); hi[ks] = *(const LAS u32x2*)(L + base + (32 * ks + 16 + 4 * g) * 2); }
#pragma unroll
                for (int ks = 0; ks < 4; ++ks) { v4u w; w.x = cvtpk(bflo(lo[ks].x) * e, bfhi(lo[ks].x) * e); w.y = cvtpk(bflo(lo[ks].y) * e, bfhi(lo[ks].y) * e); w.z = cvtpk(bflo(hi[ks].x) * e, bfhi(hi[ks].x) * e); w.w = cvtpk(bflo(hi[ks].y) * e, bfhi(hi[ks].y) * e);
                    *(v4u*)(R.QG + ((size_t)(ch * 16 + mt * 4 + ks) * 64 + lane) * 8) = w; }
            }
            {
                const float gl = GC[63]; float ed[2][8];
#pragma unroll
                for (int kt = 0; kt < 2; ++kt)
#pragma unroll
                    for (int j = 0; j < 8; ++j) { const int tok = 32 * kt + (j < 4 ? 4 * g + j : 16 + 4 * g + j - 4); ed[kt][j] = __expf(gl - GC[tok]); }
#pragma unroll
                for (int i = 0; i < 4; ++i) { const int f = 4 * w4 + i, mt8 = f >> 1, kt = i & 1, dk = 16 * mt8 + r16; float v[8];
#pragma unroll
                    for (int j = 0; j < 8; ++j) { const int tok = 32 * kt + (j < 4 ? 4 * g + j : 16 + 4 * g + j - 4); v[j] = bf1(*(const LAS unsigned short*)(L + DNL_KT + tok * TP + dk * 2)) * ed[kt][j]; }
                    v4u w; w.x = cvtpk(v[0], v[1]); w.y = cvtpk(v[2], v[3]); w.z = cvtpk(v[4], v[5]); w.w = cvtpk(v[6], v[7]);
                    *(v4u*)(R.KD + ((size_t)(ch * 16 + f) * 64 + lane) * 8) = w; }
            }
#pragma unroll
            for (int i = 0; i < 2; ++i) { const int q = w4 + 4 * i;
                if (q < 6) { const int mt = (q == 0) ? 0 : (q == 1) ? 1 : (q < 4) ? 2 : 3, kt = (q == 3 || q == 5) ? 1 : 0;
                    const u32x2 lo = *(const LAS u32x2*)(L + DNL_QKM + (16 * mt + r16) * NP2 + (32 * kt + 4 * g) * 2);
                    u32x2 hi = {0u, 0u}; if (2 * kt + 1 <= mt) hi = *(const LAS u32x2*)(L + DNL_QKM + (16 * mt + r16) * NP2 + (32 * kt + 16 + 4 * g) * 2);
                    const v4u w = {lo.x, lo.y, hi.x, hi.y};
                    *(v4u*)(R.QK + ((size_t)(ch * 6 + q) * 64 + lane) * 8) = w; } }
            if (lane == 0 && w4 == 0) R.EGL[ch] = __expf(GC[63]);
        }
        __syncthreads(); DNSTAMP(2)
#if DNA_PREFETCH
        if (ch + F.G < 1024) DN_LOAD_INPUTS(ch + F.G);
#endif
        {
            const int part = wave >> 2, colbase = 32 * (wave & 3);
            f32x4 rhs[4][2];
#pragma unroll
            for (int I = 0; I < 4; ++I) { float sc[4];
#pragma unroll
                for (int r = 0; r < 4; ++r) { const int tok = 16 * I + 4 * g + r; sc[r] = part == 0 ? BETA[tok] : -(BETA[tok] * __expf(GC[tok])); }
#pragma unroll
                for (int nt = 0; nt < 2; ++nt) { const int col = colbase + 16 * nt + r16;
#pragma unroll
                    for (int r = 0; r < 4; ++r) { const int tok = 16 * I + 4 * g + r; rhs[I][nt][r] = sc[r] * bf1(*(const LAS unsigned short*)(L + (part == 0 ? DNL_VT : DNL_KT) + tok * TP + col * 2)); } } }
            u32x2 na10, na20l, na20h, na30l, na30h, na31l, ti[4];
            na10 = *(const LAS u32x2*)(L + DNL_NA + (16 * 1 + r16) * NP2 + (4 * g) * 2);
            na20l = *(const LAS u32x2*)(L + DNL_NA + (16 * 2 + r16) * NP2 + (4 * g) * 2); na20h = *(const LAS u32x2*)(L + DNL_NA + (16 * 2 + r16) * NP2 + (16 + 4 * g) * 2);
            na30l = *(const LAS u32x2*)(L + DNL_NA + (16 * 3 + r16) * NP2 + (4 * g) * 2); na30h = *(const LAS u32x2*)(L + DNL_NA + (16 * 3 + r16) * NP2 + (16 + 4 * g) * 2);
            na31l = *(const LAS u32x2*)(L + DNL_NA + (16 * 3 + r16) * NP2 + (32 + 4 * g) * 2);
#pragma unroll
            for (int I = 0; I < 4; ++I) ti[I] = *(const LAS u32x2*)(L + DNL_TIB + ((I * 16 + r16) * 16 + 4 * g) * 2);
            const bf16x8 A10 = __builtin_bit_cast(bf16x8, (v4u){na10.x, na10.y, 0u, 0u}), A20 = __builtin_bit_cast(bf16x8, (v4u){na20l.x, na20l.y, na20h.x, na20h.y}),
                         A30 = __builtin_bit_cast(bf16x8, (v4u){na30l.x, na30l.y, na30h.x, na30h.y}), A31 = __builtin_bit_cast(bf16x8, (v4u){na31l.x, na31l.y, 0u, 0u});
            const f32x4 zero = {0.f, 0.f, 0.f, 0.f};
            f32x4 X[2][4];
#pragma unroll
            for (int nt = 0; nt < 2; ++nt) {
                X[nt][0] = MFMA16(__builtin_bit_cast(bf16x8, (v4u){ti[0].x, ti[0].y, 0u, 0u}), pack8z(rhs[0][nt]), zero);
                f32x4 a1 = MFMA16(A10, pack8z(X[nt][0]), rhs[1][nt]);
                X[nt][1] = MFMA16(__builtin_bit_cast(bf16x8, (v4u){ti[1].x, ti[1].y, 0u, 0u}), pack8z(a1), zero);
                f32x4 a2 = MFMA16(A20, pack8(X[nt][0], X[nt][1]), rhs[2][nt]);
                X[nt][2] = MFMA16(__builtin_bit_cast(bf16x8, (v4u){ti[2].x, ti[2].y, 0u, 0u}), pack8z(a2), zero);
                f32x4 a3 = MFMA16(A30, pack8(X[nt][0], X[nt][1]), rhs[3][nt]); a3 = MFMA16(A31, pack8z(X[nt][2]), a3);
                X[nt][3] = MFMA16(__builtin_bit_cast(bf16x8, (v4u){ti[3].x, ti[3].y, 0u, 0u}), pack8z(a3), zero);
            }
#pragma unroll
            for (int nt = 0; nt < 2; ++nt)
#pragma unroll
                for (int I = 0; I < 4; ++I) {
                    if (part == 0) { u32x2 w; w.x = cvtpk(X[nt][I][0], X[nt][I][1]); w.y = cvtpk(X[nt][I][2], X[nt][I][3]); *(u32x2*)R.u(ch, 2 * (wave & 3) + nt, I, lane) = w; }
                    else { const int col = colbase + 16 * nt + r16;
#pragma unroll
                        for (int r = 0; r < 4; ++r) *(LAS unsigned short*)(L + DNL_WL + (16 * I + 4 * g + r) * TP + col * 2) = (unsigned short)(cvtpk(X[nt][I][r], 0.f) & 0xffffu); }
                }
        }
        __syncthreads(); DNSTAMP(3)
        {
            const int mt = wave >> 1, base = DNL_WL + (16 * mt + r16) * TP;
            u32x2 lo[2], hi[2];
#pragma unroll
            for (int i = 0; i < 2; ++i) { const int ks = 2 * (wave & 1) + i; lo[i] = *(const LAS u32x2*)(L + base + (32 * ks + 4 * g) * 2); hi[i] = *(const LAS u32x2*)(L + base + (32 * ks + 16 + 4 * g) * 2); }
#pragma unroll
            for (int i = 0; i < 2; ++i) { const int ks = 2 * (wave & 1) + i; const v4u w = {lo[i].x, lo[i].y, hi[i].x, hi[i].y}; *(v4u*)(R.W + ((size_t)(ch * 16 + mt * 4 + ks) * 64 + lane) * 8) = w; }
        }
        __syncthreads(); DNSTAMP(4)
    }
#if STAMP_DN >= 0
    if (blockIdx.x == STAMP_BLOCK && threadIdx.x == 0) { for (int i = 0; i < 8; ++i) g_dn[i] = dnacc_[i]; }
#endif
}
__device__ __forceinline__ void dn_out2(Frame& F, int worker, int nworkers, int task_lo = 0, int task_hi = 4096) {
    const DnRec R = dn_rec(F);
    const int lane = F.lane, r16 = lane & 15, g = lane >> 4;
    bf16* proj = (bf16*)(F.ws + WS_PROJ); const float* gain = FIN(6);
    int pub_pm = -1;
    for (int task = worker; task < (DNO_SKIPALL ? 0 : task_hi); task += nworkers) {
        if (task < task_lo) continue;
        const int c = task >> 6, bh = (task >> 2) & 15, mt = task & 3, ch = bh * 64 + c, b = bh >> 2, h = bh & 3;
        {   gu32* f0 = F.ctl + CW_SCAN + 64 * (bh * 2);
            for (unsigned sp = 0;; ++sp) {
                const unsigned p0 = (unsigned)__builtin_amdgcn_readfirstlane((int)__hip_atomic_load(f0, RLX_AGENT)), p1 = (unsigned)__builtin_amdgcn_readfirstlane((int)__hip_atomic_load(f0 + 64, RLX_AGENT));
                if ((p0 < p1 ? p0 : p1) > (unsigned)(c + DNO_LAG < 63 ? c + DNO_LAG : 63) || sp > (1u << 16)) break;
                __builtin_amdgcn_s_sleep(DNO_SLEEP);
            }
            if (DNO_FENCE) __builtin_amdgcn_fence(__ATOMIC_ACQUIRE, "agent"); else asm volatile("" ::: "memory"); }
        if (DNO_SKIPWORK) continue;
        if (SEAM35 && pub_pm >= 0) { asm volatile("s_waitcnt vmcnt(0)" ::: "memory"); if (lane == 0) __hip_atomic_fetch_add(F.ctl + CW_PAN + 64 * pub_pm, 1u, RLX_AGENT); }
        pub_pm = (bh >> 2) * 16 + (c >> 2);
        f32x4 o[8]; float ss[4] = {0.f, 0.f, 0.f, 0.f};
#pragma unroll
        for (int sl = 0; sl < 8; ++sl) { u32x2 w;
            if (DNO_FENCE) w = *(const u32x2*)R.u(ch, sl, mt, lane);
            else { const unsigned long long q = __hip_atomic_load((GAS unsigned long long*)R.u(ch, sl, mt, lane), RLX_AGENT); w.x = (unsigned)q; w.y = (unsigned)(q >> 32); }
            o[sl] = (f32x4){bflo(w.x), bfhi(w.x), bflo(w.y), bfhi(w.y)};
#pragma unroll
            for (int r = 0; r < 4; ++r) ss[r] += o[sl][r] * o[sl][r]; }
#pragma unroll
        for (int r = 0; r < 4; ++r) { float s = sum16(ss[r]); ss[r] = frsq(s * (1.0f / DN_D) + EPS); }
        float gdv[8];
#pragma unroll
        for (int sl = 0; sl < 8; ++sl) gdv[sl] = gain[16 * sl + r16];
        unsigned short zz[8][4];
#pragma unroll
        for (int sl = 0; sl < 8; ++sl)
#pragma unroll
            for (int r = 0; r < 4; ++r) zz[sl][r] = proj[((size_t)b * SEQ + 64 * c + 16 * mt + 4 * g + r) * NP + PC_Z + h * DN_D + 16 * sl + r16];
#if DNO_STAGE
        {   LAS unsigned char* stg = F.lds + RING_OFF + F.wave * 16384;
#pragma unroll
            for (int sl = 0; sl < 8; ++sl) { const float gd = gdv[sl];
#pragma unroll
                for (int r = 0; r < 4; ++r) { const float z = bf1(zz[sl][r]);
                    *(LAS unsigned short*)(stg + (4 * g + r) * 272 + (16 * sl + r16) * 2) = (unsigned short)(cvtpk(o[sl][r] * ss[r] * gd * z * sigm(z), 0.f) & 0xffffu); } }
            asm volatile("s_waitcnt lgkmcnt(0)" ::: "memory");
            const size_t m0 = (size_t)b * SEQ + 64 * c + 16 * mt;
#pragma unroll
            for (int i = 0; i < 4; ++i) { const int q = lane + 64 * i, row = q >> 4, cc = q & 15; const v4u v = *(const LAS v4u*)(stg + row * 272 + cc * 16);
                GAS v4u* dst = (GAS v4u*)(proj + (m0 + row) * NP + PC_YDN + h * DN_D + cc * 8);
                asm volatile("global_store_dwordx4 %0, %1, off sc1\n\ts_nop 2" :: "v"(dst), "v"(v) : "memory"); }
            asm volatile("s_waitcnt lgkmcnt(0)" ::: "memory");
        }
#else
#pragma unroll
        for (int sl = 0; sl < 8; ++sl) { const int d = 16 * sl + r16; const float gd = gdv[sl];
#pragma unroll
            for (int r = 0; r < 4; ++r) { const size_t m = (size_t)b * SEQ + 64 * c + 16 * mt + 4 * g + r; const float z = bf1(zz[sl][r]);
                proj[m * NP + PC_YDN + h * DN_D + d] = (bf16)(cvtpk(o[sl][r] * ss[r] * gd * z * sigm(z), 0.f) & 0xffffu); } }
#endif
    }
    if (SEAM35 && pub_pm >= 0) { asm volatile("s_waitcnt vmcnt(0)" ::: "memory"); if (lane == 0) __hip_atomic_fetch_add(F.ctl + CW_PAN + 64 * pub_pm, 1u, RLX_AGENT); }
    if (SEAM78 && lane == 0) { unsigned nt_ = 0u; for (int task = worker; task < task_hi; task += nworkers) if (task >= task_lo) ++nt_;
        if (nt_) __hip_atomic_fetch_add(F.ctl + CW_NORMDONE + 64 * (worker & 7), nt_, RLX_AGENT); }
}
constexpr int SCAN_H0 = 32768, SCAN_H1 = 24576;
__device__ __forceinline__ void dn_scan_wg(Frame& F, int bh, int half) {
    const DnRec R = dn_rec(F);
    const int lane = F.lane, wave = F.wave;
    LAS unsigned char* ring = F.lds + RING_OFF;
    if (wave >= 4) {
        const int lw = wave - 4;
        v4u r0[8], r1[6], r2[8], r3[6];
#if SCAN_SETS == 6
        v4u r4[8], r5[6];
#endif
#define LD_H0(set_, k_) do { const int ch_ = bh * 64 + ((k_) >> 1); _Pragma("unroll") for (int i_ = 0; i_ < 8; ++i_) { const int p_ = lw + 4 * i_; \
            const bf16* src_ = p_ < 16 ? R.W + (size_t)ch_ * 8192 + p_ * 512 : R.QG + (size_t)ch_ * 8192 + (p_ - 16) * 512; set_[i_] = SCAN_NT ? __builtin_nontemporal_load((const v4u*)(src_ + lane * 8)) : *(const v4u*)(src_ + lane * 8); } } while (0)
#define LD_H1(set_, k_) do { const int ch_ = bh * 64 + ((k_) >> 1); _Pragma("unroll") for (int i_ = 0; i_ < 6; ++i_) { const int p_ = lw + 4 * i_, q_ = p_ < 22 ? p_ : p_ - 22; \
            const bf16* src_ = q_ < 6 ? R.QK + (size_t)ch_ * 3072 + q_ * 512 : R.KD + (size_t)ch_ * 8192 + (q_ - 6) * 512; set_[i_] = SCAN_NT ? __builtin_nontemporal_load((const v4u*)(src_ + lane * 8)) : *(const v4u*)(src_ + lane * 8); } } while (0)
#define ST_H0(set_, k_) do { LAS unsigned char* slot_ = ring + (((k_) >> 1) & 1) * (SCAN_H0 + SCAN_H1) + lane * 16; _Pragma("unroll") for (int i_ = 0; i_ < 8; ++i_) *(LAS v4u*)(slot_ + (lw + 4 * i_) * 1024) = set_[i_]; } while (0)
#define ST_H1(set_, k_) do { LAS unsigned char* slot_ = ring + (((k_) >> 1) & 1) * (SCAN_H0 + SCAN_H1) + SCAN_H0 + lane * 16; _Pragma("unroll") for (int i_ = 0; i_ < 6; ++i_) *(LAS v4u*)(slot_ + (lw + 4 * i_) * 1024) = set_[i_]; } while (0)
#define LD_BAR() do { asm volatile("s_waitcnt lgkmcnt(0)" ::: "memory"); __builtin_amdgcn_s_barrier(); asm volatile("" ::: "memory"); } while (0)
#if SCAN_SETS == 6
        LD_H0(r0, 0); LD_H1(r1, 1); LD_H0(r2, 2); LD_H1(r3, 3); LD_H0(r4, 4); LD_H1(r5, 5);
        ST_H0(r0, 0); LD_H0(r0, 6); ST_H1(r1, 1); LD_H1(r1, 7); ST_H0(r2, 2); LD_H0(r2, 8);
        for (int k = 0; k < 128; k += 6) {
            if (k + 0 < 128) { LD_BAR(); if (k + 3 < 128) { ST_H1(r3, k + 3); if (k + 9 < 128) LD_H1(r3, k + 9); } }
            if (k + 1 < 128) { LD_BAR(); if (k + 4 < 128) { ST_H0(r4, k + 4); if (k + 10 < 128) LD_H0(r4, k + 10); } }
            if (k + 2 < 128) { LD_BAR(); if (k + 5 < 128) { ST_H1(r5, k + 5); if (k + 11 < 128) LD_H1(r5, k + 11); } }
            if (k + 3 < 128) { LD_BAR(); if (k + 6 < 128) { ST_H0(r0, k + 6); if (k + 12 < 128) LD_H0(r0, k + 12); } }
            if (k + 4 < 128) { LD_BAR(); if (k + 7 < 128) { ST_H1(r1, k + 7); if (k + 13 < 128) LD_H1(r1, k + 13); } }
            if (k + 5 < 128) { LD_BAR(); if (k + 8 < 128) { ST_H0(r2, k + 8); if (k + 14 < 128) LD_H0(r2, k + 14); } }
        }
#else
        LD_H0(r0, 0); LD_H1(r1, 1); LD_H0(r2, 2); LD_H1(r3, 3);
        ST_H0(r0, 0); LD_H0(r0, 4); ST_H1(r1, 1); LD_H1(r1, 5); ST_H0(r2, 2); LD_H0(r2, 6);
#define PUB(k_) do { if (SCAN_PUBLISH && SCAN_PUB_LOADER && lw == 0 && lane == 0 && (k_) >= 4 && (((k_) >> 1) % SCAN_PUB_EVERY) == 0) asm volatile("global_store_dword %0, %1, off sc1" :: "v"(F.ctl + CW_SCAN + 64 * (bh * 2 + half)), "v"((unsigned)(((k_) >> 1) - 1)) : "memory"); } while (0)
        for (int k = 0; k < 128; k += 4) {
            LD_BAR(); PUB(k); ST_H1(r3, k + 3); if (k + 7 < 128) LD_H1(r3, k + 7);
            LD_BAR(); if (k + 4 < 128) { ST_H0(r0, k + 4); if (k + 8 < 128) LD_H0(r0, k + 8); }
            LD_BAR(); PUB(k + 2); if (k + 5 < 128) { ST_H1(r1, k + 5); if (k + 9 < 128) LD_H1(r1, k + 9); }
            LD_BAR(); if (k + 6 < 128) { ST_H0(r2, k + 6); if (k + 10 < 128) LD_H0(r2, k + 10); }
        }
#endif
#undef LD_H0
#undef LD_H1
#undef ST_H0
#undef ST_H1
#undef LD_BAR
#undef PUB
    } else {
        const int sl = half * 4 + wave;
        f32x4 S[8];
#pragma unroll
        for (int i = 0; i < 8; ++i) S[i] = (f32x4){0.f, 0.f, 0.f, 0.f};
        constexpr int UPRE = SCAN_UPRE;
        u32x2 Uq[UPRE][4]; float eq[UPRE];
#pragma unroll
        for (int d = 0; d < UPRE; ++d) { eq[d] = R.EGL[bh * 64 + d];
#pragma unroll
            for (int mt = 0; mt < 4; ++mt) Uq[d][mt] = *(const u32x2*)R.u(bh * 64 + d, sl, mt, lane); }
        for (int c4 = 0; c4 < 64; c4 += UPRE) {
#pragma unroll
        for (int j4 = 0; j4 < UPRE; ++j4) {
            const int c = c4 + j4, ch = bh * 64 + c;
            const LAS unsigned char* h0 = ring + (c & 1) * (SCAN_H0 + SCAN_H1) + lane * 16; const LAS unsigned char* h1 = h0 + SCAN_H0;
            asm volatile("s_waitcnt lgkmcnt(0)" ::: "memory");
            __builtin_amdgcn_s_barrier();
            asm volatile("" ::: "memory");
#if SCAN_PUBLISH && !SCAN_PUB_LOADER
            if (wave == 0 && c >= 2 && lane == 0) __hip_atomic_store(F.ctl + CW_SCAN + 64 * (bh * 2 + half), (unsigned)(c - 1), RLX_AGENT);
#endif
            bf16x8 fa[16];
#pragma unroll
            for (int f = 0; f < 16; ++f) fa[f] = *(const LAS bf16x8*)(h0 + f * 1024);
#if SCAN_QG_EARLY
            bf16x8 fb[8];
#pragma unroll
            for (int f = 0; f < 8; ++f) fb[f] = *(const LAS bf16x8*)(h0 + 16384 + f * 1024);
#endif
            bf16x8 Sb[4];
#pragma unroll
            for (int ks = 0; ks < 4; ++ks) Sb[ks] = pack8(S[2 * ks], S[2 * ks + 1]);
            const float egl = eq[j4];
            u32x2 Uf[4];
#pragma unroll
            for (int mt = 0; mt < 4; ++mt) Uf[mt] = Uq[j4][mt];
            __builtin_amdgcn_sched_barrier(0);
            f32x4 vn[4], o[4];
#pragma unroll
            for (int mt = 0; mt < 4; ++mt) { vn[mt] = (f32x4){bflo(Uf[mt].x), bfhi(Uf[mt].x), bflo(Uf[mt].y), bfhi(Uf[mt].y)};
#pragma unroll
                for (int ks = 0; ks < 4; ++ks) vn[mt] = MFMA16(fa[mt * 4 + ks], Sb[ks], vn[mt]); }
            __builtin_amdgcn_sched_barrier(0);
#if SCAN_QG_EARLY
#pragma unroll
            for (int f = 8; f < 16; ++f) fa[f] = *(const LAS bf16x8*)(h0 + 16384 + f * 1024);
            __builtin_amdgcn_sched_barrier(0);
#pragma unroll
            for (int mt = 0; mt < 2; ++mt) { o[mt] = (f32x4){0.f, 0.f, 0.f, 0.f};
#pragma unroll
                for (int ks = 0; ks < 4; ++ks) o[mt] = MFMA16(fb[mt * 4 + ks], Sb[ks], o[mt]); }
#pragma unroll
            for (int mt = 2; mt < 4; ++mt) { o[mt] = (f32x4){0.f, 0.f, 0.f, 0.f};
#pragma unroll
                for (int ks = 0; ks < 4; ++ks) o[mt] = MFMA16(fa[mt * 4 + ks], Sb[ks], o[mt]); }
#else
#pragma unroll
            for (int f = 0; f < 16; ++f) fa[f] = *(const LAS bf16x8*)(h0 + 16384 + f * 1024);
            __builtin_amdgcn_sched_barrier(0);
#pragma unroll
            for (int mt = 0; mt < 4; ++mt) { o[mt] = (f32x4){0.f, 0.f, 0.f, 0.f};
#pragma unroll
                for (int ks = 0; ks < 4; ++ks) o[mt] = MFMA16(fa[mt * 4 + ks], Sb[ks], o[mt]); }
#endif
            const bf16x8 vb0 = pack8(vn[0], vn[1]), vb1 = pack8(vn[2], vn[3]);
#if !SCAN_PUBLISH || !SCAN_REFILL_LATE
            { const int cn = (c + UPRE < 64) ? c + UPRE : 63;
#pragma unroll
                for (int mt = 0; mt < 4; ++mt) Uq[j4][mt] = *(const u32x2*)R.u(bh * 64 + cn, sl, mt, lane);
                eq[j4] = R.EGL[bh * 64 + cn]; }
#endif
            asm volatile("s_waitcnt lgkmcnt(0)" ::: "memory");
            __builtin_amdgcn_s_barrier();
            asm volatile("" ::: "memory");
            bf16x8 fq_[6];
#pragma unroll
            for (int f = 0; f < 6; ++f) fq_[f] = *(const LAS bf16x8*)(h1 + f * 1024);
#pragma unroll
            for (int f = 0; f < 16; ++f) fa[f] = *(const LAS bf16x8*)(h1 + 6144 + f * 1024);
            __builtin_amdgcn_sched_barrier(0);
            o[0] = MFMA16(fq_[0], vb0, o[0]); o[1] = MFMA16(fq_[1], vb0, o[1]);
            o[2] = MFMA16(fq_[2], vb0, o[2]); o[2] = MFMA16(fq_[3], vb1, o[2]);
            o[3] = MFMA16(fq_[4], vb0, o[3]); o[3] = MFMA16(fq_[5], vb1, o[3]);
#pragma unroll
            for (int i = 0; i < 8; ++i) { S[i] = S[i] * egl; S[i] = MFMA16(fa[2 * i], vb0, S[i]); S[i] = MFMA16(fa[2 * i + 1], vb1, S[i]); }
#if SCAN_PUBLISH
#if !SCAN_DRAIN_NONE
            VM_WAIT();
#endif
#if SCAN_O16
#pragma unroll
            for (int p2 = 0; p2 < 2; ++p2) {
                const unsigned a0 = cvtpk(o[2 * p2][0], o[2 * p2][1]), a1 = cvtpk(o[2 * p2][2], o[2 * p2][3]), b0 = cvtpk(o[2 * p2 + 1][0], o[2 * p2 + 1][1]), b1 = cvtpk(o[2 * p2 + 1][2], o[2 * p2 + 1][3]);
                const bool odd = (lane & 1) != 0;
                const unsigned r0 = (unsigned)__builtin_amdgcn_update_dpp(0, (int)(odd ? a0 : b0), 0xB1, 0xf, 0xf, true), r1 = (unsigned)__builtin_amdgcn_update_dpp(0, (int)(odd ? a1 : b1), 0xB1, 0xf, 0xf, true);
                v4u w; w.x = odd ? r0 : a0; w.y = odd ? r1 : a1; w.z = odd ? b0 : r0; w.w = odd ? b1 : r1;
                GAS v4u* dst = (GAS v4u*)R.u(ch, sl, 2 * p2 + (odd ? 1 : 0), lane & ~1);
                asm volatile("global_store_dwordx4 %0, %1, off sc1\n\ts_nop 2" :: "v"(dst), "v"(w) : "memory"); }
#else
#pragma unroll
            for (int mt = 0; mt < 4; ++mt) { const unsigned long long w = (unsigned long long)cvtpk(o[mt][0], o[mt][1]) | ((unsigned long long)cvtpk(o[mt][2], o[mt][3]) << 32);
                if (SCAN_O_SC1) __hip_atomic_store((GAS unsigned long long*)R.u(ch, sl, mt, lane), w, RLX_AGENT); else *(unsigned long long*)R.u(ch, sl, mt, lane) = w; }
#endif
            if (SCAN_REFILL_LATE) { const int cn = (c + UPRE < 64) ? c + UPRE : 63;
#pragma unroll
                for (int mt = 0; mt < 4; ++mt) Uq[j4][mt] = *(const u32x2*)R.u(bh * 64 + cn, sl, mt, lane);
                eq[j4] = R.EGL[bh * 64 + cn]; }
#else
#pragma unroll
            for (int mt = 0; mt < 4; ++mt) { u32x2 w; w.x = cvtpk(o[mt][0], o[mt][1]); w.y = cvtpk(o[mt][2], o[mt][3]); *(u32x2*)R.u(ch, sl, mt, lane) = w; }
#endif
        }
        }
    }
#if SCAN_PUBLISH
    VM_WAIT(); __syncthreads();
    if (F.tid == 0) __hip_atomic_store(F.ctl + CW_SCAN + 64 * (bh * 2 + half), 64u, RLX_AGENT);
#endif
}
__device__ unsigned long long g_ts[16];
__device__ __forceinline__ void run_phase0(Frame& F0) {
    Frame F = F0; asm volatile("" : "+v"(F.tid)); F.lane = F.tid & 63;
    unsigned char* ws = F.ws; bf16* XB = (bf16*)(ws + WS_XB); bf16* Y = (bf16*)(ws + WS_Y); bf16* PROJ = (bf16*)(ws + WS_PROJ); (void)XB; (void)Y; (void)PROJ;
        p0_prologue(F);
}
__device__ __forceinline__ void run_phase1(Frame& F0) {
    Frame F = F0; asm volatile("" : "+v"(F.tid)); F.lane = F.tid & 63;
    unsigned char* ws = F.ws; bf16* XB = (bf16*)(ws + WS_XB); bf16* Y = (bf16*)(ws + WS_Y); bf16* PROJ = (bf16*)(ws + WS_PROJ); (void)XB; (void)Y; (void)PROJ;
        const int N1 = (F.G == 256) ? P1_TILES * 256 : NP;
        pg8::Gemm g{XB, (const bf16*)(ws + WS_WIN), M, N1, D}; pg8::StaticOrder S; S.init(M, N1, F.G, (int)blockIdx.x);
        pg8::EpiProj E{PROJ, NP, (const float*)(ws + WS_RSTD), PC_G / 256, 0, FUSE_QKNORM ? Y + (size_t)M * SW_W : nullptr, Y, FIN(7), FIN(8), PC_SQ / 256, PC_SK / 256, 0.125f * 1.4426950408889634f, SEQ};
        pg8::gemm_phase<pg8::EpiProj, pg8::StaticOrder, ALIGN_P1, true>(F.lds + RING_OFF, g, S, E);
}
__device__ __forceinline__ void run_phase2(Frame& F0) {
    Frame F = F0; asm volatile("" : "+v"(F.tid)); F.lane = F.tid & 63;
    unsigned char* ws = F.ws; bf16* XB = (bf16*)(ws + WS_XB); bf16* Y = (bf16*)(ws + WS_Y); bf16* PROJ = (bf16*)(ws + WS_PROJ); (void)XB; (void)Y; (void)PROJ;
#if FAST_DN
        SUBSTAMP(0) for (int rep_ = 0; rep_ < REP_DNA; ++rep_) dn_chunk_prep(F); SUBSTAMP(1)
#else
        dn_pre(F);
#endif
#if FAST_SWA
        for (int rep_ = 0; rep_ < REP_SWAPRE; ++rep_) swa_pre(F); SUBSTAMP(2)
#endif
}
__device__ __forceinline__ void run_phase3(Frame& F0) {
    Frame F = F0; asm volatile("" : "+v"(F.tid)); F.lane = F.tid & 63;
    unsigned char* ws = F.ws; bf16* XB = (bf16*)(ws + WS_XB); bf16* Y = (bf16*)(ws + WS_Y); bf16* PROJ = (bf16*)(ws + WS_PROJ); (void)XB; (void)Y; (void)PROJ;
#if FAST_DN
        if (F.G == 256) {
            const int bx = (int)blockIdx.x;
            SUBSTAMP(3)
            if (((bx >> 3) & 7) == 0) {
                const int xcd = bx & 7, j = bx >> 6;
                if (!P3_SKIP_SCAN) dn_scan_wg(F, xcd * 2 + (j >> 1), j & 1);
                SUBSTAMP(4)
            } else if (!P3_SKIP_GEMM) {
                const int gi = (bx >> 6) * 56 + (bx & 63) - 8, NG = NP - P1_TILES * 256;
#if P3_ORDER == 1
                if (DEFER_WEIGHTS) { weight_copies(F, WI_P0, WI_ALL, gi * NWAVES + F.wave, 224 * NWAVES); __syncthreads(); }
                swa_bias_table(F); __syncthreads();
                swa_main(F, gi * NWAVES + F.wave, 224 * NWAVES);
                __syncthreads();
#endif
                pg8::Gemm g{XB, (const bf16*)(ws + WS_WIN) + (size_t)P1_TILES * 256 * D, M, NG, D}; pg8::StaticOrder S; S.init(M, NG, 224, gi);
                pg8::EpiProj E{PROJ, NP, (const float*)(ws + WS_RSTD), PC_G / 256, P1_TILES, nullptr, nullptr, nullptr, nullptr, 0, 0, 0.f, SEQ, SEAM35};
                pg8::gemm_phase<pg8::EpiProj, pg8::StaticOrder, true, true>(F.lds + RING_OFF, g, S, E);
                if (SEAM35 && F.tid == 0) {
                    pg8::Unit u_; for (int i_ = 0; S.next(i_, u_); ++i_) __hip_atomic_fetch_add(F.ctl + CW_PAN + 64 * u_.pm + 2, 1u, RLX_AGENT); }
                SUBSTAMP(4)
#if P3_ORDER == 0
                if (!P3_ONLY_SCAN) { swa_bias_table(F); __syncthreads();
                swa_main(F, gi * NWAVES + F.wave, 224 * NWAVES);
                SUBSTAMP(5)
#if ASYM_WCOPY
                __syncthreads();
                const int hi_ = (bx >> 6) * 28 + (((bx & 63) - 8) >> 1);
#if ASYM_DNO
                if (!(bx & 1)) dn_out2(F, hi_ * NWAVES + F.wave, 112 * NWAVES, 0, 2048);
#else
                dn_out2(F, gi * NWAVES + F.wave, 224 * NWAVES, 0, 224 * NWAVES);
#endif
                if (DEFER_WEIGHTS && (bx & 1)) weight_copies(F, WI_P0, WI_ALL, hi_ * NWAVES + F.wave, 112 * NWAVES); }
#else
                if (DEFER_WEIGHTS) { __syncthreads(); weight_copies(F, WI_P0, WI_ALL, gi * NWAVES + F.wave, 224 * NWAVES); } }
#endif
                if (SEAM67 && DEFER_WEIGHTS) { asm volatile("s_waitcnt vmcnt(0)" ::: "memory"); if (F.lane == 0) __hip_atomic_fetch_add(F.ctl + CW_WCOPY + 64 * (F.wave & 7), 1u, RLX_AGENT); }
                SUBSTAMP(6)
#endif
#if ASYM_WCOPY && ASYM_DNO
                if (bx & 1) dn_out2(F, 2048 + ((bx >> 6) * 28 + (((bx & 63) - 8) >> 1)) * NWAVES + F.wave, 112 * NWAVES, 0, 4096);
                SUBSTAMP(7)
#else
                dn_out2(F, gi * NWAVES + F.wave, 224 * NWAVES, ASYM_WCOPY ? 224 * NWAVES : 0, 4096); SUBSTAMP(7)
#endif
            }
        } else {
        for (int task = F.vcu; task < 32; task += F.G) { dn_scan_wg(F, task >> 1, task & 1); __syncthreads(); }
        swa_bias_table(F); __syncthreads();
        swa_main(F, F.vcu * NWAVES + F.wave, F.G * NWAVES);
        __syncthreads();
        dn_out2(F, F.vcu * NWAVES + F.wave, F.G * NWAVES);
        }
#elif FAST_SWA
        if (F.vcu < 16) dn_scan_naive(F, F.vcu);
        else { swa_bias_table(F); __syncthreads(); swa_main(F, (F.vcu - 16) * NWAVES + F.wave, (F.G - 16) * NWAVES); }
#else
        if (F.G > 16) { if (F.vcu < 16) dn_scan_naive(F, F.vcu); else swa_naive(F, (F.vcu - 16) * NWAVES + F.wave, (F.G - 16) * NWAVES); }
        else { for (int bh = F.vcu; bh < 16; bh += F.G) dn_scan_naive(F, bh); swa_naive(F, F.vcu * NWAVES + F.wave, F.G * NWAVES); }
#endif
}
__device__ __forceinline__ void run_phase4(Frame& F0) {
    Frame F = F0; asm volatile("" : "+v"(F.tid)); F.lane = F.tid & 63;
    unsigned char* ws = F.ws; bf16* XB = (bf16*)(ws + WS_XB); bf16* Y = (bf16*)(ws + WS_Y); bf16* PROJ = (bf16*)(ws + WS_PROJ); (void)XB; (void)Y; (void)PROJ;
}
__device__ __forceinline__ void run_phase5(Frame& F0) {
    Frame F = F0; asm volatile("" : "+v"(F.tid)); F.lane = F.tid & 63;
    unsigned char* ws = F.ws; bf16* XB = (bf16*)(ws + WS_XB); bf16* Y = (bf16*)(ws + WS_Y); bf16* PROJ = (bf16*)(ws + WS_PROJ); (void)XB; (void)Y; (void)PROJ;
        pg8::Gemm g{PROJ + PC_YDN, (const bf16*)(ws + WS_WAB), 2 * M, 2 * D, DN_W, NP, M / 256, (PC_YSW - PC_YDN) * 2};
        pg8::PairedOrder S; S.init(M, D, F.G, (int)blockIdx.x);
        if (SEAM35 && F.G == 256) {
            pg8::Unit u0;
            if (S.next(0, u0) && F.wave == 0) { gu32* pc = F.ctl + CW_PAN + 64 * u0.pm;
                for (unsigned sp = 0; sp < (1u << 18); ++sp) {
                    const unsigned a0 = (unsigned)__builtin_amdgcn_readfirstlane((int)__hip_atomic_load(pc, RLX_AGENT)), a1 = (unsigned)__builtin_amdgcn_readfirstlane((int)__hip_atomic_load(pc + 1, RLX_AGENT)), a2 = (unsigned)__builtin_amdgcn_readfirstlane((int)__hip_atomic_load(pc + 2, RLX_AGENT));
                    if (a0 >= 64u && a1 >= 64u && a2 >= 7u) break;
                    __builtin_amdgcn_s_sleep(4); }
                __builtin_amdgcn_fence(__ATOMIC_ACQUIRE, "agent"); asm volatile("s_waitcnt vmcnt(0)" ::: "memory"); }
            __syncthreads(); }
#if P5_TOUCH_G
        {
            pg8::Unit u0; if (S.next(0, u0)) { const bf16* gt = PROJ + PC_G + (size_t)u0.pm * 256 * NP + u0.pn * 256;
#pragma unroll
                for (int i = 0; i < 4; ++i) { const int line = i * 512 + F.tid, half = line >> 10, row = (line >> 2) & 255, seg = line & 3;
                    __builtin_amdgcn_global_load_lds((const unsigned*)(gt + (size_t)row * NP + half * 1024 + seg * 64), (LAS unsigned*)(F.lds + LDSCTL_OFF + 1024 + F.wave * 256), 4, 0, 0); } } }
#endif
        pg8::EpiMerge E{PROJ + PC_G, NP, XB, D, M / 256, D / 256};
        pg8::gemm_phase<pg8::EpiMerge, pg8::PairedOrder, ALIGN_P5, true>(F.lds + RING_OFF, g, S, E);
        SUBSTAMP(1)
        if (SEAM56 && F.G == 256) {
            pg8::Unit u0; if (S.next(0, u0) && F.tid == 0) __hip_atomic_fetch_add(F.ctl + CW_P56 + 64 * u0.pm, 1u, RLX_AGENT); }
}
__device__ __forceinline__ void run_phase6(Frame& F0) {
    Frame F = F0; asm volatile("" : "+v"(F.tid)); F.lane = F.tid & 63;
    unsigned char* ws = F.ws; bf16* XB = (bf16*)(ws + WS_XB); bf16* Y = (bf16*)(ws + WS_Y); bf16* PROJ = (bf16*)(ws + WS_PROJ); (void)XB; (void)Y; (void)PROJ;
        pg8::Gemm g{XB, (const bf16*)(ws + WS_WOUT), M, D, D}; pg8::StaticOrder S; S.init(M, D, F.G, (int)blockIdx.x);
        {
            pg8::Unit u0; if (P6_TOUCH_X && S.next(0, u0)) { const float* xt = FIN(0) + (size_t)u0.pm * 256 * D + u0.pn * 256;
#pragma unroll
                for (int i = 0; i < 4; ++i) { const int line = (F.wave * 4 + i) * 64 + F.lane;
                    __builtin_amdgcn_global_load_lds((const unsigned*)(xt + (size_t)(line >> 3) * D + (line & 7) * 32), (LAS unsigned*)(F.lds + LDSCTL_OFF + 1024 + F.wave * 256), 4, 0, 0); } } }
#if P6_TOUCH_AB
        {
            pg8::Unit u0; if (S.next(0, u0)) {
                const char* bt = (const char*)(ws + WS_WOUT) + (size_t)u0.pn * 256 * D * 2; const char* at = (const char*)XB + (size_t)u0.pm * 256 * D * 2;
#pragma unroll
                for (int i = 0; i < 8; ++i) { const int line = i * 512 + F.tid;
                    __builtin_amdgcn_global_load_lds((const unsigned*)(bt + (size_t)line * 128), (LAS unsigned*)(F.lds + LDSCTL_OFF + 1024 + F.wave * 256), 4, 0, 0); }
#if P6_TOUCH_AB > 1
#pragma unroll
                for (int i = 0; i < 8; ++i) { const int line = i * 512 + F.tid;
                    __builtin_amdgcn_global_load_lds((const unsigned*)(at + (size_t)line * 128), (LAS unsigned*)(F.lds + LDSCTL_OFF + 1024 + F.wave * 256), 4, 0, 0); }
#endif
            } }
#endif
        if (SEAM56 && F.G == 256) {
            pg8::Unit u0;
            if (S.next(0, u0) && F.wave == 0) {
                for (unsigned sp = 0; sp < (1u << 18); ++sp) {
                    bool ok = (unsigned)__builtin_amdgcn_readfirstlane((int)__hip_atomic_load(F.ctl + CW_P56 + 64 * u0.pm, RLX_AGENT)) >= 4u;
                    if (SEAM35 && ok) { unsigned tot = 0u;
                        for (int q = 0; q < 8; ++q) tot += (unsigned)__builtin_amdgcn_readfirstlane((int)__hip_atomic_load(F.ctl + CW_SWADONE + 64 * q, RLX_AGENT));
                        ok = tot >= (unsigned)(BATCH * SW_H * (SEQ / 32)); }
                    if (ok) break;
                    __builtin_amdgcn_s_sleep(2); }
                __builtin_amdgcn_fence(__ATOMIC_ACQUIRE, "agent"); asm volatile("s_waitcnt vmcnt(0)" ::: "memory"); }
            __syncthreads(); }
        pg8::EpiX1 E{FIN(0), F.out, Y, (float*)(ws + WS_SSQ2), D};
        pg8::gemm_phase<pg8::EpiX1, pg8::StaticOrder, ALIGN_P6, true>(F.lds + RING_OFF, g, S, E);
        if (SEAM67 && F.G == 256) { pg8::Unit u0; if (S.next(0, u0) && F.tid == 0) __hip_atomic_fetch_add(F.ctl + CW_PAN + 64 * u0.pm + 3, 1u, RLX_AGENT); }
        SUBSTAMP(2)
}
__device__ __forceinline__ void run_phase7(Frame& F0) {
    Frame F = F0; asm volatile("" : "+v"(F.tid)); F.lane = F.tid & 63;
    unsigned char* ws = F.ws; bf16* XB = (bf16*)(ws + WS_XB); bf16* Y = (bf16*)(ws + WS_Y); bf16* PROJ = (bf16*)(ws + WS_PROJ); (void)XB; (void)Y; (void)PROJ;
        pg8::Gemm g{Y, (const bf16*)(ws + WS_WGU), M, 2 * FF, D};
        pg8::EpiSwiGLU E{PROJ, FF, (const float*)(ws + WS_SSQ2), EPS};
#if SEAM67
        if (F.G == 256) {
            pg8::SkewOrder S; S.init(M, 2 * FF, F.G, (int)blockIdx.x); S.pan = (const unsigned*)(F.ctl + CW_PAN); S.p56 = (const unsigned*)(F.ctl + CW_P56); S.act_row_bytes = FF * 2; S.proj_row_bytes = NP * 2;
            pg8::Unit u0;
            if (S.next(0, u0) && F.wave == 0) {
                const int fm = u0.pm & ~7;
                for (unsigned sp = 0; sp < (1u << 18); ++sp) {
                    unsigned wc_ = 0u;
                    for (int q = 0; q < 8; ++q) wc_ += (unsigned)__builtin_amdgcn_readfirstlane((int)__hip_atomic_load(F.ctl + CW_WCOPY + 64 * q, RLX_AGENT));
                    bool ok = wc_ >= 224u * NWAVES;
                    if (SKEW_CHK_ALL) ok = ok && S.panel_ready(u0.pm);
                    else for (int q = 0; q < 8; ++q) ok = ok && S.panel_ready(fm + q);
                    if (ok) break;
                    __builtin_amdgcn_s_sleep(4); }
                __builtin_amdgcn_fence(__ATOMIC_ACQUIRE, "agent"); asm volatile("s_waitcnt vmcnt(0)" ::: "memory"); }
            __syncthreads();
            pg8::gemm_phase<pg8::EpiSwiGLU, pg8::SkewOrder, ALIGN_P7, true>(F.lds + RING_OFF, g, S, E);
            if (SEAM78 && F.tid == 0) {
                pg8::Unit u_; for (int i_ = 0; S.next(i_, u_); ++i_) __hip_atomic_fetch_add(F.ctl + CW_PAN + 64 * u_.pm + 4, 1u, RLX_AGENT); }
            SUBSTAMP(0)
            return;
        }
#endif
#if TAIL_SPLIT
        pg8::TailSplitOrder S; S.init(M, 2 * FF, F.G, (int)blockIdx.x);
#else
        pg8::StaticOrder S; S.init(M, 2 * FF, F.G, (int)blockIdx.x);
#endif
#if TAIL_SPLIT
        pg8::gemm_phase<pg8::EpiSwiGLU, pg8::TailSplitOrder, ALIGN_P7, true, true>(F.lds + RING_OFF, g, S, E);
#else
        pg8::gemm_phase<pg8::EpiSwiGLU, pg8::StaticOrder, ALIGN_P7, SP2_P7>(F.lds + RING_OFF, g, S, E);
#endif
}
__device__ __forceinline__ void run_phase8(Frame& F0) {
    Frame F = F0; asm volatile("" : "+v"(F.tid)); F.lane = F.tid & 63;
    unsigned char* ws = F.ws; bf16* XB = (bf16*)(ws + WS_XB); bf16* Y = (bf16*)(ws + WS_Y); bf16* PROJ = (bf16*)(ws + WS_PROJ); (void)XB; (void)Y; (void)PROJ;
        pg8::Gemm g{PROJ, (const bf16*)(ws + WS_WD), M, D, FF}; pg8::StaticOrder S; S.init(M, D, F.G, (int)blockIdx.x);
        if (SEAM78 && SEAM67 && F.G == 256) {
            pg8::Unit u0;
            if (S.next(0, u0) && F.wave == 0) {
                for (unsigned sp = 0; sp < (1u << 18); ++sp) {
                    bool ok = (unsigned)__builtin_amdgcn_readfirstlane((int)__hip_atomic_load(F.ctl + CW_PAN + 64 * u0.pm + 4, RLX_AGENT)) >= 22u;
                    if (ok) { unsigned tot = 0u;
                        for (int q = 0; q < 8; ++q) tot += (unsigned)__builtin_amdgcn_readfirstlane((int)__hip_atomic_load(F.ctl + CW_NORMDONE + 64 * q, RLX_AGENT));
                        ok = tot >= 4096u; }
                    if (ok) break;
                    __builtin_amdgcn_s_sleep(4); }
                __builtin_amdgcn_fence(__ATOMIC_ACQUIRE, "agent"); asm volatile("s_waitcnt vmcnt(0)" ::: "memory"); }
            __syncthreads(); }
        pg8::EpiOut E{F.out, D, Y};
        pg8::gemm_phase<pg8::EpiOut, pg8::StaticOrder, ALIGN_P8, true>(F.lds + RING_OFF, g, S, E);
}
#ifndef PROGRAM
#define PROGRAM RUN(0) BAR RUN(1) BAR RUN(2) BAR RUN(3) if (!(SEAM35 && F.G == 256)) { BAR } RUN(5) if (!(SEAM56 && F.G == 256)) { BAR } RUN(6) if (!(SEAM67 && F.G == 256)) { BAR } RUN(7) if (!(SEAM78 && SEAM67 && F.G == 256)) { BAR } RUN(8)
#endif
__global__ void __launch_bounds__(NWAVES * 64, 2) fwd_kernel(Args args) {
    extern __shared__ __attribute__((aligned(16))) unsigned char lds[];
    Frame F;
    F.lds = (LAS unsigned char*)lds;
    F.MISC = (volatile LAS unsigned*)(F.lds + MISC_OFF);
    F.tid = threadIdx.x; F.lane = F.tid & 63; F.wave = __builtin_amdgcn_readfirstlane(F.tid >> 6);
    F.G = gridDim.x; { const int bx = blockIdx.x; F.vcu = (F.G % 8 == 0) ? (bx % 8) * (F.G / 8) + bx / 8 : bx; }
    F.ka = (KArgs)__builtin_amdgcn_kernarg_segment_ptr();
    F.out = args.out; F.ws = args.ws; unsigned char* ws = args.ws;
    F.ctl = (gu32*)(ws + WS_CTL);
    for (int u = F.tid; u < (LDS_BYTES - LDSCTL_OFF) / 4; u += NWAVES * 64) ((LAS unsigned*)(F.lds + LDSCTL_OFF))[u] = 0u;
    __syncthreads();
    XcdBarrier bar; bar.bar = (unsigned*)(F.ctl + CW_BAR) + args.li * XCD_BAR_WORDS; bar.x = 0; bar.st = nullptr;
    bar = xcd_barrier_post((unsigned*)(F.ctl + CW_BAR) + args.li * XCD_BAR_WORDS, F.MISC + 8);
#if STAMP_PHASE >= 0
#if STAMP_SUB >= 0 || STAMP_DN >= 0
#define STAMP_()
#else
    int ns_ = 0;
#define STAMP_() { if (ns_ == STAMP_PHASE || ns_ == STAMP_PHASE + 1) { unsigned long long t_; asm volatile("s_memrealtime %0\n\ts_waitcnt lgkmcnt(0)" : "=s"(t_) :: "memory"); g_ts[ns_ - STAMP_PHASE] = t_; } ++ns_; }
#endif
#define RUN(k) run_phase##k(F);
#define BAR xcd_barrier(bar); STAMP_()
    STAMP_()
    PROGRAM
    BAR
#if STAMP_WS
    if (blockIdx.x == 0 && F.tid == 0) F.out[0] += (float)args.ws_mib;
#elif STAMP_DN >= 0
    if (blockIdx.x == STAMP_BLOCK && F.tid == 0) F.out[0] += (float)(g_dn[STAMP_DN]) * 0.01f;
#elif STAMP_SUB >= 0
    if (blockIdx.x == STAMP_BLOCK && F.tid == 0) F.out[0] += floorf((float)(g_sub[STAMP_SUBB] - g_sub[STAMP_SUB]) * 0.01f / STAMP_Q + 0.5f) * STAMP_Q - STAMP_OFF;
#else
    if (blockIdx.x == 0 && F.tid == 0) F.out[0] += floorf((float)(g_ts[1] - g_ts[0]) * 0.01f / STAMP_Q + 0.5f) * STAMP_Q - STAMP_OFF;
#endif
#undef RUN
#undef BAR
#else
#define RUN(k) run_phase##k(F);
#define BAR xcd_barrier(bar);
    PROGRAM
#if STAMP_WS
    BAR
    if (blockIdx.x == 0 && F.tid == 0) F.out[0] += (float)args.ws_mib;
#endif
#undef RUN
#undef BAR
#endif
}

extern "C" void kernel_launch(void* const* d_in, const int* in_sizes, int n_in, void* d_out, int out_size, void* d_ws, size_t ws_size, hipStream_t stream) {
    static int grid = 0;
    if (grid == 0) {
        if (n_in != 18 || in_sizes[0] != M * D || out_size != M * D || ws_size < WS_END) { fprintf(stderr, "kernel_launch: unexpected shapes (n_in %d, in0 %d, out %d, ws %zu)\n", n_in, n_in > 0 ? in_sizes[0] : -1, out_size, ws_size); grid = -1; return; }
        int dev = 0, cus = 0;
        if (hipGetDevice(&dev) != hipSuccess || hipDeviceGetAttribute(&cus, hipDeviceAttributeMultiprocessorCount, dev) != hipSuccess) { grid = -1; return; }
        if (hipFuncSetAttribute((const void*)fwd_kernel, hipFuncAttributeMaxDynamicSharedMemorySize, LDS_BYTES) != hipSuccess) { fprintf(stderr, "kernel_launch: hipFuncSetAttribute failed\n"); grid = -1; return; }
        int per_cu = 0;
        if (hipOccupancyMaxActiveBlocksPerMultiprocessor(&per_cu, (const void*)fwd_kernel, NWAVES * 64, LDS_BYTES) != hipSuccess || per_cu < 1) fprintf(stderr, "kernel_launch: occupancy query reports %d\n", per_cu);
        (void)hipGetLastError();
        grid = cus;
    }
    if (grid < 0) return;
    if (hipMemsetAsync((char*)d_ws + WS_CTL, 0, CTL_ZERO_BYTES, stream) != hipSuccess) return;
    Args a{};
    for (int i = 0; i < 18; ++i) a.in[i] = (const float*)d_in[i];
    a.out = (float*)d_out; a.ws = (unsigned char*)d_ws; a.ws_mib = (int)(ws_size >> 20);
    for (int li = 0; li < 1; ++li) {
        a.ph_lo = 0; a.ph_hi = 0;
        a.li = li;
        hipLaunchKernelGGL(fwd_kernel, dim3(grid), dim3(NWAVES * 64), LDS_BYTES, stream, a);
        const hipError_t le = hipPeekAtLastError();
        if (le != hipSuccess) { fprintf(stderr, "kernel_launch: launch %d failed: %s\n", li, hipGetErrorName(le)); break; }
    }
}
```

```cpp
#ifndef FAST_SWA
#define FAST_SWA 1
#endif
#ifndef FAST_DN
#define FAST_DN 1
#endif
#ifndef REP_DNA
#define REP_DNA 1
#endif
#ifndef REP_SWAPRE
#define REP_SWAPRE 1
#endif
#ifndef REP_S1
#define REP_S1 1
#endif
#ifndef REP_S2
#define REP_S2 1
#endif
#ifndef REP_S3A
#define REP_S3A 1
#endif
#ifndef REP_S3B
#define REP_S3B 1
#endif
#ifndef REP_S4
#define REP_S4 1
#endif
#ifndef S1_RELOAD
#define S1_RELOAD 0
#endif
#ifndef S1_OPAQUE
#define S1_OPAQUE 0
#endif
#ifndef P1_TILES
#define P1_TILES 12
#endif
#ifndef STAMP_PHASE
#define STAMP_PHASE -1
#endif
#ifndef STAMP_SUB
#define STAMP_SUB -1
#endif
#ifndef STAMP_BLOCK
#define STAMP_BLOCK 0
#endif
#ifndef STAMP_DN
#define STAMP_DN -1
#endif
#ifndef STAMP_WS
#define STAMP_WS 0
#endif
#ifndef P3_SKIP_SCAN
#define P3_SKIP_SCAN 0
#endif
#ifndef P3_SKIP_GEMM
#define P3_SKIP_GEMM 0
#endif
#ifndef SCAN_HOT
#define SCAN_HOT 0
#endif
#ifndef STAMP_Q
#define STAMP_Q 8.0f
#endif
#ifndef SCAN_AHEAD
#define SCAN_AHEAD 6
#endif
#ifndef SCAN_TOUCH_EN
#define SCAN_TOUCH_EN 0
#endif
#ifndef DEFER_WEIGHTS
#define DEFER_WEIGHTS 1
#endif
#ifndef P3_ONLY_SCAN
#define P3_ONLY_SCAN 0
#endif
#ifndef ALIGN_P7
#define ALIGN_P7 true
#endif
#ifndef ALIGN_P1
#define ALIGN_P1 true
#endif
#ifndef ALIGN_P5
#define ALIGN_P5 true
#endif
#ifndef ALIGN_P6
#define ALIGN_P6 true
#endif
#ifndef ALIGN_P8
#define ALIGN_P8 true
#endif
#ifndef SP2_P7
#define SP2_P7 true
#endif
#ifndef P3_ORDER
#define P3_ORDER 0
#endif
#ifndef SCAN_SETS
#define SCAN_SETS 4
#endif
#ifndef DNA_PREFETCH
#define DNA_PREFETCH 0
#endif
#ifndef SCAN_NT
#define SCAN_NT 0
#endif
#ifndef FUSE_QKNORM
#define FUSE_QKNORM 1
#endif
#ifndef STAMP_SUBB
#define STAMP_SUBB (STAMP_SUB + 1)
#endif
#ifndef SCAN_UPRE
#define SCAN_UPRE 2
#endif
#ifndef SCAN_PUBLISH
#define SCAN_PUBLISH 1
#endif
#ifndef SCAN_DRAIN_CNT
#define SCAN_DRAIN_CNT 0
#endif
#ifndef SCAN_O_SC1
#define SCAN_O_SC1 1
#endif
#ifndef SCAN_REFILL_LATE
#define SCAN_REFILL_LATE 1
#endif
#ifndef SCAN_O16
#define SCAN_O16 1
#endif
#ifndef STAMP_OFF
#define STAMP_OFF 0.0f
#endif
#ifndef DNO_SLEEP
#define DNO_SLEEP 8
#endif
#ifndef DNO_SKIPWORK
#define DNO_SKIPWORK 0
#endif
#ifndef DNO_SKIPALL
#define DNO_SKIPALL 0
#endif
#ifndef SCAN_PUB_LOADER
#define SCAN_PUB_LOADER 1
#endif
#ifndef SCAN_PUB_EVERY
#define SCAN_PUB_EVERY 1
#endif
#ifndef DNO_FENCE
#define DNO_FENCE 0
#endif
#ifndef SCAN_DRAIN_NONE
#define SCAN_DRAIN_NONE 0
#endif
#ifndef DNO_LAG
#define DNO_LAG 0
#endif
#ifndef EPI_WT
#define EPI_WT 0
#endif
#ifndef TAIL_SPLIT
#define TAIL_SPLIT 0
#endif
#ifndef GEMM_SAMETILE
#define GEMM_SAMETILE 0
#endif
#ifndef STAMP_EPI
#define STAMP_EPI 0
#endif
#ifndef SEAM56
#define SEAM56 1
#endif
#ifndef SCAN_QG_EARLY
#define SCAN_QG_EARLY 0
#endif
#ifndef BAR_EARLY_WB
#define BAR_EARLY_WB 0
#endif
#ifndef P0_DEEP
#define P0_DEEP 0
#endif
#ifndef DNO_STAGE
#define DNO_STAGE 1
#endif
#ifndef SEAM35
#define SEAM35 1
#endif
#ifndef P6_TOUCH_AB
#define P6_TOUCH_AB 0
#endif
#ifndef P5_TOUCH_G
#define P5_TOUCH_G 0
#endif
#ifndef P6_TOUCH_X
#define P6_TOUCH_X 0
#endif
#ifndef SEAM67
#define SEAM67 1
#endif
#ifndef SKEW_TAIL
#define SKEW_TAIL 1
#endif
#ifndef SEAM78
#define SEAM78 1
#endif
#ifndef ASYM_WCOPY
#define ASYM_WCOPY 1
#endif
#ifndef ASYM_DNO
#define ASYM_DNO 1
#endif
#ifndef SKEW_CHK_ALL
#define SKEW_CHK_ALL 1
#endif
#ifndef ASYM_SWA
#define ASYM_SWA 1
#endif
#include <hip/hip_runtime.h>
#include <cstdio>
#include <cstdint>

#ifndef WGM_KNOB
#define WGM_KNOB 8
#endif
#ifndef EPI_REP
#define EPI_REP 1
#endif
#ifndef EPI_REP_WHICH
#define EPI_REP_WHICH 0
#endif
#ifndef RES_F32
#define RES_F32 0
#endif
#if STAMP_SUB >= 0
__device__ unsigned long long g_sub[8];
#define SUBSTAMP(i) if (blockIdx.x == STAMP_BLOCK && threadIdx.x == 0) g_sub[i] = __builtin_amdgcn_s_memrealtime();
#else
#define SUBSTAMP(i)
#endif
namespace pg8 {
#define PG8_LAS __attribute__((address_space(3)))
typedef unsigned short bf16_t;
typedef short bf16x8 __attribute__((ext_vector_type(8)));
typedef float f32x4 __attribute__((ext_vector_type(4)));
typedef unsigned u32x4 __attribute__((ext_vector_type(4)));
typedef unsigned u32x2 __attribute__((ext_vector_type(2)));
constexpr int BM = 256, BK = 64, HALF = 128, HTB = HALF * BK * 2  , STAGE_BYTES = 8 * HTB, NXCD = 8, WGM = WGM_KNOB;

__host__ __device__ __forceinline__ int lds_byte(int r, int c) { const int st = (r >> 4) * 2 + (c >> 5), rr = r & 15, cc = c & 31, ob = rr * 64 + cc * 2; return st * 1024 + (ob ^ (((ob >> 9) & 1) << 5)); }
__host__ __device__ __forceinline__ void stage_rc(int b, int& R, int& C) { const int st = b / 1024, sb = b % 1024, swz = sb ^ (((sb >> 9) & 1) << 5); R = (st >> 1) * 16 + swz / 64; C = (st & 1) * 32 + (swz % 64) / 2; }
__host__ __device__ __forceinline__ int perm32(int rho) { const int n = rho >> 4, i = rho & 15; return 8 * (i >> 2) + 4 * n + (i & 3); }

struct Unit { int pm, pn, hm, chk; };
struct Gemm { const bf16_t* A; const bf16_t* Bt; int M, N, K; int lda = 0, nMA = 1 << 30, a2off = 0; };

struct StaticOrder {
    int nM, nN, nwg, G, c;
    __host__ __device__ void init(int M, int N, int G_, int c_) { nM = M / BM; nN = N / BM; nwg = nM * nN; G = G_; c = c_; }
    __host__ __device__ bool next(int i, Unit& u) const { return nextL((long)i * G + c, u); }
    __host__ __device__ bool nextL(long L, Unit& u) const {
        if (L >= nwg) return false;
        u.hm = 0; u.chk = 0;
        int wgid = (int)L; { const int q = nwg / NXCD, r = nwg % NXCD, xcd = wgid % NXCD, off = wgid / NXCD; wgid = (xcd < r ? xcd * (q + 1) : r * (q + 1) + (xcd - r) * q) + off; }
        const int nig = WGM * nN, gid = wgid / nig, fm = gid * WGM, gsz = (nM - fm) < WGM ? (nM - fm) : WGM;
        u.pm = fm + ((wgid % nig) % gsz); u.pn = (wgid % nig) / gsz; return true;
    }
    __device__ __forceinline__ void a_ready(const Unit&) const {}
    __device__ __forceinline__ void done(const Unit&) const {}
};
struct TailSplitOrder {
    StaticOrder so; int full, rem; bool split;
    __host__ __device__ void init(int M, int N, int G_, int c_) { so.init(M, N, G_, c_); full = so.nwg / G_; rem = so.nwg - full * G_; split = TAIL_SPLIT && rem > 0 && 2 * rem <= G_; }
    __host__ __device__ bool next(int i, Unit& u) const {
        if (i < full || !split) return so.next(i, u);
        if (i > full || so.c >= 2 * rem) return false;
        if (!so.nextL((long)full * so.G + (so.c >> 1), u)) return false;
        u.hm = 1 + (so.c & 1); return true;
    }
    __device__ __forceinline__ void a_ready(const Unit&) const {}
    __device__ __forceinline__ void done(const Unit&) const {}
};
struct SkewOrder {
    StaticOrder so; const unsigned* pan; const unsigned* p56; int act_row_bytes, proj_row_bytes;
    __host__ __device__ void init(int M, int N, int G_, int c_) { so.init(M, N, G_, c_); }
    __host__ __device__ bool next(int i, Unit& u) const {
        const int full = so.nwg / so.G;
        if (i < full || !SKEW_TAIL) return so.next(i, u);
        if (i > full) return false;
        const int x = so.c & 7, off = so.c >> 3; if (x & 1) return false;
        if (!so.nextL((long)full * so.G + 8 * (off >> 1) + x + (off & 1), u)) return false;
        u.chk = SKEW_CHK_ALL ? 1 : (off & 1); return true;
    }
    __device__ __forceinline__ bool panel_ready(int pm) const {
        bool ok = (unsigned)__builtin_amdgcn_readfirstlane((int)__hip_atomic_load(pan + 64 * pm + 3, __ATOMIC_RELAXED, __HIP_MEMORY_SCOPE_AGENT)) >= 4u;
        const int lo = (pm * act_row_bytes) / proj_row_bytes, hi = ((pm + 1) * act_row_bytes - 1) / proj_row_bytes;
        for (int q = lo; q <= hi; ++q) ok = ok && (unsigned)__builtin_amdgcn_readfirstlane((int)__hip_atomic_load(p56 + 64 * q, __ATOMIC_RELAXED, __HIP_MEMORY_SCOPE_AGENT)) >= 4u;
        return ok;
    }
    __device__ __forceinline__ void a_ready(const Unit& u) const {
        if (u.chk) {
            if (threadIdx.x < 64) {
                for (unsigned sp = 0; !panel_ready(u.pm) && sp < (1u << 18); ++sp) __builtin_amdgcn_s_sleep(2);
                __builtin_amdgcn_fence(__ATOMIC_ACQUIRE, "agent"); asm volatile("s_waitcnt vmcnt(0)" ::: "memory"); }
            asm volatile("" ::: "memory"); __builtin_amdgcn_s_barrier(); asm volatile("" ::: "memory");
        }
    }
    __device__ __forceinline__ void done(const Unit&) const {}
};
struct PairedOrder {
    StaticOrder so;
    __host__ __device__ void init(int M, int N, int G_, int c_) { so.init(M, N, G_, c_); }
    __host__ __device__ bool next(int i, Unit& u) const { if (!so.next(i >> 1, u)) return false; if (i & 1) { u.pm += so.nM; u.pn += so.nN; } return true; }
    __device__ __forceinline__ void a_ready(const Unit&) const {}
    __device__ __forceinline__ void done(const Unit&) const {}
};

__device__ __forceinline__ unsigned cvt_pk_bf16(float lo, float hi) { unsigned r; asm volatile("v_cvt_pk_bf16_f32 %0, %1, %2" : "=v"(r) : "v"(lo), "v"(hi)); return r; }
__device__ __forceinline__ float bf_lo(unsigned w) { return __builtin_bit_cast(float, w << 16); }
__device__ __forceinline__ float bf_hi(unsigned w) { return __builtin_bit_cast(float, w & 0xffff0000u); }
__device__ __forceinline__ float sigmoidf_(float x) { return 1.0f / (1.0f + __expf(-x)); }
template <class V> __device__ __forceinline__ void st16wt(void* p, V v) {
    asm volatile("global_store_dwordx4 %0, %1, off sc1\n\ts_nop 1" :: "v"((__attribute__((address_space(1))) V*)p), "v"(v) : "memory");
}
template <class V> __device__ __forceinline__ void st16(void* p, V v) {
#if EPI_WT
    asm volatile("global_store_dwordx4 %0, %1, off sc1\n\ts_nop 1" :: "v"((__attribute__((address_space(1))) V*)p), "v"(v) : "memory");
#else
    *(V*)p = v;
#endif
}


struct EpiProj {
    static constexpr bool SUBST = false, PERM = true, AFTER_DRAIN = false, PROBE_REP = (EPI_REP_WHICH == 1);
    bf16_t* O; int ldc; const float* rstd; int gate_pn0, pn_off;
    bf16_t* QS; bf16_t* KS; const float* qg; const float* kg; int q_pn0, k_pn;
    float qscale; int seq; int wt = 0;
    __device__ __forceinline__ bool keep(const Unit&) const { return false; }
    __device__ __forceinline__ void operator()(f32x4 (&acc)[2][2][4][2], const Unit& u, int wr, int wc, int fr, int fq) const {
        const int pna = u.pn + pn_off;
        const int row0 = u.pm * BM + wr * 64 + fr, col0 = pna * BM + wc * 64 + 8 * fq; const bool gate = pna >= gate_pn0;
        float sr[2][4];
#pragma unroll
        for (int ai = 0; ai < 2; ++ai)
#pragma unroll
            for (int m = 0; m < 4; ++m) sr[ai][m] = rstd[row0 + ai * HALF + m * 16];
        const bool isq = QS != nullptr && (pna == q_pn0 || pna == q_pn0 + 1), isk = QS != nullptr && pna == k_pn && wc < 2;
        if (isq || isk) {
            f32x4 gn[2][2];
#pragma unroll
            for (int bj = 0; bj < 2; ++bj)
#pragma unroll
                for (int n = 0; n < 2; ++n) { const int d = 32 * bj + 8 * fq + 4 * n; gn[bj][n] = isq ? *(const f32x4*)(qg + d) * qscale : *(const f32x4*)(kg + d); }
#pragma unroll
            for (int ai = 0; ai < 2; ++ai)
#pragma unroll
                for (int m = 0; m < 4; ++m) { const int row = row0 + ai * HALF + m * 16; const float s = sr[ai][m];
                    float ss = 0.f;
#pragma unroll
                    for (int bj = 0; bj < 2; ++bj)
#pragma unroll
                        for (int n = 0; n < 2; ++n) { const f32x4 v = acc[ai][bj][m][n] * s; ss += (v[0] * v[0] + v[1] * v[1]) + (v[2] * v[2] + v[3] * v[3]); }
                    ss += __shfl_xor(ss, 16); ss += __shfl_xor(ss, 32);
                    const float r = s * __builtin_amdgcn_rsqf(ss * (1.0f / 64.0f) + 1e-6f);
                    bf16_t* dst = isq ? QS + (size_t)row * 512 + (pna - q_pn0) * 256 + wc * 64 + 8 * fq
                                      : KS + ((size_t)((row / seq) * 2 + wc) * seq + (row % seq)) * 64 + 8 * fq;
#pragma unroll
                    for (int bj = 0; bj < 2; ++bj) { const f32x4 v0 = acc[ai][bj][m][0] * r * gn[bj][0], v1 = acc[ai][bj][m][1] * r * gn[bj][1];
                        u32x4 w; w.x = cvt_pk_bf16(v0[0], v0[1]); w.y = cvt_pk_bf16(v0[2], v0[3]); w.z = cvt_pk_bf16(v1[0], v1[1]); w.w = cvt_pk_bf16(v1[2], v1[3]);
                        st16(dst + bj * 32, w); } }
            return;
        }
#pragma unroll
        for (int ai = 0; ai < 2; ++ai)
#pragma unroll
            for (int m = 0; m < 4; ++m) { const int row = row0 + ai * HALF + m * 16; const float s = sr[ai][m]; bf16_t* rowp = O + (size_t)row * ldc + col0;
#pragma unroll
                for (int bj = 0; bj < 2; ++bj) { f32x4 v0 = acc[ai][bj][m][0] * s, v1 = acc[ai][bj][m][1] * s;
                    if (gate) {
#pragma unroll
                        for (int j = 0; j < 4; ++j) { v0[j] = __builtin_amdgcn_rcpf(1.0f + __expf(-v0[j])); v1[j] = __builtin_amdgcn_rcpf(1.0f + __expf(-v1[j])); } }
                    u32x4 w; w.x = cvt_pk_bf16(v0[0], v0[1]); w.y = cvt_pk_bf16(v0[2], v0[3]); w.z = cvt_pk_bf16(v1[0], v1[1]); w.w = cvt_pk_bf16(v1[2], v1[3]);
                    if (wt) st16wt(rowp + bj * 32, w); else st16(rowp + bj * 32, w); } }
    }
};
struct EpiMerge {
    static constexpr bool SUBST = false, PERM = true, AFTER_DRAIN = false, PROBE_REP = false;
    const bf16_t* G; int ldg; bf16_t* O; int ldc; int nM, nN;
    __device__ __forceinline__ bool keep(const Unit& u) const { return u.pm < nM; }
    __device__ __forceinline__ void operator()(f32x4 (&acc)[2][2][4][2], const Unit& u, int wr, int wc, int fr, int fq) const {
        const bool second = u.pm >= nM; const int pm = second ? u.pm - nM : u.pm, pn = second ? u.pn - nN : u.pn;
        const int row0 = pm * BM + wr * 64 + fr, col0 = pn * BM + wc * 64 + 8 * fq;
#pragma unroll
        for (int ai = 0; ai < 2; ++ai) {
            u32x4 gA[4][2], gB[4][2];
#pragma unroll
            for (int m = 0; m < 4; ++m)
#pragma unroll
                for (int bj = 0; bj < 2; ++bj) { const size_t o = (size_t)(row0 + ai * HALF + m * 16) * ldg + col0 + bj * 32; if (!second) gA[m][bj] = *(const u32x4*)(G + o); gB[m][bj] = *(const u32x4*)(G + o + 1024); }
#pragma unroll
            for (int m = 0; m < 4; ++m) { const int row = row0 + ai * HALF + m * 16;
#pragma unroll
                for (int bj = 0; bj < 2; ++bj) { const int col = col0 + bj * 32;
                    float sb[8];
#pragma unroll
                    for (int j = 0; j < 4; ++j) { sb[2 * j] = bf_lo(gB[m][bj][j]); sb[2 * j + 1] = bf_hi(gB[m][bj][j]); }
                    if (!second) {
                        float sa[8];
#pragma unroll
                        for (int j = 0; j < 4; ++j) { sa[2 * j] = bf_lo(gA[m][bj][j]); sa[2 * j + 1] = bf_hi(gA[m][bj][j]); }
#pragma unroll
                        for (int j = 0; j < 4; ++j) { acc[ai][bj][m][0][j] *= sa[j] * __builtin_amdgcn_rcpf(sb[j]); acc[ai][bj][m][1][j] *= sa[4 + j] * __builtin_amdgcn_rcpf(sb[4 + j]); }
                    } else {
                        f32x4 v0, v1;
#pragma unroll
                        for (int j = 0; j < 4; ++j) { v0[j] = acc[ai][bj][m][0][j] * sb[j]; v1[j] = acc[ai][bj][m][1][j] * sb[4 + j]; }
                        u32x4 w; w.x = cvt_pk_bf16(v0[0], v0[1]); w.y = cvt_pk_bf16(v0[2], v0[3]); w.z = cvt_pk_bf16(v1[0], v1[1]); w.w = cvt_pk_bf16(v1[2], v1[3]);
                        if (SEAM56) st16wt(O + (size_t)row * ldc + col, w); else st16(O + (size_t)row * ldc + col, w); } } }
            asm volatile("" ::: "memory"); }
    }
};
struct EpiX1 {
    static constexpr bool SUBST = (STAMP_EPI == 6), PERM = (SEAM67 != 0), AFTER_DRAIN = false, PROBE_REP = (EPI_REP_WHICH == 6);
    const float* X; float* out; bf16_t* xb; float* ssq; int ldc;
    __device__ __forceinline__ bool keep(const Unit&) const { return false; }
    __device__ __forceinline__ void operator()(f32x4 (&acc)[2][2][4][2], const Unit& u, int wr, int wc, int fr, int fq) const {
        const int row0 = u.pm * BM + wr * 64 + fr, col0 = u.pn * BM + wc * 32 + (PERM ? 8 : 4) * fq; constexpr int NOFF = PERM ? 4 : 16;
#pragma unroll
        for (int ai = 0; ai < 2; ++ai) {
            f32x4 xv[4][2][2];
#pragma unroll
            for (int m = 0; m < 4; ++m)
#pragma unroll
                for (int bj = 0; bj < 2; ++bj)
#pragma unroll
                    for (int n = 0; n < 2; ++n) xv[m][bj][n] = *(const f32x4*)(X + (size_t)(row0 + ai * HALF + m * 16) * ldc + col0 + bj * HALF + n * NOFF);
#pragma unroll
            for (int m = 0; m < 4; ++m) { const int row = row0 + ai * HALF + m * 16; const size_t off = (size_t)row * ldc + col0; float ss = 0.f;
#pragma unroll
                for (int bj = 0; bj < 2; ++bj) { u32x4 w4;
#pragma unroll
                    for (int n = 0; n < 2; ++n) { const f32x4 o = xv[m][bj][n] + acc[ai][bj][m][n];
                        if (RES_F32) *(f32x4*)(out + off + bj * HALF + n * NOFF) = o; ss += (o[0] * o[0] + o[1] * o[1]) + (o[2] * o[2] + o[3] * o[3]);
                        u32x2 w; w.x = cvt_pk_bf16(o[0], o[1]); w.y = cvt_pk_bf16(o[2], o[3]);
                        if (PERM) { if (n == 0) { w4.x = w.x; w4.y = w.y; } else { w4.z = w.x; w4.w = w.y; } }
                        else *(u32x2*)(xb + off + bj * HALF + n * 16) = w; }
                    if (PERM) st16wt(xb + off + bj * HALF, w4); }
                ss += __shfl_xor(ss, 16); ss += __shfl_xor(ss, 32);
                if (fq == 0) atomicAdd(ssq + row, ss); }
            asm volatile("" ::: "memory"); }
    }
};
struct EpiSwiGLU {
    static constexpr bool SUBST = false, PERM = true, AFTER_DRAIN = false, PROBE_REP = (EPI_REP_WHICH == 7);
    bf16_t* O; int ldc; const float* ssq; float eps;
    __device__ __forceinline__ bool keep(const Unit&) const { return false; }
    __device__ __forceinline__ void operator()(f32x4 (&acc)[2][2][4][2], const Unit& u, int wr, int wc, int fr, int fq) const {
        const int row0 = u.pm * BM + (u.hm == 2 ? HALF : 0) + wr * 64 + fr, col0 = u.pn * HALF + wc * 32 + 8 * fq;
        float sr[2][4];
#pragma unroll
        for (int ai = 0; ai < 2; ++ai)
#pragma unroll
            for (int m = 0; m < 4; ++m) sr[ai][m] = ssq[row0 + (u.hm ? 0 : ai * HALF) + m * 16];
#pragma unroll
        for (int ai = 0; ai < 2; ++ai)
#pragma unroll
            for (int m = 0; m < 4; ++m) { const int row = row0 + ai * HALF + m * 16;
                if (ai == 1 && u.hm) continue;
                const float s = __builtin_amdgcn_rsqf(sr[ai][m] * (1.0f / 1024.0f) + eps);
                float a[8];
#pragma unroll
                for (int n = 0; n < 2; ++n)
#pragma unroll
                    for (int j = 0; j < 4; ++j) { const float g = acc[ai][0][m][n][j] * s, up = acc[ai][1][m][n][j] * s; a[4 * n + j] = g * up * __builtin_amdgcn_rcpf(1.0f + __expf(-g)); }
                u32x4 w; w.x = cvt_pk_bf16(a[0], a[1]); w.y = cvt_pk_bf16(a[2], a[3]); w.z = cvt_pk_bf16(a[4], a[5]); w.w = cvt_pk_bf16(a[6], a[7]);
                if (SEAM78) st16wt(O + (size_t)row * ldc + col0, w); else st16(O + (size_t)row * ldc + col0, w); }
    }
};
struct EpiOut {
    static constexpr bool SUBST = (STAMP_EPI == 8), PERM = false, AFTER_DRAIN = false, PROBE_REP = false;
    float* out; int ldc; const bf16_t* xb;
    __device__ __forceinline__ bool keep(const Unit&) const { return false; }
    __device__ __forceinline__ void operator()(f32x4 (&acc)[2][2][4][2], const Unit& u, int wr, int wc, int fr, int fq) const {
        const int row0 = u.pm * BM + wr * 64 + fr, col0 = u.pn * BM + wc * 32 + 4 * fq;
#pragma unroll
        for (int ai = 0; ai < 2; ++ai) {
            u32x2 rb[4][2][2]; f32x4 rf[4][2][2];
#pragma unroll
            for (int m = 0; m < 4; ++m)
#pragma unroll
                for (int bj = 0; bj < 2; ++bj)
#pragma unroll
                    for (int n = 0; n < 2; ++n) { const size_t o = (size_t)(row0 + ai * HALF + m * 16) * ldc + col0 + bj * HALF + n * 16;
                        if (RES_F32) rf[m][bj][n] = *(const f32x4*)(out + o); else rb[m][bj][n] = *(const u32x2*)(xb + o); }
#pragma unroll
            for (int m = 0; m < 4; ++m) { const size_t off = (size_t)(row0 + ai * HALF + m * 16) * ldc + col0;
#pragma unroll
                for (int bj = 0; bj < 2; ++bj)
#pragma unroll
                    for (int n = 0; n < 2; ++n) { f32x4 b;
                        if (RES_F32) b = rf[m][bj][n]; else { const u32x2 w = rb[m][bj][n]; b = (f32x4){bf_lo(w.x), bf_hi(w.x), bf_lo(w.y), bf_hi(w.y)}; }
                        *(f32x4*)(out + off + bj * HALF + n * 16) = b + acc[ai][bj][m][n]; } }
            asm volatile("" ::: "memory"); }
    }
};

template <class Epi, class Sched, bool ALIGN_EPI = false, bool SP2 = false, bool HM = false>
__device__ __forceinline__ void gemm_phase(PG8_LAS unsigned char* lds, const Gemm g, const Sched& S, const Epi& E) {
    int tid_ = threadIdx.x; asm volatile("" : "+v"(tid_));
    const int tid = tid_, wid = __builtin_amdgcn_readfirstlane(tid >> 6), lane = tid & 63, wr = wid >> 2, wc = wid & 3, fr = lane & 15, fq = lane >> 4;
    const int K = g.K, nt = K / BK, LDA = g.lda ? g.lda : g.K;
    unsigned voffA[2], voffB[2];
#pragma unroll
    for (int i = 0; i < 2; ++i) { int R, C; stage_rc(tid * 16 + i * 8192, R, C); const int Rb = Epi::PERM ? ((R & ~31) + perm32(R & 31)) : R;
        voffA[i] = (unsigned)(R * LDA + C) * 2u; voffB[i] = (unsigned)(Rb * K + C) * 2u; }
    const size_t kstep = (size_t)(BK * 2);
    const size_t hstep = (size_t)HALF * K * 2;
    const size_t tstep = 2 * hstep;
    const size_t hstepA = (size_t)HALF * LDA * 2, tstepA = 2 * hstepA;
#define PG8_ABASE(pm_) ((const char*)g.A + (GEMM_SAMETILE ? (size_t)0 : ((pm_) < g.nMA ? (size_t)(pm_) * tstepA : (size_t)((pm_) - g.nMA) * tstepA + (size_t)g.a2off)))
    const unsigned ldsw = (unsigned)wid * 1024u;
    const int aoff = lds_byte(wr * 64 + fr, fq * 8), boff = lds_byte(wc * 32 + fr, fq * 8);
#define PG8_SA(b, h) (((b) * 2 + (h)) * HTB)
#define PG8_SB(b, h) ((4 + (b) * 2 + (h)) * HTB)
#define PG8_STAGE(bufoff, gbase, voff) do { _Pragma("unroll") for (int _i = 0; _i < 2; ++_i) \
        __builtin_amdgcn_global_load_lds((const unsigned*)((const char*)(gbase) + (voff)[_i]), (PG8_LAS unsigned*)(lds + (bufoff) + ldsw + _i * 8192), 16, 0, 0); } while (0)
#define PG8_LDA(dst, b, h) do { _Pragma("unroll") for (int m = 0; m < 4; ++m) _Pragma("unroll") for (int k = 0; k < 2; ++k) dst[m][k] = *(const PG8_LAS bf16x8*)(lds + PG8_SA(b, h) + aoff + m * 2048 + k * 1024); } while (0)
#define PG8_LDB(dst, b, h) do { _Pragma("unroll") for (int n = 0; n < 2; ++n) _Pragma("unroll") for (int k = 0; k < 2; ++k) dst[n][k] = *(const PG8_LAS bf16x8*)(lds + PG8_SB(b, h) + boff + n * 2048 + k * 1024); } while (0)
#define PG8_MMA(ai, bj, At, Bt) do { __builtin_amdgcn_s_setprio(1); _Pragma("unroll") for (int m = 0; m < 4; ++m) _Pragma("unroll") for (int n = 0; n < 2; ++n) _Pragma("unroll") for (int k = 0; k < 2; ++k) \
        acc[ai][bj][m][n] = __builtin_amdgcn_mfma_f32_16x16x32_bf16(Bt[n][k], At[m][k], acc[ai][bj][m][n], 0, 0, 0); __builtin_amdgcn_s_setprio(0); } while (0)
#define PG8_WAIT_V(n) asm volatile("s_waitcnt vmcnt(" #n ")" ::: "memory")
#define PG8_WAIT_L(n) asm volatile("s_waitcnt lgkmcnt(" #n ")" ::: "memory")
#define PG8_BAR __builtin_amdgcn_s_barrier()
#define PG8_SCHED __builtin_amdgcn_sched_barrier(0)
    Unit cur, nxt; int ui = 0;
    if (!S.next(0, cur)) return;
    f32x4 acc[2][2][4][2];
#pragma unroll
    for (int a = 0; a < 2; ++a)
#pragma unroll
        for (int b = 0; b < 2; ++b)
#pragma unroll
            for (int m = 0; m < 4; ++m)
#pragma unroll
                for (int n = 0; n < 2; ++n) acc[a][b][m][n] = (f32x4){0.f, 0.f, 0.f, 0.f};
    bf16x8 At[4][2], B0[2][2], B1[2][2];
    static_assert(!HM || SP2, "half units: SP2 schedule only");
    bool chalf = HM && cur.hm != 0; size_t cH = chalf ? 0 : hstepA;
    const char* cA = PG8_ABASE(cur.pm) + ((HM && cur.hm == 2) ? hstepA : 0); const char* cB = (const char*)g.Bt + (GEMM_SAMETILE ? (size_t)0 : (size_t)cur.pn * tstep);
    S.a_ready(cur);
    if constexpr (SP2) {
        PG8_STAGE(PG8_SB(0, 0), cB, voffB); PG8_STAGE(PG8_SB(0, 1), cB + hstep, voffB); PG8_STAGE(PG8_SA(0, 0), cA, voffA); PG8_STAGE(PG8_SA(0, 1), cA + cH, voffA);
        if (wr == 1) PG8_BAR;
        PG8_WAIT_V(2); PG8_BAR;
        PG8_STAGE(PG8_SB(1, 0), cB + kstep, voffB); PG8_STAGE(PG8_SA(1, 0), cA + kstep, voffA); PG8_STAGE(PG8_SB(1, 1), cB + hstep + kstep, voffB);
        PG8_WAIT_V(6); PG8_BAR;
    } else {
        PG8_STAGE(PG8_SB(0, 0), cB, voffB); PG8_STAGE(PG8_SA(0, 0), cA, voffA); PG8_STAGE(PG8_SB(0, 1), cB + hstep, voffB); PG8_STAGE(PG8_SA(0, 1), cA + cH, voffA);
        if (wr == 1) PG8_BAR;
        PG8_WAIT_V(4); PG8_BAR;
        PG8_STAGE(PG8_SB(1, 0), cB + kstep, voffB); PG8_STAGE(PG8_SA(1, 0), cA + kstep, voffA); PG8_STAGE(PG8_SB(1, 1), cB + hstep + kstep, voffB);
        PG8_WAIT_V(6); PG8_BAR;
    }
    for (;;) {
        const bool has_next = S.next(ui + 1, nxt);
        const bool nhalf = has_next ? (HM && nxt.hm != 0) : chalf; const size_t nH = nhalf ? 0 : hstepA;
        const char* nA = has_next ? PG8_ABASE(nxt.pm) + ((HM && nxt.hm == 2) ? hstepA : 0) : cA; const char* nB = has_next ? (const char*)g.Bt + (GEMM_SAMETILE ? (size_t)0 : (size_t)nxt.pn * tstep) : cB;
        for (int t = 0; t < nt; t += 2) {
            const bool last = (t == nt - 2);
            const char* a1 = cA + (size_t)(t + 1) * kstep;
            const char* a2 = last ? nA : cA + (size_t)(t + 2) * kstep; const char* b2 = last ? nB : cB + (size_t)(t + 2) * kstep;
            const char* a3 = a2 + kstep; const char* b3 = b2 + kstep;
            const size_t h2 = last ? nH : cH;
            if (last && has_next) S.a_ready(nxt);
            if constexpr (SP2) {
            PG8_LDB(B0, 0, 0); PG8_LDB(B1, 0, 1); PG8_SCHED; PG8_LDA(At, 0, 0); PG8_STAGE(PG8_SA(1, 1), a1 + cH, voffA);
            PG8_WAIT_V(8); PG8_WAIT_L(0); PG8_BAR; PG8_MMA(0, 0, At, B0); PG8_MMA(0, 1, At, B1); PG8_BAR; PG8_SCHED;
            if (!chalf) PG8_LDA(At, 0, 1); PG8_STAGE(PG8_SB(0, 0), b2, voffB); PG8_STAGE(PG8_SB(0, 1), b2 + hstep, voffB); PG8_STAGE(PG8_SA(0, 0), a2, voffA);
            PG8_WAIT_V(8); PG8_WAIT_L(0); PG8_BAR; if (!chalf) { PG8_MMA(1, 0, At, B0); PG8_MMA(1, 1, At, B1); } PG8_BAR; PG8_SCHED;
            PG8_LDB(B0, 1, 0); PG8_LDB(B1, 1, 1); PG8_SCHED; PG8_LDA(At, 1, 0); PG8_STAGE(PG8_SA(0, 1), a2 + h2, voffA);
            PG8_WAIT_V(8); PG8_WAIT_L(0); PG8_BAR; PG8_MMA(0, 0, At, B0); PG8_MMA(0, 1, At, B1); PG8_BAR; PG8_SCHED;
            if (!chalf) PG8_LDA(At, 1, 1); PG8_STAGE(PG8_SB(1, 0), b3, voffB); PG8_STAGE(PG8_SB(1, 1), b3 + hstep, voffB); PG8_STAGE(PG8_SA(1, 0), a3, voffA);
            PG8_WAIT_V(8); PG8_WAIT_L(0); PG8_BAR; if (!chalf) { PG8_MMA(1, 0, At, B0); PG8_MMA(1, 1, At, B1); } PG8_BAR; PG8_SCHED;
            } else {
            PG8_LDB(B0, 0, 0); PG8_SCHED; PG8_LDA(At, 0, 0); PG8_STAGE(PG8_SA(1, 1), a1 + cH, voffA);
            PG8_WAIT_L(8); PG8_BAR; PG8_WAIT_L(0); PG8_MMA(0, 0, At, B0); PG8_BAR; PG8_SCHED;
            PG8_LDB(B1, 0, 1); PG8_STAGE(PG8_SB(0, 0), b2, voffB);
            PG8_BAR; PG8_WAIT_L(0); PG8_MMA(0, 1, At, B1); PG8_BAR;
            PG8_LDA(At, 0, 1); PG8_STAGE(PG8_SA(0, 0), a2, voffA);
            PG8_BAR; PG8_WAIT_L(0); PG8_MMA(1, 0, At, B0); PG8_BAR; PG8_SCHED;
            PG8_STAGE(PG8_SB(0, 1), b2 + hstep, voffB);
            PG8_WAIT_V(6); PG8_BAR; PG8_MMA(1, 1, At, B1); PG8_BAR;
            PG8_LDB(B0, 1, 0); PG8_SCHED; PG8_LDA(At, 1, 0); PG8_STAGE(PG8_SA(0, 1), a2 + h2, voffA);
            PG8_WAIT_L(8); PG8_BAR; PG8_WAIT_L(0); PG8_MMA(0, 0, At, B0); PG8_BAR; PG8_SCHED;
            PG8_LDB(B1, 1, 1); PG8_STAGE(PG8_SB(1, 0), b3, voffB);
            PG8_BAR; PG8_WAIT_L(0); PG8_MMA(0, 1, At, B1); PG8_BAR;
            PG8_LDA(At, 1, 1); PG8_STAGE(PG8_SA(1, 0), a3, voffA);
            PG8_BAR; PG8_WAIT_L(0); PG8_MMA(1, 0, At, B0); PG8_BAR; PG8_SCHED;
            PG8_STAGE(PG8_SB(1, 1), b3 + hstep, voffB);
            PG8_WAIT_V(6); PG8_BAR; PG8_MMA(1, 1, At, B1); PG8_BAR;
            }
        }
        if (Epi::SUBST) { SUBSTAMP(5) }
        if constexpr (ALIGN_EPI) { if (wr == 0) PG8_BAR; }
        if constexpr (!Epi::AFTER_DRAIN) { for (int er_ = 0; er_ < (Epi::PROBE_REP ? EPI_REP : 1); ++er_) { E(acc, cur, wr, wc, fr, fq); if (Epi::PROBE_REP && EPI_REP > 1) asm volatile("" ::: "memory"); } S.done(cur); }
        if (Epi::SUBST) { SUBSTAMP(6) }
        if (!has_next) break;
        if (!E.keep(cur)) {
#pragma unroll
        for (int a = 0; a < 2; ++a)
#pragma unroll
            for (int b = 0; b < 2; ++b)
#pragma unroll
                for (int m = 0; m < 4; ++m)
#pragma unroll
                    for (int n = 0; n < 2; ++n) acc[a][b][m][n] = (f32x4){0.f, 0.f, 0.f, 0.f};
        }
        cur = nxt; cA = nA; cB = nB; chalf = nhalf; cH = nH; ++ui;
        if constexpr (ALIGN_EPI) { if (wr == 1) PG8_BAR; }
    }
    PG8_WAIT_V(0);
    if constexpr (!ALIGN_EPI) { if (wr == 0) PG8_BAR; }
    PG8_BAR;
    if constexpr (Epi::AFTER_DRAIN) { E.fused(acc, cur, wr, wc, fr, fq, lds, wid, lane); S.done(cur); }
#undef PG8_ABASE
#undef PG8_SA
#undef PG8_SB
#undef PG8_STAGE
#undef PG8_LDA
#undef PG8_LDB
#undef PG8_MMA
#undef PG8_WAIT_V
#undef PG8_WAIT_L
#undef PG8_BAR
#undef PG8_SCHED
}
}

constexpr int NWAVES = 8;
#ifndef MK_N_LAUNCHES
#define MK_N_LAUNCHES 1
#endif
constexpr int PER_PHASE = 9;
constexpr int N_LAUNCHES = MK_N_LAUNCHES;

constexpr int BATCH = 4, SEQ = 4096, D = 1024, M = BATCH * SEQ;
constexpr int DN_H = 4, DN_D = 128, DN_W = 512, DN_QKV = 1536;
constexpr int SW_H = 8, SW_KV = 2, SW_D = 64, SW_W = 512, SW_KVW = 128, WINDOW = 128;
constexpr int FF = 2816;
constexpr int D_IN = 4872;
constexpr int NP = 4864;
constexpr int PC_Z = 1536, PC_SQ = 2048, PC_SK = 2560, PC_SV = 2688, PC_G = 2816;
constexpr int PC_YDN = 0, PC_YSW = 512;
constexpr float EPS = 1e-6f;

constexpr size_t MiB = 1u << 20;
constexpr size_t WS_CTL = 0, CTL_ZERO_BYTES = 65536;
constexpr size_t WS_WIN = 1 * MiB;
constexpr size_t WS_WAB = 11 * MiB;
constexpr size_t WS_WOUT = 13 * MiB;
constexpr size_t WS_WGU = 15 * MiB;
constexpr size_t WS_WD = 26 * MiB;
constexpr size_t WS_RSTD = 32 * MiB;
constexpr size_t WS_GB = WS_RSTD + 64 * 1024;
constexpr size_t WS_SSQ = 33 * MiB;
constexpr size_t WS_SSQ2 = WS_SSQ + 65536;
constexpr size_t WS_XB = 34 * MiB;
constexpr size_t WS_Y = 66 * MiB;
constexpr size_t WS_PROJ = 98 * MiB;
constexpr size_t WS_UB = 250 * MiB;
constexpr size_t WS_END = 256 * MiB;
static_assert(WS_PROJ + (size_t)M * NP * 2 <= WS_UB, "ws map");
constexpr int CW_TMO = 0, CW_SCAN = 1024  , CW_WCOPY = 3201  , CW_NORMDONE = 3202  , CW_SWADONE = 3200  , CW_BAR = 4096, CW_P56 = 8192  , CW_P67 = 12288, CW_PAN = 12288  ;

constexpr int RING_OFF = 0, RING_BYTES = 131072;
constexpr int LDSCTL_OFF = RING_BYTES, MISC_OFF = LDSCTL_OFF + 320;
constexpr int LDS_BYTES = 147456;

#define GAS __attribute__((address_space(1)))
#define LAS __attribute__((address_space(3)))
typedef unsigned short bf16;
typedef unsigned v4u __attribute__((ext_vector_type(4)));
typedef float f32x4 __attribute__((ext_vector_type(4)));
typedef float f32x2 __attribute__((ext_vector_type(2)));
typedef GAS unsigned gu32;
#define RLX_AGENT __ATOMIC_RELAXED, __HIP_MEMORY_SCOPE_AGENT
#define LDS_WAIT() asm volatile("s_waitcnt lgkmcnt(0)" ::: "memory")
#define VM_WAIT() asm volatile("s_waitcnt vmcnt(0)" ::: "memory")
__device__ __forceinline__ unsigned f2bf(float f) { unsigned u = __builtin_bit_cast(unsigned, f); return (u + 0x7fffu + ((u >> 16) & 1u)) >> 16; }
__device__ __forceinline__ unsigned pk2(float lo, float hi) { return f2bf(lo) | (f2bf(hi) << 16); }
__device__ __forceinline__ float bflo(unsigned w) { return __builtin_bit_cast(float, w << 16); }
__device__ __forceinline__ float bfhi(unsigned w) { return __builtin_bit_cast(float, w & 0xffff0000u); }
__device__ __forceinline__ float bf1(bf16 h) { return __builtin_bit_cast(float, (unsigned)h << 16); }
__device__ __forceinline__ float sigm(float x) { return __builtin_amdgcn_rcpf(1.0f + __expf(-x)); }
__device__ __forceinline__ float frsq(float x) { return __builtin_amdgcn_rsqf(x); }
template <int CTRL> __device__ __forceinline__ float dpp_mov(float v) { return __builtin_bit_cast(float, __builtin_amdgcn_update_dpp(0, __builtin_bit_cast(int, v), CTRL, 0xf, 0xf, true)); }
__device__ __forceinline__ float sum4(float v) { v += dpp_mov<0xB1>(v); v += dpp_mov<0x4E>(v); return v; }
__device__ __forceinline__ float sum8(float v) { v = sum4(v); v += dpp_mov<0x141>(v); return v; }
__device__ __forceinline__ float sum16(float v) { v = sum8(v); v += dpp_mov<0x140>(v); return v; }
__device__ __forceinline__ float rdlane(float v, int l) { return __builtin_bit_cast(float, __builtin_amdgcn_readlane(__builtin_bit_cast(int, v), l)); }
__device__ __forceinline__ float wave_sum(float v) { v = sum16(v); return (rdlane(v, 0) + rdlane(v, 16)) + (rdlane(v, 32) + rdlane(v, 48)); }
__device__ __forceinline__ float sum32(float v, int lane) { v = sum16(v); const float lo = rdlane(v, 0) + rdlane(v, 16), hi = rdlane(v, 32) + rdlane(v, 48); return (lane & 32) ? hi : lo; }
__device__ __forceinline__ float wave_max(float v) {
#pragma unroll
    for (int o = 1; o < 64; o <<= 1) v = fmaxf(v, __shfl_xor(v, o));
    return v;
}

#define XB_TMO      128
#define XB_XCNT(j)  (256  + 64 * (j))
#define XB_XSUB(j)  (1280 + 64 * (j))
#define XB_XGEN(j)  (2304 + 64 * (j))
#define XB_TOP      3328
#define XB_TOPGEN   3392
#define XCD_BAR_WORDS 3456
#define XB_SPIN_CAP (1u << 18)
__device__ __forceinline__ unsigned xb_ld(unsigned* p)              { return __hip_atomic_load(p, __ATOMIC_RELAXED, __HIP_MEMORY_SCOPE_AGENT); }
__device__ __forceinline__ unsigned xb_add(unsigned* p, unsigned v) { return __hip_atomic_fetch_add(p, v, __ATOMIC_RELAXED, __HIP_MEMORY_SCOPE_AGENT); }
__device__ __forceinline__ unsigned xb_xcc_id() { return (unsigned)__builtin_amdgcn_s_getreg((3 << 11) | 20) & 0xFu; }
#define XB_SPIN(cond, bar) do { unsigned _sp = 0; while (cond) { __builtin_amdgcn_s_sleep(1); \
    if ((++_sp & 255u) == 0u) { if (xb_ld(&(bar)[XB_TMO])) break; if (_sp > XB_SPIN_CAP) { atomicAdd(&(bar)[XB_TMO], 1u); break; } } } } while (0)
struct XcdBarrier { unsigned* bar; unsigned x; volatile LAS unsigned* st; };
__device__ __forceinline__ XcdBarrier xcd_barrier_post(unsigned* bar, volatile LAS unsigned* st) {
    XcdBarrier b; b.bar = bar; b.x = xb_xcc_id(); b.st = st;
    if (threadIdx.x == 0) (void)xb_add(&bar[XB_XCNT(b.x)], 1u);
    return b;
}
__device__ __forceinline__ void xcd_barrier_complete(unsigned* bar, unsigned x, unsigned& nloc, unsigned& nx) {
    const unsigned G = gridDim.x * gridDim.y * gridDim.z;
    unsigned sum, cnt, mine, sp = 0u;
    for (;;) {
        sum = 0u; cnt = 0u; mine = 0u;
#pragma unroll
        for (unsigned j = 0; j < 16; ++j) { const unsigned c = xb_ld(&bar[XB_XCNT(j)]); sum += c; cnt += (c > 0u) ? 1u : 0u; mine = (j == x) ? c : mine; }
        if (sum == G) break;
        __builtin_amdgcn_s_sleep(1);
        if ((++sp & 255u) == 0u) { if (xb_ld(&bar[XB_TMO])) break; if (sp > XB_SPIN_CAP) { atomicAdd(&bar[XB_TMO], 1u); break; } }
    }
    nloc = mine > 0u ? mine : 1u; nx = cnt > 0u ? cnt : 1u;
}
__device__ __forceinline__ void xcd_barrier(const XcdBarrier& b) {
    asm volatile("s_waitcnt vmcnt(0)" ::: "memory");
    __syncthreads();
    if (threadIdx.x == 0) {
        unsigned* bar = b.bar;
        __builtin_amdgcn_s_waitcnt(0);
        unsigned nloc = b.st[0], nx = b.st[1];
        if (nloc == 0u) { xcd_barrier_complete(bar, b.x, nloc, nx); b.st[0] = nloc; b.st[1] = nx; }
#if BAR_EARLY_WB
        asm volatile("buffer_wbl2 sc1" ::: "memory");
#endif
        const unsigned old = xb_add(&bar[XB_XSUB(b.x)], 1u);
        const unsigned gen = old / nloc;
        if (old + 1u == (gen + 1u) * nloc) {
            __builtin_amdgcn_fence(__ATOMIC_RELEASE, "agent");
            asm volatile("s_waitcnt vmcnt(0)" ::: "memory");
            const unsigned og = xb_add(&bar[XB_TOP], 1u);
            const unsigned tg = og / nx;
            if (og + 1u == (tg + 1u) * nx) xb_add(&bar[XB_TOPGEN], 1u);
            else XB_SPIN(xb_ld(&bar[XB_TOPGEN]) == tg, bar);
            __builtin_amdgcn_fence(__ATOMIC_ACQUIRE, "agent");
            xb_add(&bar[XB_XGEN(b.x)], 1u);
            asm volatile("s_waitcnt vmcnt(0)" ::: "memory");
        } else {
            XB_SPIN(xb_ld(&bar[XB_XGEN(b.x)]) == gen, bar);
            __builtin_amdgcn_fence(__ATOMIC_ACQUIRE, "agent");
            asm volatile("s_waitcnt vmcnt(0)" ::: "memory");
        }
    }
    __syncthreads();
}

struct Args { const float* in[18]; float* out; unsigned char* ws; int ph_lo, ph_hi, li, ws_mib; };
typedef const __attribute__((address_space(4))) Args* KArgs;
#define FIN(k) (F.ka->in[k])
struct Frame {
    LAS unsigned char* lds;
    volatile LAS unsigned* MISC;
    gu32* ctl;
    int tid, lane, wave;
    int vcu, G;
    KArgs ka; float* out; unsigned char* ws;
};
__device__ const unsigned char T5_BUCKET[128] = {0,1,2,3,4,5,6,7,8,9,10,11,12,13,14,15,16,16,16,17,17,18,18,18,19,19,19,20,20,20,20,21,21,21,21,22,22,22,22,22,23,23,23,23,23,23,24,24,24,24,24,24,25,25,25,25,25,25,25,26,26,26,26,26,26,26,26,27,27,27,27,27,27,27,27,27,27,28,28,28,28,28,28,28,28,28,28,29,29,29,29,29,29,29,29,29,29,29,29,30,30,30,30,30,30,30,30,30,30,30,30,30,30,31,31,31,31,31,31,31,31,31,31,31,31,31,31,31};

__device__ __forceinline__ int lcol32(int nb) { return 256 * (nb >> 3) + 32 * (2 * (nb & 3) + ((nb >> 2) & 1)); }
constexpr int WI_IN = 16 * (NP / 32), WI_AB = 8 * 32, WI_OUT = 16 * 32, WI_GU = 16 * (2 * FF / 32), WI_D = (FF / 64) * 32, WI_ALL = WI_IN + 2 * WI_AB + WI_OUT + WI_GU + WI_D, WI_P0 = SEAM35 ? (SEAM56 ? WI_IN + 2 * WI_AB + WI_OUT : WI_IN + 2 * WI_AB) : WI_IN;
struct WItem { const float* W; int ldw, src_col0, K; bf16* WT; int dst_row0; const float* gain; int kb; };
__device__ __forceinline__ WItem weight_item(Frame& F, int it) {
    unsigned char* ws = F.ws;
    bf16* WinT = (bf16*)(ws + WS_WIN); bf16* WabT = (bf16*)(ws + WS_WAB); bf16* WoutT = (bf16*)(ws + WS_WOUT); bf16* WguT = (bf16*)(ws + WS_WGU); bf16* WdT = (bf16*)(ws + WS_WD);
    int r = it;
    if (r < WI_IN) { const int nb = r % (NP / 32), kb = r / (NP / 32), dr = 32 * nb, lc = lcol32(nb); return WItem{FIN(2), D_IN, lc < 2048 ? lc : lc + 8, D, WinT, dr, FIN(1), kb}; } r -= WI_IN;
    if (r < WI_AB) { const int nb = r % 32, kb = r / 32; return WItem{FIN(11), D, lcol32(nb), DN_W, WabT, 32 * nb, nullptr, kb}; } r -= WI_AB;
    if (r < WI_AB) { const int nb = r % 32, kb = r / 32; return WItem{FIN(12), D, lcol32(nb), SW_W, WabT, 1024 + 32 * nb, nullptr, kb}; } r -= WI_AB;
    if (r < WI_OUT) { const int nb = r % 32, kb = r / 32; return WItem{FIN(13), D, 32 * nb, D, WoutT, 32 * nb, nullptr, kb}; } r -= WI_OUT;
    if (r < WI_GU) { const int nb = r % (2 * FF / 32), kb = r / (2 * FF / 32), dr = 32 * nb, pn = dr >> 8, j = dr & 255;
        return WItem{(j < 128) ? FIN(15) : FIN(16), FF, 128 * pn + (j & 127), D, WguT, dr, FIN(14), kb}; } r -= WI_GU;
    { const int nb = r % 32, kb = r / 32; return WItem{FIN(17), D, 32 * nb, FF, WdT, 32 * nb, nullptr, kb}; }
}
__device__ __forceinline__ void witem_load(const WItem& w, int lane, f32x4 (&v)[8], float (&gn)[8]) {
    const int k0 = 64 * w.kb, c4 = 4 * (lane & 7);
#pragma unroll
    for (int i = 0; i < 8; ++i) { const int kk = 8 * i + (lane >> 3); v[i] = *(const f32x4*)(w.W + (size_t)(k0 + kk) * w.ldw + w.src_col0 + c4); gn[i] = w.gain ? w.gain[k0 + kk] : 1.0f; }
}
__device__ __forceinline__ void witem_store(const WItem& w, int lane, const f32x4 (&v)[8], const float (&gn)[8], LAS float* scr) {
    const int k0 = 64 * w.kb, c4 = 4 * (lane & 7);
#pragma unroll
    for (int i = 0; i < 8; ++i) { const int kk = 8 * i + (lane >> 3);
        scr[kk * 33 + c4] = v[i].x * gn[i]; scr[kk * 33 + c4 + 1] = v[i].y * gn[i]; scr[kk * 33 + c4 + 2] = v[i].z * gn[i]; scr[kk * 33 + c4 + 3] = v[i].w * gn[i]; }
    LDS_WAIT(); asm volatile("" ::: "memory");
    const int c = lane & 7;
#pragma unroll
    for (int j = 0; j < 4; ++j) { const int n = (lane >> 3) + 8 * j; const LAS float* s = scr + (8 * c) * 33 + n;
        v4u o; o.x = pk2(s[0 * 33], s[1 * 33]); o.y = pk2(s[2 * 33], s[3 * 33]); o.z = pk2(s[4 * 33], s[5 * 33]); o.w = pk2(s[6 * 33], s[7 * 33]);
        if (SEAM67) asm volatile("global_store_dwordx4 %0, %1, off sc1\n\ts_nop 2" :: "v"((GAS v4u*)(w.WT + (size_t)(w.dst_row0 + n) * w.K + k0 + 8 * c)), "v"(o) : "memory");
        else *(GAS v4u*)(w.WT + (size_t)(w.dst_row0 + n) * w.K + k0 + 8 * c) = o; }
    LDS_WAIT(); asm volatile("" ::: "memory");
}
__device__ __forceinline__ void weight_copies(Frame& F, int lo, int hi, int gw, int NGW) {
    LAS float* scr = (LAS float*)(F.lds + RING_OFF + F.wave * 16384);
    int it = lo + gw; if (it >= hi) return;
    f32x4 vc[8]; float gc[8];
    WItem cur = weight_item(F, it); witem_load(cur, F.lane, vc, gc);
    for (;;) {
        const int nx = it + NGW; const bool more = nx < hi;
        f32x4 vn[8]; float gnx[8]; WItem nxt = cur;
        if (more) { nxt = weight_item(F, nx); witem_load(nxt, F.lane, vn, gnx); }
        witem_store(cur, F.lane, vc, gc, scr);
        if (!more) break;
#pragma unroll
        for (int i = 0; i < 8; ++i) { vc[i] = vn[i]; gc[i] = gnx[i]; }
        cur = nxt; it = nx;
    }
}
__device__ __forceinline__ void p0_prologue(Frame& F) {
    const int gw = F.vcu * NWAVES + F.wave, NGW = F.G * NWAVES;
    unsigned char* ws = F.ws;
    weight_copies(F, 0, (F.G == 256 && DEFER_WEIGHTS) ? WI_P0 : WI_ALL, gw, NGW);
    __syncthreads();
    LAS float* wba = (LAS float*)(F.lds + RING_OFF);
    for (int idx = F.tid; idx < 8 * D; idx += NWAVES * 64) { const int k = idx >> 3, j = idx & 7; wba[j * D + k] = FIN(2)[(size_t)k * D_IN + 2048 + j] * FIN(1)[k]; }
    __syncthreads();
    const float* x = FIN(0); bf16* XB = (bf16*)(ws + WS_XB); float* rstd1 = (float*)(ws + WS_RSTD); float* gbp = (float*)(ws + WS_GB); float* ssq2 = (float*)(ws + WS_SSQ2);
    const float alog_or_dt = (F.lane & 32) ? FIN(5)[(F.lane >> 3) & 3] : 0.f;
    const float negA = -expf(FIN(4)[(F.lane >> 3) & 3]);
#if P0_DEEP
    auto do_row = [&](const f32x4 (&v)[4], int m) {
        float ss = 0.f;
#pragma unroll
        for (int j = 0; j < 4; ++j) ss += (v[j].x * v[j].x + v[j].y * v[j].y) + (v[j].z * v[j].z + v[j].w * v[j].w);
        GAS unsigned long long* o8 = (GAS unsigned long long*)(XB + (size_t)m * D) + F.lane;
#pragma unroll
        for (int j = 0; j < 4; ++j) { const unsigned long long w = (unsigned long long)pk2(v[j].x, v[j].y) | ((unsigned long long)pk2(v[j].z, v[j].w) << 32);
            asm volatile("global_store_dwordx2 %0, %1, off" :: "v"(o8 + 64 * j), "v"(w) : "memory"); }
        float acc[8];
#pragma unroll
        for (int c = 0; c < 8; ++c) { float a = 0.f;
#pragma unroll
            for (int j = 0; j < 4; ++j) { const f32x4 w = *(const LAS f32x4*)(wba + c * D + 256 * j + 4 * F.lane); a += (v[j].x * w.x + v[j].y * w.y) + (v[j].z * w.z + v[j].w * w.w); }
            acc[c] = a; }
        ss = wave_sum(ss);
        float r4[4], r2[2], r1;
        { const bool up = (F.lane & 32) != 0;
#pragma unroll
          for (int i = 0; i < 4; ++i) { const float keep = up ? acc[4 + i] : acc[i], send = up ? acc[i] : acc[4 + i]; r4[i] = keep + __shfl_xor(send, 32); } }
        { const bool up = (F.lane & 16) != 0;
#pragma unroll
          for (int i = 0; i < 2; ++i) { const float keep = up ? r4[2 + i] : r4[i], send = up ? r4[i] : r4[2 + i]; r2[i] = keep + __shfl_xor(send, 16); } }
        { const bool up = (F.lane & 8) != 0; const float keep = up ? r2[1] : r2[0], send = up ? r2[0] : r2[1]; r1 = keep + __shfl_xor(send, 8); }
        r1 = sum8(r1);
        const float rstd = frsq(ss * (1.0f / D) + EPS);
        if (F.lane == 0) { asm volatile("global_store_dword %0, %1, off" :: "v"((GAS float*)(rstd1 + m)), "v"(rstd) : "memory"); asm volatile("global_store_dword %0, %1, off" :: "v"((GAS float*)(ssq2 + m)), "v"(0.f) : "memory"); }
        if ((F.lane & 7) == 0) {
            const float val = r1 * rstd; float res;
            if (F.lane < 32) res = 1.0f / (1.0f + expf(-val));
            else { const float xx = val + alog_or_dt; const float sp = xx > 20.f ? xx : log1pf(expf(xx)); res = negA * sp; }
            asm volatile("global_store_dword %0, %1, off" :: "v"((GAS float*)(gbp + (size_t)m * 8 + (F.lane >> 3))), "v"(res) : "memory");
        }
    };
    f32x4 qa[4], qb[4];
#pragma unroll
    for (int j = 0; j < 4; ++j) { qa[j] = (f32x4){0.f, 0.f, 0.f, 0.f}; qb[j] = qa[j]; }
    if (gw < M) {
#pragma unroll
        for (int j = 0; j < 4; ++j) qa[j] = ((const GAS f32x4*)(x + (size_t)gw * D) + F.lane)[64 * j]; }
    if (gw + NGW < M) {
#pragma unroll
        for (int j = 0; j < 4; ++j) qb[j] = ((const GAS f32x4*)(x + (size_t)(gw + NGW) * D) + F.lane)[64 * j]; }
    for (int m = gw; m < M; m += 2 * NGW) {
        f32x4 v[4];
#pragma unroll
        for (int j = 0; j < 4; ++j) v[j] = qa[j];
        if (m + 2 * NGW < M) {
#pragma unroll
            for (int j = 0; j < 4; ++j) qa[j] = ((const GAS f32x4*)(x + (size_t)(m + 2 * NGW) * D) + F.lane)[64 * j]; }
        do_row(v, m);
        if (m + NGW < M) {
#pragma unroll
            for (int j = 0; j < 4; ++j) v[j] = qb[j];
            if (m + 3 * NGW < M) {
#pragma unroll
                for (int j = 0; j < 4; ++j) qb[j] = ((const GAS f32x4*)(x + (size_t)(m + 3 * NGW) * D) + F.lane)[64 * j]; }
            do_row(v, m + NGW);
        }
    }
}
#else
    f32x4 vnx[4];
    if (gw < M) {
#pragma unroll
        for (int j = 0; j < 4; ++j) vnx[j] = ((const GAS f32x4*)(x + (size_t)gw * D) + F.lane)[64 * j]; }
    for (int m = gw; m < M; m += NGW) {
        f32x4 v[4]; float ss = 0.f;
#pragma unroll
        for (int j = 0; j < 4; ++j) { v[j] = vnx[j]; ss += (v[j].x * v[j].x + v[j].y * v[j].y) + (v[j].z * v[j].z + v[j].w * v[j].w); }
        if (m + NGW < M) {
#pragma unroll
            for (int j = 0; j < 4; ++j) vnx[j] = ((const GAS f32x4*)(x + (size_t)(m + NGW) * D) + F.lane)[64 * j]; }
        GAS unsigned long long* o8 = (GAS unsigned long long*)(XB + (size_t)m * D) + F.lane;
#pragma unroll
        for (int j = 0; j < 4; ++j) o8[64 * j] = (unsigned long long)pk2(v[j].x, v[j].y) | ((unsigned long long)pk2(v[j].z, v[j].w) << 32);
        float acc[8];
#pragma unroll
        for (int c = 0; c < 8; ++c) { float a = 0.f;
#pragma unroll
            for (int j = 0; j < 4; ++j) { const f32x4 w = *(const LAS f32x4*)(wba + c * D + 256 * j + 4 * F.lane); a += (v[j].x * w.x + v[j].y * w.y) + (v[j].z * w.z + v[j].w * w.w); }
            acc[c] = a; }
        ss = wave_sum(ss);
        float r4[4], r2[2], r1;
        { const bool up = (F.lane & 32) != 0;
#pragma unroll
          for (int i = 0; i < 4; ++i) { const float keep = up ? acc[4 + i] : acc[i], send = up ? acc[i] : acc[4 + i]; r4[i] = keep + __shfl_xor(send, 32); } }
        { const bool up = (F.lane & 16) != 0;
#pragma unroll
          for (int i = 0; i < 2; ++i) { const float keep = up ? r4[2 + i] : r4[i], send = up ? r4[i] : r4[2 + i]; r2[i] = keep + __shfl_xor(send, 16); } }
        { const bool up = (F.lane & 8) != 0; const float keep = up ? r2[1] : r2[0], send = up ? r2[0] : r2[1]; r1 = keep + __shfl_xor(send, 8); }
        r1 = sum8(r1);
        const float rstd = frsq(ss * (1.0f / D) + EPS);
        if (F.lane == 0) { rstd1[m] = rstd; ssq2[m] = 0.f; }
        if ((F.lane & 7) == 0) {
            const float val = r1 * rstd; float res;
            if (F.lane < 32) res = 1.0f / (1.0f + expf(-val));
            else { const float xx = val + alog_or_dt; const float sp = xx > 20.f ? xx : log1pf(expf(xx)); res = negA * sp; }
            gbp[(size_t)m * 8 + (F.lane >> 3)] = res;
        }
    }
}
#endif

__device__ __forceinline__ void dn_pre(Frame& F) {
    const int gw = F.vcu * NWAVES + F.wave, NGW = F.G * NWAVES;
    const bf16* proj = (const bf16*)(F.ws + WS_PROJ); const float* conv = FIN(3);
    float* QN = F.out; float* KN = F.out + (size_t)M * DN_W; float* VV = (float*)(F.ws + WS_XB);
    for (int task = gw; task < M * DN_H; task += NGW) {
        const int m = task >> 2, h = task & 3, t = m & (SEQ - 1);
        float val[3][2];
#pragma unroll
        for (int part = 0; part < 3; ++part) { const int col = part * DN_W + h * DN_D + 2 * F.lane; float a0 = 0.f, a1 = 0.f;
#pragma unroll
            for (int j = 0; j < 4; ++j) { if (t - 3 + j >= 0) { const unsigned w = *(const unsigned*)(proj + (size_t)(m - 3 + j) * NP + col); a0 += conv[j * DN_QKV + col] * bflo(w); a1 += conv[j * DN_QKV + col + 1] * bfhi(w); } }
            val[part][0] = a0 * sigm(a0); val[part][1] = a1 * sigm(a1); }
        const float rq = 1.0f / sqrtf(wave_sum(val[0][0] * val[0][0] + val[0][1] * val[0][1]) + EPS) * 0.08838834764831845f;
        const float rk = 1.0f / sqrtf(wave_sum(val[1][0] * val[1][0] + val[1][1] * val[1][1]) + EPS);
        const size_t o = (size_t)m * DN_W + h * DN_D + 2 * F.lane;
        *(f32x2*)(QN + o) = (f32x2){val[0][0] * rq, val[0][1] * rq};
        *(f32x2*)(KN + o) = (f32x2){val[1][0] * rk, val[1][1] * rk};
        *(f32x2*)(VV + o) = (f32x2){val[2][0], val[2][1]};
    }
}
__device__ __forceinline__ void dn_scan_naive(Frame& F, int bh) {
    const int b = bh >> 2, h = bh & 3, tid = F.tid, dvi = tid >> 2, kq = tid & 3;
    LAS float* kL = (LAS float*)(F.lds + RING_OFF); LAS float* qL = kL + 32 * 128; LAS float* vL = qL + 32 * 128; LAS float* gL = vL + 32 * 128; LAS float* bL = gL + 32;
    const float* QN = F.out; const float* KN = F.out + (size_t)M * DN_W; float* VV = (float*)(F.ws + WS_XB); const float* gbp = (const float*)(F.ws + WS_GB);
    float S[32];
#pragma unroll
    for (int j = 0; j < 32; ++j) S[j] = 0.f;
    for (int t0 = 0; t0 < SEQ; t0 += 32) {
#pragma unroll
        for (int r = 0; r < 2; ++r) { const int idx = tid + 512 * r, tok = idx >> 5, c4 = idx & 31; const size_t src = (size_t)(b * SEQ + t0 + tok) * DN_W + h * DN_D + c4 * 4;
            *(LAS f32x4*)(kL + tok * 128 + c4 * 4) = *(const f32x4*)(KN + src); *(LAS f32x4*)(qL + tok * 128 + c4 * 4) = *(const f32x4*)(QN + src); *(LAS f32x4*)(vL + tok * 128 + c4 * 4) = *(const f32x4*)(VV + src); }
        if (tid < 32) { const size_t mm = (size_t)(b * SEQ + t0 + tid); bL[tid] = gbp[mm * 8 + h]; gL[tid] = gbp[mm * 8 + 4 + h]; }
        __syncthreads();
        for (int i = 0; i < 32; ++i) {
            const float eg = __expf(gL[i]), be = bL[i];
            float kk[32];
#pragma unroll
            for (int j = 0; j < 8; ++j) { const f32x4 w = *(const LAS f32x4*)(kL + i * 128 + kq * 32 + 4 * j); kk[4 * j] = w.x; kk[4 * j + 1] = w.y; kk[4 * j + 2] = w.z; kk[4 * j + 3] = w.w; }
            float part = 0.f;
#pragma unroll
            for (int j = 0; j < 32; ++j) part += kk[j] * S[j];
            part += __shfl_xor(part, 1); part += __shfl_xor(part, 2);
            const float c = be * (vL[i * 128 + dvi] - eg * part);
#pragma unroll
            for (int j = 0; j < 32; ++j) S[j] = eg * S[j] + c * kk[j];
            float po = 0.f;
#pragma unroll
            for (int j = 0; j < 8; ++j) { const f32x4 w = *(const LAS f32x4*)(qL + i * 128 + kq * 32 + 4 * j); po += (w.x * S[4 * j] + w.y * S[4 * j + 1]) + (w.z * S[4 * j + 2] + w.w * S[4 * j + 3]); }
            po += __shfl_xor(po, 1); po += __shfl_xor(po, 2);
            if (kq == 0) vL[i * 128 + dvi] = po;
        }
        __syncthreads();
#pragma unroll
        for (int r = 0; r < 2; ++r) { const int idx = tid + 512 * r, tok = idx >> 5, c4 = idx & 31; const size_t src = (size_t)(b * SEQ + t0 + tok) * DN_W + h * DN_D + c4 * 4;
            *(f32x4*)(VV + src) = *(const LAS f32x4*)(vL + tok * 128 + c4 * 4); }
        __syncthreads();
    }
}
__device__ __forceinline__ void swa_naive(Frame& F, int wv, int nworkers) {
    const bf16* proj = (const bf16*)(F.ws + WS_PROJ); bf16* YSWA = (bf16*)(F.ws + WS_Y) + (size_t)M * SW_W;
    LAS float* qs = (LAS float*)(F.lds + RING_OFF + 65536 + F.wave * 1024); LAS float* ps = qs + 64;
    const float* qg = FIN(7); const float* kg = FIN(8); const float* sinks = FIN(9); const float* relb = FIN(10);
    const int lane = F.lane;
    for (int task = wv; task < M * SW_H; task += nworkers) {
        const int m = task >> 3, qh = task & 7, kvh = qh >> 2, t = m & (SEQ - 1);
        const float q = bf1(proj[(size_t)m * NP + PC_SQ + qh * SW_D + lane]);
        const float qn = q * (1.0f / sqrtf(wave_sum(q * q) * (1.0f / SW_D) + EPS)) * qg[lane];
        qs[lane] = qn * kg[lane];
        LDS_WAIT(); asm volatile("" ::: "memory");
        float lg[2];
#pragma unroll
        for (int hf = 0; hf < 2; ++hf) { const int j = lane + 64 * hf; lg[hf] = -INFINITY;
            if (t - 127 + j >= 0) { const v4u* kr = (const v4u*)(proj + (size_t)(m - 127 + j) * NP + PC_SK + kvh * SW_D); float ssk = 0.f, dot = 0.f;
#pragma unroll
                for (int c = 0; c < 8; ++c) { const v4u w = kr[c];
#pragma unroll
                    for (int e = 0; e < 4; ++e) { const float k0 = bflo(w[e]), k1 = bfhi(w[e]); ssk += k0 * k0 + k1 * k1; dot += qs[8 * c + 2 * e] * k0 + qs[8 * c + 2 * e + 1] * k1; } }
                lg[hf] = dot * (1.0f / sqrtf(ssk * (1.0f / SW_D) + EPS)) * 0.125f + relb[(int)T5_BUCKET[127 - j] * SW_H + qh]; } }
        const float sink = sinks[qh];
        const float mx = fmaxf(wave_max(fmaxf(lg[0], lg[1])), sink);
        const float p0 = (lg[0] == -INFINITY) ? 0.f : __expf(lg[0] - mx), p1 = (lg[1] == -INFINITY) ? 0.f : __expf(lg[1] - mx);
        const float den = wave_sum(p0 + p1) + __expf(sink - mx);
        ps[lane] = p0; ps[lane + 64] = p1;
        LDS_WAIT(); asm volatile("" ::: "memory");
        float o = 0.f; const int jmin = (127 - t) > 0 ? (127 - t) : 0;
        for (int j = jmin; j < 128; ++j) o += ps[j] * bf1(proj[(size_t)(m - 127 + j) * NP + PC_SV + kvh * SW_D + lane]);
        YSWA[(size_t)m * SW_W + qh * SW_D + lane] = (bf16)f2bf(o / den);
        LDS_WAIT(); asm volatile("" ::: "memory");
    }
}
__device__ __forceinline__ void dn_out(Frame& F) {
    const int gw = F.vcu * NWAVES + F.wave, NGW = F.G * NWAVES;
    const bf16* proj = (const bf16*)(F.ws + WS_PROJ); const float* VV = (const float*)(F.ws + WS_XB); bf16* YDN = (bf16*)(F.ws + WS_Y); const float* gain = FIN(6);
    for (int task = gw; task < M * DN_H; task += NGW) {
        const int m = task >> 2, h = task & 3;
        const f32x2 o = *(const f32x2*)(VV + (size_t)m * DN_W + h * DN_D + 2 * F.lane);
        const float r = 1.0f / sqrtf(wave_sum(o.x * o.x + o.y * o.y) * (1.0f / DN_D) + EPS);
        const unsigned zw = *(const unsigned*)(proj + (size_t)m * NP + PC_Z + h * DN_D + 2 * F.lane); const float z0 = bflo(zw), z1 = bfhi(zw);
        *(unsigned*)(YDN + (size_t)m * DN_W + h * DN_D + 2 * F.lane) = pk2(o.x * r * gain[2 * F.lane] * z0 * sigm(z0), o.y * r * gain[2 * F.lane + 1] * z1 * sigm(z1));
    }
}

typedef short bf16x8 __attribute__((ext_vector_type(8)));
typedef float f32x16 __attribute__((ext_vector_type(16)));
typedef unsigned u32x2 __attribute__((ext_vector_type(2)));
typedef __bf16 bf16x2_t __attribute__((ext_vector_type(2)));
__device__ __forceinline__ unsigned cvtpk(float lo, float hi) { f32x2 v = {lo, hi}; return __builtin_bit_cast(unsigned, __builtin_convertvector(v, bf16x2_t)); }
__device__ __forceinline__ bf16x8 pack8(f32x4 a, f32x4 b) { v4u w; w.x = cvtpk(a[0], a[1]); w.y = cvtpk(a[2], a[3]); w.z = cvtpk(b[0], b[1]); w.w = cvtpk(b[2], b[3]); return __builtin_bit_cast(bf16x8, w); }
__device__ __forceinline__ bf16x8 pack8z(f32x4 a) { v4u w; w.x = cvtpk(a[0], a[1]); w.y = cvtpk(a[2], a[3]); w.z = 0u; w.w = 0u; return __builtin_bit_cast(bf16x8, w); }
#define MFMA16(a, b, c) __builtin_amdgcn_mfma_f32_16x16x32_bf16((a), (b), (c), 0, 0, 0)
#define MFMA32(a, b, c) __builtin_amdgcn_mfma_f32_32x32x16_bf16((a), (b), (c), 0, 0, 0)
constexpr float LOG2E = 1.4426950408889634f;

__device__ __forceinline__ void swa_pre(Frame& F) {
    const int gw = F.vcu * NWAVES + F.wave, NGW = F.G * NWAVES, lane = F.lane;
    const bf16* proj = (const bf16*)(F.ws + WS_PROJ);
    bf16* KS = (bf16*)(F.ws + WS_Y); bf16* VT = KS + 2 * 1024 * 1024; bf16* QS = (bf16*)(F.ws + WS_Y) + (size_t)M * SW_W;
    const float* qg = FIN(7); const float* kg = FIN(8);
    v4u wq_n = {0u, 0u, 0u, 0u}; unsigned wk_n = 0u;
    if (!FUSE_QKNORM && gw < M) { wq_n = *(const v4u*)(proj + (size_t)gw * NP + PC_SQ + 8 * lane); wk_n = *(const unsigned*)(proj + (size_t)gw * NP + PC_SK + 2 * lane); }
    const f32x4 g0 = *(const f32x4*)(qg + 8 * (lane & 7)), g1 = *(const f32x4*)(qg + 8 * (lane & 7) + 4);
    const float kg0 = kg[2 * (lane & 31)], kg1 = kg[2 * (lane & 31) + 1];
    if (!FUSE_QKNORM)
    for (int m = gw; m < M; m += NGW) {
        const v4u w = wq_n; const unsigned wk = wk_n;
        if (m + NGW < M) { wq_n = *(const v4u*)(proj + (size_t)(m + NGW) * NP + PC_SQ + 8 * lane); wk_n = *(const unsigned*)(proj + (size_t)(m + NGW) * NP + PC_SK + 2 * lane); }
        {
            float x[8];
#pragma unroll
            for (int j = 0; j < 4; ++j) { x[2 * j] = bflo(w[j]); x[2 * j + 1] = bfhi(w[j]); }
            float ss = 0.f;
#pragma unroll
            for (int j = 0; j < 8; ++j) ss += x[j] * x[j];
            ss = sum8(ss);
            const float r = frsq(ss * (1.0f / SW_D) + EPS) * (0.125f * LOG2E);
            v4u o; o.x = cvtpk(x[0] * r * g0[0], x[1] * r * g0[1]); o.y = cvtpk(x[2] * r * g0[2], x[3] * r * g0[3]); o.z = cvtpk(x[4] * r * g1[0], x[5] * r * g1[1]); o.w = cvtpk(x[6] * r * g1[2], x[7] * r * g1[3]);
            *(v4u*)(QS + (size_t)m * SW_W + 8 * lane) = o;
        }
        {
            const float k0 = bflo(wk), k1 = bfhi(wk);
            float ss = k0 * k0 + k1 * k1;
            ss = sum32(ss, lane);
            const float r = frsq(ss * (1.0f / SW_D) + EPS); const int d = 2 * (lane & 31), b = m >> 12, t = m & (SEQ - 1), kvh = lane >> 5;
            *(unsigned*)(KS + ((size_t)(b * 2 + kvh) * SEQ + t) * SW_D + d) = cvtpk(k0 * r * kg0, k1 * r * kg1);
        }
    }
    for (int task = gw; task < BATCH * SW_KV * (SEQ / 32); task += NGW) {
        const int bk = task >> 7, tile = task & 127, b = bk >> 1, kvh = bk & 1; const size_t m0 = (size_t)b * SEQ + tile * 32;
        unsigned v[32];
#pragma unroll
        for (int i = 0; i < 32; ++i) v[i] = proj[(m0 + i) * NP + PC_SV + kvh * SW_D + lane];
        bf16* dst = VT + ((size_t)(bk * 128 + tile) * 64 + lane) * 32;
#pragma unroll
        for (int q4 = 0; q4 < 4; ++q4) { v4u o;
#pragma unroll
            for (int jj = 0; jj < 4; ++jj) { const int p0 = 8 * q4 + 2 * jj, p1 = p0 + 1;
                const int k0 = 16 * (p0 >> 4) + 8 * ((p0 & 7) >> 2) + 4 * ((p0 >> 3) & 1) + (p0 & 3), k1 = 16 * (p1 >> 4) + 8 * ((p1 & 7) >> 2) + 4 * ((p1 >> 3) & 1) + (p1 & 3);
                o[jj] = v[k0] | (v[k1] << 16); }
            *(v4u*)(dst + 8 * q4) = o; }
    }
}
__device__ __forceinline__ void swa_bias_table(Frame& F) {
    LAS float* biasT = (LAS float*)(F.lds + RING_OFF);
    for (int idx = F.tid; idx < SW_H * 128; idx += NWAVES * 64) { const int h = idx >> 7, dist = idx & 127; biasT[idx] = FIN(10)[(int)T5_BUCKET[dist] * SW_H + h] * LOG2E; }
}
__device__ __forceinline__ void swa_main(Frame& F, int worker, int nworkers, int u_hi = BATCH * SW_H * (SEQ / 32)) {
    const LAS float* biasT = (const LAS float*)(F.lds + RING_OFF);
    const bf16* KS = (const bf16*)(F.ws + WS_Y); const bf16* VT = KS + 2 * 1024 * 1024; const bf16* QS = (const bf16*)(F.ws + WS_Y) + (size_t)M * SW_W;
    bf16* YSW = (bf16*)(F.ws + WS_PROJ) + PC_YSW;
    const int lane = F.lane, l31 = lane & 31, hh = lane >> 5;
    for (int u = worker; u < u_hi; u += nworkers) {
        const int qblk = u & 127, h = (u >> 7) & 7, b = u >> 10, kvh = h >> 2, bk = b * 2 + kvh, q0 = qblk * 32; const size_t m0 = (size_t)b * SEQ + q0;
        bf16x8 qf[4], kf[5][4];
#pragma unroll
        for (int ks = 0; ks < 4; ++ks) qf[ks] = *(const bf16x8*)(QS + (m0 + l31) * SW_W + h * SW_D + 16 * ks + 8 * hh);
#pragma unroll
        for (int i = 0; i < 5; ++i) { const int ts = q0 - 128 + 32 * i, tsc = ts < 0 ? 0 : ts;
#pragma unroll
            for (int ks = 0; ks < 4; ++ks) kf[i][ks] = *(const bf16x8*)(KS + ((size_t)bk * SEQ + tsc + l31) * SW_D + 16 * ks + 8 * hh); }
        __builtin_amdgcn_sched_barrier(0);
        f32x16 s[5];
#pragma unroll
        for (int i = 0; i < 5; ++i) {
            const int ts = q0 - 128 + 32 * i;
            f32x16 acc;
#pragma unroll
            for (int r = 0; r < 16; ++r) acc[r] = 0.f;
#pragma unroll
            for (int ks = 0; ks < 4; ++ks) acc = MFMA32(kf[i][ks], qf[ks], acc);
#pragma unroll
            for (int r = 0; r < 16; ++r) { const int row = (r & 3) + 8 * (r >> 2) + 4 * hh, dist = 128 - 32 * i + l31 - row; const bool ok = ts >= 0 && dist >= 0 && dist <= 127;
                s[i][r] = ok ? acc[r] + biasT[h * 128 + (dist & 127)] : -INFINITY; }
        }
        bf16x8 vf[5][2][2];
#pragma unroll
        for (int i = 0; i < 5; ++i) { const int ts = q0 - 128 + 32 * i, tsc = ts < 0 ? 0 : ts;
#pragma unroll
            for (int s2 = 0; s2 < 2; ++s2)
#pragma unroll
                for (int nt = 0; nt < 2; ++nt) vf[i][s2][nt] = *(const bf16x8*)(VT + ((size_t)(bk * 128 + (tsc >> 5)) * 64 + 32 * nt + l31) * 32 + s2 * 16 + hh * 8); }
        __builtin_amdgcn_sched_barrier(0);
        const float sink2 = FIN(9)[h] * LOG2E;
        float mx = sink2;
#pragma unroll
        for (int i = 0; i < 5; ++i)
#pragma unroll
            for (int r = 0; r < 16; ++r) mx = fmaxf(mx, s[i][r]);
        mx = fmaxf(mx, __shfl_xor(mx, 32));
        float sum = 0.f;
#pragma unroll
        for (int i = 0; i < 5; ++i)
#pragma unroll
            for (int r = 0; r < 16; ++r) { const float p = __builtin_amdgcn_exp2f(s[i][r] - mx); s[i][r] = p; sum += p; }
        sum += __shfl_xor(sum, 32);
        const float inv = __builtin_amdgcn_rcpf(sum + __builtin_amdgcn_exp2f(sink2 - mx));
        f32x16 O[2];
#pragma unroll
        for (int r = 0; r < 16; ++r) { O[0][r] = 0.f; O[1][r] = 0.f; }
#pragma unroll
        for (int i = 0; i < 5; ++i) {
#pragma unroll
            for (int s2 = 0; s2 < 2; ++s2) {
                v4u w; w.x = cvtpk(s[i][8 * s2] * inv, s[i][8 * s2 + 1] * inv); w.y = cvtpk(s[i][8 * s2 + 2] * inv, s[i][8 * s2 + 3] * inv); w.z = cvtpk(s[i][8 * s2 + 4] * inv, s[i][8 * s2 + 5] * inv); w.w = cvtpk(s[i][8 * s2 + 6] * inv, s[i][8 * s2 + 7] * inv);
                const bf16x8 pa = __builtin_bit_cast(bf16x8, w);
#pragma unroll
                for (int nt = 0; nt < 2; ++nt) O[nt] = MFMA32(pa, vf[i][s2][nt], O[nt]);
            }
        }
        {
            LAS unsigned char* stg = F.lds + RING_OFF + 8192 + F.wave * 4608;
#pragma unroll
            for (int nt = 0; nt < 2; ++nt)
#pragma unroll
                for (int r = 0; r < 16; ++r) { const int q = (r & 3) + 8 * (r >> 2) + 4 * hh; *(LAS unsigned short*)(stg + q * 144 + (32 * nt + l31) * 2) = (unsigned short)(cvtpk(O[nt][r], 0.f) & 0xffffu); }
            asm volatile("s_waitcnt lgkmcnt(0)" ::: "memory");
#pragma unroll
            for (int i = 0; i < 4; ++i) { const int row = 8 * i + (lane >> 3), ch16 = lane & 7; const v4u v = *(const LAS v4u*)(stg + row * 144 + ch16 * 16);
                if (SEAM35) { GAS v4u* dst = (GAS v4u*)(YSW + (m0 + row) * NP + h * SW_D + ch16 * 8); asm volatile("global_store_dwordx4 %0, %1, off sc1\n\ts_nop 2" :: "v"(dst), "v"(v) : "memory"); }
                else *(v4u*)(YSW + (m0 + row) * NP + h * SW_D + ch16 * 8) = v; }
            asm volatile("s_waitcnt lgkmcnt(0)" ::: "memory");
        }
    }
#if SEAM35
    asm volatile("s_waitcnt vmcnt(0)" ::: "memory");
    unsigned nun = 0u;
    for (int u = worker; u < u_hi; u += nworkers) { const int qblk = u & 127, b = u >> 10; ++nun;
        if (lane == 0) __hip_atomic_fetch_add(F.ctl + CW_PAN + 64 * (b * 16 + (qblk >> 3)) + 1, 1u, RLX_AGENT); }
    if (lane == 0 && nun) __hip_atomic_fetch_add(F.ctl + CW_SWADONE + 64 * (worker & 7), nun, RLX_AGENT);
#endif
}

constexpr int DNL_QT = 0, DNL_KT = 17408, DNL_VT = 34816, DNL_WL = 52224, DNL_NA = 69632, DNL_QKM = 78848, DNL_DB = 88064, DNL_TIB = 92160, DNL_GC = 94208, DNL_BETA = 94464;
constexpr int TP = 272;
constexpr int NP2 = 144;
struct DnRec { bf16* UA; bf16* UB; bf16* W; bf16* QG; bf16* KD; bf16* QK; float* EGL;
    __device__ __forceinline__ bf16* u(int ch, int sl, int mt, int lane) const { return (ch < 640 ? UA + (size_t)ch * 8192 : UB + (size_t)(ch - 640) * 8192) + ((sl * 4 + mt) * 64 + lane) * 4; } };
__device__ __forceinline__ DnRec dn_rec(Frame& F) {
    DnRec r; r.W = (bf16*)F.out; r.QG = r.W + 8 * 1024 * 1024; r.KD = r.W + 16 * 1024 * 1024; r.QK = r.W + 24 * 1024 * 1024; r.UA = r.W + 27 * 1024 * 1024; r.UB = (bf16*)(F.ws + WS_UB); r.EGL = (float*)(F.ws + WS_SSQ); return r;
}
#if STAMP_DN >= 0
__device__ unsigned long long g_dn[8];
#define DNSTAMP(i) if (blockIdx.x == STAMP_BLOCK && threadIdx.x == 0) { const unsigned long long now_ = __builtin_amdgcn_s_memrealtime(); dnacc_[i] += now_ - dnlast_; dnlast_ = now_; }
#else
#define DNSTAMP(i)
#endif
__device__ __forceinline__ void dn_chunk_prep(Frame& F) {
#if STAMP_DN >= 0
    unsigned long long dnacc_[8] = {0, 0, 0, 0, 0, 0, 0, 0}; unsigned long long dnlast_ = __builtin_amdgcn_s_memrealtime();
#endif
    const DnRec R = dn_rec(F);
    const bf16* proj = (const bf16*)(F.ws + WS_PROJ); const float* conv = FIN(3); const float* gbp = (const float*)(F.ws + WS_GB);
    LAS unsigned char* L = F.lds + RING_OFF;
    LAS float* GC = (LAS float*)(L + DNL_GC); LAS float* BETA = (LAS float*)(L + DNL_BETA); LAS float* DB = (LAS float*)(L + DNL_DB);
    const int lane = F.lane, wave = F.wave, r16 = lane & 15, g = lane >> 4;
    const int tk0 = 8 * wave;
    unsigned raw[3][11]; float gx, gbl;
#define DN_LOAD_INPUTS(ch_) do { const int bh_ = (ch_) >> 6, c_ = (ch_) & 63, b_ = bh_ >> 2, h_ = bh_ & 3; const size_t m0_ = (size_t)b_ * SEQ + 64 * c_; \
        gx = gbp[(m0_ + lane) * 8 + 4 + h_]; gbl = gbp[(m0_ + lane) * 8 + h_]; \
        _Pragma("unroll") for (int p = 0; p < 3; ++p) { const int col_ = p * DN_W + h_ * DN_D + 2 * lane; \
            _Pragma("unroll") for (int r = 0; r < 11; ++r) { const int tr_ = 64 * c_ + tk0 - 3 + r; raw[p][r] = *(const unsigned*)(proj + (m0_ - 64 * c_ + (tr_ < 0 ? 0 : tr_)) * NP + col_); } } } while (0)
#if DNA_PREFETCH
    if (F.vcu < 1024) DN_LOAD_INPUTS(F.vcu);
#endif
    for (int ch = F.vcu; ch < 1024; ch += F.G) {
        const int bh = ch >> 6, c = ch & 63, b = bh >> 2, h = bh & 3; const size_t m0 = (size_t)b * SEQ + 64 * c;
        {
#if !DNA_PREFETCH
            DN_LOAD_INPUTS(ch);
#endif
            float cw[3][4][2];
#pragma unroll
            for (int p = 0; p < 3; ++p) { const int col = p * DN_W + h * DN_D + 2 * lane;
#pragma unroll
                for (int j = 0; j < 4; ++j) { cw[p][j][0] = conv[j * DN_QKV + col]; cw[p][j][1] = conv[j * DN_QKV + col + 1]; } }
            if (wave == 0) { float x = gx;
#pragma unroll
                for (int off = 1; off < 64; off <<= 1) { const float t = __shfl_up(x, off); if (lane >= off) x += t; }
                GC[lane] = x; BETA[lane] = gbl; }
            if (64 * c + tk0 < 3) {
#pragma unroll
                for (int p = 0; p < 3; ++p)
#pragma unroll
                    for (int r = 0; r < 3; ++r) if (64 * c + tk0 - 3 + r < 0) raw[p][r] = 0u;
            }
#pragma unroll
            for (int hb = 0; hb < 2; ++hb) {
                float val[4][3][2], sq[4], sk[4];
#pragma unroll
                for (int i4 = 0; i4 < 4; ++i4) { const int i = 4 * hb + i4;
#pragma unroll
                    for (int p = 0; p < 3; ++p) { float a0 = 0.f, a1 = 0.f;
#pragma unroll
                        for (int j = 0; j < 4; ++j) { a0 += cw[p][j][0] * bflo(raw[p][i + j]); a1 += cw[p][j][1] * bfhi(raw[p][i + j]); }
                        val[i4][p][0] = a0 * sigm(a0); val[i4][p][1] = a1 * sigm(a1); }
                    sq[i4] = val[i4][0][0] * val[i4][0][0] + val[i4][0][1] * val[i4][0][1]; sk[i4] = val[i4][1][0] * val[i4][1][0] + val[i4][1][1] * val[i4][1][1]; }
#pragma unroll
                for (int i4 = 0; i4 < 4; ++i4) { sq[i4] = wave_sum(sq[i4]); sk[i4] = wave_sum(sk[i4]); }
#pragma unroll
                for (int i4 = 0; i4 < 4; ++i4) {
                    const float rq = frsq(sq[i4] + EPS) * 0.08838834764831845f, rk = frsq(sk[i4] + EPS);
                    const int o = (tk0 + 4 * hb + i4) * TP + 4 * lane;
                    *(LAS unsigned*)(L + DNL_QT + o) = cvtpk(val[i4][0][0] * rq, val[i4][0][1] * rq);
                    *(LAS unsigned*)(L + DNL_KT + o) = cvtpk(val[i4][1][0] * rk, val[i4][1][1] * rk);
                    *(LAS unsigned*)(L + DNL_VT + o) = cvtpk(val[i4][2][0], val[i4][2][1]);
                }
            }
        }
        __syncthreads(); DNSTAMP(0)
#pragma unroll
        for (int k_ = 0; k_ < 3; ++k_) { const int id = wave + 8 * k_; if (id < 20) {
            const int e = id % 10, isqk = (id / 10) & 1, ti = (e >= 6) ? 3 : (e >= 3) ? 2 : (e >= 1) ? 1 : 0, tj = e - ti * (ti + 1) / 2;
            f32x4 acc = {0.f, 0.f, 0.f, 0.f};
            const int xoff = isqk ? DNL_QT : DNL_KT;
#pragma unroll
            for (int ks = 0; ks < 4; ++ks) {
                const bf16x8 a = *(const LAS bf16x8*)(L + DNL_KT + (16 * tj + r16) * TP + (32 * ks + 8 * g) * 2);
                const bf16x8 bq = *(const LAS bf16x8*)(L + xoff + (16 * ti + r16) * TP + (32 * ks + 8 * g) * 2);
                acc = MFMA16(a, bq, acc); }
            const int i = 16 * ti + r16; const float gi = GC[i], bi = BETA[i]; const f32x4 gj = *(const LAS f32x4*)(GC + 16 * tj + 4 * g);
            f32x4 v;
#pragma unroll
            for (int r = 0; r < 4; ++r) { const int jp = 16 * tj + 4 * g + r; const float d = __expf(fminf(gi - gj[r], 0.f));
                v[r] = isqk ? ((i >= jp) ? acc[r] * d : 0.f) : ((i > jp) ? bi * acc[r] * d : 0.f); }
            if (!isqk) {
                u32x2 w; w.x = cvtpk(-v[0], -v[1]); w.y = cvtpk(-v[2], -v[3]);
                *(LAS u32x2*)(L + DNL_NA + i * NP2 + (16 * tj + 4 * g) * 2) = w;
                if (ti == tj) *(LAS f32x4*)(DB + (ti * 16 + r16) * 16 + 4 * g) = v;
            } else { u32x2 w; w.x = cvtpk(v[0], v[1]); w.y = cvtpk(v[2], v[3]); *(LAS u32x2*)(L + DNL_QKM + i * NP2 + (16 * tj + 4 * g) * 2) = w; }
        } }
        __syncthreads(); DNSTAMP(1)
        if (wave < 4) {
            const int I = wave; float x[16];
#pragma unroll
            for (int i = 0; i < 16; ++i) { float a = (i == r16) ? 1.f : 0.f;
#pragma unroll
                for (int j4 = 0; j4 < (i + 3) / 4; ++j4) { const f32x4 d = *(const LAS f32x4*)(DB + (I * 16 + i) * 16 + 4 * j4);
#pragma unroll
                    for (int jj = 0; jj < 4; ++jj) if (4 * j4 + jj < i) a -= d[jj] * x[4 * j4 + jj]; }
                x[i] = a; }
            if (lane < 16) {
#pragma unroll
                for (int i = 0; i < 16; ++i) *(LAS unsigned short*)(L + DNL_TIB + ((I * 16 + i) * 16 + r16) * 2) = (unsigned short)(cvtpk(x[i], 0.f) & 0xffffu);
            }
        } else {
            const int w4 = wave - 4;
            {
                const int mt = w4; const float e = __expf(GC[16 * mt + r16]); const int base = DNL_QT + (16 * mt + r16) * TP;
                u32x2 lo[4], hi[4];
#pragma unroll
                for (int ks = 0; ks < 4; ++ks) { lo[ks] = *(const LAS u32x2*)(L + base + (32 * ks + 4 * g) * 2); hi[ks] = *(const LAS u32x2*)(L + base + (32 * ks + 16 + 4 * g) * 2); }
#pragma unroll
                for (int ks = 0; ks < 4; ++ks) { v4u w; w.x = cvtpk(bflo(lo[ks].x) * e, bfhi(lo[ks].x) * e); w.y = cvtpk(bflo(lo[ks].y) * e, bfhi(lo[ks].y) * e); w.z = cvtpk(bflo(hi[ks].x) * e, bfhi(hi[ks].x) * e); w.w = cvtpk(bflo(hi[ks].y) * e, bfhi(hi[ks].y) * e);
                    *(v4u*)(R.QG + ((size_t)(ch * 16 + mt * 4 + ks) * 64 + lane) * 8) = w; }
            }
            {
                const float gl = GC[63]; float ed[2][8];
#pragma unroll
                for (int kt = 0; kt < 2; ++kt)
#pragma unroll
                    for (int j = 0; j < 8; ++j) { const int tok = 32 * kt + (j < 4 ? 4 * g + j : 16 + 4 * g + j - 4); ed[kt][j] = __expf(gl - GC[tok]); }
#pragma unroll
                for (int i = 0; i < 4; ++i) { const int f = 4 * w4 + i, mt8 = f >> 1, kt = i & 1, dk = 16 * mt8 + r16; float v[8];
#pragma unroll
                    for (int j = 0; j < 8; ++j) { const int tok = 32 * kt + (j < 4 ? 4 * g + j : 16 + 4 * g + j - 4); v[j] = bf1(*(const LAS unsigned short*)(L + DNL_KT + tok * TP + dk * 2)) * ed[kt][j]; }
                    v4u w; w.x = cvtpk(v[0], v[1]); w.y = cvtpk(v[2], v[3]); w.z = cvtpk(v[4], v[5]); w.w = cvtpk(v[6], v[7]);
                    *(v4u*)(R.KD + ((size_t)(ch * 16 + f) * 64 + lane) * 8) = w; }
            }
#pragma unroll
            for (int i = 0; i < 2; ++i) { const int q = w4 + 4 * i;
                if (q < 6) { const int mt = (q == 0) ? 0 : (q == 1) ? 1 : (q < 4) ? 2 : 3, kt = (q == 3 || q == 5) ? 1 : 0;
                    const u32x2 lo = *(const LAS u32x2*)(L + DNL_QKM + (16 * mt + r16) * NP2 + (32 * kt + 4 * g) * 2);
                    u32x2 hi = {0u, 0u}; if (2 * kt + 1 <= mt) hi = *(const LAS u32x2*)(L + DNL_QKM + (16 * mt + r16) * NP2 + (32 * kt + 16 + 4 * g) * 2);
                    const v4u w = {lo.x, lo.y, hi.x, hi.y};
                    *(v4u*)(R.QK + ((size_t)(ch * 6 + q) * 64 + lane) * 8) = w; } }
            if (lane == 0 && w4 == 0) R.EGL[ch] = __expf(GC[63]);
        }
        __syncthreads(); DNSTAMP(2)
#if DNA_PREFETCH
        if (ch + F.G < 1024) DN_LOAD_INPUTS(ch + F.G);
#endif
        {
            const int part = wave >> 2, colbase = 32 * (wave & 3);
            f32x4 rhs[4][2];
#pragma unroll
            for (int I = 0; I < 4; ++I) { float sc[4];
#pragma unroll
                for (int r = 0; r < 4; ++r) { const int tok = 16 * I + 4 * g + r; sc[r] = part == 0 ? BETA[tok] : -(BETA[tok] * __expf(GC[tok])); }
#pragma unroll
                for (int nt = 0; nt < 2; ++nt) { const int col = colbase + 16 * nt + r16;
#pragma unroll
                    for (int r = 0; r < 4; ++r) { const int tok = 16 * I + 4 * g + r; rhs[I][nt][r] = sc[r] * bf1(*(const LAS unsigned short*)(L + (part == 0 ? DNL_VT : DNL_KT) + tok * TP + col * 2)); } } }
            u32x2 na10, na20l, na20h, na30l, na30h, na31l, ti[4];
            na10 = *(const LAS u32x2*)(L + DNL_NA + (16 * 1 + r16) * NP2 + (4 * g) * 2);
            na20l = *(const LAS u32x2*)(L + DNL_NA + (16 * 2 + r16) * NP2 + (4 * g) * 2); na20h = *(const LAS u32x2*)(L + DNL_NA + (16 * 2 + r16) * NP2 + (16 + 4 * g) * 2);
            na30l = *(const LAS u32x2*)(L + DNL_NA + (16 * 3 + r16) * NP2 + (4 * g) * 2); na30h = *(const LAS u32x2*)(L + DNL_NA + (16 * 3 + r16) * NP2 + (16 + 4 * g) * 2);
            na31l = *(const LAS u32x2*)(L + DNL_NA + (16 * 3 + r16) * NP2 + (32 + 4 * g) * 2);
#pragma unroll
            for (int I = 0; I < 4; ++I) ti[I] = *(const LAS u32x2*)(L + DNL_TIB + ((I * 16 + r16) * 16 + 4 * g) * 2);
            const bf16x8 A10 = __builtin_bit_cast(bf16x8, (v4u){na10.x, na10.y, 0u, 0u}), A20 = __builtin_bit_cast(bf16x8, (v4u){na20l.x, na20l.y, na20h.x, na20h.y}),
                         A30 = __builtin_bit_cast(bf16x8, (v4u){na30l.x, na30l.y, na30h.x, na30h.y}), A31 = __builtin_bit_cast(bf16x8, (v4u){na31l.x, na31l.y, 0u, 0u});
            const f32x4 zero = {0.f, 0.f, 0.f, 0.f};
            f32x4 X[2][4];
#pragma unroll
            for (int nt = 0; nt < 2; ++nt) {
                X[nt][0] = MFMA16(__builtin_bit_cast(bf16x8, (v4u){ti[0].x, ti[0].y, 0u, 0u}), pack8z(rhs[0][nt]), zero);
                f32x4 a1 = MFMA16(A10, pack8z(X[nt][0]), rhs[1][nt]);
                X[nt][1] = MFMA16(__builtin_bit_cast(bf16x8, (v4u){ti[1].x, ti[1].y, 0u, 0u}), pack8z(a1), zero);
                f32x4 a2 = MFMA16(A20, pack8(X[nt][0], X[nt][1]), rhs[2][nt]);
                X[nt][2] = MFMA16(__builtin_bit_cast(bf16x8, (v4u){ti[2].x, ti[2].y, 0u, 0u}), pack8z(a2), zero);
                f32x4 a3 = MFMA16(A30, pack8(X[nt][0], X[nt][1]), rhs[3][nt]); a3 = MFMA16(A31, pack8z(X[nt][2]), a3);
                X[nt][3] = MFMA16(__builtin_bit_cast(bf16x8, (v4u){ti[3].x, ti[3].y, 0u, 0u}), pack8z(a3), zero);
            }
#pragma unroll
            for (int nt = 0; nt < 2; ++nt)
#pragma unroll
                for (int I = 0; I < 4; ++I) {
                    if (part == 0) { u32x2 w; w.x = cvtpk(X[nt][I][0], X[nt][I][1]); w.y = cvtpk(X[nt][I][2], X[nt][I][3]); *(u32x2*)R.u(ch, 2 * (wave & 3) + nt, I, lane) = w; }
                    else { const int col = colbase + 16 * nt + r16;
#pragma unroll
                        for (int r = 0; r < 4; ++r) *(LAS unsigned short*)(L + DNL_WL + (16 * I + 4 * g + r) * TP + col * 2) = (unsigned short)(cvtpk(X[nt][I][r], 0.f) & 0xffffu); }
                }
        }
        __syncthreads(); DNSTAMP(3)
        {
            const int mt = wave >> 1, base = DNL_WL + (16 * mt + r16) * TP;
            u32x2 lo[2], hi[2];
#pragma unroll
            for (int i = 0; i < 2; ++i) { const int ks = 2 * (wave & 1) + i; lo[i] = *(const LAS u32x2*)(L + base + (32 * ks + 4 * g) * 2); hi[i] = *(const LAS u32x2*)(L + base + (32 * ks + 16 + 4 * g) * 2); }
#pragma unroll
            for (int i = 0; i < 2; ++i) { const int ks = 2 * (wave & 1) + i; const v4u w = {lo[i].x, lo[i].y, hi[i].x, hi[i].y}; *(v4u*)(R.W + ((size_t)(ch * 16 + mt * 4 + ks) * 64 + lane) * 8) = w; }
        }
        __syncthreads(); DNSTAMP(4)
    }
#if STAMP_DN >= 0
    if (blockIdx.x == STAMP_BLOCK && threadIdx.x == 0) { for (int i = 0; i < 8; ++i) g_dn[i] = dnacc_[i]; }
#endif
}
__device__ __forceinline__ void dn_out2(Frame& F, int worker, int nworkers, int task_lo = 0, int task_hi = 4096) {
    const DnRec R = dn_rec(F);
    const int lane = F.lane, r16 = lane & 15, g = lane >> 4;
    bf16* proj = (bf16*)(F.ws + WS_PROJ); const float* gain = FIN(6);
    int pub_pm = -1;
    for (int task = worker; task < (DNO_SKIPALL ? 0 : task_hi); task += nworkers) {
        if (task < task_lo) continue;
        const int c = task >> 6, bh = (task >> 2) & 15, mt = task & 3, ch = bh * 64 + c, b = bh >> 2, h = bh & 3;
        {   gu32* f0 = F.ctl + CW_SCAN + 64 * (bh * 2);
            for (unsigned sp = 0;; ++sp) {
                const unsigned p0 = (unsigned)__builtin_amdgcn_readfirstlane((int)__hip_atomic_load(f0, RLX_AGENT)), p1 = (unsigned)__builtin_amdgcn_readfirstlane((int)__hip_atomic_load(f0 + 64, RLX_AGENT));
                if ((p0 < p1 ? p0 : p1) > (unsigned)(c + DNO_LAG < 63 ? c + DNO_LAG : 63) || sp > (1u << 16)) break;
                __builtin_amdgcn_s_sleep(DNO_SLEEP);
            }
            if (DNO_FENCE) __builtin_amdgcn_fence(__ATOMIC_ACQUIRE, "agent"); else asm volatile("" ::: "memory"); }
        if (DNO_SKIPWORK) continue;
        if (SEAM35 && pub_pm >= 0) { asm volatile("s_waitcnt vmcnt(0)" ::: "memory"); if (lane == 0) __hip_atomic_fetch_add(F.ctl + CW_PAN + 64 * pub_pm, 1u, RLX_AGENT); }
        pub_pm = (bh >> 2) * 16 + (c >> 2);
        f32x4 o[8]; float ss[4] = {0.f, 0.f, 0.f, 0.f};
#pragma unroll
        for (int sl = 0; sl < 8; ++sl) { u32x2 w;
            if (DNO_FENCE) w = *(const u32x2*)R.u(ch, sl, mt, lane);
            else { const unsigned long long q = __hip_atomic_load((GAS unsigned long long*)R.u(ch, sl, mt, lane), RLX_AGENT); w.x = (unsigned)q; w.y = (unsigned)(q >> 32); }
            o[sl] = (f32x4){bflo(w.x), bfhi(w.x), bflo(w.y), bfhi(w.y)};
#pragma unroll
            for (int r = 0; r < 4; ++r) ss[r] += o[sl][r] * o[sl][r]; }
#pragma unroll
        for (int r = 0; r < 4; ++r) { float s = sum16(ss[r]); ss[r] = frsq(s * (1.0f / DN_D) + EPS); }
        float gdv[8];
#pragma unroll
        for (int sl = 0; sl < 8; ++sl) gdv[sl] = gain[16 * sl + r16];
        unsigned short zz[8][4];
#pragma unroll
        for (int sl = 0; sl < 8; ++sl)
#pragma unroll
            for (int r = 0; r < 4; ++r) zz[sl][r] = proj[((size_t)b * SEQ + 64 * c + 16 * mt + 4 * g + r) * NP + PC_Z + h * DN_D + 16 * sl + r16];
#if DNO_STAGE
        {   LAS unsigned char* stg = F.lds + RING_OFF + F.wave * 16384;
#pragma unroll
            for (int sl = 0; sl < 8; ++sl) { const float gd = gdv[sl];
#pragma unroll
                for (int r = 0; r < 4; ++r) { const float z = bf1(zz[sl][r]);
                    *(LAS unsigned short*)(stg + (4 * g + r) * 272 + (16 * sl + r16) * 2) = (unsigned short)(cvtpk(o[sl][r] * ss[r] * gd * z * sigm(z), 0.f) & 0xffffu); } }
            asm volatile("s_waitcnt lgkmcnt(0)" ::: "memory");
            const size_t m0 = (size_t)b * SEQ + 64 * c + 16 * mt;
#pragma unroll
            for (int i = 0; i < 4; ++i) { const int q = lane + 64 * i, row = q >> 4, cc = q & 15; const v4u v = *(const LAS v4u*)(stg + row * 272 + cc * 16);
                GAS v4u* dst = (GAS v4u*)(proj + (m0 + row) * NP + PC_YDN + h * DN_D + cc * 8);
                asm volatile("global_store_dwordx4 %0, %1, off sc1\n\ts_nop 2" :: "v"(dst), "v"(v) : "memory"); }
            asm volatile("s_waitcnt lgkmcnt(0)" ::: "memory");
        }
#else
#pragma unroll
        for (int sl = 0; sl < 8; ++sl) { const int d = 16 * sl + r16; const float gd = gdv[sl];
#pragma unroll
            for (int r = 0; r < 4; ++r) { const size_t m = (size_t)b * SEQ + 64 * c + 16 * mt + 4 * g + r; const float z = bf1(zz[sl][r]);
                proj[m * NP + PC_YDN + h * DN_D + d] = (bf16)(cvtpk(o[sl][r] * ss[r] * gd * z * sigm(z), 0.f) & 0xffffu); } }
#endif
    }
    if (SEAM35 && pub_pm >= 0) { asm volatile("s_waitcnt vmcnt(0)" ::: "memory"); if (lane == 0) __hip_atomic_fetch_add(F.ctl + CW_PAN + 64 * pub_pm, 1u, RLX_AGENT); }
    if (SEAM78 && lane == 0) { unsigned nt_ = 0u; for (int task = worker; task < task_hi; task += nworkers) if (task >= task_lo) ++nt_;
        if (nt_) __hip_atomic_fetch_add(F.ctl + CW_NORMDONE + 64 * (worker & 7), nt_, RLX_AGENT); }
}
constexpr int SCAN_H0 = 32768, SCAN_H1 = 24576;
__device__ __forceinline__ void dn_scan_wg(Frame& F, int bh, int half) {
    const DnRec R = dn_rec(F);
    const int lane = F.lane, wave = F.wave;
    LAS unsigned char* ring = F.lds + RING_OFF;
    if (wave >= 4) {
        const int lw = wave - 4;
        v4u r0[8], r1[6], r2[8], r3[6];
#if SCAN_SETS == 6
        v4u r4[8], r5[6];
#endif
#define LD_H0(set_, k_) do { const int ch_ = bh * 64 + ((k_) >> 1); _Pragma("unroll") for (int i_ = 0; i_ < 8; ++i_) { const int p_ = lw + 4 * i_; \
            const bf16* src_ = p_ < 16 ? R.W + (size_t)ch_ * 8192 + p_ * 512 : R.QG + (size_t)ch_ * 8192 + (p_ - 16) * 512; set_[i_] = SCAN_NT ? __builtin_nontemporal_load((const v4u*)(src_ + lane * 8)) : *(const v4u*)(src_ + lane * 8); } } while (0)
#define LD_H1(set_, k_) do { const int ch_ = bh * 64 + ((k_) >> 1); _Pragma("unroll") for (int i_ = 0; i_ < 6; ++i_) { const int p_ = lw + 4 * i_, q_ = p_ < 22 ? p_ : p_ - 22; \
            const bf16* src_ = q_ < 6 ? R.QK + (size_t)ch_ * 3072 + q_ * 512 : R.KD + (size_t)ch_ * 8192 + (q_ - 6) * 512; set_[i_] = SCAN_NT ? __builtin_nontemporal_load((const v4u*)(src_ + lane * 8)) : *(const v4u*)(src_ + lane * 8); } } while (0)
#define ST_H0(set_, k_) do { LAS unsigned char* slot_ = ring + (((k_) >> 1) & 1) * (SCAN_H0 + SCAN_H1) + lane * 16; _Pragma("unroll") for (int i_ = 0; i_ < 8; ++i_) *(LAS v4u*)(slot_ + (lw + 4 * i_) * 1024) = set_[i_]; } while (0)
#define ST_H1(set_, k_) do { LAS unsigned char* slot_ = ring + (((k_) >> 1) & 1) * (SCAN_H0 + SCAN_H1) + SCAN_H0 + lane * 16; _Pragma("unroll") for (int i_ = 0; i_ < 6; ++i_) *(LAS v4u*)(slot_ + (lw + 4 * i_) * 1024) = set_[i_]; } while (0)
#define LD_BAR() do { asm volatile("s_waitcnt lgkmcnt(0)" ::: "memory"); __builtin_amdgcn_s_barrier(); asm volatile("" ::: "memory"); } while (0)
#if SCAN_SETS == 6
        LD_H0(r0, 0); LD_H1(r1, 1); LD_H0(r2, 2); LD_H1(r3, 3); LD_H0(r4, 4); LD_H1(r5, 5);
        ST_H0(r0, 0); LD_H0(r0, 6); ST_H1(r1, 1); LD_H1(r1, 7); ST_H0(r2, 2); LD_H0(r2, 8);
        for (int k = 0; k < 128; k += 6) {
            if (k + 0 < 128) { LD_BAR(); if (k + 3 < 128) { ST_H1(r3, k + 3); if (k + 9 < 128) LD_H1(r3, k + 9); } }
            if (k + 1 < 128) { LD_BAR(); if (k + 4 < 128) { ST_H0(r4, k + 4); if (k + 10 < 128) LD_H0(r4, k + 10); } }
            if (k + 2 < 128) { LD_BAR(); if (k + 5 < 128) { ST_H1(r5, k + 5); if (k + 11 < 128) LD_H1(r5, k + 11); } }
            if (k + 3 < 128) { LD_BAR(); if (k + 6 < 128) { ST_H0(r0, k + 6); if (k + 12 < 128) LD_H0(r0, k + 12); } }
            if (k + 4 < 128) { LD_BAR(); if (k + 7 < 128) { ST_H1(r1, k + 7); if (k + 13 < 128) LD_H1(r1, k + 13); } }
            if (k + 5 < 128) { LD_BAR(); if (k + 8 < 128) { ST_H0(r2, k + 8); if (k + 14 < 128) LD_H0(r2, k + 14); } }
        }
#else
        LD_H0(r0, 0); LD_H1(r1, 1); LD_H0(r2, 2); LD_H1(r3, 3);
        ST_H0(r0, 0); LD_H0(r0, 4); ST_H1(r1, 1); LD_H1(r1, 5); ST_H0(r2, 2); LD_H0(r2, 6);
#define PUB(k_) do { if (SCAN_PUBLISH && SCAN_PUB_LOADER && lw == 0 && lane == 0 && (k_) >= 4 && (((k_) >> 1) % SCAN_PUB_EVERY) == 0) asm volatile("global_store_dword %0, %1, off sc1" :: "v"(F.ctl + CW_SCAN + 64 * (bh * 2 + half)), "v"((unsigned)(((k_) >> 1) - 1)) : "memory"); } while (0)
        for (int k = 0; k < 128; k += 4) {
            LD_BAR(); PUB(k); ST_H1(r3, k + 3); if (k + 7 < 128) LD_H1(r3, k + 7);
            LD_BAR(); if (k + 4 < 128) { ST_H0(r0, k + 4); if (k + 8 < 128) LD_H0(r0, k + 8); }
            LD_BAR(); PUB(k + 2); if (k + 5 < 128) { ST_H1(r1, k + 5); if (k + 9 < 128) LD_H1(r1, k + 9); }
            LD_BAR(); if (k + 6 < 128) { ST_H0(r2, k + 6); if (k + 10 < 128) LD_H0(r2, k + 10); }
        }
#endif
#undef LD_H0
#undef LD_H1
#undef ST_H0
#undef ST_H1
#undef LD_BAR
#undef PUB
    } else {
        const int sl = half * 4 + wave;
        f32x4 S[8];
#pragma unroll
        for (int i = 0; i < 8; ++i) S[i] = (f32x4){0.f, 0.f, 0.f, 0.f};
        constexpr int UPRE = SCAN_UPRE;
        u32x2 Uq[UPRE][4]; float eq[UPRE];
#pragma unroll
        for (int d = 0; d < UPRE; ++d) { eq[d] = R.EGL[bh * 64 + d];
#pragma unroll
            for (int mt = 0; mt < 4; ++mt) Uq[d][mt] = *(const u32x2*)R.u(bh * 64 + d, sl, mt, lane); }
        for (int c4 = 0; c4 < 64; c4 += UPRE) {
#pragma unroll
        for (int j4 = 0; j4 < UPRE; ++j4) {
            const int c = c4 + j4, ch = bh * 64 + c;
            const LAS unsigned char* h0 = ring + (c & 1) * (SCAN_H0 + SCAN_H1) + lane * 16; const LAS unsigned char* h1 = h0 + SCAN_H0;
            asm volatile("s_waitcnt lgkmcnt(0)" ::: "memory");
            __builtin_amdgcn_s_barrier();
            asm volatile("" ::: "memory");
#if SCAN_PUBLISH && !SCAN_PUB_LOADER
            if (wave == 0 && c >= 2 && lane == 0) __hip_atomic_store(F.ctl + CW_SCAN + 64 * (bh * 2 + half), (unsigned)(c - 1), RLX_AGENT);
#endif
            bf16x8 fa[16];
#pragma unroll
            for (int f = 0; f < 16; ++f) fa[f] = *(const LAS bf16x8*)(h0 + f * 1024);
#if SCAN_QG_EARLY
            bf16x8 fb[8];
#pragma unroll
            for (int f = 0; f < 8; ++f) fb[f] = *(const LAS bf16x8*)(h0 + 16384 + f * 1024);
#endif
            bf16x8 Sb[4];
#pragma unroll
            for (int ks = 0; ks < 4; ++ks) Sb[ks] = pack8(S[2 * ks], S[2 * ks + 1]);
            const float egl = eq[j4];
            u32x2 Uf[4];
#pragma unroll
            for (int mt = 0; mt < 4; ++mt) Uf[mt] = Uq[j4][mt];
            __builtin_amdgcn_sched_barrier(0);
            f32x4 vn[4], o[4];
#pragma unroll
            for (int mt = 0; mt < 4; ++mt) { vn[mt] = (f32x4){bflo(Uf[mt].x), bfhi(Uf[mt].x), bflo(Uf[mt].y), bfhi(Uf[mt].y)};
#pragma unroll
                for (int ks = 0; ks < 4; ++ks) vn[mt] = MFMA16(fa[mt * 4 + ks], Sb[ks], vn[mt]); }
            __builtin_amdgcn_sched_barrier(0);
#if SCAN_QG_EARLY
#pragma unroll
            for (int f = 8; f < 16; ++f) fa[f] = *(const LAS bf16x8*)(h0 + 16384 + f * 1024);
            __builtin_amdgcn_sched_barrier(0);
#pragma unroll
            for (int mt = 0; mt < 2; ++mt) { o[mt] = (f32x4){0.f, 0.f, 0.f, 0.f};
#pragma unroll
                for (int ks = 0; ks < 4; ++ks) o[mt] = MFMA16(fb[mt * 4 + ks], Sb[ks], o[mt]); }
#pragma unroll
            for (int mt = 2; mt < 4; ++mt) { o[mt] = (f32x4){0.f, 0.f, 0.f, 0.f};
#pragma unroll
                for (int ks = 0; ks < 4; ++ks) o[mt] = MFMA16(fa[mt * 4 + ks], Sb[ks], o[mt]); }
#else
#pragma unroll
            for (int f = 0; f < 16; ++f) fa[f] = *(const LAS bf16x8*)(h0 + 16384 + f * 1024);
            __builtin_amdgcn_sched_barrier(0);
#pragma unroll
            for (int mt = 0; mt < 4; ++mt) { o[mt] = (f32x4){0.f, 0.f, 0.f, 0.f};
#pragma unroll
                for (int ks = 0; ks < 4; ++ks) o[mt] = MFMA16(fa[mt * 4 + ks], Sb[ks], o[mt]); }
#endif
            const bf16x8 vb0 = pack8(vn[0], vn[1]), vb1 = pack8(vn[2], vn[3]);
#if !SCAN_PUBLISH || !SCAN_REFILL_LATE
            { const int cn = (c + UPRE < 64) ? c + UPRE : 63;
#pragma unroll
                for (int mt = 0; mt < 4; ++mt) Uq[j4][mt] = *(const u32x2*)R.u(bh * 64 + cn, sl, mt, lane);
                eq[j4] = R.EGL[bh * 64 + cn]; }
#endif
            asm volatile("s_waitcnt lgkmcnt(0)" ::: "memory");
            __builtin_amdgcn_s_barrier();
            asm volatile("" ::: "memory");
            bf16x8 fq_[6];
#pragma unroll
            for (int f = 0; f < 6; ++f) fq_[f] = *(const LAS bf16x8*)(h1 + f * 1024);
#pragma unroll
            for (int f = 0; f < 16; ++f) fa[f] = *(const LAS bf16x8*)(h1 + 6144 + f * 1024);
            __builtin_amdgcn_sched_barrier(0);
            o[0] = MFMA16(fq_[0], vb0, o[0]); o[1] = MFMA16(fq_[1], vb0, o[1]);
            o[2] = MFMA16(fq_[2], vb0, o[2]); o[2] = MFMA16(fq_[3], vb1, o[2]);
            o[3] = MFMA16(fq_[4], vb0, o[3]); o[3] = MFMA16(fq_[5], vb1, o[3]);
#pragma unroll
            for (int i = 0; i < 8; ++i) { S[i] = S[i] * egl; S[i] = MFMA16(fa[2 * i], vb0, S[i]); S[i] = MFMA16(fa[2 * i + 1], vb1, S[i]); }
#if SCAN_PUBLISH
#if !SCAN_DRAIN_NONE
            VM_WAIT();
#endif
#if SCAN_O16
#pragma unroll
            for (int p2 = 0; p2 < 2; ++p2) {
                const unsigned a0 = cvtpk(o[2 * p2][0], o[2 * p2][1]), a1 = cvtpk(o[2 * p2][2], o[2 * p2][3]), b0 = cvtpk(o[2 * p2 + 1][0], o[2 * p2 + 1][1]), b1 = cvtpk(o[2 * p2 + 1][2], o[2 * p2 + 1][3]);
                const bool odd = (lane & 1) != 0;
                const unsigned r0 = (unsigned)__builtin_amdgcn_update_dpp(0, (int)(odd ? a0 : b0), 0xB1, 0xf, 0xf, true), r1 = (unsigned)__builtin_amdgcn_update_dpp(0, (int)(odd ? a1 : b1), 0xB1, 0xf, 0xf, true);
                v4u w; w.x = odd ? r0 : a0; w.y = odd ? r1 : a1; w.z = odd ? b0 : r0; w.w = odd ? b1 : r1;
                GAS v4u* dst = (GAS v4u*)R.u(ch, sl, 2 * p2 + (odd ? 1 : 0), lane & ~1);
                asm volatile("global_store_dwordx4 %0, %1, off sc1\n\ts_nop 2" :: "v"(dst), "v"(w) : "memory"); }
#else
#pragma unroll
            for (int mt = 0; mt < 4; ++mt) { const unsigned long long w = (unsigned long long)cvtpk(o[mt][0], o[mt][1]) | ((unsigned long long)cvtpk(o[mt][2], o[mt][3]) << 32);
                if (SCAN_O_SC1) __hip_atomic_store((GAS unsigned long long*)R.u(ch, sl, mt, lane), w, RLX_AGENT); else *(unsigned long long*)R.u(ch, sl, mt, lane) = w; }
#endif
            if (SCAN_REFILL_LATE) { const int cn = (c + UPRE < 64) ? c + UPRE : 63;
#pragma unroll
                for (int mt = 0; mt < 4; ++mt) Uq[j4][mt] = *(const u32x2*)R.u(bh * 64 + cn, sl, mt, lane);
                eq[j4] = R.EGL[bh * 64 + cn]; }
#else
#pragma unroll
            for (int mt = 0; mt < 4; ++mt) { u32x2 w; w.x = cvtpk(o[mt][0], o[mt][1]); w.y = cvtpk(o[mt][2], o[mt][3]); *(u32x2*)R.u(ch, sl, mt, lane) = w; }
#endif
        }
        }
    }
#if SCAN_PUBLISH
    VM_WAIT(); __syncthreads();
    if (F.tid == 0) __hip_atomic_store(F.ctl + CW_SCAN + 64 * (bh * 2 + half), 64u, RLX_AGENT);
#endif
}
__device__ unsigned long long g_ts[16];
__device__ __forceinline__ void run_phase0(Frame& F0) {
    Frame F = F0; asm volatile("" : "+v"(F.tid)); F.lane = F.tid & 63;
    unsigned char* ws = F.ws; bf16* XB = (bf16*)(ws + WS_XB); bf16* Y = (bf16*)(ws + WS_Y); bf16* PROJ = (bf16*)(ws + WS_PROJ); (void)XB; (void)Y; (void)PROJ;
        p0_prologue(F);
}
__device__ __forceinline__ void run_phase1(Frame& F0) {
    Frame F = F0; asm volatile("" : "+v"(F.tid)); F.lane = F.tid & 63;
    unsigned char* ws = F.ws; bf16* XB = (bf16*)(ws + WS_XB); bf16* Y = (bf16*)(ws + WS_Y); bf16* PROJ = (bf16*)(ws + WS_PROJ); (void)XB; (void)Y; (void)PROJ;
        const int N1 = (F.G == 256) ? P1_TILES * 256 : NP;
        pg8::Gemm g{XB, (const bf16*)(ws + WS_WIN), M, N1, D}; pg8::StaticOrder S; S.init(M, N1, F.G, (int)blockIdx.x);
        pg8::EpiProj E{PROJ, NP, (const float*)(ws + WS_RSTD), PC_G / 256, 0, FUSE_QKNORM ? Y + (size_t)M * SW_W : nullptr, Y, FIN(7), FIN(8), PC_SQ / 256, PC_SK / 256, 0.125f * 1.4426950408889634f, SEQ};
        pg8::gemm_phase<pg8::EpiProj, pg8::StaticOrder, ALIGN_P1, true>(F.lds + RING_OFF, g, S, E);
}
__device__ __forceinline__ void run_phase2(Frame& F0) {
    Frame F = F0; asm volatile("" : "+v"(F.tid)); F.lane = F.tid & 63;
    unsigned char* ws = F.ws; bf16* XB = (bf16*)(ws + WS_XB); bf16* Y = (bf16*)(ws + WS_Y); bf16* PROJ = (bf16*)(ws + WS_PROJ); (void)XB; (void)Y; (void)PROJ;
#if FAST_DN
        SUBSTAMP(0) for (int rep_ = 0; rep_ < REP_DNA; ++rep_) dn_chunk_prep(F); SUBSTAMP(1)
#else
        dn_pre(F);
#endif
#if FAST_SWA
        for (int rep_ = 0; rep_ < REP_SWAPRE; ++rep_) swa_pre(F); SUBSTAMP(2)
#endif
}
__device__ __forceinline__ void run_phase3(Frame& F0) {
    Frame F = F0; asm volatile("" : "+v"(F.tid)); F.lane = F.tid & 63;
    unsigned char* ws = F.ws; bf16* XB = (bf16*)(ws + WS_XB); bf16* Y = (bf16*)(ws + WS_Y); bf16* PROJ = (bf16*)(ws + WS_PROJ); (void)XB; (void)Y; (void)PROJ;
#if FAST_DN
        if (F.G == 256) {
            const int bx = (int)blockIdx.x;
            SUBSTAMP(3)
            if (((bx >> 3) & 7) == 0) {
                const int xcd = bx & 7, j = bx >> 6;
                if (!P3_SKIP_SCAN) dn_scan_wg(F, xcd * 2 + (j >> 1), j & 1);
                SUBSTAMP(4)
            } else if (!P3_SKIP_GEMM) {
                const int gi = (bx >> 6) * 56 + (bx & 63) - 8, NG = NP - P1_TILES * 256;
#if P3_ORDER == 1
                if (DEFER_WEIGHTS) { weight_copies(F, WI_P0, WI_ALL, gi * NWAVES + F.wave, 224 * NWAVES); __syncthreads(); }
                swa_bias_table(F); __syncthreads();
                swa_main(F, gi * NWAVES + F.wave, 224 * NWAVES);
                __syncthreads();
#endif
                pg8::Gemm g{XB, (const bf16*)(ws + WS_WIN) + (size_t)P1_TILES * 256 * D, M, NG, D}; pg8::StaticOrder S; S.init(M, NG, 224, gi);
                pg8::EpiProj E{PROJ, NP, (const float*)(ws + WS_RSTD), PC_G / 256, P1_TILES, nullptr, nullptr, nullptr, nullptr, 0, 0, 0.f, SEQ, SEAM35};
                pg8::gemm_phase<pg8::EpiProj, pg8::StaticOrder, true, true>(F.lds + RING_OFF, g, S, E);
                if (SEAM35 && F.tid == 0) {
                    pg8::Unit u_; for (int i_ = 0; S.next(i_, u_); ++i_) __hip_atomic_fetch_add(F.ctl + CW_PAN + 64 * u_.pm + 2, 1u, RLX_AGENT); }
                SUBSTAMP(4)
#if P3_ORDER == 0
                if (!P3_ONLY_SCAN) { swa_bias_table(F); __syncthreads();
#if ASYM_WCOPY && ASYM_SWA
                { const int hs_ = ((bx >> 6) * 28 + (((bx & 63) - 8) >> 1)) * NWAVES + F.wave;
                  if (bx & 1) swa_main(F, 2 * 112 * NWAVES + hs_, 112 * NWAVES); else swa_main(F, hs_, 112 * NWAVES, 2 * 112 * NWAVES); }
#else
                swa_main(F, gi * NWAVES + F.wave, 224 * NWAVES);
#endif
                SUBSTAMP(5)
#if ASYM_WCOPY
                __syncthreads();
                const int hi_ = (bx >> 6) * 28 + (((bx & 63) - 8) >> 1);
#if ASYM_DNO
                if (!(bx & 1)) dn_out2(F, hi_ * NWAVES + F.wave, 112 * NWAVES, 0, 2048);
#else
                dn_out2(F, gi * NWAVES + F.wave, 224 * NWAVES, 0, 224 * NWAVES);
#endif
                if (DEFER_WEIGHTS && (bx & 1)) weight_copies(F, WI_P0, WI_ALL, hi_ * NWAVES + F.wave, 112 * NWAVES); }
#else
                if (DEFER_WEIGHTS) { __syncthreads(); weight_copies(F, WI_P0, WI_ALL, gi * NWAVES + F.wave, 224 * NWAVES); } }
#endif
                if (SEAM67 && DEFER_WEIGHTS) { asm volatile("s_waitcnt vmcnt(0)" ::: "memory"); if (F.lane == 0) __hip_atomic_fetch_add(F.ctl + CW_WCOPY + 64 * (F.wave & 7), 1u, RLX_AGENT); }
                SUBSTAMP(6)
#endif
#if ASYM_WCOPY && ASYM_DNO
                if (bx & 1) dn_out2(F, 2048 + ((bx >> 6) * 28 + (((bx & 63) - 8) >> 1)) * NWAVES + F.wave, 112 * NWAVES, 0, 4096);
                SUBSTAMP(7)
#else
                dn_out2(F, gi * NWAVES + F.wave, 224 * NWAVES, ASYM_WCOPY ? 224 * NWAVES : 0, 4096); SUBSTAMP(7)
#endif
            }
        } else {
        for (int task = F.vcu; task < 32; task += F.G) { dn_scan_wg(F, task >> 1, task & 1); __syncthreads(); }
        swa_bias_table(F); __syncthreads();
        swa_main(F, F.vcu * NWAVES + F.wave, F.G * NWAVES);
        __syncthreads();
        dn_out2(F, F.vcu * NWAVES + F.wave, F.G * NWAVES);
        }
#elif FAST_SWA
        if (F.vcu < 16) dn_scan_naive(F, F.vcu);
        else { swa_bias_table(F); __syncthreads(); swa_main(F, (F.vcu - 16) * NWAVES + F.wave, (F.G - 16) * NWAVES); }
#else
        if (F.G > 16) { if (F.vcu < 16) dn_scan_naive(F, F.vcu); else swa_naive(F, (F.vcu - 16) * NWAVES + F.wave, (F.G - 16) * NWAVES); }
        else { for (int bh = F.vcu; bh < 16; bh += F.G) dn_scan_naive(F, bh); swa_naive(F, F.vcu * NWAVES + F.wave, F.G * NWAVES); }
#endif
}
__device__ __forceinline__ void run_phase4(Frame& F0) {
    Frame F = F0; asm volatile("" : "+v"(F.tid)); F.lane = F.tid & 63;
    unsigned char* ws = F.ws; bf16* XB = (bf16*)(ws + WS_XB); bf16* Y = (bf16*)(ws + WS_Y); bf16* PROJ = (bf16*)(ws + WS_PROJ); (void)XB; (void)Y; (void)PROJ;
}
__device__ __forceinline__ void run_phase5(Frame& F0) {
    Frame F = F0; asm volatile("" : "+v"(F.tid)); F.lane = F.tid & 63;
    unsigned char* ws = F.ws; bf16* XB = (bf16*)(ws + WS_XB); bf16* Y = (bf16*)(ws + WS_Y); bf16* PROJ = (bf16*)(ws + WS_PROJ); (void)XB; (void)Y; (void)PROJ;
        pg8::Gemm g{PROJ + PC_YDN, (const bf16*)(ws + WS_WAB), 2 * M, 2 * D, DN_W, NP, M / 256, (PC_YSW - PC_YDN) * 2};
        pg8::PairedOrder S; S.init(M, D, F.G, (int)blockIdx.x);
        if (SEAM35 && F.G == 256) {
            pg8::Unit u0;
            if (S.next(0, u0) && F.wave == 0) { gu32* pc = F.ctl + CW_PAN + 64 * u0.pm;
                for (unsigned sp = 0; sp < (1u << 18); ++sp) {
                    const unsigned a0 = (unsigned)__builtin_amdgcn_readfirstlane((int)__hip_atomic_load(pc, RLX_AGENT)), a1 = (unsigned)__builtin_amdgcn_readfirstlane((int)__hip_atomic_load(pc + 1, RLX_AGENT)), a2 = (unsigned)__builtin_amdgcn_readfirstlane((int)__hip_atomic_load(pc + 2, RLX_AGENT));
                    if (a0 >= 64u && a1 >= 64u && a2 >= 7u) break;
                    __builtin_amdgcn_s_sleep(4); }
                __builtin_amdgcn_fence(__ATOMIC_ACQUIRE, "agent"); asm volatile("s_waitcnt vmcnt(0)" ::: "memory"); }
            __syncthreads(); }
#if P5_TOUCH_G
        {
            pg8::Unit u0; if (S.next(0, u0)) { const bf16* gt = PROJ + PC_G + (size_t)u0.pm * 256 * NP + u0.pn * 256;
#pragma unroll
                for (int i = 0; i < 4; ++i) { const int line = i * 512 + F.tid, half = line >> 10, row = (line >> 2) & 255, seg = line & 3;
                    __builtin_amdgcn_global_load_lds((const unsigned*)(gt + (size_t)row * NP + half * 1024 + seg * 64), (LAS unsigned*)(F.lds + LDSCTL_OFF + 1024 + F.wave * 256), 4, 0, 0); } } }
#endif
        pg8::EpiMerge E{PROJ + PC_G, NP, XB, D, M / 256, D / 256};
        pg8::gemm_phase<pg8::EpiMerge, pg8::PairedOrder, ALIGN_P5, true>(F.lds + RING_OFF, g, S, E);
        SUBSTAMP(1)
        if (SEAM56 && F.G == 256) {
            pg8::Unit u0; if (S.next(0, u0) && F.tid == 0) __hip_atomic_fetch_add(F.ctl + CW_P56 + 64 * u0.pm, 1u, RLX_AGENT); }
}
__device__ __forceinline__ void run_phase6(Frame& F0) {
    Frame F = F0; asm volatile("" : "+v"(F.tid)); F.lane = F.tid & 63;
    unsigned char* ws = F.ws; bf16* XB = (bf16*)(ws + WS_XB); bf16* Y = (bf16*)(ws + WS_Y); bf16* PROJ = (bf16*)(ws + WS_PROJ); (void)XB; (void)Y; (void)PROJ;
        pg8::Gemm g{XB, (const bf16*)(ws + WS_WOUT), M, D, D}; pg8::StaticOrder S; S.init(M, D, F.G, (int)blockIdx.x);
        {
            pg8::Unit u0; if (P6_TOUCH_X && S.next(0, u0)) { const float* xt = FIN(0) + (size_t)u0.pm * 256 * D + u0.pn * 256;
#pragma unroll
                for (int i = 0; i < 4; ++i) { const int line = (F.wave * 4 + i) * 64 + F.lane;
                    __builtin_amdgcn_global_load_lds((const unsigned*)(xt + (size_t)(line >> 3) * D + (line & 7) * 32), (LAS unsigned*)(F.lds + LDSCTL_OFF + 1024 + F.wave * 256), 4, 0, 0); } } }
#if P6_TOUCH_AB
        {
            pg8::Unit u0; if (S.next(0, u0)) {
                const char* bt = (const char*)(ws + WS_WOUT) + (size_t)u0.pn * 256 * D * 2; const char* at = (const char*)XB + (size_t)u0.pm * 256 * D * 2;
#pragma unroll
                for (int i = 0; i < 8; ++i) { const int line = i * 512 + F.tid;
                    __builtin_amdgcn_global_load_lds((const unsigned*)(bt + (size_t)line * 128), (LAS unsigned*)(F.lds + LDSCTL_OFF + 1024 + F.wave * 256), 4, 0, 0); }
#if P6_TOUCH_AB > 1
#pragma unroll
                for (int i = 0; i < 8; ++i) { const int line = i * 512 + F.tid;
                    __builtin_amdgcn_global_load_lds((const unsigned*)(at + (size_t)line * 128), (LAS unsigned*)(F.lds + LDSCTL_OFF + 1024 + F.wave * 256), 4, 0, 0); }
#endif
            } }
#endif
        if (SEAM56 && F.G == 256) {
            pg8::Unit u0;
            if (S.next(0, u0) && F.wave == 0) {
                for (unsigned sp = 0; sp < (1u << 18); ++sp) {
                    bool ok = (unsigned)__builtin_amdgcn_readfirstlane((int)__hip_atomic_load(F.ctl + CW_P56 + 64 * u0.pm, RLX_AGENT)) >= 4u;
                    if (SEAM35 && ok) { unsigned tot = 0u;
                        for (int q = 0; q < 8; ++q) tot += (unsigned)__builtin_amdgcn_readfirstlane((int)__hip_atomic_load(F.ctl + CW_SWADONE + 64 * q, RLX_AGENT));
                        ok = tot >= (unsigned)(BATCH * SW_H * (SEQ / 32)); }
                    if (ok) break;
                    __builtin_amdgcn_s_sleep(2); }
                __builtin_amdgcn_fence(__ATOMIC_ACQUIRE, "agent"); asm volatile("s_waitcnt vmcnt(0)" ::: "memory"); }
            __syncthreads(); }
        pg8::EpiX1 E{FIN(0), F.out, Y, (float*)(ws + WS_SSQ2), D};
        pg8::gemm_phase<pg8::EpiX1, pg8::StaticOrder, ALIGN_P6, true>(F.lds + RING_OFF, g, S, E);
        if (SEAM67 && F.G == 256) { pg8::Unit u0; if (S.next(0, u0) && F.tid == 0) __hip_atomic_fetch_add(F.ctl + CW_PAN + 64 * u0.pm + 3, 1u, RLX_AGENT); }
        SUBSTAMP(2)
}
__device__ __forceinline__ void run_phase7(Frame& F0) {
    Frame F = F0; asm volatile("" : "+v"(F.tid)); F.lane = F.tid & 63;
    unsigned char* ws = F.ws; bf16* XB = (bf16*)(ws + WS_XB); bf16* Y = (bf16*)(ws + WS_Y); bf16* PROJ = (bf16*)(ws + WS_PROJ); (void)XB; (void)Y; (void)PROJ;
        pg8::Gemm g{Y, (const bf16*)(ws + WS_WGU), M, 2 * FF, D};
        pg8::EpiSwiGLU E{PROJ, FF, (const float*)(ws + WS_SSQ2), EPS};
#if SEAM67
        if (F.G == 256) {
            pg8::SkewOrder S; S.init(M, 2 * FF, F.G, (int)blockIdx.x); S.pan = (const unsigned*)(F.ctl + CW_PAN); S.p56 = (const unsigned*)(F.ctl + CW_P56); S.act_row_bytes = FF * 2; S.proj_row_bytes = NP * 2;
            pg8::Unit u0;
            if (S.next(0, u0) && F.wave == 0) {
                const int fm = u0.pm & ~7;
                for (unsigned sp = 0; sp < (1u << 18); ++sp) {
                    unsigned wc_ = 0u;
                    for (int q = 0; q < 8; ++q) wc_ += (unsigned)__builtin_amdgcn_readfirstlane((int)__hip_atomic_load(F.ctl + CW_WCOPY + 64 * q, RLX_AGENT));
                    bool ok = wc_ >= 224u * NWAVES;
                    if (SKEW_CHK_ALL) ok = ok && S.panel_ready(u0.pm);
                    else for (int q = 0; q < 8; ++q) ok = ok && S.panel_ready(fm + q);
                    if (ok) break;
                    __builtin_amdgcn_s_sleep(4); }
                __builtin_amdgcn_fence(__ATOMIC_ACQUIRE, "agent"); asm volatile("s_waitcnt vmcnt(0)" ::: "memory"); }
            __syncthreads();
            pg8::gemm_phase<pg8::EpiSwiGLU, pg8::SkewOrder, ALIGN_P7, true>(F.lds + RING_OFF, g, S, E);
            if (SEAM78 && F.tid == 0) {
                pg8::Unit u_; for (int i_ = 0; S.next(i_, u_); ++i_) __hip_atomic_fetch_add(F.ctl + CW_PAN + 64 * u_.pm + 4, 1u, RLX_AGENT); }
            SUBSTAMP(0)
            return;
        }
#endif
#if TAIL_SPLIT
        pg8::TailSplitOrder S; S.init(M, 2 * FF, F.G, (int)blockIdx.x);
#else
        pg8::StaticOrder S; S.init(M, 2 * FF, F.G, (int)blockIdx.x);
#endif
#if TAIL_SPLIT
        pg8::gemm_phase<pg8::EpiSwiGLU, pg8::TailSplitOrder, ALIGN_P7, true, true>(F.lds + RING_OFF, g, S, E);
#else
        pg8::gemm_phase<pg8::EpiSwiGLU, pg8::StaticOrder, ALIGN_P7, SP2_P7>(F.lds + RING_OFF, g, S, E);
#endif
}
__device__ __forceinline__ void run_phase8(Frame& F0) {
    Frame F = F0; asm volatile("" : "+v"(F.tid)); F.lane = F.tid & 63;
    unsigned char* ws = F.ws; bf16* XB = (bf16*)(ws + WS_XB); bf16* Y = (bf16*)(ws + WS_Y); bf16* PROJ = (bf16*)(ws + WS_PROJ); (void)XB; (void)Y; (void)PROJ;
        pg8::Gemm g{PROJ, (const bf16*)(ws + WS_WD), M, D, FF}; pg8::StaticOrder S; S.init(M, D, F.G, (int)blockIdx.x);
        if (SEAM78 && SEAM67 && F.G == 256) {
            pg8::Unit u0;
            if (S.next(0, u0) && F.wave == 0) {
                for (unsigned sp = 0; sp < (1u << 18); ++sp) {
                    bool ok = (unsigned)__builtin_amdgcn_readfirstlane((int)__hip_atomic_load(F.ctl + CW_PAN + 64 * u0.pm + 4, RLX_AGENT)) >= 22u;
                    if (ok) { unsigned tot = 0u;
                        for (int q = 0; q < 8; ++q) tot += (unsigned)__builtin_amdgcn_readfirstlane((int)__hip_atomic_load(F.ctl + CW_NORMDONE + 64 * q, RLX_AGENT));
                        ok = tot >= 4096u; }
                    if (ok) break;
                    __builtin_amdgcn_s_sleep(4); }
                __builtin_amdgcn_fence(__ATOMIC_ACQUIRE, "agent"); asm volatile("s_waitcnt vmcnt(0)" ::: "memory"); }
            __syncthreads(); }
        pg8::EpiOut E{F.out, D, Y};
        pg8::gemm_phase<pg8::EpiOut, pg8::StaticOrder, ALIGN_P8, true>(F.lds + RING_OFF, g, S, E);
        SUBSTAMP(4)
}
#ifndef PROGRAM
#define PROGRAM RUN(0) BAR RUN(1) BAR RUN(2) BAR RUN(3) if (!(SEAM35 && F.G == 256)) { BAR } RUN(5) if (!(SEAM56 && F.G == 256)) { BAR } RUN(6) if (!(SEAM67 && F.G == 256)) { BAR } RUN(7) if (!(SEAM78 && SEAM67 && F.G == 256)) { BAR } RUN(8)
#endif
__global__ void __launch_bounds__(NWAVES * 64, 2) fwd_kernel(Args args) {
    extern __shared__ __attribute__((aligned(16))) unsigned char lds[];
    Frame F;
    F.lds = (LAS unsigned char*)lds;
    F.MISC = (volatile LAS unsigned*)(F.lds + MISC_OFF);
    F.tid = threadIdx.x; F.lane = F.tid & 63; F.wave = __builtin_amdgcn_readfirstlane(F.tid >> 6);
    F.G = gridDim.x; { const int bx = blockIdx.x; F.vcu = (F.G % 8 == 0) ? (bx % 8) * (F.G / 8) + bx / 8 : bx; }
    F.ka = (KArgs)__builtin_amdgcn_kernarg_segment_ptr();
    F.out = args.out; F.ws = args.ws; unsigned char* ws = args.ws;
    F.ctl = (gu32*)(ws + WS_CTL);
    for (int u = F.tid; u < (LDS_BYTES - LDSCTL_OFF) / 4; u += NWAVES * 64) ((LAS unsigned*)(F.lds + LDSCTL_OFF))[u] = 0u;
    __syncthreads();
    XcdBarrier bar; bar.bar = (unsigned*)(F.ctl + CW_BAR) + args.li * XCD_BAR_WORDS; bar.x = 0; bar.st = nullptr;
    bar = xcd_barrier_post((unsigned*)(F.ctl + CW_BAR) + args.li * XCD_BAR_WORDS, F.MISC + 8);
#if STAMP_PHASE >= 0
#if STAMP_SUB >= 0 || STAMP_DN >= 0
#define STAMP_()
#else
    int ns_ = 0;
#define STAMP_() { if (ns_ == STAMP_PHASE || ns_ == STAMP_PHASE + 1) { unsigned long long t_; asm volatile("s_memrealtime %0\n\ts_waitcnt lgkmcnt(0)" : "=s"(t_) :: "memory"); g_ts[ns_ - STAMP_PHASE] = t_; } ++ns_; }
#endif
#define RUN(k) run_phase##k(F);
#define BAR xcd_barrier(bar); STAMP_()
    STAMP_()
    PROGRAM
    BAR
#if STAMP_WS
    if (blockIdx.x == 0 && F.tid == 0) F.out[0] += (float)args.ws_mib;
#elif STAMP_DN >= 0
    if (blockIdx.x == STAMP_BLOCK && F.tid == 0) F.out[0] += (float)(g_dn[STAMP_DN]) * 0.01f;
#elif STAMP_SUB >= 0
    if (blockIdx.x == STAMP_BLOCK && F.tid == 0) F.out[0] += floorf((float)(g_sub[STAMP_SUBB] - g_sub[STAMP_SUB]) * 0.01f / STAMP_Q + 0.5f) * STAMP_Q - STAMP_OFF;
#else
    if (blockIdx.x == 0 && F.tid == 0) F.out[0] += floorf((float)(g_ts[1] - g_ts[0]) * 0.01f / STAMP_Q + 0.5f) * STAMP_Q - STAMP_OFF;
#endif
#undef RUN
#undef BAR
#else
#define RUN(k) run_phase##k(F);
#define BAR xcd_barrier(bar);
    PROGRAM
#if STAMP_WS
    BAR
    if (blockIdx.x == 0 && F.tid == 0) F.out[0] += (float)args.ws_mib;
#endif
#undef RUN
#undef BAR
#endif
}

extern "C" void kernel_launch(void* const* d_in, const int* in_sizes, int n_in, void* d_out, int out_size, void* d_ws, size_t ws_size, hipStream_t stream) {
    static int grid = 0;
    if (grid == 0) {
        if (n_in != 18 || in_sizes[0] != M * D || out_size != M * D || ws_size < WS_END) { fprintf(stderr, "kernel_launch: unexpected shapes (n_in %d, in0 %d, out %d, ws %zu)\n", n_in, n_in > 0 ? in_sizes[0] : -1, out_size, ws_size); grid = -1; return; }
        int dev = 0, cus = 0;
        if (hipGetDevice(&dev) != hipSuccess || hipDeviceGetAttribute(&cus, hipDeviceAttributeMultiprocessorCount, dev) != hipSuccess) { grid = -1; return; }
        if (hipFuncSetAttribute((const void*)fwd_kernel, hipFuncAttributeMaxDynamicSharedMemorySize, LDS_BYTES) != hipSuccess) { fprintf(stderr, "kernel_launch: hipFuncSetAttribute failed\n"); grid = -1; return; }
        int per_cu = 0;
        if (hipOccupancyMaxActiveBlocksPerMultiprocessor(&per_cu, (const void*)fwd_kernel, NWAVES * 64, LDS_BYTES) != hipSuccess || per_cu < 1) fprintf(stderr, "kernel_launch: occupancy query reports %d\n", per_cu);
        (void)hipGetLastError();
        grid = cus;
    }
    if (grid < 0) return;
    if (hipMemsetAsync((char*)d_ws + WS_CTL, 0, CTL_ZERO_BYTES, stream) != hipSuccess) return;
    Args a{};
    for (int i = 0; i < 18; ++i) a.in[i] = (const float*)d_in[i];
    a.out = (float*)d_out; a.ws = (unsigned char*)d_ws; a.ws_mib = (int)(ws_size >> 20);
    for (int li = 0; li < 1; ++li) {
        a.ph_lo = 0; a.ph_hi = 0;
        a.li = li;
        hipLaunchKernelGGL(fwd_kernel, dim3(grid), dim3(NWAVES * 64), LDS_BYTES, stream, a);
        const hipError_t le = hipPeekAtLastError();
        if (le != hipSuccess) { fprintf(stderr, "kernel_launch: launch %d failed: %s\n", li, hipGetErrorName(le)); break; }
    }
}
```

```cpp
#ifndef FAST_SWA
#define FAST_SWA 1
#endif
#ifndef FAST_DN
#define FAST_DN 1
#endif
#ifndef REP_DNA
#define REP_DNA 1
#endif
#ifndef REP_SWAPRE
#define REP_SWAPRE 1
#endif
#ifndef REP_S1
#define REP_S1 1
#endif
#ifndef REP_S2
#define REP_S2 1
#endif
#ifndef REP_S3A
#define REP_S3A 1
#endif
#ifndef REP_S3B
#define REP_S3B 1
#endif
#ifndef REP_S4
#define REP_S4 1
#endif
#ifndef S1_RELOAD
#define S1_RELOAD 0
#endif
#ifndef S1_OPAQUE
#define S1_OPAQUE 0
#endif
#ifndef P1_TILES
#define P1_TILES 12
#endif
#ifndef STAMP_PHASE
#define STAMP_PHASE -1
#endif
#ifndef STAMP_SUB
#define STAMP_SUB -1
#endif
#ifndef STAMP_BLOCK
#define STAMP_BLOCK 0
#endif
#ifndef STAMP_DN
#define STAMP_DN -1
#endif
#ifndef STAMP_WS
#define STAMP_WS 0
#endif
#ifndef P3_SKIP_SCAN
#define P3_SKIP_SCAN 0
#endif
#ifndef P3_SKIP_GEMM
#define P3_SKIP_GEMM 0
#endif
#ifndef SCAN_HOT
#define SCAN_HOT 0
#endif
#ifndef STAMP_Q
#define STAMP_Q 8.0f
#endif
#ifndef SCAN_AHEAD
#define SCAN_AHEAD 6
#endif
#ifndef SCAN_TOUCH_EN
#define SCAN_TOUCH_EN 0
#endif
#ifndef DEFER_WEIGHTS
#define DEFER_WEIGHTS 1
#endif
#ifndef P3_ONLY_SCAN
#define P3_ONLY_SCAN 0
#endif
#ifndef ALIGN_P7
#define ALIGN_P7 true
#endif
#ifndef ALIGN_P1
#define ALIGN_P1 true
#endif
#ifndef ALIGN_P5
#define ALIGN_P5 true
#endif
#ifndef ALIGN_P6
#define ALIGN_P6 true
#endif
#ifndef ALIGN_P8
#define ALIGN_P8 true
#endif
#ifndef SP2_P7
#define SP2_P7 true
#endif
#ifndef P3_ORDER
#define P3_ORDER 0
#endif
#ifndef SCAN_SETS
#define SCAN_SETS 4
#endif
#ifndef DNA_PREFETCH
#define DNA_PREFETCH 0
#endif
#ifndef SCAN_NT
#define SCAN_NT 0
#endif
#ifndef FUSE_QKNORM
#define FUSE_QKNORM 1
#endif
#ifndef STAMP_SUBB
#define STAMP_SUBB (STAMP_SUB + 1)
#endif
#ifndef SCAN_UPRE
#define SCAN_UPRE 2
#endif
#ifndef SCAN_PUBLISH
#define SCAN_PUBLISH 1
#endif
#ifndef SCAN_DRAIN_CNT
#define SCAN_DRAIN_CNT 0
#endif
#ifndef SCAN_O_SC1
#define SCAN_O_SC1 1
#endif
#ifndef SCAN_REFILL_LATE
#define SCAN_REFILL_LATE 1
#endif
#ifndef SCAN_O16
#define SCAN_O16 1
#endif
#ifndef STAMP_OFF
#define STAMP_OFF 0.0f
#endif
#ifndef DNO_SLEEP
#define DNO_SLEEP 8
#endif
#ifndef DNO_SKIPWORK
#define DNO_SKIPWORK 0
#endif
#ifndef DNO_SKIPALL
#define DNO_SKIPALL 0
#endif
#ifndef SCAN_PUB_LOADER
#define SCAN_PUB_LOADER 1
#endif
#ifndef SCAN_PUB_EVERY
#define SCAN_PUB_EVERY 1
#endif
#ifndef DNO_FENCE
#define DNO_FENCE 0
#endif
#ifndef SCAN_DRAIN_NONE
#define SCAN_DRAIN_NONE 0
#endif
#ifndef DNO_LAG
#define DNO_LAG 0
#endif
#ifndef EPI_WT
#define EPI_WT 0
#endif
#ifndef TAIL_SPLIT
#define TAIL_SPLIT 0
#endif
#ifndef GEMM_SAMETILE
#define GEMM_SAMETILE 0
#endif
#ifndef STAMP_EPI
#define STAMP_EPI 0
#endif
#ifndef SEAM56
#define SEAM56 1
#endif
#ifndef SCAN_QG_EARLY
#define SCAN_QG_EARLY 0
#endif
#ifndef BAR_EARLY_WB
#define BAR_EARLY_WB 0
#endif
#ifndef P0_DEEP
#define P0_DEEP 0
#endif
#ifndef DNO_STAGE
#define DNO_STAGE 1
#endif
#ifndef SEAM35
#define SEAM35 1
#endif
#ifndef P6_TOUCH_AB
#define P6_TOUCH_AB 0
#endif
#ifndef P5_TOUCH_G
#define P5_TOUCH_G 0
#endif
#ifndef P6_TOUCH_X
#define P6_TOUCH_X 0
#endif
#ifndef SEAM67
#define SEAM67 1
#endif
#ifndef SKEW_TAIL
#define SKEW_TAIL 1
#endif
#ifndef SEAM78
#define SEAM78 1
#endif
#ifndef ASYM_WCOPY
#define ASYM_WCOPY 1
#endif
#ifndef ASYM_DNO
#define ASYM_DNO 1
#endif
#ifndef SKEW_CHK_ALL
#define SKEW_CHK_ALL 1
#endif
#ifndef ASYM_SWA
#define ASYM_SWA 1
#endif
#ifndef ASYM_GATE
#define ASYM_GATE 1
#endif
#ifndef GEMM_B_AUX
#define GEMM_B_AUX 0
#endif
#ifndef FORCE_GRID
#define FORCE_GRID 0
#endif
#ifndef SPLIT23
#define SPLIT23 0
#endif
#ifndef WCOPY_EVEN
#define WCOPY_EVEN 1
#endif
#include <hip/hip_runtime.h>
#include <cstdio>
#include <cstdint>

#ifndef WGM_KNOB
#define WGM_KNOB 8
#endif
#ifndef EPI_REP
#define EPI_REP 1
#endif
#ifndef EPI_REP_WHICH
#define EPI_REP_WHICH 0
#endif
#ifndef RES_F32
#define RES_F32 0
#endif
#if STAMP_SUB >= 0
__device__ unsigned long long g_sub[8];
#define SUBSTAMP(i) if (blockIdx.x == STAMP_BLOCK && threadIdx.x == 0) g_sub[i] = __builtin_amdgcn_s_memrealtime();
#else
#define SUBSTAMP(i)
#endif
namespace pg8 {
#define PG8_LAS __attribute__((address_space(3)))
typedef unsigned short bf16_t;
typedef short bf16x8 __attribute__((ext_vector_type(8)));
typedef float f32x4 __attribute__((ext_vector_type(4)));
typedef unsigned u32x4 __attribute__((ext_vector_type(4)));
typedef unsigned u32x2 __attribute__((ext_vector_type(2)));
constexpr int BM = 256, BK = 64, HALF = 128, HTB = HALF * BK * 2  , STAGE_BYTES = 8 * HTB, NXCD = 8, WGM = WGM_KNOB;

__host__ __device__ __forceinline__ int lds_byte(int r, int c) { const int st = (r >> 4) * 2 + (c >> 5), rr = r & 15, cc = c & 31, ob = rr * 64 + cc * 2; return st * 1024 + (ob ^ (((ob >> 9) & 1) << 5)); }
__host__ __device__ __forceinline__ void stage_rc(int b, int& R, int& C) { const int st = b / 1024, sb = b % 1024, swz = sb ^ (((sb >> 9) & 1) << 5); R = (st >> 1) * 16 + swz / 64; C = (st & 1) * 32 + (swz % 64) / 2; }
__host__ __device__ __forceinline__ int perm32(int rho) { const int n = rho >> 4, i = rho & 15; return 8 * (i >> 2) + 4 * n + (i & 3); }

struct Unit { int pm, pn, hm, chk; };
struct Gemm { const bf16_t* A; const bf16_t* Bt; int M, N, K; int lda = 0, nMA = 1 << 30, a2off = 0; };

struct StaticOrder {
    int nM, nN, nwg, G, c;
    __host__ __device__ void init(int M, int N, int G_, int c_) { nM = M / BM; nN = N / BM; nwg = nM * nN; G = G_; c = c_; }
    __host__ __device__ bool next(int i, Unit& u) const { return nextL((long)i * G + c, u); }
    __host__ __device__ bool nextL(long L, Unit& u) const {
        if (L >= nwg) return false;
        u.hm = 0; u.chk = 0;
        int wgid = (int)L; { const int q = nwg / NXCD, r = nwg % NXCD, xcd = wgid % NXCD, off = wgid / NXCD; wgid = (xcd < r ? xcd * (q + 1) : r * (q + 1) + (xcd - r) * q) + off; }
        const int nig = WGM * nN, gid = wgid / nig, fm = gid * WGM, gsz = (nM - fm) < WGM ? (nM - fm) : WGM;
        u.pm = fm + ((wgid % nig) % gsz); u.pn = (wgid % nig) / gsz; return true;
    }
    __device__ __forceinline__ void a_ready(const Unit&) const {}
    __device__ __forceinline__ void done(const Unit&) const {}
};
struct TailSplitOrder {
    StaticOrder so; int full, rem; bool split;
    __host__ __device__ void init(int M, int N, int G_, int c_) { so.init(M, N, G_, c_); full = so.nwg / G_; rem = so.nwg - full * G_; split = TAIL_SPLIT && rem > 0 && 2 * rem <= G_; }
    __host__ __device__ bool next(int i, Unit& u) const {
        if (i < full || !split) return so.next(i, u);
        if (i > full || so.c >= 2 * rem) return false;
        if (!so.nextL((long)full * so.G + (so.c >> 1), u)) return false;
        u.hm = 1 + (so.c & 1); return true;
    }
    __device__ __forceinline__ void a_ready(const Unit&) const {}
    __device__ __forceinline__ void done(const Unit&) const {}
};
struct SkewOrder {
    StaticOrder so; const unsigned* pan; const unsigned* p56; int act_row_bytes, proj_row_bytes;
    __host__ __device__ void init(int M, int N, int G_, int c_) { so.init(M, N, G_, c_); }
    __host__ __device__ bool next(int i, Unit& u) const {
        const int full = so.nwg / so.G;
        if (i < full || !SKEW_TAIL) return so.next(i, u);
        if (i > full) return false;
        const int x = so.c & 7, off = so.c >> 3; if (x & 1) return false;
        if (!so.nextL((long)full * so.G + 8 * (off >> 1) + x + (off & 1), u)) return false;
        u.chk = SKEW_CHK_ALL ? 1 : (off & 1); return true;
    }
    __device__ __forceinline__ bool panel_ready(int pm) const {
        bool ok = (unsigned)__builtin_amdgcn_readfirstlane((int)__hip_atomic_load(pan + 64 * pm + 3, __ATOMIC_RELAXED, __HIP_MEMORY_SCOPE_AGENT)) >= 4u;
        const int lo = (pm * act_row_bytes) / proj_row_bytes, hi = ((pm + 1) * act_row_bytes - 1) / proj_row_bytes;
        for (int q = lo; q <= hi; ++q) ok = ok && (unsigned)__builtin_amdgcn_readfirstlane((int)__hip_atomic_load(p56 + 64 * q, __ATOMIC_RELAXED, __HIP_MEMORY_SCOPE_AGENT)) >= 4u;
        return ok;
    }
    __device__ __forceinline__ void a_ready(const Unit& u) const {
        if (u.chk) {
            if (threadIdx.x < 64) {
                for (unsigned sp = 0; !panel_ready(u.pm) && sp < (1u << 18); ++sp) __builtin_amdgcn_s_sleep(2);
                __builtin_amdgcn_fence(__ATOMIC_ACQUIRE, "agent"); asm volatile("s_waitcnt vmcnt(0)" ::: "memory"); }
            asm volatile("" ::: "memory"); __builtin_amdgcn_s_barrier(); asm volatile("" ::: "memory");
        }
    }
    __device__ __forceinline__ void done(const Unit&) const {}
};
struct GateSkewOrder {
    StaticOrder so; int par, x, s, call;
    __host__ __device__ bool next(int i, Unit& u) const {
        if (!par) return call == 0 && i == 0 && so.nextL((long)s * 8 + x, u);
        if (call == 0) return i == 0 && so.nextL((long)(28 + s) * 8 + (x - 1), u);
        return i < 2 && so.nextL((long)(28 * i + s) * 8 + x, u);
    }
    __device__ __forceinline__ void a_ready(const Unit&) const {}
    __device__ __forceinline__ void done(const Unit&) const {}
};
struct PairedOrder {
    StaticOrder so;
    __host__ __device__ void init(int M, int N, int G_, int c_) { so.init(M, N, G_, c_); }
    __host__ __device__ bool next(int i, Unit& u) const { if (!so.next(i >> 1, u)) return false; if (i & 1) { u.pm += so.nM; u.pn += so.nN; } return true; }
    __device__ __forceinline__ void a_ready(const Unit&) const {}
    __device__ __forceinline__ void done(const Unit&) const {}
};

__device__ __forceinline__ unsigned cvt_pk_bf16(float lo, float hi) { unsigned r; asm volatile("v_cvt_pk_bf16_f32 %0, %1, %2" : "=v"(r) : "v"(lo), "v"(hi)); return r; }
__device__ __forceinline__ float bf_lo(unsigned w) { return __builtin_bit_cast(float, w << 16); }
__device__ __forceinline__ float bf_hi(unsigned w) { return __builtin_bit_cast(float, w & 0xffff0000u); }
__device__ __forceinline__ float sigmoidf_(float x) { return 1.0f / (1.0f + __expf(-x)); }
template <class V> __device__ __forceinline__ void st16wt(void* p, V v) {
    asm volatile("global_store_dwordx4 %0, %1, off sc1\n\ts_nop 1" :: "v"((__attribute__((address_space(1))) V*)p), "v"(v) : "memory");
}
template <class V> __device__ __forceinline__ void st16(void* p, V v) {
#if EPI_WT
    asm volatile("global_store_dwordx4 %0, %1, off sc1\n\ts_nop 1" :: "v"((__attribute__((address_space(1))) V*)p), "v"(v) : "memory");
#else
    *(V*)p = v;
#endif
}


struct EpiProj {
    static constexpr bool SUBST = false, PERM = true, AFTER_DRAIN = false, PROBE_REP = (EPI_REP_WHICH == 1);
    bf16_t* O; int ldc; const float* rstd; int gate_pn0, pn_off;
    bf16_t* QS; bf16_t* KS; const float* qg; const float* kg; int q_pn0, k_pn;
    float qscale; int seq; int wt = 0;
    __device__ __forceinline__ bool keep(const Unit&) const { return false; }
    __device__ __forceinline__ void operator()(f32x4 (&acc)[2][2][4][2], const Unit& u, int wr, int wc, int fr, int fq) const {
        const int pna = u.pn + pn_off;
        const int row0 = u.pm * BM + wr * 64 + fr, col0 = pna * BM + wc * 64 + 8 * fq; const bool gate = pna >= gate_pn0;
        float sr[2][4];
#pragma unroll
        for (int ai = 0; ai < 2; ++ai)
#pragma unroll
            for (int m = 0; m < 4; ++m) sr[ai][m] = rstd[row0 + ai * HALF + m * 16];
        const bool isq = QS != nullptr && (pna == q_pn0 || pna == q_pn0 + 1), isk = QS != nullptr && pna == k_pn && wc < 2;
        if (isq || isk) {
            f32x4 gn[2][2];
#pragma unroll
            for (int bj = 0; bj < 2; ++bj)
#pragma unroll
                for (int n = 0; n < 2; ++n) { const int d = 32 * bj + 8 * fq + 4 * n; gn[bj][n] = isq ? *(const f32x4*)(qg + d) * qscale : *(const f32x4*)(kg + d); }
#pragma unroll
            for (int ai = 0; ai < 2; ++ai)
#pragma unroll
                for (int m = 0; m < 4; ++m) { const int row = row0 + ai * HALF + m * 16; const float s = sr[ai][m];
                    float ss = 0.f;
#pragma unroll
                    for (int bj = 0; bj < 2; ++bj)
#pragma unroll
                        for (int n = 0; n < 2; ++n) { const f32x4 v = acc[ai][bj][m][n] * s; ss += (v[0] * v[0] + v[1] * v[1]) + (v[2] * v[2] + v[3] * v[3]); }
                    ss += __shfl_xor(ss, 16); ss += __shfl_xor(ss, 32);
                    const float r = s * __builtin_amdgcn_rsqf(ss * (1.0f / 64.0f) + 1e-6f);
                    bf16_t* dst = isq ? QS + (size_t)row * 512 + (pna - q_pn0) * 256 + wc * 64 + 8 * fq
                                      : KS + ((size_t)((row / seq) * 2 + wc) * seq + (row % seq)) * 64 + 8 * fq;
#pragma unroll
                    for (int bj = 0; bj < 2; ++bj) { const f32x4 v0 = acc[ai][bj][m][0] * r * gn[bj][0], v1 = acc[ai][bj][m][1] * r * gn[bj][1];
                        u32x4 w; w.x = cvt_pk_bf16(v0[0], v0[1]); w.y = cvt_pk_bf16(v0[2], v0[3]); w.z = cvt_pk_bf16(v1[0], v1[1]); w.w = cvt_pk_bf16(v1[2], v1[3]);
                        st16(dst + bj * 32, w); } }
            return;
        }
#pragma unroll
        for (int ai = 0; ai < 2; ++ai)
#pragma unroll
            for (int m = 0; m < 4; ++m) { const int row = row0 + ai * HALF + m * 16; const float s = sr[ai][m]; bf16_t* rowp = O + (size_t)row * ldc + col0;
#pragma unroll
                for (int bj = 0; bj < 2; ++bj) { f32x4 v0 = acc[ai][bj][m][0] * s, v1 = acc[ai][bj][m][1] * s;
                    if (gate) {
#pragma unroll
                        for (int j = 0; j < 4; ++j) { v0[j] = __builtin_amdgcn_rcpf(1.0f + __expf(-v0[j])); v1[j] = __builtin_amdgcn_rcpf(1.0f + __expf(-v1[j])); } }
                    u32x4 w; w.x = cvt_pk_bf16(v0[0], v0[1]); w.y = cvt_pk_bf16(v0[2], v0[3]); w.z = cvt_pk_bf16(v1[0], v1[1]); w.w = cvt_pk_bf16(v1[2], v1[3]);
                    if (wt) st16wt(rowp + bj * 32, w); else st16(rowp + bj * 32, w); } }
    }
};
struct EpiMerge {
    static constexpr bool SUBST = false, PERM = true, AFTER_DRAIN = false, PROBE_REP = false;
    const bf16_t* G; int ldg; bf16_t* O; int ldc; int nM, nN;
    __device__ __forceinline__ bool keep(const Unit& u) const { return u.pm < nM; }
    __device__ __forceinline__ void operator()(f32x4 (&acc)[2][2][4][2], const Unit& u, int wr, int wc, int fr, int fq) const {
        const bool second = u.pm >= nM; const int pm = second ? u.pm - nM : u.pm, pn = second ? u.pn - nN : u.pn;
        const int row0 = pm * BM + wr * 64 + fr, col0 = pn * BM + wc * 64 + 8 * fq;
#pragma unroll
        for (int ai = 0; ai < 2; ++ai) {
            u32x4 gA[4][2], gB[4][2];
#pragma unroll
            for (int m = 0; m < 4; ++m)
#pragma unroll
                for (int bj = 0; bj < 2; ++bj) { const size_t o = (size_t)(row0 + ai * HALF + m * 16) * ldg + col0 + bj * 32; if (!second) gA[m][bj] = *(const u32x4*)(G + o); gB[m][bj] = *(const u32x4*)(G + o + 1024); }
#pragma unroll
            for (int m = 0; m < 4; ++m) { const int row = row0 + ai * HALF + m * 16;
#pragma unroll
                for (int bj = 0; bj < 2; ++bj) { const int col = col0 + bj * 32;
                    float sb[8];
#pragma unroll
                    for (int j = 0; j < 4; ++j) { sb[2 * j] = bf_lo(gB[m][bj][j]); sb[2 * j + 1] = bf_hi(gB[m][bj][j]); }
                    if (!second) {
                        float sa[8];
#pragma unroll
                        for (int j = 0; j < 4; ++j) { sa[2 * j] = bf_lo(gA[m][bj][j]); sa[2 * j + 1] = bf_hi(gA[m][bj][j]); }
#pragma unroll
                        for (int j = 0; j < 4; ++j) { acc[ai][bj][m][0][j] *= sa[j] * __builtin_amdgcn_rcpf(sb[j]); acc[ai][bj][m][1][j] *= sa[4 + j] * __builtin_amdgcn_rcpf(sb[4 + j]); }
                    } else {
                        f32x4 v0, v1;
#pragma unroll
                        for (int j = 0; j < 4; ++j) { v0[j] = acc[ai][bj][m][0][j] * sb[j]; v1[j] = acc[ai][bj][m][1][j] * sb[4 + j]; }
                        u32x4 w; w.x = cvt_pk_bf16(v0[0], v0[1]); w.y = cvt_pk_bf16(v0[2], v0[3]); w.z = cvt_pk_bf16(v1[0], v1[1]); w.w = cvt_pk_bf16(v1[2], v1[3]);
                        if (SEAM56) st16wt(O + (size_t)row * ldc + col, w); else st16(O + (size_t)row * ldc + col, w); } } }
            asm volatile("" ::: "memory"); }
    }
};
struct EpiX1 {
    static constexpr bool SUBST = (STAMP_EPI == 6), PERM = (SEAM67 != 0), AFTER_DRAIN = false, PROBE_REP = (EPI_REP_WHICH == 6);
    const float* X; float* out; bf16_t* xb; float* ssq; int ldc;
    __device__ __forceinline__ bool keep(const Unit&) const { return false; }
    __device__ __forceinline__ void operator()(f32x4 (&acc)[2][2][4][2], const Unit& u, int wr, int wc, int fr, int fq) const {
        const int row0 = u.pm * BM + wr * 64 + fr, col0 = u.pn * BM + wc * 32 + (PERM ? 8 : 4) * fq; constexpr int NOFF = PERM ? 4 : 16;
#pragma unroll
        for (int ai = 0; ai < 2; ++ai) {
            f32x4 xv[4][2][2];
#pragma unroll
            for (int m = 0; m < 4; ++m)
#pragma unroll
                for (int bj = 0; bj < 2; ++bj)
#pragma unroll
                    for (int n = 0; n < 2; ++n) xv[m][bj][n] = *(const f32x4*)(X + (size_t)(row0 + ai * HALF + m * 16) * ldc + col0 + bj * HALF + n * NOFF);
#pragma unroll
            for (int m = 0; m < 4; ++m) { const int row = row0 + ai * HALF + m * 16; const size_t off = (size_t)row * ldc + col0; float ss = 0.f;
#pragma unroll
                for (int bj = 0; bj < 2; ++bj) { u32x4 w4;
#pragma unroll
                    for (int n = 0; n < 2; ++n) { const f32x4 o = xv[m][bj][n] + acc[ai][bj][m][n];
                        if (RES_F32) *(f32x4*)(out + off + bj * HALF + n * NOFF) = o; ss += (o[0] * o[0] + o[1] * o[1]) + (o[2] * o[2] + o[3] * o[3]);
                        u32x2 w; w.x = cvt_pk_bf16(o[0], o[1]); w.y = cvt_pk_bf16(o[2], o[3]);
                        if (PERM) { if (n == 0) { w4.x = w.x; w4.y = w.y; } else { w4.z = w.x; w4.w = w.y; } }
                        else *(u32x2*)(xb + off + bj * HALF + n * 16) = w; }
                    if (PERM) st16wt(xb + off + bj * HALF, w4); }
                ss += __shfl_xor(ss, 16); ss += __shfl_xor(ss, 32);
                if (fq == 0) atomicAdd(ssq + row, ss); }
            asm volatile("" ::: "memory"); }
    }
};
struct EpiSwiGLU {
    static constexpr bool SUBST = false, PERM = true, AFTER_DRAIN = false, PROBE_REP = (EPI_REP_WHICH == 7);
    bf16_t* O; int ldc; const float* ssq; float eps;
    __device__ __forceinline__ bool keep(const Unit&) const { return false; }
    __device__ __forceinline__ void operator()(f32x4 (&acc)[2][2][4][2], const Unit& u, int wr, int wc, int fr, int fq) const {
        const int row0 = u.pm * BM + (u.hm == 2 ? HALF : 0) + wr * 64 + fr, col0 = u.pn * HALF + wc * 32 + 8 * fq;
        float sr[2][4];
#pragma unroll
        for (int ai = 0; ai < 2; ++ai)
#pragma unroll
            for (int m = 0; m < 4; ++m) sr[ai][m] = ssq[row0 + (u.hm ? 0 : ai * HALF) + m * 16];
#pragma unroll
        for (int ai = 0; ai < 2; ++ai)
#pragma unroll
            for (int m = 0; m < 4; ++m) { const int row = row0 + ai * HALF + m * 16;
                if (ai == 1 && u.hm) continue;
                const float s = __builtin_amdgcn_rsqf(sr[ai][m] * (1.0f / 1024.0f) + eps);
                float a[8];
#pragma unroll
                for (int n = 0; n < 2; ++n)
#pragma unroll
                    for (int j = 0; j < 4; ++j) { const float g = acc[ai][0][m][n][j] * s, up = acc[ai][1][m][n][j] * s; a[4 * n + j] = g * up * __builtin_amdgcn_rcpf(1.0f + __expf(-g)); }
                u32x4 w; w.x = cvt_pk_bf16(a[0], a[1]); w.y = cvt_pk_bf16(a[2], a[3]); w.z = cvt_pk_bf16(a[4], a[5]); w.w = cvt_pk_bf16(a[6], a[7]);
                if (SEAM78) st16wt(O + (size_t)row * ldc + col0, w); else st16(O + (size_t)row * ldc + col0, w); }
    }
};
struct EpiOut {
    static constexpr bool SUBST = (STAMP_EPI == 8), PERM = false, AFTER_DRAIN = false, PROBE_REP = false;
    float* out; int ldc; const bf16_t* xb;
    __device__ __forceinline__ bool keep(const Unit&) const { return false; }
    __device__ __forceinline__ void operator()(f32x4 (&acc)[2][2][4][2], const Unit& u, int wr, int wc, int fr, int fq) const {
        const int row0 = u.pm * BM + wr * 64 + fr, col0 = u.pn * BM + wc * 32 + 4 * fq;
#pragma unroll
        for (int ai = 0; ai < 2; ++ai) {
            u32x2 rb[4][2][2]; f32x4 rf[4][2][2];
#pragma unroll
            for (int m = 0; m < 4; ++m)
#pragma unroll
                for (int bj = 0; bj < 2; ++bj)
#pragma unroll
                    for (int n = 0; n < 2; ++n) { const size_t o = (size_t)(row0 + ai * HALF + m * 16) * ldc + col0 + bj * HALF + n * 16;
                        if (RES_F32) rf[m][bj][n] = *(const f32x4*)(out + o); else rb[m][bj][n] = *(const u32x2*)(xb + o); }
#pragma unroll
            for (int m = 0; m < 4; ++m) { const size_t off = (size_t)(row0 + ai * HALF + m * 16) * ldc + col0;
#pragma unroll
                for (int bj = 0; bj < 2; ++bj)
#pragma unroll
                    for (int n = 0; n < 2; ++n) { f32x4 b;
                        if (RES_F32) b = rf[m][bj][n]; else { const u32x2 w = rb[m][bj][n]; b = (f32x4){bf_lo(w.x), bf_hi(w.x), bf_lo(w.y), bf_hi(w.y)}; }
                        *(f32x4*)(out + off + bj * HALF + n * 16) = b + acc[ai][bj][m][n]; } }
            asm volatile("" ::: "memory"); }
    }
};

template <class Epi, class Sched, bool ALIGN_EPI = false, bool SP2 = false, bool HM = false>
__device__ __forceinline__ void gemm_phase(PG8_LAS unsigned char* lds, const Gemm g, const Sched& S, const Epi& E) {
    int tid_ = threadIdx.x; asm volatile("" : "+v"(tid_));
    const int tid = tid_, wid = __builtin_amdgcn_readfirstlane(tid >> 6), lane = tid & 63, wr = wid >> 2, wc = wid & 3, fr = lane & 15, fq = lane >> 4;
    const int K = g.K, nt = K / BK, LDA = g.lda ? g.lda : g.K;
    unsigned voffA[2], voffB[2];
#pragma unroll
    for (int i = 0; i < 2; ++i) { int R, C; stage_rc(tid * 16 + i * 8192, R, C); const int Rb = Epi::PERM ? ((R & ~31) + perm32(R & 31)) : R;
        voffA[i] = (unsigned)(R * LDA + C) * 2u; voffB[i] = (unsigned)(Rb * K + C) * 2u; }
    const size_t kstep = (size_t)(BK * 2);
    const size_t hstep = (size_t)HALF * K * 2;
    const size_t tstep = 2 * hstep;
    const size_t hstepA = (size_t)HALF * LDA * 2, tstepA = 2 * hstepA;
#define PG8_ABASE(pm_) ((const char*)g.A + (GEMM_SAMETILE ? (size_t)0 : ((pm_) < g.nMA ? (size_t)(pm_) * tstepA : (size_t)((pm_) - g.nMA) * tstepA + (size_t)g.a2off)))
    const unsigned ldsw = (unsigned)wid * 1024u;
    const int aoff = lds_byte(wr * 64 + fr, fq * 8), boff = lds_byte(wc * 32 + fr, fq * 8);
#define PG8_SA(b, h) (((b) * 2 + (h)) * HTB)
#define PG8_SB(b, h) ((4 + (b) * 2 + (h)) * HTB)
#define PG8_STAGE(bufoff, gbase, voff) do { _Pragma("unroll") for (int _i = 0; _i < 2; ++_i) \
        __builtin_amdgcn_global_load_lds((const unsigned*)((const char*)(gbase) + (voff)[_i]), (PG8_LAS unsigned*)(lds + (bufoff) + ldsw + _i * 8192), 16, 0, 0); } while (0)
#define PG8_STAGEB(bufoff, gbase, voff) do { _Pragma("unroll") for (int _i = 0; _i < 2; ++_i) \
        __builtin_amdgcn_global_load_lds((const unsigned*)((const char*)(gbase) + (voff)[_i]), (PG8_LAS unsigned*)(lds + (bufoff) + ldsw + _i * 8192), 16, 0, GEMM_B_AUX); } while (0)
#define PG8_LDA(dst, b, h) do { _Pragma("unroll") for (int m = 0; m < 4; ++m) _Pragma("unroll") for (int k = 0; k < 2; ++k) dst[m][k] = *(const PG8_LAS bf16x8*)(lds + PG8_SA(b, h) + aoff + m * 2048 + k * 1024); } while (0)
#define PG8_LDB(dst, b, h) do { _Pragma("unroll") for (int n = 0; n < 2; ++n) _Pragma("unroll") for (int k = 0; k < 2; ++k) dst[n][k] = *(const PG8_LAS bf16x8*)(lds + PG8_SB(b, h) + boff + n * 2048 + k * 1024); } while (0)
#define PG8_MMA(ai, bj, At, Bt) do { __builtin_amdgcn_s_setprio(1); _Pragma("unroll") for (int m = 0; m < 4; ++m) _Pragma("unroll") for (int n = 0; n < 2; ++n) _Pragma("unroll") for (int k = 0; k < 2; ++k) \
        acc[ai][bj][m][n] = __builtin_amdgcn_mfma_f32_16x16x32_bf16(Bt[n][k], At[m][k], acc[ai][bj][m][n], 0, 0, 0); __builtin_amdgcn_s_setprio(0); } while (0)
#define PG8_WAIT_V(n) asm volatile("s_waitcnt vmcnt(" #n ")" ::: "memory")
#define PG8_WAIT_L(n) asm volatile("s_waitcnt lgkmcnt(" #n ")" ::: "memory")
#define PG8_BAR __builtin_amdgcn_s_barrier()
#define PG8_SCHED __builtin_amdgcn_sched_barrier(0)
    Unit cur, nxt; int ui = 0;
    if (!S.next(0, cur)) return;
    f32x4 acc[2][2][4][2];
#pragma unroll
    for (int a = 0; a < 2; ++a)
#pragma unroll
        for (int b = 0; b < 2; ++b)
#pragma unroll
            for (int m = 0; m < 4; ++m)
#pragma unroll
                for (int n = 0; n < 2; ++n) acc[a][b][m][n] = (f32x4){0.f, 0.f, 0.f, 0.f};
    bf16x8 At[4][2], B0[2][2], B1[2][2];
    static_assert(!HM || SP2, "half units: SP2 schedule only");
    bool chalf = HM && cur.hm != 0; size_t cH = chalf ? 0 : hstepA;
    const char* cA = PG8_ABASE(cur.pm) + ((HM && cur.hm == 2) ? hstepA : 0); const char* cB = (const char*)g.Bt + (GEMM_SAMETILE ? (size_t)0 : (size_t)cur.pn * tstep);
    S.a_ready(cur);
    if constexpr (SP2) {
        PG8_STAGEB(PG8_SB(0, 0), cB, voffB); PG8_STAGEB(PG8_SB(0, 1), cB + hstep, voffB); PG8_STAGE(PG8_SA(0, 0), cA, voffA); PG8_STAGE(PG8_SA(0, 1), cA + cH, voffA);
        if (wr == 1) PG8_BAR;
        PG8_WAIT_V(2); PG8_BAR;
        PG8_STAGEB(PG8_SB(1, 0), cB + kstep, voffB); PG8_STAGE(PG8_SA(1, 0), cA + kstep, voffA); PG8_STAGEB(PG8_SB(1, 1), cB + hstep + kstep, voffB);
        PG8_WAIT_V(6); PG8_BAR;
    } else {
        PG8_STAGEB(PG8_SB(0, 0), cB, voffB); PG8_STAGE(PG8_SA(0, 0), cA, voffA); PG8_STAGEB(PG8_SB(0, 1), cB + hstep, voffB); PG8_STAGE(PG8_SA(0, 1), cA + cH, voffA);
        if (wr == 1) PG8_BAR;
        PG8_WAIT_V(4); PG8_BAR;
        PG8_STAGEB(PG8_SB(1, 0), cB + kstep, voffB); PG8_STAGE(PG8_SA(1, 0), cA + kstep, voffA); PG8_STAGEB(PG8_SB(1, 1), cB + hstep + kstep, voffB);
        PG8_WAIT_V(6); PG8_BAR;
    }
    for (;;) {
        const bool has_next = S.next(ui + 1, nxt);
        const bool nhalf = has_next ? (HM && nxt.hm != 0) : chalf; const size_t nH = nhalf ? 0 : hstepA;
        const char* nA = has_next ? PG8_ABASE(nxt.pm) + ((HM && nxt.hm == 2) ? hstepA : 0) : cA; const char* nB = has_next ? (const char*)g.Bt + (GEMM_SAMETILE ? (size_t)0 : (size_t)nxt.pn * tstep) : cB;
        for (int t = 0; t < nt; t += 2) {
            const bool last = (t == nt - 2);
            const char* a1 = cA + (size_t)(t + 1) * kstep;
            const char* a2 = last ? nA : cA + (size_t)(t + 2) * kstep; const char* b2 = last ? nB : cB + (size_t)(t + 2) * kstep;
            const char* a3 = a2 + kstep; const char* b3 = b2 + kstep;
            const size_t h2 = last ? nH : cH;
            if (last && has_next) S.a_ready(nxt);
            if constexpr (SP2) {
            PG8_LDB(B0, 0, 0); PG8_LDB(B1, 0, 1); PG8_SCHED; PG8_LDA(At, 0, 0); PG8_STAGE(PG8_SA(1, 1), a1 + cH, voffA);
            PG8_WAIT_V(8); PG8_WAIT_L(0); PG8_BAR; PG8_MMA(0, 0, At, B0); PG8_MMA(0, 1, At, B1); PG8_BAR; PG8_SCHED;
            if (!chalf) PG8_LDA(At, 0, 1); PG8_STAGEB(PG8_SB(0, 0), b2, voffB); PG8_STAGEB(PG8_SB(0, 1), b2 + hstep, voffB); PG8_STAGE(PG8_SA(0, 0), a2, voffA);
            PG8_WAIT_V(8); PG8_WAIT_L(0); PG8_BAR; if (!chalf) { PG8_MMA(1, 0, At, B0); PG8_MMA(1, 1, At, B1); } PG8_BAR; PG8_SCHED;
            PG8_LDB(B0, 1, 0); PG8_LDB(B1, 1, 1); PG8_SCHED; PG8_LDA(At, 1, 0); PG8_STAGE(PG8_SA(0, 1), a2 + h2, voffA);
            PG8_WAIT_V(8); PG8_WAIT_L(0); PG8_BAR; PG8_MMA(0, 0, At, B0); PG8_MMA(0, 1, At, B1); PG8_BAR; PG8_SCHED;
            if (!chalf) PG8_LDA(At, 1, 1); PG8_STAGEB(PG8_SB(1, 0), b3, voffB); PG8_STAGEB(PG8_SB(1, 1), b3 + hstep, voffB); PG8_STAGE(PG8_SA(1, 0), a3, voffA);
            PG8_WAIT_V(8); PG8_WAIT_L(0); PG8_BAR; if (!chalf) { PG8_MMA(1, 0, At, B0); PG8_MMA(1, 1, At, B1); } PG8_BAR; PG8_SCHED;
            } else {
            PG8_LDB(B0, 0, 0); PG8_SCHED; PG8_LDA(At, 0, 0); PG8_STAGE(PG8_SA(1, 1), a1 + cH, voffA);
            PG8_WAIT_L(8); PG8_BAR; PG8_WAIT_L(0); PG8_MMA(0, 0, At, B0); PG8_BAR; PG8_SCHED;
            PG8_LDB(B1, 0, 1); PG8_STAGEB(PG8_SB(0, 0), b2, voffB);
            PG8_BAR; PG8_WAIT_L(0); PG8_MMA(0, 1, At, B1); PG8_BAR;
            PG8_LDA(At, 0, 1); PG8_STAGE(PG8_SA(0, 0), a2, voffA);
            PG8_BAR; PG8_WAIT_L(0); PG8_MMA(1, 0, At, B0); PG8_BAR; PG8_SCHED;
            PG8_STAGEB(PG8_SB(0, 1), b2 + hstep, voffB);
            PG8_WAIT_V(6); PG8_BAR; PG8_MMA(1, 1, At, B1); PG8_BAR;
            PG8_LDB(B0, 1, 0); PG8_SCHED; PG8_LDA(At, 1, 0); PG8_STAGE(PG8_SA(0, 1), a2 + h2, voffA);
            PG8_WAIT_L(8); PG8_BAR; PG8_WAIT_L(0); PG8_MMA(0, 0, At, B0); PG8_BAR; PG8_SCHED;
            PG8_LDB(B1, 1, 1); PG8_STAGEB(PG8_SB(1, 0), b3, voffB);
            PG8_BAR; PG8_WAIT_L(0); PG8_MMA(0, 1, At, B1); PG8_BAR;
            PG8_LDA(At, 1, 1); PG8_STAGE(PG8_SA(1, 0), a3, voffA);
            PG8_BAR; PG8_WAIT_L(0); PG8_MMA(1, 0, At, B0); PG8_BAR; PG8_SCHED;
            PG8_STAGEB(PG8_SB(1, 1), b3 + hstep, voffB);
            PG8_WAIT_V(6); PG8_BAR; PG8_MMA(1, 1, At, B1); PG8_BAR;
            }
        }
        if (Epi::SUBST) { SUBSTAMP(5) }
        if constexpr (ALIGN_EPI) { if (wr == 0) PG8_BAR; }
        if constexpr (!Epi::AFTER_DRAIN) { for (int er_ = 0; er_ < (Epi::PROBE_REP ? EPI_REP : 1); ++er_) { E(acc, cur, wr, wc, fr, fq); if (Epi::PROBE_REP && EPI_REP > 1) asm volatile("" ::: "memory"); } S.done(cur); }
        if (Epi::SUBST) { SUBSTAMP(6) }
        if (!has_next) break;
        if (!E.keep(cur)) {
#pragma unroll
        for (int a = 0; a < 2; ++a)
#pragma unroll
            for (int b = 0; b < 2; ++b)
#pragma unroll
                for (int m = 0; m < 4; ++m)
#pragma unroll
                    for (int n = 0; n < 2; ++n) acc[a][b][m][n] = (f32x4){0.f, 0.f, 0.f, 0.f};
        }
        cur = nxt; cA = nA; cB = nB; chalf = nhalf; cH = nH; ++ui;
        if constexpr (ALIGN_EPI) { if (wr == 1) PG8_BAR; }
    }
    PG8_WAIT_V(0);
    if constexpr (!ALIGN_EPI) { if (wr == 0) PG8_BAR; }
    PG8_BAR;
    if constexpr (Epi::AFTER_DRAIN) { E.fused(acc, cur, wr, wc, fr, fq, lds, wid, lane); S.done(cur); }
#undef PG8_ABASE
#undef PG8_SA
#undef PG8_SB
#undef PG8_STAGE
#undef PG8_STAGEB
#undef PG8_LDA
#undef PG8_LDB
#undef PG8_MMA
#undef PG8_WAIT_V
#undef PG8_WAIT_L
#undef PG8_BAR
#undef PG8_SCHED
}
}

constexpr int NWAVES = 8;
#ifndef MK_N_LAUNCHES
#define MK_N_LAUNCHES 1
#endif
constexpr int PER_PHASE = 9;
constexpr int N_LAUNCHES = MK_N_LAUNCHES;

constexpr int BATCH = 4, SEQ = 4096, D = 1024, M = BATCH * SEQ;
constexpr int DN_H = 4, DN_D = 128, DN_W = 512, DN_QKV = 1536;
constexpr int SW_H = 8, SW_KV = 2, SW_D = 64, SW_W = 512, SW_KVW = 128, WINDOW = 128;
constexpr int FF = 2816;
constexpr int D_IN = 4872;
constexpr int NP = 4864;
constexpr int PC_Z = 1536, PC_SQ = 2048, PC_SK = 2560, PC_SV = 2688, PC_G = 2816;
constexpr int PC_YDN = 0, PC_YSW = 512;
constexpr float EPS = 1e-6f;

constexpr size_t MiB = 1u << 20;
constexpr size_t WS_CTL = 0, CTL_ZERO_BYTES = 65536;
constexpr size_t WS_WIN = 1 * MiB;
constexpr size_t WS_WAB = 11 * MiB;
constexpr size_t WS_WOUT = 13 * MiB;
constexpr size_t WS_WGU = 15 * MiB;
constexpr size_t WS_WD = 26 * MiB;
constexpr size_t WS_RSTD = 32 * MiB;
constexpr size_t WS_GB = WS_RSTD + 64 * 1024;
constexpr size_t WS_SSQ = 33 * MiB;
constexpr size_t WS_SSQ2 = WS_SSQ + 65536;
constexpr size_t WS_XB = 34 * MiB;
constexpr size_t WS_Y = 66 * MiB;
constexpr size_t WS_PROJ = 98 * MiB;
constexpr size_t WS_UB = 250 * MiB;
constexpr size_t WS_END = 256 * MiB;
static_assert(WS_PROJ + (size_t)M * NP * 2 <= WS_UB, "ws map");
constexpr int CW_TMO = 0, CW_SCAN = 1024  , CW_WCOPY = 3201  , CW_NORMDONE = 3202  , CW_SWADONE = 3200  , CW_BAR = 4096, CW_P56 = 8192  , CW_P67 = 12288, CW_PAN = 12288  ;

constexpr int RING_OFF = 0, RING_BYTES = 131072;
constexpr int LDSCTL_OFF = RING_BYTES, MISC_OFF = LDSCTL_OFF + 320;
constexpr int LDS_BYTES = 147456;

#define GAS __attribute__((address_space(1)))
#define LAS __attribute__((address_space(3)))
typedef unsigned short bf16;
typedef unsigned v4u __attribute__((ext_vector_type(4)));
typedef float f32x4 __attribute__((ext_vector_type(4)));
typedef float f32x2 __attribute__((ext_vector_type(2)));
typedef GAS unsigned gu32;
#define RLX_AGENT __ATOMIC_RELAXED, __HIP_MEMORY_SCOPE_AGENT
#define LDS_WAIT() asm volatile("s_waitcnt lgkmcnt(0)" ::: "memory")
#define VM_WAIT() asm volatile("s_waitcnt vmcnt(0)" ::: "memory")
__device__ __forceinline__ unsigned f2bf(float f) { unsigned u = __builtin_bit_cast(unsigned, f); return (u + 0x7fffu + ((u >> 16) & 1u)) >> 16; }
__device__ __forceinline__ unsigned pk2(float lo, float hi) { return f2bf(lo) | (f2bf(hi) << 16); }
__device__ __forceinline__ float bflo(unsigned w) { return __builtin_bit_cast(float, w << 16); }
__device__ __forceinline__ float bfhi(unsigned w) { return __builtin_bit_cast(float, w & 0xffff0000u); }
__device__ __forceinline__ float bf1(bf16 h) { return __builtin_bit_cast(float, (unsigned)h << 16); }
__device__ __forceinline__ float sigm(float x) { return __builtin_amdgcn_rcpf(1.0f + __expf(-x)); }
__device__ __forceinline__ float frsq(float x) { return __builtin_amdgcn_rsqf(x); }
template <int CTRL> __device__ __forceinline__ float dpp_mov(float v) { return __builtin_bit_cast(float, __builtin_amdgcn_update_dpp(0, __builtin_bit_cast(int, v), CTRL, 0xf, 0xf, true)); }
__device__ __forceinline__ float sum4(float v) { v += dpp_mov<0xB1>(v); v += dpp_mov<0x4E>(v); return v; }
__device__ __forceinline__ float sum8(float v) { v = sum4(v); v += dpp_mov<0x141>(v); return v; }
__device__ __forceinline__ float sum16(float v) { v = sum8(v); v += dpp_mov<0x140>(v); return v; }
__device__ __forceinline__ float rdlane(float v, int l) { return __builtin_bit_cast(float, __builtin_amdgcn_readlane(__builtin_bit_cast(int, v), l)); }
__device__ __forceinline__ float wave_sum(float v) { v = sum16(v); return (rdlane(v, 0) + rdlane(v, 16)) + (rdlane(v, 32) + rdlane(v, 48)); }
__device__ __forceinline__ float sum32(float v, int lane) { v = sum16(v); const float lo = rdlane(v, 0) + rdlane(v, 16), hi = rdlane(v, 32) + rdlane(v, 48); return (lane & 32) ? hi : lo; }
__device__ __forceinline__ float wave_max(float v) {
#pragma unroll
    for (int o = 1; o < 64; o <<= 1) v = fmaxf(v, __shfl_xor(v, o));
    return v;
}

#define XB_TMO      128
#define XB_XCNT(j)  (256  + 64 * (j))
#define XB_XSUB(j)  (1280 + 64 * (j))
#define XB_XGEN(j)  (2304 + 64 * (j))
#define XB_TOP      3328
#define XB_TOPGEN   3392
#define XCD_BAR_WORDS 3456
#define XB_SPIN_CAP (1u << 18)
__device__ __forceinline__ unsigned xb_ld(unsigned* p)              { return __hip_atomic_load(p, __ATOMIC_RELAXED, __HIP_MEMORY_SCOPE_AGENT); }
__device__ __forceinline__ unsigned xb_add(unsigned* p, unsigned v) { return __hip_atomic_fetch_add(p, v, __ATOMIC_RELAXED, __HIP_MEMORY_SCOPE_AGENT); }
__device__ __forceinline__ unsigned xb_xcc_id() { return (unsigned)__builtin_amdgcn_s_getreg((3 << 11) | 20) & 0xFu; }
#define XB_SPIN(cond, bar) do { unsigned _sp = 0; while (cond) { __builtin_amdgcn_s_sleep(1); \
    if ((++_sp & 255u) == 0u) { if (xb_ld(&(bar)[XB_TMO])) break; if (_sp > XB_SPIN_CAP) { atomicAdd(&(bar)[XB_TMO], 1u); break; } } } } while (0)
struct XcdBarrier { unsigned* bar; unsigned x; volatile LAS unsigned* st; };
__device__ __forceinline__ XcdBarrier xcd_barrier_post(unsigned* bar, volatile LAS unsigned* st) {
    XcdBarrier b; b.bar = bar; b.x = xb_xcc_id(); b.st = st;
    if (threadIdx.x == 0) (void)xb_add(&bar[XB_XCNT(b.x)], 1u);
    return b;
}
__device__ __forceinline__ void xcd_barrier_complete(unsigned* bar, unsigned x, unsigned& nloc, unsigned& nx) {
    const unsigned G = gridDim.x * gridDim.y * gridDim.z;
    unsigned sum, cnt, mine, sp = 0u;
    for (;;) {
        sum = 0u; cnt = 0u; mine = 0u;
#pragma unroll
        for (unsigned j = 0; j < 16; ++j) { const unsigned c = xb_ld(&bar[XB_XCNT(j)]); sum += c; cnt += (c > 0u) ? 1u : 0u; mine = (j == x) ? c : mine; }
        if (sum == G) break;
        __builtin_amdgcn_s_sleep(1);
        if ((++sp & 255u) == 0u) { if (xb_ld(&bar[XB_TMO])) break; if (sp > XB_SPIN_CAP) { atomicAdd(&bar[XB_TMO], 1u); break; } }
    }
    nloc = mine > 0u ? mine : 1u; nx = cnt > 0u ? cnt : 1u;
}
__device__ __forceinline__ void xcd_barrier(const XcdBarrier& b) {
    asm volatile("s_waitcnt vmcnt(0)" ::: "memory");
    __syncthreads();
    if (threadIdx.x == 0) {
        unsigned* bar = b.bar;
        __builtin_amdgcn_s_waitcnt(0);
        unsigned nloc = b.st[0], nx = b.st[1];
        if (nloc == 0u) { xcd_barrier_complete(bar, b.x, nloc, nx); b.st[0] = nloc; b.st[1] = nx; }
#if BAR_EARLY_WB
        asm volatile("buffer_wbl2 sc1" ::: "memory");
#endif
        const unsigned old = xb_add(&bar[XB_XSUB(b.x)], 1u);
        const unsigned gen = old / nloc;
        if (old + 1u == (gen + 1u) * nloc) {
            __builtin_amdgcn_fence(__ATOMIC_RELEASE, "agent");
            asm volatile("s_waitcnt vmcnt(0)" ::: "memory");
            const unsigned og = xb_add(&bar[XB_TOP], 1u);
            const unsigned tg = og / nx;
            if (og + 1u == (tg + 1u) * nx) xb_add(&bar[XB_TOPGEN], 1u);
            else XB_SPIN(xb_ld(&bar[XB_TOPGEN]) == tg, bar);
            __builtin_amdgcn_fence(__ATOMIC_ACQUIRE, "agent");
            xb_add(&bar[XB_XGEN(b.x)], 1u);
            asm volatile("s_waitcnt vmcnt(0)" ::: "memory");
        } else {
            XB_SPIN(xb_ld(&bar[XB_XGEN(b.x)]) == gen, bar);
            __builtin_amdgcn_fence(__ATOMIC_ACQUIRE, "agent");
            asm volatile("s_waitcnt vmcnt(0)" ::: "memory");
        }
    }
    __syncthreads();
}

__device__ __forceinline__ void xcd_barrier_arrive(const XcdBarrier& b) {
    asm volatile("s_waitcnt vmcnt(0)" ::: "memory");
    __syncthreads();
    if (threadIdx.x == 0) {
        unsigned* bar = b.bar;
        __builtin_amdgcn_s_waitcnt(0);
        unsigned nloc = b.st[0], nx = b.st[1];
        if (nloc == 0u) { xcd_barrier_complete(bar, b.x, nloc, nx); b.st[0] = nloc; b.st[1] = nx; }
        const unsigned old = xb_add(&bar[XB_XSUB(b.x)], 1u);
        const unsigned gen = old / nloc;
        if (old + 1u == (gen + 1u) * nloc) {
            __builtin_amdgcn_fence(__ATOMIC_RELEASE, "agent");
            asm volatile("s_waitcnt vmcnt(0)" ::: "memory");
            const unsigned og = xb_add(&bar[XB_TOP], 1u);
            const unsigned tg = og / nx;
            if (og + 1u == (tg + 1u) * nx) xb_add(&bar[XB_TOPGEN], 1u);
            else XB_SPIN(xb_ld(&bar[XB_TOPGEN]) == tg, bar);
            __builtin_amdgcn_fence(__ATOMIC_ACQUIRE, "agent");
            xb_add(&bar[XB_XGEN(b.x)], 1u);
            asm volatile("s_waitcnt vmcnt(0)" ::: "memory");
            b.st[2] = 0u;
        } else b.st[2] = gen + 1u;
    }
}
__device__ __forceinline__ void xcd_barrier_wait(const XcdBarrier& b) {
    if (threadIdx.x == 0) {
        const unsigned p = b.st[2];
        if (p) { unsigned* bar = b.bar; XB_SPIN(xb_ld(&bar[XB_XGEN(b.x)]) == p - 1u, bar);
            __builtin_amdgcn_fence(__ATOMIC_ACQUIRE, "agent"); asm volatile("s_waitcnt vmcnt(0)" ::: "memory"); b.st[2] = 0u; }
    }
    __syncthreads();
}

struct Args { const float* in[18]; float* out; unsigned char* ws; int ph_lo, ph_hi, li, ws_mib; };
typedef const __attribute__((address_space(4))) Args* KArgs;
#define FIN(k) (F.ka->in[k])
struct Frame {
    LAS unsigned char* lds;
    volatile LAS unsigned* MISC;
    gu32* ctl;
    int tid, lane, wave;
    int vcu, G;
    KArgs ka; float* out; unsigned char* ws;
    const XcdBarrier* bar;
};
__device__ const unsigned char T5_BUCKET[128] = {0,1,2,3,4,5,6,7,8,9,10,11,12,13,14,15,16,16,16,17,17,18,18,18,19,19,19,20,20,20,20,21,21,21,21,22,22,22,22,22,23,23,23,23,23,23,24,24,24,24,24,24,25,25,25,25,25,25,25,26,26,26,26,26,26,26,26,27,27,27,27,27,27,27,27,27,27,28,28,28,28,28,28,28,28,28,28,29,29,29,29,29,29,29,29,29,29,29,29,30,30,30,30,30,30,30,30,30,30,30,30,30,30,31,31,31,31,31,31,31,31,31,31,31,31,31,31,31};

__device__ __forceinline__ int lcol32(int nb) { return 256 * (nb >> 3) + 32 * (2 * (nb & 3) + ((nb >> 2) & 1)); }
constexpr int WI_IN = 16 * (NP / 32), WI_AB = 8 * 32, WI_OUT = 16 * 32, WI_GU = 16 * (2 * FF / 32), WI_D = (FF / 64) * 32, WI_ALL = WI_IN + 2 * WI_AB + WI_OUT + WI_GU + WI_D, WI_P0 = SEAM35 ? (SEAM56 ? WI_IN + 2 * WI_AB + WI_OUT : WI_IN + 2 * WI_AB) : WI_IN;
struct WItem { const float* W; int ldw, src_col0, K; bf16* WT; int dst_row0; const float* gain; int kb; };
__device__ __forceinline__ WItem weight_item(Frame& F, int it) {
    unsigned char* ws = F.ws;
    bf16* WinT = (bf16*)(ws + WS_WIN); bf16* WabT = (bf16*)(ws + WS_WAB); bf16* WoutT = (bf16*)(ws + WS_WOUT); bf16* WguT = (bf16*)(ws + WS_WGU); bf16* WdT = (bf16*)(ws + WS_WD);
    int r = it;
    if (r < WI_IN) { const int nb = r % (NP / 32), kb = r / (NP / 32), dr = 32 * nb, lc = lcol32(nb); return WItem{FIN(2), D_IN, lc < 2048 ? lc : lc + 8, D, WinT, dr, FIN(1), kb}; } r -= WI_IN;
    if (r < WI_AB) { const int nb = r % 32, kb = r / 32; return WItem{FIN(11), D, lcol32(nb), DN_W, WabT, 32 * nb, nullptr, kb}; } r -= WI_AB;
    if (r < WI_AB) { const int nb = r % 32, kb = r / 32; return WItem{FIN(12), D, lcol32(nb), SW_W, WabT, 1024 + 32 * nb, nullptr, kb}; } r -= WI_AB;
    if (r < WI_OUT) { const int nb = r % 32, kb = r / 32; return WItem{FIN(13), D, 32 * nb, D, WoutT, 32 * nb, nullptr, kb}; } r -= WI_OUT;
    if (r < WI_GU) { const int nb = r % (2 * FF / 32), kb = r / (2 * FF / 32), dr = 32 * nb, pn = dr >> 8, j = dr & 255;
        return WItem{(j < 128) ? FIN(15) : FIN(16), FF, 128 * pn + (j & 127), D, WguT, dr, FIN(14), kb}; } r -= WI_GU;
    { const int nb = r % 32, kb = r / 32; return WItem{FIN(17), D, 32 * nb, FF, WdT, 32 * nb, nullptr, kb}; }
}
__device__ __forceinline__ void witem_load(const WItem& w, int lane, f32x4 (&v)[8], float (&gn)[8]) {
    const int k0 = 64 * w.kb, c4 = 4 * (lane & 7);
#pragma unroll
    for (int i = 0; i < 8; ++i) { const int kk = 8 * i + (lane >> 3); v[i] = *(const f32x4*)(w.W + (size_t)(k0 + kk) * w.ldw + w.src_col0 + c4); gn[i] = w.gain ? w.gain[k0 + kk] : 1.0f; }
}
__device__ __forceinline__ void witem_store(const WItem& w, int lane, const f32x4 (&v)[8], const float (&gn)[8], LAS float* scr) {
    const int k0 = 64 * w.kb, c4 = 4 * (lane & 7);
#pragma unroll
    for (int i = 0; i < 8; ++i) { const int kk = 8 * i + (lane >> 3);
        scr[kk * 33 + c4] = v[i].x * gn[i]; scr[kk * 33 + c4 + 1] = v[i].y * gn[i]; scr[kk * 33 + c4 + 2] = v[i].z * gn[i]; scr[kk * 33 + c4 + 3] = v[i].w * gn[i]; }
    LDS_WAIT(); asm volatile("" ::: "memory");
    const int c = lane & 7;
#pragma unroll
    for (int j = 0; j < 4; ++j) { const int n = (lane >> 3) + 8 * j; const LAS float* s = scr + (8 * c) * 33 + n;
        v4u o; o.x = pk2(s[0 * 33], s[1 * 33]); o.y = pk2(s[2 * 33], s[3 * 33]); o.z = pk2(s[4 * 33], s[5 * 33]); o.w = pk2(s[6 * 33], s[7 * 33]);
        if (SEAM67) asm volatile("global_store_dwordx4 %0, %1, off sc1\n\ts_nop 2" :: "v"((GAS v4u*)(w.WT + (size_t)(w.dst_row0 + n) * w.K + k0 + 8 * c)), "v"(o) : "memory");
        else *(GAS v4u*)(w.WT + (size_t)(w.dst_row0 + n) * w.K + k0 + 8 * c) = o; }
    LDS_WAIT(); asm volatile("" ::: "memory");
}
__device__ __forceinline__ void weight_copies(Frame& F, int lo, int hi, int gw, int NGW) {
    LAS float* scr = (LAS float*)(F.lds + RING_OFF + F.wave * 16384);
    int it = lo + gw; if (it >= hi) return;
    f32x4 vc[8]; float gc[8];
    WItem cur = weight_item(F, it); witem_load(cur, F.lane, vc, gc);
    for (;;) {
        const int nx = it + NGW; const bool more = nx < hi;
        f32x4 vn[8]; float gnx[8]; WItem nxt = cur;
        if (more) { nxt = weight_item(F, nx); witem_load(nxt, F.lane, vn, gnx); }
        witem_store(cur, F.lane, vc, gc, scr);
        if (!more) break;
#pragma unroll
        for (int i = 0; i < 8; ++i) { vc[i] = vn[i]; gc[i] = gnx[i]; }
        cur = nxt; it = nx;
    }
}
__device__ __forceinline__ void p0_prologue(Frame& F) {
    const int gw = F.vcu * NWAVES + F.wave, NGW = F.G * NWAVES;
    unsigned char* ws = F.ws;
    weight_copies(F, 0, (F.G == 256 && DEFER_WEIGHTS) ? WI_P0 : WI_ALL, gw, NGW);
    __syncthreads();
    LAS float* wba = (LAS float*)(F.lds + RING_OFF);
    for (int idx = F.tid; idx < 8 * D; idx += NWAVES * 64) { const int k = idx >> 3, j = idx & 7; wba[j * D + k] = FIN(2)[(size_t)k * D_IN + 2048 + j] * FIN(1)[k]; }
    __syncthreads();
    const float* x = FIN(0); bf16* XB = (bf16*)(ws + WS_XB); float* rstd1 = (float*)(ws + WS_RSTD); float* gbp = (float*)(ws + WS_GB); float* ssq2 = (float*)(ws + WS_SSQ2);
    const float alog_or_dt = (F.lane & 32) ? FIN(5)[(F.lane >> 3) & 3] : 0.f;
    const float negA = -expf(FIN(4)[(F.lane >> 3) & 3]);
#if P0_DEEP
    auto do_row = [&](const f32x4 (&v)[4], int m) {
        float ss = 0.f;
#pragma unroll
        for (int j = 0; j < 4; ++j) ss += (v[j].x * v[j].x + v[j].y * v[j].y) + (v[j].z * v[j].z + v[j].w * v[j].w);
        GAS unsigned long long* o8 = (GAS unsigned long long*)(XB + (size_t)m * D) + F.lane;
#pragma unroll
        for (int j = 0; j < 4; ++j) { const unsigned long long w = (unsigned long long)pk2(v[j].x, v[j].y) | ((unsigned long long)pk2(v[j].z, v[j].w) << 32);
            asm volatile("global_store_dwordx2 %0, %1, off" :: "v"(o8 + 64 * j), "v"(w) : "memory"); }
        float acc[8];
#pragma unroll
        for (int c = 0; c < 8; ++c) { float a = 0.f;
#pragma unroll
            for (int j = 0; j < 4; ++j) { const f32x4 w = *(const LAS f32x4*)(wba + c * D + 256 * j + 4 * F.lane); a += (v[j].x * w.x + v[j].y * w.y) + (v[j].z * w.z + v[j].w * w.w); }
            acc[c] = a; }
        ss = wave_sum(ss);
        float r4[4], r2[2], r1;
        { const bool up = (F.lane & 32) != 0;
#pragma unroll
          for (int i = 0; i < 4; ++i) { const float keep = up ? acc[4 + i] : acc[i], send = up ? acc[i] : acc[4 + i]; r4[i] = keep + __shfl_xor(send, 32); } }
        { const bool up = (F.lane & 16) != 0;
#pragma unroll
          for (int i = 0; i < 2; ++i) { const float keep = up ? r4[2 + i] : r4[i], send = up ? r4[i] : r4[2 + i]; r2[i] = keep + __shfl_xor(send, 16); } }
        { const bool up = (F.lane & 8) != 0; const float keep = up ? r2[1] : r2[0], send = up ? r2[0] : r2[1]; r1 = keep + __shfl_xor(send, 8); }
        r1 = sum8(r1);
        const float rstd = frsq(ss * (1.0f / D) + EPS);
        if (F.lane == 0) { asm volatile("global_store_dword %0, %1, off" :: "v"((GAS float*)(rstd1 + m)), "v"(rstd) : "memory"); asm volatile("global_store_dword %0, %1, off" :: "v"((GAS float*)(ssq2 + m)), "v"(0.f) : "memory"); }
        if ((F.lane & 7) == 0) {
            const float val = r1 * rstd; float res;
            if (F.lane < 32) res = 1.0f / (1.0f + expf(-val));
            else { const float xx = val + alog_or_dt; const float sp = xx > 20.f ? xx : log1pf(expf(xx)); res = negA * sp; }
            asm volatile("global_store_dword %0, %1, off" :: "v"((GAS float*)(gbp + (size_t)m * 8 + (F.lane >> 3))), "v"(res) : "memory");
        }
    };
    f32x4 qa[4], qb[4];
#pragma unroll
    for (int j = 0; j < 4; ++j) { qa[j] = (f32x4){0.f, 0.f, 0.f, 0.f}; qb[j] = qa[j]; }
    if (gw < M) {
#pragma unroll
        for (int j = 0; j < 4; ++j) qa[j] = ((const GAS f32x4*)(x + (size_t)gw * D) + F.lane)[64 * j]; }
    if (gw + NGW < M) {
#pragma unroll
        for (int j = 0; j < 4; ++j) qb[j] = ((const GAS f32x4*)(x + (size_t)(gw + NGW) * D) + F.lane)[64 * j]; }
    for (int m = gw; m < M; m += 2 * NGW) {
        f32x4 v[4];
#pragma unroll
        for (int j = 0; j < 4; ++j) v[j] = qa[j];
        if (m + 2 * NGW < M) {
#pragma unroll
            for (int j = 0; j < 4; ++j) qa[j] = ((const GAS f32x4*)(x + (size_t)(m + 2 * NGW) * D) + F.lane)[64 * j]; }
        do_row(v, m);
        if (m + NGW < M) {
#pragma unroll
            for (int j = 0; j < 4; ++j) v[j] = qb[j];
            if (m + 3 * NGW < M) {
#pragma unroll
                for (int j = 0; j < 4; ++j) qb[j] = ((const GAS f32x4*)(x + (size_t)(m + 3 * NGW) * D) + F.lane)[64 * j]; }
            do_row(v, m + NGW);
        }
    }
}
#else
    f32x4 vnx[4];
    if (gw < M) {
#pragma unroll
        for (int j = 0; j < 4; ++j) vnx[j] = ((const GAS f32x4*)(x + (size_t)gw * D) + F.lane)[64 * j]; }
    for (int m = gw; m < M; m += NGW) {
        f32x4 v[4]; float ss = 0.f;
#pragma unroll
        for (int j = 0; j < 4; ++j) { v[j] = vnx[j]; ss += (v[j].x * v[j].x + v[j].y * v[j].y) + (v[j].z * v[j].z + v[j].w * v[j].w); }
        if (m + NGW < M) {
#pragma unroll
            for (int j = 0; j < 4; ++j) vnx[j] = ((const GAS f32x4*)(x + (size_t)(m + NGW) * D) + F.lane)[64 * j]; }
        GAS unsigned long long* o8 = (GAS unsigned long long*)(XB + (size_t)m * D) + F.lane;
#pragma unroll
        for (int j = 0; j < 4; ++j) o8[64 * j] = (unsigned long long)pk2(v[j].x, v[j].y) | ((unsigned long long)pk2(v[j].z, v[j].w) << 32);
        float acc[8];
#pragma unroll
        for (int c = 0; c < 8; ++c) { float a = 0.f;
#pragma unroll
            for (int j = 0; j < 4; ++j) { const f32x4 w = *(const LAS f32x4*)(wba + c * D + 256 * j + 4 * F.lane); a += (v[j].x * w.x + v[j].y * w.y) + (v[j].z * w.z + v[j].w * w.w); }
            acc[c] = a; }
        ss = wave_sum(ss);
        float r4[4], r2[2], r1;
        { const bool up = (F.lane & 32) != 0;
#pragma unroll
          for (int i = 0; i < 4; ++i) { const float keep = up ? acc[4 + i] : acc[i], send = up ? acc[i] : acc[4 + i]; r4[i] = keep + __shfl_xor(send, 32); } }
        { const bool up = (F.lane & 16) != 0;
#pragma unroll
          for (int i = 0; i < 2; ++i) { const float keep = up ? r4[2 + i] : r4[i], send = up ? r4[i] : r4[2 + i]; r2[i] = keep + __shfl_xor(send, 16); } }
        { const bool up = (F.lane & 8) != 0; const float keep = up ? r2[1] : r2[0], send = up ? r2[0] : r2[1]; r1 = keep + __shfl_xor(send, 8); }
        r1 = sum8(r1);
        const float rstd = frsq(ss * (1.0f / D) + EPS);
        if (F.lane == 0) { rstd1[m] = rstd; ssq2[m] = 0.f; }
        if ((F.lane & 7) == 0) {
            const float val = r1 * rstd; float res;
            if (F.lane < 32) res = 1.0f / (1.0f + expf(-val));
            else { const float xx = val + alog_or_dt; const float sp = xx > 20.f ? xx : log1pf(expf(xx)); res = negA * sp; }
            gbp[(size_t)m * 8 + (F.lane >> 3)] = res;
        }
    }
}
#endif

__device__ __forceinline__ void dn_pre(Frame& F) {
    const int gw = F.vcu * NWAVES + F.wave, NGW = F.G * NWAVES;
    const bf16* proj = (const bf16*)(F.ws + WS_PROJ); const float* conv = FIN(3);
    float* QN = F.out; float* KN = F.out + (size_t)M * DN_W; float* VV = (float*)(F.ws + WS_XB);
    for (int task = gw; task < M * DN_H; task += NGW) {
        const int m = task >> 2, h = task & 3, t = m & (SEQ - 1);
        float val[3][2];
#pragma unroll
        for (int part = 0; part < 3; ++part) { const int col = part * DN_W + h * DN_D + 2 * F.lane; float a0 = 0.f, a1 = 0.f;
#pragma unroll
            for (int j = 0; j < 4; ++j) { if (t - 3 + j >= 0) { const unsigned w = *(const unsigned*)(proj + (size_t)(m - 3 + j) * NP + col); a0 += conv[j * DN_QKV + col] * bflo(w); a1 += conv[j * DN_QKV + col + 1] * bfhi(w); } }
            val[part][0] = a0 * sigm(a0); val[part][1] = a1 * sigm(a1); }
        const float rq = 1.0f / sqrtf(wave_sum(val[0][0] * val[0][0] + val[0][1] * val[0][1]) + EPS) * 0.08838834764831845f;
        const float rk = 1.0f / sqrtf(wave_sum(val[1][0] * val[1][0] + val[1][1] * val[1][1]) + EPS);
        const size_t o = (size_t)m * DN_W + h * DN_D + 2 * F.lane;
        *(f32x2*)(QN + o) = (f32x2){val[0][0] * rq, val[0][1] * rq};
        *(f32x2*)(KN + o) = (f32x2){val[1][0] * rk, val[1][1] * rk};
        *(f32x2*)(VV + o) = (f32x2){val[2][0], val[2][1]};
    }
}
__device__ __forceinline__ void dn_scan_naive(Frame& F, int bh) {
    const int b = bh >> 2, h = bh & 3, tid = F.tid, dvi = tid >> 2, kq = tid & 3;
    LAS float* kL = (LAS float*)(F.lds + RING_OFF); LAS float* qL = kL + 32 * 128; LAS float* vL = qL + 32 * 128; LAS float* gL = vL + 32 * 128; LAS float* bL = gL + 32;
    const float* QN = F.out; const float* KN = F.out + (size_t)M * DN_W; float* VV = (float*)(F.ws + WS_XB); const float* gbp = (const float*)(F.ws + WS_GB);
    float S[32];
#pragma unroll
    for (int j = 0; j < 32; ++j) S[j] = 0.f;
    for (int t0 = 0; t0 < SEQ; t0 += 32) {
#pragma unroll
        for (int r = 0; r < 2; ++r) { const int idx = tid + 512 * r, tok = idx >> 5, c4 = idx & 31; const size_t src = (size_t)(b * SEQ + t0 + tok) * DN_W + h * DN_D + c4 * 4;
            *(LAS f32x4*)(kL + tok * 128 + c4 * 4) = *(const f32x4*)(KN + src); *(LAS f32x4*)(qL + tok * 128 + c4 * 4) = *(const f32x4*)(QN + src); *(LAS f32x4*)(vL + tok * 128 + c4 * 4) = *(const f32x4*)(VV + src); }
        if (tid < 32) { const size_t mm = (size_t)(b * SEQ + t0 + tid); bL[tid] = gbp[mm * 8 + h]; gL[tid] = gbp[mm * 8 + 4 + h]; }
        __syncthreads();
        for (int i = 0; i < 32; ++i) {
            const float eg = __expf(gL[i]), be = bL[i];
            float kk[32];
#pragma unroll
            for (int j = 0; j < 8; ++j) { const f32x4 w = *(const LAS f32x4*)(kL + i * 128 + kq * 32 + 4 * j); kk[4 * j] = w.x; kk[4 * j + 1] = w.y; kk[4 * j + 2] = w.z; kk[4 * j + 3] = w.w; }
            float part = 0.f;
#pragma unroll
            for (int j = 0; j < 32; ++j) part += kk[j] * S[j];
            part += __shfl_xor(part, 1); part += __shfl_xor(part, 2);
            const float c = be * (vL[i * 128 + dvi] - eg * part);
#pragma unroll
            for (int j = 0; j < 32; ++j) S[j] = eg * S[j] + c * kk[j];
            float po = 0.f;
#pragma unroll
            for (int j = 0; j < 8; ++j) { const f32x4 w = *(const LAS f32x4*)(qL + i * 128 + kq * 32 + 4 * j); po += (w.x * S[4 * j] + w.y * S[4 * j + 1]) + (w.z * S[4 * j + 2] + w.w * S[4 * j + 3]); }
            po += __shfl_xor(po, 1); po += __shfl_xor(po, 2);
            if (kq == 0) vL[i * 128 + dvi] = po;
        }
        __syncthreads();
#pragma unroll
        for (int r = 0; r < 2; ++r) { const int idx = tid + 512 * r, tok = idx >> 5, c4 = idx & 31; const size_t src = (size_t)(b * SEQ + t0 + tok) * DN_W + h * DN_D + c4 * 4;
            *(f32x4*)(VV + src) = *(const LAS f32x4*)(vL + tok * 128 + c4 * 4); }
        __syncthreads();
    }
}
__device__ __forceinline__ void swa_naive(Frame& F, int wv, int nworkers) {
    const bf16* proj = (const bf16*)(F.ws + WS_PROJ); bf16* YSWA = (bf16*)(F.ws + WS_Y) + (size_t)M * SW_W;
    LAS float* qs = (LAS float*)(F.lds + RING_OFF + 65536 + F.wave * 1024); LAS float* ps = qs + 64;
    const float* qg = FIN(7); const float* kg = FIN(8); const float* sinks = FIN(9); const float* relb = FIN(10);
    const int lane = F.lane;
    for (int task = wv; task < M * SW_H; task += nworkers) {
        const int m = task >> 3, qh = task & 7, kvh = qh >> 2, t = m & (SEQ - 1);
        const float q = bf1(proj[(size_t)m * NP + PC_SQ + qh * SW_D + lane]);
        const float qn = q * (1.0f / sqrtf(wave_sum(q * q) * (1.0f / SW_D) + EPS)) * qg[lane];
        qs[lane] = qn * kg[lane];
        LDS_WAIT(); asm volatile("" ::: "memory");
        float lg[2];
#pragma unroll
        for (int hf = 0; hf < 2; ++hf) { const int j = lane + 64 * hf; lg[hf] = -INFINITY;
            if (t - 127 + j >= 0) { const v4u* kr = (const v4u*)(proj + (size_t)(m - 127 + j) * NP + PC_SK + kvh * SW_D); float ssk = 0.f, dot = 0.f;
#pragma unroll
                for (int c = 0; c < 8; ++c) { const v4u w = kr[c];
#pragma unroll
                    for (int e = 0; e < 4; ++e) { const float k0 = bflo(w[e]), k1 = bfhi(w[e]); ssk += k0 * k0 + k1 * k1; dot += qs[8 * c + 2 * e] * k0 + qs[8 * c + 2 * e + 1] * k1; } }
                lg[hf] = dot * (1.0f / sqrtf(ssk * (1.0f / SW_D) + EPS)) * 0.125f + relb[(int)T5_BUCKET[127 - j] * SW_H + qh]; } }
        const float sink = sinks[qh];
        const float mx = fmaxf(wave_max(fmaxf(lg[0], lg[1])), sink);
        const float p0 = (lg[0] == -INFINITY) ? 0.f : __expf(lg[0] - mx), p1 = (lg[1] == -INFINITY) ? 0.f : __expf(lg[1] - mx);
        const float den = wave_sum(p0 + p1) + __expf(sink - mx);
        ps[lane] = p0; ps[lane + 64] = p1;
        LDS_WAIT(); asm volatile("" ::: "memory");
        float o = 0.f; const int jmin = (127 - t) > 0 ? (127 - t) : 0;
        for (int j = jmin; j < 128; ++j) o += ps[j] * bf1(proj[(size_t)(m - 127 + j) * NP + PC_SV + kvh * SW_D + lane]);
        YSWA[(size_t)m * SW_W + qh * SW_D + lane] = (bf16)f2bf(o / den);
        LDS_WAIT(); asm volatile("" ::: "memory");
    }
}
__device__ __forceinline__ void dn_out(Frame& F) {
    const int gw = F.vcu * NWAVES + F.wave, NGW = F.G * NWAVES;
    const bf16* proj = (const bf16*)(F.ws + WS_PROJ); const float* VV = (const float*)(F.ws + WS_XB); bf16* YDN = (bf16*)(F.ws + WS_Y); const float* gain = FIN(6);
    for (int task = gw; task < M * DN_H; task += NGW) {
        const int m = task >> 2, h = task & 3;
        const f32x2 o = *(const f32x2*)(VV + (size_t)m * DN_W + h * DN_D + 2 * F.lane);
        const float r = 1.0f / sqrtf(wave_sum(o.x * o.x + o.y * o.y) * (1.0f / DN_D) + EPS);
        const unsigned zw = *(const unsigned*)(proj + (size_t)m * NP + PC_Z + h * DN_D + 2 * F.lane); const float z0 = bflo(zw), z1 = bfhi(zw);
        *(unsigned*)(YDN + (size_t)m * DN_W + h * DN_D + 2 * F.lane) = pk2(o.x * r * gain[2 * F.lane] * z0 * sigm(z0), o.y * r * gain[2 * F.lane + 1] * z1 * sigm(z1));
    }
}

typedef short bf16x8 __attribute__((ext_vector_type(8)));
typedef float f32x16 __attribute__((ext_vector_type(16)));
typedef unsigned u32x2 __attribute__((ext_vector_type(2)));
typedef __bf16 bf16x2_t __attribute__((ext_vector_type(2)));
__device__ __forceinline__ unsigned cvtpk(float lo, float hi) { f32x2 v = {lo, hi}; return __builtin_bit_cast(unsigned, __builtin_convertvector(v, bf16x2_t)); }
__device__ __forceinline__ bf16x8 pack8(f32x4 a, f32x4 b) { v4u w; w.x = cvtpk(a[0], a[1]); w.y = cvtpk(a[2], a[3]); w.z = cvtpk(b[0], b[1]); w.w = cvtpk(b[2], b[3]); return __builtin_bit_cast(bf16x8, w); }
__device__ __forceinline__ bf16x8 pack8z(f32x4 a) { v4u w; w.x = cvtpk(a[0], a[1]); w.y = cvtpk(a[2], a[3]); w.z = 0u; w.w = 0u; return __builtin_bit_cast(bf16x8, w); }
#define MFMA16(a, b, c) __builtin_amdgcn_mfma_f32_16x16x32_bf16((a), (b), (c), 0, 0, 0)
#define MFMA32(a, b, c) __builtin_amdgcn_mfma_f32_32x32x16_bf16((a), (b), (c), 0, 0, 0)
constexpr float LOG2E = 1.4426950408889634f;

__device__ __forceinline__ void swa_pre(Frame& F) {
    const int gw = F.vcu * NWAVES + F.wave, NGW = F.G * NWAVES, lane = F.lane;
    const bf16* proj = (const bf16*)(F.ws + WS_PROJ);
    bf16* KS = (bf16*)(F.ws + WS_Y); bf16* VT = KS + 2 * 1024 * 1024; bf16* QS = (bf16*)(F.ws + WS_Y) + (size_t)M * SW_W;
    const float* qg = FIN(7); const float* kg = FIN(8);
    v4u wq_n = {0u, 0u, 0u, 0u}; unsigned wk_n = 0u;
    if (!FUSE_QKNORM && gw < M) { wq_n = *(const v4u*)(proj + (size_t)gw * NP + PC_SQ + 8 * lane); wk_n = *(const unsigned*)(proj + (size_t)gw * NP + PC_SK + 2 * lane); }
    const f32x4 g0 = *(const f32x4*)(qg + 8 * (lane & 7)), g1 = *(const f32x4*)(qg + 8 * (lane & 7) + 4);
    const float kg0 = kg[2 * (lane & 31)], kg1 = kg[2 * (lane & 31) + 1];
    if (!FUSE_QKNORM)
    for (int m = gw; m < M; m += NGW) {
        const v4u w = wq_n; const unsigned wk = wk_n;
        if (m + NGW < M) { wq_n = *(const v4u*)(proj + (size_t)(m + NGW) * NP + PC_SQ + 8 * lane); wk_n = *(const unsigned*)(proj + (size_t)(m + NGW) * NP + PC_SK + 2 * lane); }
        {
            float x[8];
#pragma unroll
            for (int j = 0; j < 4; ++j) { x[2 * j] = bflo(w[j]); x[2 * j + 1] = bfhi(w[j]); }
            float ss = 0.f;
#pragma unroll
            for (int j = 0; j < 8; ++j) ss += x[j] * x[j];
            ss = sum8(ss);
            const float r = frsq(ss * (1.0f / SW_D) + EPS) * (0.125f * LOG2E);
            v4u o; o.x = cvtpk(x[0] * r * g0[0], x[1] * r * g0[1]); o.y = cvtpk(x[2] * r * g0[2], x[3] * r * g0[3]); o.z = cvtpk(x[4] * r * g1[0], x[5] * r * g1[1]); o.w = cvtpk(x[6] * r * g1[2], x[7] * r * g1[3]);
            *(v4u*)(QS + (size_t)m * SW_W + 8 * lane) = o;
        }
        {
            const float k0 = bflo(wk), k1 = bfhi(wk);
            float ss = k0 * k0 + k1 * k1;
            ss = sum32(ss, lane);
            const float r = frsq(ss * (1.0f / SW_D) + EPS); const int d = 2 * (lane & 31), b = m >> 12, t = m & (SEQ - 1), kvh = lane >> 5;
            *(unsigned*)(KS + ((size_t)(b * 2 + kvh) * SEQ + t) * SW_D + d) = cvtpk(k0 * r * kg0, k1 * r * kg1);
        }
    }
    for (int task = gw; task < BATCH * SW_KV * (SEQ / 32); task += NGW) {
        const int bk = task >> 7, tile = task & 127, b = bk >> 1, kvh = bk & 1; const size_t m0 = (size_t)b * SEQ + tile * 32;
        unsigned v[32];
#pragma unroll
        for (int i = 0; i < 32; ++i) v[i] = proj[(m0 + i) * NP + PC_SV + kvh * SW_D + lane];
        bf16* dst = VT + ((size_t)(bk * 128 + tile) * 64 + lane) * 32;
#pragma unroll
        for (int q4 = 0; q4 < 4; ++q4) { v4u o;
#pragma unroll
            for (int jj = 0; jj < 4; ++jj) { const int p0 = 8 * q4 + 2 * jj, p1 = p0 + 1;
                const int k0 = 16 * (p0 >> 4) + 8 * ((p0 & 7) >> 2) + 4 * ((p0 >> 3) & 1) + (p0 & 3), k1 = 16 * (p1 >> 4) + 8 * ((p1 & 7) >> 2) + 4 * ((p1 >> 3) & 1) + (p1 & 3);
                o[jj] = v[k0] | (v[k1] << 16); }
            *(v4u*)(dst + 8 * q4) = o; }
    }
}
__device__ __forceinline__ void swa_bias_table(Frame& F) {
    LAS float* biasT = (LAS float*)(F.lds + RING_OFF);
    for (int idx = F.tid; idx < SW_H * 128; idx += NWAVES * 64) { const int h = idx >> 7, dist = idx & 127; biasT[idx] = FIN(10)[(int)T5_BUCKET[dist] * SW_H + h] * LOG2E; }
}
template <bool REMAP = false>
__device__ __forceinline__ void swa_main(Frame& F, int worker, int nworkers, int u_hi = BATCH * SW_H * (SEQ / 32)) {
    const LAS float* biasT = (const LAS float*)(F.lds + RING_OFF);
    const bf16* KS = (const bf16*)(F.ws + WS_Y); const bf16* VT = KS + 2 * 1024 * 1024; const bf16* QS = (const bf16*)(F.ws + WS_Y) + (size_t)M * SW_W;
    bf16* YSW = (bf16*)(F.ws + WS_PROJ) + PC_YSW;
    const int lane = F.lane, l31 = lane & 31, hh = lane >> 5;
    for (int u = worker; u < u_hi; u += nworkers) {
        const int qblk = REMAP ? (((u >> 11) << 6) | (u & 63)) : (u & 127), h = REMAP ? ((u >> 6) & 7) : ((u >> 7) & 7), b = REMAP ? ((u & 2047) >> 9) : (u >> 10), kvh = h >> 2, bk = b * 2 + kvh, q0 = qblk * 32; const size_t m0 = (size_t)b * SEQ + q0;
        bf16x8 qf[4], kf[5][4];
#pragma unroll
        for (int ks = 0; ks < 4; ++ks) qf[ks] = *(const bf16x8*)(QS + (m0 + l31) * SW_W + h * SW_D + 16 * ks + 8 * hh);
#pragma unroll
        for (int i = 0; i < 5; ++i) { const int ts = q0 - 128 + 32 * i, tsc = ts < 0 ? 0 : ts;
#pragma unroll
            for (int ks = 0; ks < 4; ++ks) kf[i][ks] = *(const bf16x8*)(KS + ((size_t)bk * SEQ + tsc + l31) * SW_D + 16 * ks + 8 * hh); }
        __builtin_amdgcn_sched_barrier(0);
        f32x16 s[5];
#pragma unroll
        for (int i = 0; i < 5; ++i) {
            const int ts = q0 - 128 + 32 * i;
            f32x16 acc;
#pragma unroll
            for (int r = 0; r < 16; ++r) acc[r] = 0.f;
#pragma unroll
            for (int ks = 0; ks < 4; ++ks) acc = MFMA32(kf[i][ks], qf[ks], acc);
#pragma unroll
            for (int r = 0; r < 16; ++r) { const int row = (r & 3) + 8 * (r >> 2) + 4 * hh, dist = 128 - 32 * i + l31 - row; const bool ok = ts >= 0 && dist >= 0 && dist <= 127;
                s[i][r] = ok ? acc[r] + biasT[h * 128 + (dist & 127)] : -INFINITY; }
        }
        bf16x8 vf[5][2][2];
#pragma unroll
        for (int i = 0; i < 5; ++i) { const int ts = q0 - 128 + 32 * i, tsc = ts < 0 ? 0 : ts;
#pragma unroll
            for (int s2 = 0; s2 < 2; ++s2)
#pragma unroll
                for (int nt = 0; nt < 2; ++nt) vf[i][s2][nt] = *(const bf16x8*)(VT + ((size_t)(bk * 128 + (tsc >> 5)) * 64 + 32 * nt + l31) * 32 + s2 * 16 + hh * 8); }
        __builtin_amdgcn_sched_barrier(0);
        const float sink2 = FIN(9)[h] * LOG2E;
        float mx = sink2;
#pragma unroll
        for (int i = 0; i < 5; ++i)
#pragma unroll
            for (int r = 0; r < 16; ++r) mx = fmaxf(mx, s[i][r]);
        mx = fmaxf(mx, __shfl_xor(mx, 32));
        float sum = 0.f;
#pragma unroll
        for (int i = 0; i < 5; ++i)
#pragma unroll
            for (int r = 0; r < 16; ++r) { const float p = __builtin_amdgcn_exp2f(s[i][r] - mx); s[i][r] = p; sum += p; }
        sum += __shfl_xor(sum, 32);
        const float inv = __builtin_amdgcn_rcpf(sum + __builtin_amdgcn_exp2f(sink2 - mx));
        f32x16 O[2];
#pragma unroll
        for (int r = 0; r < 16; ++r) { O[0][r] = 0.f; O[1][r] = 0.f; }
#pragma unroll
        for (int i = 0; i < 5; ++i) {
#pragma unroll
            for (int s2 = 0; s2 < 2; ++s2) {
                v4u w; w.x = cvtpk(s[i][8 * s2] * inv, s[i][8 * s2 + 1] * inv); w.y = cvtpk(s[i][8 * s2 + 2] * inv, s[i][8 * s2 + 3] * inv); w.z = cvtpk(s[i][8 * s2 + 4] * inv, s[i][8 * s2 + 5] * inv); w.w = cvtpk(s[i][8 * s2 + 6] * inv, s[i][8 * s2 + 7] * inv);
                const bf16x8 pa = __builtin_bit_cast(bf16x8, w);
#pragma unroll
                for (int nt = 0; nt < 2; ++nt) O[nt] = MFMA32(pa, vf[i][s2][nt], O[nt]);
            }
        }
        {
            LAS unsigned char* stg = F.lds + RING_OFF + 8192 + F.wave * 4608;
#pragma unroll
            for (int nt = 0; nt < 2; ++nt)
#pragma unroll
                for (int r = 0; r < 16; ++r) { const int q = (r & 3) + 8 * (r >> 2) + 4 * hh; *(LAS unsigned short*)(stg + q * 144 + (32 * nt + l31) * 2) = (unsigned short)(cvtpk(O[nt][r], 0.f) & 0xffffu); }
            asm volatile("s_waitcnt lgkmcnt(0)" ::: "memory");
#pragma unroll
            for (int i = 0; i < 4; ++i) { const int row = 8 * i + (lane >> 3), ch16 = lane & 7; const v4u v = *(const LAS v4u*)(stg + row * 144 + ch16 * 16);
                if (SEAM35) { GAS v4u* dst = (GAS v4u*)(YSW + (m0 + row) * NP + h * SW_D + ch16 * 8); asm volatile("global_store_dwordx4 %0, %1, off sc1\n\ts_nop 2" :: "v"(dst), "v"(v) : "memory"); }
                else *(v4u*)(YSW + (m0 + row) * NP + h * SW_D + ch16 * 8) = v; }
            asm volatile("s_waitcnt lgkmcnt(0)" ::: "memory");
        }
    }
#if SEAM35
    asm volatile("s_waitcnt vmcnt(0)" ::: "memory");
    unsigned nun = 0u;
    for (int u = worker; u < u_hi; u += nworkers) { const int qblk = REMAP ? (((u >> 11) << 6) | (u & 63)) : (u & 127), b = REMAP ? ((u & 2047) >> 9) : (u >> 10); ++nun;
        if (lane == 0) __hip_atomic_fetch_add(F.ctl + CW_PAN + 64 * (b * 16 + (qblk >> 3)) + 1, 1u, RLX_AGENT); }
    if (lane == 0 && nun) __hip_atomic_fetch_add(F.ctl + CW_SWADONE + 64 * (worker & 7), nun, RLX_AGENT);
#endif
}

constexpr int DNL_QT = 0, DNL_KT = 17408, DNL_VT = 34816, DNL_WL = 52224, DNL_NA = 69632, DNL_QKM = 78848, DNL_DB = 88064, DNL_TIB = 92160, DNL_GC = 94208, DNL_BETA = 94464;
constexpr int TP = 272;
constexpr int NP2 = 144;
struct DnRec { bf16* UA; bf16* UB; bf16* W; bf16* QG; bf16* KD; bf16* QK; float* EGL;
    __device__ __forceinline__ bf16* u(int ch, int sl, int mt, int lane) const { return (ch < 640 ? UA + (size_t)ch * 8192 : UB + (size_t)(ch - 640) * 8192) + ((sl * 4 + mt) * 64 + lane) * 4; } };
__device__ __forceinline__ DnRec dn_rec(Frame& F) {
    DnRec r; r.W = (bf16*)F.out; r.QG = r.W + 8 * 1024 * 1024; r.KD = r.W + 16 * 1024 * 1024; r.QK = r.W + 24 * 1024 * 1024; r.UA = r.W + 27 * 1024 * 1024; r.UB = (bf16*)(F.ws + WS_UB); r.EGL = (float*)(F.ws + WS_SSQ); return r;
}
#if STAMP_DN >= 0
__device__ unsigned long long g_dn[8];
#define DNSTAMP(i) if (blockIdx.x == STAMP_BLOCK && threadIdx.x == 0) { const unsigned long long now_ = __builtin_amdgcn_s_memrealtime(); dnacc_[i] += now_ - dnlast_; dnlast_ = now_; }
#else
#define DNSTAMP(i)
#endif
__device__ __forceinline__ void dn_chunk_prep(Frame& F) {
#if STAMP_DN >= 0
    unsigned long long dnacc_[8] = {0, 0, 0, 0, 0, 0, 0, 0}; unsigned long long dnlast_ = __builtin_amdgcn_s_memrealtime();
#endif
    const DnRec R = dn_rec(F);
    const bf16* proj = (const bf16*)(F.ws + WS_PROJ); const float* conv = FIN(3); const float* gbp = (const float*)(F.ws + WS_GB);
    LAS unsigned char* L = F.lds + RING_OFF;
    LAS float* GC = (LAS float*)(L + DNL_GC); LAS float* BETA = (LAS float*)(L + DNL_BETA); LAS float* DB = (LAS float*)(L + DNL_DB);
    const int lane = F.lane, wave = F.wave, r16 = lane & 15, g = lane >> 4;
    const int tk0 = 8 * wave;
    unsigned raw[3][11]; float gx, gbl;
#define DN_LOAD_INPUTS(ch_) do { const int bh_ = (ch_) >> 6, c_ = (ch_) & 63, b_ = bh_ >> 2, h_ = bh_ & 3; const size_t m0_ = (size_t)b_ * SEQ + 64 * c_; \
        gx = gbp[(m0_ + lane) * 8 + 4 + h_]; gbl = gbp[(m0_ + lane) * 8 + h_]; \
        _Pragma("unroll") for (int p = 0; p < 3; ++p) { const int col_ = p * DN_W + h_ * DN_D + 2 * lane; \
            _Pragma("unroll") for (int r = 0; r < 11; ++r) { const int tr_ = 64 * c_ + tk0 - 3 + r; raw[p][r] = *(const unsigned*)(proj + (m0_ - 64 * c_ + (tr_ < 0 ? 0 : tr_)) * NP + col_); } } } while (0)
#if DNA_PREFETCH
    if (F.vcu < 1024) DN_LOAD_INPUTS(F.vcu);
#endif
    for (int ch = F.vcu; ch < 1024; ch += F.G) {
        const int bh = ch >> 6, c = ch & 63, b = bh >> 2, h = bh & 3; const size_t m0 = (size_t)b * SEQ + 64 * c;
        {
#if !DNA_PREFETCH
            DN_LOAD_INPUTS(ch);
#endif
            float cw[3][4][2];
#pragma unroll
            for (int p = 0; p < 3; ++p) { const int col = p * DN_W + h * DN_D + 2 * lane;
#pragma unroll
                for (int j = 0; j < 4; ++j) { cw[p][j][0] = conv[j * DN_QKV + col]; cw[p][j][1] = conv[j * DN_QKV + col + 1]; } }
            if (wave == 0) { float x = gx;
#pragma unroll
                for (int off = 1; off < 64; off <<= 1) { const float t = __shfl_up(x, off); if (lane >= off) x += t; }
                GC[lane] = x; BETA[lane] = gbl; }
            if (64 * c + tk0 < 3) {
#pragma unroll
                for (int p = 0; p < 3; ++p)
#pragma unroll
                    for (int r = 0; r < 3; ++r) if (64 * c + tk0 - 3 + r < 0) raw[p][r] = 0u;
            }
#pragma unroll
            for (int hb = 0; hb < 2; ++hb) {
                float val[4][3][2], sq[4], sk[4];
#pragma unroll
                for (int i4 = 0; i4 < 4; ++i4) { const int i = 4 * hb + i4;
#pragma unroll
                    for (int p = 0; p < 3; ++p) { float a0 = 0.f, a1 = 0.f;
#pragma unroll
                        for (int j = 0; j < 4; ++j) { a0 += cw[p][j][0] * bflo(raw[p][i + j]); a1 += cw[p][j][1] * bfhi(raw[p][i + j]); }
                        val[i4][p][0] = a0 * sigm(a0); val[i4][p][1] = a1 * sigm(a1); }
                    sq[i4] = val[i4][0][0] * val[i4][0][0] + val[i4][0][1] * val[i4][0][1]; sk[i4] = val[i4][1][0] * val[i4][1][0] + val[i4][1][1] * val[i4][1][1]; }
#pragma unroll
                for (int i4 = 0; i4 < 4; ++i4) { sq[i4] = wave_sum(sq[i4]); sk[i4] = wave_sum(sk[i4]); }
#pragma unroll
                for (int i4 = 0; i4 < 4; ++i4) {
                    const float rq = frsq(sq[i4] + EPS) * 0.08838834764831845f, rk = frsq(sk[i4] + EPS);
                    const int o = (tk0 + 4 * hb + i4) * TP + 4 * lane;
                    *(LAS unsigned*)(L + DNL_QT + o) = cvtpk(val[i4][0][0] * rq, val[i4][0][1] * rq);
                    *(LAS unsigned*)(L + DNL_KT + o) = cvtpk(val[i4][1][0] * rk, val[i4][1][1] * rk);
                    *(LAS unsigned*)(L + DNL_VT + o) = cvtpk(val[i4][2][0], val[i4][2][1]);
                }
            }
        }
        __syncthreads(); DNSTAMP(0)
#pragma unroll
        for (int k_ = 0; k_ < 3; ++k_) { const int id = wave + 8 * k_; if (id < 20) {
            const int e = id % 10, isqk = (id / 10) & 1, ti = (e >= 6) ? 3 : (e >= 3) ? 2 : (e >= 1) ? 1 : 0, tj = e - ti * (ti + 1) / 2;
            f32x4 acc = {0.f, 0.f, 0.f, 0.f};
            const int xoff = isqk ? DNL_QT : DNL_KT;
#pragma unroll
            for (int ks = 0; ks < 4; ++ks) {
                const bf16x8 a = *(const LAS bf16x8*)(L + DNL_KT + (16 * tj + r16) * TP + (32 * ks + 8 * g) * 2);
                const bf16x8 bq = *(const LAS bf16x8*)(L + xoff + (16 * ti + r16) * TP + (32 * ks + 8 * g) * 2);
                acc = MFMA16(a, bq, acc); }
            const int i = 16 * ti + r16; const float gi = GC[i], bi = BETA[i]; const f32x4 gj = *(const LAS f32x4*)(GC + 16 * tj + 4 * g);
            f32x4 v;
#pragma unroll
            for (int r = 0; r < 4; ++r) { const int jp = 16 * tj + 4 * g + r; const float d = __expf(fminf(gi - gj[r], 0.f));
                v[r] = isqk ? ((i >= jp) ? acc[r] * d : 0.f) : ((i > jp) ? bi * acc[r] * d : 0.f); }
            if (!isqk) {
                u32x2 w; w.x = cvtpk(-v[0], -v[1]); w.y = cvtpk(-v[2], -v[3]);
                *(LAS u32x2*)(L + DNL_NA + i * NP2 + (16 * tj + 4 * g) * 2) = w;
                if (ti == tj) *(LAS f32x4*)(DB + (ti * 16 + r16) * 16 + 4 * g) = v;
            } else { u32x2 w; w.x = cvtpk(v[0], v[1]); w.y = cvtpk(v[2], v[3]); *(LAS u32x2*)(L + DNL_QKM + i * NP2 + (16 * tj + 4 * g) * 2) = w; }
        } }
        __syncthreads(); DNSTAMP(1)
        if (wave < 4) {
            const int I = wave; float x[16];
#pragma unroll
            for (int i = 0; i < 16; ++i) { float a = (i == r16) ? 1.f : 0.f;
#pragma unroll
                for (int j4 = 0; j4 < (i + 3) / 4; ++j4) { const f32x4 d = *(const LAS f32x4*)(DB + (I * 16 + i) * 16 + 4 * j4);
#pragma unroll
                    for (int jj = 0; jj < 4; ++jj) if (4 * j4 + jj < i) a -= d[jj] * x[4 * j4 + jj]; }
                x[i] = a; }
            if (lane < 16) {
#pragma unroll
                for (int i = 0; i < 16; ++i) *(LAS unsigned short*)(L + DNL_TIB + ((I * 16 + i) * 16 + r16) * 2) = (unsigned short)(cvtpk(x[i], 0.f) & 0xffffu);
            }
        } else {
            const int w4 = wave - 4;
            {
                const int mt = w4; const float e = __expf(GC[16 * mt + r16]); const int base = DNL_QT + (16 * mt + r16) * TP;
                u32x2 lo[4], hi[4];
#pragma unroll
                for (int ks = 0; ks < 4; ++ks) { lo[ks] = *(const LAS u32x2*)(L + base + (32 * ks + 4 * g) * 2); hi[ks] = *(const LAS u32x2*)(L + base + (32 * ks + 16 + 4 * g) * 2); }
#pragma unroll
                for (int ks = 0; ks < 4; ++ks) { v4u w; w.x = cvtpk(bflo(lo[ks].x) * e, bfhi(lo[ks].x) * e); w.y = cvtpk(bflo(lo[ks].y) * e, bfhi(lo[ks].y) * e); w.z = cvtpk(bflo(hi[ks].x) * e, bfhi(hi[ks].x) * e); w.w = cvtpk(bflo(hi[ks].y) * e, bfhi(hi[ks].y) * e);
                    *(v4u*)(R.QG + ((size_t)(ch * 16 + mt * 4 + ks) * 64 + lane) * 8) = w; }
            }
            {
                const float gl = GC[63]; float ed[2][8];
#pragma unroll
                for (int kt = 0; kt < 2; ++kt)
#pragma unroll
                    for (int j = 0; j < 8; ++j) { const int tok = 32 * kt + (j < 4 ? 4 * g + j : 16 + 4 * g + j - 4); ed[kt][j] = __expf(gl - GC[tok]); }
#pragma unroll
                for (int i = 0; i < 4; ++i) { const int f = 4 * w4 + i, mt8 = f >> 1, kt = i & 1, dk = 16 * mt8 + r16; float v[8];
#pragma unroll
                    for (int j = 0; j < 8; ++j) { const int tok = 32 * kt + (j < 4 ? 4 * g + j : 16 + 4 * g + j - 4); v[j] = bf1(*(const LAS unsigned short*)(L + DNL_KT + tok * TP + dk * 2)) * ed[kt][j]; }
                    v4u w; w.x = cvtpk(v[0], v[1]); w.y = cvtpk(v[2], v[3]); w.z = cvtpk(v[4], v[5]); w.w = cvtpk(v[6], v[7]);
                    *(v4u*)(R.KD + ((size_t)(ch * 16 + f) * 64 + lane) * 8) = w; }
            }
#pragma unroll
            for (int i = 0; i < 2; ++i) { const int q = w4 + 4 * i;
                if (q < 6) { const int mt = (q == 0) ? 0 : (q == 1) ? 1 : (q < 4) ? 2 : 3, kt = (q == 3 || q == 5) ? 1 : 0;
                    const u32x2 lo = *(const LAS u32x2*)(L + DNL_QKM + (16 * mt + r16) * NP2 + (32 * kt + 4 * g) * 2);
                    u32x2 hi = {0u, 0u}; if (2 * kt + 1 <= mt) hi = *(const LAS u32x2*)(L + DNL_QKM + (16 * mt + r16) * NP2 + (32 * kt + 16 + 4 * g) * 2);
                    const v4u w = {lo.x, lo.y, hi.x, hi.y};
                    *(v4u*)(R.QK + ((size_t)(ch * 6 + q) * 64 + lane) * 8) = w; } }
            if (lane == 0 && w4 == 0) R.EGL[ch] = __expf(GC[63]);
        }
        __syncthreads(); DNSTAMP(2)
#if DNA_PREFETCH
        if (ch + F.G < 1024) DN_LOAD_INPUTS(ch + F.G);
#endif
        {
            const int part = wave >> 2, colbase = 32 * (wave & 3);
            f32x4 rhs[4][2];
#pragma unroll
            for (int I = 0; I < 4; ++I) { float sc[4];
#pragma unroll
                for (int r = 0; r < 4; ++r) { const int tok = 16 * I + 4 * g + r; sc[r] = part == 0 ? BETA[tok] : -(BETA[tok] * __expf(GC[tok])); }
#pragma unroll
                for (int nt = 0; nt < 2; ++nt) { const int col = colbase + 16 * nt + r16;
#pragma unroll
                    for (int r = 0; r < 4; ++r) { const int tok = 16 * I + 4 * g + r; rhs[I][nt][r] = sc[r] * bf1(*(const LAS unsigned short*)(L + (part == 0 ? DNL_VT : DNL_KT) + tok * TP + col * 2)); } } }
            u32x2 na10, na20l, na20h, na30l, na30h, na31l, ti[4];
            na10 = *(const LAS u32x2*)(L + DNL_NA + (16 * 1 + r16) * NP2 + (4 * g) * 2);
            na20l = *(const LAS u32x2*)(L + DNL_NA + (16 * 2 + r16) * NP2 + (4 * g) * 2); na20h = *(const LAS u32x2*)(L + DNL_NA + (16 * 2 + r16) * NP2 + (16 + 4 * g) * 2);
            na30l = *(const LAS u32x2*)(L + DNL_NA + (16 * 3 + r16) * NP2 + (4 * g) * 2); na30h = *(const LAS u32x2*)(L + DNL_NA + (16 * 3 + r16) * NP2 + (16 + 4 * g) * 2);
            na31l = *(const LAS u32x2*)(L + DNL_NA + (16 * 3 + r16) * NP2 + (32 + 4 * g) * 2);
#pragma unroll
            for (int I = 0; I < 4; ++I) ti[I] = *(const LAS u32x2*)(L + DNL_TIB + ((I * 16 + r16) * 16 + 4 * g) * 2);
            const bf16x8 A10 = __builtin_bit_cast(bf16x8, (v4u){na10.x, na10.y, 0u, 0u}), A20 = __builtin_bit_cast(bf16x8, (v4u){na20l.x, na20l.y, na20h.x, na20h.y}),
                         A30 = __builtin_bit_cast(bf16x8, (v4u){na30l.x, na30l.y, na30h.x, na30h.y}), A31 = __builtin_bit_cast(bf16x8, (v4u){na31l.x, na31l.y, 0u, 0u});
            const f32x4 zero = {0.f, 0.f, 0.f, 0.f};
            f32x4 X[2][4];
#pragma unroll
            for (int nt = 0; nt < 2; ++nt) {
                X[nt][0] = MFMA16(__builtin_bit_cast(bf16x8, (v4u){ti[0].x, ti[0].y, 0u, 0u}), pack8z(rhs[0][nt]), zero);
                f32x4 a1 = MFMA16(A10, pack8z(X[nt][0]), rhs[1][nt]);
                X[nt][1] = MFMA16(__builtin_bit_cast(bf16x8, (v4u){ti[1].x, ti[1].y, 0u, 0u}), pack8z(a1), zero);
                f32x4 a2 = MFMA16(A20, pack8(X[nt][0], X[nt][1]), rhs[2][nt]);
                X[nt][2] = MFMA16(__builtin_bit_cast(bf16x8, (v4u){ti[2].x, ti[2].y, 0u, 0u}), pack8z(a2), zero);
                f32x4 a3 = MFMA16(A30, pack8(X[nt][0], X[nt][1]), rhs[3][nt]); a3 = MFMA16(A31, pack8z(X[nt][2]), a3);
                X[nt][3] = MFMA16(__builtin_bit_cast(bf16x8, (v4u){ti[3].x, ti[3].y, 0u, 0u}), pack8z(a3), zero);
            }
#pragma unroll
            for (int nt = 0; nt < 2; ++nt)
#pragma unroll
                for (int I = 0; I < 4; ++I) {
                    if (part == 0) { u32x2 w; w.x = cvtpk(X[nt][I][0], X[nt][I][1]); w.y = cvtpk(X[nt][I][2], X[nt][I][3]); *(u32x2*)R.u(ch, 2 * (wave & 3) + nt, I, lane) = w; }
                    else { const int col = colbase + 16 * nt + r16;
#pragma unroll
                        for (int r = 0; r < 4; ++r) *(LAS unsigned short*)(L + DNL_WL + (16 * I + 4 * g + r) * TP + col * 2) = (unsigned short)(cvtpk(X[nt][I][r], 0.f) & 0xffffu); }
                }
        }
        __syncthreads(); DNSTAMP(3)
        {
            const int mt = wave >> 1, base = DNL_WL + (16 * mt + r16) * TP;
            u32x2 lo[2], hi[2];
#pragma unroll
            for (int i = 0; i < 2; ++i) { const int ks = 2 * (wave & 1) + i; lo[i] = *(const LAS u32x2*)(L + base + (32 * ks + 4 * g) * 2); hi[i] = *(const LAS u32x2*)(L + base + (32 * ks + 16 + 4 * g) * 2); }
#pragma unroll
            for (int i = 0; i < 2; ++i) { const int ks = 2 * (wave & 1) + i; const v4u w = {lo[i].x, lo[i].y, hi[i].x, hi[i].y}; *(v4u*)(R.W + ((size_t)(ch * 16 + mt * 4 + ks) * 64 + lane) * 8) = w; }
        }
        __syncthreads(); DNSTAMP(4)
    }
#if STAMP_DN >= 0
    if (blockIdx.x == STAMP_BLOCK && threadIdx.x == 0) { for (int i = 0; i < 8; ++i) g_dn[i] = dnacc_[i]; }
#endif
}
__device__ __forceinline__ void dn_out2(Frame& F, int worker, int nworkers, int task_lo = 0, int task_hi = 4096) {
    const DnRec R = dn_rec(F);
    const int lane = F.lane, r16 = lane & 15, g = lane >> 4;
    bf16* proj = (bf16*)(F.ws + WS_PROJ); const float* gain = FIN(6);
    int pub_pm = -1;
    for (int task = worker; task < (DNO_SKIPALL ? 0 : task_hi); task += nworkers) {
        if (task < task_lo) continue;
        const int c = task >> 6, bh = (task >> 2) & 15, mt = task & 3, ch = bh * 64 + c, b = bh >> 2, h = bh & 3;
        {   gu32* f0 = F.ctl + CW_SCAN + 64 * (bh * 2);
            for (unsigned sp = 0;; ++sp) {
                const unsigned p0 = (unsigned)__builtin_amdgcn_readfirstlane((int)__hip_atomic_load(f0, RLX_AGENT)), p1 = (unsigned)__builtin_amdgcn_readfirstlane((int)__hip_atomic_load(f0 + 64, RLX_AGENT));
                if ((p0 < p1 ? p0 : p1) > (unsigned)(c + DNO_LAG < 63 ? c + DNO_LAG : 63) || sp > (1u << 16)) break;
                __builtin_amdgcn_s_sleep(DNO_SLEEP);
            }
            if (DNO_FENCE) __builtin_amdgcn_fence(__ATOMIC_ACQUIRE, "agent"); else asm volatile("" ::: "memory"); }
        if (DNO_SKIPWORK) continue;
        if (SEAM35 && pub_pm >= 0) { asm volatile("s_waitcnt vmcnt(0)" ::: "memory"); if (lane == 0) __hip_atomic_fetch_add(F.ctl + CW_PAN + 64 * pub_pm, 1u, RLX_AGENT); }
        pub_pm = (bh >> 2) * 16 + (c >> 2);
        f32x4 o[8]; float ss[4] = {0.f, 0.f, 0.f, 0.f};
#pragma unroll
        for (int sl = 0; sl < 8; ++sl) { u32x2 w;
            if (DNO_FENCE) w = *(const u32x2*)R.u(ch, sl, mt, lane);
            else { const unsigned long long q = __hip_atomic_load((GAS unsigned long long*)R.u(ch, sl, mt, lane), RLX_AGENT); w.x = (unsigned)q; w.y = (unsigned)(q >> 32); }
            o[sl] = (f32x4){bflo(w.x), bfhi(w.x), bflo(w.y), bfhi(w.y)};
#pragma unroll
            for (int r = 0; r < 4; ++r) ss[r] += o[sl][r] * o[sl][r]; }
#pragma unroll
        for (int r = 0; r < 4; ++r) { float s = sum16(ss[r]); ss[r] = frsq(s * (1.0f / DN_D) + EPS); }
        float gdv[8];
#pragma unroll
        for (int sl = 0; sl < 8; ++sl) gdv[sl] = gain[16 * sl + r16];
        unsigned short zz[8][4];
#pragma unroll
        for (int sl = 0; sl < 8; ++sl)
#pragma unroll
            for (int r = 0; r < 4; ++r) zz[sl][r] = proj[((size_t)b * SEQ + 64 * c + 16 * mt + 4 * g + r) * NP + PC_Z + h * DN_D + 16 * sl + r16];
#if DNO_STAGE
        {   LAS unsigned char* stg = F.lds + RING_OFF + F.wave * 16384;
#pragma unroll
            for (int sl = 0; sl < 8; ++sl) { const float gd = gdv[sl];
#pragma unroll
                for (int r = 0; r < 4; ++r) { const float z = bf1(zz[sl][r]);
                    *(LAS unsigned short*)(stg + (4 * g + r) * 272 + (16 * sl + r16) * 2) = (unsigned short)(cvtpk(o[sl][r] * ss[r] * gd * z * sigm(z), 0.f) & 0xffffu); } }
            asm volatile("s_waitcnt lgkmcnt(0)" ::: "memory");
            const size_t m0 = (size_t)b * SEQ + 64 * c + 16 * mt;
#pragma unroll
            for (int i = 0; i < 4; ++i) { const int q = lane + 64 * i, row = q >> 4, cc = q & 15; const v4u v = *(const LAS v4u*)(stg + row * 272 + cc * 16);
                GAS v4u* dst = (GAS v4u*)(proj + (m0 + row) * NP + PC_YDN + h * DN_D + cc * 8);
                asm volatile("global_store_dwordx4 %0, %1, off sc1\n\ts_nop 2" :: "v"(dst), "v"(v) : "memory"); }
            asm volatile("s_waitcnt lgkmcnt(0)" ::: "memory");
        }
#else
#pragma unroll
        for (int sl = 0; sl < 8; ++sl) { const int d = 16 * sl + r16; const float gd = gdv[sl];
#pragma unroll
            for (int r = 0; r < 4; ++r) { const size_t m = (size_t)b * SEQ + 64 * c + 16 * mt + 4 * g + r; const float z = bf1(zz[sl][r]);
                proj[m * NP + PC_YDN + h * DN_D + d] = (bf16)(cvtpk(o[sl][r] * ss[r] * gd * z * sigm(z), 0.f) & 0xffffu); } }
#endif
    }
    if (SEAM35 && pub_pm >= 0) { asm volatile("s_waitcnt vmcnt(0)" ::: "memory"); if (lane == 0) __hip_atomic_fetch_add(F.ctl + CW_PAN + 64 * pub_pm, 1u, RLX_AGENT); }
    if (SEAM78 && lane == 0) { unsigned nt_ = 0u; for (int task = worker; task < task_hi; task += nworkers) if (task >= task_lo) ++nt_;
        if (nt_) __hip_atomic_fetch_add(F.ctl + CW_NORMDONE + 64 * (worker & 7), nt_, RLX_AGENT); }
}
constexpr int SCAN_H0 = 32768, SCAN_H1 = 24576;
__device__ __forceinline__ void dn_scan_wg(Frame& F, int bh, int half) {
    const DnRec R = dn_rec(F);
    const int lane = F.lane, wave = F.wave;
    LAS unsigned char* ring = F.lds + RING_OFF;
    if (wave >= 4) {
        const int lw = wave - 4;
        v4u r0[8], r1[6], r2[8], r3[6];
#if SCAN_SETS == 6
        v4u r4[8], r5[6];
#endif
#define LD_H0(set_, k_) do { const int ch_ = bh * 64 + ((k_) >> 1); _Pragma("unroll") for (int i_ = 0; i_ < 8; ++i_) { const int p_ = lw + 4 * i_; \
            const bf16* src_ = p_ < 16 ? R.W + (size_t)ch_ * 8192 + p_ * 512 : R.QG + (size_t)ch_ * 8192 + (p_ - 16) * 512; set_[i_] = SCAN_NT ? __builtin_nontemporal_load((const v4u*)(src_ + lane * 8)) : *(const v4u*)(src_ + lane * 8); } } while (0)
#define LD_H1(set_, k_) do { const int ch_ = bh * 64 + ((k_) >> 1); _Pragma("unroll") for (int i_ = 0; i_ < 6; ++i_) { const int p_ = lw + 4 * i_, q_ = p_ < 22 ? p_ : p_ - 22; \
            const bf16* src_ = q_ < 6 ? R.QK + (size_t)ch_ * 3072 + q_ * 512 : R.KD + (size_t)ch_ * 8192 + (q_ - 6) * 512; set_[i_] = SCAN_NT ? __builtin_nontemporal_load((const v4u*)(src_ + lane * 8)) : *(const v4u*)(src_ + lane * 8); } } while (0)
#define ST_H0(set_, k_) do { LAS unsigned char* slot_ = ring + (((k_) >> 1) & 1) * (SCAN_H0 + SCAN_H1) + lane * 16; _Pragma("unroll") for (int i_ = 0; i_ < 8; ++i_) *(LAS v4u*)(slot_ + (lw + 4 * i_) * 1024) = set_[i_]; } while (0)
#define ST_H1(set_, k_) do { LAS unsigned char* slot_ = ring + (((k_) >> 1) & 1) * (SCAN_H0 + SCAN_H1) + SCAN_H0 + lane * 16; _Pragma("unroll") for (int i_ = 0; i_ < 6; ++i_) *(LAS v4u*)(slot_ + (lw + 4 * i_) * 1024) = set_[i_]; } while (0)
#define LD_BAR() do { asm volatile("s_waitcnt lgkmcnt(0)" ::: "memory"); __builtin_amdgcn_s_barrier(); asm volatile("" ::: "memory"); } while (0)
#if SCAN_SETS == 6
        LD_H0(r0, 0); LD_H1(r1, 1); LD_H0(r2, 2); LD_H1(r3, 3); LD_H0(r4, 4); LD_H1(r5, 5);
        ST_H0(r0, 0); LD_H0(r0, 6); ST_H1(r1, 1); LD_H1(r1, 7); ST_H0(r2, 2); LD_H0(r2, 8);
        for (int k = 0; k < 128; k += 6) {
            if (k + 0 < 128) { LD_BAR(); if (k + 3 < 128) { ST_H1(r3, k + 3); if (k + 9 < 128) LD_H1(r3, k + 9); } }
            if (k + 1 < 128) { LD_BAR(); if (k + 4 < 128) { ST_H0(r4, k + 4); if (k + 10 < 128) LD_H0(r4, k + 10); } }
            if (k + 2 < 128) { LD_BAR(); if (k + 5 < 128) { ST_H1(r5, k + 5); if (k + 11 < 128) LD_H1(r5, k + 11); } }
            if (k + 3 < 128) { LD_BAR(); if (k + 6 < 128) { ST_H0(r0, k + 6); if (k + 12 < 128) LD_H0(r0, k + 12); } }
            if (k + 4 < 128) { LD_BAR(); if (k + 7 < 128) { ST_H1(r1, k + 7); if (k + 13 < 128) LD_H1(r1, k + 13); } }
            if (k + 5 < 128) { LD_BAR(); if (k + 8 < 128) { ST_H0(r2, k + 8); if (k + 14 < 128) LD_H0(r2, k + 14); } }
        }
#else
        LD_H0(r0, 0); LD_H1(r1, 1); LD_H0(r2, 2); LD_H1(r3, 3);
        ST_H0(r0, 0); LD_H0(r0, 4); ST_H1(r1, 1); LD_H1(r1, 5); ST_H0(r2, 2); LD_H0(r2, 6);
#define PUB(k_) do { if (SCAN_PUBLISH && SCAN_PUB_LOADER && lw == 0 && lane == 0 && (k_) >= 4 && (((k_) >> 1) % SCAN_PUB_EVERY) == 0) asm volatile("global_store_dword %0, %1, off sc1" :: "v"(F.ctl + CW_SCAN + 64 * (bh * 2 + half)), "v"((unsigned)(((k_) >> 1) - 1)) : "memory"); } while (0)
        for (int k = 0; k < 128; k += 4) {
            LD_BAR(); PUB(k); ST_H1(r3, k + 3); if (k + 7 < 128) LD_H1(r3, k + 7);
            LD_BAR(); if (k + 4 < 128) { ST_H0(r0, k + 4); if (k + 8 < 128) LD_H0(r0, k + 8); }
            LD_BAR(); PUB(k + 2); if (k + 5 < 128) { ST_H1(r1, k + 5); if (k + 9 < 128) LD_H1(r1, k + 9); }
            LD_BAR(); if (k + 6 < 128) { ST_H0(r2, k + 6); if (k + 10 < 128) LD_H0(r2, k + 10); }
        }
#endif
#undef LD_H0
#undef LD_H1
#undef ST_H0
#undef ST_H1
#undef LD_BAR
#undef PUB
    } else {
        const int sl = half * 4 + wave;
        f32x4 S[8];
#pragma unroll
        for (int i = 0; i < 8; ++i) S[i] = (f32x4){0.f, 0.f, 0.f, 0.f};
        constexpr int UPRE = SCAN_UPRE;
        u32x2 Uq[UPRE][4]; float eq[UPRE];
#pragma unroll
        for (int d = 0; d < UPRE; ++d) { eq[d] = R.EGL[bh * 64 + d];
#pragma unroll
            for (int mt = 0; mt < 4; ++mt) Uq[d][mt] = *(const u32x2*)R.u(bh * 64 + d, sl, mt, lane); }
        for (int c4 = 0; c4 < 64; c4 += UPRE) {
#pragma unroll
        for (int j4 = 0; j4 < UPRE; ++j4) {
            const int c = c4 + j4, ch = bh * 64 + c;
            const LAS unsigned char* h0 = ring + (c & 1) * (SCAN_H0 + SCAN_H1) + lane * 16; const LAS unsigned char* h1 = h0 + SCAN_H0;
            asm volatile("s_waitcnt lgkmcnt(0)" ::: "memory");
            __builtin_amdgcn_s_barrier();
            asm volatile("" ::: "memory");
#if SCAN_PUBLISH && !SCAN_PUB_LOADER
            if (wave == 0 && c >= 2 && lane == 0) __hip_atomic_store(F.ctl + CW_SCAN + 64 * (bh * 2 + half), (unsigned)(c - 1), RLX_AGENT);
#endif
            bf16x8 fa[16];
#pragma unroll
            for (int f = 0; f < 16; ++f) fa[f] = *(const LAS bf16x8*)(h0 + f * 1024);
#if SCAN_QG_EARLY
            bf16x8 fb[8];
#pragma unroll
            for (int f = 0; f < 8; ++f) fb[f] = *(const LAS bf16x8*)(h0 + 16384 + f * 1024);
#endif
            bf16x8 Sb[4];
#pragma unroll
            for (int ks = 0; ks < 4; ++ks) Sb[ks] = pack8(S[2 * ks], S[2 * ks + 1]);
            const float egl = eq[j4];
            u32x2 Uf[4];
#pragma unroll
            for (int mt = 0; mt < 4; ++mt) Uf[mt] = Uq[j4][mt];
            __builtin_amdgcn_sched_barrier(0);
            f32x4 vn[4], o[4];
#pragma unroll
            for (int mt = 0; mt < 4; ++mt) { vn[mt] = (f32x4){bflo(Uf[mt].x), bfhi(Uf[mt].x), bflo(Uf[mt].y), bfhi(Uf[mt].y)};
#pragma unroll
                for (int ks = 0; ks < 4; ++ks) vn[mt] = MFMA16(fa[mt * 4 + ks], Sb[ks], vn[mt]); }
            __builtin_amdgcn_sched_barrier(0);
#if SCAN_QG_EARLY
#pragma unroll
            for (int f = 8; f < 16; ++f) fa[f] = *(const LAS bf16x8*)(h0 + 16384 + f * 1024);
            __builtin_amdgcn_sched_barrier(0);
#pragma unroll
            for (int mt = 0; mt < 2; ++mt) { o[mt] = (f32x4){0.f, 0.f, 0.f, 0.f};
#pragma unroll
                for (int ks = 0; ks < 4; ++ks) o[mt] = MFMA16(fb[mt * 4 + ks], Sb[ks], o[mt]); }
#pragma unroll
            for (int mt = 2; mt < 4; ++mt) { o[mt] = (f32x4){0.f, 0.f, 0.f, 0.f};
#pragma unroll
                for (int ks = 0; ks < 4; ++ks) o[mt] = MFMA16(fa[mt * 4 + ks], Sb[ks], o[mt]); }
#else
#pragma unroll
            for (int f = 0; f < 16; ++f) fa[f] = *(const LAS bf16x8*)(h0 + 16384 + f * 1024);
            __builtin_amdgcn_sched_barrier(0);
#pragma unroll
            for (int mt = 0; mt < 4; ++mt) { o[mt] = (f32x4){0.f, 0.f, 0.f, 0.f};
#pragma unroll
                for (int ks = 0; ks < 4; ++ks) o[mt] = MFMA16(fa[mt * 4 + ks], Sb[ks], o[mt]); }
#endif
            const bf16x8 vb0 = pack8(vn[0], vn[1]), vb1 = pack8(vn[2], vn[3]);
#if !SCAN_PUBLISH || !SCAN_REFILL_LATE
            { const int cn = (c + UPRE < 64) ? c + UPRE : 63;
#pragma unroll
                for (int mt = 0; mt < 4; ++mt) Uq[j4][mt] = *(const u32x2*)R.u(bh * 64 + cn, sl, mt, lane);
                eq[j4] = R.EGL[bh * 64 + cn]; }
#endif
            asm volatile("s_waitcnt lgkmcnt(0)" ::: "memory");
            __builtin_amdgcn_s_barrier();
            asm volatile("" ::: "memory");
            bf16x8 fq_[6];
#pragma unroll
            for (int f = 0; f < 6; ++f) fq_[f] = *(const LAS bf16x8*)(h1 + f * 1024);
#pragma unroll
            for (int f = 0; f < 16; ++f) fa[f] = *(const LAS bf16x8*)(h1 + 6144 + f * 1024);
            __builtin_amdgcn_sched_barrier(0);
            o[0] = MFMA16(fq_[0], vb0, o[0]); o[1] = MFMA16(fq_[1], vb0, o[1]);
            o[2] = MFMA16(fq_[2], vb0, o[2]); o[2] = MFMA16(fq_[3], vb1, o[2]);
            o[3] = MFMA16(fq_[4], vb0, o[3]); o[3] = MFMA16(fq_[5], vb1, o[3]);
#pragma unroll
            for (int i = 0; i < 8; ++i) { S[i] = S[i] * egl; S[i] = MFMA16(fa[2 * i], vb0, S[i]); S[i] = MFMA16(fa[2 * i + 1], vb1, S[i]); }
#if SCAN_PUBLISH
#if !SCAN_DRAIN_NONE
            VM_WAIT();
#endif
#if SCAN_O16
#pragma unroll
            for (int p2 = 0; p2 < 2; ++p2) {
                const unsigned a0 = cvtpk(o[2 * p2][0], o[2 * p2][1]), a1 = cvtpk(o[2 * p2][2], o[2 * p2][3]), b0 = cvtpk(o[2 * p2 + 1][0], o[2 * p2 + 1][1]), b1 = cvtpk(o[2 * p2 + 1][2], o[2 * p2 + 1][3]);
                const bool odd = (lane & 1) != 0;
                const unsigned r0 = (unsigned)__builtin_amdgcn_update_dpp(0, (int)(odd ? a0 : b0), 0xB1, 0xf, 0xf, true), r1 = (unsigned)__builtin_amdgcn_update_dpp(0, (int)(odd ? a1 : b1), 0xB1, 0xf, 0xf, true);
                v4u w; w.x = odd ? r0 : a0; w.y = odd ? r1 : a1; w.z = odd ? b0 : r0; w.w = odd ? b1 : r1;
                GAS v4u* dst = (GAS v4u*)R.u(ch, sl, 2 * p2 + (odd ? 1 : 0), lane & ~1);
                asm volatile("global_store_dwordx4 %0, %1, off sc1\n\ts_nop 2" :: "v"(dst), "v"(w) : "memory"); }
#else
#pragma unroll
            for (int mt = 0; mt < 4; ++mt) { const unsigned long long w = (unsigned long long)cvtpk(o[mt][0], o[mt][1]) | ((unsigned long long)cvtpk(o[mt][2], o[mt][3]) << 32);
                if (SCAN_O_SC1) __hip_atomic_store((GAS unsigned long long*)R.u(ch, sl, mt, lane), w, RLX_AGENT); else *(unsigned long long*)R.u(ch, sl, mt, lane) = w; }
#endif
            if (SCAN_REFILL_LATE) { const int cn = (c + UPRE < 64) ? c + UPRE : 63;
#pragma unroll
                for (int mt = 0; mt < 4; ++mt) Uq[j4][mt] = *(const u32x2*)R.u(bh * 64 + cn, sl, mt, lane);
                eq[j4] = R.EGL[bh * 64 + cn]; }
#else
#pragma unroll
            for (int mt = 0; mt < 4; ++mt) { u32x2 w; w.x = cvtpk(o[mt][0], o[mt][1]); w.y = cvtpk(o[mt][2], o[mt][3]); *(u32x2*)R.u(ch, sl, mt, lane) = w; }
#endif
        }
        }
    }
#if SCAN_PUBLISH
    VM_WAIT(); __syncthreads();
    if (F.tid == 0) __hip_atomic_store(F.ctl + CW_SCAN + 64 * (bh * 2 + half), 64u, RLX_AGENT);
#endif
}
__device__ unsigned long long g_ts[16];
__device__ __forceinline__ void run_phase0(Frame& F0) {
    Frame F = F0; asm volatile("" : "+v"(F.tid)); F.lane = F.tid & 63;
    unsigned char* ws = F.ws; bf16* XB = (bf16*)(ws + WS_XB); bf16* Y = (bf16*)(ws + WS_Y); bf16* PROJ = (bf16*)(ws + WS_PROJ); (void)XB; (void)Y; (void)PROJ;
        p0_prologue(F);
}
__device__ __forceinline__ void run_phase1(Frame& F0) {
    Frame F = F0; asm volatile("" : "+v"(F.tid)); F.lane = F.tid & 63;
    unsigned char* ws = F.ws; bf16* XB = (bf16*)(ws + WS_XB); bf16* Y = (bf16*)(ws + WS_Y); bf16* PROJ = (bf16*)(ws + WS_PROJ); (void)XB; (void)Y; (void)PROJ;
        const int N1 = (F.G == 256) ? P1_TILES * 256 : NP;
        pg8::Gemm g{XB, (const bf16*)(ws + WS_WIN), M, N1, D}; pg8::StaticOrder S; S.init(M, N1, F.G, (int)blockIdx.x);
        pg8::EpiProj E{PROJ, NP, (const float*)(ws + WS_RSTD), PC_G / 256, 0, FUSE_QKNORM ? Y + (size_t)M * SW_W : nullptr, Y, FIN(7), FIN(8), PC_SQ / 256, PC_SK / 256, 0.125f * 1.4426950408889634f, SEQ};
        pg8::gemm_phase<pg8::EpiProj, pg8::StaticOrder, ALIGN_P1, true>(F.lds + RING_OFF, g, S, E);
}
__device__ __forceinline__ void run_phase2(Frame& F0) {
    Frame F = F0; asm volatile("" : "+v"(F.tid)); F.lane = F.tid & 63;
    unsigned char* ws = F.ws; bf16* XB = (bf16*)(ws + WS_XB); bf16* Y = (bf16*)(ws + WS_Y); bf16* PROJ = (bf16*)(ws + WS_PROJ); (void)XB; (void)Y; (void)PROJ;
#if FAST_DN
        SUBSTAMP(0) for (int rep_ = 0; rep_ < REP_DNA; ++rep_) dn_chunk_prep(F); SUBSTAMP(1)
#else
        dn_pre(F);
#endif
#if FAST_SWA
        for (int rep_ = 0; rep_ < REP_SWAPRE; ++rep_) swa_pre(F); SUBSTAMP(2)
#endif
}
__device__ __forceinline__ void run_phase3(Frame& F0) {
    Frame F = F0; asm volatile("" : "+v"(F.tid)); F.lane = F.tid & 63;
    unsigned char* ws = F.ws; bf16* XB = (bf16*)(ws + WS_XB); bf16* Y = (bf16*)(ws + WS_Y); bf16* PROJ = (bf16*)(ws + WS_PROJ); (void)XB; (void)Y; (void)PROJ;
#if FAST_DN
        if (F.G == 256) {
            const int bx = (int)blockIdx.x;
            SUBSTAMP(3)
            if (((bx >> 3) & 7) == 0) {
                if (SPLIT23) xcd_barrier_wait(*F.bar);
                const int xcd = bx & 7, j = bx >> 6;
                if (!P3_SKIP_SCAN) dn_scan_wg(F, xcd * 2 + (j >> 1), j & 1);
                SUBSTAMP(4)
            } else if (!P3_SKIP_GEMM) {
                const int gi = (bx >> 6) * 56 + (bx & 63) - 8, NG = NP - P1_TILES * 256;
#if P3_ORDER == 1
                if (DEFER_WEIGHTS) { weight_copies(F, WI_P0, WI_ALL, gi * NWAVES + F.wave, 224 * NWAVES); __syncthreads(); }
                swa_bias_table(F); __syncthreads();
                swa_main(F, gi * NWAVES + F.wave, 224 * NWAVES);
                __syncthreads();
#endif
                pg8::Gemm g{XB, (const bf16*)(ws + WS_WIN) + (size_t)P1_TILES * 256 * D, M, NG, D};
                pg8::EpiProj E{PROJ, NP, (const float*)(ws + WS_RSTD), PC_G / 256, P1_TILES, nullptr, nullptr, nullptr, nullptr, 0, 0, 0.f, SEQ, SEAM35};
#if ASYM_GATE
                pg8::GateSkewOrder S; S.so.init(M, NG, 224, gi); S.par = bx & 1; S.x = bx & 7; S.s = gi >> 3; S.call = 0;
                pg8::gemm_phase<pg8::EpiProj, pg8::GateSkewOrder, true, true>(F.lds + RING_OFF, g, S, E);
#else
                pg8::StaticOrder S; S.init(M, NG, 224, gi);
                pg8::gemm_phase<pg8::EpiProj, pg8::StaticOrder, true, true>(F.lds + RING_OFF, g, S, E);
#endif
                if (SEAM35 && F.tid == 0) {
                    pg8::Unit u_; for (int i_ = 0; S.next(i_, u_); ++i_) __hip_atomic_fetch_add(F.ctl + CW_PAN + 64 * u_.pm + 2, 1u, RLX_AGENT); }
                SUBSTAMP(4)
                if (SPLIT23) xcd_barrier_wait(*F.bar);
#if P3_ORDER == 0
                if (!P3_ONLY_SCAN) { swa_bias_table(F); __syncthreads();
#if ASYM_WCOPY && ASYM_SWA
                { const int hs_ = ((bx >> 6) * 28 + (((bx & 63) - 8) >> 1)) * NWAVES + F.wave;
#if ASYM_GATE
                  if (bx & 1) swa_main<true>(F, 2 * 112 * NWAVES + hs_, 112 * NWAVES); else swa_main<true>(F, hs_, 112 * NWAVES, 2 * 112 * NWAVES);
                  if (bx & 1) {
                      __syncthreads();
                      S.call = 1;
                      pg8::gemm_phase<pg8::EpiProj, pg8::GateSkewOrder, true, true>(F.lds + RING_OFF, g, S, E);
                      if (SEAM35 && F.tid == 0) { pg8::Unit u_; for (int i_ = 0; S.next(i_, u_); ++i_) __hip_atomic_fetch_add(F.ctl + CW_PAN + 64 * u_.pm + 2, 1u, RLX_AGENT); } } }
#else
#if ASYM_SWA == 5
                  if (bx & 1) swa_main<true>(F, 2 * 112 * NWAVES + (hs_ * 18) / 7, 1, 2 * 112 * NWAVES + ((hs_ + 1) * 18) / 7); else swa_main<true>(F, 2 * hs_, 1, 2 * hs_ + 2); }
#elif ASYM_SWA == 4
                  if (bx & 1) swa_main<true>(F, 2 * 112 * NWAVES + hs_, 112 * NWAVES); else swa_main<true>(F, hs_, 112 * NWAVES, 2 * 112 * NWAVES); }
#elif ASYM_SWA == 3
                  if (bx & 1) swa_main<true>(F, 112 * NWAVES + hs_, 112 * NWAVES); else swa_main<true>(F, hs_, 112 * NWAVES, 112 * NWAVES); }
#elif ASYM_SWA == 2
                  if (bx & 1) swa_main<true>(F, hs_, 112 * NWAVES); }
#else
                  if (bx & 1) swa_main(F, 2 * 112 * NWAVES + hs_, 112 * NWAVES); else swa_main(F, hs_, 112 * NWAVES, 2 * 112 * NWAVES); }
#endif
#endif
#else
                swa_main(F, gi * NWAVES + F.wave, 224 * NWAVES);
#endif
                SUBSTAMP(5)
#if ASYM_WCOPY
                __syncthreads();
                const int hi_ = (bx >> 6) * 28 + (((bx & 63) - 8) >> 1);
#if WCOPY_EVEN
                if (DEFER_WEIGHTS && !(bx & 1)) weight_copies(F, WI_P0, WI_ALL, hi_ * NWAVES + F.wave, 112 * NWAVES);
                if (!(bx & 1)) dn_out2(F, hi_ * NWAVES + F.wave, 112 * NWAVES, 0, 2048); }
#else
#if ASYM_DNO
                if (!(bx & 1)) dn_out2(F, hi_ * NWAVES + F.wave, 112 * NWAVES, 0, 2048);
#else
                dn_out2(F, gi * NWAVES + F.wave, 224 * NWAVES, 0, 224 * NWAVES);
#endif
                if (DEFER_WEIGHTS && (bx & 1)) weight_copies(F, WI_P0, WI_ALL, hi_ * NWAVES + F.wave, 112 * NWAVES); }
#endif
#else
                if (DEFER_WEIGHTS) { __syncthreads(); weight_copies(F, WI_P0, WI_ALL, gi * NWAVES + F.wave, 224 * NWAVES); } }
#endif
                if (SEAM67 && DEFER_WEIGHTS) { asm volatile("s_waitcnt vmcnt(0)" ::: "memory"); if (F.lane == 0) __hip_atomic_fetch_add(F.ctl + CW_WCOPY + 64 * (F.wave & 7), 1u, RLX_AGENT); }
                SUBSTAMP(6)
#endif
#if ASYM_WCOPY && ASYM_DNO
                if (bx & 1) dn_out2(F, 2048 + ((bx >> 6) * 28 + (((bx & 63) - 8) >> 1)) * NWAVES + F.wave, 112 * NWAVES, 0, 4096);
                SUBSTAMP(7)
#else
                dn_out2(F, gi * NWAVES + F.wave, 224 * NWAVES, ASYM_WCOPY ? 224 * NWAVES : 0, 4096); SUBSTAMP(7)
#endif
            }
        } else {
        if (SPLIT23) xcd_barrier_wait(*F.bar);
        for (int task = F.vcu; task < 32; task += F.G) { dn_scan_wg(F, task >> 1, task & 1); __syncthreads(); }
        swa_bias_table(F); __syncthreads();
        swa_main(F, F.vcu * NWAVES + F.wave, F.G * NWAVES);
        __syncthreads();
        dn_out2(F, F.vcu * NWAVES + F.wave, F.G * NWAVES);
        }
#elif FAST_SWA
        if (F.vcu < 16) dn_scan_naive(F, F.vcu);
        else { swa_bias_table(F); __syncthreads(); swa_main(F, (F.vcu - 16) * NWAVES + F.wave, (F.G - 16) * NWAVES); }
#else
        if (F.G > 16) { if (F.vcu < 16) dn_scan_naive(F, F.vcu); else swa_naive(F, (F.vcu - 16) * NWAVES + F.wave, (F.G - 16) * NWAVES); }
        else { for (int bh = F.vcu; bh < 16; bh += F.G) dn_scan_naive(F, bh); swa_naive(F, F.vcu * NWAVES + F.wave, F.G * NWAVES); }
#endif
}
__device__ __forceinline__ void run_phase4(Frame& F0) {
    Frame F = F0; asm volatile("" : "+v"(F.tid)); F.lane = F.tid & 63;
    unsigned char* ws = F.ws; bf16* XB = (bf16*)(ws + WS_XB); bf16* Y = (bf16*)(ws + WS_Y); bf16* PROJ = (bf16*)(ws + WS_PROJ); (void)XB; (void)Y; (void)PROJ;
}
__device__ __forceinline__ void run_phase5(Frame& F0) {
    Frame F = F0; asm volatile("" : "+v"(F.tid)); F.lane = F.tid & 63;
    unsigned char* ws = F.ws; bf16* XB = (bf16*)(ws + WS_XB); bf16* Y = (bf16*)(ws + WS_Y); bf16* PROJ = (bf16*)(ws + WS_PROJ); (void)XB; (void)Y; (void)PROJ;
        pg8::Gemm g{PROJ + PC_YDN, (const bf16*)(ws + WS_WAB), 2 * M, 2 * D, DN_W, NP, M / 256, (PC_YSW - PC_YDN) * 2};
        pg8::PairedOrder S; S.init(M, D, F.G, (int)blockIdx.x);
        if (SEAM35 && F.G == 256) {
            pg8::Unit u0;
            if (S.next(0, u0) && F.wave == 0) { gu32* pc = F.ctl + CW_PAN + 64 * u0.pm;
                for (unsigned sp = 0; sp < (1u << 18); ++sp) {
                    const unsigned a0 = (unsigned)__builtin_amdgcn_readfirstlane((int)__hip_atomic_load(pc, RLX_AGENT)), a1 = (unsigned)__builtin_amdgcn_readfirstlane((int)__hip_atomic_load(pc + 1, RLX_AGENT)), a2 = (unsigned)__builtin_amdgcn_readfirstlane((int)__hip_atomic_load(pc + 2, RLX_AGENT));
                    if (a0 >= 64u && a1 >= 64u && a2 >= 7u) break;
                    __builtin_amdgcn_s_sleep(4); }
                __builtin_amdgcn_fence(__ATOMIC_ACQUIRE, "agent"); asm volatile("s_waitcnt vmcnt(0)" ::: "memory"); }
            __syncthreads(); }
#if P5_TOUCH_G
        {
            pg8::Unit u0; if (S.next(0, u0)) { const bf16* gt = PROJ + PC_G + (size_t)u0.pm * 256 * NP + u0.pn * 256;
#pragma unroll
                for (int i = 0; i < 4; ++i) { const int line = i * 512 + F.tid, half = line >> 10, row = (line >> 2) & 255, seg = line & 3;
                    __builtin_amdgcn_global_load_lds((const unsigned*)(gt + (size_t)row * NP + half * 1024 + seg * 64), (LAS unsigned*)(F.lds + LDSCTL_OFF + 1024 + F.wave * 256), 4, 0, 0); } } }
#endif
        pg8::EpiMerge E{PROJ + PC_G, NP, XB, D, M / 256, D / 256};
        pg8::gemm_phase<pg8::EpiMerge, pg8::PairedOrder, ALIGN_P5, true>(F.lds + RING_OFF, g, S, E);
        SUBSTAMP(1)
        if (SEAM56 && F.G == 256) {
            pg8::Unit u0; if (S.next(0, u0) && F.tid == 0) __hip_atomic_fetch_add(F.ctl + CW_P56 + 64 * u0.pm, 1u, RLX_AGENT); }
}
__device__ __forceinline__ void run_phase6(Frame& F0) {
    Frame F = F0; asm volatile("" : "+v"(F.tid)); F.lane = F.tid & 63;
    unsigned char* ws = F.ws; bf16* XB = (bf16*)(ws + WS_XB); bf16* Y = (bf16*)(ws + WS_Y); bf16* PROJ = (bf16*)(ws + WS_PROJ); (void)XB; (void)Y; (void)PROJ;
        pg8::Gemm g{XB, (const bf16*)(ws + WS_WOUT), M, D, D}; pg8::StaticOrder S; S.init(M, D, F.G, (int)blockIdx.x);
        {
            pg8::Unit u0; if (P6_TOUCH_X && S.next(0, u0)) { const float* xt = FIN(0) + (size_t)u0.pm * 256 * D + u0.pn * 256;
#pragma unroll
                for (int i = 0; i < 4; ++i) { const int line = (F.wave * 4 + i) * 64 + F.lane;
                    __builtin_amdgcn_global_load_lds((const unsigned*)(xt + (size_t)(line >> 3) * D + (line & 7) * 32), (LAS unsigned*)(F.lds + LDSCTL_OFF + 1024 + F.wave * 256), 4, 0, 0); } } }
#if P6_TOUCH_AB
        {
            pg8::Unit u0; if (S.next(0, u0)) {
                const char* bt = (const char*)(ws + WS_WOUT) + (size_t)u0.pn * 256 * D * 2; const char* at = (const char*)XB + (size_t)u0.pm * 256 * D * 2;
#pragma unroll
                for (int i = 0; i < 8; ++i) { const int line = i * 512 + F.tid;
                    __builtin_amdgcn_global_load_lds((const unsigned*)(bt + (size_t)line * 128), (LAS unsigned*)(F.lds + LDSCTL_OFF + 1024 + F.wave * 256), 4, 0, 0); }
#if P6_TOUCH_AB > 1
#pragma unroll
                for (int i = 0; i < 8; ++i) { const int line = i * 512 + F.tid;
                    __builtin_amdgcn_global_load_lds((const unsigned*)(at + (size_t)line * 128), (LAS unsigned*)(F.lds + LDSCTL_OFF + 1024 + F.wave * 256), 4, 0, 0); }
#endif
            } }
#endif
        if (SEAM56 && F.G == 256) {
            pg8::Unit u0;
            if (S.next(0, u0) && F.wave == 0) {
                for (unsigned sp = 0; sp < (1u << 18); ++sp) {
                    bool ok = (unsigned)__builtin_amdgcn_readfirstlane((int)__hip_atomic_load(F.ctl + CW_P56 + 64 * u0.pm, RLX_AGENT)) >= 4u;
                    if (SEAM35 && ok) { unsigned tot = 0u;
                        for (int q = 0; q < 8; ++q) tot += (unsigned)__builtin_amdgcn_readfirstlane((int)__hip_atomic_load(F.ctl + CW_SWADONE + 64 * q, RLX_AGENT));
                        ok = tot >= (unsigned)(BATCH * SW_H * (SEQ / 32)); }
                    if (ok) break;
                    __builtin_amdgcn_s_sleep(2); }
                __builtin_amdgcn_fence(__ATOMIC_ACQUIRE, "agent"); asm volatile("s_waitcnt vmcnt(0)" ::: "memory"); }
            __syncthreads(); }
        pg8::EpiX1 E{FIN(0), F.out, Y, (float*)(ws + WS_SSQ2), D};
        pg8::gemm_phase<pg8::EpiX1, pg8::StaticOrder, ALIGN_P6, true>(F.lds + RING_OFF, g, S, E);
        if (SEAM67 && F.G == 256) { pg8::Unit u0; if (S.next(0, u0) && F.tid == 0) __hip_atomic_fetch_add(F.ctl + CW_PAN + 64 * u0.pm + 3, 1u, RLX_AGENT); }
        SUBSTAMP(2)
}
__device__ __forceinline__ void run_phase7(Frame& F0) {
    Frame F = F0; asm volatile("" : "+v"(F.tid)); F.lane = F.tid & 63;
    unsigned char* ws = F.ws; bf16* XB = (bf16*)(ws + WS_XB); bf16* Y = (bf16*)(ws + WS_Y); bf16* PROJ = (bf16*)(ws + WS_PROJ); (void)XB; (void)Y; (void)PROJ;
        pg8::Gemm g{Y, (const bf16*)(ws + WS_WGU), M, 2 * FF, D};
        pg8::EpiSwiGLU E{PROJ, FF, (const float*)(ws + WS_SSQ2), EPS};
#if SEAM67
        if (F.G == 256) {
            pg8::SkewOrder S; S.init(M, 2 * FF, F.G, (int)blockIdx.x); S.pan = (const unsigned*)(F.ctl + CW_PAN); S.p56 = (const unsigned*)(F.ctl + CW_P56); S.act_row_bytes = FF * 2; S.proj_row_bytes = NP * 2;
            pg8::Unit u0;
            if (S.next(0, u0) && F.wave == 0) {
                const int fm = u0.pm & ~7;
                for (unsigned sp = 0; sp < (1u << 18); ++sp) {
                    unsigned wc_ = 0u;
                    for (int q = 0; q < 8; ++q) wc_ += (unsigned)__builtin_amdgcn_readfirstlane((int)__hip_atomic_load(F.ctl + CW_WCOPY + 64 * q, RLX_AGENT));
                    bool ok = wc_ >= 224u * NWAVES;
                    if (SKEW_CHK_ALL) ok = ok && S.panel_ready(u0.pm);
                    else for (int q = 0; q < 8; ++q) ok = ok && S.panel_ready(fm + q);
                    if (ok) break;
                    __builtin_amdgcn_s_sleep(4); }
                __builtin_amdgcn_fence(__ATOMIC_ACQUIRE, "agent"); asm volatile("s_waitcnt vmcnt(0)" ::: "memory"); }
            __syncthreads();
            pg8::gemm_phase<pg8::EpiSwiGLU, pg8::SkewOrder, ALIGN_P7, true>(F.lds + RING_OFF, g, S, E);
            if (SEAM78 && F.tid == 0) {
                pg8::Unit u_; for (int i_ = 0; S.next(i_, u_); ++i_) __hip_atomic_fetch_add(F.ctl + CW_PAN + 64 * u_.pm + 4, 1u, RLX_AGENT); }
            SUBSTAMP(0)
            return;
        }
#endif
#if TAIL_SPLIT
        pg8::TailSplitOrder S; S.init(M, 2 * FF, F.G, (int)blockIdx.x);
#else
        pg8::StaticOrder S; S.init(M, 2 * FF, F.G, (int)blockIdx.x);
#endif
#if TAIL_SPLIT
        pg8::gemm_phase<pg8::EpiSwiGLU, pg8::TailSplitOrder, ALIGN_P7, true, true>(F.lds + RING_OFF, g, S, E);
#else
        pg8::gemm_phase<pg8::EpiSwiGLU, pg8::StaticOrder, ALIGN_P7, SP2_P7>(F.lds + RING_OFF, g, S, E);
#endif
}
__device__ __forceinline__ void run_phase8(Frame& F0) {
    Frame F = F0; asm volatile("" : "+v"(F.tid)); F.lane = F.tid & 63;
    unsigned char* ws = F.ws; bf16* XB = (bf16*)(ws + WS_XB); bf16* Y = (bf16*)(ws + WS_Y); bf16* PROJ = (bf16*)(ws + WS_PROJ); (void)XB; (void)Y; (void)PROJ;
        pg8::Gemm g{PROJ, (const bf16*)(ws + WS_WD), M, D, FF}; pg8::StaticOrder S; S.init(M, D, F.G, (int)blockIdx.x);
        if (SEAM78 && SEAM67 && F.G == 256) {
            pg8::Unit u0;
            if (S.next(0, u0) && F.wave == 0) {
                for (unsigned sp = 0; sp < (1u << 18); ++sp) {
                    bool ok = (unsigned)__builtin_amdgcn_readfirstlane((int)__hip_atomic_load(F.ctl + CW_PAN + 64 * u0.pm + 4, RLX_AGENT)) >= 22u;
                    if (ok) { unsigned tot = 0u;
                        for (int q = 0; q < 8; ++q) tot += (unsigned)__builtin_amdgcn_readfirstlane((int)__hip_atomic_load(F.ctl + CW_NORMDONE + 64 * q, RLX_AGENT));
                        ok = tot >= 4096u; }
                    if (ok) break;
                    __builtin_amdgcn_s_sleep(4); }
                __builtin_amdgcn_fence(__ATOMIC_ACQUIRE, "agent"); asm volatile("s_waitcnt vmcnt(0)" ::: "memory"); }
            __syncthreads(); }
        pg8::EpiOut E{F.out, D, Y};
        pg8::gemm_phase<pg8::EpiOut, pg8::StaticOrder, ALIGN_P8, true>(F.lds + RING_OFF, g, S, E);
        SUBSTAMP(4)
}
#ifndef PROGRAM
#define PROGRAM RUN(0) BAR RUN(1) BAR RUN(2) BAR23 RUN(3) if (!(SEAM35 && F.G == 256)) { BAR } RUN(5) if (!(SEAM56 && F.G == 256)) { BAR } RUN(6) if (!(SEAM67 && F.G == 256)) { BAR } RUN(7) if (!(SEAM78 && SEAM67 && F.G == 256)) { BAR } RUN(8)
#endif
__global__ void __launch_bounds__(NWAVES * 64, 2) fwd_kernel(Args args) {
    extern __shared__ __attribute__((aligned(16))) unsigned char lds[];
    Frame F;
    F.lds = (LAS unsigned char*)lds;
    F.MISC = (volatile LAS unsigned*)(F.lds + MISC_OFF);
    F.tid = threadIdx.x; F.lane = F.tid & 63; F.wave = __builtin_amdgcn_readfirstlane(F.tid >> 6);
    F.G = gridDim.x; { const int bx = blockIdx.x; F.vcu = (F.G % 8 == 0) ? (bx % 8) * (F.G / 8) + bx / 8 : bx; }
    F.ka = (KArgs)__builtin_amdgcn_kernarg_segment_ptr();
    F.out = args.out; F.ws = args.ws; unsigned char* ws = args.ws;
    F.ctl = (gu32*)(ws + WS_CTL);
    for (int u = F.tid; u < (LDS_BYTES - LDSCTL_OFF) / 4; u += NWAVES * 64) ((LAS unsigned*)(F.lds + LDSCTL_OFF))[u] = 0u;
    __syncthreads();
    XcdBarrier bar; bar.bar = (unsigned*)(F.ctl + CW_BAR) + args.li * XCD_BAR_WORDS; bar.x = 0; bar.st = nullptr;
    bar = xcd_barrier_post((unsigned*)(F.ctl + CW_BAR) + args.li * XCD_BAR_WORDS, F.MISC + 8);
    F.bar = &bar;
#if STAMP_PHASE >= 0
#if STAMP_SUB >= 0 || STAMP_DN >= 0
#define STAMP_()
#else
    int ns_ = 0;
#define STAMP_() { if (ns_ == STAMP_PHASE || ns_ == STAMP_PHASE + 1) { unsigned long long t_; asm volatile("s_memrealtime %0\n\ts_waitcnt lgkmcnt(0)" : "=s"(t_) :: "memory"); g_ts[ns_ - STAMP_PHASE] = t_; } ++ns_; }
#endif
#define RUN(k) run_phase##k(F);
#define BAR xcd_barrier(bar); STAMP_()
#define BAR23 if (SPLIT23) xcd_barrier_arrive(bar); else xcd_barrier(bar); STAMP_()
    STAMP_()
    PROGRAM
    BAR
#if STAMP_WS
    if (blockIdx.x == 0 && F.tid == 0) F.out[0] += (float)args.ws_mib;
#elif STAMP_DN >= 0
    if (blockIdx.x == STAMP_BLOCK && F.tid == 0) F.out[0] += (float)(g_dn[STAMP_DN]) * 0.01f;
#elif STAMP_SUB >= 0
    if (blockIdx.x == STAMP_BLOCK && F.tid == 0) F.out[0] += floorf((float)(g_sub[STAMP_SUBB] - g_sub[STAMP_SUB]) * 0.01f / STAMP_Q + 0.5f) * STAMP_Q - STAMP_OFF;
#else
    if (blockIdx.x == 0 && F.tid == 0) F.out[0] += floorf((float)(g_ts[1] - g_ts[0]) * 0.01f / STAMP_Q + 0.5f) * STAMP_Q - STAMP_OFF;
#endif
#undef RUN
#undef BAR
#undef BAR23
#else
#define RUN(k) run_phase##k(F);
#define BAR xcd_barrier(bar);
#define BAR23 if (SPLIT23) xcd_barrier_arrive(bar); else xcd_barrier(bar);
    PROGRAM
#if STAMP_WS
    BAR
    if (blockIdx.x == 0 && F.tid == 0) F.out[0] += (float)args.ws_mib;
#endif
#undef RUN
#undef BAR
#undef BAR23
#endif
}

extern "C" void kernel_launch(void* const* d_in, const int* in_sizes, int n_in, void* d_out, int out_size, void* d_ws, size_t ws_size, hipStream_t stream) {
    static int grid = 0;
    if (grid == 0) {
        if (n_in != 18 || in_sizes[0] != M * D || out_size != M * D || ws_size < WS_END) { fprintf(stderr, "kernel_launch: unexpected shapes (n_in %d, in0 %d, out %d, ws %zu)\n", n_in, n_in > 0 ? in_sizes[0] : -1, out_size, ws_size); grid = -1; return; }
        int dev = 0, cus = 0;
        if (hipGetDevice(&dev) != hipSuccess || hipDeviceGetAttribute(&cus, hipDeviceAttributeMultiprocessorCount, dev) != hipSuccess) { grid = -1; return; }
        if (hipFuncSetAttribute((const void*)fwd_kernel, hipFuncAttributeMaxDynamicSharedMemorySize, LDS_BYTES) != hipSuccess) { fprintf(stderr, "kernel_launch: hipFuncSetAttribute failed\n"); grid = -1; return; }
        int per_cu = 0;
        if (hipOccupancyMaxActiveBlocksPerMultiprocessor(&per_cu, (const void*)fwd_kernel, NWAVES * 64, LDS_BYTES) != hipSuccess || per_cu < 1) fprintf(stderr, "kernel_launch: occupancy query reports %d\n", per_cu);
        (void)hipGetLastError();
        grid = FORCE_GRID ? FORCE_GRID : cus;
    }
    if (grid < 0) return;
    if (hipMemsetAsync((char*)d_ws + WS_CTL, 0, CTL_ZERO_BYTES, stream) != hipSuccess) return;
    Args a{};
    for (int i = 0; i < 18; ++i) a.in[i] = (const float*)d_in[i];
    a.out = (float*)d_out; a.ws = (unsigned char*)d_ws; a.ws_mib = (int)(ws_size >> 20);
    for (int li = 0; li < 1; ++li) {
        a.ph_lo = 0; a.ph_hi = 0;
        a.li = li;
        hipLaunchKernelGGL(fwd_kernel, dim3(grid), dim3(NWAVES * 64), LDS_BYTES, stream, a);
        const hipError_t le = hipPeekAtLastError();
        if (le != hipSuccess) { fprintf(stderr, "kernel_launch: launch %d failed: %s\n", li, hipGetErrorName(le)); break; }
    }
}
```
